# Optimizing an MI355X kernel written in HIP

```python
import jax, jax.numpy as jnp
from jax import lax
import numpy as np

D_MODEL = 1024
BATCH = 16
SEQ = 2048
DEPTH = 1

N_Q_HEADS = 8
N_KV_HEADS = 2
HEAD_DIM = 64
ATTN_WIDTH = N_Q_HEADS * HEAD_DIM
KV_WIDTH = N_KV_HEADS * HEAD_DIM
WINDOW = 128
BLOCK = 128
ROPE_THETA = 500000.0
ROPE_DIM = HEAD_DIM // 4
CONV_WIDTH = D_MODEL - ATTN_WIDTH
CONV_GROUPS = 8
CONV_WIDTH_K = 31
MIX_WIDTH = ATTN_WIDTH + CONV_WIDTH
IN_WIDTH = ATTN_WIDTH + 2 * KV_WIDTH + 2 * CONV_WIDTH
PEER_HEADS = 8
N_KEYS = 128
N_EXPERTS = N_KEYS * N_KEYS
PEER_QUERY_DIM = 256
PEER_HALF = PEER_QUERY_DIM // 2
PEER_TOPK = 16
PEER_CHUNK = 128
PLE_DIM = 256
DEEPNORM_ALPHA = (2 * DEPTH) ** 0.25
DEEPNORM_BETA = (8 * DEPTH) ** -0.25
LN_EPS = 1e-5
NEG_INF = -1e30

kernel_name = "hymba_conv_swa_sink_peer_deepnorm_ple"


def layer_norm(x, g, b):
    xf = x.astype(jnp.float32)
    mu = jnp.mean(xf, axis=-1, keepdims=True)
    var = jnp.mean(jnp.square(xf - mu), axis=-1, keepdims=True)
    y = (xf - mu) * lax.rsqrt(var + LN_EPS) * g.astype(jnp.float32) + b.astype(jnp.float32)
    return y.astype(x.dtype)


def partial_rotary(t, positions):
    half = ROPE_DIM // 2
    inv_freq = ROPE_THETA ** (-jnp.arange(half, dtype=jnp.float32) * (2.0 / ROPE_DIM))
    ang = positions.astype(jnp.float32)[..., None] * inv_freq
    cos = jnp.cos(ang)[:, :, None, :]
    sin = jnp.sin(ang)[:, :, None, :]
    tr = t[..., :ROPE_DIM].astype(jnp.float32)
    t1, t2 = tr[..., :half], tr[..., half:]
    rot = jnp.concatenate([t1 * cos - t2 * sin, t2 * cos + t1 * sin], axis=-1).astype(t.dtype)
    return jnp.concatenate([rot, t[..., ROPE_DIM:]], axis=-1)


def sliding_window_attention(q, k, v, sinks):
    b, s = q.shape[0], q.shape[1]
    nb = s // BLOCK
    g = N_Q_HEADS // N_KV_HEADS
    qb = q.reshape(b, nb, BLOCK, N_KV_HEADS, g, HEAD_DIM)

    def band(t):
        tp = jnp.pad(t, ((0, 0), (BLOCK, 0), (0, 0), (0, 0)))
        tp = tp.reshape(b, nb + 1, BLOCK, N_KV_HEADS, HEAD_DIM)
        return jnp.concatenate([tp[:, :-1], tp[:, 1:]], axis=2)

    kb, vb = band(k), band(v)
    scores = jnp.einsum('bnqkgd,bnskd->bnkgqs', qb, kb).astype(jnp.float32) * (HEAD_DIM ** -0.5)
    qi = jnp.arange(BLOCK)[:, None]
    si = jnp.arange(2 * BLOCK)[None, :]
    diff = qi + BLOCK - si
    blk = jnp.arange(nb)[:, None, None]
    valid = (diff >= 0) & (diff < WINDOW) & (blk * BLOCK - BLOCK + si[None] >= 0)
    scores = jnp.where(valid[None, :, None, None], scores, NEG_INF)
    sink = sinks.astype(jnp.float32).reshape(1, 1, N_KV_HEADS, g, 1, 1)
    m = jnp.maximum(jnp.max(scores, axis=-1, keepdims=True), sink)
    e = jnp.exp(scores - m)
    denom = jnp.sum(e, axis=-1, keepdims=True) + jnp.exp(sink - m)
    probs = (e / denom).astype(v.dtype)
    out = jnp.einsum('bnkgqs,bnskd->bnqkgd', probs, vb)
    return out.reshape(b, s, ATTN_WIDTH)


def conv_group(a, gate, conv_w, conv_b, ln_g, ln_b):
    h = a * jax.nn.sigmoid(gate)
    h = lax.conv_general_dilated(
        h, conv_w[:, None, :].astype(h.dtype), window_strides=(1,),
        padding=((CONV_WIDTH_K - 1, 0),),
        dimension_numbers=('NWC', 'WIO', 'NWC'),
        feature_group_count=CONV_WIDTH) + conv_b
    h = layer_norm(h, ln_g, ln_b)
    return jax.nn.silu(h)


def peer(x, w_query, sub_keys, u_table, v_table):
    b, s, d = x.shape
    t = b * s
    xt = x.reshape(t, d)
    q = (xt @ w_query).reshape(t, PEER_HEADS, 2, PEER_HALF)
    sc = jnp.einsum('thpc,hpnc->thpn', q, sub_keys).astype(jnp.float32)
    top_s, top_i = lax.top_k(sc, PEER_TOPK)
    cand = top_s[:, :, 0, :, None] + top_s[:, :, 1, None, :]
    best_s, best_c = lax.top_k(cand.reshape(t, PEER_HEADS, PEER_TOPK * PEER_TOPK), PEER_TOPK)
    i1 = jnp.take_along_axis(top_i[:, :, 0], best_c // PEER_TOPK, axis=-1)
    i2 = jnp.take_along_axis(top_i[:, :, 1], best_c % PEER_TOPK, axis=-1)
    n_chunks = t // PEER_CHUNK
    ids = (i1 * N_KEYS + i2).reshape(n_chunks, PEER_CHUNK, PEER_HEADS * PEER_TOPK)
    gates = jax.nn.softmax(best_s, axis=-1).astype(x.dtype).reshape(n_chunks, PEER_CHUNK, PEER_HEADS * PEER_TOPK)
    xc = xt.reshape(n_chunks, PEER_CHUNK, d)

    def chunk(args):
        xk, idk, gk = args
        u = jnp.take(u_table, idk, axis=0)
        h = jnp.einsum('cd,ced->ce', xk, u)
        act = jax.nn.gelu(h, approximate=False) * gk
        return jnp.einsum('ce,ced->cd', act, jnp.take(v_table, idk, axis=0))

    out = lax.map(chunk, (xc, ids, gates))
    return out.reshape(b, s, d)


def setup_inputs(seed: int = 0) -> dict:
    key = jax.random.key(seed)
    ks = jax.random.split(key, 24)
    f32 = jnp.float32
    nrm = lambda k, shape, scale: jax.random.normal(k, shape, f32) * scale
    x = jax.random.normal(ks[0], (BATCH, SEQ, D_MODEL), f32)
    p = jax.random.normal(ks[1], (DEPTH, BATCH, SEQ, PLE_DIM), f32)
    offsets = jax.random.randint(ks[2], (BATCH,), 0, 1024, dtype=jnp.int32)
    positions = (offsets[:, None] + jnp.arange(SEQ, dtype=jnp.int32)[None, :]).astype(jnp.int32)
    return {
        "x": x,
        "p": p,
        "positions": positions,
        "w_in": nrm(ks[3], (DEPTH, D_MODEL, IN_WIDTH), D_MODEL ** -0.5),
        "sinks": nrm(ks[4], (DEPTH, N_Q_HEADS), 0.5),
        "conv_w": nrm(ks[5], (DEPTH, CONV_WIDTH_K, CONV_WIDTH), CONV_WIDTH_K ** -0.5),
        "conv_b": nrm(ks[6], (DEPTH, CONV_WIDTH), 0.01),
        "conv_ln_g": 1.0 + nrm(ks[7], (DEPTH, CONV_WIDTH), 0.02),
        "conv_ln_b": nrm(ks[8], (DEPTH, CONV_WIDTH), 0.01),
        "w_out": nrm(ks[9], (DEPTH, MIX_WIDTH, D_MODEL), DEEPNORM_BETA * MIX_WIDTH ** -0.5),
        "ln1_g": 1.0 + nrm(ks[10], (DEPTH, D_MODEL), 0.02),
        "ln1_b": nrm(ks[11], (DEPTH, D_MODEL), 0.01),
        "peer_query": nrm(ks[12], (DEPTH, D_MODEL, PEER_HEADS * PEER_QUERY_DIM), D_MODEL ** -0.5),
        "peer_keys": nrm(ks[13], (DEPTH, PEER_HEADS, 2, N_KEYS, PEER_HALF), PEER_HALF ** -0.5),
        "peer_u": nrm(ks[14], (DEPTH, N_EXPERTS, D_MODEL), D_MODEL ** -0.5),
        "peer_v": nrm(ks[15], (DEPTH, N_EXPERTS, D_MODEL), DEEPNORM_BETA * PEER_HEADS ** -0.5),
        "ple_proj": nrm(ks[16], (DEPTH, PLE_DIM, D_MODEL), DEEPNORM_BETA * PLE_DIM ** -0.5),
        "ple_gate": nrm(ks[17], (DEPTH, D_MODEL, D_MODEL), D_MODEL ** -0.5),
        "ln2_g": 1.0 + nrm(ks[18], (DEPTH, D_MODEL), 0.02),
        "ln2_b": nrm(ks[19], (DEPTH, D_MODEL), 0.01),
    }


def reference(x, p, positions, w_in, sinks, conv_w, conv_b, conv_ln_g, conv_ln_b, w_out,
              ln1_g, ln1_b, peer_query, peer_keys, peer_u, peer_v, ple_proj, ple_gate,
              ln2_g, ln2_b):
    b, s, _ = x.shape
    splits = [ATTN_WIDTH, ATTN_WIDTH + KV_WIDTH, ATTN_WIDTH + 2 * KV_WIDTH,
              ATTN_WIDTH + 2 * KV_WIDTH + CONV_WIDTH]
    for i in range(DEPTH):
        h = x @ w_in[i]
        q, k, v, ca, cg = jnp.split(h, splits, axis=-1)
        q = partial_rotary(q.reshape(b, s, N_Q_HEADS, HEAD_DIM), positions)
        k = partial_rotary(k.reshape(b, s, N_KV_HEADS, HEAD_DIM), positions)
        v = v.reshape(b, s, N_KV_HEADS, HEAD_DIM)
        attn = sliding_window_attention(q, k, v, sinks[i])
        conv = conv_group(ca, cg, conv_w[i], conv_b[i], conv_ln_g[i], conv_ln_b[i])
        mixed = jnp.concatenate([attn, conv], axis=-1) @ w_out[i]
        x = layer_norm(DEEPNORM_ALPHA * x + mixed, ln1_g[i], ln1_b[i])
        r = DEEPNORM_ALPHA * x + peer(x, peer_query[i], peer_keys[i], peer_u[i], peer_v[i])
        e = jax.nn.sigmoid(r @ ple_gate[i]) * (p[i] @ ple_proj[i])
        x = layer_norm(r + e, ln2_g[i], ln2_b[i])
    return x
```

```cpp
#include <hip/hip_runtime.h>
#include <stdint.h>

typedef unsigned short bf16_t;
typedef short bf16x8 __attribute__((ext_vector_type(8)));
typedef float f32x4 __attribute__((ext_vector_type(4)));
typedef unsigned u32x4 __attribute__((ext_vector_type(4)));

#define T_TOK 32768
#define SEQ 2048
#define DM 1024
#define INW 1792
#define ALPHA 1.189207115002721f
#define LN_EPS 1e-5f

__device__ __forceinline__ bf16_t f2bf(float f) {
    unsigned u = __float_as_uint(f);
    u += 0x7fffu + ((u >> 16) & 1u);
    return (bf16_t)(u >> 16);
}
__device__ __forceinline__ float bf2f(bf16_t b) { return __uint_as_float(((unsigned)b) << 16); }
__device__ __forceinline__ float bflo(unsigned w) { return __uint_as_float(w << 16); }
__device__ __forceinline__ float bfhi(unsigned w) { return __uint_as_float(w & 0xffff0000u); }
__device__ __forceinline__ unsigned pack2(float a, float b) { return (unsigned)f2bf(a) | ((unsigned)f2bf(b) << 16); }

__device__ __forceinline__ float wave_sum(float v) {
#pragma unroll
    for (int o = 32; o >= 1; o >>= 1) v += __shfl_xor(v, o);
    return v;
}

struct Params {
    const float *x, *p; const int* pos;
    const float *w_in, *sinks, *conv_w, *conv_b, *cln_g, *cln_b, *w_out, *ln1_g, *ln1_b;
    const float *wq, *keys, *pu, *pv, *ple_proj, *ple_gate, *ln2_g, *ln2_b;
    float* out;
    bf16_t *xb, *pb, *WinT, *WoutT, *WqT, *WgT, *WpT, *keysb, *ub, *vb, *hb, *mixb, *x1b, *qb, *rb;
    float *y1, *x1, *tops, *gates;
    int *topi, *ids;
};

__device__ void cvt_rows(const float* __restrict__ src, bf16_t* __restrict__ dst, size_t n) {
    size_t nv = n / 8;
    for (size_t i = (size_t)blockIdx.x * blockDim.x + threadIdx.x; i < nv; i += (size_t)gridDim.x * blockDim.x) {
        const float4 a = ((const float4*)src)[2 * i], b = ((const float4*)src)[2 * i + 1];
        uint4 o; o.x = pack2(a.x, a.y); o.y = pack2(a.z, a.w); o.z = pack2(b.x, b.y); o.w = pack2(b.z, b.w);
        ((uint4*)dst)[i] = o;
    }
}
__device__ void transpose_cvt(const float* __restrict__ W, bf16_t* __restrict__ Wt, int K, int N, float* tile  ) {
    const int tk = K / 32, tn = N / 32;
    const int tx = threadIdx.x & 31, ty = threadIdx.x >> 5;
    for (int t = blockIdx.x; t < tk * tn; t += gridDim.x) {
        const int k0 = (t / tn) * 32, n0 = (t % tn) * 32;
        __syncthreads();
#pragma unroll
        for (int i = 0; i < 4; ++i) tile[(ty + i * 8) * 33 + tx] = W[(size_t)(k0 + ty + i * 8) * N + n0 + tx];
        __syncthreads();
#pragma unroll
        for (int i = 0; i < 4; ++i) Wt[(size_t)(n0 + ty + i * 8) * K + k0 + tx] = f2bf(tile[tx * 33 + ty + i * 8]);
    }
}

__global__ void __launch_bounds__(256) k_prep(Params p) {
    __shared__ float tile[32 * 33];
    cvt_rows(p.x, p.xb, (size_t)T_TOK * DM);
    cvt_rows(p.p, p.pb, (size_t)T_TOK * 256);
    cvt_rows(p.pu, p.ub, (size_t)16384 * DM);
    cvt_rows(p.pv, p.vb, (size_t)16384 * DM);
    cvt_rows(p.keys, p.keysb, (size_t)16 * 128 * 128);
    transpose_cvt(p.w_in, p.WinT, DM, INW, tile);
    transpose_cvt(p.w_out, p.WoutT, DM, DM, tile);
    transpose_cvt(p.wq, p.WqT, DM, 2048, tile);
    transpose_cvt(p.ple_gate, p.WgT, DM, DM, tile);
    transpose_cvt(p.ple_proj, p.WpT, 256, DM, tile);
}

#define LSTR 72
__device__ __forceinline__ void gemm128(const bf16_t* __restrict__ A, int lda, const bf16_t* __restrict__ Bt, int ldb, int K,
                                        unsigned char* smem, f32x4 (&acc)[4][4]) {
    bf16_t* sA = (bf16_t*)smem;
    bf16_t* sB = sA + 128 * LSTR;
    const int tid = threadIdx.x, lane = tid & 63, wid = tid >> 6;
    const int wr = wid >> 1, wc = wid & 1, fr = lane & 15, fq = lane >> 4;
    u32x4 ra0, ra1, ra2, ra3, rb0, rb1, rb2, rb3;
    const int nk = K / 64;
    const int row0 = tid >> 3, kc8 = (tid & 7) * 8;
    const bf16_t* ga = A + (size_t)row0 * lda + kc8;
    const bf16_t* gb = Bt + (size_t)row0 * ldb + kc8;
    const size_t sa32 = (size_t)32 * lda, sb32 = (size_t)32 * ldb;
    ra0 = *(const u32x4*)(ga); ra1 = *(const u32x4*)(ga + sa32); ra2 = *(const u32x4*)(ga + 2 * sa32); ra3 = *(const u32x4*)(ga + 3 * sa32);
    rb0 = *(const u32x4*)(gb); rb1 = *(const u32x4*)(gb + sb32); rb2 = *(const u32x4*)(gb + 2 * sb32); rb3 = *(const u32x4*)(gb + 3 * sb32);
    bf16_t* wa = sA + row0 * LSTR + kc8;
    bf16_t* wb = sB + row0 * LSTR + kc8;
#pragma unroll 1
    for (int kt = 0; kt < nk; ++kt) {
        *(u32x4*)(wa) = ra0; *(u32x4*)(wa + 32 * LSTR) = ra1; *(u32x4*)(wa + 64 * LSTR) = ra2; *(u32x4*)(wa + 96 * LSTR) = ra3;
        *(u32x4*)(wb) = rb0; *(u32x4*)(wb + 32 * LSTR) = rb1; *(u32x4*)(wb + 64 * LSTR) = rb2; *(u32x4*)(wb + 96 * LSTR) = rb3;
        __syncthreads();
        if (kt + 1 < nk) {
            ga += 64; gb += 64;
            ra0 = *(const u32x4*)(ga); ra1 = *(const u32x4*)(ga + sa32); ra2 = *(const u32x4*)(ga + 2 * sa32); ra3 = *(const u32x4*)(ga + 3 * sa32);
            rb0 = *(const u32x4*)(gb); rb1 = *(const u32x4*)(gb + sb32); rb2 = *(const u32x4*)(gb + 2 * sb32); rb3 = *(const u32x4*)(gb + 3 * sb32);
        }
#pragma unroll
        for (int kk = 0; kk < 2; ++kk) {
            bf16x8 af[4], bfr[4];
#pragma unroll
            for (int mi = 0; mi < 4; ++mi) af[mi] = *(const bf16x8*)(sA + (wr * 64 + mi * 16 + fr) * LSTR + kk * 32 + fq * 8);
#pragma unroll
            for (int ni = 0; ni < 4; ++ni) bfr[ni] = *(const bf16x8*)(sB + (wc * 64 + ni * 16 + fr) * LSTR + kk * 32 + fq * 8);
#pragma unroll
            for (int mi = 0; mi < 4; ++mi)
#pragma unroll
                for (int ni = 0; ni < 4; ++ni)
                    acc[mi][ni] = __builtin_amdgcn_mfma_f32_16x16x32_bf16(bfr[ni], af[mi], acc[mi][ni], 0, 0, 0);
        }
        __syncthreads();
    }
}
__device__ __forceinline__ void zero_acc(f32x4 (&acc)[4][4]) {
#pragma unroll
    for (int a = 0; a < 4; ++a)
#pragma unroll
        for (int b = 0; b < 4; ++b) acc[a][b] = (f32x4){0.f, 0.f, 0.f, 0.f};
}
#define GEMM_SMEM (2 * 128 * LSTR * 2)

__global__ void __launch_bounds__(256) k_gemm_in(Params p) {
    __shared__ __attribute__((aligned(16))) unsigned char smem[GEMM_SMEM];
    const int ntn = INW / 128;
    const int tid = threadIdx.x, lane = tid & 63, wid = tid >> 6, wr = wid >> 1, wc = wid & 1, fr = lane & 15, fq = lane >> 4;
    for (int t = blockIdx.x; t < (T_TOK / 128) * ntn; t += gridDim.x) {
        const int m0 = (t / ntn) * 128, n0 = (t % ntn) * 128;
        f32x4 acc[4][4]; zero_acc(acc);
        gemm128(p.xb + (size_t)m0 * DM, DM, p.WinT + (size_t)n0 * DM, DM, DM, smem, acc);
#pragma unroll
        for (int mi = 0; mi < 4; ++mi) {
            const int row = m0 + wr * 64 + mi * 16 + fr;
            const float posf = (float)p.pos[row];
#pragma unroll
            for (int ni = 0; ni < 4; ++ni) {
                const int col0 = n0 + wc * 64 + ni * 16;
                f32x4 v = acc[mi][ni];
                if (col0 < 640 && (col0 & 63) == 0) {
#pragma unroll
                    for (int r = 0; r < 4; ++r) {
                        const float other = __shfl_xor(v[r], 32);
                        const int j = (fq & 1) * 4 + r;
                        const float inv = powf(500000.0f, -(float)j * 0.125f);
                        float sn, cs; sincosf(posf * inv, &sn, &cs);
                        v[r] = (fq < 2) ? (v[r] * cs - other * sn) : (v[r] * cs + other * sn);
                    }
                }
                uint2 o; o.x = pack2(v[0], v[1]); o.y = pack2(v[2], v[3]);
                *(uint2*)(p.hb + (size_t)row * INW + col0 + fq * 4) = o;
            }
        }
    }
}

#define ASTR 72
__global__ void __launch_bounds__(256) k_attn(Params p) {
    __shared__ __attribute__((aligned(16))) bf16_t sK[256 * ASTR];
    __shared__ __attribute__((aligned(16))) bf16_t sV[256 * ASTR];
    const int tid = threadIdx.x;
    for (int u = blockIdx.x; u < 16 * 16 * 2; u += gridDim.x) {
        const int kvh = u & 1, nb = (u >> 1) & 15, b = u >> 5;
        __syncthreads();
        for (int c = tid; c < 256 * 8; c += 256) {
            const int li = c >> 3, kc = c & 7;
            const int pos = nb * 128 - 128 + li;
            uint4 kv = make_uint4(0, 0, 0, 0), vv = make_uint4(0, 0, 0, 0);
            if (pos >= 0) {
                const bf16_t* base = p.hb + (size_t)(b * SEQ + pos) * INW;
                kv = *(const uint4*)(base + 512 + kvh * 64 + kc * 8);
                vv = *(const uint4*)(base + 640 + kvh * 64 + kc * 8);
            }
            *(uint4*)(sK + li * ASTR + kc * 8) = kv;
            *(uint4*)(sV + li * ASTR + kc * 8) = vv;
        }
        __syncthreads();
        const int qi = tid & 127;
        const size_t trow = (size_t)(b * SEQ + nb * 128 + qi);
        for (int g2 = 0; g2 < 2; ++g2) {
            const int hq = kvh * 4 + g2 * 2 + (tid >> 7);
            float q[64];
            {
                const uint4* qp = (const uint4*)(p.hb + trow * INW + hq * 64);
#pragma unroll
                for (int c = 0; c < 8; ++c) {
                    const uint4 w = qp[c];
                    q[c * 8 + 0] = bflo(w.x) * 0.125f; q[c * 8 + 1] = bfhi(w.x) * 0.125f;
                    q[c * 8 + 2] = bflo(w.y) * 0.125f; q[c * 8 + 3] = bfhi(w.y) * 0.125f;
                    q[c * 8 + 4] = bflo(w.z) * 0.125f; q[c * 8 + 5] = bfhi(w.z) * 0.125f;
                    q[c * 8 + 6] = bflo(w.w) * 0.125f; q[c * 8 + 7] = bfhi(w.w) * 0.125f;
                }
            }
            float o[64];
#pragma unroll
            for (int d = 0; d < 64; ++d) o[d] = 0.f;
            float m = p.sinks[hq], l = 1.0f;
            for (int kk = 0; kk < 128; ++kk) {
                const int li = qi + 1 + kk;
                if (nb * 128 - 128 + li < 0) continue;
                const uint4* kp = (const uint4*)(sK + li * ASTR);
                float s = 0.f;
#pragma unroll
                for (int c = 0; c < 8; ++c) {
                    const uint4 w = kp[c];
                    s += q[c * 8 + 0] * bflo(w.x); s += q[c * 8 + 1] * bfhi(w.x);
                    s += q[c * 8 + 2] * bflo(w.y); s += q[c * 8 + 3] * bfhi(w.y);
                    s += q[c * 8 + 4] * bflo(w.z); s += q[c * 8 + 5] * bfhi(w.z);
                    s += q[c * 8 + 6] * bflo(w.w); s += q[c * 8 + 7] * bfhi(w.w);
                }
                if (s > m) {
                    const float sc = __expf(m - s);
                    l *= sc;
#pragma unroll
                    for (int d = 0; d < 64; ++d) o[d] *= sc;
                    m = s;
                }
                const float pr = __expf(s - m);
                l += pr;
                const uint4* vp = (const uint4*)(sV + li * ASTR);
#pragma unroll
                for (int c = 0; c < 8; ++c) {
                    const uint4 w = vp[c];
                    o[c * 8 + 0] += pr * bflo(w.x); o[c * 8 + 1] += pr * bfhi(w.x);
                    o[c * 8 + 2] += pr * bflo(w.y); o[c * 8 + 3] += pr * bfhi(w.y);
                    o[c * 8 + 4] += pr * bflo(w.z); o[c * 8 + 5] += pr * bfhi(w.z);
                    o[c * 8 + 6] += pr * bflo(w.w); o[c * 8 + 7] += pr * bfhi(w.w);
                }
            }
            const float il = 1.0f / l;
            uint4* op = (uint4*)(p.mixb + trow * DM + hq * 64);
#pragma unroll
            for (int c = 0; c < 8; ++c) {
                uint4 w;
                w.x = pack2(o[c * 8 + 0] * il, o[c * 8 + 1] * il); w.y = pack2(o[c * 8 + 2] * il, o[c * 8 + 3] * il);
                w.z = pack2(o[c * 8 + 4] * il, o[c * 8 + 5] * il); w.w = pack2(o[c * 8 + 6] * il, o[c * 8 + 7] * il);
                op[c] = w;
            }
        }
    }
}

__global__ void __launch_bounds__(256) k_conv(Params p) {
    __shared__ float cv[32 * 512];
    const int tid = threadIdx.x, lane = tid & 63, wid = tid >> 6;
    for (int u = blockIdx.x; u < T_TOK / 32; u += gridDim.x) {
        const int tok0 = u * 32;
        const int s0 = tok0 & (SEQ - 1);
        __syncthreads();
        for (int half = 0; half < 2; ++half) {
            const int c = tid + half * 256;
            float glu[62];
#pragma unroll
            for (int i = 0; i < 62; ++i) {
                const int s = s0 - 30 + i;
                float g = 0.f;
                if (s >= 0) {
                    const bf16_t* base = p.hb + (size_t)(tok0 - 30 + i) * INW;
                    const float a = bf2f(base[768 + c]), gt = bf2f(base[1280 + c]);
                    g = a / (1.0f + __expf(-gt));
                }
                glu[i] = g;
            }
            float w[31];
#pragma unroll
            for (int k = 0; k < 31; ++k) w[k] = p.conv_w[k * 512 + c];
            const float bias = p.conv_b[c];
#pragma unroll
            for (int j = 0; j < 32; ++j) {
                float a = bias;
#pragma unroll
                for (int k = 0; k < 31; ++k) a += w[k] * glu[j + k];
                cv[j * 512 + c] = a;
            }
        }
        __syncthreads();
        for (int jj = 0; jj < 8; ++jj) {
            const int j = wid * 8 + jj;
            float v[8]; float s = 0.f;
#pragma unroll
            for (int i = 0; i < 8; ++i) { v[i] = cv[j * 512 + lane + 64 * i]; s += v[i]; }
            const float mu = wave_sum(s) * (1.0f / 512.0f);
            float q = 0.f;
#pragma unroll
            for (int i = 0; i < 8; ++i) { const float d = v[i] - mu; q += d * d; }
            const float rstd = rsqrtf(wave_sum(q) * (1.0f / 512.0f) + LN_EPS);
#pragma unroll
            for (int i = 0; i < 8; ++i) {
                const int c = lane + 64 * i;
                const float y = (v[i] - mu) * rstd * p.cln_g[c] + p.cln_b[c];
                const float sl = y / (1.0f + __expf(-y));
                p.mixb[(size_t)(tok0 + j) * DM + 512 + c] = f2bf(sl);
            }
        }
    }
}

__global__ void __launch_bounds__(256) k_gemm_out(Params p) {
    __shared__ __attribute__((aligned(16))) unsigned char smem[GEMM_SMEM];
    const int ntn = DM / 128;
    const int tid = threadIdx.x, lane = tid & 63, wid = tid >> 6, wr = wid >> 1, wc = wid & 1, fr = lane & 15, fq = lane >> 4;
    for (int t = blockIdx.x; t < (T_TOK / 128) * ntn; t += gridDim.x) {
        const int m0 = (t / ntn) * 128, n0 = (t % ntn) * 128;
        f32x4 acc[4][4]; zero_acc(acc);
        gemm128(p.mixb + (size_t)m0 * DM, DM, p.WoutT + (size_t)n0 * DM, DM, DM, smem, acc);
#pragma unroll
        for (int mi = 0; mi < 4; ++mi) {
            const int row = m0 + wr * 64 + mi * 16 + fr;
#pragma unroll
            for (int ni = 0; ni < 4; ++ni) {
                const int col = n0 + wc * 64 + ni * 16 + fq * 4;
                const f32x4 xv = *(const f32x4*)(p.x + (size_t)row * DM + col);
                *(f32x4*)(p.y1 + (size_t)row * DM + col) = xv * ALPHA + acc[mi][ni];
            }
        }
    }
}

__device__ __forceinline__ void ln_row(const float* __restrict__ src, const float* __restrict__ g, const float* __restrict__ bta,
                                       float* __restrict__ dstf, bf16_t* __restrict__ dstb, int lane) {
    f32x4 v[4]; float s = 0.f;
#pragma unroll
    for (int i = 0; i < 4; ++i) { v[i] = *(const f32x4*)(src + i * 256 + lane * 4); s += (v[i][0] + v[i][1]) + (v[i][2] + v[i][3]); }
    const float mu = wave_sum(s) * (1.0f / 1024.0f);
    float q = 0.f;
#pragma unroll
    for (int i = 0; i < 4; ++i) { const f32x4 d = v[i] - mu; q += (d[0] * d[0] + d[1] * d[1]) + (d[2] * d[2] + d[3] * d[3]); }
    const float rstd = rsqrtf(wave_sum(q) * (1.0f / 1024.0f) + LN_EPS);
#pragma unroll
    for (int i = 0; i < 4; ++i) {
        const f32x4 gg = *(const f32x4*)(g + i * 256 + lane * 4), bb = *(const f32x4*)(bta + i * 256 + lane * 4);
        const f32x4 y = (v[i] - mu) * rstd * gg + bb;
        *(f32x4*)(dstf + i * 256 + lane * 4) = y;
        if (dstb) { uint2 o; o.x = pack2(y[0], y[1]); o.y = pack2(y[2], y[3]); *(uint2*)(dstb + i * 256 + lane * 4) = o; }
    }
}
__global__ void __launch_bounds__(256) k_ln1(Params p) {
    const int lane = threadIdx.x & 63, wid = threadIdx.x >> 6;
    for (int r = blockIdx.x * 4 + wid; r < T_TOK; r += gridDim.x * 4)
        ln_row(p.y1 + (size_t)r * DM, p.ln1_g, p.ln1_b, p.x1 + (size_t)r * DM, p.x1b + (size_t)r * DM, lane);
}
__global__ void __launch_bounds__(256) k_ln2(Params p) {
    const int lane = threadIdx.x & 63, wid = threadIdx.x >> 6;
    for (int r = blockIdx.x * 4 + wid; r < T_TOK; r += gridDim.x * 4)
        ln_row(p.y1 + (size_t)r * DM, p.ln2_g, p.ln2_b, p.out + (size_t)r * DM, (bf16_t*)nullptr, lane);
}

__global__ void __launch_bounds__(256) k_gemm_q(Params p) {
    __shared__ __attribute__((aligned(16))) unsigned char smem[GEMM_SMEM];
    const int ntn = 2048 / 128;
    const int tid = threadIdx.x, lane = tid & 63, wid = tid >> 6, wr = wid >> 1, wc = wid & 1, fr = lane & 15, fq = lane >> 4;
    for (int t = blockIdx.x; t < (T_TOK / 128) * ntn; t += gridDim.x) {
        const int m0 = (t / ntn) * 128, n0 = (t % ntn) * 128;
        f32x4 acc[4][4]; zero_acc(acc);
        gemm128(p.x1b + (size_t)m0 * DM, DM, p.WqT + (size_t)n0 * DM, DM, DM, smem, acc);
#pragma unroll
        for (int mi = 0; mi < 4; ++mi) {
            const int row = m0 + wr * 64 + mi * 16 + fr;
#pragma unroll
            for (int ni = 0; ni < 4; ++ni) {
                const int col = n0 + wc * 64 + ni * 16 + fq * 4;
                uint2 o; o.x = pack2(acc[mi][ni][0], acc[mi][ni][1]); o.y = pack2(acc[mi][ni][2], acc[mi][ni][3]);
                *(uint2*)(p.qb + (size_t)row * 2048 + col) = o;
            }
        }
    }
}

#define SCS 129
__global__ void __launch_bounds__(256) k_scores_topk(Params p) {
    __shared__ __attribute__((aligned(16))) unsigned char smem[GEMM_SMEM];
    __shared__ float sc[128 * SCS];
    const int tid = threadIdx.x, lane = tid & 63, wid = tid >> 6, wr = wid >> 1, wc = wid & 1, fr = lane & 15, fq = lane >> 4;
    for (int t = blockIdx.x; t < (T_TOK / 128) * 16; t += gridDim.x) {
        const int m0 = (t >> 4) * 128, hp = t & 15;
        f32x4 acc[4][4]; zero_acc(acc);
        gemm128(p.qb + (size_t)m0 * 2048 + hp * 128, 2048, p.keysb + (size_t)hp * 128 * 128, 128, 128, smem, acc);
#pragma unroll
        for (int mi = 0; mi < 4; ++mi)
#pragma unroll
            for (int ni = 0; ni < 4; ++ni)
#pragma unroll
                for (int r = 0; r < 4; ++r)
                    sc[(wr * 64 + mi * 16 + fr) * SCS + wc * 64 + ni * 16 + fq * 4 + r] = acc[mi][ni][r];
        __syncthreads();
        if (tid < 128) {
            float* row = sc + tid * SCS;
            float* os = p.tops + ((size_t)(m0 + tid) * 16 + hp) * 16;
            int* oi = p.topi + ((size_t)(m0 + tid) * 16 + hp) * 16;
            for (int r = 0; r < 16; ++r) {
                float bv = row[0]; int bj = 0;
                for (int j = 1; j < 128; ++j) { const float v = row[j]; if (v > bv) { bv = v; bj = j; } }
                os[r] = bv; oi[r] = bj;
                row[bj] = -3.0e38f;
            }
        }
        __syncthreads();
    }
}

__global__ void __launch_bounds__(256) k_combine(Params p) {
    for (int u = blockIdx.x * 256 + threadIdx.x; u < T_TOK * 8; u += gridDim.x * 256) {
        const int t = u >> 3, h = u & 7;
        float s1[16], s2[16]; int i1[16], i2[16];
        {
            const float* a = p.tops + ((size_t)t * 16 + h * 2) * 16;
            const int* ai = p.topi + ((size_t)t * 16 + h * 2) * 16;
#pragma unroll
            for (int i = 0; i < 16; ++i) { s1[i] = a[i]; s2[i] = a[16 + i]; i1[i] = ai[i]; i2[i] = ai[16 + i]; }
        }
        float pv = 3.0e38f; int pidx = -1;
        float mx = 0.f, den = 0.f;
        float* og = p.gates + (size_t)t * 128 + h * 16;
        int* oid = p.ids + (size_t)t * 128 + h * 16;
#pragma unroll 1
        for (int r = 0; r < 16; ++r) {
            float bv = -3.0e38f; int bidx = 1 << 20, bid = 0;
#pragma unroll
            for (int i = 0; i < 16; ++i) {
#pragma unroll
                for (int j = 0; j < 16; ++j) {
                    if ((i + 1) * (j + 1) <= 16) {
                        const float v = s1[i] + s2[j];
                        const int idx = i * 16 + j;
                        const bool after = (v < pv) || (v == pv && idx > pidx);
                        const bool better = (v > bv) || (v == bv && idx < bidx);
                        if (after && better) { bv = v; bidx = idx; bid = i1[i] * 128 + i2[j]; }
                    }
                }
            }
            pv = bv; pidx = bidx;
            if (r == 0) mx = bv;
            const float e = __expf(bv - mx);
            den += e;
            og[r] = e; oid[r] = bid;
        }
        const float inv = 1.0f / den;
#pragma unroll 1
        for (int r = 0; r < 16; ++r) og[r] *= inv;
    }
}

__global__ void __launch_bounds__(256) k_peer(Params p) {
    const int lane = threadIdx.x & 63, wid = threadIdx.x >> 6;
    for (int t = blockIdx.x * 4 + wid; t < T_TOK; t += gridDim.x * 4) {
        float xv[16];
        {
            const float* xr = p.x1 + (size_t)t * DM;
            const f32x4 a = *(const f32x4*)(xr + lane * 8), b = *(const f32x4*)(xr + lane * 8 + 4);
            const f32x4 c = *(const f32x4*)(xr + 512 + lane * 8), d = *(const f32x4*)(xr + 512 + lane * 8 + 4);
#pragma unroll
            for (int i = 0; i < 4; ++i) { xv[i] = a[i]; xv[4 + i] = b[i]; xv[8 + i] = c[i]; xv[12 + i] = d[i]; }
        }
        float o[16];
#pragma unroll
        for (int i = 0; i < 16; ++i) o[i] = 0.f;
        const int* idp = p.ids + (size_t)t * 128;
        const float* gp = p.gates + (size_t)t * 128;
        for (int e = 0; e < 128; ++e) {
            const int id = idp[e];
            const float gate = gp[e];
            const bf16_t* ur = p.ub + (size_t)id * DM;
            const uint4 u0 = *(const uint4*)(ur + lane * 8), u1 = *(const uint4*)(ur + 512 + lane * 8);
            float s = xv[0] * bflo(u0.x) + xv[1] * bfhi(u0.x) + xv[2] * bflo(u0.y) + xv[3] * bfhi(u0.y)
                    + xv[4] * bflo(u0.z) + xv[5] * bfhi(u0.z) + xv[6] * bflo(u0.w) + xv[7] * bfhi(u0.w)
                    + xv[8] * bflo(u1.x) + xv[9] * bfhi(u1.x) + xv[10] * bflo(u1.y) + xv[11] * bfhi(u1.y)
                    + xv[12] * bflo(u1.z) + xv[13] * bfhi(u1.z) + xv[14] * bflo(u1.w) + xv[15] * bfhi(u1.w);
            s = wave_sum(s);
            const float act = 0.5f * s * (1.0f + erff(s * 0.70710678118654752f)) * gate;
            const bf16_t* vr = p.vb + (size_t)id * DM;
            const uint4 v0 = *(const uint4*)(vr + lane * 8), v1 = *(const uint4*)(vr + 512 + lane * 8);
            o[0] += act * bflo(v0.x); o[1] += act * bfhi(v0.x); o[2] += act * bflo(v0.y); o[3] += act * bfhi(v0.y);
            o[4] += act * bflo(v0.z); o[5] += act * bfhi(v0.z); o[6] += act * bflo(v0.w); o[7] += act * bfhi(v0.w);
            o[8] += act * bflo(v1.x); o[9] += act * bfhi(v1.x); o[10] += act * bflo(v1.y); o[11] += act * bfhi(v1.y);
            o[12] += act * bflo(v1.z); o[13] += act * bfhi(v1.z); o[14] += act * bflo(v1.w); o[15] += act * bfhi(v1.w);
        }
        float r[16];
#pragma unroll
        for (int i = 0; i < 16; ++i) r[i] = ALPHA * xv[i] + o[i];
        float* rr = p.y1 + (size_t)t * DM;
        *(f32x4*)(rr + lane * 8) = (f32x4){r[0], r[1], r[2], r[3]};
        *(f32x4*)(rr + lane * 8 + 4) = (f32x4){r[4], r[5], r[6], r[7]};
        *(f32x4*)(rr + 512 + lane * 8) = (f32x4){r[8], r[9], r[10], r[11]};
        *(f32x4*)(rr + 512 + lane * 8 + 4) = (f32x4){r[12], r[13], r[14], r[15]};
        bf16_t* rb = p.rb + (size_t)t * DM;
        uint4 w0, w1;
        w0.x = pack2(r[0], r[1]); w0.y = pack2(r[2], r[3]); w0.z = pack2(r[4], r[5]); w0.w = pack2(r[6], r[7]);
        w1.x = pack2(r[8], r[9]); w1.y = pack2(r[10], r[11]); w1.z = pack2(r[12], r[13]); w1.w = pack2(r[14], r[15]);
        *(uint4*)(rb + lane * 8) = w0; *(uint4*)(rb + 512 + lane * 8) = w1;
    }
}

__global__ void __launch_bounds__(256) k_gemm_ple(Params p) {
    __shared__ __attribute__((aligned(16))) unsigned char smem[GEMM_SMEM];
    const int ntn = DM / 128;
    const int tid = threadIdx.x, lane = tid & 63, wid = tid >> 6, wr = wid >> 1, wc = wid & 1, fr = lane & 15, fq = lane >> 4;
    for (int t = blockIdx.x; t < (T_TOK / 128) * ntn; t += gridDim.x) {
        const int m0 = (t / ntn) * 128, n0 = (t % ntn) * 128;
        f32x4 acc[4][4], acc2[4][4]; zero_acc(acc); zero_acc(acc2);
        gemm128(p.pb + (size_t)m0 * 256, 256, p.WpT + (size_t)n0 * 256, 256, 256, smem, acc2);
        gemm128(p.rb + (size_t)m0 * DM, DM, p.WgT + (size_t)n0 * DM, DM, DM, smem, acc);
#pragma unroll
        for (int mi = 0; mi < 4; ++mi) {
            const int row = m0 + wr * 64 + mi * 16 + fr;
#pragma unroll
            for (int ni = 0; ni < 4; ++ni) {
                const int col = n0 + wc * 64 + ni * 16 + fq * 4;
                float* yp = p.y1 + (size_t)row * DM + col;
                f32x4 rv = *(const f32x4*)yp;
#pragma unroll
                for (int r = 0; r < 4; ++r) rv[r] += acc2[mi][ni][r] / (1.0f + __expf(-acc[mi][ni][r]));
                *(f32x4*)yp = rv;
            }
        }
    }
}

extern "C" void kernel_launch(void* const* d_in, const int* in_sizes, int n_in, void* d_out, int out_size, void* d_ws, size_t ws_size,
                              hipStream_t stream) {
    Params p{};
    p.x = (const float*)d_in[0]; p.p = (const float*)d_in[1]; p.pos = (const int*)d_in[2];
    p.w_in = (const float*)d_in[3]; p.sinks = (const float*)d_in[4]; p.conv_w = (const float*)d_in[5]; p.conv_b = (const float*)d_in[6];
    p.cln_g = (const float*)d_in[7]; p.cln_b = (const float*)d_in[8]; p.w_out = (const float*)d_in[9]; p.ln1_g = (const float*)d_in[10];
    p.ln1_b = (const float*)d_in[11]; p.wq = (const float*)d_in[12]; p.keys = (const float*)d_in[13]; p.pu = (const float*)d_in[14];
    p.pv = (const float*)d_in[15]; p.ple_proj = (const float*)d_in[16]; p.ple_gate = (const float*)d_in[17]; p.ln2_g = (const float*)d_in[18];
    p.ln2_b = (const float*)d_in[19];
    p.out = (float*)d_out;
    unsigned char* ws = (unsigned char*)d_ws;
    const size_t MiB = 1024 * 1024;
    p.y1 = (float*)(ws + 0 * MiB);
    p.hb = (bf16_t*)(ws + 128 * MiB);
    p.qb = (bf16_t*)(ws + 128 * MiB);
    p.xb = (bf16_t*)(ws + 256 * MiB);
    p.x1b = (bf16_t*)(ws + 256 * MiB);
    p.mixb = (bf16_t*)(ws + 320 * MiB);
    p.tops = (float*)(ws + 320 * MiB);
    p.topi = (int*)(ws + 352 * MiB);
    p.rb = (bf16_t*)(ws + 320 * MiB);
    p.pb = (bf16_t*)(ws + 384 * MiB);
    p.ub = (bf16_t*)(ws + 400 * MiB);
    p.vb = (bf16_t*)(ws + 432 * MiB);
    p.ids = (int*)(ws + 464 * MiB);
    p.gates = (float*)(ws + 480 * MiB);
    unsigned char* wb = ws + 496 * MiB;
    p.WinT = (bf16_t*)wb; wb += (size_t)INW * DM * 2;
    p.WoutT = (bf16_t*)wb; wb += (size_t)DM * DM * 2;
    p.WqT = (bf16_t*)wb; wb += (size_t)2048 * DM * 2;
    p.WgT = (bf16_t*)wb; wb += (size_t)DM * DM * 2;
    p.WpT = (bf16_t*)wb; wb += (size_t)DM * 256 * 2;
    p.keysb = (bf16_t*)wb; wb += (size_t)16 * 128 * 128 * 2;
    p.x1 = (float*)d_out;

    k_prep<<<2048, 256, 0, stream>>>(p);
    k_gemm_in<<<(T_TOK / 128) * (INW / 128), 256, 0, stream>>>(p);
    k_attn<<<512, 256, 0, stream>>>(p);
    k_conv<<<T_TOK / 32, 256, 0, stream>>>(p);
    k_gemm_out<<<(T_TOK / 128) * (DM / 128), 256, 0, stream>>>(p);
    k_ln1<<<2048, 256, 0, stream>>>(p);
    k_gemm_q<<<(T_TOK / 128) * 16, 256, 0, stream>>>(p);
    k_scores_topk<<<(T_TOK / 128) * 16, 256, 0, stream>>>(p);
    k_combine<<<1024, 256, 0, stream>>>(p);
    k_peer<<<T_TOK / 4, 256, 0, stream>>>(p);
    k_gemm_ple<<<(T_TOK / 128) * (DM / 128), 256, 0, stream>>>(p);
    k_ln2<<<2048, 256, 0, stream>>>(p);
}
```

```cpp
#include <hip/hip_runtime.h>
#include <hip/hip_cooperative_groups.h>
#include <stdint.h>
#include <cstdio>
namespace cg = cooperative_groups;

typedef unsigned short bf16_t;
typedef short bf16x8 __attribute__((ext_vector_type(8)));
typedef float f32x4 __attribute__((ext_vector_type(4)));
typedef unsigned u32x4 __attribute__((ext_vector_type(4)));

#define T_TOK 32768
#define SEQ 2048
#define DM 1024
#define INW 1792
#define ALPHA 1.189207115002721f
#define LN_EPS 1e-5f

__device__ __forceinline__ bf16_t f2bf(float f) {
    unsigned u = __float_as_uint(f);
    u += 0x7fffu + ((u >> 16) & 1u);
    return (bf16_t)(u >> 16);
}
__device__ __forceinline__ float bf2f(bf16_t b) { return __uint_as_float(((unsigned)b) << 16); }
__device__ __forceinline__ float bflo(unsigned w) { return __uint_as_float(w << 16); }
__device__ __forceinline__ float bfhi(unsigned w) { return __uint_as_float(w & 0xffff0000u); }
__device__ __forceinline__ unsigned pack2(float a, float b) { return (unsigned)f2bf(a) | ((unsigned)f2bf(b) << 16); }

__device__ __forceinline__ float wave_sum(float v) {
#pragma unroll
    for (int o = 32; o >= 1; o >>= 1) v += __shfl_xor(v, o);
    return v;
}

struct Params {
    const float *x, *p; const int* pos;
    const float *w_in, *sinks, *conv_w, *conv_b, *cln_g, *cln_b, *w_out, *ln1_g, *ln1_b;
    const float *wq, *keys, *pu, *pv, *ple_proj, *ple_gate, *ln2_g, *ln2_b;
    float* out;
    bf16_t *xb, *pb, *WinT, *WoutT, *WqT, *WgT, *WpT, *keysb, *ub, *vb, *hb, *mixb, *x1b, *qb, *rb;
    float *y1, *x1, *tops, *gates;
    int *topi, *ids;
};

__device__ void cvt_rows(const float* __restrict__ src, bf16_t* __restrict__ dst, size_t n) {
    size_t nv = n / 8;
    for (size_t i = (size_t)blockIdx.x * blockDim.x + threadIdx.x; i < nv; i += (size_t)gridDim.x * blockDim.x) {
        const float4 a = ((const float4*)src)[2 * i], b = ((const float4*)src)[2 * i + 1];
        uint4 o; o.x = pack2(a.x, a.y); o.y = pack2(a.z, a.w); o.z = pack2(b.x, b.y); o.w = pack2(b.z, b.w);
        ((uint4*)dst)[i] = o;
    }
}
__device__ void transpose_cvt(const float* __restrict__ W, bf16_t* __restrict__ Wt, int K, int N, float* tile  ) {
    const int tk = K / 32, tn = N / 32;
    const int tx = threadIdx.x & 31, ty = threadIdx.x >> 5;
    for (int t = blockIdx.x; t < tk * tn; t += gridDim.x) {
        const int k0 = (t / tn) * 32, n0 = (t % tn) * 32;
        __syncthreads();
#pragma unroll
        for (int i = 0; i < 4; ++i) tile[(ty + i * 8) * 33 + tx] = W[(size_t)(k0 + ty + i * 8) * N + n0 + tx];
        __syncthreads();
#pragma unroll
        for (int i = 0; i < 4; ++i) Wt[(size_t)(n0 + ty + i * 8) * K + k0 + tx] = f2bf(tile[tx * 33 + ty + i * 8]);
    }
}

__device__ void ph_prep(const Params& p, unsigned char* smem) {
    float* tile = (float*)smem;
    cvt_rows(p.x, p.xb, (size_t)T_TOK * DM);
    cvt_rows(p.p, p.pb, (size_t)T_TOK * 256);
    cvt_rows(p.pu, p.ub, (size_t)16384 * DM);
    cvt_rows(p.pv, p.vb, (size_t)16384 * DM);
    cvt_rows(p.keys, p.keysb, (size_t)16 * 128 * 128);
    transpose_cvt(p.w_in, p.WinT, DM, INW, tile);
    transpose_cvt(p.w_out, p.WoutT, DM, DM, tile);
    transpose_cvt(p.wq, p.WqT, DM, 2048, tile);
    transpose_cvt(p.ple_gate, p.WgT, DM, DM, tile);
    transpose_cvt(p.ple_proj, p.WpT, 256, DM, tile);
}

#define LSTR 72
__device__ __forceinline__ void gemm128(const bf16_t* __restrict__ A, int lda, const bf16_t* __restrict__ Bt, int ldb, int K,
                                        unsigned char* smem, f32x4 (&acc)[4][4]) {
    bf16_t* sA = (bf16_t*)smem;
    bf16_t* sB = sA + 128 * LSTR;
    const int tid = threadIdx.x, lane = tid & 63, wid = tid >> 6;
    const int wr = wid >> 1, wc = wid & 1, fr = lane & 15, fq = lane >> 4;
    u32x4 ra0, ra1, ra2, ra3, rb0, rb1, rb2, rb3;
    const int nk = K / 64;
    const int row0 = tid >> 3, kc8 = (tid & 7) * 8;
    const bf16_t* ga = A + (size_t)row0 * lda + kc8;
    const bf16_t* gb = Bt + (size_t)row0 * ldb + kc8;
    const size_t sa32 = (size_t)32 * lda, sb32 = (size_t)32 * ldb;
    ra0 = *(const u32x4*)(ga); ra1 = *(const u32x4*)(ga + sa32); ra2 = *(const u32x4*)(ga + 2 * sa32); ra3 = *(const u32x4*)(ga + 3 * sa32);
    rb0 = *(const u32x4*)(gb); rb1 = *(const u32x4*)(gb + sb32); rb2 = *(const u32x4*)(gb + 2 * sb32); rb3 = *(const u32x4*)(gb + 3 * sb32);
    bf16_t* wa = sA + row0 * LSTR + kc8;
    bf16_t* wb = sB + row0 * LSTR + kc8;
#pragma unroll 1
    for (int kt = 0; kt < nk; ++kt) {
        *(u32x4*)(wa) = ra0; *(u32x4*)(wa + 32 * LSTR) = ra1; *(u32x4*)(wa + 64 * LSTR) = ra2; *(u32x4*)(wa + 96 * LSTR) = ra3;
        *(u32x4*)(wb) = rb0; *(u32x4*)(wb + 32 * LSTR) = rb1; *(u32x4*)(wb + 64 * LSTR) = rb2; *(u32x4*)(wb + 96 * LSTR) = rb3;
        __syncthreads();
        if (kt + 1 < nk) {
            ga += 64; gb += 64;
            ra0 = *(const u32x4*)(ga); ra1 = *(const u32x4*)(ga + sa32); ra2 = *(const u32x4*)(ga + 2 * sa32); ra3 = *(const u32x4*)(ga + 3 * sa32);
            rb0 = *(const u32x4*)(gb); rb1 = *(const u32x4*)(gb + sb32); rb2 = *(const u32x4*)(gb + 2 * sb32); rb3 = *(const u32x4*)(gb + 3 * sb32);
        }
#pragma unroll
        for (int kk = 0; kk < 2; ++kk) {
            bf16x8 af[4], bfr[4];
#pragma unroll
            for (int mi = 0; mi < 4; ++mi) af[mi] = *(const bf16x8*)(sA + (wr * 64 + mi * 16 + fr) * LSTR + kk * 32 + fq * 8);
#pragma unroll
            for (int ni = 0; ni < 4; ++ni) bfr[ni] = *(const bf16x8*)(sB + (wc * 64 + ni * 16 + fr) * LSTR + kk * 32 + fq * 8);
#pragma unroll
            for (int mi = 0; mi < 4; ++mi)
#pragma unroll
                for (int ni = 0; ni < 4; ++ni)
                    acc[mi][ni] = __builtin_amdgcn_mfma_f32_16x16x32_bf16(bfr[ni], af[mi], acc[mi][ni], 0, 0, 0);
        }
        __syncthreads();
    }
}
__device__ __forceinline__ void zero_acc(f32x4 (&acc)[4][4]) {
#pragma unroll
    for (int a = 0; a < 4; ++a)
#pragma unroll
        for (int b = 0; b < 4; ++b) acc[a][b] = (f32x4){0.f, 0.f, 0.f, 0.f};
}
#define GEMM_SMEM (2 * 128 * LSTR * 2)

__device__ void ph_gemm_in(const Params& p, unsigned char* smem) {
    const int ntn = INW / 128;
    const int tid = threadIdx.x, lane = tid & 63, wid = tid >> 6, wr = wid >> 1, wc = wid & 1, fr = lane & 15, fq = lane >> 4;
    for (int t = blockIdx.x; t < (T_TOK / 128) * ntn; t += gridDim.x) {
        const int m0 = (t / ntn) * 128, n0 = (t % ntn) * 128;
        f32x4 acc[4][4]; zero_acc(acc);
        gemm128(p.xb + (size_t)m0 * DM, DM, p.WinT + (size_t)n0 * DM, DM, DM, smem, acc);
#pragma unroll
        for (int mi = 0; mi < 4; ++mi) {
            const int row = m0 + wr * 64 + mi * 16 + fr;
            const float posf = (float)p.pos[row];
#pragma unroll
            for (int ni = 0; ni < 4; ++ni) {
                const int col0 = n0 + wc * 64 + ni * 16;
                f32x4 v = acc[mi][ni];
                if (col0 < 640 && (col0 & 63) == 0) {
#pragma unroll
                    for (int r = 0; r < 4; ++r) {
                        const float other = __shfl_xor(v[r], 32);
                        const int j = (fq & 1) * 4 + r;
                        const float inv = powf(500000.0f, -(float)j * 0.125f);
                        float sn, cs; sincosf(posf * inv, &sn, &cs);
                        v[r] = (fq < 2) ? (v[r] * cs - other * sn) : (v[r] * cs + other * sn);
                    }
                }
                uint2 o; o.x = pack2(v[0], v[1]); o.y = pack2(v[2], v[3]);
                *(uint2*)(p.hb + (size_t)row * INW + col0 + fq * 4) = o;
            }
        }
    }
}

#define ASTR 72
__device__ void ph_attn(const Params& p, unsigned char* smem) {
    bf16_t* sK = (bf16_t*)smem;
    bf16_t* sV = sK + 256 * ASTR;
    const int tid = threadIdx.x;
    for (int u = blockIdx.x; u < 16 * 16 * 2; u += gridDim.x) {
        const int kvh = u & 1, nb = (u >> 1) & 15, b = u >> 5;
        __syncthreads();
        for (int c = tid; c < 256 * 8; c += 256) {
            const int li = c >> 3, kc = c & 7;
            const int pos = nb * 128 - 128 + li;
            uint4 kv = make_uint4(0, 0, 0, 0), vv = make_uint4(0, 0, 0, 0);
            if (pos >= 0) {
                const bf16_t* base = p.hb + (size_t)(b * SEQ + pos) * INW;
                kv = *(const uint4*)(base + 512 + kvh * 64 + kc * 8);
                vv = *(const uint4*)(base + 640 + kvh * 64 + kc * 8);
            }
            *(uint4*)(sK + li * ASTR + kc * 8) = kv;
            *(uint4*)(sV + li * ASTR + kc * 8) = vv;
        }
        __syncthreads();
        const int qi = tid & 127;
        const size_t trow = (size_t)(b * SEQ + nb * 128 + qi);
        for (int g2 = 0; g2 < 2; ++g2) {
            const int hq = kvh * 4 + g2 * 2 + (tid >> 7);
            float q[64];
            {
                const uint4* qp = (const uint4*)(p.hb + trow * INW + hq * 64);
#pragma unroll
                for (int c = 0; c < 8; ++c) {
                    const uint4 w = qp[c];
                    q[c * 8 + 0] = bflo(w.x) * 0.125f; q[c * 8 + 1] = bfhi(w.x) * 0.125f;
                    q[c * 8 + 2] = bflo(w.y) * 0.125f; q[c * 8 + 3] = bfhi(w.y) * 0.125f;
                    q[c * 8 + 4] = bflo(w.z) * 0.125f; q[c * 8 + 5] = bfhi(w.z) * 0.125f;
                    q[c * 8 + 6] = bflo(w.w) * 0.125f; q[c * 8 + 7] = bfhi(w.w) * 0.125f;
                }
            }
            float o[64];
#pragma unroll
            for (int d = 0; d < 64; ++d) o[d] = 0.f;
            float m = p.sinks[hq], l = 1.0f;
            for (int kk = 0; kk < 128; ++kk) {
                const int li = qi + 1 + kk;
                if (nb * 128 - 128 + li < 0) continue;
                const uint4* kp = (const uint4*)(sK + li * ASTR);
                float s = 0.f;
#pragma unroll
                for (int c = 0; c < 8; ++c) {
                    const uint4 w = kp[c];
                    s += q[c * 8 + 0] * bflo(w.x); s += q[c * 8 + 1] * bfhi(w.x);
                    s += q[c * 8 + 2] * bflo(w.y); s += q[c * 8 + 3] * bfhi(w.y);
                    s += q[c * 8 + 4] * bflo(w.z); s += q[c * 8 + 5] * bfhi(w.z);
                    s += q[c * 8 + 6] * bflo(w.w); s += q[c * 8 + 7] * bfhi(w.w);
                }
                if (s > m) {
                    const float sc = __expf(m - s);
                    l *= sc;
#pragma unroll
                    for (int d = 0; d < 64; ++d) o[d] *= sc;
                    m = s;
                }
                const float pr = __expf(s - m);
                l += pr;
                const uint4* vp = (const uint4*)(sV + li * ASTR);
#pragma unroll
                for (int c = 0; c < 8; ++c) {
                    const uint4 w = vp[c];
                    o[c * 8 + 0] += pr * bflo(w.x); o[c * 8 + 1] += pr * bfhi(w.x);
                    o[c * 8 + 2] += pr * bflo(w.y); o[c * 8 + 3] += pr * bfhi(w.y);
                    o[c * 8 + 4] += pr * bflo(w.z); o[c * 8 + 5] += pr * bfhi(w.z);
                    o[c * 8 + 6] += pr * bflo(w.w); o[c * 8 + 7] += pr * bfhi(w.w);
                }
            }
            const float il = 1.0f / l;
            uint4* op = (uint4*)(p.mixb + trow * DM + hq * 64);
#pragma unroll
            for (int c = 0; c < 8; ++c) {
                uint4 w;
                w.x = pack2(o[c * 8 + 0] * il, o[c * 8 + 1] * il); w.y = pack2(o[c * 8 + 2] * il, o[c * 8 + 3] * il);
                w.z = pack2(o[c * 8 + 4] * il, o[c * 8 + 5] * il); w.w = pack2(o[c * 8 + 6] * il, o[c * 8 + 7] * il);
                op[c] = w;
            }
        }
    }
}

__device__ void ph_conv(const Params& p, unsigned char* smem) {
    float* cv = (float*)smem;
    const int tid = threadIdx.x, lane = tid & 63, wid = tid >> 6;
    for (int u = blockIdx.x; u < T_TOK / 32; u += gridDim.x) {
        const int tok0 = u * 32;
        const int s0 = tok0 & (SEQ - 1);
        __syncthreads();
        for (int half = 0; half < 2; ++half) {
            const int c = tid + half * 256;
            float glu[62];
#pragma unroll
            for (int i = 0; i < 62; ++i) {
                const int s = s0 - 30 + i;
                float g = 0.f;
                if (s >= 0) {
                    const bf16_t* base = p.hb + (size_t)(tok0 - 30 + i) * INW;
                    const float a = bf2f(base[768 + c]), gt = bf2f(base[1280 + c]);
                    g = a / (1.0f + __expf(-gt));
                }
                glu[i] = g;
            }
            float w[31];
#pragma unroll
            for (int k = 0; k < 31; ++k) w[k] = p.conv_w[k * 512 + c];
            const float bias = p.conv_b[c];
#pragma unroll
            for (int j = 0; j < 32; ++j) {
                float a = bias;
#pragma unroll
                for (int k = 0; k < 31; ++k) a += w[k] * glu[j + k];
                cv[j * 512 + c] = a;
            }
        }
        __syncthreads();
        for (int jj = 0; jj < 8; ++jj) {
            const int j = wid * 8 + jj;
            float v[8]; float s = 0.f;
#pragma unroll
            for (int i = 0; i < 8; ++i) { v[i] = cv[j * 512 + lane + 64 * i]; s += v[i]; }
            const float mu = wave_sum(s) * (1.0f / 512.0f);
            float q = 0.f;
#pragma unroll
            for (int i = 0; i < 8; ++i) { const float d = v[i] - mu; q += d * d; }
            const float rstd = rsqrtf(wave_sum(q) * (1.0f / 512.0f) + LN_EPS);
#pragma unroll
            for (int i = 0; i < 8; ++i) {
                const int c = lane + 64 * i;
                const float y = (v[i] - mu) * rstd * p.cln_g[c] + p.cln_b[c];
                const float sl = y / (1.0f + __expf(-y));
                p.mixb[(size_t)(tok0 + j) * DM + 512 + c] = f2bf(sl);
            }
        }
    }
}

__device__ void ph_gemm_out(const Params& p, unsigned char* smem) {
    const int ntn = DM / 128;
    const int tid = threadIdx.x, lane = tid & 63, wid = tid >> 6, wr = wid >> 1, wc = wid & 1, fr = lane & 15, fq = lane >> 4;
    for (int t = blockIdx.x; t < (T_TOK / 128) * ntn; t += gridDim.x) {
        const int m0 = (t / ntn) * 128, n0 = (t % ntn) * 128;
        f32x4 acc[4][4]; zero_acc(acc);
        gemm128(p.mixb + (size_t)m0 * DM, DM, p.WoutT + (size_t)n0 * DM, DM, DM, smem, acc);
#pragma unroll
        for (int mi = 0; mi < 4; ++mi) {
            const int row = m0 + wr * 64 + mi * 16 + fr;
#pragma unroll
            for (int ni = 0; ni < 4; ++ni) {
                const int col = n0 + wc * 64 + ni * 16 + fq * 4;
                const f32x4 xv = *(const f32x4*)(p.x + (size_t)row * DM + col);
                *(f32x4*)(p.y1 + (size_t)row * DM + col) = xv * ALPHA + acc[mi][ni];
            }
        }
    }
}

__device__ __forceinline__ void ln_row(const float* __restrict__ src, const float* __restrict__ g, const float* __restrict__ bta,
                                       float* __restrict__ dstf, bf16_t* __restrict__ dstb, int lane) {
    f32x4 v[4]; float s = 0.f;
#pragma unroll
    for (int i = 0; i < 4; ++i) { v[i] = *(const f32x4*)(src + i * 256 + lane * 4); s += (v[i][0] + v[i][1]) + (v[i][2] + v[i][3]); }
    const float mu = wave_sum(s) * (1.0f / 1024.0f);
    float q = 0.f;
#pragma unroll
    for (int i = 0; i < 4; ++i) { const f32x4 d = v[i] - mu; q += (d[0] * d[0] + d[1] * d[1]) + (d[2] * d[2] + d[3] * d[3]); }
    const float rstd = rsqrtf(wave_sum(q) * (1.0f / 1024.0f) + LN_EPS);
#pragma unroll
    for (int i = 0; i < 4; ++i) {
        const f32x4 gg = *(const f32x4*)(g + i * 256 + lane * 4), bb = *(const f32x4*)(bta + i * 256 + lane * 4);
        const f32x4 y = (v[i] - mu) * rstd * gg + bb;
        *(f32x4*)(dstf + i * 256 + lane * 4) = y;
        if (dstb) { uint2 o; o.x = pack2(y[0], y[1]); o.y = pack2(y[2], y[3]); *(uint2*)(dstb + i * 256 + lane * 4) = o; }
    }
}
__device__ void ph_ln1(const Params& p) {
    const int lane = threadIdx.x & 63, wid = threadIdx.x >> 6;
    for (int r = blockIdx.x * 4 + wid; r < T_TOK; r += gridDim.x * 4)
        ln_row(p.y1 + (size_t)r * DM, p.ln1_g, p.ln1_b, p.x1 + (size_t)r * DM, p.x1b + (size_t)r * DM, lane);
}
__device__ void ph_ln2(const Params& p) {
    const int lane = threadIdx.x & 63, wid = threadIdx.x >> 6;
    for (int r = blockIdx.x * 4 + wid; r < T_TOK; r += gridDim.x * 4)
        ln_row(p.y1 + (size_t)r * DM, p.ln2_g, p.ln2_b, p.out + (size_t)r * DM, (bf16_t*)nullptr, lane);
}

__device__ void ph_gemm_q(const Params& p, unsigned char* smem) {
    const int ntn = 2048 / 128;
    const int tid = threadIdx.x, lane = tid & 63, wid = tid >> 6, wr = wid >> 1, wc = wid & 1, fr = lane & 15, fq = lane >> 4;
    for (int t = blockIdx.x; t < (T_TOK / 128) * ntn; t += gridDim.x) {
        const int m0 = (t / ntn) * 128, n0 = (t % ntn) * 128;
        f32x4 acc[4][4]; zero_acc(acc);
        gemm128(p.x1b + (size_t)m0 * DM, DM, p.WqT + (size_t)n0 * DM, DM, DM, smem, acc);
#pragma unroll
        for (int mi = 0; mi < 4; ++mi) {
            const int row = m0 + wr * 64 + mi * 16 + fr;
#pragma unroll
            for (int ni = 0; ni < 4; ++ni) {
                const int col = n0 + wc * 64 + ni * 16 + fq * 4;
                uint2 o; o.x = pack2(acc[mi][ni][0], acc[mi][ni][1]); o.y = pack2(acc[mi][ni][2], acc[mi][ni][3]);
                *(uint2*)(p.qb + (size_t)row * 2048 + col) = o;
            }
        }
    }
}

#define SCS 129
__device__ void ph_scores_topk(const Params& p, unsigned char* smem) {
    float* sc = (float*)(smem + GEMM_SMEM);
    const int tid = threadIdx.x, lane = tid & 63, wid = tid >> 6, wr = wid >> 1, wc = wid & 1, fr = lane & 15, fq = lane >> 4;
    for (int t = blockIdx.x; t < (T_TOK / 128) * 16; t += gridDim.x) {
        const int m0 = (t >> 4) * 128, hp = t & 15;
        f32x4 acc[4][4]; zero_acc(acc);
        gemm128(p.qb + (size_t)m0 * 2048 + hp * 128, 2048, p.keysb + (size_t)hp * 128 * 128, 128, 128, smem, acc);
#pragma unroll
        for (int mi = 0; mi < 4; ++mi)
#pragma unroll
            for (int ni = 0; ni < 4; ++ni)
#pragma unroll
                for (int r = 0; r < 4; ++r)
                    sc[(wr * 64 + mi * 16 + fr) * SCS + wc * 64 + ni * 16 + fq * 4 + r] = acc[mi][ni][r];
        __syncthreads();
        if (tid < 128) {
            float* row = sc + tid * SCS;
            float* os = p.tops + ((size_t)(m0 + tid) * 16 + hp) * 16;
            int* oi = p.topi + ((size_t)(m0 + tid) * 16 + hp) * 16;
            for (int r = 0; r < 16; ++r) {
                float bv = row[0]; int bj = 0;
                for (int j = 1; j < 128; ++j) { const float v = row[j]; if (v > bv) { bv = v; bj = j; } }
                os[r] = bv; oi[r] = bj;
                row[bj] = -3.0e38f;
            }
        }
        __syncthreads();
    }
}

__device__ void ph_combine(const Params& p) {
    for (int u = blockIdx.x * 256 + threadIdx.x; u < T_TOK * 8; u += gridDim.x * 256) {
        const int t = u >> 3, h = u & 7;
        float s1[16], s2[16]; int i1[16], i2[16];
        {
            const float* a = p.tops + ((size_t)t * 16 + h * 2) * 16;
            const int* ai = p.topi + ((size_t)t * 16 + h * 2) * 16;
#pragma unroll
            for (int i = 0; i < 16; ++i) { s1[i] = a[i]; s2[i] = a[16 + i]; i1[i] = ai[i]; i2[i] = ai[16 + i]; }
        }
        float pv = 3.0e38f; int pidx = -1;
        float mx = 0.f, den = 0.f;
        float* og = p.gates + (size_t)t * 128 + h * 16;
        int* oid = p.ids + (size_t)t * 128 + h * 16;
#pragma unroll 1
        for (int r = 0; r < 16; ++r) {
            float bv = -3.0e38f; int bidx = 1 << 20, bid = 0;
#pragma unroll
            for (int i = 0; i < 16; ++i) {
#pragma unroll
                for (int j = 0; j < 16; ++j) {
                    if ((i + 1) * (j + 1) <= 16) {
                        const float v = s1[i] + s2[j];
                        const int idx = i * 16 + j;
                        const bool after = (v < pv) || (v == pv && idx > pidx);
                        const bool better = (v > bv) || (v == bv && idx < bidx);
                        if (after && better) { bv = v; bidx = idx; bid = i1[i] * 128 + i2[j]; }
                    }
                }
            }
            pv = bv; pidx = bidx;
            if (r == 0) mx = bv;
            const float e = __expf(bv - mx);
            den += e;
            og[r] = e; oid[r] = bid;
        }
        const float inv = 1.0f / den;
#pragma unroll 1
        for (int r = 0; r < 16; ++r) og[r] *= inv;
    }
}

__device__ void ph_peer(const Params& p) {
    const int lane = threadIdx.x & 63, wid = threadIdx.x >> 6;
    for (int t = blockIdx.x * 4 + wid; t < T_TOK; t += gridDim.x * 4) {
        float xv[16];
        {
            const float* xr = p.x1 + (size_t)t * DM;
            const f32x4 a = *(const f32x4*)(xr + lane * 8), b = *(const f32x4*)(xr + lane * 8 + 4);
            const f32x4 c = *(const f32x4*)(xr + 512 + lane * 8), d = *(const f32x4*)(xr + 512 + lane * 8 + 4);
#pragma unroll
            for (int i = 0; i < 4; ++i) { xv[i] = a[i]; xv[4 + i] = b[i]; xv[8 + i] = c[i]; xv[12 + i] = d[i]; }
        }
        float o[16];
#pragma unroll
        for (int i = 0; i < 16; ++i) o[i] = 0.f;
        const int* idp = p.ids + (size_t)t * 128;
        const float* gp = p.gates + (size_t)t * 128;
        for (int e = 0; e < 128; ++e) {
            const int id = idp[e];
            const float gate = gp[e];
            const bf16_t* ur = p.ub + (size_t)id * DM;
            const uint4 u0 = *(const uint4*)(ur + lane * 8), u1 = *(const uint4*)(ur + 512 + lane * 8);
            float s = xv[0] * bflo(u0.x) + xv[1] * bfhi(u0.x) + xv[2] * bflo(u0.y) + xv[3] * bfhi(u0.y)
                    + xv[4] * bflo(u0.z) + xv[5] * bfhi(u0.z) + xv[6] * bflo(u0.w) + xv[7] * bfhi(u0.w)
                    + xv[8] * bflo(u1.x) + xv[9] * bfhi(u1.x) + xv[10] * bflo(u1.y) + xv[11] * bfhi(u1.y)
                    + xv[12] * bflo(u1.z) + xv[13] * bfhi(u1.z) + xv[14] * bflo(u1.w) + xv[15] * bfhi(u1.w);
            s = wave_sum(s);
            const float act = 0.5f * s * (1.0f + erff(s * 0.70710678118654752f)) * gate;
            const bf16_t* vr = p.vb + (size_t)id * DM;
            const uint4 v0 = *(const uint4*)(vr + lane * 8), v1 = *(const uint4*)(vr + 512 + lane * 8);
            o[0] += act * bflo(v0.x); o[1] += act * bfhi(v0.x); o[2] += act * bflo(v0.y); o[3] += act * bfhi(v0.y);
            o[4] += act * bflo(v0.z); o[5] += act * bfhi(v0.z); o[6] += act * bflo(v0.w); o[7] += act * bfhi(v0.w);
            o[8] += act * bflo(v1.x); o[9] += act * bfhi(v1.x); o[10] += act * bflo(v1.y); o[11] += act * bfhi(v1.y);
            o[12] += act * bflo(v1.z); o[13] += act * bfhi(v1.z); o[14] += act * bflo(v1.w); o[15] += act * bfhi(v1.w);
        }
        float r[16];
#pragma unroll
        for (int i = 0; i < 16; ++i) r[i] = ALPHA * xv[i] + o[i];
        float* rr = p.y1 + (size_t)t * DM;
        *(f32x4*)(rr + lane * 8) = (f32x4){r[0], r[1], r[2], r[3]};
        *(f32x4*)(rr + lane * 8 + 4) = (f32x4){r[4], r[5], r[6], r[7]};
        *(f32x4*)(rr + 512 + lane * 8) = (f32x4){r[8], r[9], r[10], r[11]};
        *(f32x4*)(rr + 512 + lane * 8 + 4) = (f32x4){r[12], r[13], r[14], r[15]};
        bf16_t* rb = p.rb + (size_t)t * DM;
        uint4 w0, w1;
        w0.x = pack2(r[0], r[1]); w0.y = pack2(r[2], r[3]); w0.z = pack2(r[4], r[5]); w0.w = pack2(r[6], r[7]);
        w1.x = pack2(r[8], r[9]); w1.y = pack2(r[10], r[11]); w1.z = pack2(r[12], r[13]); w1.w = pack2(r[14], r[15]);
        *(uint4*)(rb + lane * 8) = w0; *(uint4*)(rb + 512 + lane * 8) = w1;
    }
}

__device__ void ph_gemm_ple(const Params& p, unsigned char* smem) {
    const int ntn = DM / 128;
    const int tid = threadIdx.x, lane = tid & 63, wid = tid >> 6, wr = wid >> 1, wc = wid & 1, fr = lane & 15, fq = lane >> 4;
    for (int t = blockIdx.x; t < (T_TOK / 128) * ntn; t += gridDim.x) {
        const int m0 = (t / ntn) * 128, n0 = (t % ntn) * 128;
        f32x4 acc[4][4], acc2[4][4]; zero_acc(acc); zero_acc(acc2);
        gemm128(p.pb + (size_t)m0 * 256, 256, p.WpT + (size_t)n0 * 256, 256, 256, smem, acc2);
        gemm128(p.rb + (size_t)m0 * DM, DM, p.WgT + (size_t)n0 * DM, DM, DM, smem, acc);
#pragma unroll
        for (int mi = 0; mi < 4; ++mi) {
            const int row = m0 + wr * 64 + mi * 16 + fr;
#pragma unroll
            for (int ni = 0; ni < 4; ++ni) {
                const int col = n0 + wc * 64 + ni * 16 + fq * 4;
                float* yp = p.y1 + (size_t)row * DM + col;
                f32x4 rv = *(const f32x4*)yp;
#pragma unroll
                for (int r = 0; r < 4; ++r) rv[r] += acc2[mi][ni][r] / (1.0f + __expf(-acc[mi][ni][r]));
                *(f32x4*)yp = rv;
            }
        }
    }
}

#define SMEM_BYTES (GEMM_SMEM + 128 * SCS * 4)
__global__ void __launch_bounds__(256) mega(Params p) {
    __shared__ __attribute__((aligned(16))) unsigned char smem[SMEM_BYTES];
    cg::grid_group grid = cg::this_grid();
    ph_prep(p, smem);        grid.sync();
    ph_gemm_in(p, smem);     grid.sync();
    ph_attn(p, smem);
    ph_conv(p, smem);        grid.sync();
    ph_gemm_out(p, smem);    grid.sync();
    ph_ln1(p);               grid.sync();
    ph_gemm_q(p, smem);      grid.sync();
    ph_scores_topk(p, smem); grid.sync();
    ph_combine(p);           grid.sync();
    ph_peer(p);              grid.sync();
    ph_gemm_ple(p, smem);    grid.sync();
    ph_ln2(p);
}

extern "C" void kernel_launch(void* const* d_in, const int* in_sizes, int n_in, void* d_out, int out_size, void* d_ws, size_t ws_size,
                              hipStream_t stream) {
    Params p{};
    p.x = (const float*)d_in[0]; p.p = (const float*)d_in[1]; p.pos = (const int*)d_in[2];
    p.w_in = (const float*)d_in[3]; p.sinks = (const float*)d_in[4]; p.conv_w = (const float*)d_in[5]; p.conv_b = (const float*)d_in[6];
    p.cln_g = (const float*)d_in[7]; p.cln_b = (const float*)d_in[8]; p.w_out = (const float*)d_in[9]; p.ln1_g = (const float*)d_in[10];
    p.ln1_b = (const float*)d_in[11]; p.wq = (const float*)d_in[12]; p.keys = (const float*)d_in[13]; p.pu = (const float*)d_in[14];
    p.pv = (const float*)d_in[15]; p.ple_proj = (const float*)d_in[16]; p.ple_gate = (const float*)d_in[17]; p.ln2_g = (const float*)d_in[18];
    p.ln2_b = (const float*)d_in[19];
    p.out = (float*)d_out;
    unsigned char* ws = (unsigned char*)d_ws;
    const size_t MiB = 1024 * 1024;
    p.y1 = (float*)(ws + 0 * MiB);
    p.hb = (bf16_t*)(ws + 128 * MiB);
    p.qb = (bf16_t*)(ws + 128 * MiB);
    p.xb = (bf16_t*)(ws + 256 * MiB);
    p.x1b = (bf16_t*)(ws + 256 * MiB);
    p.mixb = (bf16_t*)(ws + 320 * MiB);
    p.tops = (float*)(ws + 320 * MiB);
    p.topi = (int*)(ws + 352 * MiB);
    p.rb = (bf16_t*)(ws + 320 * MiB);
    p.pb = (bf16_t*)(ws + 384 * MiB);
    p.ub = (bf16_t*)(ws + 400 * MiB);
    p.vb = (bf16_t*)(ws + 432 * MiB);
    p.ids = (int*)(ws + 464 * MiB);
    p.gates = (float*)(ws + 480 * MiB);
    unsigned char* wb = ws + 496 * MiB;
    p.WinT = (bf16_t*)wb; wb += (size_t)INW * DM * 2;
    p.WoutT = (bf16_t*)wb; wb += (size_t)DM * DM * 2;
    p.WqT = (bf16_t*)wb; wb += (size_t)2048 * DM * 2;
    p.WgT = (bf16_t*)wb; wb += (size_t)DM * DM * 2;
    p.WpT = (bf16_t*)wb; wb += (size_t)DM * 256 * 2;
    p.keysb = (bf16_t*)wb; wb += (size_t)16 * 128 * 128 * 2;
    p.x1 = (float*)d_out;

    static int grid_blocks = 0;
    if (!grid_blocks) {
        int dev = 0, cus = 0, per_cu = 0;
        (void)hipGetDevice(&dev);
        (void)hipDeviceGetAttribute(&cus, hipDeviceAttributeMultiprocessorCount, dev);
        (void)hipOccupancyMaxActiveBlocksPerMultiprocessor(&per_cu, mega, 256, 0);
        if (per_cu > 2) per_cu = 2;
        grid_blocks = cus * per_cu;
    }
    void* args[] = {&p};
    hipError_t e = hipLaunchCooperativeKernel((void*)mega, dim3(grid_blocks), dim3(256), args, 0, stream);
    if (e != hipSuccess) fprintf(stderr, "cooperative launch failed: %s (grid %d)\n", hipGetErrorString(e), grid_blocks);
}
```

```cpp
#include <hip/hip_runtime.h>
#include <hip/hip_cooperative_groups.h>
#include <stdint.h>
#include <cstdio>
namespace cg = cooperative_groups;

typedef unsigned short bf16_t;
typedef short bf16x8 __attribute__((ext_vector_type(8)));
typedef float f32x4 __attribute__((ext_vector_type(4)));
typedef unsigned u32x4 __attribute__((ext_vector_type(4)));

#define T_TOK 32768
#define SEQ 2048
#define DM 1024
#define INW 1792
#define ALPHA 1.189207115002721f
#define LN_EPS 1e-5f

__device__ __forceinline__ bf16_t f2bf(float f) {
    unsigned u = __float_as_uint(f);
    u += 0x7fffu + ((u >> 16) & 1u);
    return (bf16_t)(u >> 16);
}
__device__ __forceinline__ float bf2f(bf16_t b) { return __uint_as_float(((unsigned)b) << 16); }
__device__ __forceinline__ float bflo(unsigned w) { return __uint_as_float(w << 16); }
__device__ __forceinline__ float bfhi(unsigned w) { return __uint_as_float(w & 0xffff0000u); }
__device__ __forceinline__ unsigned pack2(float a, float b) { return (unsigned)f2bf(a) | ((unsigned)f2bf(b) << 16); }

__device__ __forceinline__ float wave_sum(float v) {
#pragma unroll
    for (int o = 32; o >= 1; o >>= 1) v += __shfl_xor(v, o);
    return v;
}

struct Params {
    const float *x, *p; const int* pos;
    const float *w_in, *sinks, *conv_w, *conv_b, *cln_g, *cln_b, *w_out, *ln1_g, *ln1_b;
    const float *wq, *keys, *pu, *pv, *ple_proj, *ple_gate, *ln2_g, *ln2_b;
    float* out;
    bf16_t *xb, *pb, *WinT, *WoutT, *WqT, *WgT, *WpT, *keysb, *ub, *vb, *hb, *mixb, *x1b, *qb, *rb;
    float *y1, *x1, *tops, *gates, *su, *sv;
    int *topi, *ids;
    unsigned char *u8, *v8;
};

__device__ void cvt_rows(const float* __restrict__ src, bf16_t* __restrict__ dst, size_t n) {
    size_t nv = n / 8;
    for (size_t i = (size_t)blockIdx.x * blockDim.x + threadIdx.x; i < nv; i += (size_t)gridDim.x * blockDim.x) {
        const float4 a = ((const float4*)src)[2 * i], b = ((const float4*)src)[2 * i + 1];
        uint4 o; o.x = pack2(a.x, a.y); o.y = pack2(a.z, a.w); o.z = pack2(b.x, b.y); o.w = pack2(b.z, b.w);
        ((uint4*)dst)[i] = o;
    }
}
__device__ void transpose_cvt(const float* __restrict__ W, bf16_t* __restrict__ Wt, int K, int N, float* tile  ) {
    const int tk = K / 32, tn = N / 32;
    const int tx = threadIdx.x & 31, ty = threadIdx.x >> 5;
    for (int t = blockIdx.x; t < tk * tn; t += gridDim.x) {
        const int k0 = (t / tn) * 32, n0 = (t % tn) * 32;
        __syncthreads();
#pragma unroll
        for (int i = 0; i < 4; ++i) tile[(ty + i * 8) * 33 + tx] = W[(size_t)(k0 + ty + i * 8) * N + n0 + tx];
        __syncthreads();
#pragma unroll
        for (int i = 0; i < 4; ++i) Wt[(size_t)(n0 + ty + i * 8) * K + k0 + tx] = f2bf(tile[tx * 33 + ty + i * 8]);
    }
}

__device__ void cvt_table_fp8(const float* __restrict__ src, unsigned char* __restrict__ dst, float* __restrict__ scl, int rows) {
    const int lane = threadIdx.x & 63, wid = threadIdx.x >> 6;
    for (int r = blockIdx.x * 4 + wid; r < rows; r += gridDim.x * 4) {
        const float* sr = src + (size_t)r * DM + lane * 16;
        const f32x4 a = *(const f32x4*)(sr), b = *(const f32x4*)(sr + 4), c = *(const f32x4*)(sr + 8), d = *(const f32x4*)(sr + 12);
        float m = 0.f;
#pragma unroll
        for (int i = 0; i < 4; ++i) m = fmaxf(m, fmaxf(fmaxf(fabsf(a[i]), fabsf(b[i])), fmaxf(fabsf(c[i]), fabsf(d[i]))));
#pragma unroll
        for (int o = 32; o >= 1; o >>= 1) m = fmaxf(m, __shfl_xor(m, o));
        const float q = (m > 0.f) ? 448.0f / m : 1.0f;
        u32x4 w;
        w[0] = __builtin_amdgcn_cvt_pk_fp8_f32(a[2] * q, a[3] * q, __builtin_amdgcn_cvt_pk_fp8_f32(a[0] * q, a[1] * q, 0, false), true);
        w[1] = __builtin_amdgcn_cvt_pk_fp8_f32(b[2] * q, b[3] * q, __builtin_amdgcn_cvt_pk_fp8_f32(b[0] * q, b[1] * q, 0, false), true);
        w[2] = __builtin_amdgcn_cvt_pk_fp8_f32(c[2] * q, c[3] * q, __builtin_amdgcn_cvt_pk_fp8_f32(c[0] * q, c[1] * q, 0, false), true);
        w[3] = __builtin_amdgcn_cvt_pk_fp8_f32(d[2] * q, d[3] * q, __builtin_amdgcn_cvt_pk_fp8_f32(d[0] * q, d[1] * q, 0, false), true);
        *(u32x4*)(dst + (size_t)r * DM + lane * 16) = w;
        if (lane == 0) scl[r] = (m > 0.f) ? m * (1.0f / 448.0f) : 1.0f;
    }
}
__device__ void ph_prep(const Params& p, unsigned char* smem) {
    float* tile = (float*)smem;
    cvt_rows(p.x, p.xb, (size_t)T_TOK * DM);
    cvt_rows(p.p, p.pb, (size_t)T_TOK * 256);
    cvt_table_fp8(p.pu, p.u8, p.su, 16384);
    cvt_table_fp8(p.pv, p.v8, p.sv, 16384);
    cvt_rows(p.keys, p.keysb, (size_t)16 * 128 * 128);
    transpose_cvt(p.w_in, p.WinT, DM, INW, tile);
    transpose_cvt(p.w_out, p.WoutT, DM, DM, tile);
    transpose_cvt(p.wq, p.WqT, DM, 2048, tile);
    transpose_cvt(p.ple_gate, p.WgT, DM, DM, tile);
    transpose_cvt(p.ple_proj, p.WpT, 256, DM, tile);
}

#define LSTR 72
__device__ __forceinline__ void gemm128(const bf16_t* __restrict__ A, int lda, const bf16_t* __restrict__ Bt, int ldb, int K,
                                        unsigned char* smem, f32x4 (&acc)[4][4]) {
    bf16_t* sA = (bf16_t*)smem;
    bf16_t* sB = sA + 128 * LSTR;
    const int tid = threadIdx.x, lane = tid & 63, wid = tid >> 6;
    const int wr = wid >> 1, wc = wid & 1, fr = lane & 15, fq = lane >> 4;
    u32x4 ra0, ra1, ra2, ra3, rb0, rb1, rb2, rb3;
    const int nk = K / 64;
    const int row0 = tid >> 3, kc8 = (tid & 7) * 8;
    const bf16_t* ga = A + (size_t)row0 * lda + kc8;
    const bf16_t* gb = Bt + (size_t)row0 * ldb + kc8;
    const size_t sa32 = (size_t)32 * lda, sb32 = (size_t)32 * ldb;
    ra0 = *(const u32x4*)(ga); ra1 = *(const u32x4*)(ga + sa32); ra2 = *(const u32x4*)(ga + 2 * sa32); ra3 = *(const u32x4*)(ga + 3 * sa32);
    rb0 = *(const u32x4*)(gb); rb1 = *(const u32x4*)(gb + sb32); rb2 = *(const u32x4*)(gb + 2 * sb32); rb3 = *(const u32x4*)(gb + 3 * sb32);
    bf16_t* wa = sA + row0 * LSTR + kc8;
    bf16_t* wb = sB + row0 * LSTR + kc8;
#pragma unroll 1
    for (int kt = 0; kt < nk; ++kt) {
        *(u32x4*)(wa) = ra0; *(u32x4*)(wa + 32 * LSTR) = ra1; *(u32x4*)(wa + 64 * LSTR) = ra2; *(u32x4*)(wa + 96 * LSTR) = ra3;
        *(u32x4*)(wb) = rb0; *(u32x4*)(wb + 32 * LSTR) = rb1; *(u32x4*)(wb + 64 * LSTR) = rb2; *(u32x4*)(wb + 96 * LSTR) = rb3;
        __syncthreads();
        if (kt + 1 < nk) {
            ga += 64; gb += 64;
            ra0 = *(const u32x4*)(ga); ra1 = *(const u32x4*)(ga + sa32); ra2 = *(const u32x4*)(ga + 2 * sa32); ra3 = *(const u32x4*)(ga + 3 * sa32);
            rb0 = *(const u32x4*)(gb); rb1 = *(const u32x4*)(gb + sb32); rb2 = *(const u32x4*)(gb + 2 * sb32); rb3 = *(const u32x4*)(gb + 3 * sb32);
        }
#pragma unroll
        for (int kk = 0; kk < 2; ++kk) {
            bf16x8 af[4], bfr[4];
#pragma unroll
            for (int mi = 0; mi < 4; ++mi) af[mi] = *(const bf16x8*)(sA + (wr * 64 + mi * 16 + fr) * LSTR + kk * 32 + fq * 8);
#pragma unroll
            for (int ni = 0; ni < 4; ++ni) bfr[ni] = *(const bf16x8*)(sB + (wc * 64 + ni * 16 + fr) * LSTR + kk * 32 + fq * 8);
#pragma unroll
            for (int mi = 0; mi < 4; ++mi)
#pragma unroll
                for (int ni = 0; ni < 4; ++ni)
                    acc[mi][ni] = __builtin_amdgcn_mfma_f32_16x16x32_bf16(bfr[ni], af[mi], acc[mi][ni], 0, 0, 0);
        }
        __syncthreads();
    }
}
__device__ __forceinline__ void zero_acc(f32x4 (&acc)[4][4]) {
#pragma unroll
    for (int a = 0; a < 4; ++a)
#pragma unroll
        for (int b = 0; b < 4; ++b) acc[a][b] = (f32x4){0.f, 0.f, 0.f, 0.f};
}
#define GEMM_SMEM (2 * 128 * LSTR * 2)

__device__ void ph_gemm_in(const Params& p, unsigned char* smem) {
    const int ntn = INW / 128;
    const int tid = threadIdx.x, lane = tid & 63, wid = tid >> 6, wr = wid >> 1, wc = wid & 1, fr = lane & 15, fq = lane >> 4;
    for (int t = blockIdx.x; t < (T_TOK / 128) * ntn; t += gridDim.x) {
        const int m0 = (t / ntn) * 128, n0 = (t % ntn) * 128;
        f32x4 acc[4][4]; zero_acc(acc);
        gemm128(p.xb + (size_t)m0 * DM, DM, p.WinT + (size_t)n0 * DM, DM, DM, smem, acc);
#pragma unroll
        for (int mi = 0; mi < 4; ++mi) {
            const int row = m0 + wr * 64 + mi * 16 + fr;
            const float posf = (float)p.pos[row];
#pragma unroll
            for (int ni = 0; ni < 4; ++ni) {
                const int col0 = n0 + wc * 64 + ni * 16;
                f32x4 v = acc[mi][ni];
                if (col0 < 640 && (col0 & 63) == 0) {
#pragma unroll
                    for (int r = 0; r < 4; ++r) {
                        const float other = __shfl_xor(v[r], 32);
                        const int j = (fq & 1) * 4 + r;
                        const float inv = powf(500000.0f, -(float)j * 0.125f);
                        float sn, cs; sincosf(posf * inv, &sn, &cs);
                        v[r] = (fq < 2) ? (v[r] * cs - other * sn) : (v[r] * cs + other * sn);
                    }
                }
                uint2 o; o.x = pack2(v[0], v[1]); o.y = pack2(v[2], v[3]);
                *(uint2*)(p.hb + (size_t)row * INW + col0 + fq * 4) = o;
            }
        }
    }
}

#define ASTR 72
__device__ void ph_attn(const Params& p, unsigned char* smem) {
    bf16_t* sK = (bf16_t*)smem;
    bf16_t* sV = sK + 256 * ASTR;
    const int tid = threadIdx.x;
    for (int u = blockIdx.x; u < 16 * 16 * 2; u += gridDim.x) {
        const int kvh = u & 1, nb = (u >> 1) & 15, b = u >> 5;
        __syncthreads();
        for (int c = tid; c < 256 * 8; c += 256) {
            const int li = c >> 3, kc = c & 7;
            const int pos = nb * 128 - 128 + li;
            uint4 kv = make_uint4(0, 0, 0, 0), vv = make_uint4(0, 0, 0, 0);
            if (pos >= 0) {
                const bf16_t* base = p.hb + (size_t)(b * SEQ + pos) * INW;
                kv = *(const uint4*)(base + 512 + kvh * 64 + kc * 8);
                vv = *(const uint4*)(base + 640 + kvh * 64 + kc * 8);
            }
            *(uint4*)(sK + li * ASTR + kc * 8) = kv;
            *(uint4*)(sV + li * ASTR + kc * 8) = vv;
        }
        __syncthreads();
        const int qi = tid & 127;
        const size_t trow = (size_t)(b * SEQ + nb * 128 + qi);
        for (int g2 = 0; g2 < 2; ++g2) {
            const int hq = kvh * 4 + g2 * 2 + (tid >> 7);
            float q[64];
            {
                const uint4* qp = (const uint4*)(p.hb + trow * INW + hq * 64);
#pragma unroll
                for (int c = 0; c < 8; ++c) {
                    const uint4 w = qp[c];
                    q[c * 8 + 0] = bflo(w.x) * 0.125f; q[c * 8 + 1] = bfhi(w.x) * 0.125f;
                    q[c * 8 + 2] = bflo(w.y) * 0.125f; q[c * 8 + 3] = bfhi(w.y) * 0.125f;
                    q[c * 8 + 4] = bflo(w.z) * 0.125f; q[c * 8 + 5] = bfhi(w.z) * 0.125f;
                    q[c * 8 + 6] = bflo(w.w) * 0.125f; q[c * 8 + 7] = bfhi(w.w) * 0.125f;
                }
            }
            float o[64];
#pragma unroll
            for (int d = 0; d < 64; ++d) o[d] = 0.f;
            float m = p.sinks[hq], l = 1.0f;
            for (int kk = 0; kk < 128; ++kk) {
                const int li = qi + 1 + kk;
                if (nb * 128 - 128 + li < 0) continue;
                const uint4* kp = (const uint4*)(sK + li * ASTR);
                float s = 0.f;
#pragma unroll
                for (int c = 0; c < 8; ++c) {
                    const uint4 w = kp[c];
                    s += q[c * 8 + 0] * bflo(w.x); s += q[c * 8 + 1] * bfhi(w.x);
                    s += q[c * 8 + 2] * bflo(w.y); s += q[c * 8 + 3] * bfhi(w.y);
                    s += q[c * 8 + 4] * bflo(w.z); s += q[c * 8 + 5] * bfhi(w.z);
                    s += q[c * 8 + 6] * bflo(w.w); s += q[c * 8 + 7] * bfhi(w.w);
                }
                if (s > m) {
                    const float sc = __expf(m - s);
                    l *= sc;
#pragma unroll
                    for (int d = 0; d < 64; ++d) o[d] *= sc;
                    m = s;
                }
                const float pr = __expf(s - m);
                l += pr;
                const uint4* vp = (const uint4*)(sV + li * ASTR);
#pragma unroll
                for (int c = 0; c < 8; ++c) {
                    const uint4 w = vp[c];
                    o[c * 8 + 0] += pr * bflo(w.x); o[c * 8 + 1] += pr * bfhi(w.x);
                    o[c * 8 + 2] += pr * bflo(w.y); o[c * 8 + 3] += pr * bfhi(w.y);
                    o[c * 8 + 4] += pr * bflo(w.z); o[c * 8 + 5] += pr * bfhi(w.z);
                    o[c * 8 + 6] += pr * bflo(w.w); o[c * 8 + 7] += pr * bfhi(w.w);
                }
            }
            const float il = 1.0f / l;
            uint4* op = (uint4*)(p.mixb + trow * DM + hq * 64);
#pragma unroll
            for (int c = 0; c < 8; ++c) {
                uint4 w;
                w.x = pack2(o[c * 8 + 0] * il, o[c * 8 + 1] * il); w.y = pack2(o[c * 8 + 2] * il, o[c * 8 + 3] * il);
                w.z = pack2(o[c * 8 + 4] * il, o[c * 8 + 5] * il); w.w = pack2(o[c * 8 + 6] * il, o[c * 8 + 7] * il);
                op[c] = w;
            }
        }
    }
}

__device__ void ph_conv(const Params& p, unsigned char* smem) {
    float* cv = (float*)smem;
    const int tid = threadIdx.x, lane = tid & 63, wid = tid >> 6;
    for (int u = blockIdx.x; u < T_TOK / 32; u += gridDim.x) {
        const int tok0 = u * 32;
        const int s0 = tok0 & (SEQ - 1);
        __syncthreads();
        for (int half = 0; half < 2; ++half) {
            const int c = tid + half * 256;
            float glu[62];
#pragma unroll
            for (int i = 0; i < 62; ++i) {
                const int s = s0 - 30 + i;
                float g = 0.f;
                if (s >= 0) {
                    const bf16_t* base = p.hb + (size_t)(tok0 - 30 + i) * INW;
                    const float a = bf2f(base[768 + c]), gt = bf2f(base[1280 + c]);
                    g = a / (1.0f + __expf(-gt));
                }
                glu[i] = g;
            }
            float w[31];
#pragma unroll
            for (int k = 0; k < 31; ++k) w[k] = p.conv_w[k * 512 + c];
            const float bias = p.conv_b[c];
#pragma unroll
            for (int j = 0; j < 32; ++j) {
                float a = bias;
#pragma unroll
                for (int k = 0; k < 31; ++k) a += w[k] * glu[j + k];
                cv[j * 512 + c] = a;
            }
        }
        __syncthreads();
        for (int jj = 0; jj < 8; ++jj) {
            const int j = wid * 8 + jj;
            float v[8]; float s = 0.f;
#pragma unroll
            for (int i = 0; i < 8; ++i) { v[i] = cv[j * 512 + lane + 64 * i]; s += v[i]; }
            const float mu = wave_sum(s) * (1.0f / 512.0f);
            float q = 0.f;
#pragma unroll
            for (int i = 0; i < 8; ++i) { const float d = v[i] - mu; q += d * d; }
            const float rstd = rsqrtf(wave_sum(q) * (1.0f / 512.0f) + LN_EPS);
#pragma unroll
            for (int i = 0; i < 8; ++i) {
                const int c = lane + 64 * i;
                const float y = (v[i] - mu) * rstd * p.cln_g[c] + p.cln_b[c];
                const float sl = y / (1.0f + __expf(-y));
                p.mixb[(size_t)(tok0 + j) * DM + 512 + c] = f2bf(sl);
            }
        }
    }
}

__device__ void ph_gemm_out(const Params& p, unsigned char* smem) {
    const int ntn = DM / 128;
    const int tid = threadIdx.x, lane = tid & 63, wid = tid >> 6, wr = wid >> 1, wc = wid & 1, fr = lane & 15, fq = lane >> 4;
    for (int t = blockIdx.x; t < (T_TOK / 128) * ntn; t += gridDim.x) {
        const int m0 = (t / ntn) * 128, n0 = (t % ntn) * 128;
        f32x4 acc[4][4]; zero_acc(acc);
        gemm128(p.mixb + (size_t)m0 * DM, DM, p.WoutT + (size_t)n0 * DM, DM, DM, smem, acc);
#pragma unroll
        for (int mi = 0; mi < 4; ++mi) {
            const int row = m0 + wr * 64 + mi * 16 + fr;
#pragma unroll
            for (int ni = 0; ni < 4; ++ni) {
                const int col = n0 + wc * 64 + ni * 16 + fq * 4;
                const f32x4 xv = *(const f32x4*)(p.x + (size_t)row * DM + col);
                *(f32x4*)(p.y1 + (size_t)row * DM + col) = xv * ALPHA + acc[mi][ni];
            }
        }
    }
}

__device__ __forceinline__ void ln_row(const float* __restrict__ src, const float* __restrict__ g, const float* __restrict__ bta,
                                       float* __restrict__ dstf, bf16_t* __restrict__ dstb, int lane) {
    f32x4 v[4]; float s = 0.f;
#pragma unroll
    for (int i = 0; i < 4; ++i) { v[i] = *(const f32x4*)(src + i * 256 + lane * 4); s += (v[i][0] + v[i][1]) + (v[i][2] + v[i][3]); }
    const float mu = wave_sum(s) * (1.0f / 1024.0f);
    float q = 0.f;
#pragma unroll
    for (int i = 0; i < 4; ++i) { const f32x4 d = v[i] - mu; q += (d[0] * d[0] + d[1] * d[1]) + (d[2] * d[2] + d[3] * d[3]); }
    const float rstd = rsqrtf(wave_sum(q) * (1.0f / 1024.0f) + LN_EPS);
#pragma unroll
    for (int i = 0; i < 4; ++i) {
        const f32x4 gg = *(const f32x4*)(g + i * 256 + lane * 4), bb = *(const f32x4*)(bta + i * 256 + lane * 4);
        const f32x4 y = (v[i] - mu) * rstd * gg + bb;
        *(f32x4*)(dstf + i * 256 + lane * 4) = y;
        if (dstb) { uint2 o; o.x = pack2(y[0], y[1]); o.y = pack2(y[2], y[3]); *(uint2*)(dstb + i * 256 + lane * 4) = o; }
    }
}
__device__ void ph_ln1(const Params& p) {
    const int lane = threadIdx.x & 63, wid = threadIdx.x >> 6;
    for (int r = blockIdx.x * 4 + wid; r < T_TOK; r += gridDim.x * 4)
        ln_row(p.y1 + (size_t)r * DM, p.ln1_g, p.ln1_b, p.x1 + (size_t)r * DM, p.x1b + (size_t)r * DM, lane);
}
__device__ void ph_ln2(const Params& p) {
    const int lane = threadIdx.x & 63, wid = threadIdx.x >> 6;
    for (int r = blockIdx.x * 4 + wid; r < T_TOK; r += gridDim.x * 4)
        ln_row(p.y1 + (size_t)r * DM, p.ln2_g, p.ln2_b, p.out + (size_t)r * DM, (bf16_t*)nullptr, lane);
}

typedef float f32x16 __attribute__((ext_vector_type(16)));
#define QSTR 136
__device__ __forceinline__ int f2key(float f) { const int b = __float_as_int(f); return b ^ ((b >> 31) & 0x7fffffff); }
__device__ __forceinline__ float key2f(int k) { return __int_as_float(k ^ ((k >> 31) & 0x7fffffff)); }
__device__ __forceinline__ void sort16_desc(int (&a)[16]) {
#pragma unroll
    for (int lk = 1; lk <= 4; ++lk) {
#pragma unroll
        for (int lj = lk - 1; lj >= 0; --lj) {
            const int k = 1 << lk, j = 1 << lj;
#pragma unroll
            for (int i = 0; i < 16; ++i) {
                const int l = i ^ j;
                if (l > i) {
                    const int hi = max(a[i], a[l]), lo = min(a[i], a[l]);
                    if ((i & k) == 0) { a[i] = hi; a[l] = lo; } else { a[i] = lo; a[l] = hi; }
                }
            }
        }
    }
}
__device__ __forceinline__ void merge_top16(int (&a)[16], const int (&b)[16]) {
#pragma unroll
    for (int i = 0; i < 16; ++i) a[i] = max(a[i], b[15 - i]);
#pragma unroll
    for (int lj = 3; lj >= 0; --lj) {
        const int j = 1 << lj;
#pragma unroll
        for (int i = 0; i < 16; ++i) {
            const int l = i ^ j;
            if (l > i) { const int hi = max(a[i], a[l]), lo = min(a[i], a[l]); a[i] = hi; a[l] = lo; }
        }
    }
}
__device__ __forceinline__ void top16_of_64(int (&v)[4][16]) {
    sort16_desc(v[0]); sort16_desc(v[1]); sort16_desc(v[2]); sort16_desc(v[3]);
    merge_top16(v[0], v[1]); merge_top16(v[0], v[2]); merge_top16(v[0], v[3]);
}

__device__ __forceinline__ void route_half(const Params& p, unsigned char* smem, int m0, int hp, int (&K)[16]) {
    bf16_t* Ks = (bf16_t*)smem;
    bf16_t* Qs = (bf16_t*)(smem + GEMM_SMEM);
    const int tid = threadIdx.x, lane = tid & 63, wid = tid >> 6, wr = wid >> 1, wc = wid & 1, fr = lane & 15, fq = lane >> 4;
    const int r32 = lane & 31, hh = lane >> 5;
    {
        f32x4 acc[4][4]; zero_acc(acc);
        gemm128(p.x1b + (size_t)m0 * DM, DM, p.WqT + (size_t)hp * 128 * DM, DM, DM, smem, acc);
#pragma unroll
        for (int mi = 0; mi < 4; ++mi)
#pragma unroll
            for (int ni = 0; ni < 4; ++ni) {
                uint2 o; o.x = pack2(acc[mi][ni][0], acc[mi][ni][1]); o.y = pack2(acc[mi][ni][2], acc[mi][ni][3]);
                *(uint2*)(Qs + (wr * 64 + mi * 16 + fr) * QSTR + wc * 64 + ni * 16 + fq * 4) = o;
            }
    }
    {
        const bf16_t* kg = p.keysb + (size_t)hp * 128 * 128;
#pragma unroll
        for (int i = 0; i < 8; ++i) {
            const int c = tid + i * 256, row = c >> 4, kc = c & 15;
            *(u32x4*)(Ks + row * QSTR + kc * 8) = *(const u32x4*)(kg + row * 128 + kc * 8);
        }
    }
    __syncthreads();
    f32x16 S[4];
#pragma unroll
    for (int mt = 0; mt < 4; ++mt)
#pragma unroll
        for (int r = 0; r < 16; ++r) S[mt][r] = 0.f;
#pragma unroll
    for (int kk = 0; kk < 8; ++kk) {
        const bf16x8 b = *(const bf16x8*)(Qs + (wid * 32 + r32) * QSTR + kk * 16 + hh * 8);
#pragma unroll
        for (int mt = 0; mt < 4; ++mt) {
            const bf16x8 a = *(const bf16x8*)(Ks + (mt * 32 + r32) * QSTR + kk * 16 + hh * 8);
            S[mt] = __builtin_amdgcn_mfma_f32_32x32x16_bf16(a, b, S[mt], 0, 0, 0);
        }
    }
    __syncthreads();
    int v[4][16];
#pragma unroll
    for (int mt = 0; mt < 4; ++mt)
#pragma unroll
        for (int r = 0; r < 16; ++r) {
            const int n = mt * 32 + (r & 3) + 8 * (r >> 2) + 4 * hh;
            v[mt][r] = (f2key(S[mt][r]) & ~0x7F) | (127 - n);
        }
    top16_of_64(v);
    int o[16];
#pragma unroll
    for (int i = 0; i < 16; ++i) o[i] = __shfl_xor(v[0][i], 32);
    merge_top16(v[0], o);
#pragma unroll
    for (int i = 0; i < 16; ++i) K[i] = v[0][i];
}

__device__ void ph_route(const Params& p, unsigned char* smem) {
    const int tid = threadIdx.x, lane = tid & 63, wid = tid >> 6;
    const int r32 = lane & 31, hh = lane >> 5;
    const int hmask = -hh;
    int* KL = (int*)(smem + GEMM_SMEM + (size_t)wid * 32 * QSTR * 2);
    for (int u = blockIdx.x; u < (T_TOK / 128) * 8; u += gridDim.x) {
        const int m0 = (u >> 3) * 128, h = u & 7;
        int K0[16], K1[16];
        route_half(p, smem, m0, h * 2 + 0, K0);
        route_half(p, smem, m0, h * 2 + 1, K1);
#pragma unroll
        for (int i = 0; i < 16; ++i) KL[r32 * 33 + hh * 16 + i] = K0[i] ^ ((K0[i] ^ K1[i]) & hmask);
        float s1[16], s2[16];
#pragma unroll
        for (int i = 0; i < 16; ++i) { s1[i] = key2f(K0[i] & ~0x7F); s2[i] = key2f(K1[i] & ~0x7F); }
        int c[4][16];
#pragma unroll
        for (int i = 0; i < 16; ++i)
#pragma unroll
            for (int j = 0; j < 16; ++j)
                if ((i + 1) * (j + 1) <= 16) {
                    constexpr int OFFS[16] = {0, 16, 24, 29, 33, 36, 38, 40, 42, 43, 44, 45, 46, 47, 48, 49};
                    const int q = OFFS[i] + j;
                    c[q >> 4][q & 15] = (f2key(s1[i] + s2[j]) & ~0xFF) | (255 - (i * 16 + j));
                }
#pragma unroll
        for (int qq = 50; qq < 64; ++qq) c[qq >> 4][qq & 15] = (int)0x80000000;
        top16_of_64(c);
        const float mx = key2f(c[0][0] & ~0xFF);
        float e[16]; float den = 0.f;
#pragma unroll
        for (int i = 0; i < 16; ++i) { e[i] = __expf(key2f(c[0][i] & ~0xFF) - mx); den += e[i]; }
        const float inv = 1.0f / den;
        const size_t ob = (size_t)(m0 + wid * 32 + r32) * 128 + h * 16 + hh * 8;
        int idv[8]; float gv[8];
#pragma unroll
        for (int qq = 0; qq < 8; ++qq) {
            const int F = c[0][qq] ^ ((c[0][qq] ^ c[0][8 + qq]) & hmask);
            gv[qq] = __int_as_float(__float_as_int(e[qq]) ^ ((__float_as_int(e[qq]) ^ __float_as_int(e[8 + qq])) & hmask)) * inv;
            const int idx = 255 - (F & 0xFF);
            const int k0 = KL[r32 * 33 + (idx >> 4)], k1 = KL[r32 * 33 + 16 + (idx & 15)];
            idv[qq] = (127 - (k0 & 0x7F)) * 128 + (127 - (k1 & 0x7F));
        }
        *(int4*)(p.ids + ob) = make_int4(idv[0], idv[1], idv[2], idv[3]);
        *(int4*)(p.ids + ob + 4) = make_int4(idv[4], idv[5], idv[6], idv[7]);
        *(float4*)(p.gates + ob) = make_float4(gv[0], gv[1], gv[2], gv[3]);
        *(float4*)(p.gates + ob + 4) = make_float4(gv[4], gv[5], gv[6], gv[7]);
    }
}

typedef __bf16 bf16x2_t __attribute__((ext_vector_type(2)));
__device__ __forceinline__ float dot2bf(unsigned a, unsigned b, float acc) {
    return __builtin_amdgcn_fdot2_f32_bf16(__builtin_bit_cast(bf16x2_t, a), __builtin_bit_cast(bf16x2_t, b), acc, false);
}
typedef float f32x2 __attribute__((ext_vector_type(2)));
__device__ __forceinline__ f32x2 row_dot(const u32x4 w, const f32x2 (&x)[8], f32x2 acc) {
#pragma unroll
    for (int k = 0; k < 4; ++k) {
        acc = __builtin_amdgcn_cvt_pk_f32_fp8(w[k], false) * x[2 * k] + acc;
        acc = __builtin_amdgcn_cvt_pk_f32_fp8(w[k], true) * x[2 * k + 1] + acc;
    }
    return acc;
}
__device__ __forceinline__ float peer_u_round(const unsigned char* __restrict__ u8, int idv, const f32x2 (&x)[8], int lane) {
    u32x4 ra[8], rb[8];
#pragma unroll
    for (int j = 0; j < 8; ++j) {
        ra[j] = *(const u32x4*)(u8 + (size_t)__builtin_amdgcn_readlane(idv, j * 8) * DM + lane * 16);
        rb[j] = *(const u32x4*)(u8 + (size_t)__builtin_amdgcn_readlane(idv, j * 8 + 1) * DM + lane * 16);
    }
    float h = 0.f;
    const bool up16 = (lane & 16) != 0, up8 = (lane & 8) != 0;
#pragma unroll 1
    for (int c2 = 0; c2 < 4; ++c2) {
#pragma unroll
        for (int par = 0; par < 2; ++par) {
            const int c = c2 * 2 + par;
            float s[8];
#pragma unroll
            for (int j = 0; j < 8; ++j) {
                const f32x2 a = row_dot(par ? rb[j] : ra[j], x, (f32x2){0.f, 0.f});
                s[j] = a.x + a.y;
                if (c2 < 3) {
                    const u32x4 nw = *(const u32x4*)(u8 + (size_t)__builtin_amdgcn_readlane(idv, j * 8 + c + 2) * DM + lane * 16);
                    if (par) rb[j] = nw; else ra[j] = nw;
                }
            }
#pragma unroll
            for (int j = 0; j < 4; ++j) {
                auto r = __builtin_amdgcn_permlane32_swap(__float_as_uint(s[j]), __float_as_uint(s[j + 4]), false, false);
                s[j] = __uint_as_float(r[0]) + __uint_as_float(r[1]);
            }
#pragma unroll
            for (int j = 0; j < 2; ++j) {
                const float keep = up16 ? s[j + 2] : s[j], send = up16 ? s[j] : s[j + 2];
                s[j] = keep + __shfl_xor(send, 16);
            }
            float t;
            { const float keep = up8 ? s[1] : s[0], send = up8 ? s[0] : s[1]; t = keep + __shfl_xor(send, 8); }
            t += __shfl_xor(t, 4); t += __shfl_xor(t, 2); t += __shfl_xor(t, 1);
            if ((lane & 7) == c) h = t;
        }
    }
    return h;
}
#define PEER_DV 16
__device__ __forceinline__ void peer_v_round(const unsigned char* __restrict__ v8, int idv, float actv, f32x2 (&o)[8], int lane) {
    u32x4 rb[PEER_DV];
#pragma unroll
    for (int i = 0; i < PEER_DV; ++i) rb[i] = *(const u32x4*)(v8 + (size_t)__builtin_amdgcn_readlane(idv, i) * DM + lane * 16);
#pragma unroll 1
    for (int e0 = 0; e0 < 64; e0 += PEER_DV) {
#pragma unroll
        for (int i = 0; i < PEER_DV; ++i) {
            const float a = __int_as_float(__builtin_amdgcn_readlane(__float_as_int(actv), e0 + i));
            const f32x2 a2 = {a, a};
            const u32x4 w = rb[i];
#pragma unroll
            for (int k = 0; k < 4; ++k) {
                o[2 * k] = __builtin_amdgcn_cvt_pk_f32_fp8(w[k], false) * a2 + o[2 * k];
                o[2 * k + 1] = __builtin_amdgcn_cvt_pk_f32_fp8(w[k], true) * a2 + o[2 * k + 1];
            }
            if (e0 + PEER_DV < 64) rb[i] = *(const u32x4*)(v8 + (size_t)__builtin_amdgcn_readlane(idv, e0 + PEER_DV + i) * DM + lane * 16);
        }
    }
}
__device__ __forceinline__ float gelu_gate(float h, float g) { return 0.5f * h * (1.0f + erff(h * 0.70710678118654752f)) * g; }

__device__ void ph_peer(const Params& p) {
    const int lane = threadIdx.x & 63;
    const int wid = __builtin_amdgcn_readfirstlane(threadIdx.x >> 6);
    for (int t = blockIdx.x * 4 + wid; t < T_TOK; t += gridDim.x * 4) {
        const int id0 = p.ids[(size_t)t * 128 + lane], id1 = p.ids[(size_t)t * 128 + 64 + lane];
        const float g0 = p.gates[(size_t)t * 128 + lane], g1 = p.gates[(size_t)t * 128 + 64 + lane];
        const float su0 = p.su[id0], su1 = p.su[id1], sv0 = p.sv[id0], sv1 = p.sv[id1];
        const float* xr = p.x1 + (size_t)t * DM + lane * 16;
        f32x2 x[8];
        {
            const f32x4 a = *(const f32x4*)(xr), b = *(const f32x4*)(xr + 4), c = *(const f32x4*)(xr + 8), d = *(const f32x4*)(xr + 12);
            x[0] = (f32x2){a[0], a[1]}; x[1] = (f32x2){a[2], a[3]}; x[2] = (f32x2){b[0], b[1]}; x[3] = (f32x2){b[2], b[3]};
            x[4] = (f32x2){c[0], c[1]}; x[5] = (f32x2){c[2], c[3]}; x[6] = (f32x2){d[0], d[1]}; x[7] = (f32x2){d[2], d[3]};
        }
        const float h0 = peer_u_round(p.u8, id0, x, lane) * su0;
        const float h1 = peer_u_round(p.u8, id1, x, lane) * su1;
        const float a0 = gelu_gate(h0, g0) * sv0, a1 = gelu_gate(h1, g1) * sv1;
        f32x2 o[8];
#pragma unroll
        for (int i = 0; i < 8; ++i) o[i] = (f32x2){0.f, 0.f};
        peer_v_round(p.v8, id0, a0, o, lane);
        peer_v_round(p.v8, id1, a1, o, lane);
        float r[16];
#pragma unroll
        for (int i = 0; i < 8; ++i) { r[2 * i] = ALPHA * x[i].x + o[i].x; r[2 * i + 1] = ALPHA * x[i].y + o[i].y; }
        float* rr = p.y1 + (size_t)t * DM + lane * 16;
        *(f32x4*)(rr) = (f32x4){r[0], r[1], r[2], r[3]};
        *(f32x4*)(rr + 4) = (f32x4){r[4], r[5], r[6], r[7]};
        *(f32x4*)(rr + 8) = (f32x4){r[8], r[9], r[10], r[11]};
        *(f32x4*)(rr + 12) = (f32x4){r[12], r[13], r[14], r[15]};
        bf16_t* rbp = p.rb + (size_t)t * DM + lane * 16;
        u32x4 w0, w1;
        w0[0] = pack2(r[0], r[1]); w0[1] = pack2(r[2], r[3]); w0[2] = pack2(r[4], r[5]); w0[3] = pack2(r[6], r[7]);
        w1[0] = pack2(r[8], r[9]); w1[1] = pack2(r[10], r[11]); w1[2] = pack2(r[12], r[13]); w1[3] = pack2(r[14], r[15]);
        *(u32x4*)(rbp) = w0; *(u32x4*)(rbp + 8) = w1;
    }
}

__device__ void ph_gemm_ple(const Params& p, unsigned char* smem) {
    const int ntn = DM / 128;
    const int tid = threadIdx.x, lane = tid & 63, wid = tid >> 6, wr = wid >> 1, wc = wid & 1, fr = lane & 15, fq = lane >> 4;
    for (int t = blockIdx.x; t < (T_TOK / 128) * ntn; t += gridDim.x) {
        const int m0 = (t / ntn) * 128, n0 = (t % ntn) * 128;
        f32x4 acc[4][4], acc2[4][4]; zero_acc(acc); zero_acc(acc2);
        gemm128(p.pb + (size_t)m0 * 256, 256, p.WpT + (size_t)n0 * 256, 256, 256, smem, acc2);
        gemm128(p.rb + (size_t)m0 * DM, DM, p.WgT + (size_t)n0 * DM, DM, DM, smem, acc);
#pragma unroll
        for (int mi = 0; mi < 4; ++mi) {
            const int row = m0 + wr * 64 + mi * 16 + fr;
#pragma unroll
            for (int ni = 0; ni < 4; ++ni) {
                const int col = n0 + wc * 64 + ni * 16 + fq * 4;
                float* yp = p.y1 + (size_t)row * DM + col;
                f32x4 rv = *(const f32x4*)yp;
#pragma unroll
                for (int r = 0; r < 4; ++r) rv[r] += acc2[mi][ni][r] / (1.0f + __expf(-acc[mi][ni][r]));
                *(f32x4*)yp = rv;
            }
        }
    }
}

#define SMEM_BYTES (256 * ASTR * 2 * 2)
__global__ void __launch_bounds__(256, 2) mega(Params p) {
    __shared__ __attribute__((aligned(16))) unsigned char smem[SMEM_BYTES];
    cg::grid_group grid = cg::this_grid();
    ph_prep(p, smem);        grid.sync();
    ph_gemm_in(p, smem);     grid.sync();
    ph_attn(p, smem);
    ph_conv(p, smem);        grid.sync();
    ph_gemm_out(p, smem);    grid.sync();
    ph_ln1(p);               grid.sync();
    ph_route(p, smem);       grid.sync();
    ph_peer(p);              grid.sync();
    ph_gemm_ple(p, smem);    grid.sync();
    ph_ln2(p);
}

extern "C" void kernel_launch(void* const* d_in, const int* in_sizes, int n_in, void* d_out, int out_size, void* d_ws, size_t ws_size,
                              hipStream_t stream) {
    Params p{};
    p.x = (const float*)d_in[0]; p.p = (const float*)d_in[1]; p.pos = (const int*)d_in[2];
    p.w_in = (const float*)d_in[3]; p.sinks = (const float*)d_in[4]; p.conv_w = (const float*)d_in[5]; p.conv_b = (const float*)d_in[6];
    p.cln_g = (const float*)d_in[7]; p.cln_b = (const float*)d_in[8]; p.w_out = (const float*)d_in[9]; p.ln1_g = (const float*)d_in[10];
    p.ln1_b = (const float*)d_in[11]; p.wq = (const float*)d_in[12]; p.keys = (const float*)d_in[13]; p.pu = (const float*)d_in[14];
    p.pv = (const float*)d_in[15]; p.ple_proj = (const float*)d_in[16]; p.ple_gate = (const float*)d_in[17]; p.ln2_g = (const float*)d_in[18];
    p.ln2_b = (const float*)d_in[19];
    p.out = (float*)d_out;
    unsigned char* ws = (unsigned char*)d_ws;
    const size_t MiB = 1024 * 1024;
    p.y1 = (float*)(ws + 0 * MiB);
    p.hb = (bf16_t*)(ws + 128 * MiB);
    p.qb = (bf16_t*)(ws + 128 * MiB);
    p.xb = (bf16_t*)(ws + 256 * MiB);
    p.x1b = (bf16_t*)(ws + 256 * MiB);
    p.mixb = (bf16_t*)(ws + 320 * MiB);
    p.tops = (float*)(ws + 320 * MiB);
    p.topi = (int*)(ws + 352 * MiB);
    p.rb = (bf16_t*)(ws + 320 * MiB);
    p.pb = (bf16_t*)(ws + 384 * MiB);
    p.ub = (bf16_t*)(ws + 400 * MiB);
    p.vb = (bf16_t*)(ws + 432 * MiB);
    p.u8 = (unsigned char*)(ws + 400 * MiB);
    p.v8 = (unsigned char*)(ws + 416 * MiB);
    p.su = (float*)(ws + 432 * MiB);
    p.sv = (float*)(ws + 433 * MiB);
    p.ids = (int*)(ws + 464 * MiB);
    p.gates = (float*)(ws + 480 * MiB);
    unsigned char* wb = ws + 496 * MiB;
    p.WinT = (bf16_t*)wb; wb += (size_t)INW * DM * 2;
    p.WoutT = (bf16_t*)wb; wb += (size_t)DM * DM * 2;
    p.WqT = (bf16_t*)wb; wb += (size_t)2048 * DM * 2;
    p.WgT = (bf16_t*)wb; wb += (size_t)DM * DM * 2;
    p.WpT = (bf16_t*)wb; wb += (size_t)DM * 256 * 2;
    p.keysb = (bf16_t*)wb; wb += (size_t)16 * 128 * 128 * 2;
    p.x1 = (float*)d_out;

    static int grid_blocks = 0;
    if (!grid_blocks) {
        int dev = 0, cus = 0, per_cu = 0;
        (void)hipGetDevice(&dev);
        (void)hipDeviceGetAttribute(&cus, hipDeviceAttributeMultiprocessorCount, dev);
        (void)hipOccupancyMaxActiveBlocksPerMultiprocessor(&per_cu, mega, 256, 0);
        if (per_cu > 2) per_cu = 2;
        grid_blocks = cus * per_cu;
    }
    void* args[] = {&p};
    hipError_t e = hipLaunchCooperativeKernel((void*)mega, dim3(grid_blocks), dim3(256), args, 0, stream);
    if (e != hipSuccess) fprintf(stderr, "cooperative launch failed: %s (grid %d)\n", hipGetErrorString(e), grid_blocks);
}
```

```cpp
#include <hip/hip_runtime.h>
#include <hip/hip_cooperative_groups.h>
#include <stdint.h>
#include <cstdio>
namespace cg = cooperative_groups;

typedef unsigned short bf16_t;
typedef short bf16x8 __attribute__((ext_vector_type(8)));
typedef float f32x4 __attribute__((ext_vector_type(4)));
typedef unsigned u32x4 __attribute__((ext_vector_type(4)));

#define T_TOK 32768
#define SEQ 2048
#define DM 1024
#define INW 1792
#define ALPHA 1.189207115002721f
#define LN_EPS 1e-5f

__device__ __forceinline__ bf16_t f2bf(float f) {
    unsigned u = __float_as_uint(f);
    u += 0x7fffu + ((u >> 16) & 1u);
    return (bf16_t)(u >> 16);
}
__device__ __forceinline__ float bf2f(bf16_t b) { return __uint_as_float(((unsigned)b) << 16); }
__device__ __forceinline__ float bflo(unsigned w) { return __uint_as_float(w << 16); }
__device__ __forceinline__ float bfhi(unsigned w) { return __uint_as_float(w & 0xffff0000u); }
__device__ __forceinline__ unsigned pack2(float a, float b) { return (unsigned)f2bf(a) | ((unsigned)f2bf(b) << 16); }

__device__ __forceinline__ float wave_sum(float v) {
#pragma unroll
    for (int o = 32; o >= 1; o >>= 1) v += __shfl_xor(v, o);
    return v;
}

struct Params {
    const float *x, *p; const int* pos;
    const float *w_in, *sinks, *conv_w, *conv_b, *cln_g, *cln_b, *w_out, *ln1_g, *ln1_b;
    const float *wq, *keys, *pu, *pv, *ple_proj, *ple_gate, *ln2_g, *ln2_b;
    float* out;
    bf16_t *xb, *pb, *WinT, *WoutT, *WqT, *WgT, *WpT, *keysb, *ub, *vb, *hb, *mixb, *x1b, *qb, *rb;
    float *y1, *x1, *tops, *gates, *su, *sv;
    int *topi, *ids;
    unsigned char *u8, *v8;
    unsigned* bar;
};

__device__ void cvt_rows(const float* __restrict__ src, bf16_t* __restrict__ dst, size_t n) {
    size_t nv = n / 8;
    for (size_t i = (size_t)blockIdx.x * blockDim.x + threadIdx.x; i < nv; i += (size_t)gridDim.x * blockDim.x) {
        const float4 a = ((const float4*)src)[2 * i], b = ((const float4*)src)[2 * i + 1];
        uint4 o; o.x = pack2(a.x, a.y); o.y = pack2(a.z, a.w); o.z = pack2(b.x, b.y); o.w = pack2(b.z, b.w);
        ((uint4*)dst)[i] = o;
    }
}
__device__ void transpose_cvt(const float* __restrict__ W, bf16_t* __restrict__ Wt, int K, int N, float* tile  ) {
    const int tk = K / 32, tn = N / 32;
    const int tx = threadIdx.x & 31, ty = threadIdx.x >> 5;
    for (int t = blockIdx.x; t < tk * tn; t += gridDim.x) {
        const int k0 = (t / tn) * 32, n0 = (t % tn) * 32;
        __syncthreads();
#pragma unroll
        for (int i = 0; i < 4; ++i) tile[(ty + i * 8) * 33 + tx] = W[(size_t)(k0 + ty + i * 8) * N + n0 + tx];
        __syncthreads();
#pragma unroll
        for (int i = 0; i < 4; ++i) Wt[(size_t)(n0 + ty + i * 8) * K + k0 + tx] = f2bf(tile[tx * 33 + ty + i * 8]);
    }
}

__device__ void cvt_table_fp8(const float* __restrict__ src, unsigned char* __restrict__ dst, float* __restrict__ scl, int rows) {
    const int lane = threadIdx.x & 63, wid = threadIdx.x >> 6;
    for (int r = blockIdx.x * 4 + wid; r < rows; r += gridDim.x * 4) {
        const float* sr = src + (size_t)r * DM + lane * 16;
        const f32x4 a = *(const f32x4*)(sr), b = *(const f32x4*)(sr + 4), c = *(const f32x4*)(sr + 8), d = *(const f32x4*)(sr + 12);
        float m = 0.f;
#pragma unroll
        for (int i = 0; i < 4; ++i) m = fmaxf(m, fmaxf(fmaxf(fabsf(a[i]), fabsf(b[i])), fmaxf(fabsf(c[i]), fabsf(d[i]))));
#pragma unroll
        for (int o = 32; o >= 1; o >>= 1) m = fmaxf(m, __shfl_xor(m, o));
        const float q = (m > 0.f) ? 448.0f / m : 1.0f;
        u32x4 w;
        w[0] = __builtin_amdgcn_cvt_pk_fp8_f32(a[2] * q, a[3] * q, __builtin_amdgcn_cvt_pk_fp8_f32(a[0] * q, a[1] * q, 0, false), true);
        w[1] = __builtin_amdgcn_cvt_pk_fp8_f32(b[2] * q, b[3] * q, __builtin_amdgcn_cvt_pk_fp8_f32(b[0] * q, b[1] * q, 0, false), true);
        w[2] = __builtin_amdgcn_cvt_pk_fp8_f32(c[2] * q, c[3] * q, __builtin_amdgcn_cvt_pk_fp8_f32(c[0] * q, c[1] * q, 0, false), true);
        w[3] = __builtin_amdgcn_cvt_pk_fp8_f32(d[2] * q, d[3] * q, __builtin_amdgcn_cvt_pk_fp8_f32(d[0] * q, d[1] * q, 0, false), true);
        *(u32x4*)(dst + (size_t)r * DM + lane * 16) = w;
        if (lane == 0) scl[r] = (m > 0.f) ? m * (1.0f / 448.0f) : 1.0f;
    }
}
__device__ void ph_prep(const Params& p, unsigned char* smem) {
    float* tile = (float*)smem;
    cvt_rows(p.x, p.xb, (size_t)T_TOK * DM);
    cvt_rows(p.p, p.pb, (size_t)T_TOK * 256);
    cvt_table_fp8(p.pu, p.u8, p.su, 16384);
    cvt_table_fp8(p.pv, p.v8, p.sv, 16384);
    cvt_rows(p.keys, p.keysb, (size_t)16 * 128 * 128);
    transpose_cvt(p.w_in, p.WinT, DM, INW, tile);
    transpose_cvt(p.w_out, p.WoutT, DM, DM, tile);
    transpose_cvt(p.wq, p.WqT, DM, 2048, tile);
    transpose_cvt(p.ple_gate, p.WgT, DM, DM, tile);
    transpose_cvt(p.ple_proj, p.WpT, 256, DM, tile);
}

#define LDS_AS __attribute__((address_space(3)))
#define GEMM_STAGE 32768
__device__ __forceinline__ void gemm128(const bf16_t* __restrict__ A, int lda, const bf16_t* __restrict__ Bt, int ldb, int K,
                                        unsigned char* smem, f32x4 (&acc)[4][4]) {
    LDS_AS unsigned char* lds = (LDS_AS unsigned char*)smem;
    const int tid = threadIdx.x, lane = tid & 63, wid = __builtin_amdgcn_readfirstlane(tid >> 6);
    const int wr = wid >> 1, wc = wid & 1, fr = lane & 15, fq = lane >> 4;
    const int nk = K / 64;
    const int prow = lane >> 3, pc = (lane & 7) ^ prow;
    const bf16_t* gA = A + (size_t)(wid * 32 + prow) * lda + pc * 8;
    const bf16_t* gB = Bt + (size_t)(wid * 32 + prow) * ldb + pc * 8;
    const size_t a8 = (size_t)8 * lda, b8 = (size_t)8 * ldb;
#define GEMM_ISSUE(kt, st) do { \
        _Pragma("unroll") for (int _i = 0; _i < 4; ++_i) { \
            __builtin_amdgcn_global_load_lds((const unsigned*)(gA + _i * a8 + (size_t)(kt) * 64), (LDS_AS unsigned*)(lds + (st) * GEMM_STAGE + (wid * 4 + _i) * 1024), 16, 0, 0); \
            __builtin_amdgcn_global_load_lds((const unsigned*)(gB + _i * b8 + (size_t)(kt) * 64), (LDS_AS unsigned*)(lds + (st) * GEMM_STAGE + 16384 + (wid * 4 + _i) * 1024), 16, 0, 0); \
        } } while (0)
    const int swz0 = ((0 * 4 + fq) ^ (fr & 7)) * 16, swz1 = ((1 * 4 + fq) ^ (fr & 7)) * 16;
    const int aoff = (wr * 64 + fr) * 128, boff = 16384 + (wc * 64 + fr) * 128;
    GEMM_ISSUE(0, 0);
#pragma unroll 1
    for (int kt = 0; kt < nk; ++kt) {
        const int st = kt & 1;
        if (kt + 1 < nk) { GEMM_ISSUE(kt + 1, st ^ 1); asm volatile("s_waitcnt vmcnt(8)" ::: "memory"); }
        else { asm volatile("s_waitcnt vmcnt(0)" ::: "memory"); }
        __builtin_amdgcn_s_barrier();
        asm volatile("" ::: "memory");
        const LDS_AS unsigned char* sb = lds + st * GEMM_STAGE;
#pragma unroll
        for (int kk = 0; kk < 2; ++kk) {
            const int swz = kk ? swz1 : swz0;
            bf16x8 af[4], bfr[4];
#pragma unroll
            for (int mi = 0; mi < 4; ++mi) af[mi] = *(const LDS_AS bf16x8*)(sb + aoff + mi * 2048 + swz);
#pragma unroll
            for (int ni = 0; ni < 4; ++ni) bfr[ni] = *(const LDS_AS bf16x8*)(sb + boff + ni * 2048 + swz);
#pragma unroll
            for (int mi = 0; mi < 4; ++mi)
#pragma unroll
                for (int ni = 0; ni < 4; ++ni)
                    acc[mi][ni] = __builtin_amdgcn_mfma_f32_16x16x32_bf16(bfr[ni], af[mi], acc[mi][ni], 0, 0, 0);
        }
        asm volatile("s_waitcnt lgkmcnt(0)" ::: "memory");
        __builtin_amdgcn_s_barrier();
        asm volatile("" ::: "memory");
    }
#undef GEMM_ISSUE
}
__device__ __forceinline__ void zero_acc(f32x4 (&acc)[4][4]) {
#pragma unroll
    for (int a = 0; a < 4; ++a)
#pragma unroll
        for (int b = 0; b < 4; ++b) acc[a][b] = (f32x4){0.f, 0.f, 0.f, 0.f};
}
#define GEMM_SMEM (2 * GEMM_STAGE)

__device__ void ph_gemm_in(const Params& p, unsigned char* smem, const int vb) {
    const int ntn = INW / 128;
    const int tid = threadIdx.x, lane = tid & 63, wid = tid >> 6, wr = wid >> 1, wc = wid & 1, fr = lane & 15, fq = lane >> 4;
    for (int t = vb; t < (T_TOK / 128) * ntn; t += gridDim.x) {
        const int m0 = (t / ntn) * 128, n0 = (t % ntn) * 128;
        f32x4 acc[4][4]; zero_acc(acc);
        gemm128(p.xb + (size_t)m0 * DM, DM, p.WinT + (size_t)n0 * DM, DM, DM, smem, acc);
#pragma unroll
        for (int mi = 0; mi < 4; ++mi) {
            const int row = m0 + wr * 64 + mi * 16 + fr;
            const float posf = (float)p.pos[row];
#pragma unroll
            for (int ni = 0; ni < 4; ++ni) {
                const int col0 = n0 + wc * 64 + ni * 16;
                f32x4 v = acc[mi][ni];
                if (col0 < 640 && (col0 & 63) == 0) {
#pragma unroll
                    for (int r = 0; r < 4; ++r) {
                        const float other = __shfl_xor(v[r], 32);
                        const int j = (fq & 1) * 4 + r;
                        const float inv = powf(500000.0f, -(float)j * 0.125f);
                        float sn, cs; sincosf(posf * inv, &sn, &cs);
                        v[r] = (fq < 2) ? (v[r] * cs - other * sn) : (v[r] * cs + other * sn);
                    }
                }
                uint2 o; o.x = pack2(v[0], v[1]); o.y = pack2(v[2], v[3]);
                *(uint2*)(p.hb + (size_t)row * INW + col0 + fq * 4) = o;
            }
        }
    }
}

#define ASTR 72
#define VSTR 260
typedef float f32x16 __attribute__((ext_vector_type(16)));
typedef unsigned u32x2 __attribute__((ext_vector_type(2)));
__device__ void ph_attn(const Params& p, unsigned char* smem, const int vb) {
    bf16_t* sK = (bf16_t*)smem;
    bf16_t* sVt = sK + 256 * ASTR;
    const int tid = threadIdx.x, lane = tid & 63, wid = tid >> 6, r32 = lane & 31, hh = lane >> 5;
    const float C1 = 0.125f * 1.4426950408889634f, LOG2E = 1.4426950408889634f;
    for (int u = vb; u < 16 * 16 * 2; u += gridDim.x) {
        const int kvh = u & 1, nb = (u >> 1) & 15, b = u >> 5;
        __syncthreads();
        for (int c = tid; c < 256 * 8; c += 256) {
            const int li = c >> 3, kc = c & 7;
            const int pos = nb * 128 - 128 + li;
            u32x4 kv = {0u, 0u, 0u, 0u}, vv = {0u, 0u, 0u, 0u};
            if (pos >= 0) {
                const bf16_t* base = p.hb + (size_t)(b * SEQ + pos) * INW;
                kv = *(const u32x4*)(base + 512 + kvh * 64 + kc * 8);
                vv = *(const u32x4*)(base + 640 + kvh * 64 + kc * 8);
            }
            *(u32x4*)(sK + li * ASTR + kc * 8) = kv;
#pragma unroll
            for (int i = 0; i < 4; ++i) {
                sVt[(kc * 8 + 2 * i) * VSTR + li] = (bf16_t)(vv[i] & 0xffffu);
                sVt[(kc * 8 + 2 * i + 1) * VSTR + li] = (bf16_t)(vv[i] >> 16);
            }
        }
        __syncthreads();
        const int hq = kvh * 4 + wid;
        const float sink2 = p.sinks[hq] * LOG2E;
#pragma unroll 1
        for (int qt = 0; qt < 4; ++qt) {
            const size_t trow = (size_t)(b * SEQ + nb * 128 + qt * 32 + r32);
            bf16x8 qf[4];
#pragma unroll
            for (int ks = 0; ks < 4; ++ks) qf[ks] = *(const bf16x8*)(p.hb + trow * INW + hq * 64 + ks * 16 + hh * 8);
            f32x16 S[5];
#pragma unroll
            for (int j = 0; j < 5; ++j) {
#pragma unroll
                for (int r = 0; r < 16; ++r) S[j][r] = 0.f;
#pragma unroll
                for (int ks = 0; ks < 4; ++ks) {
                    const bf16x8 a = *(const bf16x8*)(sK + ((qt + j) * 32 + r32) * ASTR + ks * 16 + hh * 8);
                    S[j] = __builtin_amdgcn_mfma_f32_32x32x16_bf16(a, qf[ks], S[j], 0, 0, 0);
                }
            }
            float m2 = sink2;
#pragma unroll
            for (int j = 0; j < 5; ++j) {
                const bool tile_ok = (nb > 0) || (qt + j >= 4);
#pragma unroll
                for (int r = 0; r < 16; ++r) {
                    const int kl = (r & 3) + 8 * (r >> 2) + 4 * hh;
                    bool ok = tile_ok;
                    if (j == 0) ok = ok && (kl > r32);
                    if (j == 4) ok = ok && (kl <= r32);
                    const float t = ok ? S[j][r] * C1 : -1.0e30f;
                    S[j][r] = t;
                    m2 = fmaxf(m2, t);
                }
            }
            m2 = fmaxf(m2, __shfl_xor(m2, 32));
            float l = 0.f;
#pragma unroll
            for (int j = 0; j < 5; ++j)
#pragma unroll
                for (int r = 0; r < 16; ++r) { const float e = __builtin_amdgcn_exp2f(S[j][r] - m2); S[j][r] = e; l += e; }
            l += __shfl_xor(l, 32);
            l += __builtin_amdgcn_exp2f(sink2 - m2);
            f32x16 O[2];
#pragma unroll
            for (int dt = 0; dt < 2; ++dt)
#pragma unroll
                for (int r = 0; r < 16; ++r) O[dt][r] = 0.f;
#pragma unroll
            for (int j = 0; j < 5; ++j)
#pragma unroll
                for (int s2 = 0; s2 < 2; ++s2) {
                    u32x4 pw;
#pragma unroll
                    for (int k = 0; k < 4; ++k) pw[k] = pack2(S[j][8 * s2 + 2 * k], S[j][8 * s2 + 2 * k + 1]);
                    const bf16x8 pf = __builtin_bit_cast(bf16x8, pw);
                    const int kbase = (qt + j) * 32 + 16 * s2 + 4 * hh;
#pragma unroll
                    for (int dt = 0; dt < 2; ++dt) {
                        const bf16_t* vp = sVt + (dt * 32 + r32) * VSTR + kbase;
                        const u32x2 v0 = *(const u32x2*)(vp), v1 = *(const u32x2*)(vp + 8);
                        const u32x4 vw = {v0[0], v0[1], v1[0], v1[1]};
                        O[dt] = __builtin_amdgcn_mfma_f32_32x32x16_bf16(__builtin_bit_cast(bf16x8, vw), pf, O[dt], 0, 0, 0);
                    }
                }
            const float il = 1.0f / l;
#pragma unroll
            for (int dt = 0; dt < 2; ++dt)
#pragma unroll
                for (int g = 0; g < 4; ++g) {
                    u32x2 w;
                    w[0] = pack2(O[dt][4 * g] * il, O[dt][4 * g + 1] * il);
                    w[1] = pack2(O[dt][4 * g + 2] * il, O[dt][4 * g + 3] * il);
                    *(u32x2*)(p.mixb + trow * DM + hq * 64 + dt * 32 + 8 * g + 4 * hh) = w;
                }
        }
    }
}

__device__ void ph_conv(const Params& p, unsigned char* smem, const int vb) {
    float* cv = (float*)smem;
    const int tid = threadIdx.x, lane = tid & 63, wid = tid >> 6;
    for (int u = vb; u < T_TOK / 32; u += gridDim.x) {
        const int tok0 = u * 32;
        const int s0 = tok0 & (SEQ - 1);
        __syncthreads();
        for (int half = 0; half < 2; ++half) {
            const int c = tid + half * 256;
            float glu[62];
#pragma unroll
            for (int i = 0; i < 62; ++i) {
                const int s = s0 - 30 + i;
                float g = 0.f;
                if (s >= 0) {
                    const bf16_t* base = p.hb + (size_t)(tok0 - 30 + i) * INW;
                    const float a = bf2f(base[768 + c]), gt = bf2f(base[1280 + c]);
                    g = a / (1.0f + __expf(-gt));
                }
                glu[i] = g;
            }
            float w[31];
#pragma unroll
            for (int k = 0; k < 31; ++k) w[k] = p.conv_w[k * 512 + c];
            const float bias = p.conv_b[c];
#pragma unroll
            for (int j = 0; j < 32; ++j) {
                float a = bias;
#pragma unroll
                for (int k = 0; k < 31; ++k) a += w[k] * glu[j + k];
                cv[j * 512 + c] = a;
            }
        }
        __syncthreads();
        for (int jj = 0; jj < 8; ++jj) {
            const int j = wid * 8 + jj;
            float v[8]; float s = 0.f;
#pragma unroll
            for (int i = 0; i < 8; ++i) { v[i] = cv[j * 512 + lane + 64 * i]; s += v[i]; }
            const float mu = wave_sum(s) * (1.0f / 512.0f);
            float q = 0.f;
#pragma unroll
            for (int i = 0; i < 8; ++i) { const float d = v[i] - mu; q += d * d; }
            const float rstd = rsqrtf(wave_sum(q) * (1.0f / 512.0f) + LN_EPS);
#pragma unroll
            for (int i = 0; i < 8; ++i) {
                const int c = lane + 64 * i;
                const float y = (v[i] - mu) * rstd * p.cln_g[c] + p.cln_b[c];
                const float sl = y / (1.0f + __expf(-y));
                p.mixb[(size_t)(tok0 + j) * DM + 512 + c] = f2bf(sl);
            }
        }
    }
}

__device__ void ph_gemm_out(const Params& p, unsigned char* smem, const int vb) {
    const int ntn = DM / 128;
    const int tid = threadIdx.x, lane = tid & 63, wid = tid >> 6, wr = wid >> 1, wc = wid & 1, fr = lane & 15, fq = lane >> 4;
    for (int t = vb; t < (T_TOK / 128) * ntn; t += gridDim.x) {
        const int m0 = (t / ntn) * 128, n0 = (t % ntn) * 128;
        f32x4 acc[4][4]; zero_acc(acc);
        gemm128(p.mixb + (size_t)m0 * DM, DM, p.WoutT + (size_t)n0 * DM, DM, DM, smem, acc);
#pragma unroll
        for (int mi = 0; mi < 4; ++mi) {
            const int row = m0 + wr * 64 + mi * 16 + fr;
#pragma unroll
            for (int ni = 0; ni < 4; ++ni) {
                const int col = n0 + wc * 64 + ni * 16 + fq * 4;
                const f32x4 xv = *(const f32x4*)(p.x + (size_t)row * DM + col);
                *(f32x4*)(p.y1 + (size_t)row * DM + col) = xv * ALPHA + acc[mi][ni];
            }
        }
    }
}

__device__ __forceinline__ void ln_row(const float* __restrict__ src, const float* __restrict__ g, const float* __restrict__ bta,
                                       float* __restrict__ dstf, bf16_t* __restrict__ dstb, int lane) {
    f32x4 v[4]; float s = 0.f;
#pragma unroll
    for (int i = 0; i < 4; ++i) { v[i] = *(const f32x4*)(src + i * 256 + lane * 4); s += (v[i][0] + v[i][1]) + (v[i][2] + v[i][3]); }
    const float mu = wave_sum(s) * (1.0f / 1024.0f);
    float q = 0.f;
#pragma unroll
    for (int i = 0; i < 4; ++i) { const f32x4 d = v[i] - mu; q += (d[0] * d[0] + d[1] * d[1]) + (d[2] * d[2] + d[3] * d[3]); }
    const float rstd = rsqrtf(wave_sum(q) * (1.0f / 1024.0f) + LN_EPS);
#pragma unroll
    for (int i = 0; i < 4; ++i) {
        const f32x4 gg = *(const f32x4*)(g + i * 256 + lane * 4), bb = *(const f32x4*)(bta + i * 256 + lane * 4);
        const f32x4 y = (v[i] - mu) * rstd * gg + bb;
        *(f32x4*)(dstf + i * 256 + lane * 4) = y;
        if (dstb) { uint2 o; o.x = pack2(y[0], y[1]); o.y = pack2(y[2], y[3]); *(uint2*)(dstb + i * 256 + lane * 4) = o; }
    }
}
__device__ void ph_ln1(const Params& p, const int vb) {
    const int lane = threadIdx.x & 63, wid = threadIdx.x >> 6;
    for (int r = vb * 4 + wid; r < T_TOK; r += gridDim.x * 4)
        ln_row(p.y1 + (size_t)r * DM, p.ln1_g, p.ln1_b, p.x1 + (size_t)r * DM, p.x1b + (size_t)r * DM, lane);
}
__device__ void ph_ln2(const Params& p, const int vb) {
    const int lane = threadIdx.x & 63, wid = threadIdx.x >> 6;
    for (int r = vb * 4 + wid; r < T_TOK; r += gridDim.x * 4)
        ln_row(p.y1 + (size_t)r * DM, p.ln2_g, p.ln2_b, p.out + (size_t)r * DM, (bf16_t*)nullptr, lane);
}

#define QSTR 136
__device__ __forceinline__ int f2key(float f) { const int b = __float_as_int(f); return b ^ ((b >> 31) & 0x7fffffff); }
__device__ __forceinline__ float key2f(int k) { return __int_as_float(k ^ ((k >> 31) & 0x7fffffff)); }
__device__ __forceinline__ void sort16_desc(int (&a)[16]) {
#pragma unroll
    for (int lk = 1; lk <= 4; ++lk) {
#pragma unroll
        for (int lj = lk - 1; lj >= 0; --lj) {
            const int k = 1 << lk, j = 1 << lj;
#pragma unroll
            for (int i = 0; i < 16; ++i) {
                const int l = i ^ j;
                if (l > i) {
                    const int hi = max(a[i], a[l]), lo = min(a[i], a[l]);
                    if ((i & k) == 0) { a[i] = hi; a[l] = lo; } else { a[i] = lo; a[l] = hi; }
                }
            }
        }
    }
}
__device__ __forceinline__ void merge_top16(int (&a)[16], const int (&b)[16]) {
#pragma unroll
    for (int i = 0; i < 16; ++i) a[i] = max(a[i], b[15 - i]);
#pragma unroll
    for (int lj = 3; lj >= 0; --lj) {
        const int j = 1 << lj;
#pragma unroll
        for (int i = 0; i < 16; ++i) {
            const int l = i ^ j;
            if (l > i) { const int hi = max(a[i], a[l]), lo = min(a[i], a[l]); a[i] = hi; a[l] = lo; }
        }
    }
}
__device__ __forceinline__ void top16_of_64(int (&v)[4][16]) {
    sort16_desc(v[0]); sort16_desc(v[1]); sort16_desc(v[2]); sort16_desc(v[3]);
    merge_top16(v[0], v[1]); merge_top16(v[0], v[2]); merge_top16(v[0], v[3]);
}

__device__ __forceinline__ void route_half(const Params& p, unsigned char* smem, int m0, int hp, int (&K)[16]) {
    bf16_t* Qs = (bf16_t*)smem;
    bf16_t* Ks = (bf16_t*)(smem + 128 * QSTR * 2);
    const int tid = threadIdx.x, lane = tid & 63, wid = tid >> 6, wr = wid >> 1, wc = wid & 1, fr = lane & 15, fq = lane >> 4;
    const int r32 = lane & 31, hh = lane >> 5;
    {
        f32x4 acc[4][4]; zero_acc(acc);
        gemm128(p.x1b + (size_t)m0 * DM, DM, p.WqT + (size_t)hp * 128 * DM, DM, DM, smem, acc);
#pragma unroll
        for (int mi = 0; mi < 4; ++mi)
#pragma unroll
            for (int ni = 0; ni < 4; ++ni) {
                uint2 o; o.x = pack2(acc[mi][ni][0], acc[mi][ni][1]); o.y = pack2(acc[mi][ni][2], acc[mi][ni][3]);
                *(uint2*)(Qs + (wr * 64 + mi * 16 + fr) * QSTR + wc * 64 + ni * 16 + fq * 4) = o;
            }
    }
    {
        const bf16_t* kg = p.keysb + (size_t)hp * 128 * 128;
#pragma unroll
        for (int i = 0; i < 8; ++i) {
            const int c = tid + i * 256, row = c >> 4, kc = c & 15;
            *(u32x4*)(Ks + row * QSTR + kc * 8) = *(const u32x4*)(kg + row * 128 + kc * 8);
        }
    }
    __syncthreads();
    f32x16 S[4];
#pragma unroll
    for (int mt = 0; mt < 4; ++mt)
#pragma unroll
        for (int r = 0; r < 16; ++r) S[mt][r] = 0.f;
#pragma unroll
    for (int kk = 0; kk < 8; ++kk) {
        const bf16x8 b = *(const bf16x8*)(Qs + (wid * 32 + r32) * QSTR + kk * 16 + hh * 8);
#pragma unroll
        for (int mt = 0; mt < 4; ++mt) {
            const bf16x8 a = *(const bf16x8*)(Ks + (mt * 32 + r32) * QSTR + kk * 16 + hh * 8);
            S[mt] = __builtin_amdgcn_mfma_f32_32x32x16_bf16(a, b, S[mt], 0, 0, 0);
        }
    }
    __syncthreads();
    int v[4][16];
#pragma unroll
    for (int mt = 0; mt < 4; ++mt)
#pragma unroll
        for (int r = 0; r < 16; ++r) {
            const int n = mt * 32 + (r & 3) + 8 * (r >> 2) + 4 * hh;
            v[mt][r] = (f2key(S[mt][r]) & ~0x7F) | (127 - n);
        }
    top16_of_64(v);
    int o[16];
#pragma unroll
    for (int i = 0; i < 16; ++i) o[i] = __shfl_xor(v[0][i], 32);
    merge_top16(v[0], o);
#pragma unroll
    for (int i = 0; i < 16; ++i) K[i] = v[0][i];
}

__device__ void ph_route(const Params& p, unsigned char* smem, const int vb) {
    const int tid = threadIdx.x, lane = tid & 63, wid = tid >> 6;
    const int r32 = lane & 31, hh = lane >> 5;
    const int hmask = -hh;
    int* KL = (int*)(smem + (size_t)wid * 32 * QSTR * 2);
    for (int u = vb; u < (T_TOK / 128) * 8; u += gridDim.x) {
        const int m0 = (u >> 3) * 128, h = u & 7;
        __syncthreads();
        int K0[16], K1[16];
        route_half(p, smem, m0, h * 2 + 0, K0);
        route_half(p, smem, m0, h * 2 + 1, K1);
#pragma unroll
        for (int i = 0; i < 16; ++i) KL[r32 * 33 + hh * 16 + i] = K0[i] ^ ((K0[i] ^ K1[i]) & hmask);
        float s1[16], s2[16];
#pragma unroll
        for (int i = 0; i < 16; ++i) { s1[i] = key2f(K0[i] & ~0x7F); s2[i] = key2f(K1[i] & ~0x7F); }
        int c[4][16];
#pragma unroll
        for (int i = 0; i < 16; ++i)
#pragma unroll
            for (int j = 0; j < 16; ++j)
                if ((i + 1) * (j + 1) <= 16) {
                    constexpr int OFFS[16] = {0, 16, 24, 29, 33, 36, 38, 40, 42, 43, 44, 45, 46, 47, 48, 49};
                    const int q = OFFS[i] + j;
                    c[q >> 4][q & 15] = (f2key(s1[i] + s2[j]) & ~0xFF) | (255 - (i * 16 + j));
                }
#pragma unroll
        for (int qq = 50; qq < 64; ++qq) c[qq >> 4][qq & 15] = (int)0x80000000;
        top16_of_64(c);
        const float mx = key2f(c[0][0] & ~0xFF);
        float e[16]; float den = 0.f;
#pragma unroll
        for (int i = 0; i < 16; ++i) { e[i] = __expf(key2f(c[0][i] & ~0xFF) - mx); den += e[i]; }
        const float inv = 1.0f / den;
        const size_t ob = (size_t)(m0 + wid * 32 + r32) * 128 + h * 16 + hh * 8;
        int idv[8]; float gv[8];
#pragma unroll
        for (int qq = 0; qq < 8; ++qq) {
            const int F = c[0][qq] ^ ((c[0][qq] ^ c[0][8 + qq]) & hmask);
            gv[qq] = __int_as_float(__float_as_int(e[qq]) ^ ((__float_as_int(e[qq]) ^ __float_as_int(e[8 + qq])) & hmask)) * inv;
            const int idx = 255 - (F & 0xFF);
            const int k0 = KL[r32 * 33 + (idx >> 4)], k1 = KL[r32 * 33 + 16 + (idx & 15)];
            idv[qq] = (127 - (k0 & 0x7F)) * 128 + (127 - (k1 & 0x7F));
        }
        *(int4*)(p.ids + ob) = make_int4(idv[0], idv[1], idv[2], idv[3]);
        *(int4*)(p.ids + ob + 4) = make_int4(idv[4], idv[5], idv[6], idv[7]);
        *(float4*)(p.gates + ob) = make_float4(gv[0], gv[1], gv[2], gv[3]);
        *(float4*)(p.gates + ob + 4) = make_float4(gv[4], gv[5], gv[6], gv[7]);
    }
}

typedef __bf16 bf16x2_t __attribute__((ext_vector_type(2)));
__device__ __forceinline__ float dot2bf(unsigned a, unsigned b, float acc) {
    return __builtin_amdgcn_fdot2_f32_bf16(__builtin_bit_cast(bf16x2_t, a), __builtin_bit_cast(bf16x2_t, b), acc, false);
}
typedef float f32x2 __attribute__((ext_vector_type(2)));
__device__ __forceinline__ f32x2 row_dot(const u32x4 w, const f32x2 (&x)[8], f32x2 acc) {
#pragma unroll
    for (int k = 0; k < 4; ++k) {
        acc = __builtin_amdgcn_cvt_pk_f32_fp8(w[k], false) * x[2 * k] + acc;
        acc = __builtin_amdgcn_cvt_pk_f32_fp8(w[k], true) * x[2 * k + 1] + acc;
    }
    return acc;
}
__device__ __forceinline__ float peer_u_round(const unsigned char* __restrict__ u8, int idv, const f32x2 (&x)[8], int lane) {
    u32x4 ra[8], rb[8];
#pragma unroll
    for (int j = 0; j < 8; ++j) {
        ra[j] = *(const u32x4*)(u8 + (size_t)__builtin_amdgcn_readlane(idv, j * 8) * DM + lane * 16);
        rb[j] = *(const u32x4*)(u8 + (size_t)__builtin_amdgcn_readlane(idv, j * 8 + 1) * DM + lane * 16);
    }
    float h = 0.f;
    const bool up16 = (lane & 16) != 0, up8 = (lane & 8) != 0;
#pragma unroll 1
    for (int c2 = 0; c2 < 4; ++c2) {
#pragma unroll
        for (int par = 0; par < 2; ++par) {
            const int c = c2 * 2 + par;
            float s[8];
#pragma unroll
            for (int j = 0; j < 8; ++j) {
                const f32x2 a = row_dot(par ? rb[j] : ra[j], x, (f32x2){0.f, 0.f});
                s[j] = a.x + a.y;
                if (c2 < 3) {
                    const u32x4 nw = *(const u32x4*)(u8 + (size_t)__builtin_amdgcn_readlane(idv, j * 8 + c + 2) * DM + lane * 16);
                    if (par) rb[j] = nw; else ra[j] = nw;
                }
            }
#pragma unroll
            for (int j = 0; j < 4; ++j) {
                auto r = __builtin_amdgcn_permlane32_swap(__float_as_uint(s[j]), __float_as_uint(s[j + 4]), false, false);
                s[j] = __uint_as_float(r[0]) + __uint_as_float(r[1]);
            }
#pragma unroll
            for (int j = 0; j < 2; ++j) {
                const float keep = up16 ? s[j + 2] : s[j], send = up16 ? s[j] : s[j + 2];
                s[j] = keep + __shfl_xor(send, 16);
            }
            float t;
            { const float keep = up8 ? s[1] : s[0], send = up8 ? s[0] : s[1]; t = keep + __shfl_xor(send, 8); }
            t += __shfl_xor(t, 4); t += __shfl_xor(t, 2); t += __shfl_xor(t, 1);
            if ((lane & 7) == c) h = t;
        }
    }
    return h;
}
#define PEER_DV 16
__device__ __forceinline__ void peer_v_round(const unsigned char* __restrict__ v8, int idv, float actv, f32x2 (&o)[8], int lane) {
    u32x4 rb[PEER_DV];
#pragma unroll
    for (int i = 0; i < PEER_DV; ++i) rb[i] = *(const u32x4*)(v8 + (size_t)__builtin_amdgcn_readlane(idv, i) * DM + lane * 16);
#pragma unroll 1
    for (int e0 = 0; e0 < 64; e0 += PEER_DV) {
#pragma unroll
        for (int i = 0; i < PEER_DV; ++i) {
            const float a = __int_as_float(__builtin_amdgcn_readlane(__float_as_int(actv), e0 + i));
            const f32x2 a2 = {a, a};
            const u32x4 w = rb[i];
#pragma unroll
            for (int k = 0; k < 4; ++k) {
                o[2 * k] = __builtin_amdgcn_cvt_pk_f32_fp8(w[k], false) * a2 + o[2 * k];
                o[2 * k + 1] = __builtin_amdgcn_cvt_pk_f32_fp8(w[k], true) * a2 + o[2 * k + 1];
            }
            if (e0 + PEER_DV < 64) rb[i] = *(const u32x4*)(v8 + (size_t)__builtin_amdgcn_readlane(idv, e0 + PEER_DV + i) * DM + lane * 16);
        }
    }
}
__device__ __forceinline__ float gelu_gate(float h, float g) { return 0.5f * h * (1.0f + erff(h * 0.70710678118654752f)) * g; }

__device__ void ph_peer(const Params& p, const int vb) {
    const int lane = threadIdx.x & 63;
    const int wid = __builtin_amdgcn_readfirstlane(threadIdx.x >> 6);
    for (int t = vb * 4 + wid; t < T_TOK; t += gridDim.x * 4) {
        const int id0 = p.ids[(size_t)t * 128 + lane], id1 = p.ids[(size_t)t * 128 + 64 + lane];
        const float g0 = p.gates[(size_t)t * 128 + lane], g1 = p.gates[(size_t)t * 128 + 64 + lane];
        const float su0 = p.su[id0], su1 = p.su[id1], sv0 = p.sv[id0], sv1 = p.sv[id1];
        const float* xr = p.x1 + (size_t)t * DM + lane * 16;
        f32x2 x[8];
        {
            const f32x4 a = *(const f32x4*)(xr), b = *(const f32x4*)(xr + 4), c = *(const f32x4*)(xr + 8), d = *(const f32x4*)(xr + 12);
            x[0] = (f32x2){a[0], a[1]}; x[1] = (f32x2){a[2], a[3]}; x[2] = (f32x2){b[0], b[1]}; x[3] = (f32x2){b[2], b[3]};
            x[4] = (f32x2){c[0], c[1]}; x[5] = (f32x2){c[2], c[3]}; x[6] = (f32x2){d[0], d[1]}; x[7] = (f32x2){d[2], d[3]};
        }
        const float h0 = peer_u_round(p.u8, id0, x, lane) * su0;
        const float h1 = peer_u_round(p.u8, id1, x, lane) * su1;
        const float a0 = gelu_gate(h0, g0) * sv0, a1 = gelu_gate(h1, g1) * sv1;
        f32x2 o[8];
#pragma unroll
        for (int i = 0; i < 8; ++i) o[i] = (f32x2){0.f, 0.f};
        peer_v_round(p.v8, id0, a0, o, lane);
        peer_v_round(p.v8, id1, a1, o, lane);
        float r[16];
#pragma unroll
        for (int i = 0; i < 8; ++i) { r[2 * i] = ALPHA * x[i].x + o[i].x; r[2 * i + 1] = ALPHA * x[i].y + o[i].y; }
        float* rr = p.y1 + (size_t)t * DM + lane * 16;
        *(f32x4*)(rr) = (f32x4){r[0], r[1], r[2], r[3]};
        *(f32x4*)(rr + 4) = (f32x4){r[4], r[5], r[6], r[7]};
        *(f32x4*)(rr + 8) = (f32x4){r[8], r[9], r[10], r[11]};
        *(f32x4*)(rr + 12) = (f32x4){r[12], r[13], r[14], r[15]};
        bf16_t* rbp = p.rb + (size_t)t * DM + lane * 16;
        u32x4 w0, w1;
        w0[0] = pack2(r[0], r[1]); w0[1] = pack2(r[2], r[3]); w0[2] = pack2(r[4], r[5]); w0[3] = pack2(r[6], r[7]);
        w1[0] = pack2(r[8], r[9]); w1[1] = pack2(r[10], r[11]); w1[2] = pack2(r[12], r[13]); w1[3] = pack2(r[14], r[15]);
        *(u32x4*)(rbp) = w0; *(u32x4*)(rbp + 8) = w1;
    }
}

__device__ void ph_gemm_ple(const Params& p, unsigned char* smem, const int vb) {
    const int ntn = DM / 128;
    const int tid = threadIdx.x, lane = tid & 63, wid = tid >> 6, wr = wid >> 1, wc = wid & 1, fr = lane & 15, fq = lane >> 4;
    for (int t = vb; t < (T_TOK / 128) * ntn; t += gridDim.x) {
        const int m0 = (t / ntn) * 128, n0 = (t % ntn) * 128;
        f32x4 acc[4][4], acc2[4][4]; zero_acc(acc); zero_acc(acc2);
        gemm128(p.pb + (size_t)m0 * 256, 256, p.WpT + (size_t)n0 * 256, 256, 256, smem, acc2);
        gemm128(p.rb + (size_t)m0 * DM, DM, p.WgT + (size_t)n0 * DM, DM, DM, smem, acc);
#pragma unroll
        for (int mi = 0; mi < 4; ++mi) {
            const int row = m0 + wr * 64 + mi * 16 + fr;
#pragma unroll
            for (int ni = 0; ni < 4; ++ni) {
                const int col = n0 + wc * 64 + ni * 16 + fq * 4;
                float* yp = p.y1 + (size_t)row * DM + col;
                f32x4 rv = *(const f32x4*)yp;
#pragma unroll
                for (int r = 0; r < 4; ++r) rv[r] += acc2[mi][ni][r] / (1.0f + __expf(-acc[mi][ni][r]));
                *(f32x4*)yp = rv;
            }
        }
    }
}

#define XB_TMO      128
#define XB_XCNT(j)  (256  + 64 * (j))
#define XB_XSUB(j)  (1280 + 64 * (j))
#define XB_XGEN(j)  (2304 + 64 * (j))
#define XB_TOP      3328
#define XB_TOPGEN   3392
#define XCD_BAR_WORDS 3456
#define XB_SPIN_CAP (1u << 20)
__device__ __forceinline__ unsigned xb_ld(unsigned* p)              { return __hip_atomic_load(p, __ATOMIC_RELAXED, __HIP_MEMORY_SCOPE_AGENT); }
__device__ __forceinline__ unsigned xb_add(unsigned* p, unsigned v) { return __hip_atomic_fetch_add(p, v, __ATOMIC_RELAXED, __HIP_MEMORY_SCOPE_AGENT); }
__device__ __forceinline__ unsigned xb_xcc_id() { return (unsigned)__builtin_amdgcn_s_getreg((3 << 11) | 20) & 0xFu; }
#define XB_SPIN(cond, bar) do { unsigned _sp = 0; while (cond) { __builtin_amdgcn_s_sleep(1); \
    if ((++_sp & 255u) == 0u) { if (xb_ld(&(bar)[XB_TMO])) break; if (_sp > XB_SPIN_CAP) { atomicAdd(&(bar)[XB_TMO], 1u); break; } } } } while (0)
struct XcdBarrier { unsigned* bar; unsigned x; volatile LDS_AS unsigned* st; };
__device__ __forceinline__ XcdBarrier xcd_barrier_post(unsigned* bar, volatile LDS_AS unsigned* st) {
    XcdBarrier b; b.bar = bar; b.x = xb_xcc_id(); b.st = st;
    if (threadIdx.x == 0) st[3] = xb_add(&bar[XB_XCNT(b.x)], 1u);
    return b;
}
__device__ __forceinline__ void xcd_barrier_complete(unsigned* bar, unsigned x, unsigned rank, unsigned& nloc, unsigned& nx, unsigned& vb) {
    const unsigned G = gridDim.x;
    unsigned sum, cnt, mine, sp = 0u; bool even;
    for (;;) {
        sum = 0u; cnt = 0u; mine = 0u; even = true;
#pragma unroll
        for (unsigned j = 0; j < 16; ++j) {
            const unsigned c = xb_ld(&bar[XB_XCNT(j)]); sum += c; cnt += (c > 0u) ? 1u : 0u; mine = (j == x) ? c : mine;
            even = even && (c == ((j < 8u) ? (G >> 3) : 0u));
        }
        if (sum == G) break;
        __builtin_amdgcn_s_sleep(1);
        if ((++sp & 255u) == 0u) { if (xb_ld(&bar[XB_TMO])) break; if (sp > XB_SPIN_CAP) { atomicAdd(&bar[XB_TMO], 1u); break; } }
    }
    nloc = mine > 0u ? mine : 1u; nx = cnt > 0u ? cnt : 1u;
    vb = (even && sum == G && (G & 7u) == 0u) ? (x * (G >> 3) + rank) : blockIdx.x;
}
__device__ __forceinline__ void xcd_barrier(const XcdBarrier& b) {
    asm volatile("s_waitcnt vmcnt(0)" ::: "memory");
    __syncthreads();
    if (threadIdx.x == 0) {
        unsigned* bar = b.bar;
        __builtin_amdgcn_s_waitcnt(0);
        unsigned nloc = b.st[0], nx = b.st[1];
        if (nloc == 0u) { unsigned vb; xcd_barrier_complete(bar, b.x, b.st[3], nloc, nx, vb); b.st[0] = nloc; b.st[1] = nx; b.st[2] = vb; }
        const unsigned old = xb_add(&bar[XB_XSUB(b.x)], 1u);
        const unsigned gen = old / nloc;
        if (old + 1u == (gen + 1u) * nloc) {
            __builtin_amdgcn_fence(__ATOMIC_RELEASE, "agent");
            asm volatile("s_waitcnt vmcnt(0)" ::: "memory");
            const unsigned og = xb_add(&bar[XB_TOP], 1u);
            const unsigned tg = og / nx;
            if (og + 1u == (tg + 1u) * nx) xb_add(&bar[XB_TOPGEN], 1u);
            else XB_SPIN(xb_ld(&bar[XB_TOPGEN]) == tg, bar);
            __builtin_amdgcn_fence(__ATOMIC_ACQUIRE, "agent");
            xb_add(&bar[XB_XGEN(b.x)], 1u);
            asm volatile("s_waitcnt vmcnt(0)" ::: "memory");
        } else {
            XB_SPIN(xb_ld(&bar[XB_XGEN(b.x)]) == gen, bar);
            __builtin_amdgcn_fence(__ATOMIC_ACQUIRE, "agent");
            asm volatile("s_waitcnt vmcnt(0)" ::: "memory");
        }
    }
    __syncthreads();
}

#define SMEM_PHASE (256 * ASTR * 2 * 2)
#define SMEM_BYTES (SMEM_PHASE + 16)
__global__ void __launch_bounds__(256, 2) mega(Params p) {
    __shared__ __attribute__((aligned(16))) unsigned char smem[SMEM_BYTES];
    volatile LDS_AS unsigned* st = (volatile LDS_AS unsigned*)(LDS_AS unsigned char*)(smem + SMEM_PHASE);
    if (threadIdx.x < 4) st[threadIdx.x] = 0u;
    __syncthreads();
    const XcdBarrier gb = xcd_barrier_post(p.bar, st);
    ph_prep(p, smem);            xcd_barrier(gb);
    const int vb = (int)st[2];
    ph_gemm_in(p, smem, vb);     xcd_barrier(gb);
    ph_attn(p, smem, vb);
    ph_conv(p, smem, vb);        xcd_barrier(gb);
    ph_gemm_out(p, smem, vb);    xcd_barrier(gb);
    ph_ln1(p, vb);               xcd_barrier(gb);
    ph_route(p, smem, vb);       xcd_barrier(gb);
    ph_peer(p, vb);              xcd_barrier(gb);
    ph_gemm_ple(p, smem, vb);    xcd_barrier(gb);
    ph_ln2(p, vb);
}

extern "C" void kernel_launch(void* const* d_in, const int* in_sizes, int n_in, void* d_out, int out_size, void* d_ws, size_t ws_size,
                              hipStream_t stream) {
    Params p{};
    p.x = (const float*)d_in[0]; p.p = (const float*)d_in[1]; p.pos = (const int*)d_in[2];
    p.w_in = (const float*)d_in[3]; p.sinks = (const float*)d_in[4]; p.conv_w = (const float*)d_in[5]; p.conv_b = (const float*)d_in[6];
    p.cln_g = (const float*)d_in[7]; p.cln_b = (const float*)d_in[8]; p.w_out = (const float*)d_in[9]; p.ln1_g = (const float*)d_in[10];
    p.ln1_b = (const float*)d_in[11]; p.wq = (const float*)d_in[12]; p.keys = (const float*)d_in[13]; p.pu = (const float*)d_in[14];
    p.pv = (const float*)d_in[15]; p.ple_proj = (const float*)d_in[16]; p.ple_gate = (const float*)d_in[17]; p.ln2_g = (const float*)d_in[18];
    p.ln2_b = (const float*)d_in[19];
    p.out = (float*)d_out;
    unsigned char* ws = (unsigned char*)d_ws;
    const size_t MiB = 1024 * 1024;
    p.y1 = (float*)(ws + 0 * MiB);
    p.hb = (bf16_t*)(ws + 128 * MiB);
    p.qb = (bf16_t*)(ws + 128 * MiB);
    p.xb = (bf16_t*)(ws + 256 * MiB);
    p.x1b = (bf16_t*)(ws + 256 * MiB);
    p.mixb = (bf16_t*)(ws + 320 * MiB);
    p.tops = (float*)(ws + 320 * MiB);
    p.topi = (int*)(ws + 352 * MiB);
    p.rb = (bf16_t*)(ws + 320 * MiB);
    p.pb = (bf16_t*)(ws + 384 * MiB);
    p.ub = (bf16_t*)(ws + 400 * MiB);
    p.vb = (bf16_t*)(ws + 432 * MiB);
    p.u8 = (unsigned char*)(ws + 400 * MiB);
    p.v8 = (unsigned char*)(ws + 416 * MiB);
    p.su = (float*)(ws + 432 * MiB);
    p.sv = (float*)(ws + 433 * MiB);
    p.ids = (int*)(ws + 464 * MiB);
    p.gates = (float*)(ws + 480 * MiB);
    unsigned char* wb = ws + 496 * MiB;
    p.WinT = (bf16_t*)wb; wb += (size_t)INW * DM * 2;
    p.WoutT = (bf16_t*)wb; wb += (size_t)DM * DM * 2;
    p.WqT = (bf16_t*)wb; wb += (size_t)2048 * DM * 2;
    p.WgT = (bf16_t*)wb; wb += (size_t)DM * DM * 2;
    p.WpT = (bf16_t*)wb; wb += (size_t)DM * 256 * 2;
    p.keysb = (bf16_t*)wb; wb += (size_t)16 * 128 * 128 * 2;
    p.bar = (unsigned*)(ws + 510 * MiB);
    p.x1 = (float*)d_out;

    static int grid_blocks = 0;
    if (!grid_blocks) {
        int dev = 0, cus = 0, per_cu = 0;
        (void)hipGetDevice(&dev);
        (void)hipDeviceGetAttribute(&cus, hipDeviceAttributeMultiprocessorCount, dev);
        (void)hipOccupancyMaxActiveBlocksPerMultiprocessor(&per_cu, mega, 256, 0);
        if (per_cu > 2) per_cu = 2;
        grid_blocks = cus * per_cu;
    }
    (void)hipMemsetAsync(p.bar, 0, XCD_BAR_WORDS * sizeof(unsigned), stream);
    void* args[] = {&p};
    hipError_t e = hipLaunchCooperativeKernel((void*)mega, dim3(grid_blocks), dim3(256), args, 0, stream);
    if (e != hipSuccess) fprintf(stderr, "cooperative launch failed: %s (grid %d)\n", hipGetErrorString(e), grid_blocks);
}
```

```cpp
#include <hip/hip_runtime.h>
#include <hip/hip_cooperative_groups.h>
#include <stdint.h>
#include <cstdio>
namespace cg = cooperative_groups;

typedef unsigned short bf16_t;
typedef short bf16x8 __attribute__((ext_vector_type(8)));
typedef float f32x4 __attribute__((ext_vector_type(4)));
typedef unsigned u32x4 __attribute__((ext_vector_type(4)));

#define T_TOK 32768
#define SEQ 2048
#define DM 1024
#define INW 1792
#define ALPHA 1.189207115002721f
#define LN_EPS 1e-5f

__device__ __forceinline__ bf16_t f2bf(float f) {
    unsigned u = __float_as_uint(f);
    u += 0x7fffu + ((u >> 16) & 1u);
    return (bf16_t)(u >> 16);
}
__device__ __forceinline__ float bf2f(bf16_t b) { return __uint_as_float(((unsigned)b) << 16); }
__device__ __forceinline__ float bflo(unsigned w) { return __uint_as_float(w << 16); }
__device__ __forceinline__ float bfhi(unsigned w) { return __uint_as_float(w & 0xffff0000u); }
__device__ __forceinline__ unsigned pack2(float a, float b) { return (unsigned)f2bf(a) | ((unsigned)f2bf(b) << 16); }

__device__ __forceinline__ float wave_sum(float v) {
#pragma unroll
    for (int o = 32; o >= 1; o >>= 1) v += __shfl_xor(v, o);
    return v;
}

struct Params {
    const float *x, *p; const int* pos;
    const float *w_in, *sinks, *conv_w, *conv_b, *cln_g, *cln_b, *w_out, *ln1_g, *ln1_b;
    const float *wq, *keys, *pu, *pv, *ple_proj, *ple_gate, *ln2_g, *ln2_b;
    float* out;
    bf16_t *xb, *pb, *WinT, *WoutT, *WqT, *WgT, *WpT, *keysb, *ub, *vb, *hb, *mixb, *x1b, *qb, *rb;
    float *y1, *x1, *tops, *gates, *su, *sv, *hp;
    int *topi, *ids;
    unsigned char *u8, *v8;
    unsigned* bar;
};

__device__ void cvt_rows(const float* __restrict__ src, bf16_t* __restrict__ dst, size_t n) {
    size_t nv = n / 8;
    for (size_t i = (size_t)blockIdx.x * blockDim.x + threadIdx.x; i < nv; i += (size_t)gridDim.x * blockDim.x) {
        const float4 a = ((const float4*)src)[2 * i], b = ((const float4*)src)[2 * i + 1];
        uint4 o; o.x = pack2(a.x, a.y); o.y = pack2(a.z, a.w); o.z = pack2(b.x, b.y); o.w = pack2(b.z, b.w);
        ((uint4*)dst)[i] = o;
    }
}
__device__ void transpose_cvt(const float* __restrict__ W, bf16_t* __restrict__ Wt, int K, int N, float* tile  ) {
    const int tk = K / 32, tn = N / 32;
    const int tx = threadIdx.x & 31, ty = threadIdx.x >> 5;
    for (int t = blockIdx.x; t < tk * tn; t += gridDim.x) {
        const int k0 = (t / tn) * 32, n0 = (t % tn) * 32;
        __syncthreads();
#pragma unroll
        for (int i = 0; i < 4; ++i) tile[(ty + i * 8) * 33 + tx] = W[(size_t)(k0 + ty + i * 8) * N + n0 + tx];
        __syncthreads();
#pragma unroll
        for (int i = 0; i < 4; ++i) Wt[(size_t)(n0 + ty + i * 8) * K + k0 + tx] = f2bf(tile[tx * 33 + ty + i * 8]);
    }
}

__device__ void cvt_table_fp8(const float* __restrict__ src, unsigned char* __restrict__ dst, float* __restrict__ scl, int rows) {
    const int lane = threadIdx.x & 63, wid = threadIdx.x >> 6;
    for (int r = blockIdx.x * 4 + wid; r < rows; r += gridDim.x * 4) {
        const float* sr = src + (size_t)r * DM + lane * 16;
        const f32x4 a = *(const f32x4*)(sr), b = *(const f32x4*)(sr + 4), c = *(const f32x4*)(sr + 8), d = *(const f32x4*)(sr + 12);
        float m = 0.f;
#pragma unroll
        for (int i = 0; i < 4; ++i) m = fmaxf(m, fmaxf(fmaxf(fabsf(a[i]), fabsf(b[i])), fmaxf(fabsf(c[i]), fabsf(d[i]))));
#pragma unroll
        for (int o = 32; o >= 1; o >>= 1) m = fmaxf(m, __shfl_xor(m, o));
        const float q = (m > 0.f) ? 448.0f / m : 1.0f;
        u32x4 w;
        w[0] = __builtin_amdgcn_cvt_pk_fp8_f32(a[2] * q, a[3] * q, __builtin_amdgcn_cvt_pk_fp8_f32(a[0] * q, a[1] * q, 0, false), true);
        w[1] = __builtin_amdgcn_cvt_pk_fp8_f32(b[2] * q, b[3] * q, __builtin_amdgcn_cvt_pk_fp8_f32(b[0] * q, b[1] * q, 0, false), true);
        w[2] = __builtin_amdgcn_cvt_pk_fp8_f32(c[2] * q, c[3] * q, __builtin_amdgcn_cvt_pk_fp8_f32(c[0] * q, c[1] * q, 0, false), true);
        w[3] = __builtin_amdgcn_cvt_pk_fp8_f32(d[2] * q, d[3] * q, __builtin_amdgcn_cvt_pk_fp8_f32(d[0] * q, d[1] * q, 0, false), true);
        *(u32x4*)(dst + (size_t)(lane >> 3) * (16384 * 128) + (size_t)r * 128 + (lane & 7) * 16) = w;
        if (lane == 0) scl[r] = (m > 0.f) ? m * (1.0f / 448.0f) : 1.0f;
    }
}
__device__ void ph_prep(const Params& p, unsigned char* smem) {
    float* tile = (float*)smem;
    cvt_rows(p.x, p.xb, (size_t)T_TOK * DM);
    cvt_rows(p.p, p.pb, (size_t)T_TOK * 256);
    cvt_table_fp8(p.pu, p.u8, p.su, 16384);
    cvt_table_fp8(p.pv, p.v8, p.sv, 16384);
    cvt_rows(p.keys, p.keysb, (size_t)16 * 128 * 128);
    transpose_cvt(p.w_in, p.WinT, DM, INW, tile);
    transpose_cvt(p.w_out, p.WoutT, DM, DM, tile);
    transpose_cvt(p.wq, p.WqT, DM, 2048, tile);
    transpose_cvt(p.ple_gate, p.WgT, DM, DM, tile);
    transpose_cvt(p.ple_proj, p.WpT, 256, DM, tile);
}

#define LDS_AS __attribute__((address_space(3)))
#define GEMM_STAGE 32768
__device__ __forceinline__ void gemm128(const bf16_t* __restrict__ A, int lda, const bf16_t* __restrict__ Bt, int ldb, int K,
                                        unsigned char* smem, f32x4 (&acc)[4][4]) {
    LDS_AS unsigned char* lds = (LDS_AS unsigned char*)smem;
    const int tid = threadIdx.x, lane = tid & 63, wid = __builtin_amdgcn_readfirstlane(tid >> 6);
    const int wr = wid >> 1, wc = wid & 1, fr = lane & 15, fq = lane >> 4;
    const int nk = K / 64;
    const int prow = lane >> 3, pc = (lane & 7) ^ prow;
    const bf16_t* gA = A + (size_t)(wid * 32 + prow) * lda + pc * 8;
    const bf16_t* gB = Bt + (size_t)(wid * 32 + prow) * ldb + pc * 8;
    const size_t a8 = (size_t)8 * lda, b8 = (size_t)8 * ldb;
#define GEMM_ISSUE(kt, st) do { \
        _Pragma("unroll") for (int _i = 0; _i < 4; ++_i) { \
            __builtin_amdgcn_global_load_lds((const unsigned*)(gA + _i * a8 + (size_t)(kt) * 64), (LDS_AS unsigned*)(lds + (st) * GEMM_STAGE + (wid * 4 + _i) * 1024), 16, 0, 0); \
            __builtin_amdgcn_global_load_lds((const unsigned*)(gB + _i * b8 + (size_t)(kt) * 64), (LDS_AS unsigned*)(lds + (st) * GEMM_STAGE + 16384 + (wid * 4 + _i) * 1024), 16, 0, 0); \
        } } while (0)
    const int swz0 = ((0 * 4 + fq) ^ (fr & 7)) * 16, swz1 = ((1 * 4 + fq) ^ (fr & 7)) * 16;
    const int aoff = (wr * 64 + fr) * 128, boff = 16384 + (wc * 64 + fr) * 128;
    GEMM_ISSUE(0, 0);
#pragma unroll 1
    for (int kt = 0; kt < nk; ++kt) {
        const int st = kt & 1;
        if (kt + 1 < nk) { GEMM_ISSUE(kt + 1, st ^ 1); asm volatile("s_waitcnt vmcnt(8)" ::: "memory"); }
        else { asm volatile("s_waitcnt vmcnt(0)" ::: "memory"); }
        __builtin_amdgcn_s_barrier();
        asm volatile("" ::: "memory");
        const LDS_AS unsigned char* sb = lds + st * GEMM_STAGE;
#pragma unroll
        for (int kk = 0; kk < 2; ++kk) {
            const int swz = kk ? swz1 : swz0;
            bf16x8 af[4], bfr[4];
#pragma unroll
            for (int mi = 0; mi < 4; ++mi) af[mi] = *(const LDS_AS bf16x8*)(sb + aoff + mi * 2048 + swz);
#pragma unroll
            for (int ni = 0; ni < 4; ++ni) bfr[ni] = *(const LDS_AS bf16x8*)(sb + boff + ni * 2048 + swz);
#pragma unroll
            for (int mi = 0; mi < 4; ++mi)
#pragma unroll
                for (int ni = 0; ni < 4; ++ni)
                    acc[mi][ni] = __builtin_amdgcn_mfma_f32_16x16x32_bf16(bfr[ni], af[mi], acc[mi][ni], 0, 0, 0);
        }
        asm volatile("s_waitcnt lgkmcnt(0)" ::: "memory");
        __builtin_amdgcn_s_barrier();
        asm volatile("" ::: "memory");
    }
#undef GEMM_ISSUE
}
__device__ __forceinline__ void zero_acc(f32x4 (&acc)[4][4]) {
#pragma unroll
    for (int a = 0; a < 4; ++a)
#pragma unroll
        for (int b = 0; b < 4; ++b) acc[a][b] = (f32x4){0.f, 0.f, 0.f, 0.f};
}
#define GEMM_SMEM (2 * GEMM_STAGE)

__device__ void ph_gemm_in(const Params& p, unsigned char* smem, const int vb) {
    const int ntn = INW / 128;
    const int tid = threadIdx.x, lane = tid & 63, wid = tid >> 6, wr = wid >> 1, wc = wid & 1, fr = lane & 15, fq = lane >> 4;
    for (int t = vb; t < (T_TOK / 128) * ntn; t += gridDim.x) {
        const int m0 = (t / ntn) * 128, n0 = (t % ntn) * 128;
        f32x4 acc[4][4]; zero_acc(acc);
        gemm128(p.xb + (size_t)m0 * DM, DM, p.WinT + (size_t)n0 * DM, DM, DM, smem, acc);
#pragma unroll
        for (int mi = 0; mi < 4; ++mi) {
            const int row = m0 + wr * 64 + mi * 16 + fr;
            const float posf = (float)p.pos[row];
#pragma unroll
            for (int ni = 0; ni < 4; ++ni) {
                const int col0 = n0 + wc * 64 + ni * 16;
                f32x4 v = acc[mi][ni];
                if (col0 < 640 && (col0 & 63) == 0) {
#pragma unroll
                    for (int r = 0; r < 4; ++r) {
                        const float other = __shfl_xor(v[r], 32);
                        const int j = (fq & 1) * 4 + r;
                        const float inv = powf(500000.0f, -(float)j * 0.125f);
                        float sn, cs; sincosf(posf * inv, &sn, &cs);
                        v[r] = (fq < 2) ? (v[r] * cs - other * sn) : (v[r] * cs + other * sn);
                    }
                }
                uint2 o; o.x = pack2(v[0], v[1]); o.y = pack2(v[2], v[3]);
                *(uint2*)(p.hb + (size_t)row * INW + col0 + fq * 4) = o;
            }
        }
    }
}

#define ASTR 72
#define VSTR 260
typedef float f32x16 __attribute__((ext_vector_type(16)));
typedef unsigned u32x2 __attribute__((ext_vector_type(2)));
__device__ void ph_attn(const Params& p, unsigned char* smem, const int vb) {
    bf16_t* sK = (bf16_t*)smem;
    bf16_t* sVt = sK + 256 * ASTR;
    const int tid = threadIdx.x, lane = tid & 63, wid = tid >> 6, r32 = lane & 31, hh = lane >> 5;
    const float C1 = 0.125f * 1.4426950408889634f, LOG2E = 1.4426950408889634f;
    for (int u = vb; u < 16 * 16 * 2; u += gridDim.x) {
        const int kvh = u & 1, nb = (u >> 1) & 15, b = u >> 5;
        __syncthreads();
        for (int c = tid; c < 256 * 8; c += 256) {
            const int li = c >> 3, kc = c & 7;
            const int pos = nb * 128 - 128 + li;
            u32x4 kv = {0u, 0u, 0u, 0u}, vv = {0u, 0u, 0u, 0u};
            if (pos >= 0) {
                const bf16_t* base = p.hb + (size_t)(b * SEQ + pos) * INW;
                kv = *(const u32x4*)(base + 512 + kvh * 64 + kc * 8);
                vv = *(const u32x4*)(base + 640 + kvh * 64 + kc * 8);
            }
            *(u32x4*)(sK + li * ASTR + kc * 8) = kv;
#pragma unroll
            for (int i = 0; i < 4; ++i) {
                sVt[(kc * 8 + 2 * i) * VSTR + li] = (bf16_t)(vv[i] & 0xffffu);
                sVt[(kc * 8 + 2 * i + 1) * VSTR + li] = (bf16_t)(vv[i] >> 16);
            }
        }
        __syncthreads();
        const int hq = kvh * 4 + wid;
        const float sink2 = p.sinks[hq] * LOG2E;
#pragma unroll 1
        for (int qt = 0; qt < 4; ++qt) {
            const size_t trow = (size_t)(b * SEQ + nb * 128 + qt * 32 + r32);
            bf16x8 qf[4];
#pragma unroll
            for (int ks = 0; ks < 4; ++ks) qf[ks] = *(const bf16x8*)(p.hb + trow * INW + hq * 64 + ks * 16 + hh * 8);
            f32x16 S[5];
#pragma unroll
            for (int j = 0; j < 5; ++j) {
#pragma unroll
                for (int r = 0; r < 16; ++r) S[j][r] = 0.f;
#pragma unroll
                for (int ks = 0; ks < 4; ++ks) {
                    const bf16x8 a = *(const bf16x8*)(sK + ((qt + j) * 32 + r32) * ASTR + ks * 16 + hh * 8);
                    S[j] = __builtin_amdgcn_mfma_f32_32x32x16_bf16(a, qf[ks], S[j], 0, 0, 0);
                }
            }
            float m2 = sink2;
#pragma unroll
            for (int j = 0; j < 5; ++j) {
                const bool tile_ok = (nb > 0) || (qt + j >= 4);
#pragma unroll
                for (int r = 0; r < 16; ++r) {
                    const int kl = (r & 3) + 8 * (r >> 2) + 4 * hh;
                    bool ok = tile_ok;
                    if (j == 0) ok = ok && (kl > r32);
                    if (j == 4) ok = ok && (kl <= r32);
                    const float t = ok ? S[j][r] * C1 : -1.0e30f;
                    S[j][r] = t;
                    m2 = fmaxf(m2, t);
                }
            }
            m2 = fmaxf(m2, __shfl_xor(m2, 32));
            float l = 0.f;
#pragma unroll
            for (int j = 0; j < 5; ++j)
#pragma unroll
                for (int r = 0; r < 16; ++r) { const float e = __builtin_amdgcn_exp2f(S[j][r] - m2); S[j][r] = e; l += e; }
            l += __shfl_xor(l, 32);
            l += __builtin_amdgcn_exp2f(sink2 - m2);
            f32x16 O[2];
#pragma unroll
            for (int dt = 0; dt < 2; ++dt)
#pragma unroll
                for (int r = 0; r < 16; ++r) O[dt][r] = 0.f;
#pragma unroll
            for (int j = 0; j < 5; ++j)
#pragma unroll
                for (int s2 = 0; s2 < 2; ++s2) {
                    u32x4 pw;
#pragma unroll
                    for (int k = 0; k < 4; ++k) pw[k] = pack2(S[j][8 * s2 + 2 * k], S[j][8 * s2 + 2 * k + 1]);
                    const bf16x8 pf = __builtin_bit_cast(bf16x8, pw);
                    const int kbase = (qt + j) * 32 + 16 * s2 + 4 * hh;
#pragma unroll
                    for (int dt = 0; dt < 2; ++dt) {
                        const bf16_t* vp = sVt + (dt * 32 + r32) * VSTR + kbase;
                        const u32x2 v0 = *(const u32x2*)(vp), v1 = *(const u32x2*)(vp + 8);
                        const u32x4 vw = {v0[0], v0[1], v1[0], v1[1]};
                        O[dt] = __builtin_amdgcn_mfma_f32_32x32x16_bf16(__builtin_bit_cast(bf16x8, vw), pf, O[dt], 0, 0, 0);
                    }
                }
            const float il = 1.0f / l;
#pragma unroll
            for (int dt = 0; dt < 2; ++dt)
#pragma unroll
                for (int g = 0; g < 4; ++g) {
                    u32x2 w;
                    w[0] = pack2(O[dt][4 * g] * il, O[dt][4 * g + 1] * il);
                    w[1] = pack2(O[dt][4 * g + 2] * il, O[dt][4 * g + 3] * il);
                    *(u32x2*)(p.mixb + trow * DM + hq * 64 + dt * 32 + 8 * g + 4 * hh) = w;
                }
        }
    }
}

__device__ void ph_conv(const Params& p, unsigned char* smem, const int vb) {
    float* cv = (float*)smem;
    const int tid = threadIdx.x, lane = tid & 63, wid = tid >> 6;
    for (int u = vb; u < T_TOK / 32; u += gridDim.x) {
        const int tok0 = u * 32;
        const int s0 = tok0 & (SEQ - 1);
        __syncthreads();
        for (int half = 0; half < 2; ++half) {
            const int c = tid + half * 256;
            float glu[62];
#pragma unroll
            for (int i = 0; i < 62; ++i) {
                const int s = s0 - 30 + i;
                float g = 0.f;
                if (s >= 0) {
                    const bf16_t* base = p.hb + (size_t)(tok0 - 30 + i) * INW;
                    const float a = bf2f(base[768 + c]), gt = bf2f(base[1280 + c]);
                    g = a / (1.0f + __expf(-gt));
                }
                glu[i] = g;
            }
            float w[31];
#pragma unroll
            for (int k = 0; k < 31; ++k) w[k] = p.conv_w[k * 512 + c];
            const float bias = p.conv_b[c];
#pragma unroll
            for (int j = 0; j < 32; ++j) {
                float a = bias;
#pragma unroll
                for (int k = 0; k < 31; ++k) a += w[k] * glu[j + k];
                cv[j * 512 + c] = a;
            }
        }
        __syncthreads();
        for (int jj = 0; jj < 8; ++jj) {
            const int j = wid * 8 + jj;
            float v[8]; float s = 0.f;
#pragma unroll
            for (int i = 0; i < 8; ++i) { v[i] = cv[j * 512 + lane + 64 * i]; s += v[i]; }
            const float mu = wave_sum(s) * (1.0f / 512.0f);
            float q = 0.f;
#pragma unroll
            for (int i = 0; i < 8; ++i) { const float d = v[i] - mu; q += d * d; }
            const float rstd = rsqrtf(wave_sum(q) * (1.0f / 512.0f) + LN_EPS);
#pragma unroll
            for (int i = 0; i < 8; ++i) {
                const int c = lane + 64 * i;
                const float y = (v[i] - mu) * rstd * p.cln_g[c] + p.cln_b[c];
                const float sl = y / (1.0f + __expf(-y));
                p.mixb[(size_t)(tok0 + j) * DM + 512 + c] = f2bf(sl);
            }
        }
    }
}

__device__ void ph_gemm_out(const Params& p, unsigned char* smem, const int vb) {
    const int ntn = DM / 128;
    const int tid = threadIdx.x, lane = tid & 63, wid = tid >> 6, wr = wid >> 1, wc = wid & 1, fr = lane & 15, fq = lane >> 4;
    for (int t = vb; t < (T_TOK / 128) * ntn; t += gridDim.x) {
        const int m0 = (t / ntn) * 128, n0 = (t % ntn) * 128;
        f32x4 acc[4][4]; zero_acc(acc);
        gemm128(p.mixb + (size_t)m0 * DM, DM, p.WoutT + (size_t)n0 * DM, DM, DM, smem, acc);
#pragma unroll
        for (int mi = 0; mi < 4; ++mi) {
            const int row = m0 + wr * 64 + mi * 16 + fr;
#pragma unroll
            for (int ni = 0; ni < 4; ++ni) {
                const int col = n0 + wc * 64 + ni * 16 + fq * 4;
                const f32x4 xv = *(const f32x4*)(p.x + (size_t)row * DM + col);
                *(f32x4*)(p.y1 + (size_t)row * DM + col) = xv * ALPHA + acc[mi][ni];
            }
        }
    }
}

__device__ __forceinline__ void ln_row(const float* __restrict__ src, const float* __restrict__ g, const float* __restrict__ bta,
                                       float* __restrict__ dstf, bf16_t* __restrict__ dstb, int lane) {
    f32x4 v[4]; float s = 0.f;
#pragma unroll
    for (int i = 0; i < 4; ++i) { v[i] = *(const f32x4*)(src + i * 256 + lane * 4); s += (v[i][0] + v[i][1]) + (v[i][2] + v[i][3]); }
    const float mu = wave_sum(s) * (1.0f / 1024.0f);
    float q = 0.f;
#pragma unroll
    for (int i = 0; i < 4; ++i) { const f32x4 d = v[i] - mu; q += (d[0] * d[0] + d[1] * d[1]) + (d[2] * d[2] + d[3] * d[3]); }
    const float rstd = rsqrtf(wave_sum(q) * (1.0f / 1024.0f) + LN_EPS);
#pragma unroll
    for (int i = 0; i < 4; ++i) {
        const f32x4 gg = *(const f32x4*)(g + i * 256 + lane * 4), bb = *(const f32x4*)(bta + i * 256 + lane * 4);
        const f32x4 y = (v[i] - mu) * rstd * gg + bb;
        *(f32x4*)(dstf + i * 256 + lane * 4) = y;
        if (dstb) { uint2 o; o.x = pack2(y[0], y[1]); o.y = pack2(y[2], y[3]); *(uint2*)(dstb + i * 256 + lane * 4) = o; }
    }
}
__device__ void ph_ln1(const Params& p, const int vb) {
    const int lane = threadIdx.x & 63, wid = threadIdx.x >> 6;
    for (int r = vb * 4 + wid; r < T_TOK; r += gridDim.x * 4)
        ln_row(p.y1 + (size_t)r * DM, p.ln1_g, p.ln1_b, p.x1 + (size_t)r * DM, p.x1b + (size_t)r * DM, lane);
}
__device__ void ph_ln2(const Params& p, const int vb) {
    const int lane = threadIdx.x & 63, wid = threadIdx.x >> 6;
    for (int r = vb * 4 + wid; r < T_TOK; r += gridDim.x * 4)
        ln_row(p.y1 + (size_t)r * DM, p.ln2_g, p.ln2_b, p.out + (size_t)r * DM, (bf16_t*)nullptr, lane);
}

#define QSTR 136
__device__ __forceinline__ int f2key(float f) { const int b = __float_as_int(f); return b ^ ((b >> 31) & 0x7fffffff); }
__device__ __forceinline__ float key2f(int k) { return __int_as_float(k ^ ((k >> 31) & 0x7fffffff)); }
__device__ __forceinline__ void sort16_desc(int (&a)[16]) {
#pragma unroll
    for (int lk = 1; lk <= 4; ++lk) {
#pragma unroll
        for (int lj = lk - 1; lj >= 0; --lj) {
            const int k = 1 << lk, j = 1 << lj;
#pragma unroll
            for (int i = 0; i < 16; ++i) {
                const int l = i ^ j;
                if (l > i) {
                    const int hi = max(a[i], a[l]), lo = min(a[i], a[l]);
                    if ((i & k) == 0) { a[i] = hi; a[l] = lo; } else { a[i] = lo; a[l] = hi; }
                }
            }
        }
    }
}
__device__ __forceinline__ void merge_top16(int (&a)[16], const int (&b)[16]) {
#pragma unroll
    for (int i = 0; i < 16; ++i) a[i] = max(a[i], b[15 - i]);
#pragma unroll
    for (int lj = 3; lj >= 0; --lj) {
        const int j = 1 << lj;
#pragma unroll
        for (int i = 0; i < 16; ++i) {
            const int l = i ^ j;
            if (l > i) { const int hi = max(a[i], a[l]), lo = min(a[i], a[l]); a[i] = hi; a[l] = lo; }
        }
    }
}
__device__ __forceinline__ void top16_of_64(int (&v)[4][16]) {
    sort16_desc(v[0]); sort16_desc(v[1]); sort16_desc(v[2]); sort16_desc(v[3]);
    merge_top16(v[0], v[1]); merge_top16(v[0], v[2]); merge_top16(v[0], v[3]);
}

__device__ __forceinline__ void route_half(const Params& p, unsigned char* smem, int m0, int hp, int (&K)[16]) {
    bf16_t* Qs = (bf16_t*)smem;
    bf16_t* Ks = (bf16_t*)(smem + 128 * QSTR * 2);
    const int tid = threadIdx.x, lane = tid & 63, wid = tid >> 6, wr = wid >> 1, wc = wid & 1, fr = lane & 15, fq = lane >> 4;
    const int r32 = lane & 31, hh = lane >> 5;
    {
        f32x4 acc[4][4]; zero_acc(acc);
        gemm128(p.x1b + (size_t)m0 * DM, DM, p.WqT + (size_t)hp * 128 * DM, DM, DM, smem, acc);
#pragma unroll
        for (int mi = 0; mi < 4; ++mi)
#pragma unroll
            for (int ni = 0; ni < 4; ++ni) {
                uint2 o; o.x = pack2(acc[mi][ni][0], acc[mi][ni][1]); o.y = pack2(acc[mi][ni][2], acc[mi][ni][3]);
                *(uint2*)(Qs + (wr * 64 + mi * 16 + fr) * QSTR + wc * 64 + ni * 16 + fq * 4) = o;
            }
    }
    {
        const bf16_t* kg = p.keysb + (size_t)hp * 128 * 128;
#pragma unroll
        for (int i = 0; i < 8; ++i) {
            const int c = tid + i * 256, row = c >> 4, kc = c & 15;
            *(u32x4*)(Ks + row * QSTR + kc * 8) = *(const u32x4*)(kg + row * 128 + kc * 8);
        }
    }
    __syncthreads();
    f32x16 S[4];
#pragma unroll
    for (int mt = 0; mt < 4; ++mt)
#pragma unroll
        for (int r = 0; r < 16; ++r) S[mt][r] = 0.f;
#pragma unroll
    for (int kk = 0; kk < 8; ++kk) {
        const bf16x8 b = *(const bf16x8*)(Qs + (wid * 32 + r32) * QSTR + kk * 16 + hh * 8);
#pragma unroll
        for (int mt = 0; mt < 4; ++mt) {
            const bf16x8 a = *(const bf16x8*)(Ks + (mt * 32 + r32) * QSTR + kk * 16 + hh * 8);
            S[mt] = __builtin_amdgcn_mfma_f32_32x32x16_bf16(a, b, S[mt], 0, 0, 0);
        }
    }
    __syncthreads();
    int v[4][16];
#pragma unroll
    for (int mt = 0; mt < 4; ++mt)
#pragma unroll
        for (int r = 0; r < 16; ++r) {
            const int n = mt * 32 + (r & 3) + 8 * (r >> 2) + 4 * hh;
            v[mt][r] = (f2key(S[mt][r]) & ~0x7F) | (127 - n);
        }
    top16_of_64(v);
    int o[16];
#pragma unroll
    for (int i = 0; i < 16; ++i) o[i] = __shfl_xor(v[0][i], 32);
    merge_top16(v[0], o);
#pragma unroll
    for (int i = 0; i < 16; ++i) K[i] = v[0][i];
}

__device__ void ph_route(const Params& p, unsigned char* smem, const int vb) {
    const int tid = threadIdx.x, lane = tid & 63, wid = tid >> 6;
    const int r32 = lane & 31, hh = lane >> 5;
    const int hmask = -hh;
    int* KL = (int*)(smem + (size_t)wid * 32 * QSTR * 2);
    for (int u = vb; u < (T_TOK / 128) * 8; u += gridDim.x) {
        const int m0 = (u >> 3) * 128, h = u & 7;
        __syncthreads();
        int K0[16], K1[16];
        route_half(p, smem, m0, h * 2 + 0, K0);
        route_half(p, smem, m0, h * 2 + 1, K1);
#pragma unroll
        for (int i = 0; i < 16; ++i) KL[r32 * 33 + hh * 16 + i] = K0[i] ^ ((K0[i] ^ K1[i]) & hmask);
        float s1[16], s2[16];
#pragma unroll
        for (int i = 0; i < 16; ++i) { s1[i] = key2f(K0[i] & ~0x7F); s2[i] = key2f(K1[i] & ~0x7F); }
        int c[4][16];
#pragma unroll
        for (int i = 0; i < 16; ++i)
#pragma unroll
            for (int j = 0; j < 16; ++j)
                if ((i + 1) * (j + 1) <= 16) {
                    constexpr int OFFS[16] = {0, 16, 24, 29, 33, 36, 38, 40, 42, 43, 44, 45, 46, 47, 48, 49};
                    const int q = OFFS[i] + j;
                    c[q >> 4][q & 15] = (f2key(s1[i] + s2[j]) & ~0xFF) | (255 - (i * 16 + j));
                }
#pragma unroll
        for (int qq = 50; qq < 64; ++qq) c[qq >> 4][qq & 15] = (int)0x80000000;
        top16_of_64(c);
        const float mx = key2f(c[0][0] & ~0xFF);
        float e[16]; float den = 0.f;
#pragma unroll
        for (int i = 0; i < 16; ++i) { e[i] = __expf(key2f(c[0][i] & ~0xFF) - mx); den += e[i]; }
        const float inv = 1.0f / den;
        const size_t ob = (size_t)(m0 + wid * 32 + r32) * 128 + h * 16 + hh * 8;
        int idv[8]; float gv[8];
#pragma unroll
        for (int qq = 0; qq < 8; ++qq) {
            const int F = c[0][qq] ^ ((c[0][qq] ^ c[0][8 + qq]) & hmask);
            gv[qq] = __int_as_float(__float_as_int(e[qq]) ^ ((__float_as_int(e[qq]) ^ __float_as_int(e[8 + qq])) & hmask)) * inv;
            const int idx = 255 - (F & 0xFF);
            const int k0 = KL[r32 * 33 + (idx >> 4)], k1 = KL[r32 * 33 + 16 + (idx & 15)];
            idv[qq] = (127 - (k0 & 0x7F)) * 128 + (127 - (k1 & 0x7F));
        }
        *(int4*)(p.ids + ob) = make_int4(idv[0], idv[1], idv[2], idv[3]);
        *(int4*)(p.ids + ob + 4) = make_int4(idv[4], idv[5], idv[6], idv[7]);
        *(float4*)(p.gates + ob) = make_float4(gv[0], gv[1], gv[2], gv[3]);
        *(float4*)(p.gates + ob + 4) = make_float4(gv[4], gv[5], gv[6], gv[7]);
    }
}

typedef __bf16 bf16x2_t __attribute__((ext_vector_type(2)));
__device__ __forceinline__ float dot2bf(unsigned a, unsigned b, float acc) {
    return __builtin_amdgcn_fdot2_f32_bf16(__builtin_bit_cast(bf16x2_t, a), __builtin_bit_cast(bf16x2_t, b), acc, false);
}
typedef float f32x2 __attribute__((ext_vector_type(2)));
__device__ __forceinline__ f32x2 row_dot(const u32x4 w, const f32x2 (&x)[8], f32x2 acc) {
#pragma unroll
    for (int k = 0; k < 4; ++k) {
        acc = __builtin_amdgcn_cvt_pk_f32_fp8(w[k], false) * x[2 * k] + acc;
        acc = __builtin_amdgcn_cvt_pk_f32_fp8(w[k], true) * x[2 * k + 1] + acc;
    }
    return acc;
}
__device__ __forceinline__ float peer_u_round(const unsigned char* __restrict__ u8, int idv, const f32x2 (&x)[8], int lane) {
    u32x4 ra[8], rb[8];
#pragma unroll
    for (int j = 0; j < 8; ++j) {
        ra[j] = *(const u32x4*)(u8 + (size_t)__builtin_amdgcn_readlane(idv, j * 8) * DM + lane * 16);
        rb[j] = *(const u32x4*)(u8 + (size_t)__builtin_amdgcn_readlane(idv, j * 8 + 1) * DM + lane * 16);
    }
    float h = 0.f;
    const bool up16 = (lane & 16) != 0, up8 = (lane & 8) != 0;
#pragma unroll 1
    for (int c2 = 0; c2 < 4; ++c2) {
#pragma unroll
        for (int par = 0; par < 2; ++par) {
            const int c = c2 * 2 + par;
            float s[8];
#pragma unroll
            for (int j = 0; j < 8; ++j) {
                const f32x2 a = row_dot(par ? rb[j] : ra[j], x, (f32x2){0.f, 0.f});
                s[j] = a.x + a.y;
                if (c2 < 3) {
                    const u32x4 nw = *(const u32x4*)(u8 + (size_t)__builtin_amdgcn_readlane(idv, j * 8 + c + 2) * DM + lane * 16);
                    if (par) rb[j] = nw; else ra[j] = nw;
                }
            }
#pragma unroll
            for (int j = 0; j < 4; ++j) {
                auto r = __builtin_amdgcn_permlane32_swap(__float_as_uint(s[j]), __float_as_uint(s[j + 4]), false, false);
                s[j] = __uint_as_float(r[0]) + __uint_as_float(r[1]);
            }
#pragma unroll
            for (int j = 0; j < 2; ++j) {
                const float keep = up16 ? s[j + 2] : s[j], send = up16 ? s[j] : s[j + 2];
                s[j] = keep + __shfl_xor(send, 16);
            }
            float t;
            { const float keep = up8 ? s[1] : s[0], send = up8 ? s[0] : s[1]; t = keep + __shfl_xor(send, 8); }
            t += __shfl_xor(t, 4); t += __shfl_xor(t, 2); t += __shfl_xor(t, 1);
            if ((lane & 7) == c) h = t;
        }
    }
    return h;
}
#define PEER_DV 16
__device__ __forceinline__ void peer_v_round(const unsigned char* __restrict__ v8, int idv, float actv, f32x2 (&o)[8], int lane) {
    u32x4 rb[PEER_DV];
#pragma unroll
    for (int i = 0; i < PEER_DV; ++i) rb[i] = *(const u32x4*)(v8 + (size_t)__builtin_amdgcn_readlane(idv, i) * DM + lane * 16);
#pragma unroll 1
    for (int e0 = 0; e0 < 64; e0 += PEER_DV) {
#pragma unroll
        for (int i = 0; i < PEER_DV; ++i) {
            const float a = __int_as_float(__builtin_amdgcn_readlane(__float_as_int(actv), e0 + i));
            const f32x2 a2 = {a, a};
            const u32x4 w = rb[i];
#pragma unroll
            for (int k = 0; k < 4; ++k) {
                o[2 * k] = __builtin_amdgcn_cvt_pk_f32_fp8(w[k], false) * a2 + o[2 * k];
                o[2 * k + 1] = __builtin_amdgcn_cvt_pk_f32_fp8(w[k], true) * a2 + o[2 * k + 1];
            }
            if (e0 + PEER_DV < 64) rb[i] = *(const u32x4*)(v8 + (size_t)__builtin_amdgcn_readlane(idv, e0 + PEER_DV + i) * DM + lane * 16);
        }
    }
}
__device__ __forceinline__ float gelu_gate(float h, float g) { return 0.5f * h * (1.0f + erff(h * 0.70710678118654752f)) * g; }

__device__ void ph_peer(const Params& p, const int vb) {
    const int lane = threadIdx.x & 63;
    const int wid = __builtin_amdgcn_readfirstlane(threadIdx.x >> 6);
    for (int t = vb * 4 + wid; t < T_TOK; t += gridDim.x * 4) {
        const int id0 = p.ids[(size_t)t * 128 + lane], id1 = p.ids[(size_t)t * 128 + 64 + lane];
        const float g0 = p.gates[(size_t)t * 128 + lane], g1 = p.gates[(size_t)t * 128 + 64 + lane];
        const float su0 = p.su[id0], su1 = p.su[id1], sv0 = p.sv[id0], sv1 = p.sv[id1];
        const float* xr = p.x1 + (size_t)t * DM + lane * 16;
        f32x2 x[8];
        {
            const f32x4 a = *(const f32x4*)(xr), b = *(const f32x4*)(xr + 4), c = *(const f32x4*)(xr + 8), d = *(const f32x4*)(xr + 12);
            x[0] = (f32x2){a[0], a[1]}; x[1] = (f32x2){a[2], a[3]}; x[2] = (f32x2){b[0], b[1]}; x[3] = (f32x2){b[2], b[3]};
            x[4] = (f32x2){c[0], c[1]}; x[5] = (f32x2){c[2], c[3]}; x[6] = (f32x2){d[0], d[1]}; x[7] = (f32x2){d[2], d[3]};
        }
        const float h0 = peer_u_round(p.u8, id0, x, lane) * su0;
        const float h1 = peer_u_round(p.u8, id1, x, lane) * su1;
        const float a0 = gelu_gate(h0, g0) * sv0, a1 = gelu_gate(h1, g1) * sv1;
        f32x2 o[8];
#pragma unroll
        for (int i = 0; i < 8; ++i) o[i] = (f32x2){0.f, 0.f};
        peer_v_round(p.v8, id0, a0, o, lane);
        peer_v_round(p.v8, id1, a1, o, lane);
        float r[16];
#pragma unroll
        for (int i = 0; i < 8; ++i) { r[2 * i] = ALPHA * x[i].x + o[i].x; r[2 * i + 1] = ALPHA * x[i].y + o[i].y; }
        float* rr = p.y1 + (size_t)t * DM + lane * 16;
        *(f32x4*)(rr) = (f32x4){r[0], r[1], r[2], r[3]};
        *(f32x4*)(rr + 4) = (f32x4){r[4], r[5], r[6], r[7]};
        *(f32x4*)(rr + 8) = (f32x4){r[8], r[9], r[10], r[11]};
        *(f32x4*)(rr + 12) = (f32x4){r[12], r[13], r[14], r[15]};
        bf16_t* rbp = p.rb + (size_t)t * DM + lane * 16;
        u32x4 w0, w1;
        w0[0] = pack2(r[0], r[1]); w0[1] = pack2(r[2], r[3]); w0[2] = pack2(r[4], r[5]); w0[3] = pack2(r[6], r[7]);
        w1[0] = pack2(r[8], r[9]); w1[1] = pack2(r[10], r[11]); w1[2] = pack2(r[12], r[13]); w1[3] = pack2(r[14], r[15]);
        *(u32x4*)(rbp) = w0; *(u32x4*)(rbp + 8) = w1;
    }
}

__device__ __forceinline__ void ld_ids16(const int* __restrict__ q, int (&idv)[16]) {
    const int4* idp = (const int4*)q;
#pragma unroll
    for (int k = 0; k < 4; ++k) { const int4 v = idp[k]; idv[4 * k] = v.x; idv[4 * k + 1] = v.y; idv[4 * k + 2] = v.z; idv[4 * k + 3] = v.w; }
}
__device__ __forceinline__ void ld_f16(const float* __restrict__ q, float (&a)[16]) {
    const f32x4* ap = (const f32x4*)q;
#pragma unroll
    for (int k = 0; k < 4; ++k) { const f32x4 v = ap[k]; a[4 * k] = v[0]; a[4 * k + 1] = v[1]; a[4 * k + 2] = v[2]; a[4 * k + 3] = v[3]; }
}
__device__ void ph_peer_u(const Params& p, unsigned char* smem, const int vb) {
    const int lane = threadIdx.x & 63, wid = threadIdx.x >> 6, g = lane >> 3, c = lane & 7;
    const int nlb = gridDim.x >> 3, s = vb / nlb, lb = vb - s * nlb;
    const bool b2 = (lane & 4) != 0, b1 = (lane & 2) != 0, b0 = (lane & 1) != 0;
    const int cc = (b0 ? 2 : 0) + (b1 ? 4 : 0) + (b2 ? 8 : 0);
    const unsigned char* ubase = p.u8 + (size_t)s * (16384 * 128) + c * 16;
    const int stride = nlb * 4, t0 = lb * 4 + wid;
    const int ntok = (T_TOK - t0 + stride - 1) / stride;
    if (ntok <= 0) return;
    LDS_AS unsigned char* ring = (LDS_AS unsigned char*)smem + wid * 2048;
    const int* idg = p.ids + 2 * lane;
    const float* xg = p.x1 + s * 128 + 2 * lane;
#define PU_TOK(n) (t0 + ((n) < ntok ? (n) : ntok - 1) * stride)
#define PU_RAW_LD(n, ri, rx) do { const int _t = PU_TOK(n); ri = *(const u32x2*)(idg + (size_t)_t * 128); rx = *(const u32x2*)(xg + (size_t)_t * DM); } while (0)
#define PU_RAW_ST(n, ri, rx) do { LDS_AS unsigned char* _b = ring + ((n) & 1) * 1024; *(LDS_AS u32x2*)(_b + lane * 8) = ri; *(LDS_AS u32x2*)(_b + 512 + lane * 8) = rx; } while (0)
#define PU_IDS(n, idv) do { const LDS_AS u32x4* _q = (const LDS_AS u32x4*)(ring + ((n) & 1) * 1024 + g * 64); \
        _Pragma("unroll") for (int _k = 0; _k < 4; ++_k) { const u32x4 _v = _q[_k]; idv[4 * _k] = (int)_v[0]; idv[4 * _k + 1] = (int)_v[1]; idv[4 * _k + 2] = (int)_v[2]; idv[4 * _k + 3] = (int)_v[3]; } } while (0)
    u32x4 wA[8], wB[8]; u32x2 ri, rx;
    {
        u32x2 i0, x0, i1, x1v;
        PU_RAW_LD(0, i0, x0); PU_RAW_LD(1, i1, x1v); PU_RAW_LD(2, ri, rx);
        PU_RAW_ST(0, i0, x0); PU_RAW_ST(1, i1, x1v);
        int id0[16]; PU_IDS(0, id0);
#pragma unroll
        for (int i = 0; i < 8; ++i) wA[i] = *(const u32x4*)(ubase + (size_t)id0[i] * 128);
#pragma unroll
        for (int i = 0; i < 8; ++i) wB[i] = *(const u32x4*)(ubase + (size_t)id0[8 + i] * 128);
    }
#pragma unroll 1
    for (int n = 0; n < ntok; ++n) {
        const int t = t0 + n * stride;
        f32x2 x[8];
        {
            const LDS_AS f32x4* q = (const LDS_AS f32x4*)(ring + (n & 1) * 1024 + 512 + c * 64);
#pragma unroll
            for (int k = 0; k < 4; ++k) { const f32x4 v4 = q[k]; x[2 * k] = (f32x2){v4[0], v4[1]}; x[2 * k + 1] = (f32x2){v4[2], v4[3]}; }
        }
        int idn[16]; PU_IDS(n + 1, idn);
        float v[16];
#pragma unroll
        for (int i = 0; i < 8; ++i) { const f32x2 a = row_dot(wA[i], x, (f32x2){0.f, 0.f}); v[i] = a.x + a.y; }
#pragma unroll
        for (int i = 0; i < 8; ++i) wA[i] = *(const u32x4*)(ubase + (size_t)idn[i] * 128);
#pragma unroll
        for (int i = 0; i < 8; ++i) { const f32x2 a = row_dot(wB[i], x, (f32x2){0.f, 0.f}); v[8 + i] = a.x + a.y; }
#pragma unroll
        for (int i = 0; i < 8; ++i) wB[i] = *(const u32x4*)(ubase + (size_t)idn[8 + i] * 128);
        PU_RAW_ST(n + 2, ri, rx);
        PU_RAW_LD(n + 3, ri, rx);
#pragma unroll
        for (int i = 0; i < 8; ++i) { const float keep = b2 ? v[i + 8] : v[i], send = b2 ? v[i] : v[i + 8]; v[i] = keep + __shfl_xor(send, 4); }
#pragma unroll
        for (int i = 0; i < 4; ++i) { const float keep = b1 ? v[i + 4] : v[i], send = b1 ? v[i] : v[i + 4]; v[i] = keep + __shfl_xor(send, 2); }
#pragma unroll
        for (int i = 0; i < 2; ++i) { const float keep = b0 ? v[i + 2] : v[i], send = b0 ? v[i] : v[i + 2]; v[i] = keep + __shfl_xor(send, 1); }
        *(f32x2*)(p.hp + ((size_t)t * 8 + s) * 128 + g * 16 + cc) = (f32x2){v[0], v[1]};
    }
}
__device__ void ph_peer_act(const Params& p, const int vb) {
    const int lane = threadIdx.x & 63, wid = threadIdx.x >> 6;
    for (int t = vb * 4 + wid; t < T_TOK; t += gridDim.x * 4) {
        f32x2 h = {0.f, 0.f};
#pragma unroll
        for (int s = 0; s < 8; ++s) h += *(const f32x2*)(p.hp + ((size_t)t * 8 + s) * 128 + 2 * lane);
        const int2 id = *(const int2*)(p.ids + (size_t)t * 128 + 2 * lane);
        const f32x2 gt = *(const f32x2*)(p.gates + (size_t)t * 128 + 2 * lane);
        f32x2 a;
        a.x = gelu_gate(h.x * p.su[id.x], gt.x) * p.sv[id.x];
        a.y = gelu_gate(h.y * p.su[id.y], gt.y) * p.sv[id.y];
        *(f32x2*)(p.gates + (size_t)t * 128 + 2 * lane) = a;
    }
}
__device__ void ph_peer_v(const Params& p, unsigned char* smem, const int vb) {
    const int lane = threadIdx.x & 63, wid = threadIdx.x >> 6, g = lane >> 3, c = lane & 7;
    const int nlb = gridDim.x >> 3, s = vb / nlb, lb = vb - s * nlb;
    const bool b4 = (lane & 16) != 0, b3 = (lane & 8) != 0;
    const unsigned char* vbase = p.v8 + (size_t)s * (16384 * 128) + c * 16;
    const int stride = nlb * 4, t0 = lb * 4 + wid;
    const int ntok = (T_TOK - t0 + stride - 1) / stride;
    if (ntok <= 0) return;
    const int d0 = s * 128 + c * 16 + 2 * g;
    LDS_AS unsigned char* ring = (LDS_AS unsigned char*)smem + wid * 2048;
    const int* idg = p.ids + 2 * lane;
    const float* ag = p.gates + 2 * lane;
#define PV_RAW_LD(n, ri, rx) do { const int _t = PU_TOK(n); ri = *(const u32x2*)(idg + (size_t)_t * 128); rx = *(const u32x2*)(ag + (size_t)_t * 128); } while (0)
    u32x4 wA[8], wB[8]; u32x2 ri, rx;
    {
        u32x2 i0, x0, i1, x1v;
        PV_RAW_LD(0, i0, x0); PV_RAW_LD(1, i1, x1v); PV_RAW_LD(2, ri, rx);
        PU_RAW_ST(0, i0, x0); PU_RAW_ST(1, i1, x1v);
        int id0[16]; PU_IDS(0, id0);
#pragma unroll
        for (int i = 0; i < 8; ++i) wA[i] = *(const u32x4*)(vbase + (size_t)id0[i] * 128);
#pragma unroll
        for (int i = 0; i < 8; ++i) wB[i] = *(const u32x4*)(vbase + (size_t)id0[8 + i] * 128);
    }
#pragma unroll 1
    for (int n = 0; n < ntok; ++n) {
        const int t = t0 + n * stride;
        const f32x2 xv = *(const f32x2*)(p.x1 + (size_t)t * DM + d0);
        float ac[16];
        {
            const LDS_AS f32x4* q = (const LDS_AS f32x4*)(ring + (n & 1) * 1024 + 512 + g * 64);
#pragma unroll
            for (int k = 0; k < 4; ++k) { const f32x4 v4 = q[k]; ac[4 * k] = v4[0]; ac[4 * k + 1] = v4[1]; ac[4 * k + 2] = v4[2]; ac[4 * k + 3] = v4[3]; }
        }
        int idn[16]; PU_IDS(n + 1, idn);
        f32x2 acc[8];
#pragma unroll
        for (int k = 0; k < 8; ++k) acc[k] = (f32x2){0.f, 0.f};
#pragma unroll
        for (int i = 0; i < 8; ++i) {
            const f32x2 a2 = {ac[i], ac[i]};
#pragma unroll
            for (int k = 0; k < 4; ++k) {
                acc[2 * k] = __builtin_amdgcn_cvt_pk_f32_fp8(wA[i][k], false) * a2 + acc[2 * k];
                acc[2 * k + 1] = __builtin_amdgcn_cvt_pk_f32_fp8(wA[i][k], true) * a2 + acc[2 * k + 1];
            }
        }
#pragma unroll
        for (int i = 0; i < 8; ++i) wA[i] = *(const u32x4*)(vbase + (size_t)idn[i] * 128);
#pragma unroll
        for (int i = 0; i < 8; ++i) {
            const f32x2 a2 = {ac[8 + i], ac[8 + i]};
#pragma unroll
            for (int k = 0; k < 4; ++k) {
                acc[2 * k] = __builtin_amdgcn_cvt_pk_f32_fp8(wB[i][k], false) * a2 + acc[2 * k];
                acc[2 * k + 1] = __builtin_amdgcn_cvt_pk_f32_fp8(wB[i][k], true) * a2 + acc[2 * k + 1];
            }
        }
#pragma unroll
        for (int i = 0; i < 8; ++i) wB[i] = *(const u32x4*)(vbase + (size_t)idn[8 + i] * 128);
        PU_RAW_ST(n + 2, ri, rx);
        PV_RAW_LD(n + 3, ri, rx);
        float v[16];
#pragma unroll
        for (int k = 0; k < 8; ++k) { v[2 * k] = acc[k].x; v[2 * k + 1] = acc[k].y; }
#pragma unroll
        for (int j2 = 0; j2 < 8; ++j2) {
            auto r = __builtin_amdgcn_permlane32_swap(__float_as_uint(v[j2]), __float_as_uint(v[j2 + 8]), false, false);
            v[j2] = __uint_as_float(r[0]) + __uint_as_float(r[1]);
        }
#pragma unroll
        for (int j2 = 0; j2 < 4; ++j2) { const float keep = b4 ? v[j2 + 4] : v[j2], send = b4 ? v[j2] : v[j2 + 4]; v[j2] = keep + __shfl_xor(send, 16); }
#pragma unroll
        for (int j2 = 0; j2 < 2; ++j2) { const float keep = b3 ? v[j2 + 2] : v[j2], send = b3 ? v[j2] : v[j2 + 2]; v[j2] = keep + __shfl_xor(send, 8); }
        const float r0 = ALPHA * xv.x + v[0], r1 = ALPHA * xv.y + v[1];
        *(f32x2*)(p.y1 + (size_t)t * DM + d0) = (f32x2){r0, r1};
        *(unsigned*)(p.rb + (size_t)t * DM + d0) = pack2(r0, r1);
    }
}

__device__ void ph_gemm_ple(const Params& p, unsigned char* smem, const int vb) {
    const int ntn = DM / 128;
    const int tid = threadIdx.x, lane = tid & 63, wid = tid >> 6, wr = wid >> 1, wc = wid & 1, fr = lane & 15, fq = lane >> 4;
    for (int t = vb; t < (T_TOK / 128) * ntn; t += gridDim.x) {
        const int m0 = (t / ntn) * 128, n0 = (t % ntn) * 128;
        f32x4 acc[4][4], acc2[4][4]; zero_acc(acc); zero_acc(acc2);
        gemm128(p.pb + (size_t)m0 * 256, 256, p.WpT + (size_t)n0 * 256, 256, 256, smem, acc2);
        gemm128(p.rb + (size_t)m0 * DM, DM, p.WgT + (size_t)n0 * DM, DM, DM, smem, acc);
#pragma unroll
        for (int mi = 0; mi < 4; ++mi) {
            const int row = m0 + wr * 64 + mi * 16 + fr;
#pragma unroll
            for (int ni = 0; ni < 4; ++ni) {
                const int col = n0 + wc * 64 + ni * 16 + fq * 4;
                float* yp = p.y1 + (size_t)row * DM + col;
                f32x4 rv = *(const f32x4*)yp;
#pragma unroll
                for (int r = 0; r < 4; ++r) rv[r] += acc2[mi][ni][r] / (1.0f + __expf(-acc[mi][ni][r]));
                *(f32x4*)yp = rv;
            }
        }
    }
}

#define XB_TMO      128
#define XB_XCNT(j)  (256  + 64 * (j))
#define XB_XSUB(j)  (1280 + 64 * (j))
#define XB_XGEN(j)  (2304 + 64 * (j))
#define XB_TOP      3328
#define XB_TOPGEN   3392
#define XCD_BAR_WORDS 3456
#define XB_SPIN_CAP (1u << 20)
__device__ __forceinline__ unsigned xb_ld(unsigned* p)              { return __hip_atomic_load(p, __ATOMIC_RELAXED, __HIP_MEMORY_SCOPE_AGENT); }
__device__ __forceinline__ unsigned xb_add(unsigned* p, unsigned v) { return __hip_atomic_fetch_add(p, v, __ATOMIC_RELAXED, __HIP_MEMORY_SCOPE_AGENT); }
__device__ __forceinline__ unsigned xb_xcc_id() { return (unsigned)__builtin_amdgcn_s_getreg((3 << 11) | 20) & 0xFu; }
#define XB_SPIN(cond, bar) do { unsigned _sp = 0; while (cond) { __builtin_amdgcn_s_sleep(1); \
    if ((++_sp & 255u) == 0u) { if (xb_ld(&(bar)[XB_TMO])) break; if (_sp > XB_SPIN_CAP) { atomicAdd(&(bar)[XB_TMO], 1u); break; } } } } while (0)
struct XcdBarrier { unsigned* bar; unsigned x; volatile LDS_AS unsigned* st; };
__device__ __forceinline__ XcdBarrier xcd_barrier_post(unsigned* bar, volatile LDS_AS unsigned* st) {
    XcdBarrier b; b.bar = bar; b.x = xb_xcc_id(); b.st = st;
    if (threadIdx.x == 0) st[3] = xb_add(&bar[XB_XCNT(b.x)], 1u);
    return b;
}
__device__ __forceinline__ void xcd_barrier_complete(unsigned* bar, unsigned x, unsigned rank, unsigned& nloc, unsigned& nx, unsigned& vb) {
    const unsigned G = gridDim.x;
    unsigned sum, cnt, mine, sp = 0u; bool even;
    for (;;) {
        sum = 0u; cnt = 0u; mine = 0u; even = true;
#pragma unroll
        for (unsigned j = 0; j < 16; ++j) {
            const unsigned c = xb_ld(&bar[XB_XCNT(j)]); sum += c; cnt += (c > 0u) ? 1u : 0u; mine = (j == x) ? c : mine;
            even = even && (c == ((j < 8u) ? (G >> 3) : 0u));
        }
        if (sum == G) break;
        __builtin_amdgcn_s_sleep(1);
        if ((++sp & 255u) == 0u) { if (xb_ld(&bar[XB_TMO])) break; if (sp > XB_SPIN_CAP) { atomicAdd(&bar[XB_TMO], 1u); break; } }
    }
    nloc = mine > 0u ? mine : 1u; nx = cnt > 0u ? cnt : 1u;
    vb = (even && sum == G && (G & 7u) == 0u) ? (x * (G >> 3) + rank) : blockIdx.x;
}
__device__ __forceinline__ void xcd_barrier(const XcdBarrier& b) {
    asm volatile("s_waitcnt vmcnt(0)" ::: "memory");
    __syncthreads();
    if (threadIdx.x == 0) {
        unsigned* bar = b.bar;
        __builtin_amdgcn_s_waitcnt(0);
        unsigned nloc = b.st[0], nx = b.st[1];
        if (nloc == 0u) { unsigned vb; xcd_barrier_complete(bar, b.x, b.st[3], nloc, nx, vb); b.st[0] = nloc; b.st[1] = nx; b.st[2] = vb; }
        const unsigned old = xb_add(&bar[XB_XSUB(b.x)], 1u);
        const unsigned gen = old / nloc;
        if (old + 1u == (gen + 1u) * nloc) {
            __builtin_amdgcn_fence(__ATOMIC_RELEASE, "agent");
            asm volatile("s_waitcnt vmcnt(0)" ::: "memory");
            const unsigned og = xb_add(&bar[XB_TOP], 1u);
            const unsigned tg = og / nx;
            if (og + 1u == (tg + 1u) * nx) xb_add(&bar[XB_TOPGEN], 1u);
            else XB_SPIN(xb_ld(&bar[XB_TOPGEN]) == tg, bar);
            __builtin_amdgcn_fence(__ATOMIC_ACQUIRE, "agent");
            xb_add(&bar[XB_XGEN(b.x)], 1u);
            asm volatile("s_waitcnt vmcnt(0)" ::: "memory");
        } else {
            XB_SPIN(xb_ld(&bar[XB_XGEN(b.x)]) == gen, bar);
            __builtin_amdgcn_fence(__ATOMIC_ACQUIRE, "agent");
            asm volatile("s_waitcnt vmcnt(0)" ::: "memory");
        }
    }
    __syncthreads();
}

#define SMEM_PHASE (256 * ASTR * 2 * 2)
#define SMEM_BYTES (SMEM_PHASE + 16)
__global__ void __launch_bounds__(256, 2) mega(Params p) {
    __shared__ __attribute__((aligned(16))) unsigned char smem[SMEM_BYTES];
    volatile LDS_AS unsigned* st = (volatile LDS_AS unsigned*)(LDS_AS unsigned char*)(smem + SMEM_PHASE);
    if (threadIdx.x < 4) st[threadIdx.x] = 0u;
    __syncthreads();
    const XcdBarrier gb = xcd_barrier_post(p.bar, st);
    ph_prep(p, smem);            xcd_barrier(gb);
    const int vb = (int)st[2];
    ph_gemm_in(p, smem, vb);     xcd_barrier(gb);
    ph_attn(p, smem, vb);
    ph_conv(p, smem, vb);        xcd_barrier(gb);
    ph_gemm_out(p, smem, vb);    xcd_barrier(gb);
    ph_ln1(p, vb);               xcd_barrier(gb);
    ph_route(p, smem, vb);       xcd_barrier(gb);
    ph_peer_u(p, smem, vb);      xcd_barrier(gb);
    ph_peer_act(p, vb);          xcd_barrier(gb);
    ph_peer_v(p, smem, vb);      xcd_barrier(gb);
    ph_gemm_ple(p, smem, vb);    xcd_barrier(gb);
    ph_ln2(p, vb);
}

extern "C" void kernel_launch(void* const* d_in, const int* in_sizes, int n_in, void* d_out, int out_size, void* d_ws, size_t ws_size,
                              hipStream_t stream) {
    Params p{};
    p.x = (const float*)d_in[0]; p.p = (const float*)d_in[1]; p.pos = (const int*)d_in[2];
    p.w_in = (const float*)d_in[3]; p.sinks = (const float*)d_in[4]; p.conv_w = (const float*)d_in[5]; p.conv_b = (const float*)d_in[6];
    p.cln_g = (const float*)d_in[7]; p.cln_b = (const float*)d_in[8]; p.w_out = (const float*)d_in[9]; p.ln1_g = (const float*)d_in[10];
    p.ln1_b = (const float*)d_in[11]; p.wq = (const float*)d_in[12]; p.keys = (const float*)d_in[13]; p.pu = (const float*)d_in[14];
    p.pv = (const float*)d_in[15]; p.ple_proj = (const float*)d_in[16]; p.ple_gate = (const float*)d_in[17]; p.ln2_g = (const float*)d_in[18];
    p.ln2_b = (const float*)d_in[19];
    p.out = (float*)d_out;
    unsigned char* ws = (unsigned char*)d_ws;
    const size_t MiB = 1024 * 1024;
    p.y1 = (float*)(ws + 0 * MiB);
    p.hb = (bf16_t*)(ws + 128 * MiB);
    p.qb = (bf16_t*)(ws + 128 * MiB);
    p.hp = (float*)(ws + 128 * MiB);
    p.xb = (bf16_t*)(ws + 256 * MiB);
    p.x1b = (bf16_t*)(ws + 256 * MiB);
    p.mixb = (bf16_t*)(ws + 320 * MiB);
    p.tops = (float*)(ws + 320 * MiB);
    p.topi = (int*)(ws + 352 * MiB);
    p.rb = (bf16_t*)(ws + 320 * MiB);
    p.pb = (bf16_t*)(ws + 384 * MiB);
    p.ub = (bf16_t*)(ws + 400 * MiB);
    p.vb = (bf16_t*)(ws + 432 * MiB);
    p.u8 = (unsigned char*)(ws + 400 * MiB);
    p.v8 = (unsigned char*)(ws + 416 * MiB);
    p.su = (float*)(ws + 432 * MiB);
    p.sv = (float*)(ws + 433 * MiB);
    p.ids = (int*)(ws + 464 * MiB);
    p.gates = (float*)(ws + 480 * MiB);
    unsigned char* wb = ws + 496 * MiB;
    p.WinT = (bf16_t*)wb; wb += (size_t)INW * DM * 2;
    p.WoutT = (bf16_t*)wb; wb += (size_t)DM * DM * 2;
    p.WqT = (bf16_t*)wb; wb += (size_t)2048 * DM * 2;
    p.WgT = (bf16_t*)wb; wb += (size_t)DM * DM * 2;
    p.WpT = (bf16_t*)wb; wb += (size_t)DM * 256 * 2;
    p.keysb = (bf16_t*)wb; wb += (size_t)16 * 128 * 128 * 2;
    p.bar = (unsigned*)(ws + 510 * MiB);
    p.x1 = (float*)d_out;

    static int grid_blocks = 0;
    if (!grid_blocks) {
        int dev = 0, cus = 0, per_cu = 0;
        (void)hipGetDevice(&dev);
        (void)hipDeviceGetAttribute(&cus, hipDeviceAttributeMultiprocessorCount, dev);
        (void)hipOccupancyMaxActiveBlocksPerMultiprocessor(&per_cu, mega, 256, 0);
        if (per_cu > 2) per_cu = 2;
        grid_blocks = cus * per_cu;
    }
    (void)hipMemsetAsync(p.bar, 0, XCD_BAR_WORDS * sizeof(unsigned), stream);
    void* args[] = {&p};
    hipError_t e = hipLaunchCooperativeKernel((void*)mega, dim3(grid_blocks), dim3(256), args, 0, stream);
    if (e != hipSuccess) fprintf(stderr, "cooperative launch failed: %s (grid %d)\n", hipGetErrorString(e), grid_blocks);
}
```

```cpp
#include <hip/hip_runtime.h>
#include <hip/hip_cooperative_groups.h>
#include <stdint.h>
#include <cstdio>
namespace cg = cooperative_groups;

typedef unsigned short bf16_t;
typedef short bf16x8 __attribute__((ext_vector_type(8)));
typedef float f32x4 __attribute__((ext_vector_type(4)));
typedef unsigned u32x4 __attribute__((ext_vector_type(4)));
typedef float f32x2 __attribute__((ext_vector_type(2)));

#define T_TOK 32768
#define SEQ 2048
#define DM 1024
#define INW 1792
#define ALPHA 1.189207115002721f
#define LN_EPS 1e-5f

__device__ __forceinline__ bf16_t f2bf(float f) {
    unsigned u = __float_as_uint(f);
    u += 0x7fffu + ((u >> 16) & 1u);
    return (bf16_t)(u >> 16);
}
__device__ __forceinline__ float bf2f(bf16_t b) { return __uint_as_float(((unsigned)b) << 16); }
__device__ __forceinline__ float bflo(unsigned w) { return __uint_as_float(w << 16); }
__device__ __forceinline__ float bfhi(unsigned w) { return __uint_as_float(w & 0xffff0000u); }
__device__ __forceinline__ unsigned pack2(float a, float b) { return (unsigned)f2bf(a) | ((unsigned)f2bf(b) << 16); }

__device__ __forceinline__ float wave_sum(float v) {
#pragma unroll
    for (int o = 32; o >= 1; o >>= 1) v += __shfl_xor(v, o);
    return v;
}

struct Params {
    const float *x, *p; const int* pos;
    const float *w_in, *sinks, *conv_w, *conv_b, *cln_g, *cln_b, *w_out, *ln1_g, *ln1_b;
    const float *wq, *keys, *pu, *pv, *ple_proj, *ple_gate, *ln2_g, *ln2_b;
    float* out;
    bf16_t *xb, *pb, *WinT, *WoutT, *WqT, *WgT, *WpT, *keysb, *ub, *vb, *hb, *mixb, *x1b, *qb, *rb;
    float *y1, *x1, *tops, *gates, *su, *sv, *hp;
    int *topi, *ids;
    unsigned char *u8, *v8;
    unsigned* bar;
};

__device__ void cvt_rows(const float* __restrict__ src, bf16_t* __restrict__ dst, size_t n) {
    const size_t nv = n / 8, gs = (size_t)gridDim.x * blockDim.x;
    for (size_t i = (size_t)blockIdx.x * blockDim.x + threadIdx.x; i < nv; i += 4 * gs) {
        f32x4 a[4], b[4];
#pragma unroll
        for (int q = 0; q < 4; ++q) { const size_t k = (i + q * gs < nv) ? i + q * gs : i; a[q] = ((const f32x4*)src)[2 * k]; b[q] = ((const f32x4*)src)[2 * k + 1]; }
#pragma unroll
        for (int q = 0; q < 4; ++q) {
            if (i + q * gs < nv) {
                u32x4 o; o[0] = pack2(a[q][0], a[q][1]); o[1] = pack2(a[q][2], a[q][3]); o[2] = pack2(b[q][0], b[q][1]); o[3] = pack2(b[q][2], b[q][3]);
                ((u32x4*)dst)[i + q * gs] = o;
            }
        }
    }
}
__device__ void transpose_cvt(const float* __restrict__ W, bf16_t* __restrict__ Wt, int K, int N, float* tile  ) {
    const int tk = K / 32, tn = N / 32;
    const int tx = threadIdx.x & 31, ty = threadIdx.x >> 5;
    for (int t = blockIdx.x; t < tk * tn; t += gridDim.x) {
        const int k0 = (t / tn) * 32, n0 = (t % tn) * 32;
        __syncthreads();
#pragma unroll
        for (int i = 0; i < 4; ++i) tile[(ty + i * 8) * 33 + tx] = W[(size_t)(k0 + ty + i * 8) * N + n0 + tx];
        __syncthreads();
#pragma unroll
        for (int i = 0; i < 4; ++i) Wt[(size_t)(n0 + ty + i * 8) * K + k0 + tx] = f2bf(tile[tx * 33 + ty + i * 8]);
    }
}

__device__ void cvt_table_fp8(const float* __restrict__ src, unsigned char* __restrict__ dst, float* __restrict__ scl, int rows) {
    const int lane = threadIdx.x & 63, wid = threadIdx.x >> 6;
    const int nw = gridDim.x * 4;
    for (int r0 = blockIdx.x * 4 + wid; r0 < rows; r0 += 4 * nw) {
        f32x4 v[4][4];
#pragma unroll
        for (int q = 0; q < 4; ++q) {
            const int r = (r0 + q * nw < rows) ? r0 + q * nw : r0;
            const float* sr = src + (size_t)r * DM + lane * 16;
#pragma unroll
            for (int k = 0; k < 4; ++k) v[q][k] = *(const f32x4*)(sr + 4 * k);
        }
#pragma unroll
        for (int q = 0; q < 4; ++q) {
            const int r = r0 + q * nw;
            float m = 0.f;
#pragma unroll
            for (int k = 0; k < 4; ++k)
#pragma unroll
                for (int i = 0; i < 4; ++i) m = fmaxf(m, fabsf(v[q][k][i]));
#pragma unroll
            for (int o = 32; o >= 1; o >>= 1) m = fmaxf(m, __shfl_xor(m, o));
            const float sc = (m > 0.f) ? 448.0f / m : 1.0f;
            u32x4 w;
#pragma unroll
            for (int k = 0; k < 4; ++k)
                w[k] = __builtin_amdgcn_cvt_pk_fp8_f32(v[q][k][2] * sc, v[q][k][3] * sc, __builtin_amdgcn_cvt_pk_fp8_f32(v[q][k][0] * sc, v[q][k][1] * sc, 0, false), true);
            if (r < rows) {
                *(u32x4*)(dst + (size_t)(lane >> 3) * (16384 * 128) + (size_t)r * 128 + (lane & 7) * 16) = w;
                if (lane == 0) scl[r] = (m > 0.f) ? m * (1.0f / 448.0f) : 1.0f;
            }
        }
    }
}
__device__ void ph_prep(const Params& p, unsigned char* smem) {
    float* tile = (float*)smem;
    cvt_rows(p.x, p.xb, (size_t)T_TOK * DM);
    cvt_rows(p.p, p.pb, (size_t)T_TOK * 256);
    cvt_table_fp8(p.pu, p.u8, p.su, 16384);
    cvt_table_fp8(p.pv, p.v8, p.sv, 16384);
    cvt_rows(p.keys, p.keysb, (size_t)16 * 128 * 128);
    transpose_cvt(p.w_in, p.WinT, DM, INW, tile);
    transpose_cvt(p.w_out, p.WoutT, DM, DM, tile);
    transpose_cvt(p.wq, p.WqT, DM, 2048, tile);
    transpose_cvt(p.ple_gate, p.WgT, DM, DM, tile);
    transpose_cvt(p.ple_proj, p.WpT, 256, DM, tile);
}

#define LDS_AS __attribute__((address_space(3)))
#define GEMM_STAGE 32768
__device__ __forceinline__ void gemm128(const bf16_t* __restrict__ A, int lda, const bf16_t* __restrict__ Bt, int ldb, int K,
                                        unsigned char* smem, f32x4 (&acc)[4][4]) {
    LDS_AS unsigned char* lds = (LDS_AS unsigned char*)smem;
    const int tid = threadIdx.x, lane = tid & 63, wid = __builtin_amdgcn_readfirstlane(tid >> 6);
    const int wr = wid >> 1, wc = wid & 1, fr = lane & 15, fq = lane >> 4;
    const int nk = K / 64;
    const int prow = lane >> 3, pc = (lane & 7) ^ prow;
    const bf16_t* gA = A + (size_t)(wid * 32 + prow) * lda + pc * 8;
    const bf16_t* gB = Bt + (size_t)(wid * 32 + prow) * ldb + pc * 8;
    const size_t a8 = (size_t)8 * lda, b8 = (size_t)8 * ldb;
#define GEMM_ISSUE(kt, st) do { \
        _Pragma("unroll") for (int _i = 0; _i < 4; ++_i) { \
            __builtin_amdgcn_global_load_lds((const unsigned*)(gA + _i * a8 + (size_t)(kt) * 64), (LDS_AS unsigned*)(lds + (st) * GEMM_STAGE + (wid * 4 + _i) * 1024), 16, 0, 0); \
            __builtin_amdgcn_global_load_lds((const unsigned*)(gB + _i * b8 + (size_t)(kt) * 64), (LDS_AS unsigned*)(lds + (st) * GEMM_STAGE + 16384 + (wid * 4 + _i) * 1024), 16, 0, 0); \
        } } while (0)
    const int swz0 = ((0 * 4 + fq) ^ (fr & 7)) * 16, swz1 = ((1 * 4 + fq) ^ (fr & 7)) * 16;
    const int aoff = (wr * 64 + fr) * 128, boff = 16384 + (wc * 64 + fr) * 128;
    GEMM_ISSUE(0, 0);
#pragma unroll 1
    for (int kt = 0; kt < nk; ++kt) {
        const int st = kt & 1;
        asm volatile("s_waitcnt vmcnt(0)" ::: "memory");
        __builtin_amdgcn_s_barrier();
        asm volatile("" ::: "memory");
        if (kt + 1 < nk) GEMM_ISSUE(kt + 1, st ^ 1);
        const LDS_AS unsigned char* sb = lds + st * GEMM_STAGE;
        bf16x8 af0[4], bf0[4], af1[4], bf1[4];
#pragma unroll
        for (int mi = 0; mi < 4; ++mi) af0[mi] = *(const LDS_AS bf16x8*)(sb + aoff + mi * 2048 + swz0);
#pragma unroll
        for (int ni = 0; ni < 4; ++ni) bf0[ni] = *(const LDS_AS bf16x8*)(sb + boff + ni * 2048 + swz0);
#pragma unroll
        for (int mi = 0; mi < 4; ++mi) af1[mi] = *(const LDS_AS bf16x8*)(sb + aoff + mi * 2048 + swz1);
#pragma unroll
        for (int ni = 0; ni < 4; ++ni) bf1[ni] = *(const LDS_AS bf16x8*)(sb + boff + ni * 2048 + swz1);
#pragma unroll
        for (int mi = 0; mi < 4; ++mi)
#pragma unroll
            for (int ni = 0; ni < 4; ++ni)
                acc[mi][ni] = __builtin_amdgcn_mfma_f32_16x16x32_bf16(bf0[ni], af0[mi], acc[mi][ni], 0, 0, 0);
#pragma unroll
        for (int mi = 0; mi < 4; ++mi)
#pragma unroll
            for (int ni = 0; ni < 4; ++ni)
                acc[mi][ni] = __builtin_amdgcn_mfma_f32_16x16x32_bf16(bf1[ni], af1[mi], acc[mi][ni], 0, 0, 0);
        __builtin_amdgcn_sched_group_barrier(0x100, 8, 0);
#pragma unroll
        for (int q = 0; q < 8; ++q) { __builtin_amdgcn_sched_group_barrier(0x008, 2, 0); __builtin_amdgcn_sched_group_barrier(0x100, 1, 0); }
        __builtin_amdgcn_sched_group_barrier(0x008, 16, 0);
        asm volatile("s_waitcnt lgkmcnt(0)" ::: "memory");
        __builtin_amdgcn_s_barrier();
        asm volatile("" ::: "memory");
    }
#undef GEMM_ISSUE
}
__device__ __forceinline__ void zero_acc(f32x4 (&acc)[4][4]) {
#pragma unroll
    for (int a = 0; a < 4; ++a)
#pragma unroll
        for (int b = 0; b < 4; ++b) acc[a][b] = (f32x4){0.f, 0.f, 0.f, 0.f};
}
#define GEMM_SMEM (2 * GEMM_STAGE)

__device__ void ph_gemm_in(const Params& p, unsigned char* smem, const int vb) {
    const int ntn = INW / 128;
    const int tid = threadIdx.x, lane = tid & 63, wid = tid >> 6, wr = wid >> 1, wc = wid & 1, fr = lane & 15, fq = lane >> 4;
    for (int t = vb; t < (T_TOK / 128) * ntn; t += gridDim.x) {
        const int m0 = (t / ntn) * 128, n0 = (t % ntn) * 128;
        f32x4 acc[4][4]; zero_acc(acc);
        gemm128(p.xb + (size_t)m0 * DM, DM, p.WinT + (size_t)n0 * DM, DM, DM, smem, acc);
#pragma unroll
        for (int mi = 0; mi < 4; ++mi) {
            const int row = m0 + wr * 64 + mi * 16 + fr;
            const float posf = (float)p.pos[row];
#pragma unroll
            for (int ni = 0; ni < 4; ++ni) {
                const int col0 = n0 + wc * 64 + ni * 16;
                f32x4 v = acc[mi][ni];
                if (col0 < 640 && (col0 & 63) == 0) {
#pragma unroll
                    for (int r = 0; r < 4; ++r) {
                        const float other = __shfl_xor(v[r], 32);
                        const int j = (fq & 1) * 4 + r;
                        const float inv = powf(500000.0f, -(float)j * 0.125f);
                        float sn, cs; sincosf(posf * inv, &sn, &cs);
                        v[r] = (fq < 2) ? (v[r] * cs - other * sn) : (v[r] * cs + other * sn);
                    }
                }
                uint2 o; o.x = pack2(v[0], v[1]); o.y = pack2(v[2], v[3]);
                *(uint2*)(p.hb + (size_t)row * INW + col0 + fq * 4) = o;
            }
        }
    }
}

#define ASTR 72
#define VSTR 260
typedef float f32x16 __attribute__((ext_vector_type(16)));
typedef unsigned u32x2 __attribute__((ext_vector_type(2)));
__device__ void ph_attn(const Params& p, unsigned char* smem, const int vb) {
    bf16_t* sK = (bf16_t*)smem;
    bf16_t* sVt = sK + 256 * ASTR;
    const int tid = threadIdx.x, lane = tid & 63, wid = tid >> 6, r32 = lane & 31, hh = lane >> 5;
    const float C1 = 0.125f * 1.4426950408889634f, LOG2E = 1.4426950408889634f;
    for (int u = vb; u < 16 * 16 * 2; u += gridDim.x) {
        const int kvh = u & 1, nb = (u >> 1) & 15, b = u >> 5;
        __syncthreads();
        for (int c = tid; c < 256 * 8; c += 256) {
            const int li = c >> 3, kc = c & 7;
            const int pos = nb * 128 - 128 + li;
            u32x4 kv = {0u, 0u, 0u, 0u}, vv = {0u, 0u, 0u, 0u};
            if (pos >= 0) {
                const bf16_t* base = p.hb + (size_t)(b * SEQ + pos) * INW;
                kv = *(const u32x4*)(base + 512 + kvh * 64 + kc * 8);
                vv = *(const u32x4*)(base + 640 + kvh * 64 + kc * 8);
            }
            *(u32x4*)(sK + li * ASTR + kc * 8) = kv;
#pragma unroll
            for (int i = 0; i < 4; ++i) {
                sVt[(kc * 8 + 2 * i) * VSTR + li] = (bf16_t)(vv[i] & 0xffffu);
                sVt[(kc * 8 + 2 * i + 1) * VSTR + li] = (bf16_t)(vv[i] >> 16);
            }
        }
        __syncthreads();
        const int hq = kvh * 4 + wid;
        const float sink2 = p.sinks[hq] * LOG2E;
#pragma unroll 1
        for (int qt = 0; qt < 4; ++qt) {
            const size_t trow = (size_t)(b * SEQ + nb * 128 + qt * 32 + r32);
            bf16x8 qf[4];
#pragma unroll
            for (int ks = 0; ks < 4; ++ks) qf[ks] = *(const bf16x8*)(p.hb + trow * INW + hq * 64 + ks * 16 + hh * 8);
            f32x16 S[5];
#pragma unroll
            for (int j = 0; j < 5; ++j) {
#pragma unroll
                for (int r = 0; r < 16; ++r) S[j][r] = 0.f;
#pragma unroll
                for (int ks = 0; ks < 4; ++ks) {
                    const bf16x8 a = *(const bf16x8*)(sK + ((qt + j) * 32 + r32) * ASTR + ks * 16 + hh * 8);
                    S[j] = __builtin_amdgcn_mfma_f32_32x32x16_bf16(a, qf[ks], S[j], 0, 0, 0);
                }
            }
            float m2 = sink2;
#pragma unroll
            for (int j = 0; j < 5; ++j) {
                const bool tile_ok = (nb > 0) || (qt + j >= 4);
#pragma unroll
                for (int r = 0; r < 16; ++r) {
                    const int kl = (r & 3) + 8 * (r >> 2) + 4 * hh;
                    bool ok = tile_ok;
                    if (j == 0) ok = ok && (kl > r32);
                    if (j == 4) ok = ok && (kl <= r32);
                    const float t = ok ? S[j][r] * C1 : -1.0e30f;
                    S[j][r] = t;
                    m2 = fmaxf(m2, t);
                }
            }
            m2 = fmaxf(m2, __shfl_xor(m2, 32));
            float l = 0.f;
#pragma unroll
            for (int j = 0; j < 5; ++j)
#pragma unroll
                for (int r = 0; r < 16; ++r) { const float e = __builtin_amdgcn_exp2f(S[j][r] - m2); S[j][r] = e; l += e; }
            l += __shfl_xor(l, 32);
            l += __builtin_amdgcn_exp2f(sink2 - m2);
            f32x16 O[2];
#pragma unroll
            for (int dt = 0; dt < 2; ++dt)
#pragma unroll
                for (int r = 0; r < 16; ++r) O[dt][r] = 0.f;
#pragma unroll
            for (int j = 0; j < 5; ++j)
#pragma unroll
                for (int s2 = 0; s2 < 2; ++s2) {
                    u32x4 pw;
#pragma unroll
                    for (int k = 0; k < 4; ++k) pw[k] = pack2(S[j][8 * s2 + 2 * k], S[j][8 * s2 + 2 * k + 1]);
                    const bf16x8 pf = __builtin_bit_cast(bf16x8, pw);
                    const int kbase = (qt + j) * 32 + 16 * s2 + 4 * hh;
#pragma unroll
                    for (int dt = 0; dt < 2; ++dt) {
                        const bf16_t* vp = sVt + (dt * 32 + r32) * VSTR + kbase;
                        const u32x2 v0 = *(const u32x2*)(vp), v1 = *(const u32x2*)(vp + 8);
                        const u32x4 vw = {v0[0], v0[1], v1[0], v1[1]};
                        O[dt] = __builtin_amdgcn_mfma_f32_32x32x16_bf16(__builtin_bit_cast(bf16x8, vw), pf, O[dt], 0, 0, 0);
                    }
                }
            const float il = 1.0f / l;
#pragma unroll
            for (int dt = 0; dt < 2; ++dt)
#pragma unroll
                for (int g = 0; g < 4; ++g) {
                    u32x2 w;
                    w[0] = pack2(O[dt][4 * g] * il, O[dt][4 * g + 1] * il);
                    w[1] = pack2(O[dt][4 * g + 2] * il, O[dt][4 * g + 3] * il);
                    *(u32x2*)(p.mixb + trow * DM + hq * 64 + dt * 32 + 8 * g + 4 * hh) = w;
                }
        }
    }
}

#define CV_ROWS 62
__device__ void ph_conv(const Params& p, unsigned char* smem, const int vb) {
    bf16_t* gl = (bf16_t*)smem;
    float* red = (float*)(smem + CV_ROWS * 1024);
    const int tid = threadIdx.x, lane = tid & 63, wid = tid >> 6;
    const f32x2 lg = *(const f32x2*)(p.cln_g + 2 * tid), lb = *(const f32x2*)(p.cln_b + 2 * tid);
    for (int u = vb; u < T_TOK / 32; u += gridDim.x) {
        const int tok0 = u * 32, s0 = tok0 & (SEQ - 1);
        __syncthreads();
#pragma unroll
        for (int bt = 0; bt < 2; ++bt) {
            u32x4 av[8], gv[8];
#pragma unroll
            for (int it = 0; it < 8; ++it) {
                const int ch = tid + (bt * 8 + it) * 256, row = min(ch >> 6, CV_ROWS - 1), k = ch & 63;
                const int rr = (s0 - 30 + row >= 0) ? row : 30;
                const bf16_t* base = p.hb + (size_t)(tok0 - 30 + rr) * INW + k * 8;
                av[it] = *(const u32x4*)(base + 768); gv[it] = *(const u32x4*)(base + 1280);
            }
#pragma unroll
            for (int it = 0; it < 8; ++it) {
                const int ch = tid + (bt * 8 + it) * 256, row = ch >> 6, k = ch & 63;
                const bool ok = (s0 - 30 + row >= 0);
                u32x4 o;
#pragma unroll
                for (int q = 0; q < 4; ++q) {
                    const float g0 = bflo(av[it][q]) / (1.0f + __expf(-bflo(gv[it][q]))), g1 = bfhi(av[it][q]) / (1.0f + __expf(-bfhi(gv[it][q])));
                    o[q] = ok ? pack2(g0, g1) : 0u;
                }
                if (row < CV_ROWS) *(u32x4*)(gl + row * 512 + k * 8) = o;
            }
        }
        __syncthreads();
        float w0[31], w1[31];
#pragma unroll
        for (int k = 0; k < 31; ++k) { const f32x2 wv = *(const f32x2*)(p.conv_w + k * 512 + 2 * tid); w0[k] = wv.x; w1[k] = wv.y; }
        const f32x2 bias = *(const f32x2*)(p.conv_b + 2 * tid);
#pragma unroll 1
        for (int jh = 0; jh < 2; ++jh) {
            float a0[16], a1[16];
#pragma unroll
            for (int jl = 0; jl < 16; ++jl) { a0[jl] = bias.x; a1[jl] = bias.y; }
            const bf16_t* gp = gl + (jh * 16) * 512 + 2 * tid;
#pragma unroll
            for (int il = 0; il < 46; ++il) {
                const unsigned gw = *(const unsigned*)(gp + il * 512);
                const float g0 = bflo(gw), g1 = bfhi(gw);
#pragma unroll
                for (int jl = 0; jl < 16; ++jl)
                    if (il - jl >= 0 && il - jl <= 30) { a0[jl] += w0[il - jl] * g0; a1[jl] += w1[il - jl] * g1; }
            }
            float v[32];
#pragma unroll
            for (int jl = 0; jl < 16; ++jl) { v[jl] = a0[jl] + a1[jl]; v[16 + jl] = a0[jl] * a0[jl] + a1[jl] * a1[jl]; }
#pragma unroll
            for (int st = 16; st >= 1; st >>= 1) {
                const bool up = (lane & st) != 0;
#pragma unroll
                for (int i2 = 0; i2 < st; ++i2) {
                    const float keep = up ? v[i2 + st] : v[i2], send = up ? v[i2] : v[i2 + st];
                    v[i2] = keep + __shfl_xor(send, st);
                }
            }
            const float tot = v[0] + __shfl_xor(v[0], 32);
            __syncthreads();
            if (lane < 32) red[wid * 32 + lane] = tot;
            __syncthreads();
#pragma unroll
            for (int jl = 0; jl < 16; ++jl) {
                const float sm = (red[jl] + red[32 + jl]) + (red[64 + jl] + red[96 + jl]);
                const float sq = (red[16 + jl] + red[48 + jl]) + (red[80 + jl] + red[112 + jl]);
                const float mu = sm * (1.0f / 512.0f);
                const float rstd = rsqrtf(fmaxf(sq * (1.0f / 512.0f) - mu * mu, 0.f) + LN_EPS);
                const float y0 = (a0[jl] - mu) * rstd * lg.x + lb.x, y1 = (a1[jl] - mu) * rstd * lg.y + lb.y;
                *(unsigned*)(p.mixb + (size_t)(tok0 + jh * 16 + jl) * DM + 512 + 2 * tid) = pack2(y0 / (1.0f + __expf(-y0)), y1 / (1.0f + __expf(-y1)));
            }
        }
    }
}

__device__ void ph_gemm_out(const Params& p, unsigned char* smem, const int vb) {
    const int ntn = DM / 128;
    const int tid = threadIdx.x, lane = tid & 63, wid = tid >> 6, wr = wid >> 1, wc = wid & 1, fr = lane & 15, fq = lane >> 4;
    for (int t = vb; t < (T_TOK / 128) * ntn; t += gridDim.x) {
        const int m0 = (t / ntn) * 128, n0 = (t % ntn) * 128;
        f32x4 acc[4][4]; zero_acc(acc);
        gemm128(p.mixb + (size_t)m0 * DM, DM, p.WoutT + (size_t)n0 * DM, DM, DM, smem, acc);
#pragma unroll
        for (int mi = 0; mi < 4; ++mi) {
            const int row = m0 + wr * 64 + mi * 16 + fr;
#pragma unroll
            for (int ni = 0; ni < 4; ++ni) {
                const int col = n0 + wc * 64 + ni * 16 + fq * 4;
                const f32x4 xv = *(const f32x4*)(p.x + (size_t)row * DM + col);
                *(f32x4*)(p.y1 + (size_t)row * DM + col) = xv * ALPHA + acc[mi][ni];
            }
        }
    }
}

__device__ __forceinline__ void ln_row(const float* __restrict__ src, const float* __restrict__ g, const float* __restrict__ bta,
                                       float* __restrict__ dstf, bf16_t* __restrict__ dstb, int lane) {
    f32x4 v[4]; float s = 0.f;
#pragma unroll
    for (int i = 0; i < 4; ++i) { v[i] = *(const f32x4*)(src + i * 256 + lane * 4); s += (v[i][0] + v[i][1]) + (v[i][2] + v[i][3]); }
    const float mu = wave_sum(s) * (1.0f / 1024.0f);
    float q = 0.f;
#pragma unroll
    for (int i = 0; i < 4; ++i) { const f32x4 d = v[i] - mu; q += (d[0] * d[0] + d[1] * d[1]) + (d[2] * d[2] + d[3] * d[3]); }
    const float rstd = rsqrtf(wave_sum(q) * (1.0f / 1024.0f) + LN_EPS);
#pragma unroll
    for (int i = 0; i < 4; ++i) {
        const f32x4 gg = *(const f32x4*)(g + i * 256 + lane * 4), bb = *(const f32x4*)(bta + i * 256 + lane * 4);
        const f32x4 y = (v[i] - mu) * rstd * gg + bb;
        *(f32x4*)(dstf + i * 256 + lane * 4) = y;
        if (dstb) { uint2 o; o.x = pack2(y[0], y[1]); o.y = pack2(y[2], y[3]); *(uint2*)(dstb + i * 256 + lane * 4) = o; }
    }
}
__device__ void ph_ln1(const Params& p, const int vb) {
    const int lane = threadIdx.x & 63, wid = threadIdx.x >> 6;
    for (int r = vb * 4 + wid; r < T_TOK; r += gridDim.x * 4)
        ln_row(p.y1 + (size_t)r * DM, p.ln1_g, p.ln1_b, p.x1 + (size_t)r * DM, p.x1b + (size_t)r * DM, lane);
}
__device__ void ph_ln2(const Params& p, const int vb) {
    const int lane = threadIdx.x & 63, wid = threadIdx.x >> 6;
    for (int r = vb * 4 + wid; r < T_TOK; r += gridDim.x * 4)
        ln_row(p.y1 + (size_t)r * DM, p.ln2_g, p.ln2_b, p.out + (size_t)r * DM, (bf16_t*)nullptr, lane);
}

#define QSTR 136
__device__ __forceinline__ int f2key(float f) { const int b = __float_as_int(f); return b ^ ((b >> 31) & 0x7fffffff); }
__device__ __forceinline__ float key2f(int k) { return __int_as_float(k ^ ((k >> 31) & 0x7fffffff)); }
__device__ __forceinline__ void sort16_desc(int (&a)[16]) {
#pragma unroll
    for (int lk = 1; lk <= 4; ++lk) {
#pragma unroll
        for (int lj = lk - 1; lj >= 0; --lj) {
            const int k = 1 << lk, j = 1 << lj;
#pragma unroll
            for (int i = 0; i < 16; ++i) {
                const int l = i ^ j;
                if (l > i) {
                    const int hi = max(a[i], a[l]), lo = min(a[i], a[l]);
                    if ((i & k) == 0) { a[i] = hi; a[l] = lo; } else { a[i] = lo; a[l] = hi; }
                }
            }
        }
    }
}
__device__ __forceinline__ void merge_top16(int (&a)[16], const int (&b)[16]) {
#pragma unroll
    for (int i = 0; i < 16; ++i) a[i] = max(a[i], b[15 - i]);
#pragma unroll
    for (int lj = 3; lj >= 0; --lj) {
        const int j = 1 << lj;
#pragma unroll
        for (int i = 0; i < 16; ++i) {
            const int l = i ^ j;
            if (l > i) { const int hi = max(a[i], a[l]), lo = min(a[i], a[l]); a[i] = hi; a[l] = lo; }
        }
    }
}
__device__ __forceinline__ void top16_of_64(int (&v)[4][16]) {
    sort16_desc(v[0]); sort16_desc(v[1]); sort16_desc(v[2]); sort16_desc(v[3]);
    merge_top16(v[0], v[1]); merge_top16(v[0], v[2]); merge_top16(v[0], v[3]);
}

__device__ __forceinline__ void route_half(const Params& p, unsigned char* smem, int m0, int hp, int (&K)[16]) {
    bf16_t* Qs = (bf16_t*)smem;
    bf16_t* Ks = (bf16_t*)(smem + 128 * QSTR * 2);
    const int tid = threadIdx.x, lane = tid & 63, wid = tid >> 6, wr = wid >> 1, wc = wid & 1, fr = lane & 15, fq = lane >> 4;
    const int r32 = lane & 31, hh = lane >> 5;
    {
        f32x4 acc[4][4]; zero_acc(acc);
        gemm128(p.x1b + (size_t)m0 * DM, DM, p.WqT + (size_t)hp * 128 * DM, DM, DM, smem, acc);
#pragma unroll
        for (int mi = 0; mi < 4; ++mi)
#pragma unroll
            for (int ni = 0; ni < 4; ++ni) {
                uint2 o; o.x = pack2(acc[mi][ni][0], acc[mi][ni][1]); o.y = pack2(acc[mi][ni][2], acc[mi][ni][3]);
                *(uint2*)(Qs + (wr * 64 + mi * 16 + fr) * QSTR + wc * 64 + ni * 16 + fq * 4) = o;
            }
    }
    {
        const bf16_t* kg = p.keysb + (size_t)hp * 128 * 128;
#pragma unroll
        for (int i = 0; i < 8; ++i) {
            const int c = tid + i * 256, row = c >> 4, kc = c & 15;
            *(u32x4*)(Ks + row * QSTR + kc * 8) = *(const u32x4*)(kg + row * 128 + kc * 8);
        }
    }
    __syncthreads();
    f32x16 S[4];
#pragma unroll
    for (int mt = 0; mt < 4; ++mt)
#pragma unroll
        for (int r = 0; r < 16; ++r) S[mt][r] = 0.f;
#pragma unroll
    for (int kk = 0; kk < 8; ++kk) {
        const bf16x8 b = *(const bf16x8*)(Qs + (wid * 32 + r32) * QSTR + kk * 16 + hh * 8);
#pragma unroll
        for (int mt = 0; mt < 4; ++mt) {
            const bf16x8 a = *(const bf16x8*)(Ks + (mt * 32 + r32) * QSTR + kk * 16 + hh * 8);
            S[mt] = __builtin_amdgcn_mfma_f32_32x32x16_bf16(a, b, S[mt], 0, 0, 0);
        }
    }
    __syncthreads();
    int v[4][16];
#pragma unroll
    for (int mt = 0; mt < 4; ++mt)
#pragma unroll
        for (int r = 0; r < 16; ++r) {
            const int n = mt * 32 + (r & 3) + 8 * (r >> 2) + 4 * hh;
            v[mt][r] = (f2key(S[mt][r]) & ~0x7F) | (127 - n);
        }
    top16_of_64(v);
    int o[16];
#pragma unroll
    for (int i = 0; i < 16; ++i) o[i] = __shfl_xor(v[0][i], 32);
    merge_top16(v[0], o);
#pragma unroll
    for (int i = 0; i < 16; ++i) K[i] = v[0][i];
}

__device__ void ph_route(const Params& p, unsigned char* smem, const int vb) {
    const int tid = threadIdx.x, lane = tid & 63, wid = tid >> 6;
    const int r32 = lane & 31, hh = lane >> 5;
    const int hmask = -hh;
    int* KL = (int*)(smem + (size_t)wid * 32 * QSTR * 2);
    for (int u = vb; u < (T_TOK / 128) * 8; u += gridDim.x) {
        const int m0 = (u >> 3) * 128, h = u & 7;
        __syncthreads();
        int K0[16], K1[16];
        route_half(p, smem, m0, h * 2 + 0, K0);
        route_half(p, smem, m0, h * 2 + 1, K1);
#pragma unroll
        for (int i = 0; i < 16; ++i) KL[r32 * 33 + hh * 16 + i] = K0[i] ^ ((K0[i] ^ K1[i]) & hmask);
        float s1[16], s2[16];
#pragma unroll
        for (int i = 0; i < 16; ++i) { s1[i] = key2f(K0[i] & ~0x7F); s2[i] = key2f(K1[i] & ~0x7F); }
        int c[4][16];
#pragma unroll
        for (int i = 0; i < 16; ++i)
#pragma unroll
            for (int j = 0; j < 16; ++j)
                if ((i + 1) * (j + 1) <= 16) {
                    constexpr int OFFS[16] = {0, 16, 24, 29, 33, 36, 38, 40, 42, 43, 44, 45, 46, 47, 48, 49};
                    const int q = OFFS[i] + j;
                    c[q >> 4][q & 15] = (f2key(s1[i] + s2[j]) & ~0xFF) | (255 - (i * 16 + j));
                }
#pragma unroll
        for (int qq = 50; qq < 64; ++qq) c[qq >> 4][qq & 15] = (int)0x80000000;
        top16_of_64(c);
        const float mx = key2f(c[0][0] & ~0xFF);
        float e[16]; float den = 0.f;
#pragma unroll
        for (int i = 0; i < 16; ++i) { e[i] = __expf(key2f(c[0][i] & ~0xFF) - mx); den += e[i]; }
        const float inv = 1.0f / den;
        const size_t ob = (size_t)(m0 + wid * 32 + r32) * 128 + h * 16 + hh * 8;
        int idv[8]; float gv[8];
#pragma unroll
        for (int qq = 0; qq < 8; ++qq) {
            const int F = c[0][qq] ^ ((c[0][qq] ^ c[0][8 + qq]) & hmask);
            gv[qq] = __int_as_float(__float_as_int(e[qq]) ^ ((__float_as_int(e[qq]) ^ __float_as_int(e[8 + qq])) & hmask)) * inv;
            const int idx = 255 - (F & 0xFF);
            const int k0 = KL[r32 * 33 + (idx >> 4)], k1 = KL[r32 * 33 + 16 + (idx & 15)];
            idv[qq] = (127 - (k0 & 0x7F)) * 128 + (127 - (k1 & 0x7F));
        }
        *(int4*)(p.ids + ob) = make_int4(idv[0], idv[1], idv[2], idv[3]);
        *(int4*)(p.ids + ob + 4) = make_int4(idv[4], idv[5], idv[6], idv[7]);
        *(float4*)(p.gates + ob) = make_float4(gv[0], gv[1], gv[2], gv[3]);
        *(float4*)(p.gates + ob + 4) = make_float4(gv[4], gv[5], gv[6], gv[7]);
    }
}

typedef __bf16 bf16x2_t __attribute__((ext_vector_type(2)));
__device__ __forceinline__ float dot2bf(unsigned a, unsigned b, float acc) {
    return __builtin_amdgcn_fdot2_f32_bf16(__builtin_bit_cast(bf16x2_t, a), __builtin_bit_cast(bf16x2_t, b), acc, false);
}
__device__ __forceinline__ f32x2 row_dot(const u32x4 w, const f32x2 (&x)[8], f32x2 acc) {
#pragma unroll
    for (int k = 0; k < 4; ++k) {
        acc = __builtin_amdgcn_cvt_pk_f32_fp8(w[k], false) * x[2 * k] + acc;
        acc = __builtin_amdgcn_cvt_pk_f32_fp8(w[k], true) * x[2 * k + 1] + acc;
    }
    return acc;
}
__device__ __forceinline__ float peer_u_round(const unsigned char* __restrict__ u8, int idv, const f32x2 (&x)[8], int lane) {
    u32x4 ra[8], rb[8];
#pragma unroll
    for (int j = 0; j < 8; ++j) {
        ra[j] = *(const u32x4*)(u8 + (size_t)__builtin_amdgcn_readlane(idv, j * 8) * DM + lane * 16);
        rb[j] = *(const u32x4*)(u8 + (size_t)__builtin_amdgcn_readlane(idv, j * 8 + 1) * DM + lane * 16);
    }
    float h = 0.f;
    const bool up16 = (lane & 16) != 0, up8 = (lane & 8) != 0;
#pragma unroll 1
    for (int c2 = 0; c2 < 4; ++c2) {
#pragma unroll
        for (int par = 0; par < 2; ++par) {
            const int c = c2 * 2 + par;
            float s[8];
#pragma unroll
            for (int j = 0; j < 8; ++j) {
                const f32x2 a = row_dot(par ? rb[j] : ra[j], x, (f32x2){0.f, 0.f});
                s[j] = a.x + a.y;
                if (c2 < 3) {
                    const u32x4 nw = *(const u32x4*)(u8 + (size_t)__builtin_amdgcn_readlane(idv, j * 8 + c + 2) * DM + lane * 16);
                    if (par) rb[j] = nw; else ra[j] = nw;
                }
            }
#pragma unroll
            for (int j = 0; j < 4; ++j) {
                auto r = __builtin_amdgcn_permlane32_swap(__float_as_uint(s[j]), __float_as_uint(s[j + 4]), false, false);
                s[j] = __uint_as_float(r[0]) + __uint_as_float(r[1]);
            }
#pragma unroll
            for (int j = 0; j < 2; ++j) {
                const float keep = up16 ? s[j + 2] : s[j], send = up16 ? s[j] : s[j + 2];
                s[j] = keep + __shfl_xor(send, 16);
            }
            float t;
            { const float keep = up8 ? s[1] : s[0], send = up8 ? s[0] : s[1]; t = keep + __shfl_xor(send, 8); }
            t += __shfl_xor(t, 4); t += __shfl_xor(t, 2); t += __shfl_xor(t, 1);
            if ((lane & 7) == c) h = t;
        }
    }
    return h;
}
#define PEER_DV 16
__device__ __forceinline__ void peer_v_round(const unsigned char* __restrict__ v8, int idv, float actv, f32x2 (&o)[8], int lane) {
    u32x4 rb[PEER_DV];
#pragma unroll
    for (int i = 0; i < PEER_DV; ++i) rb[i] = *(const u32x4*)(v8 + (size_t)__builtin_amdgcn_readlane(idv, i) * DM + lane * 16);
#pragma unroll 1
    for (int e0 = 0; e0 < 64; e0 += PEER_DV) {
#pragma unroll
        for (int i = 0; i < PEER_DV; ++i) {
            const float a = __int_as_float(__builtin_amdgcn_readlane(__float_as_int(actv), e0 + i));
            const f32x2 a2 = {a, a};
            const u32x4 w = rb[i];
#pragma unroll
            for (int k = 0; k < 4; ++k) {
                o[2 * k] = __builtin_amdgcn_cvt_pk_f32_fp8(w[k], false) * a2 + o[2 * k];
                o[2 * k + 1] = __builtin_amdgcn_cvt_pk_f32_fp8(w[k], true) * a2 + o[2 * k + 1];
            }
            if (e0 + PEER_DV < 64) rb[i] = *(const u32x4*)(v8 + (size_t)__builtin_amdgcn_readlane(idv, e0 + PEER_DV + i) * DM + lane * 16);
        }
    }
}
__device__ __forceinline__ float gelu_gate(float h, float g) { return 0.5f * h * (1.0f + erff(h * 0.70710678118654752f)) * g; }

__device__ void ph_peer(const Params& p, const int vb) {
    const int lane = threadIdx.x & 63;
    const int wid = __builtin_amdgcn_readfirstlane(threadIdx.x >> 6);
    for (int t = vb * 4 + wid; t < T_TOK; t += gridDim.x * 4) {
        const int id0 = p.ids[(size_t)t * 128 + lane], id1 = p.ids[(size_t)t * 128 + 64 + lane];
        const float g0 = p.gates[(size_t)t * 128 + lane], g1 = p.gates[(size_t)t * 128 + 64 + lane];
        const float su0 = p.su[id0], su1 = p.su[id1], sv0 = p.sv[id0], sv1 = p.sv[id1];
        const float* xr = p.x1 + (size_t)t * DM + lane * 16;
        f32x2 x[8];
        {
            const f32x4 a = *(const f32x4*)(xr), b = *(const f32x4*)(xr + 4), c = *(const f32x4*)(xr + 8), d = *(const f32x4*)(xr + 12);
            x[0] = (f32x2){a[0], a[1]}; x[1] = (f32x2){a[2], a[3]}; x[2] = (f32x2){b[0], b[1]}; x[3] = (f32x2){b[2], b[3]};
            x[4] = (f32x2){c[0], c[1]}; x[5] = (f32x2){c[2], c[3]}; x[6] = (f32x2){d[0], d[1]}; x[7] = (f32x2){d[2], d[3]};
        }
        const float h0 = peer_u_round(p.u8, id0, x, lane) * su0;
        const float h1 = peer_u_round(p.u8, id1, x, lane) * su1;
        const float a0 = gelu_gate(h0, g0) * sv0, a1 = gelu_gate(h1, g1) * sv1;
        f32x2 o[8];
#pragma unroll
        for (int i = 0; i < 8; ++i) o[i] = (f32x2){0.f, 0.f};
        peer_v_round(p.v8, id0, a0, o, lane);
        peer_v_round(p.v8, id1, a1, o, lane);
        float r[16];
#pragma unroll
        for (int i = 0; i < 8; ++i) { r[2 * i] = ALPHA * x[i].x + o[i].x; r[2 * i + 1] = ALPHA * x[i].y + o[i].y; }
        float* rr = p.y1 + (size_t)t * DM + lane * 16;
        *(f32x4*)(rr) = (f32x4){r[0], r[1], r[2], r[3]};
        *(f32x4*)(rr + 4) = (f32x4){r[4], r[5], r[6], r[7]};
        *(f32x4*)(rr + 8) = (f32x4){r[8], r[9], r[10], r[11]};
        *(f32x4*)(rr + 12) = (f32x4){r[12], r[13], r[14], r[15]};
        bf16_t* rbp = p.rb + (size_t)t * DM + lane * 16;
        u32x4 w0, w1;
        w0[0] = pack2(r[0], r[1]); w0[1] = pack2(r[2], r[3]); w0[2] = pack2(r[4], r[5]); w0[3] = pack2(r[6], r[7]);
        w1[0] = pack2(r[8], r[9]); w1[1] = pack2(r[10], r[11]); w1[2] = pack2(r[12], r[13]); w1[3] = pack2(r[14], r[15]);
        *(u32x4*)(rbp) = w0; *(u32x4*)(rbp + 8) = w1;
    }
}

__device__ __forceinline__ void ld_ids16(const int* __restrict__ q, int (&idv)[16]) {
    const int4* idp = (const int4*)q;
#pragma unroll
    for (int k = 0; k < 4; ++k) { const int4 v = idp[k]; idv[4 * k] = v.x; idv[4 * k + 1] = v.y; idv[4 * k + 2] = v.z; idv[4 * k + 3] = v.w; }
}
__device__ __forceinline__ void ld_f16(const float* __restrict__ q, float (&a)[16]) {
    const f32x4* ap = (const f32x4*)q;
#pragma unroll
    for (int k = 0; k < 4; ++k) { const f32x4 v = ap[k]; a[4 * k] = v[0]; a[4 * k + 1] = v[1]; a[4 * k + 2] = v[2]; a[4 * k + 3] = v[3]; }
}
__device__ void ph_peer_u(const Params& p, unsigned char* smem, const int vb) {
    const int lane = threadIdx.x & 63, wid = threadIdx.x >> 6, g = lane >> 3, c = lane & 7;
    const int nlb = gridDim.x >> 3, s = vb / nlb, lb = vb - s * nlb;
    const bool b2 = (lane & 4) != 0, b1 = (lane & 2) != 0, b0 = (lane & 1) != 0;
    const int cc = (b0 ? 2 : 0) + (b1 ? 4 : 0) + (b2 ? 8 : 0);
    const unsigned char* ubase = p.u8 + (size_t)s * (16384 * 128) + c * 16;
    const int stride = nlb * 4, t0 = lb * 4 + wid;
    const int ntok = (T_TOK - t0 + stride - 1) / stride;
    if (ntok <= 0) return;
    LDS_AS unsigned char* ring = (LDS_AS unsigned char*)smem + wid * 2048;
    const int* idg = p.ids + 2 * lane;
    const float* xg = p.x1 + s * 128 + 2 * lane;
#define PU_TOK(n) (t0 + ((n) < ntok ? (n) : ntok - 1) * stride)
#define PU_RAW_LD(n, ri, rx) do { const int _t = PU_TOK(n); ri = *(const u32x2*)(idg + (size_t)_t * 128); rx = *(const u32x2*)(xg + (size_t)_t * DM); } while (0)
#define PU_RAW_ST(n, ri, rx) do { LDS_AS unsigned char* _b = ring + ((n) & 1) * 1024; *(LDS_AS u32x2*)(_b + lane * 8) = ri; *(LDS_AS u32x2*)(_b + 512 + lane * 8) = rx; } while (0)
#define PU_IDS(n, idv) do { const LDS_AS u32x4* _q = (const LDS_AS u32x4*)(ring + ((n) & 1) * 1024 + g * 64); \
        _Pragma("unroll") for (int _k = 0; _k < 4; ++_k) { const u32x4 _v = _q[_k]; idv[4 * _k] = (int)_v[0]; idv[4 * _k + 1] = (int)_v[1]; idv[4 * _k + 2] = (int)_v[2]; idv[4 * _k + 3] = (int)_v[3]; } } while (0)
    u32x4 wA[8], wB[8]; u32x2 ri, rx;
    {
        u32x2 i0, x0, i1, x1v;
        PU_RAW_LD(0, i0, x0); PU_RAW_LD(1, i1, x1v); PU_RAW_LD(2, ri, rx);
        PU_RAW_ST(0, i0, x0); PU_RAW_ST(1, i1, x1v);
        int id0[16]; PU_IDS(0, id0);
#pragma unroll
        for (int i = 0; i < 8; ++i) wA[i] = *(const u32x4*)(ubase + (size_t)id0[i] * 128);
#pragma unroll
        for (int i = 0; i < 8; ++i) wB[i] = *(const u32x4*)(ubase + (size_t)id0[8 + i] * 128);
    }
#pragma unroll 1
    for (int n = 0; n < ntok; ++n) {
        const int t = t0 + n * stride;
        f32x2 x[8];
        {
            const LDS_AS f32x4* q = (const LDS_AS f32x4*)(ring + (n & 1) * 1024 + 512 + c * 64);
#pragma unroll
            for (int k = 0; k < 4; ++k) { const f32x4 v4 = q[k]; x[2 * k] = (f32x2){v4[0], v4[1]}; x[2 * k + 1] = (f32x2){v4[2], v4[3]}; }
        }
        int idn[16]; PU_IDS(n + 1, idn);
        float v[16];
#pragma unroll
        for (int i = 0; i < 8; ++i) { const f32x2 a = row_dot(wA[i], x, (f32x2){0.f, 0.f}); v[i] = a.x + a.y; }
#pragma unroll
        for (int i = 0; i < 8; ++i) wA[i] = *(const u32x4*)(ubase + (size_t)idn[i] * 128);
#pragma unroll
        for (int i = 0; i < 8; ++i) { const f32x2 a = row_dot(wB[i], x, (f32x2){0.f, 0.f}); v[8 + i] = a.x + a.y; }
#pragma unroll
        for (int i = 0; i < 8; ++i) wB[i] = *(const u32x4*)(ubase + (size_t)idn[8 + i] * 128);
        PU_RAW_ST(n + 2, ri, rx);
        PU_RAW_LD(n + 3, ri, rx);
#pragma unroll
        for (int i = 0; i < 8; ++i) { const float keep = b2 ? v[i + 8] : v[i], send = b2 ? v[i] : v[i + 8]; v[i] = keep + __shfl_xor(send, 4); }
#pragma unroll
        for (int i = 0; i < 4; ++i) { const float keep = b1 ? v[i + 4] : v[i], send = b1 ? v[i] : v[i + 4]; v[i] = keep + __shfl_xor(send, 2); }
#pragma unroll
        for (int i = 0; i < 2; ++i) { const float keep = b0 ? v[i + 2] : v[i], send = b0 ? v[i] : v[i + 2]; v[i] = keep + __shfl_xor(send, 1); }
        *(f32x2*)(p.hp + ((size_t)t * 8 + s) * 128 + g * 16 + cc) = (f32x2){v[0], v[1]};
    }
}
__device__ void ph_peer_act(const Params& p, const int vb) {
    const int lane = threadIdx.x & 63, wid = threadIdx.x >> 6;
    for (int t = vb * 4 + wid; t < T_TOK; t += gridDim.x * 4) {
        f32x2 h = {0.f, 0.f};
#pragma unroll
        for (int s = 0; s < 8; ++s) h += *(const f32x2*)(p.hp + ((size_t)t * 8 + s) * 128 + 2 * lane);
        const int2 id = *(const int2*)(p.ids + (size_t)t * 128 + 2 * lane);
        const f32x2 gt = *(const f32x2*)(p.gates + (size_t)t * 128 + 2 * lane);
        f32x2 a;
        a.x = gelu_gate(h.x * p.su[id.x], gt.x) * p.sv[id.x];
        a.y = gelu_gate(h.y * p.su[id.y], gt.y) * p.sv[id.y];
        *(f32x2*)(p.gates + (size_t)t * 128 + 2 * lane) = a;
    }
}
__device__ void ph_peer_v(const Params& p, unsigned char* smem, const int vb) {
    const int lane = threadIdx.x & 63, wid = threadIdx.x >> 6, g = lane >> 3, c = lane & 7;
    const int nlb = gridDim.x >> 3, s = vb / nlb, lb = vb - s * nlb;
    const bool b4 = (lane & 16) != 0, b3 = (lane & 8) != 0;
    const unsigned char* vbase = p.v8 + (size_t)s * (16384 * 128) + c * 16;
    const int stride = nlb * 4, t0 = lb * 4 + wid;
    const int ntok = (T_TOK - t0 + stride - 1) / stride;
    if (ntok <= 0) return;
    const int d0 = s * 128 + c * 16 + 2 * g;
    LDS_AS unsigned char* ring = (LDS_AS unsigned char*)smem + wid * 2048;
    const int* idg = p.ids + 2 * lane;
    const float* ag = p.gates + 2 * lane;
#define PV_RAW_LD(n, ri, rx) do { const int _t = PU_TOK(n); ri = *(const u32x2*)(idg + (size_t)_t * 128); rx = *(const u32x2*)(ag + (size_t)_t * 128); } while (0)
    u32x4 wA[8], wB[8]; u32x2 ri, rx;
    {
        u32x2 i0, x0, i1, x1v;
        PV_RAW_LD(0, i0, x0); PV_RAW_LD(1, i1, x1v); PV_RAW_LD(2, ri, rx);
        PU_RAW_ST(0, i0, x0); PU_RAW_ST(1, i1, x1v);
        int id0[16]; PU_IDS(0, id0);
#pragma unroll
        for (int i = 0; i < 8; ++i) wA[i] = *(const u32x4*)(vbase + (size_t)id0[i] * 128);
#pragma unroll
        for (int i = 0; i < 8; ++i) wB[i] = *(const u32x4*)(vbase + (size_t)id0[8 + i] * 128);
    }
#pragma unroll 1
    for (int n = 0; n < ntok; ++n) {
        const int t = t0 + n * stride;
        const f32x2 xv = *(const f32x2*)(p.x1 + (size_t)t * DM + d0);
        float ac[16];
        {
            const LDS_AS f32x4* q = (const LDS_AS f32x4*)(ring + (n & 1) * 1024 + 512 + g * 64);
#pragma unroll
            for (int k = 0; k < 4; ++k) { const f32x4 v4 = q[k]; ac[4 * k] = v4[0]; ac[4 * k + 1] = v4[1]; ac[4 * k + 2] = v4[2]; ac[4 * k + 3] = v4[3]; }
        }
        int idn[16]; PU_IDS(n + 1, idn);
        f32x2 acc[8];
#pragma unroll
        for (int k = 0; k < 8; ++k) acc[k] = (f32x2){0.f, 0.f};
#pragma unroll
        for (int i = 0; i < 8; ++i) {
            const f32x2 a2 = {ac[i], ac[i]};
#pragma unroll
            for (int k = 0; k < 4; ++k) {
                acc[2 * k] = __builtin_amdgcn_cvt_pk_f32_fp8(wA[i][k], false) * a2 + acc[2 * k];
                acc[2 * k + 1] = __builtin_amdgcn_cvt_pk_f32_fp8(wA[i][k], true) * a2 + acc[2 * k + 1];
            }
        }
#pragma unroll
        for (int i = 0; i < 8; ++i) wA[i] = *(const u32x4*)(vbase + (size_t)idn[i] * 128);
#pragma unroll
        for (int i = 0; i < 8; ++i) {
            const f32x2 a2 = {ac[8 + i], ac[8 + i]};
#pragma unroll
            for (int k = 0; k < 4; ++k) {
                acc[2 * k] = __builtin_amdgcn_cvt_pk_f32_fp8(wB[i][k], false) * a2 + acc[2 * k];
                acc[2 * k + 1] = __builtin_amdgcn_cvt_pk_f32_fp8(wB[i][k], true) * a2 + acc[2 * k + 1];
            }
        }
#pragma unroll
        for (int i = 0; i < 8; ++i) wB[i] = *(const u32x4*)(vbase + (size_t)idn[8 + i] * 128);
        PU_RAW_ST(n + 2, ri, rx);
        PV_RAW_LD(n + 3, ri, rx);
        float v[16];
#pragma unroll
        for (int k = 0; k < 8; ++k) { v[2 * k] = acc[k].x; v[2 * k + 1] = acc[k].y; }
#pragma unroll
        for (int j2 = 0; j2 < 8; ++j2) {
            auto r = __builtin_amdgcn_permlane32_swap(__float_as_uint(v[j2]), __float_as_uint(v[j2 + 8]), false, false);
            v[j2] = __uint_as_float(r[0]) + __uint_as_float(r[1]);
        }
#pragma unroll
        for (int j2 = 0; j2 < 4; ++j2) { const float keep = b4 ? v[j2 + 4] : v[j2], send = b4 ? v[j2] : v[j2 + 4]; v[j2] = keep + __shfl_xor(send, 16); }
#pragma unroll
        for (int j2 = 0; j2 < 2; ++j2) { const float keep = b3 ? v[j2 + 2] : v[j2], send = b3 ? v[j2] : v[j2 + 2]; v[j2] = keep + __shfl_xor(send, 8); }
        const float r0 = ALPHA * xv.x + v[0], r1 = ALPHA * xv.y + v[1];
        *(f32x2*)(p.y1 + (size_t)t * DM + d0) = (f32x2){r0, r1};
        *(unsigned*)(p.rb + (size_t)t * DM + d0) = pack2(r0, r1);
    }
}

__device__ void ph_gemm_ple(const Params& p, unsigned char* smem, const int vb) {
    const int ntn = DM / 128;
    const int tid = threadIdx.x, lane = tid & 63, wid = tid >> 6, wr = wid >> 1, wc = wid & 1, fr = lane & 15, fq = lane >> 4;
    for (int t = vb; t < (T_TOK / 128) * ntn; t += gridDim.x) {
        const int m0 = (t / ntn) * 128, n0 = (t % ntn) * 128;
        f32x4 acc[4][4], acc2[4][4]; zero_acc(acc); zero_acc(acc2);
        gemm128(p.pb + (size_t)m0 * 256, 256, p.WpT + (size_t)n0 * 256, 256, 256, smem, acc2);
        gemm128(p.rb + (size_t)m0 * DM, DM, p.WgT + (size_t)n0 * DM, DM, DM, smem, acc);
#pragma unroll
        for (int mi = 0; mi < 4; ++mi) {
            const int row = m0 + wr * 64 + mi * 16 + fr;
#pragma unroll
            for (int ni = 0; ni < 4; ++ni) {
                const int col = n0 + wc * 64 + ni * 16 + fq * 4;
                float* yp = p.y1 + (size_t)row * DM + col;
                f32x4 rv = *(const f32x4*)yp;
#pragma unroll
                for (int r = 0; r < 4; ++r) rv[r] += acc2[mi][ni][r] / (1.0f + __expf(-acc[mi][ni][r]));
                *(f32x4*)yp = rv;
            }
        }
    }
}

#define XB_TMO      128
#define XB_XCNT(j)  (256  + 64 * (j))
#define XB_XSUB(j)  (1280 + 64 * (j))
#define XB_XGEN(j)  (2304 + 64 * (j))
#define XB_TOP      3328
#define XB_TOPGEN   3392
#define XCD_BAR_WORDS 3456
#define XB_SPIN_CAP (1u << 20)
__device__ __forceinline__ unsigned xb_ld(unsigned* p)              { return __hip_atomic_load(p, __ATOMIC_RELAXED, __HIP_MEMORY_SCOPE_AGENT); }
__device__ __forceinline__ unsigned xb_add(unsigned* p, unsigned v) { return __hip_atomic_fetch_add(p, v, __ATOMIC_RELAXED, __HIP_MEMORY_SCOPE_AGENT); }
__device__ __forceinline__ unsigned xb_xcc_id() { return (unsigned)__builtin_amdgcn_s_getreg((3 << 11) | 20) & 0xFu; }
#define XB_SPIN(cond, bar) do { unsigned _sp = 0; while (cond) { __builtin_amdgcn_s_sleep(1); \
    if ((++_sp & 255u) == 0u) { if (xb_ld(&(bar)[XB_TMO])) break; if (_sp > XB_SPIN_CAP) { atomicAdd(&(bar)[XB_TMO], 1u); break; } } } } while (0)
struct XcdBarrier { unsigned* bar; unsigned x; volatile LDS_AS unsigned* st; };
__device__ __forceinline__ XcdBarrier xcd_barrier_post(unsigned* bar, volatile LDS_AS unsigned* st) {
    XcdBarrier b; b.bar = bar; b.x = xb_xcc_id(); b.st = st;
    if (threadIdx.x == 0) st[3] = xb_add(&bar[XB_XCNT(b.x)], 1u);
    return b;
}
__device__ __forceinline__ void xcd_barrier_complete(unsigned* bar, unsigned x, unsigned rank, unsigned& nloc, unsigned& nx, unsigned& vb) {
    const unsigned G = gridDim.x;
    unsigned sum, cnt, mine, sp = 0u; bool even;
    for (;;) {
        sum = 0u; cnt = 0u; mine = 0u; even = true;
#pragma unroll
        for (unsigned j = 0; j < 16; ++j) {
            const unsigned c = xb_ld(&bar[XB_XCNT(j)]); sum += c; cnt += (c > 0u) ? 1u : 0u; mine = (j == x) ? c : mine;
            even = even && (c == ((j < 8u) ? (G >> 3) : 0u));
        }
        if (sum == G) break;
        __builtin_amdgcn_s_sleep(1);
        if ((++sp & 255u) == 0u) { if (xb_ld(&bar[XB_TMO])) break; if (sp > XB_SPIN_CAP) { atomicAdd(&bar[XB_TMO], 1u); break; } }
    }
    nloc = mine > 0u ? mine : 1u; nx = cnt > 0u ? cnt : 1u;
    vb = (even && sum == G && (G & 7u) == 0u) ? (x * (G >> 3) + rank) : blockIdx.x;
}
__device__ __forceinline__ void xcd_barrier(const XcdBarrier& b) {
    asm volatile("s_waitcnt vmcnt(0)" ::: "memory");
    __syncthreads();
    if (threadIdx.x == 0) {
        unsigned* bar = b.bar;
        __builtin_amdgcn_s_waitcnt(0);
        unsigned nloc = b.st[0], nx = b.st[1];
        if (nloc == 0u) { unsigned vb; xcd_barrier_complete(bar, b.x, b.st[3], nloc, nx, vb); b.st[0] = nloc; b.st[1] = nx; b.st[2] = vb; }
        const unsigned old = xb_add(&bar[XB_XSUB(b.x)], 1u);
        const unsigned gen = old / nloc;
        if (old + 1u == (gen + 1u) * nloc) {
            __builtin_amdgcn_fence(__ATOMIC_RELEASE, "agent");
            asm volatile("s_waitcnt vmcnt(0)" ::: "memory");
            const unsigned og = xb_add(&bar[XB_TOP], 1u);
            const unsigned tg = og / nx;
            if (og + 1u == (tg + 1u) * nx) xb_add(&bar[XB_TOPGEN], 1u);
            else XB_SPIN(xb_ld(&bar[XB_TOPGEN]) == tg, bar);
            __builtin_amdgcn_fence(__ATOMIC_ACQUIRE, "agent");
            xb_add(&bar[XB_XGEN(b.x)], 1u);
            asm volatile("s_waitcnt vmcnt(0)" ::: "memory");
        } else {
            XB_SPIN(xb_ld(&bar[XB_XGEN(b.x)]) == gen, bar);
            __builtin_amdgcn_fence(__ATOMIC_ACQUIRE, "agent");
            asm volatile("s_waitcnt vmcnt(0)" ::: "memory");
        }
    }
    __syncthreads();
}

#define SMEM_PHASE (256 * ASTR * 2 * 2)
#define SMEM_BYTES (SMEM_PHASE + 16)
__global__ void __launch_bounds__(256, 2) mega(Params p) {
    __shared__ __attribute__((aligned(16))) unsigned char smem[SMEM_BYTES];
    volatile LDS_AS unsigned* st = (volatile LDS_AS unsigned*)(LDS_AS unsigned char*)(smem + SMEM_PHASE);
    if (threadIdx.x < 4) st[threadIdx.x] = 0u;
    __syncthreads();
    const XcdBarrier gb = xcd_barrier_post(p.bar, st);
    ph_prep(p, smem);            xcd_barrier(gb);
    const int vb = (int)st[2];
    ph_gemm_in(p, smem, vb);     xcd_barrier(gb);
    ph_attn(p, smem, vb);
    ph_conv(p, smem, vb);        xcd_barrier(gb);
    ph_gemm_out(p, smem, vb);    xcd_barrier(gb);
    ph_ln1(p, vb);               xcd_barrier(gb);
    ph_route(p, smem, vb);       xcd_barrier(gb);
    ph_peer_u(p, smem, vb);      xcd_barrier(gb);
    ph_peer_act(p, vb);          xcd_barrier(gb);
    ph_peer_v(p, smem, vb);      xcd_barrier(gb);
    ph_gemm_ple(p, smem, vb);    xcd_barrier(gb);
    ph_ln2(p, vb);
}

extern "C" void kernel_launch(void* const* d_in, const int* in_sizes, int n_in, void* d_out, int out_size, void* d_ws, size_t ws_size,
                              hipStream_t stream) {
    Params p{};
    p.x = (const float*)d_in[0]; p.p = (const float*)d_in[1]; p.pos = (const int*)d_in[2];
    p.w_in = (const float*)d_in[3]; p.sinks = (const float*)d_in[4]; p.conv_w = (const float*)d_in[5]; p.conv_b = (const float*)d_in[6];
    p.cln_g = (const float*)d_in[7]; p.cln_b = (const float*)d_in[8]; p.w_out = (const float*)d_in[9]; p.ln1_g = (const float*)d_in[10];
    p.ln1_b = (const float*)d_in[11]; p.wq = (const float*)d_in[12]; p.keys = (const float*)d_in[13]; p.pu = (const float*)d_in[14];
    p.pv = (const float*)d_in[15]; p.ple_proj = (const float*)d_in[16]; p.ple_gate = (const float*)d_in[17]; p.ln2_g = (const float*)d_in[18];
    p.ln2_b = (const float*)d_in[19];
    p.out = (float*)d_out;
    unsigned char* ws = (unsigned char*)d_ws;
    const size_t MiB = 1024 * 1024;
    p.y1 = (float*)(ws + 0 * MiB);
    p.hb = (bf16_t*)(ws + 128 * MiB);
    p.qb = (bf16_t*)(ws + 128 * MiB);
    p.hp = (float*)(ws + 128 * MiB);
    p.xb = (bf16_t*)(ws + 256 * MiB);
    p.x1b = (bf16_t*)(ws + 256 * MiB);
    p.mixb = (bf16_t*)(ws + 320 * MiB);
    p.tops = (float*)(ws + 320 * MiB);
    p.topi = (int*)(ws + 352 * MiB);
    p.rb = (bf16_t*)(ws + 320 * MiB);
    p.pb = (bf16_t*)(ws + 384 * MiB);
    p.ub = (bf16_t*)(ws + 400 * MiB);
    p.vb = (bf16_t*)(ws + 432 * MiB);
    p.u8 = (unsigned char*)(ws + 400 * MiB);
    p.v8 = (unsigned char*)(ws + 416 * MiB);
    p.su = (float*)(ws + 432 * MiB);
    p.sv = (float*)(ws + 433 * MiB);
    p.ids = (int*)(ws + 464 * MiB);
    p.gates = (float*)(ws + 480 * MiB);
    unsigned char* wb = ws + 496 * MiB;
    p.WinT = (bf16_t*)wb; wb += (size_t)INW * DM * 2;
    p.WoutT = (bf16_t*)wb; wb += (size_t)DM * DM * 2;
    p.WqT = (bf16_t*)wb; wb += (size_t)2048 * DM * 2;
    p.WgT = (bf16_t*)wb; wb += (size_t)DM * DM * 2;
    p.WpT = (bf16_t*)wb; wb += (size_t)DM * 256 * 2;
    p.keysb = (bf16_t*)wb; wb += (size_t)16 * 128 * 128 * 2;
    p.bar = (unsigned*)(ws + 510 * MiB);
    p.x1 = (float*)d_out;

    static int grid_blocks = 0;
    if (!grid_blocks) {
        int dev = 0, cus = 0, per_cu = 0;
        (void)hipGetDevice(&dev);
        (void)hipDeviceGetAttribute(&cus, hipDeviceAttributeMultiprocessorCount, dev);
        (void)hipOccupancyMaxActiveBlocksPerMultiprocessor(&per_cu, mega, 256, 0);
        if (per_cu > 2) per_cu = 2;
        grid_blocks = cus * per_cu;
    }
    (void)hipMemsetAsync(p.bar, 0, XCD_BAR_WORDS * sizeof(unsigned), stream);
    void* args[] = {&p};
    hipError_t e = hipLaunchCooperativeKernel((void*)mega, dim3(grid_blocks), dim3(256), args, 0, stream);
    if (e != hipSuccess) fprintf(stderr, "cooperative launch failed: %s (grid %d)\n", hipGetErrorString(e), grid_blocks);
}
```

```cpp
#include <hip/hip_runtime.h>
#include <hip/hip_cooperative_groups.h>
#include <stdint.h>
#include <cstdio>
namespace cg = cooperative_groups;

typedef unsigned short bf16_t;
typedef short bf16x8 __attribute__((ext_vector_type(8)));
typedef float f32x4 __attribute__((ext_vector_type(4)));
typedef unsigned u32x4 __attribute__((ext_vector_type(4)));
typedef float f32x2 __attribute__((ext_vector_type(2)));

#define T_TOK 32768
#define SEQ 2048
#define DM 1024
#define INW 1792
#define ALPHA 1.189207115002721f
#define LN_EPS 1e-5f

__device__ __forceinline__ bf16_t f2bf(float f) {
    unsigned u = __float_as_uint(f);
    u += 0x7fffu + ((u >> 16) & 1u);
    return (bf16_t)(u >> 16);
}
__device__ __forceinline__ float bf2f(bf16_t b) { return __uint_as_float(((unsigned)b) << 16); }
__device__ __forceinline__ float bflo(unsigned w) { return __uint_as_float(w << 16); }
__device__ __forceinline__ float bfhi(unsigned w) { return __uint_as_float(w & 0xffff0000u); }
__device__ __forceinline__ unsigned pack2(float a, float b) { return (unsigned)f2bf(a) | ((unsigned)f2bf(b) << 16); }

__device__ __forceinline__ float wave_sum(float v) {
#pragma unroll
    for (int o = 32; o >= 1; o >>= 1) v += __shfl_xor(v, o);
    return v;
}

struct Params {
    const float *x, *p; const int* pos;
    const float *w_in, *sinks, *conv_w, *conv_b, *cln_g, *cln_b, *w_out, *ln1_g, *ln1_b;
    const float *wq, *keys, *pu, *pv, *ple_proj, *ple_gate, *ln2_g, *ln2_b;
    float* out;
    bf16_t *xb, *pb, *WinT, *WoutT, *WqT, *WgT, *WpT, *keysb, *ub, *vb, *hb, *mixb, *x1b, *qb, *rb;
    float *y1, *x1, *tops, *gates, *su, *sv;
    bf16_t* hp;
    int *topi, *ids;
    unsigned char *u8, *v8;
    unsigned* bar;
};

__device__ void cvt_rows(const float* __restrict__ src, bf16_t* __restrict__ dst, size_t n) {
    const size_t nv = n / 8, gs = (size_t)gridDim.x * blockDim.x;
    for (size_t i = (size_t)blockIdx.x * blockDim.x + threadIdx.x; i < nv; i += 4 * gs) {
        f32x4 a[4], b[4];
#pragma unroll
        for (int q = 0; q < 4; ++q) { const size_t k = (i + q * gs < nv) ? i + q * gs : i; a[q] = ((const f32x4*)src)[2 * k]; b[q] = ((const f32x4*)src)[2 * k + 1]; }
#pragma unroll
        for (int q = 0; q < 4; ++q) {
            if (i + q * gs < nv) {
                u32x4 o; o[0] = pack2(a[q][0], a[q][1]); o[1] = pack2(a[q][2], a[q][3]); o[2] = pack2(b[q][0], b[q][1]); o[3] = pack2(b[q][2], b[q][3]);
                ((u32x4*)dst)[i + q * gs] = o;
            }
        }
    }
}
__device__ void transpose_cvt(const float* __restrict__ W, bf16_t* __restrict__ Wt, int K, int N, float* tile  ) {
    const int tk = K / 32, tn = N / 32;
    const int tx = threadIdx.x & 31, ty = threadIdx.x >> 5;
    for (int t = blockIdx.x; t < tk * tn; t += gridDim.x) {
        const int k0 = (t / tn) * 32, n0 = (t % tn) * 32;
        __syncthreads();
#pragma unroll
        for (int i = 0; i < 4; ++i) tile[(ty + i * 8) * 33 + tx] = W[(size_t)(k0 + ty + i * 8) * N + n0 + tx];
        __syncthreads();
#pragma unroll
        for (int i = 0; i < 4; ++i) Wt[(size_t)(n0 + ty + i * 8) * K + k0 + tx] = f2bf(tile[tx * 33 + ty + i * 8]);
    }
}

__device__ void cvt_table_fp8(const float* __restrict__ src, unsigned char* __restrict__ dst, float* __restrict__ scl, int rows) {
    const int lane = threadIdx.x & 63, wid = threadIdx.x >> 6;
    const int nw = gridDim.x * 4;
    for (int r0 = blockIdx.x * 4 + wid; r0 < rows; r0 += 4 * nw) {
        f32x4 v[4][4];
#pragma unroll
        for (int q = 0; q < 4; ++q) {
            const int r = (r0 + q * nw < rows) ? r0 + q * nw : r0;
            const float* sr = src + (size_t)r * DM + lane * 16;
#pragma unroll
            for (int k = 0; k < 4; ++k) v[q][k] = *(const f32x4*)(sr + 4 * k);
        }
#pragma unroll
        for (int q = 0; q < 4; ++q) {
            const int r = r0 + q * nw;
            float m = 0.f;
#pragma unroll
            for (int k = 0; k < 4; ++k)
#pragma unroll
                for (int i = 0; i < 4; ++i) m = fmaxf(m, fabsf(v[q][k][i]));
#pragma unroll
            for (int o = 32; o >= 1; o >>= 1) m = fmaxf(m, __shfl_xor(m, o));
            const float sc = (m > 0.f) ? 448.0f / m : 1.0f;
            u32x4 w;
#pragma unroll
            for (int k = 0; k < 4; ++k)
                w[k] = __builtin_amdgcn_cvt_pk_fp8_f32(v[q][k][2] * sc, v[q][k][3] * sc, __builtin_amdgcn_cvt_pk_fp8_f32(v[q][k][0] * sc, v[q][k][1] * sc, 0, false), true);
            if (r < rows) {
                *(u32x4*)(dst + (size_t)(lane >> 3) * (16384 * 128) + (size_t)r * 128 + (lane & 7) * 16) = w;
                if (lane == 0) scl[r] = (m > 0.f) ? m * (1.0f / 448.0f) : 1.0f;
            }
        }
    }
}
__device__ void ph_prep(const Params& p, unsigned char* smem) {
    float* tile = (float*)smem;
    cvt_rows(p.x, p.xb, (size_t)T_TOK * DM);
    cvt_rows(p.p, p.pb, (size_t)T_TOK * 256);
    cvt_table_fp8(p.pu, p.u8, p.su, 16384);
    cvt_table_fp8(p.pv, p.v8, p.sv, 16384);
    cvt_rows(p.keys, p.keysb, (size_t)16 * 128 * 128);
    transpose_cvt(p.w_in, p.WinT, DM, INW, tile);
    transpose_cvt(p.w_out, p.WoutT, DM, DM, tile);
    transpose_cvt(p.wq, p.WqT, DM, 2048, tile);
    transpose_cvt(p.ple_gate, p.WgT, DM, DM, tile);
    transpose_cvt(p.ple_proj, p.WpT, 256, DM, tile);
}

#define LDS_AS __attribute__((address_space(3)))
#define GEMM_STAGE 32768
__device__ __forceinline__ void gemm128(const bf16_t* __restrict__ A, int lda, const bf16_t* __restrict__ Bt, int ldb, int K,
                                        unsigned char* smem, f32x4 (&acc)[4][4]) {
    LDS_AS unsigned char* lds = (LDS_AS unsigned char*)smem;
    const int tid = threadIdx.x, lane = tid & 63, wid = __builtin_amdgcn_readfirstlane(tid >> 6);
    const int wr = wid >> 1, wc = wid & 1, fr = lane & 15, fq = lane >> 4;
    const int nk = K / 64;
    const int prow = lane >> 3, pc = (lane & 7) ^ prow;
    const bf16_t* gA = A + (size_t)(wid * 32 + prow) * lda + pc * 8;
    const bf16_t* gB = Bt + (size_t)(wid * 32 + prow) * ldb + pc * 8;
    const size_t a8 = (size_t)8 * lda, b8 = (size_t)8 * ldb;
#define GEMM_ISSUE(kt, st) do { \
        _Pragma("unroll") for (int _i = 0; _i < 4; ++_i) { \
            __builtin_amdgcn_global_load_lds((const unsigned*)(gA + _i * a8 + (size_t)(kt) * 64), (LDS_AS unsigned*)(lds + (st) * GEMM_STAGE + (wid * 4 + _i) * 1024), 16, 0, 0); \
            __builtin_amdgcn_global_load_lds((const unsigned*)(gB + _i * b8 + (size_t)(kt) * 64), (LDS_AS unsigned*)(lds + (st) * GEMM_STAGE + 16384 + (wid * 4 + _i) * 1024), 16, 0, 0); \
        } } while (0)
    const int swz0 = ((0 * 4 + fq) ^ (fr & 7)) * 16, swz1 = ((1 * 4 + fq) ^ (fr & 7)) * 16;
    const int aoff = (wr * 64 + fr) * 128, boff = 16384 + (wc * 64 + fr) * 128;
    GEMM_ISSUE(0, 0);
#pragma unroll 1
    for (int kt = 0; kt < nk; ++kt) {
        const int st = kt & 1;
        asm volatile("s_waitcnt vmcnt(0)" ::: "memory");
        __builtin_amdgcn_s_barrier();
        asm volatile("" ::: "memory");
        if (kt + 1 < nk) GEMM_ISSUE(kt + 1, st ^ 1);
        const LDS_AS unsigned char* sb = lds + st * GEMM_STAGE;
        bf16x8 af0[4], bf0[4], af1[4], bf1[4];
#pragma unroll
        for (int mi = 0; mi < 4; ++mi) af0[mi] = *(const LDS_AS bf16x8*)(sb + aoff + mi * 2048 + swz0);
#pragma unroll
        for (int ni = 0; ni < 4; ++ni) bf0[ni] = *(const LDS_AS bf16x8*)(sb + boff + ni * 2048 + swz0);
#pragma unroll
        for (int mi = 0; mi < 4; ++mi) af1[mi] = *(const LDS_AS bf16x8*)(sb + aoff + mi * 2048 + swz1);
#pragma unroll
        for (int ni = 0; ni < 4; ++ni) bf1[ni] = *(const LDS_AS bf16x8*)(sb + boff + ni * 2048 + swz1);
#pragma unroll
        for (int mi = 0; mi < 4; ++mi)
#pragma unroll
            for (int ni = 0; ni < 4; ++ni)
                acc[mi][ni] = __builtin_amdgcn_mfma_f32_16x16x32_bf16(bf0[ni], af0[mi], acc[mi][ni], 0, 0, 0);
#pragma unroll
        for (int mi = 0; mi < 4; ++mi)
#pragma unroll
            for (int ni = 0; ni < 4; ++ni)
                acc[mi][ni] = __builtin_amdgcn_mfma_f32_16x16x32_bf16(bf1[ni], af1[mi], acc[mi][ni], 0, 0, 0);
        __builtin_amdgcn_sched_group_barrier(0x100, 8, 0);
#pragma unroll
        for (int q = 0; q < 8; ++q) { __builtin_amdgcn_sched_group_barrier(0x008, 2, 0); __builtin_amdgcn_sched_group_barrier(0x100, 1, 0); }
        __builtin_amdgcn_sched_group_barrier(0x008, 16, 0);
        asm volatile("s_waitcnt lgkmcnt(0)" ::: "memory");
        __builtin_amdgcn_s_barrier();
        asm volatile("" ::: "memory");
    }
#undef GEMM_ISSUE
}
__device__ __forceinline__ void zero_acc(f32x4 (&acc)[4][4]) {
#pragma unroll
    for (int a = 0; a < 4; ++a)
#pragma unroll
        for (int b = 0; b < 4; ++b) acc[a][b] = (f32x4){0.f, 0.f, 0.f, 0.f};
}
#define GEMM_SMEM (2 * GEMM_STAGE)

__device__ void ph_gemm_in(const Params& p, unsigned char* smem, const int vb) {
    const int ntn = INW / 128;
    const int tid = threadIdx.x, lane = tid & 63, wid = tid >> 6, wr = wid >> 1, wc = wid & 1, fr = lane & 15, fq = lane >> 4;
    for (int t = vb; t < (T_TOK / 128) * ntn; t += gridDim.x) {
        const int m0 = (t / ntn) * 128, n0 = (t % ntn) * 128;
        f32x4 acc[4][4]; zero_acc(acc);
        gemm128(p.xb + (size_t)m0 * DM, DM, p.WinT + (size_t)n0 * DM, DM, DM, smem, acc);
#pragma unroll
        for (int mi = 0; mi < 4; ++mi) {
            const int row = m0 + wr * 64 + mi * 16 + fr;
            const float posf = (float)p.pos[row];
#pragma unroll
            for (int ni = 0; ni < 4; ++ni) {
                const int col0 = n0 + wc * 64 + ni * 16;
                f32x4 v = acc[mi][ni];
                if (col0 < 640 && (col0 & 63) == 0) {
#pragma unroll
                    for (int r = 0; r < 4; ++r) {
                        const float other = __shfl_xor(v[r], 32);
                        const int j = (fq & 1) * 4 + r;
                        const float inv = powf(500000.0f, -(float)j * 0.125f);
                        float sn, cs; sincosf(posf * inv, &sn, &cs);
                        v[r] = (fq < 2) ? (v[r] * cs - other * sn) : (v[r] * cs + other * sn);
                    }
                }
                uint2 o; o.x = pack2(v[0], v[1]); o.y = pack2(v[2], v[3]);
                *(uint2*)(p.hb + (size_t)row * INW + col0 + fq * 4) = o;
            }
        }
    }
}

#define ASTR 72
#define VSTR 260
typedef float f32x16 __attribute__((ext_vector_type(16)));
typedef unsigned u32x2 __attribute__((ext_vector_type(2)));
__device__ void ph_attn(const Params& p, unsigned char* smem, const int vb) {
    bf16_t* sK = (bf16_t*)smem;
    bf16_t* sVt = sK + 256 * ASTR;
    const int tid = threadIdx.x, lane = tid & 63, wid = tid >> 6, r32 = lane & 31, hh = lane >> 5;
    const float C1 = 0.125f * 1.4426950408889634f, LOG2E = 1.4426950408889634f;
    for (int u = vb; u < 16 * 16 * 2; u += gridDim.x) {
        const int kvh = u & 1, nb = (u >> 1) & 15, b = u >> 5;
        __syncthreads();
        for (int c = tid; c < 256 * 8; c += 256) {
            const int li = c >> 3, kc = c & 7;
            const int pos = nb * 128 - 128 + li;
            u32x4 kv = {0u, 0u, 0u, 0u}, vv = {0u, 0u, 0u, 0u};
            if (pos >= 0) {
                const bf16_t* base = p.hb + (size_t)(b * SEQ + pos) * INW;
                kv = *(const u32x4*)(base + 512 + kvh * 64 + kc * 8);
                vv = *(const u32x4*)(base + 640 + kvh * 64 + kc * 8);
            }
            *(u32x4*)(sK + li * ASTR + kc * 8) = kv;
#pragma unroll
            for (int i = 0; i < 4; ++i) {
                sVt[(kc * 8 + 2 * i) * VSTR + li] = (bf16_t)(vv[i] & 0xffffu);
                sVt[(kc * 8 + 2 * i + 1) * VSTR + li] = (bf16_t)(vv[i] >> 16);
            }
        }
        __syncthreads();
        const int hq = kvh * 4 + wid;
        const float sink2 = p.sinks[hq] * LOG2E;
#pragma unroll 1
        for (int qt = 0; qt < 4; ++qt) {
            const size_t trow = (size_t)(b * SEQ + nb * 128 + qt * 32 + r32);
            bf16x8 qf[4];
#pragma unroll
            for (int ks = 0; ks < 4; ++ks) qf[ks] = *(const bf16x8*)(p.hb + trow * INW + hq * 64 + ks * 16 + hh * 8);
            f32x16 S[5];
#pragma unroll
            for (int j = 0; j < 5; ++j) {
#pragma unroll
                for (int r = 0; r < 16; ++r) S[j][r] = 0.f;
#pragma unroll
                for (int ks = 0; ks < 4; ++ks) {
                    const bf16x8 a = *(const bf16x8*)(sK + ((qt + j) * 32 + r32) * ASTR + ks * 16 + hh * 8);
                    S[j] = __builtin_amdgcn_mfma_f32_32x32x16_bf16(a, qf[ks], S[j], 0, 0, 0);
                }
            }
            float m2 = sink2;
#pragma unroll
            for (int j = 0; j < 5; ++j) {
                const bool tile_ok = (nb > 0) || (qt + j >= 4);
#pragma unroll
                for (int r = 0; r < 16; ++r) {
                    const int kl = (r & 3) + 8 * (r >> 2) + 4 * hh;
                    bool ok = tile_ok;
                    if (j == 0) ok = ok && (kl > r32);
                    if (j == 4) ok = ok && (kl <= r32);
                    const float t = ok ? S[j][r] * C1 : -1.0e30f;
                    S[j][r] = t;
                    m2 = fmaxf(m2, t);
                }
            }
            m2 = fmaxf(m2, __shfl_xor(m2, 32));
            float l = 0.f;
#pragma unroll
            for (int j = 0; j < 5; ++j)
#pragma unroll
                for (int r = 0; r < 16; ++r) { const float e = __builtin_amdgcn_exp2f(S[j][r] - m2); S[j][r] = e; l += e; }
            l += __shfl_xor(l, 32);
            l += __builtin_amdgcn_exp2f(sink2 - m2);
            f32x16 O[2];
#pragma unroll
            for (int dt = 0; dt < 2; ++dt)
#pragma unroll
                for (int r = 0; r < 16; ++r) O[dt][r] = 0.f;
#pragma unroll
            for (int j = 0; j < 5; ++j)
#pragma unroll
                for (int s2 = 0; s2 < 2; ++s2) {
                    u32x4 pw;
#pragma unroll
                    for (int k = 0; k < 4; ++k) pw[k] = pack2(S[j][8 * s2 + 2 * k], S[j][8 * s2 + 2 * k + 1]);
                    const bf16x8 pf = __builtin_bit_cast(bf16x8, pw);
                    const int kbase = (qt + j) * 32 + 16 * s2 + 4 * hh;
#pragma unroll
                    for (int dt = 0; dt < 2; ++dt) {
                        const bf16_t* vp = sVt + (dt * 32 + r32) * VSTR + kbase;
                        const u32x2 v0 = *(const u32x2*)(vp), v1 = *(const u32x2*)(vp + 8);
                        const u32x4 vw = {v0[0], v0[1], v1[0], v1[1]};
                        O[dt] = __builtin_amdgcn_mfma_f32_32x32x16_bf16(__builtin_bit_cast(bf16x8, vw), pf, O[dt], 0, 0, 0);
                    }
                }
            const float il = 1.0f / l;
#pragma unroll
            for (int dt = 0; dt < 2; ++dt)
#pragma unroll
                for (int g = 0; g < 4; ++g) {
                    u32x2 w;
                    w[0] = pack2(O[dt][4 * g] * il, O[dt][4 * g + 1] * il);
                    w[1] = pack2(O[dt][4 * g + 2] * il, O[dt][4 * g + 3] * il);
                    *(u32x2*)(p.mixb + trow * DM + hq * 64 + dt * 32 + 8 * g + 4 * hh) = w;
                }
        }
    }
}

#define CV_ROWS 62
__device__ void ph_conv(const Params& p, unsigned char* smem, const int vb) {
    bf16_t* gl = (bf16_t*)smem;
    float* red = (float*)(smem + CV_ROWS * 1024);
    const int tid = threadIdx.x, lane = tid & 63, wid = tid >> 6;
    const f32x2 lg = *(const f32x2*)(p.cln_g + 2 * tid), lb = *(const f32x2*)(p.cln_b + 2 * tid);
    for (int u = vb; u < T_TOK / 32; u += gridDim.x) {
        const int tok0 = u * 32, s0 = tok0 & (SEQ - 1);
        __syncthreads();
#pragma unroll
        for (int bt = 0; bt < 2; ++bt) {
            u32x4 av[8], gv[8];
#pragma unroll
            for (int it = 0; it < 8; ++it) {
                const int ch = tid + (bt * 8 + it) * 256, row = min(ch >> 6, CV_ROWS - 1), k = ch & 63;
                const int rr = (s0 - 30 + row >= 0) ? row : 30;
                const bf16_t* base = p.hb + (size_t)(tok0 - 30 + rr) * INW + k * 8;
                av[it] = *(const u32x4*)(base + 768); gv[it] = *(const u32x4*)(base + 1280);
            }
#pragma unroll
            for (int it = 0; it < 8; ++it) {
                const int ch = tid + (bt * 8 + it) * 256, row = ch >> 6, k = ch & 63;
                const bool ok = (s0 - 30 + row >= 0);
                u32x4 o;
#pragma unroll
                for (int q = 0; q < 4; ++q) {
                    const float g0 = bflo(av[it][q]) / (1.0f + __expf(-bflo(gv[it][q]))), g1 = bfhi(av[it][q]) / (1.0f + __expf(-bfhi(gv[it][q])));
                    o[q] = ok ? pack2(g0, g1) : 0u;
                }
                if (row < CV_ROWS) *(u32x4*)(gl + row * 512 + k * 8) = o;
            }
        }
        __syncthreads();
        float w0[31], w1[31];
#pragma unroll
        for (int k = 0; k < 31; ++k) { const f32x2 wv = *(const f32x2*)(p.conv_w + k * 512 + 2 * tid); w0[k] = wv.x; w1[k] = wv.y; }
        const f32x2 bias = *(const f32x2*)(p.conv_b + 2 * tid);
#pragma unroll 1
        for (int jh = 0; jh < 2; ++jh) {
            float a0[16], a1[16];
#pragma unroll
            for (int jl = 0; jl < 16; ++jl) { a0[jl] = bias.x; a1[jl] = bias.y; }
            const bf16_t* gp = gl + (jh * 16) * 512 + 2 * tid;
#pragma unroll
            for (int il = 0; il < 46; ++il) {
                const unsigned gw = *(const unsigned*)(gp + il * 512);
                const float g0 = bflo(gw), g1 = bfhi(gw);
#pragma unroll
                for (int jl = 0; jl < 16; ++jl)
                    if (il - jl >= 0 && il - jl <= 30) { a0[jl] += w0[il - jl] * g0; a1[jl] += w1[il - jl] * g1; }
            }
            float v[32];
#pragma unroll
            for (int jl = 0; jl < 16; ++jl) { v[jl] = a0[jl] + a1[jl]; v[16 + jl] = a0[jl] * a0[jl] + a1[jl] * a1[jl]; }
#pragma unroll
            for (int st = 16; st >= 1; st >>= 1) {
                const bool up = (lane & st) != 0;
#pragma unroll
                for (int i2 = 0; i2 < st; ++i2) {
                    const float keep = up ? v[i2 + st] : v[i2], send = up ? v[i2] : v[i2 + st];
                    v[i2] = keep + __shfl_xor(send, st);
                }
            }
            const float tot = v[0] + __shfl_xor(v[0], 32);
            __syncthreads();
            if (lane < 32) red[wid * 32 + lane] = tot;
            __syncthreads();
#pragma unroll
            for (int jl = 0; jl < 16; ++jl) {
                const float sm = (red[jl] + red[32 + jl]) + (red[64 + jl] + red[96 + jl]);
                const float sq = (red[16 + jl] + red[48 + jl]) + (red[80 + jl] + red[112 + jl]);
                const float mu = sm * (1.0f / 512.0f);
                const float rstd = rsqrtf(fmaxf(sq * (1.0f / 512.0f) - mu * mu, 0.f) + LN_EPS);
                const float y0 = (a0[jl] - mu) * rstd * lg.x + lb.x, y1 = (a1[jl] - mu) * rstd * lg.y + lb.y;
                *(unsigned*)(p.mixb + (size_t)(tok0 + jh * 16 + jl) * DM + 512 + 2 * tid) = pack2(y0 / (1.0f + __expf(-y0)), y1 / (1.0f + __expf(-y1)));
            }
        }
    }
}

__device__ void ph_gemm_out(const Params& p, unsigned char* smem, const int vb) {
    const int ntn = DM / 128;
    const int tid = threadIdx.x, lane = tid & 63, wid = tid >> 6, wr = wid >> 1, wc = wid & 1, fr = lane & 15, fq = lane >> 4;
    for (int t = vb; t < (T_TOK / 128) * ntn; t += gridDim.x) {
        const int m0 = (t / ntn) * 128, n0 = (t % ntn) * 128;
        f32x4 acc[4][4]; zero_acc(acc);
        gemm128(p.mixb + (size_t)m0 * DM, DM, p.WoutT + (size_t)n0 * DM, DM, DM, smem, acc);
#pragma unroll
        for (int mi = 0; mi < 4; ++mi) {
            const int row = m0 + wr * 64 + mi * 16 + fr;
#pragma unroll
            for (int ni = 0; ni < 4; ++ni) {
                const int col = n0 + wc * 64 + ni * 16 + fq * 4;
                const f32x4 xv = *(const f32x4*)(p.x + (size_t)row * DM + col);
                *(f32x4*)(p.y1 + (size_t)row * DM + col) = xv * ALPHA + acc[mi][ni];
            }
        }
    }
}

__device__ __forceinline__ void ln_row(const float* __restrict__ src, const float* __restrict__ g, const float* __restrict__ bta,
                                       float* __restrict__ dstf, bf16_t* __restrict__ dstb, int lane) {
    f32x4 v[4]; float s = 0.f;
#pragma unroll
    for (int i = 0; i < 4; ++i) { v[i] = *(const f32x4*)(src + i * 256 + lane * 4); s += (v[i][0] + v[i][1]) + (v[i][2] + v[i][3]); }
    const float mu = wave_sum(s) * (1.0f / 1024.0f);
    float q = 0.f;
#pragma unroll
    for (int i = 0; i < 4; ++i) { const f32x4 d = v[i] - mu; q += (d[0] * d[0] + d[1] * d[1]) + (d[2] * d[2] + d[3] * d[3]); }
    const float rstd = rsqrtf(wave_sum(q) * (1.0f / 1024.0f) + LN_EPS);
#pragma unroll
    for (int i = 0; i < 4; ++i) {
        const f32x4 gg = *(const f32x4*)(g + i * 256 + lane * 4), bb = *(const f32x4*)(bta + i * 256 + lane * 4);
        const f32x4 y = (v[i] - mu) * rstd * gg + bb;
        if (dstf) *(f32x4*)(dstf + i * 256 + lane * 4) = y;
        if (dstb) { uint2 o; o.x = pack2(y[0], y[1]); o.y = pack2(y[2], y[3]); *(uint2*)(dstb + i * 256 + lane * 4) = o; }
    }
}
__device__ void ph_ln1(const Params& p, const int vb) {
    const int lane = threadIdx.x & 63, wid = threadIdx.x >> 6;
    for (int r = vb * 4 + wid; r < T_TOK; r += gridDim.x * 4)
        ln_row(p.y1 + (size_t)r * DM, p.ln1_g, p.ln1_b, (float*)nullptr, p.x1b + (size_t)r * DM, lane);
}
__device__ void ph_ln2(const Params& p, const int vb) {
    const int lane = threadIdx.x & 63, wid = threadIdx.x >> 6;
    for (int r = vb * 4 + wid; r < T_TOK; r += gridDim.x * 4)
        ln_row(p.out + (size_t)r * DM, p.ln2_g, p.ln2_b, p.out + (size_t)r * DM, (bf16_t*)nullptr, lane);
}

#define QSTR 136
__device__ __forceinline__ int f2key(float f) { const int b = __float_as_int(f); return b ^ ((b >> 31) & 0x7fffffff); }
__device__ __forceinline__ float key2f(int k) { return __int_as_float(k ^ ((k >> 31) & 0x7fffffff)); }
__device__ __forceinline__ void sort16_desc(int (&a)[16]) {
#pragma unroll
    for (int lk = 1; lk <= 4; ++lk) {
#pragma unroll
        for (int lj = lk - 1; lj >= 0; --lj) {
            const int k = 1 << lk, j = 1 << lj;
#pragma unroll
            for (int i = 0; i < 16; ++i) {
                const int l = i ^ j;
                if (l > i) {
                    const int hi = max(a[i], a[l]), lo = min(a[i], a[l]);
                    if ((i & k) == 0) { a[i] = hi; a[l] = lo; } else { a[i] = lo; a[l] = hi; }
                }
            }
        }
    }
}
__device__ __forceinline__ void merge_top16(int (&a)[16], const int (&b)[16]) {
#pragma unroll
    for (int i = 0; i < 16; ++i) a[i] = max(a[i], b[15 - i]);
#pragma unroll
    for (int lj = 3; lj >= 0; --lj) {
        const int j = 1 << lj;
#pragma unroll
        for (int i = 0; i < 16; ++i) {
            const int l = i ^ j;
            if (l > i) { const int hi = max(a[i], a[l]), lo = min(a[i], a[l]); a[i] = hi; a[l] = lo; }
        }
    }
}
__device__ __forceinline__ void top16_of_64(int (&v)[4][16]) {
    sort16_desc(v[0]); sort16_desc(v[1]); sort16_desc(v[2]); sort16_desc(v[3]);
    merge_top16(v[0], v[1]); merge_top16(v[0], v[2]); merge_top16(v[0], v[3]);
}

__device__ __forceinline__ void route_half(const Params& p, unsigned char* smem, int m0, int hp, int (&K)[16]) {
    bf16_t* Qs = (bf16_t*)smem;
    bf16_t* Ks = (bf16_t*)(smem + 128 * QSTR * 2);
    const int tid = threadIdx.x, lane = tid & 63, wid = tid >> 6, wr = wid >> 1, wc = wid & 1, fr = lane & 15, fq = lane >> 4;
    const int r32 = lane & 31, hh = lane >> 5;
    {
        f32x4 acc[4][4]; zero_acc(acc);
        gemm128(p.x1b + (size_t)m0 * DM, DM, p.WqT + (size_t)hp * 128 * DM, DM, DM, smem, acc);
#pragma unroll
        for (int mi = 0; mi < 4; ++mi)
#pragma unroll
            for (int ni = 0; ni < 4; ++ni) {
                uint2 o; o.x = pack2(acc[mi][ni][0], acc[mi][ni][1]); o.y = pack2(acc[mi][ni][2], acc[mi][ni][3]);
                *(uint2*)(Qs + (wr * 64 + mi * 16 + fr) * QSTR + wc * 64 + ni * 16 + fq * 4) = o;
            }
    }
    {
        const bf16_t* kg = p.keysb + (size_t)hp * 128 * 128;
#pragma unroll
        for (int i = 0; i < 8; ++i) {
            const int c = tid + i * 256, row = c >> 4, kc = c & 15;
            *(u32x4*)(Ks + row * QSTR + kc * 8) = *(const u32x4*)(kg + row * 128 + kc * 8);
        }
    }
    __syncthreads();
    f32x16 S[4];
#pragma unroll
    for (int mt = 0; mt < 4; ++mt)
#pragma unroll
        for (int r = 0; r < 16; ++r) S[mt][r] = 0.f;
#pragma unroll
    for (int kk = 0; kk < 8; ++kk) {
        const bf16x8 b = *(const bf16x8*)(Qs + (wid * 32 + r32) * QSTR + kk * 16 + hh * 8);
#pragma unroll
        for (int mt = 0; mt < 4; ++mt) {
            const bf16x8 a = *(const bf16x8*)(Ks + (mt * 32 + r32) * QSTR + kk * 16 + hh * 8);
            S[mt] = __builtin_amdgcn_mfma_f32_32x32x16_bf16(a, b, S[mt], 0, 0, 0);
        }
    }
    __syncthreads();
    int v[4][16];
#pragma unroll
    for (int mt = 0; mt < 4; ++mt)
#pragma unroll
        for (int r = 0; r < 16; ++r) {
            const int n = mt * 32 + (r & 3) + 8 * (r >> 2) + 4 * hh;
            v[mt][r] = (f2key(S[mt][r]) & ~0x7F) | (127 - n);
        }
    top16_of_64(v);
    int o[16];
#pragma unroll
    for (int i = 0; i < 16; ++i) o[i] = __shfl_xor(v[0][i], 32);
    merge_top16(v[0], o);
#pragma unroll
    for (int i = 0; i < 16; ++i) K[i] = v[0][i];
}

__device__ void ph_route(const Params& p, unsigned char* smem, const int vb) {
    const int tid = threadIdx.x, lane = tid & 63, wid = tid >> 6;
    const int r32 = lane & 31, hh = lane >> 5;
    const int hmask = -hh;
    int* KL = (int*)(smem + (size_t)wid * 32 * QSTR * 2);
    for (int u = vb; u < (T_TOK / 128) * 8; u += gridDim.x) {
        const int m0 = (u >> 3) * 128, h = u & 7;
        __syncthreads();
        int K0[16], K1[16];
        route_half(p, smem, m0, h * 2 + 0, K0);
        route_half(p, smem, m0, h * 2 + 1, K1);
#pragma unroll
        for (int i = 0; i < 16; ++i) KL[r32 * 33 + hh * 16 + i] = K0[i] ^ ((K0[i] ^ K1[i]) & hmask);
        float s1[16], s2[16];
#pragma unroll
        for (int i = 0; i < 16; ++i) { s1[i] = key2f(K0[i] & ~0x7F); s2[i] = key2f(K1[i] & ~0x7F); }
        int c[4][16];
#pragma unroll
        for (int i = 0; i < 16; ++i)
#pragma unroll
            for (int j = 0; j < 16; ++j)
                if ((i + 1) * (j + 1) <= 16) {
                    constexpr int OFFS[16] = {0, 16, 24, 29, 33, 36, 38, 40, 42, 43, 44, 45, 46, 47, 48, 49};
                    const int q = OFFS[i] + j;
                    c[q >> 4][q & 15] = (f2key(s1[i] + s2[j]) & ~0xFF) | (255 - (i * 16 + j));
                }
#pragma unroll
        for (int qq = 50; qq < 64; ++qq) c[qq >> 4][qq & 15] = (int)0x80000000;
        top16_of_64(c);
        const float mx = key2f(c[0][0] & ~0xFF);
        float e[16]; float den = 0.f;
#pragma unroll
        for (int i = 0; i < 16; ++i) { e[i] = __expf(key2f(c[0][i] & ~0xFF) - mx); den += e[i]; }
        const float inv = 1.0f / den;
        const size_t ob = (size_t)(m0 + wid * 32 + r32) * 128 + h * 16 + hh * 8;
        int idv[8]; float gv[8];
#pragma unroll
        for (int qq = 0; qq < 8; ++qq) {
            const int F = c[0][qq] ^ ((c[0][qq] ^ c[0][8 + qq]) & hmask);
            gv[qq] = __int_as_float(__float_as_int(e[qq]) ^ ((__float_as_int(e[qq]) ^ __float_as_int(e[8 + qq])) & hmask)) * inv;
            const int idx = 255 - (F & 0xFF);
            const int k0 = KL[r32 * 33 + (idx >> 4)], k1 = KL[r32 * 33 + 16 + (idx & 15)];
            idv[qq] = (127 - (k0 & 0x7F)) * 128 + (127 - (k1 & 0x7F));
        }
        *(int4*)(p.ids + ob) = make_int4(idv[0], idv[1], idv[2], idv[3]);
        *(int4*)(p.ids + ob + 4) = make_int4(idv[4], idv[5], idv[6], idv[7]);
        *(float4*)(p.gates + ob) = make_float4(gv[0], gv[1], gv[2], gv[3]);
        *(float4*)(p.gates + ob + 4) = make_float4(gv[4], gv[5], gv[6], gv[7]);
    }
}

typedef __bf16 bf16x2_t __attribute__((ext_vector_type(2)));
__device__ __forceinline__ float dot2bf(unsigned a, unsigned b, float acc) {
    return __builtin_amdgcn_fdot2_f32_bf16(__builtin_bit_cast(bf16x2_t, a), __builtin_bit_cast(bf16x2_t, b), acc, false);
}
__device__ __forceinline__ f32x2 row_dot(const u32x4 w, const f32x2 (&x)[8], f32x2 acc) {
#pragma unroll
    for (int k = 0; k < 4; ++k) {
        acc = __builtin_amdgcn_cvt_pk_f32_fp8(w[k], false) * x[2 * k] + acc;
        acc = __builtin_amdgcn_cvt_pk_f32_fp8(w[k], true) * x[2 * k + 1] + acc;
    }
    return acc;
}
__device__ __forceinline__ float peer_u_round(const unsigned char* __restrict__ u8, int idv, const f32x2 (&x)[8], int lane) {
    u32x4 ra[8], rb[8];
#pragma unroll
    for (int j = 0; j < 8; ++j) {
        ra[j] = *(const u32x4*)(u8 + (size_t)__builtin_amdgcn_readlane(idv, j * 8) * DM + lane * 16);
        rb[j] = *(const u32x4*)(u8 + (size_t)__builtin_amdgcn_readlane(idv, j * 8 + 1) * DM + lane * 16);
    }
    float h = 0.f;
    const bool up16 = (lane & 16) != 0, up8 = (lane & 8) != 0;
#pragma unroll 1
    for (int c2 = 0; c2 < 4; ++c2) {
#pragma unroll
        for (int par = 0; par < 2; ++par) {
            const int c = c2 * 2 + par;
            float s[8];
#pragma unroll
            for (int j = 0; j < 8; ++j) {
                const f32x2 a = row_dot(par ? rb[j] : ra[j], x, (f32x2){0.f, 0.f});
                s[j] = a.x + a.y;
                if (c2 < 3) {
                    const u32x4 nw = *(const u32x4*)(u8 + (size_t)__builtin_amdgcn_readlane(idv, j * 8 + c + 2) * DM + lane * 16);
                    if (par) rb[j] = nw; else ra[j] = nw;
                }
            }
#pragma unroll
            for (int j = 0; j < 4; ++j) {
                auto r = __builtin_amdgcn_permlane32_swap(__float_as_uint(s[j]), __float_as_uint(s[j + 4]), false, false);
                s[j] = __uint_as_float(r[0]) + __uint_as_float(r[1]);
            }
#pragma unroll
            for (int j = 0; j < 2; ++j) {
                const float keep = up16 ? s[j + 2] : s[j], send = up16 ? s[j] : s[j + 2];
                s[j] = keep + __shfl_xor(send, 16);
            }
            float t;
            { const float keep = up8 ? s[1] : s[0], send = up8 ? s[0] : s[1]; t = keep + __shfl_xor(send, 8); }
            t += __shfl_xor(t, 4); t += __shfl_xor(t, 2); t += __shfl_xor(t, 1);
            if ((lane & 7) == c) h = t;
        }
    }
    return h;
}
#define PEER_DV 16
__device__ __forceinline__ void peer_v_round(const unsigned char* __restrict__ v8, int idv, float actv, f32x2 (&o)[8], int lane) {
    u32x4 rb[PEER_DV];
#pragma unroll
    for (int i = 0; i < PEER_DV; ++i) rb[i] = *(const u32x4*)(v8 + (size_t)__builtin_amdgcn_readlane(idv, i) * DM + lane * 16);
#pragma unroll 1
    for (int e0 = 0; e0 < 64; e0 += PEER_DV) {
#pragma unroll
        for (int i = 0; i < PEER_DV; ++i) {
            const float a = __int_as_float(__builtin_amdgcn_readlane(__float_as_int(actv), e0 + i));
            const f32x2 a2 = {a, a};
            const u32x4 w = rb[i];
#pragma unroll
            for (int k = 0; k < 4; ++k) {
                o[2 * k] = __builtin_amdgcn_cvt_pk_f32_fp8(w[k], false) * a2 + o[2 * k];
                o[2 * k + 1] = __builtin_amdgcn_cvt_pk_f32_fp8(w[k], true) * a2 + o[2 * k + 1];
            }
            if (e0 + PEER_DV < 64) rb[i] = *(const u32x4*)(v8 + (size_t)__builtin_amdgcn_readlane(idv, e0 + PEER_DV + i) * DM + lane * 16);
        }
    }
}
__device__ __forceinline__ float gelu_gate(float h, float g) { return 0.5f * h * (1.0f + erff(h * 0.70710678118654752f)) * g; }

__device__ void ph_peer(const Params& p, const int vb) {
    const int lane = threadIdx.x & 63;
    const int wid = __builtin_amdgcn_readfirstlane(threadIdx.x >> 6);
    for (int t = vb * 4 + wid; t < T_TOK; t += gridDim.x * 4) {
        const int id0 = p.ids[(size_t)t * 128 + lane], id1 = p.ids[(size_t)t * 128 + 64 + lane];
        const float g0 = p.gates[(size_t)t * 128 + lane], g1 = p.gates[(size_t)t * 128 + 64 + lane];
        const float su0 = p.su[id0], su1 = p.su[id1], sv0 = p.sv[id0], sv1 = p.sv[id1];
        const float* xr = p.x1 + (size_t)t * DM + lane * 16;
        f32x2 x[8];
        {
            const f32x4 a = *(const f32x4*)(xr), b = *(const f32x4*)(xr + 4), c = *(const f32x4*)(xr + 8), d = *(const f32x4*)(xr + 12);
            x[0] = (f32x2){a[0], a[1]}; x[1] = (f32x2){a[2], a[3]}; x[2] = (f32x2){b[0], b[1]}; x[3] = (f32x2){b[2], b[3]};
            x[4] = (f32x2){c[0], c[1]}; x[5] = (f32x2){c[2], c[3]}; x[6] = (f32x2){d[0], d[1]}; x[7] = (f32x2){d[2], d[3]};
        }
        const float h0 = peer_u_round(p.u8, id0, x, lane) * su0;
        const float h1 = peer_u_round(p.u8, id1, x, lane) * su1;
        const float a0 = gelu_gate(h0, g0) * sv0, a1 = gelu_gate(h1, g1) * sv1;
        f32x2 o[8];
#pragma unroll
        for (int i = 0; i < 8; ++i) o[i] = (f32x2){0.f, 0.f};
        peer_v_round(p.v8, id0, a0, o, lane);
        peer_v_round(p.v8, id1, a1, o, lane);
        float r[16];
#pragma unroll
        for (int i = 0; i < 8; ++i) { r[2 * i] = ALPHA * x[i].x + o[i].x; r[2 * i + 1] = ALPHA * x[i].y + o[i].y; }
        float* rr = p.y1 + (size_t)t * DM + lane * 16;
        *(f32x4*)(rr) = (f32x4){r[0], r[1], r[2], r[3]};
        *(f32x4*)(rr + 4) = (f32x4){r[4], r[5], r[6], r[7]};
        *(f32x4*)(rr + 8) = (f32x4){r[8], r[9], r[10], r[11]};
        *(f32x4*)(rr + 12) = (f32x4){r[12], r[13], r[14], r[15]};
        bf16_t* rbp = p.rb + (size_t)t * DM + lane * 16;
        u32x4 w0, w1;
        w0[0] = pack2(r[0], r[1]); w0[1] = pack2(r[2], r[3]); w0[2] = pack2(r[4], r[5]); w0[3] = pack2(r[6], r[7]);
        w1[0] = pack2(r[8], r[9]); w1[1] = pack2(r[10], r[11]); w1[2] = pack2(r[12], r[13]); w1[3] = pack2(r[14], r[15]);
        *(u32x4*)(rbp) = w0; *(u32x4*)(rbp + 8) = w1;
    }
}

__device__ __forceinline__ void ld_ids16(const int* __restrict__ q, int (&idv)[16]) {
    const int4* idp = (const int4*)q;
#pragma unroll
    for (int k = 0; k < 4; ++k) { const int4 v = idp[k]; idv[4 * k] = v.x; idv[4 * k + 1] = v.y; idv[4 * k + 2] = v.z; idv[4 * k + 3] = v.w; }
}
__device__ __forceinline__ void ld_f16(const float* __restrict__ q, float (&a)[16]) {
    const f32x4* ap = (const f32x4*)q;
#pragma unroll
    for (int k = 0; k < 4; ++k) { const f32x4 v = ap[k]; a[4 * k] = v[0]; a[4 * k + 1] = v[1]; a[4 * k + 2] = v[2]; a[4 * k + 3] = v[3]; }
}
__device__ void ph_peer_u(const Params& p, unsigned char* smem, const int vb) {
    const int lane = threadIdx.x & 63, wid = threadIdx.x >> 6, g = lane >> 3, c = lane & 7;
    const int nlb = gridDim.x >> 3, s = vb / nlb, lb = vb - s * nlb;
    const bool b2 = (lane & 4) != 0, b1 = (lane & 2) != 0, b0 = (lane & 1) != 0;
    const int cc = (b0 ? 2 : 0) + (b1 ? 4 : 0) + (b2 ? 8 : 0);
    const unsigned char* ubase = p.u8 + (size_t)s * (16384 * 128) + c * 16;
    const int stride = nlb * 4, t0 = lb * 4 + wid;
    const int ntok = (T_TOK - t0 + stride - 1) / stride;
    if (ntok <= 0) return;
    LDS_AS unsigned char* ring = (LDS_AS unsigned char*)smem + wid * 2048;
    const int* idg = p.ids + 2 * lane;
    const bf16_t* xg = p.x1b + s * 128 + 2 * lane;
#define PU_TOK(n) (t0 + ((n) < ntok ? (n) : ntok - 1) * stride)
#define PU_RAW_LD(n, ri, rx) do { const int _t = PU_TOK(n); ri = *(const u32x2*)(idg + (size_t)_t * 128); const unsigned _w = *(const unsigned*)(xg + (size_t)_t * DM); rx = (u32x2){_w << 16, _w & 0xffff0000u}; } while (0)
#define PU_RAW_ST(n, ri, rx) do { LDS_AS unsigned char* _b = ring + ((n) & 1) * 1024; *(LDS_AS u32x2*)(_b + lane * 8) = ri; *(LDS_AS u32x2*)(_b + 512 + lane * 8) = rx; } while (0)
#define PU_IDS(n, idv) do { const LDS_AS u32x4* _q = (const LDS_AS u32x4*)(ring + ((n) & 1) * 1024 + g * 64); \
        _Pragma("unroll") for (int _k = 0; _k < 4; ++_k) { const u32x4 _v = _q[_k]; idv[4 * _k] = (int)_v[0]; idv[4 * _k + 1] = (int)_v[1]; idv[4 * _k + 2] = (int)_v[2]; idv[4 * _k + 3] = (int)_v[3]; } } while (0)
    u32x4 wA[8], wB[8]; u32x2 ri, rx;
    {
        u32x2 i0, x0, i1, x1v;
        PU_RAW_LD(0, i0, x0); PU_RAW_LD(1, i1, x1v); PU_RAW_LD(2, ri, rx);
        PU_RAW_ST(0, i0, x0); PU_RAW_ST(1, i1, x1v);
        int id0[16]; PU_IDS(0, id0);
#pragma unroll
        for (int i = 0; i < 8; ++i) wA[i] = *(const u32x4*)(ubase + (size_t)id0[i] * 128);
#pragma unroll
        for (int i = 0; i < 8; ++i) wB[i] = *(const u32x4*)(ubase + (size_t)id0[8 + i] * 128);
    }
#pragma unroll 1
    for (int n = 0; n < ntok; ++n) {
        const int t = t0 + n * stride;
        f32x2 x[8];
        {
            const LDS_AS f32x4* q = (const LDS_AS f32x4*)(ring + (n & 1) * 1024 + 512 + c * 64);
#pragma unroll
            for (int k = 0; k < 4; ++k) { const f32x4 v4 = q[k]; x[2 * k] = (f32x2){v4[0], v4[1]}; x[2 * k + 1] = (f32x2){v4[2], v4[3]}; }
        }
        int idn[16]; PU_IDS(n + 1, idn);
        float v[16];
#pragma unroll
        for (int i = 0; i < 8; ++i) { const f32x2 a = row_dot(wA[i], x, (f32x2){0.f, 0.f}); v[i] = a.x + a.y; }
#pragma unroll
        for (int i = 0; i < 8; ++i) wA[i] = *(const u32x4*)(ubase + (size_t)idn[i] * 128);
#pragma unroll
        for (int i = 0; i < 8; ++i) { const f32x2 a = row_dot(wB[i], x, (f32x2){0.f, 0.f}); v[8 + i] = a.x + a.y; }
#pragma unroll
        for (int i = 0; i < 8; ++i) wB[i] = *(const u32x4*)(ubase + (size_t)idn[8 + i] * 128);
        PU_RAW_ST(n + 2, ri, rx);
        PU_RAW_LD(n + 3, ri, rx);
#pragma unroll
        for (int i = 0; i < 8; ++i) { const float keep = b2 ? v[i + 8] : v[i], send = b2 ? v[i] : v[i + 8]; v[i] = keep + __shfl_xor(send, 4); }
#pragma unroll
        for (int i = 0; i < 4; ++i) { const float keep = b1 ? v[i + 4] : v[i], send = b1 ? v[i] : v[i + 4]; v[i] = keep + __shfl_xor(send, 2); }
#pragma unroll
        for (int i = 0; i < 2; ++i) { const float keep = b0 ? v[i + 2] : v[i], send = b0 ? v[i] : v[i + 2]; v[i] = keep + __shfl_xor(send, 1); }
        *(unsigned*)(p.hp + ((size_t)t * 8 + s) * 128 + g * 16 + cc) = pack2(v[0], v[1]);
    }
}
__device__ void ph_peer_act(const Params& p, const int vb) {
    const int lane = threadIdx.x & 63, wid = threadIdx.x >> 6;
    for (int t = vb * 4 + wid; t < T_TOK; t += gridDim.x * 4) {
        f32x2 h = {0.f, 0.f};
#pragma unroll
        for (int s = 0; s < 8; ++s) { const unsigned w = *(const unsigned*)(p.hp + ((size_t)t * 8 + s) * 128 + 2 * lane); h += (f32x2){bflo(w), bfhi(w)}; }
        const int2 id = *(const int2*)(p.ids + (size_t)t * 128 + 2 * lane);
        const f32x2 gt = *(const f32x2*)(p.gates + (size_t)t * 128 + 2 * lane);
        f32x2 a;
        a.x = gelu_gate(h.x * p.su[id.x], gt.x) * p.sv[id.x];
        a.y = gelu_gate(h.y * p.su[id.y], gt.y) * p.sv[id.y];
        *(f32x2*)(p.gates + (size_t)t * 128 + 2 * lane) = a;
    }
}
__device__ void ph_peer_v(const Params& p, unsigned char* smem, const int vb) {
    const int lane = threadIdx.x & 63, wid = threadIdx.x >> 6, g = lane >> 3, c = lane & 7;
    const int nlb = gridDim.x >> 3, s = vb / nlb, lb = vb - s * nlb;
    const bool b4 = (lane & 16) != 0, b3 = (lane & 8) != 0;
    const unsigned char* vbase = p.v8 + (size_t)s * (16384 * 128) + c * 16;
    const int stride = nlb * 4, t0 = lb * 4 + wid;
    const int ntok = (T_TOK - t0 + stride - 1) / stride;
    if (ntok <= 0) return;
    const int d0 = s * 128 + c * 16 + 2 * g;
    LDS_AS unsigned char* ring = (LDS_AS unsigned char*)smem + wid * 2048;
    const int* idg = p.ids + 2 * lane;
    const float* ag = p.gates + 2 * lane;
#define PV_RAW_LD(n, ri, rx) do { const int _t = PU_TOK(n); ri = *(const u32x2*)(idg + (size_t)_t * 128); rx = *(const u32x2*)(ag + (size_t)_t * 128); } while (0)
    u32x4 wA[8], wB[8]; u32x2 ri, rx;
    {
        u32x2 i0, x0, i1, x1v;
        PV_RAW_LD(0, i0, x0); PV_RAW_LD(1, i1, x1v); PV_RAW_LD(2, ri, rx);
        PU_RAW_ST(0, i0, x0); PU_RAW_ST(1, i1, x1v);
        int id0[16]; PU_IDS(0, id0);
#pragma unroll
        for (int i = 0; i < 8; ++i) wA[i] = *(const u32x4*)(vbase + (size_t)id0[i] * 128);
#pragma unroll
        for (int i = 0; i < 8; ++i) wB[i] = *(const u32x4*)(vbase + (size_t)id0[8 + i] * 128);
    }
#pragma unroll 1
    for (int n = 0; n < ntok; ++n) {
        const int t = t0 + n * stride;
        const unsigned xw = *(const unsigned*)(p.x1b + (size_t)t * DM + d0);
        const f32x2 xv = {bflo(xw), bfhi(xw)};
        float ac[16];
        {
            const LDS_AS f32x4* q = (const LDS_AS f32x4*)(ring + (n & 1) * 1024 + 512 + g * 64);
#pragma unroll
            for (int k = 0; k < 4; ++k) { const f32x4 v4 = q[k]; ac[4 * k] = v4[0]; ac[4 * k + 1] = v4[1]; ac[4 * k + 2] = v4[2]; ac[4 * k + 3] = v4[3]; }
        }
        int idn[16]; PU_IDS(n + 1, idn);
        f32x2 acc[8];
#pragma unroll
        for (int k = 0; k < 8; ++k) acc[k] = (f32x2){0.f, 0.f};
#pragma unroll
        for (int i = 0; i < 8; ++i) {
            const f32x2 a2 = {ac[i], ac[i]};
#pragma unroll
            for (int k = 0; k < 4; ++k) {
                acc[2 * k] = __builtin_amdgcn_cvt_pk_f32_fp8(wA[i][k], false) * a2 + acc[2 * k];
                acc[2 * k + 1] = __builtin_amdgcn_cvt_pk_f32_fp8(wA[i][k], true) * a2 + acc[2 * k + 1];
            }
        }
#pragma unroll
        for (int i = 0; i < 8; ++i) wA[i] = *(const u32x4*)(vbase + (size_t)idn[i] * 128);
#pragma unroll
        for (int i = 0; i < 8; ++i) {
            const f32x2 a2 = {ac[8 + i], ac[8 + i]};
#pragma unroll
            for (int k = 0; k < 4; ++k) {
                acc[2 * k] = __builtin_amdgcn_cvt_pk_f32_fp8(wB[i][k], false) * a2 + acc[2 * k];
                acc[2 * k + 1] = __builtin_amdgcn_cvt_pk_f32_fp8(wB[i][k], true) * a2 + acc[2 * k + 1];
            }
        }
#pragma unroll
        for (int i = 0; i < 8; ++i) wB[i] = *(const u32x4*)(vbase + (size_t)idn[8 + i] * 128);
        PU_RAW_ST(n + 2, ri, rx);
        PV_RAW_LD(n + 3, ri, rx);
        float v[16];
#pragma unroll
        for (int k = 0; k < 8; ++k) { v[2 * k] = acc[k].x; v[2 * k + 1] = acc[k].y; }
#pragma unroll
        for (int j2 = 0; j2 < 8; ++j2) {
            auto r = __builtin_amdgcn_permlane32_swap(__float_as_uint(v[j2]), __float_as_uint(v[j2 + 8]), false, false);
            v[j2] = __uint_as_float(r[0]) + __uint_as_float(r[1]);
        }
#pragma unroll
        for (int j2 = 0; j2 < 4; ++j2) { const float keep = b4 ? v[j2 + 4] : v[j2], send = b4 ? v[j2] : v[j2 + 4]; v[j2] = keep + __shfl_xor(send, 16); }
#pragma unroll
        for (int j2 = 0; j2 < 2; ++j2) { const float keep = b3 ? v[j2 + 2] : v[j2], send = b3 ? v[j2] : v[j2 + 2]; v[j2] = keep + __shfl_xor(send, 8); }
        const float r0 = ALPHA * xv.x + v[0], r1 = ALPHA * xv.y + v[1];
        *(unsigned*)(p.rb + (size_t)t * DM + d0) = pack2(r0, r1);
    }
}

__device__ void ph_gemm_ple(const Params& p, unsigned char* smem, const int vb) {
    const int ntn = DM / 128;
    const int tid = threadIdx.x, lane = tid & 63, wid = tid >> 6, wr = wid >> 1, wc = wid & 1, fr = lane & 15, fq = lane >> 4;
    for (int t = vb; t < (T_TOK / 128) * ntn; t += gridDim.x) {
        const int m0 = (t / ntn) * 128, n0 = (t % ntn) * 128;
        f32x4 acc[4][4], acc2[4][4]; zero_acc(acc); zero_acc(acc2);
        gemm128(p.pb + (size_t)m0 * 256, 256, p.WpT + (size_t)n0 * 256, 256, 256, smem, acc2);
        gemm128(p.rb + (size_t)m0 * DM, DM, p.WgT + (size_t)n0 * DM, DM, DM, smem, acc);
#pragma unroll
        for (int mi = 0; mi < 4; ++mi) {
            const int row = m0 + wr * 64 + mi * 16 + fr;
#pragma unroll
            for (int ni = 0; ni < 4; ++ni) {
                const int col = n0 + wc * 64 + ni * 16 + fq * 4;
                const u32x2 rw = *(const u32x2*)(p.rb + (size_t)row * DM + col);
                f32x4 rv = {bflo(rw[0]), bfhi(rw[0]), bflo(rw[1]), bfhi(rw[1])};
#pragma unroll
                for (int r = 0; r < 4; ++r) rv[r] += acc2[mi][ni][r] / (1.0f + __expf(-acc[mi][ni][r]));
                *(f32x4*)(p.out + (size_t)row * DM + col) = rv;
            }
        }
    }
}

#define XB_TMO      128
#define XB_XCNT(j)  (256  + 64 * (j))
#define XB_XSUB(j)  (1280 + 64 * (j))
#define XB_XGEN(j)  (2304 + 64 * (j))
#define XB_TOP      3328
#define XB_TOPGEN   3392
#define XCD_BAR_WORDS 3456
#define XB_SPIN_CAP (1u << 20)
__device__ __forceinline__ unsigned xb_ld(unsigned* p)              { return __hip_atomic_load(p, __ATOMIC_RELAXED, __HIP_MEMORY_SCOPE_AGENT); }
__device__ __forceinline__ unsigned xb_add(unsigned* p, unsigned v) { return __hip_atomic_fetch_add(p, v, __ATOMIC_RELAXED, __HIP_MEMORY_SCOPE_AGENT); }
__device__ __forceinline__ unsigned xb_xcc_id() { return (unsigned)__builtin_amdgcn_s_getreg((3 << 11) | 20) & 0xFu; }
#define XB_SPIN(cond, bar) do { unsigned _sp = 0; while (cond) { __builtin_amdgcn_s_sleep(1); \
    if ((++_sp & 255u) == 0u) { if (xb_ld(&(bar)[XB_TMO])) break; if (_sp > XB_SPIN_CAP) { atomicAdd(&(bar)[XB_TMO], 1u); break; } } } } while (0)
struct XcdBarrier { unsigned* bar; unsigned x; volatile LDS_AS unsigned* st; };
__device__ __forceinline__ XcdBarrier xcd_barrier_post(unsigned* bar, volatile LDS_AS unsigned* st) {
    XcdBarrier b; b.bar = bar; b.x = xb_xcc_id(); b.st = st;
    if (threadIdx.x == 0) st[3] = xb_add(&bar[XB_XCNT(b.x)], 1u);
    return b;
}
__device__ __forceinline__ void xcd_barrier_complete(unsigned* bar, unsigned x, unsigned rank, unsigned& nloc, unsigned& nx, unsigned& vb) {
    const unsigned G = gridDim.x;
    unsigned sum, cnt, mine, sp = 0u; bool even;
    for (;;) {
        sum = 0u; cnt = 0u; mine = 0u; even = true;
#pragma unroll
        for (unsigned j = 0; j < 16; ++j) {
            const unsigned c = xb_ld(&bar[XB_XCNT(j)]); sum += c; cnt += (c > 0u) ? 1u : 0u; mine = (j == x) ? c : mine;
            even = even && (c == ((j < 8u) ? (G >> 3) : 0u));
        }
        if (sum == G) break;
        __builtin_amdgcn_s_sleep(1);
        if ((++sp & 255u) == 0u) { if (xb_ld(&bar[XB_TMO])) break; if (sp > XB_SPIN_CAP) { atomicAdd(&bar[XB_TMO], 1u); break; } }
    }
    nloc = mine > 0u ? mine : 1u; nx = cnt > 0u ? cnt : 1u;
    vb = (even && sum == G && (G & 7u) == 0u) ? (x * (G >> 3) + rank) : blockIdx.x;
}
__device__ __forceinline__ void xcd_barrier(const XcdBarrier& b) {
    asm volatile("s_waitcnt vmcnt(0)" ::: "memory");
    __syncthreads();
    if (threadIdx.x == 0) {
        unsigned* bar = b.bar;
        __builtin_amdgcn_s_waitcnt(0);
        unsigned nloc = b.st[0], nx = b.st[1];
        if (nloc == 0u) { unsigned vb; xcd_barrier_complete(bar, b.x, b.st[3], nloc, nx, vb); b.st[0] = nloc; b.st[1] = nx; b.st[2] = vb; }
        const unsigned old = xb_add(&bar[XB_XSUB(b.x)], 1u);
        const unsigned gen = old / nloc;
        if (old + 1u == (gen + 1u) * nloc) {
            __builtin_amdgcn_fence(__ATOMIC_RELEASE, "agent");
            asm volatile("s_waitcnt vmcnt(0)" ::: "memory");
            const unsigned og = xb_add(&bar[XB_TOP], 1u);
            const unsigned tg = og / nx;
            if (og + 1u == (tg + 1u) * nx) xb_add(&bar[XB_TOPGEN], 1u);
            else XB_SPIN(xb_ld(&bar[XB_TOPGEN]) == tg, bar);
            __builtin_amdgcn_fence(__ATOMIC_ACQUIRE, "agent");
            xb_add(&bar[XB_XGEN(b.x)], 1u);
            asm volatile("s_waitcnt vmcnt(0)" ::: "memory");
        } else {
            XB_SPIN(xb_ld(&bar[XB_XGEN(b.x)]) == gen, bar);
            __builtin_amdgcn_fence(__ATOMIC_ACQUIRE, "agent");
            asm volatile("s_waitcnt vmcnt(0)" ::: "memory");
        }
    }
    __syncthreads();
}

#define SMEM_PHASE (256 * ASTR * 2 * 2)
#define SMEM_BYTES (SMEM_PHASE + 16)
__global__ void __launch_bounds__(256, 2) mega(Params p) {
    __shared__ __attribute__((aligned(16))) unsigned char smem[SMEM_BYTES];
    volatile LDS_AS unsigned* st = (volatile LDS_AS unsigned*)(LDS_AS unsigned char*)(smem + SMEM_PHASE);
    if (threadIdx.x < 4) st[threadIdx.x] = 0u;
    __syncthreads();
    const XcdBarrier gb = xcd_barrier_post(p.bar, st);
    ph_prep(p, smem);            xcd_barrier(gb);
    const int vb = (int)st[2];
    ph_gemm_in(p, smem, vb);     xcd_barrier(gb);
    ph_attn(p, smem, vb);
    ph_conv(p, smem, vb);        xcd_barrier(gb);
    ph_gemm_out(p, smem, vb);    xcd_barrier(gb);
    ph_ln1(p, vb);               xcd_barrier(gb);
    ph_route(p, smem, vb);       xcd_barrier(gb);
    ph_peer_u(p, smem, vb);      xcd_barrier(gb);
    ph_peer_act(p, vb);          xcd_barrier(gb);
    ph_peer_v(p, smem, vb);      xcd_barrier(gb);
    ph_gemm_ple(p, smem, vb);    xcd_barrier(gb);
    ph_ln2(p, vb);
}

extern "C" void kernel_launch(void* const* d_in, const int* in_sizes, int n_in, void* d_out, int out_size, void* d_ws, size_t ws_size,
                              hipStream_t stream) {
    Params p{};
    p.x = (const float*)d_in[0]; p.p = (const float*)d_in[1]; p.pos = (const int*)d_in[2];
    p.w_in = (const float*)d_in[3]; p.sinks = (const float*)d_in[4]; p.conv_w = (const float*)d_in[5]; p.conv_b = (const float*)d_in[6];
    p.cln_g = (const float*)d_in[7]; p.cln_b = (const float*)d_in[8]; p.w_out = (const float*)d_in[9]; p.ln1_g = (const float*)d_in[10];
    p.ln1_b = (const float*)d_in[11]; p.wq = (const float*)d_in[12]; p.keys = (const float*)d_in[13]; p.pu = (const float*)d_in[14];
    p.pv = (const float*)d_in[15]; p.ple_proj = (const float*)d_in[16]; p.ple_gate = (const float*)d_in[17]; p.ln2_g = (const float*)d_in[18];
    p.ln2_b = (const float*)d_in[19];
    p.out = (float*)d_out;
    unsigned char* ws = (unsigned char*)d_ws;
    const size_t MiB = 1024 * 1024;
    p.y1 = (float*)(ws + 0 * MiB);
    p.hb = (bf16_t*)(ws + 128 * MiB);
    p.qb = (bf16_t*)(ws + 128 * MiB);
    p.hp = (bf16_t*)(ws + 128 * MiB);
    p.xb = (bf16_t*)(ws + 256 * MiB);
    p.x1b = (bf16_t*)(ws + 256 * MiB);
    p.mixb = (bf16_t*)(ws + 320 * MiB);
    p.tops = (float*)(ws + 320 * MiB);
    p.topi = (int*)(ws + 352 * MiB);
    p.rb = (bf16_t*)(ws + 320 * MiB);
    p.pb = (bf16_t*)(ws + 384 * MiB);
    p.ub = (bf16_t*)(ws + 400 * MiB);
    p.vb = (bf16_t*)(ws + 432 * MiB);
    p.u8 = (unsigned char*)(ws + 400 * MiB);
    p.v8 = (unsigned char*)(ws + 416 * MiB);
    p.su = (float*)(ws + 432 * MiB);
    p.sv = (float*)(ws + 433 * MiB);
    p.ids = (int*)(ws + 464 * MiB);
    p.gates = (float*)(ws + 480 * MiB);
    unsigned char* wb = ws + 496 * MiB;
    p.WinT = (bf16_t*)wb; wb += (size_t)INW * DM * 2;
    p.WoutT = (bf16_t*)wb; wb += (size_t)DM * DM * 2;
    p.WqT = (bf16_t*)wb; wb += (size_t)2048 * DM * 2;
    p.WgT = (bf16_t*)wb; wb += (size_t)DM * DM * 2;
    p.WpT = (bf16_t*)wb; wb += (size_t)DM * 256 * 2;
    p.keysb = (bf16_t*)wb; wb += (size_t)16 * 128 * 128 * 2;
    p.bar = (unsigned*)(ws + 510 * MiB);
    p.x1 = (float*)d_out;

    static int grid_blocks = 0;
    if (!grid_blocks) {
        int dev = 0, cus = 0, per_cu = 0;
        (void)hipGetDevice(&dev);
        (void)hipDeviceGetAttribute(&cus, hipDeviceAttributeMultiprocessorCount, dev);
        (void)hipOccupancyMaxActiveBlocksPerMultiprocessor(&per_cu, mega, 256, 0);
        if (per_cu > 2) per_cu = 2;
        grid_blocks = cus * per_cu;
    }
    (void)hipMemsetAsync(p.bar, 0, XCD_BAR_WORDS * sizeof(unsigned), stream);
    void* args[] = {&p};
    hipError_t e = hipLaunchCooperativeKernel((void*)mega, dim3(grid_blocks), dim3(256), args, 0, stream);
    if (e != hipSuccess) fprintf(stderr, "cooperative launch failed: %s (grid %d)\n", hipGetErrorString(e), grid_blocks);
}
```

```cpp
#include <hip/hip_runtime.h>
#include <hip/hip_cooperative_groups.h>
#include <stdint.h>
#include <cstdio>
namespace cg = cooperative_groups;

typedef unsigned short bf16_t;
typedef short bf16x8 __attribute__((ext_vector_type(8)));
typedef float f32x4 __attribute__((ext_vector_type(4)));
typedef unsigned u32x4 __attribute__((ext_vector_type(4)));
typedef float f32x2 __attribute__((ext_vector_type(2)));

#define T_TOK 32768
#define SEQ 2048
#define DM 1024
#define INW 1792
#define ALPHA 1.189207115002721f
#define LN_EPS 1e-5f

__device__ __forceinline__ bf16_t f2bf(float f) {
    unsigned u = __float_as_uint(f);
    u += 0x7fffu + ((u >> 16) & 1u);
    return (bf16_t)(u >> 16);
}
__device__ __forceinline__ float bf2f(bf16_t b) { return __uint_as_float(((unsigned)b) << 16); }
__device__ __forceinline__ float bflo(unsigned w) { return __uint_as_float(w << 16); }
__device__ __forceinline__ float bfhi(unsigned w) { return __uint_as_float(w & 0xffff0000u); }
__device__ __forceinline__ unsigned pack2(float a, float b) { return (unsigned)f2bf(a) | ((unsigned)f2bf(b) << 16); }

__device__ __forceinline__ float sigmul(float x, float g) { return x * __builtin_amdgcn_rcpf(1.0f + __expf(-g)); }
__device__ __forceinline__ float wave_sum(float v) {
#pragma unroll
    for (int o = 32; o >= 1; o >>= 1) v += __shfl_xor(v, o);
    return v;
}

struct Params {
    const float *x, *p; const int* pos;
    const float *w_in, *sinks, *conv_w, *conv_b, *cln_g, *cln_b, *w_out, *ln1_g, *ln1_b;
    const float *wq, *keys, *pu, *pv, *ple_proj, *ple_gate, *ln2_g, *ln2_b;
    float* out;
    bf16_t *xb, *pb, *WinT, *WoutT, *WqT, *WgT, *WpT, *keysb, *ub, *vb, *hb, *mixb, *x1b, *qb, *rb;
    float *y1, *x1, *tops, *gates, *su, *sv;
    bf16_t* hp;
    int *topi, *ids;
    unsigned char *u8, *v8;
    unsigned* bar;
};

__device__ void cvt_rows(const float* __restrict__ src, bf16_t* __restrict__ dst, size_t n) {
    const size_t nv = n / 8, gs = (size_t)gridDim.x * blockDim.x;
    for (size_t i = (size_t)blockIdx.x * blockDim.x + threadIdx.x; i < nv; i += 4 * gs) {
        f32x4 a[4], b[4];
#pragma unroll
        for (int q = 0; q < 4; ++q) { const size_t k = (i + q * gs < nv) ? i + q * gs : i; a[q] = ((const f32x4*)src)[2 * k]; b[q] = ((const f32x4*)src)[2 * k + 1]; }
#pragma unroll
        for (int q = 0; q < 4; ++q) {
            if (i + q * gs < nv) {
                u32x4 o; o[0] = pack2(a[q][0], a[q][1]); o[1] = pack2(a[q][2], a[q][3]); o[2] = pack2(b[q][0], b[q][1]); o[3] = pack2(b[q][2], b[q][3]);
                ((u32x4*)dst)[i + q * gs] = o;
            }
        }
    }
}
__device__ void transpose_cvt(const float* __restrict__ W, bf16_t* __restrict__ Wt, int K, int N, float* tile  ) {
    const int tk = K / 64, tn = N / 64;
    const int tid = threadIdx.x;
    for (int t = blockIdx.x; t < tk * tn; t += gridDim.x) {
        const int k0 = (t / tn) * 64, n0 = (t % tn) * 64;
        f32x4 v[4];
#pragma unroll
        for (int i = 0; i < 4; ++i) v[i] = *(const f32x4*)(W + (size_t)(k0 + (tid >> 4) + 16 * i) * N + n0 + (tid & 15) * 4);
        __syncthreads();
#pragma unroll
        for (int i = 0; i < 4; ++i)
#pragma unroll
            for (int j = 0; j < 4; ++j) tile[((tid >> 4) + 16 * i) * 65 + (tid & 15) * 4 + j] = v[i][j];
        __syncthreads();
        const int n = tid >> 2, kc = (tid & 3) * 16;
        u32x4 o0, o1;
#pragma unroll
        for (int q = 0; q < 4; ++q) {
            o0[q] = pack2(tile[(kc + 2 * q) * 65 + n], tile[(kc + 2 * q + 1) * 65 + n]);
            o1[q] = pack2(tile[(kc + 8 + 2 * q) * 65 + n], tile[(kc + 8 + 2 * q + 1) * 65 + n]);
        }
        *(u32x4*)(Wt + (size_t)(n0 + n) * K + k0 + kc) = o0;
        *(u32x4*)(Wt + (size_t)(n0 + n) * K + k0 + kc + 8) = o1;
    }
}
__device__ void cvt_table_fp8(const float* __restrict__ src, unsigned char* __restrict__ dst, float* __restrict__ scl, int rows) {
    const int lane = threadIdx.x & 63, wid = threadIdx.x >> 6;
    const int nw = gridDim.x * 4;
    for (int r0 = blockIdx.x * 4 + wid; r0 < rows; r0 += 4 * nw) {
        f32x4 v[4][4];
#pragma unroll
        for (int q = 0; q < 4; ++q) {
            const int r = (r0 + q * nw < rows) ? r0 + q * nw : r0;
            const float* sr = src + (size_t)r * DM + lane * 16;
#pragma unroll
            for (int k = 0; k < 4; ++k) v[q][k] = *(const f32x4*)(sr + 4 * k);
        }
#pragma unroll
        for (int q = 0; q < 4; ++q) {
            const int r = r0 + q * nw;
            float m = 0.f;
#pragma unroll
            for (int k = 0; k < 4; ++k)
#pragma unroll
                for (int i = 0; i < 4; ++i) m = fmaxf(m, fabsf(v[q][k][i]));
#pragma unroll
            for (int o = 32; o >= 1; o >>= 1) m = fmaxf(m, __shfl_xor(m, o));
            const float sc = (m > 0.f) ? 448.0f / m : 1.0f;
            u32x4 w;
#pragma unroll
            for (int k = 0; k < 4; ++k)
                w[k] = __builtin_amdgcn_cvt_pk_fp8_f32(v[q][k][2] * sc, v[q][k][3] * sc, __builtin_amdgcn_cvt_pk_fp8_f32(v[q][k][0] * sc, v[q][k][1] * sc, 0, false), true);
            if (r < rows) {
                *(u32x4*)(dst + (size_t)(lane >> 3) * (16384 * 128) + (size_t)r * 128 + (lane & 7) * 16) = w;
                if (lane == 0) scl[r] = (m > 0.f) ? m * (1.0f / 448.0f) : 1.0f;
            }
        }
    }
}
__device__ void ph_prep(const Params& p, unsigned char* smem) {
    float* tile = (float*)smem;
    cvt_rows(p.x, p.xb, (size_t)T_TOK * DM);
    cvt_rows(p.p, p.pb, (size_t)T_TOK * 256);
    cvt_table_fp8(p.pu, p.u8, p.su, 16384);
    cvt_table_fp8(p.pv, p.v8, p.sv, 16384);
    cvt_rows(p.keys, p.keysb, (size_t)16 * 128 * 128);
    transpose_cvt(p.w_in, p.WinT, DM, INW, tile);
    transpose_cvt(p.w_out, p.WoutT, DM, DM, tile);
    transpose_cvt(p.wq, p.WqT, DM, 2048, tile);
    transpose_cvt(p.ple_gate, p.WgT, DM, DM, tile);
    transpose_cvt(p.ple_proj, p.WpT, 256, DM, tile);
}

#define LDS_AS __attribute__((address_space(3)))
#define GEMM_STAGE 32768
__device__ __forceinline__ void gemm128(const bf16_t* __restrict__ A, int lda, const bf16_t* __restrict__ Bt, int ldb, int K,
                                        unsigned char* smem, f32x4 (&acc)[4][4]) {
    LDS_AS unsigned char* lds = (LDS_AS unsigned char*)smem;
    const int tid = threadIdx.x, lane = tid & 63, wid = __builtin_amdgcn_readfirstlane(tid >> 6);
    const int wr = wid >> 1, wc = wid & 1, fr = lane & 15, fq = lane >> 4;
    const int nk = K / 64;
    const int prow = lane >> 3, pc = (lane & 7) ^ prow;
    const bf16_t* gA = A + (size_t)(wid * 32 + prow) * lda + pc * 8;
    const bf16_t* gB = Bt + (size_t)(wid * 32 + prow) * ldb + pc * 8;
    const size_t a8 = (size_t)8 * lda, b8 = (size_t)8 * ldb;
#define GEMM_ISSUE(kt, st) do { \
        _Pragma("unroll") for (int _i = 0; _i < 4; ++_i) { \
            __builtin_amdgcn_global_load_lds((const unsigned*)(gA + _i * a8 + (size_t)(kt) * 64), (LDS_AS unsigned*)(lds + (st) * GEMM_STAGE + (wid * 4 + _i) * 1024), 16, 0, 0); \
            __builtin_amdgcn_global_load_lds((const unsigned*)(gB + _i * b8 + (size_t)(kt) * 64), (LDS_AS unsigned*)(lds + (st) * GEMM_STAGE + 16384 + (wid * 4 + _i) * 1024), 16, 0, 0); \
        } } while (0)
    const int swz0 = ((0 * 4 + fq) ^ (fr & 7)) * 16, swz1 = ((1 * 4 + fq) ^ (fr & 7)) * 16;
    const int aoff = (wr * 64 + fr) * 128, boff = 16384 + (wc * 64 + fr) * 128;
    GEMM_ISSUE(0, 0);
#pragma unroll 1
    for (int kt = 0; kt < nk; ++kt) {
        const int st = kt & 1;
        asm volatile("s_waitcnt vmcnt(0)" ::: "memory");
        __builtin_amdgcn_s_barrier();
        asm volatile("" ::: "memory");
        if (kt + 1 < nk) GEMM_ISSUE(kt + 1, st ^ 1);
        const LDS_AS unsigned char* sb = lds + st * GEMM_STAGE;
        bf16x8 af0[4], bf0[4], af1[4], bf1[4];
#pragma unroll
        for (int mi = 0; mi < 4; ++mi) af0[mi] = *(const LDS_AS bf16x8*)(sb + aoff + mi * 2048 + swz0);
#pragma unroll
        for (int ni = 0; ni < 4; ++ni) bf0[ni] = *(const LDS_AS bf16x8*)(sb + boff + ni * 2048 + swz0);
#pragma unroll
        for (int mi = 0; mi < 4; ++mi) af1[mi] = *(const LDS_AS bf16x8*)(sb + aoff + mi * 2048 + swz1);
#pragma unroll
        for (int ni = 0; ni < 4; ++ni) bf1[ni] = *(const LDS_AS bf16x8*)(sb + boff + ni * 2048 + swz1);
#pragma unroll
        for (int mi = 0; mi < 4; ++mi)
#pragma unroll
            for (int ni = 0; ni < 4; ++ni)
                acc[mi][ni] = __builtin_amdgcn_mfma_f32_16x16x32_bf16(bf0[ni], af0[mi], acc[mi][ni], 0, 0, 0);
#pragma unroll
        for (int mi = 0; mi < 4; ++mi)
#pragma unroll
            for (int ni = 0; ni < 4; ++ni)
                acc[mi][ni] = __builtin_amdgcn_mfma_f32_16x16x32_bf16(bf1[ni], af1[mi], acc[mi][ni], 0, 0, 0);
        __builtin_amdgcn_sched_group_barrier(0x100, 8, 0);
#pragma unroll
        for (int q = 0; q < 8; ++q) { __builtin_amdgcn_sched_group_barrier(0x008, 2, 0); __builtin_amdgcn_sched_group_barrier(0x100, 1, 0); }
        __builtin_amdgcn_sched_group_barrier(0x008, 16, 0);
        asm volatile("s_waitcnt lgkmcnt(0)" ::: "memory");
        __builtin_amdgcn_s_barrier();
        asm volatile("" ::: "memory");
    }
#undef GEMM_ISSUE
}
#define GW_STAGE 24576
__device__ __forceinline__ void gemmW(const bf16_t* __restrict__ A, int lda, const bf16_t* __restrict__ Bt, int ldb, int K,
                                      unsigned char* smem, f32x4 (&acc)[4][8]) {
    LDS_AS unsigned char* lds = (LDS_AS unsigned char*)smem;
    const int tid = threadIdx.x, lane = tid & 63, wid = __builtin_amdgcn_readfirstlane(tid >> 6);
    const int wr = wid >> 1, wc = wid & 1, fr = lane & 15, fq = lane >> 4;
    const int nk = K / 32;
    const int prow = lane >> 2, pc = (lane & 3) ^ ((4 - ((prow >> 2) & 3)) & 3);
    const bf16_t* gA = A + (size_t)(wid * 32 + prow) * lda + pc * 8;
    const bf16_t* gB = Bt + (size_t)(wid * 64 + prow) * ldb + pc * 8;
    const size_t a16 = (size_t)16 * lda, b16 = (size_t)16 * ldb;
#define GW_ISSUE(kt, st) do { \
        _Pragma("unroll") for (int _i = 0; _i < 2; ++_i) \
            __builtin_amdgcn_global_load_lds((const unsigned*)(gA + _i * a16 + (size_t)(kt) * 32), (LDS_AS unsigned*)(lds + (st) * GW_STAGE + (wid * 2 + _i) * 1024), 16, 0, 0); \
        _Pragma("unroll") for (int _i = 0; _i < 4; ++_i) \
            __builtin_amdgcn_global_load_lds((const unsigned*)(gB + _i * b16 + (size_t)(kt) * 32), (LDS_AS unsigned*)(lds + (st) * GW_STAGE + 8192 + (wid * 4 + _i) * 1024), 16, 0, 0); \
        } while (0)
    const int swz = (fq ^ ((4 - ((fr >> 2) & 3)) & 3)) * 16;
    const int aoff = (wr * 64 + fr) * 64 + swz, boff = 8192 + (wc * 128 + fr) * 64 + swz;
    GW_ISSUE(0, 0);
#pragma unroll 1
    for (int kt = 0; kt < nk; ++kt) {
        const int st = kt & 1;
        asm volatile("s_waitcnt vmcnt(0)" ::: "memory");
        __builtin_amdgcn_s_barrier();
        asm volatile("" ::: "memory");
        if (kt + 1 < nk) GW_ISSUE(kt + 1, st ^ 1);
        const LDS_AS unsigned char* sb = lds + st * GW_STAGE;
        bf16x8 af[4], bfr[8];
#pragma unroll
        for (int mi = 0; mi < 4; ++mi) af[mi] = *(const LDS_AS bf16x8*)(sb + aoff + mi * 1024);
#pragma unroll
        for (int ni = 0; ni < 8; ++ni) bfr[ni] = *(const LDS_AS bf16x8*)(sb + boff + ni * 1024);
#pragma unroll
        for (int ni = 0; ni < 8; ++ni)
#pragma unroll
            for (int mi = 0; mi < 4; ++mi)
                acc[mi][ni] = __builtin_amdgcn_mfma_f32_16x16x32_bf16(bfr[ni], af[mi], acc[mi][ni], 0, 0, 0);
        asm volatile("s_waitcnt lgkmcnt(0)" ::: "memory");
        __builtin_amdgcn_s_barrier();
        asm volatile("" ::: "memory");
    }
#undef GW_ISSUE
}
__device__ __forceinline__ void zero_accw(f32x4 (&acc)[4][8]) {
#pragma unroll
    for (int a = 0; a < 4; ++a)
#pragma unroll
        for (int b = 0; b < 8; ++b) acc[a][b] = (f32x4){0.f, 0.f, 0.f, 0.f};
}
__device__ __forceinline__ void zero_acc(f32x4 (&acc)[4][4]) {
#pragma unroll
    for (int a = 0; a < 4; ++a)
#pragma unroll
        for (int b = 0; b < 4; ++b) acc[a][b] = (f32x4){0.f, 0.f, 0.f, 0.f};
}
#define GEMM_SMEM (2 * GEMM_STAGE)

__device__ void ph_gemm_in(const Params& p, unsigned char* smem, const int vb) {
    const int ntn = INW / 128;
    const int tid = threadIdx.x, lane = tid & 63, wid = tid >> 6, wr = wid >> 1, wc = wid & 1, fr = lane & 15, fq = lane >> 4;
    for (int t = vb; t < (T_TOK / 128) * ntn; t += gridDim.x) {
        const int m0 = (t / ntn) * 128, n0 = (t % ntn) * 128;
        f32x4 acc[4][4]; zero_acc(acc);
        gemm128(p.xb + (size_t)m0 * DM, DM, p.WinT + (size_t)n0 * DM, DM, DM, smem, acc);
#pragma unroll
        for (int mi = 0; mi < 4; ++mi) {
            const int row = m0 + wr * 64 + mi * 16 + fr;
            const float posf = (float)p.pos[row];
#pragma unroll
            for (int ni = 0; ni < 4; ++ni) {
                const int col0 = n0 + wc * 64 + ni * 16;
                f32x4 v = acc[mi][ni];
                if (col0 < 640 && (col0 & 63) == 0) {
#pragma unroll
                    for (int r = 0; r < 4; ++r) {
                        const float other = __shfl_xor(v[r], 32);
                        const int j = (fq & 1) * 4 + r;
                        const float inv = powf(500000.0f, -(float)j * 0.125f);
                        float sn, cs; sincosf(posf * inv, &sn, &cs);
                        v[r] = (fq < 2) ? (v[r] * cs - other * sn) : (v[r] * cs + other * sn);
                    }
                }
                uint2 o; o.x = pack2(v[0], v[1]); o.y = pack2(v[2], v[3]);
                *(uint2*)(p.hb + (size_t)row * INW + col0 + fq * 4) = o;
            }
        }
    }
}

#define ASTR 72
#define VSTR 260
typedef float f32x16 __attribute__((ext_vector_type(16)));
typedef unsigned u32x2 __attribute__((ext_vector_type(2)));
__device__ void ph_attn(const Params& p, unsigned char* smem, const int vb) {
    bf16_t* sK = (bf16_t*)smem;
    bf16_t* sVt = sK + 256 * ASTR;
    const int tid = threadIdx.x, lane = tid & 63, wid = tid >> 6, r32 = lane & 31, hh = lane >> 5;
    const float C1 = 0.125f * 1.4426950408889634f, LOG2E = 1.4426950408889634f;
    for (int u = vb; u < 16 * 16 * 2; u += gridDim.x) {
        const int kvh = u & 1, nb = (u >> 1) & 15, b = u >> 5;
        __syncthreads();
        for (int c = tid; c < 256 * 8; c += 256) {
            const int li = c >> 3, kc = c & 7;
            const int pos = nb * 128 - 128 + li;
            u32x4 kv = {0u, 0u, 0u, 0u}, vv = {0u, 0u, 0u, 0u};
            if (pos >= 0) {
                const bf16_t* base = p.hb + (size_t)(b * SEQ + pos) * INW;
                kv = *(const u32x4*)(base + 512 + kvh * 64 + kc * 8);
                vv = *(const u32x4*)(base + 640 + kvh * 64 + kc * 8);
            }
            *(u32x4*)(sK + li * ASTR + kc * 8) = kv;
#pragma unroll
            for (int i = 0; i < 4; ++i) {
                sVt[(kc * 8 + 2 * i) * VSTR + li] = (bf16_t)(vv[i] & 0xffffu);
                sVt[(kc * 8 + 2 * i + 1) * VSTR + li] = (bf16_t)(vv[i] >> 16);
            }
        }
        __syncthreads();
        const int hq = kvh * 4 + wid;
        const float sink2 = p.sinks[hq] * LOG2E;
#pragma unroll 1
        for (int qt = 0; qt < 4; ++qt) {
            const size_t trow = (size_t)(b * SEQ + nb * 128 + qt * 32 + r32);
            bf16x8 qf[4];
#pragma unroll
            for (int ks = 0; ks < 4; ++ks) qf[ks] = *(const bf16x8*)(p.hb + trow * INW + hq * 64 + ks * 16 + hh * 8);
            f32x16 S[5];
#pragma unroll
            for (int j = 0; j < 5; ++j) {
#pragma unroll
                for (int r = 0; r < 16; ++r) S[j][r] = 0.f;
#pragma unroll
                for (int ks = 0; ks < 4; ++ks) {
                    const bf16x8 a = *(const bf16x8*)(sK + ((qt + j) * 32 + r32) * ASTR + ks * 16 + hh * 8);
                    S[j] = __builtin_amdgcn_mfma_f32_32x32x16_bf16(a, qf[ks], S[j], 0, 0, 0);
                }
            }
            float m2 = sink2;
#pragma unroll
            for (int j = 0; j < 5; ++j) {
                const bool tile_ok = (nb > 0) || (qt + j >= 4);
#pragma unroll
                for (int r = 0; r < 16; ++r) {
                    const int kl = (r & 3) + 8 * (r >> 2) + 4 * hh;
                    bool ok = tile_ok;
                    if (j == 0) ok = ok && (kl > r32);
                    if (j == 4) ok = ok && (kl <= r32);
                    const float t = ok ? S[j][r] * C1 : -1.0e30f;
                    S[j][r] = t;
                    m2 = fmaxf(m2, t);
                }
            }
            m2 = fmaxf(m2, __shfl_xor(m2, 32));
            float l = 0.f;
#pragma unroll
            for (int j = 0; j < 5; ++j)
#pragma unroll
                for (int r = 0; r < 16; ++r) { const float e = __builtin_amdgcn_exp2f(S[j][r] - m2); S[j][r] = e; l += e; }
            l += __shfl_xor(l, 32);
            l += __builtin_amdgcn_exp2f(sink2 - m2);
            f32x16 O[2];
#pragma unroll
            for (int dt = 0; dt < 2; ++dt)
#pragma unroll
                for (int r = 0; r < 16; ++r) O[dt][r] = 0.f;
#pragma unroll
            for (int j = 0; j < 5; ++j)
#pragma unroll
                for (int s2 = 0; s2 < 2; ++s2) {
                    u32x4 pw;
#pragma unroll
                    for (int k = 0; k < 4; ++k) pw[k] = pack2(S[j][8 * s2 + 2 * k], S[j][8 * s2 + 2 * k + 1]);
                    const bf16x8 pf = __builtin_bit_cast(bf16x8, pw);
                    const int kbase = (qt + j) * 32 + 16 * s2 + 4 * hh;
#pragma unroll
                    for (int dt = 0; dt < 2; ++dt) {
                        const bf16_t* vp = sVt + (dt * 32 + r32) * VSTR + kbase;
                        const u32x2 v0 = *(const u32x2*)(vp), v1 = *(const u32x2*)(vp + 8);
                        const u32x4 vw = {v0[0], v0[1], v1[0], v1[1]};
                        O[dt] = __builtin_amdgcn_mfma_f32_32x32x16_bf16(__builtin_bit_cast(bf16x8, vw), pf, O[dt], 0, 0, 0);
                    }
                }
            const float il = __builtin_amdgcn_rcpf(l);
#pragma unroll
            for (int dt = 0; dt < 2; ++dt)
#pragma unroll
                for (int g = 0; g < 4; ++g) {
                    u32x2 w;
                    w[0] = pack2(O[dt][4 * g] * il, O[dt][4 * g + 1] * il);
                    w[1] = pack2(O[dt][4 * g + 2] * il, O[dt][4 * g + 3] * il);
                    *(u32x2*)(p.mixb + trow * DM + hq * 64 + dt * 32 + 8 * g + 4 * hh) = w;
                }
        }
    }
}

#define CV_ROWS 62
__device__ void ph_conv(const Params& p, unsigned char* smem, const int vb) {
    bf16_t* gl = (bf16_t*)smem;
    float* red = (float*)(smem + CV_ROWS * 1024);
    const int tid = threadIdx.x, lane = tid & 63, wid = tid >> 6;
    const f32x2 lg = *(const f32x2*)(p.cln_g + 2 * tid), lb = *(const f32x2*)(p.cln_b + 2 * tid);
    for (int u = vb; u < T_TOK / 32; u += gridDim.x) {
        const int tok0 = u * 32, s0 = tok0 & (SEQ - 1);
        __syncthreads();
#pragma unroll 1
        for (int bt = 0; bt < 2; ++bt) {
            u32x4 av[8], gv[8];
#pragma unroll
            for (int it = 0; it < 8; ++it) {
                const int ch = tid + (bt * 8 + it) * 256, row = min(ch >> 6, CV_ROWS - 1), k = ch & 63;
                const int rr = (s0 - 30 + row >= 0) ? row : 30;
                const bf16_t* base = p.hb + (size_t)(tok0 - 30 + rr) * INW + k * 8;
                av[it] = *(const u32x4*)(base + 768); gv[it] = *(const u32x4*)(base + 1280);
            }
#pragma unroll
            for (int it = 0; it < 8; ++it) {
                const int ch = tid + (bt * 8 + it) * 256, row = ch >> 6, k = ch & 63;
                const bool ok = (s0 - 30 + row >= 0);
                u32x4 o;
#pragma unroll
                for (int q = 0; q < 4; ++q) {
                    const float g0 = sigmul(bflo(av[it][q]), bflo(gv[it][q])), g1 = sigmul(bfhi(av[it][q]), bfhi(gv[it][q]));
                    o[q] = ok ? pack2(g0, g1) : 0u;
                }
                if (row < CV_ROWS) *(u32x4*)(gl + row * 512 + k * 8) = o;
            }
        }
        __syncthreads();
        float w0[31], w1[31];
#pragma unroll
        for (int k = 0; k < 31; ++k) { const f32x2 wv = *(const f32x2*)(p.conv_w + k * 512 + 2 * tid); w0[k] = wv.x; w1[k] = wv.y; }
        const f32x2 bias = *(const f32x2*)(p.conv_b + 2 * tid);
#pragma unroll 1
        for (int jh = 0; jh < 2; ++jh) {
            float a0[16], a1[16];
#pragma unroll
            for (int jl = 0; jl < 16; ++jl) { a0[jl] = bias.x; a1[jl] = bias.y; }
            const bf16_t* gp = gl + (jh * 16) * 512 + 2 * tid;
#pragma unroll
            for (int il = 0; il < 46; ++il) {
                const unsigned gw = *(const unsigned*)(gp + il * 512);
                const float g0 = bflo(gw), g1 = bfhi(gw);
#pragma unroll
                for (int jl = 0; jl < 16; ++jl)
                    if (il - jl >= 0 && il - jl <= 30) { a0[jl] += w0[il - jl] * g0; a1[jl] += w1[il - jl] * g1; }
                if ((il & 3) == 3) __builtin_amdgcn_sched_barrier(0);
            }
            float v[32];
#pragma unroll
            for (int jl = 0; jl < 16; ++jl) { v[jl] = a0[jl] + a1[jl]; v[16 + jl] = a0[jl] * a0[jl] + a1[jl] * a1[jl]; }
#pragma unroll
            for (int st = 16; st >= 1; st >>= 1) {
                const bool up = (lane & st) != 0;
#pragma unroll
                for (int i2 = 0; i2 < st; ++i2) {
                    const float keep = up ? v[i2 + st] : v[i2], send = up ? v[i2] : v[i2 + st];
                    v[i2] = keep + __shfl_xor(send, st);
                }
            }
            const float tot = v[0] + __shfl_xor(v[0], 32);
            __syncthreads();
            if (lane < 32) red[wid * 32 + lane] = tot;
            __syncthreads();
#pragma unroll
            for (int jl = 0; jl < 16; ++jl) {
                const float sm = (red[jl] + red[32 + jl]) + (red[64 + jl] + red[96 + jl]);
                const float sq = (red[16 + jl] + red[48 + jl]) + (red[80 + jl] + red[112 + jl]);
                const float mu = sm * (1.0f / 512.0f);
                const float rstd = rsqrtf(fmaxf(sq * (1.0f / 512.0f) - mu * mu, 0.f) + LN_EPS);
                const float y0 = (a0[jl] - mu) * rstd * lg.x + lb.x, y1 = (a1[jl] - mu) * rstd * lg.y + lb.y;
                *(unsigned*)(p.mixb + (size_t)(tok0 + jh * 16 + jl) * DM + 512 + 2 * tid) = pack2(sigmul(y0, y0), sigmul(y1, y1));
            }
        }
    }
}

__device__ void ph_gemm_out(const Params& p, unsigned char* smem, const int vb) {
    const int ntn = DM / 256;
    const int tid = threadIdx.x, lane = tid & 63, wid = tid >> 6, wr = wid >> 1, wc = wid & 1, fr = lane & 15, fq = lane >> 4;
    for (int t = vb; t < (T_TOK / 128) * ntn; t += gridDim.x) {
        const int m0 = (t / ntn) * 128, n0 = (t % ntn) * 256;
        f32x4 acc[4][8]; zero_accw(acc);
        gemmW(p.mixb + (size_t)m0 * DM, DM, p.WoutT + (size_t)n0 * DM, DM, DM, smem, acc);
#pragma unroll
        for (int mi = 0; mi < 4; ++mi) {
            const int row = m0 + wr * 64 + mi * 16 + fr;
#pragma unroll
            for (int ni = 0; ni < 8; ++ni) {
                const int col = n0 + wc * 128 + ni * 16 + fq * 4;
                const f32x4 xv = *(const f32x4*)(p.x + (size_t)row * DM + col);
                *(f32x4*)(p.y1 + (size_t)row * DM + col) = xv * ALPHA + acc[mi][ni];
            }
        }
    }
}

__device__ __forceinline__ void ln_row(const float* __restrict__ src, const float* __restrict__ g, const float* __restrict__ bta,
                                       float* __restrict__ dstf, bf16_t* __restrict__ dstb, int lane) {
    f32x4 v[4]; float s = 0.f;
#pragma unroll
    for (int i = 0; i < 4; ++i) { v[i] = *(const f32x4*)(src + i * 256 + lane * 4); s += (v[i][0] + v[i][1]) + (v[i][2] + v[i][3]); }
    const float mu = wave_sum(s) * (1.0f / 1024.0f);
    float q = 0.f;
#pragma unroll
    for (int i = 0; i < 4; ++i) { const f32x4 d = v[i] - mu; q += (d[0] * d[0] + d[1] * d[1]) + (d[2] * d[2] + d[3] * d[3]); }
    const float rstd = rsqrtf(wave_sum(q) * (1.0f / 1024.0f) + LN_EPS);
#pragma unroll
    for (int i = 0; i < 4; ++i) {
        const f32x4 gg = *(const f32x4*)(g + i * 256 + lane * 4), bb = *(const f32x4*)(bta + i * 256 + lane * 4);
        const f32x4 y = (v[i] - mu) * rstd * gg + bb;
        if (dstf) *(f32x4*)(dstf + i * 256 + lane * 4) = y;
        if (dstb) { uint2 o; o.x = pack2(y[0], y[1]); o.y = pack2(y[2], y[3]); *(uint2*)(dstb + i * 256 + lane * 4) = o; }
    }
}
__device__ void ph_ln1(const Params& p, const int vb) {
    const int lane = threadIdx.x & 63, wid = threadIdx.x >> 6;
    for (int r = vb * 4 + wid; r < T_TOK; r += gridDim.x * 4)
        ln_row(p.y1 + (size_t)r * DM, p.ln1_g, p.ln1_b, (float*)nullptr, p.x1b + (size_t)r * DM, lane);
}
__device__ void ph_ln2(const Params& p, const int vb) {
    const int lane = threadIdx.x & 63, wid = threadIdx.x >> 6;
    for (int r = vb * 4 + wid; r < T_TOK; r += gridDim.x * 4)
        ln_row(p.out + (size_t)r * DM, p.ln2_g, p.ln2_b, p.out + (size_t)r * DM, (bf16_t*)nullptr, lane);
}

#define QSTR 136
__device__ __forceinline__ int f2key(float f) { const int b = __float_as_int(f); return b ^ ((b >> 31) & 0x7fffffff); }
__device__ __forceinline__ float key2f(int k) { return __int_as_float(k ^ ((k >> 31) & 0x7fffffff)); }
__device__ __forceinline__ void sort16_desc(int (&a)[16]) {
#pragma unroll
    for (int lk = 1; lk <= 4; ++lk) {
#pragma unroll
        for (int lj = lk - 1; lj >= 0; --lj) {
            const int k = 1 << lk, j = 1 << lj;
#pragma unroll
            for (int i = 0; i < 16; ++i) {
                const int l = i ^ j;
                if (l > i) {
                    const int hi = max(a[i], a[l]), lo = min(a[i], a[l]);
                    if ((i & k) == 0) { a[i] = hi; a[l] = lo; } else { a[i] = lo; a[l] = hi; }
                }
            }
        }
    }
}
__device__ __forceinline__ void merge_top16(int (&a)[16], const int (&b)[16]) {
#pragma unroll
    for (int i = 0; i < 16; ++i) a[i] = max(a[i], b[15 - i]);
#pragma unroll
    for (int lj = 3; lj >= 0; --lj) {
        const int j = 1 << lj;
#pragma unroll
        for (int i = 0; i < 16; ++i) {
            const int l = i ^ j;
            if (l > i) { const int hi = max(a[i], a[l]), lo = min(a[i], a[l]); a[i] = hi; a[l] = lo; }
        }
    }
}
__device__ __forceinline__ void top16_of_64(int (&v)[4][16]) {
    sort16_desc(v[0]); sort16_desc(v[1]); sort16_desc(v[2]); sort16_desc(v[3]);
    merge_top16(v[0], v[1]); merge_top16(v[0], v[2]); merge_top16(v[0], v[3]);
}

__device__ __forceinline__ void route_half(const Params& p, unsigned char* smem, int m0, int hp, int (&K)[16]) {
    bf16_t* Qs = (bf16_t*)smem;
    bf16_t* Ks = (bf16_t*)(smem + 128 * QSTR * 2);
    const int tid = threadIdx.x, lane = tid & 63, wid = tid >> 6, wr = wid >> 1, wc = wid & 1, fr = lane & 15, fq = lane >> 4;
    const int r32 = lane & 31, hh = lane >> 5;
    u32x4 kreg[8];
    {
        const bf16_t* kg = p.keysb + (size_t)hp * 128 * 128;
#pragma unroll
        for (int i = 0; i < 8; ++i) { const int c = tid + i * 256; kreg[i] = *(const u32x4*)(kg + (c >> 4) * 128 + (c & 15) * 8); }
    }
    {
        f32x4 acc[4][4]; zero_acc(acc);
        gemm128(p.x1b + (size_t)m0 * DM, DM, p.WqT + (size_t)hp * 128 * DM, DM, DM, smem, acc);
#pragma unroll
        for (int mi = 0; mi < 4; ++mi)
#pragma unroll
            for (int ni = 0; ni < 4; ++ni) {
                uint2 o; o.x = pack2(acc[mi][ni][0], acc[mi][ni][1]); o.y = pack2(acc[mi][ni][2], acc[mi][ni][3]);
                *(uint2*)(Qs + (wr * 64 + mi * 16 + fr) * QSTR + wc * 64 + ni * 16 + fq * 4) = o;
            }
    }
#pragma unroll
    for (int i = 0; i < 8; ++i) { const int c = tid + i * 256; *(u32x4*)(Ks + (c >> 4) * QSTR + (c & 15) * 8) = kreg[i]; }
    __syncthreads();
    f32x16 S[4];
#pragma unroll
    for (int mt = 0; mt < 4; ++mt)
#pragma unroll
        for (int r = 0; r < 16; ++r) S[mt][r] = 0.f;
#pragma unroll
    for (int kk = 0; kk < 8; ++kk) {
        const bf16x8 b = *(const bf16x8*)(Qs + (wid * 32 + r32) * QSTR + kk * 16 + hh * 8);
#pragma unroll
        for (int mt = 0; mt < 4; ++mt) {
            const bf16x8 a = *(const bf16x8*)(Ks + (mt * 32 + r32) * QSTR + kk * 16 + hh * 8);
            S[mt] = __builtin_amdgcn_mfma_f32_32x32x16_bf16(a, b, S[mt], 0, 0, 0);
        }
    }
    __syncthreads();
    int v[4][16];
#pragma unroll
    for (int mt = 0; mt < 4; ++mt)
#pragma unroll
        for (int r = 0; r < 16; ++r) {
            const int n = mt * 32 + (r & 3) + 8 * (r >> 2) + 4 * hh;
            v[mt][r] = (f2key(S[mt][r]) & ~0x7F) | (127 - n);
        }
    top16_of_64(v);
    int o[16];
#pragma unroll
    for (int i = 0; i < 16; ++i) o[i] = __shfl_xor(v[0][i], 32);
    merge_top16(v[0], o);
#pragma unroll
    for (int i = 0; i < 16; ++i) K[i] = v[0][i];
}

__device__ void ph_route(const Params& p, unsigned char* smem, const int vb) {
    const int tid = threadIdx.x, lane = tid & 63, wid = tid >> 6;
    const int r32 = lane & 31, hh = lane >> 5;
    const int hmask = -hh;
    int* KL = (int*)(smem + (size_t)wid * 32 * QSTR * 2);
    for (int u = vb; u < (T_TOK / 128) * 8; u += gridDim.x) {
        const int m0 = (u >> 3) * 128, h = u & 7;
        __syncthreads();
        int K0[16], K1[16];
        route_half(p, smem, m0, h * 2 + 0, K0);
        route_half(p, smem, m0, h * 2 + 1, K1);
#pragma unroll
        for (int i = 0; i < 16; ++i) KL[r32 * 33 + hh * 16 + i] = K0[i] ^ ((K0[i] ^ K1[i]) & hmask);
        float s1[16], s2[16];
#pragma unroll
        for (int i = 0; i < 16; ++i) { s1[i] = key2f(K0[i] & ~0x7F); s2[i] = key2f(K1[i] & ~0x7F); }
        int c[4][16];
#pragma unroll
        for (int i = 0; i < 16; ++i)
#pragma unroll
            for (int j = 0; j < 16; ++j)
                if ((i + 1) * (j + 1) <= 16) {
                    constexpr int OFFS[16] = {0, 16, 24, 29, 33, 36, 38, 40, 42, 43, 44, 45, 46, 47, 48, 49};
                    const int q = OFFS[i] + j;
                    c[q >> 4][q & 15] = (f2key(s1[i] + s2[j]) & ~0xFF) | (255 - (i * 16 + j));
                }
#pragma unroll
        for (int qq = 50; qq < 64; ++qq) c[qq >> 4][qq & 15] = (int)0x80000000;
        top16_of_64(c);
        const float mx = key2f(c[0][0] & ~0xFF);
        float e[16]; float den = 0.f;
#pragma unroll
        for (int i = 0; i < 16; ++i) { e[i] = __expf(key2f(c[0][i] & ~0xFF) - mx); den += e[i]; }
        const float inv = __builtin_amdgcn_rcpf(den);
        const size_t ob = (size_t)(m0 + wid * 32 + r32) * 128 + h * 16 + hh * 8;
        int idv[8]; float gv[8];
#pragma unroll
        for (int qq = 0; qq < 8; ++qq) {
            const int F = c[0][qq] ^ ((c[0][qq] ^ c[0][8 + qq]) & hmask);
            gv[qq] = __int_as_float(__float_as_int(e[qq]) ^ ((__float_as_int(e[qq]) ^ __float_as_int(e[8 + qq])) & hmask)) * inv;
            const int idx = 255 - (F & 0xFF);
            const int k0 = KL[r32 * 33 + (idx >> 4)], k1 = KL[r32 * 33 + 16 + (idx & 15)];
            idv[qq] = (127 - (k0 & 0x7F)) * 128 + (127 - (k1 & 0x7F));
        }
        *(int4*)(p.ids + ob) = make_int4(idv[0], idv[1], idv[2], idv[3]);
        *(int4*)(p.ids + ob + 4) = make_int4(idv[4], idv[5], idv[6], idv[7]);
        *(float4*)(p.gates + ob) = make_float4(gv[0], gv[1], gv[2], gv[3]);
        *(float4*)(p.gates + ob + 4) = make_float4(gv[4], gv[5], gv[6], gv[7]);
    }
}

typedef __bf16 bf16x2_t __attribute__((ext_vector_type(2)));
__device__ __forceinline__ float dot2bf(unsigned a, unsigned b, float acc) {
    return __builtin_amdgcn_fdot2_f32_bf16(__builtin_bit_cast(bf16x2_t, a), __builtin_bit_cast(bf16x2_t, b), acc, false);
}
__device__ __forceinline__ f32x2 row_dot(const u32x4 w, const f32x2 (&x)[8], f32x2 acc) {
#pragma unroll
    for (int k = 0; k < 4; ++k) {
        acc = __builtin_amdgcn_cvt_pk_f32_fp8(w[k], false) * x[2 * k] + acc;
        acc = __builtin_amdgcn_cvt_pk_f32_fp8(w[k], true) * x[2 * k + 1] + acc;
    }
    return acc;
}
__device__ __forceinline__ float peer_u_round(const unsigned char* __restrict__ u8, int idv, const f32x2 (&x)[8], int lane) {
    u32x4 ra[8], rb[8];
#pragma unroll
    for (int j = 0; j < 8; ++j) {
        ra[j] = *(const u32x4*)(u8 + (size_t)__builtin_amdgcn_readlane(idv, j * 8) * DM + lane * 16);
        rb[j] = *(const u32x4*)(u8 + (size_t)__builtin_amdgcn_readlane(idv, j * 8 + 1) * DM + lane * 16);
    }
    float h = 0.f;
    const bool up16 = (lane & 16) != 0, up8 = (lane & 8) != 0;
#pragma unroll 1
    for (int c2 = 0; c2 < 4; ++c2) {
#pragma unroll
        for (int par = 0; par < 2; ++par) {
            const int c = c2 * 2 + par;
            float s[8];
#pragma unroll
            for (int j = 0; j < 8; ++j) {
                const f32x2 a = row_dot(par ? rb[j] : ra[j], x, (f32x2){0.f, 0.f});
                s[j] = a.x + a.y;
                if (c2 < 3) {
                    const u32x4 nw = *(const u32x4*)(u8 + (size_t)__builtin_amdgcn_readlane(idv, j * 8 + c + 2) * DM + lane * 16);
                    if (par) rb[j] = nw; else ra[j] = nw;
                }
            }
#pragma unroll
            for (int j = 0; j < 4; ++j) {
                auto r = __builtin_amdgcn_permlane32_swap(__float_as_uint(s[j]), __float_as_uint(s[j + 4]), false, false);
                s[j] = __uint_as_float(r[0]) + __uint_as_float(r[1]);
            }
#pragma unroll
            for (int j = 0; j < 2; ++j) {
                const float keep = up16 ? s[j + 2] : s[j], send = up16 ? s[j] : s[j + 2];
                s[j] = keep + __shfl_xor(send, 16);
            }
            float t;
            { const float keep = up8 ? s[1] : s[0], send = up8 ? s[0] : s[1]; t = keep + __shfl_xor(send, 8); }
            t += __shfl_xor(t, 4); t += __shfl_xor(t, 2); t += __shfl_xor(t, 1);
            if ((lane & 7) == c) h = t;
        }
    }
    return h;
}
#define PEER_DV 16
__device__ __forceinline__ void peer_v_round(const unsigned char* __restrict__ v8, int idv, float actv, f32x2 (&o)[8], int lane) {
    u32x4 rb[PEER_DV];
#pragma unroll
    for (int i = 0; i < PEER_DV; ++i) rb[i] = *(const u32x4*)(v8 + (size_t)__builtin_amdgcn_readlane(idv, i) * DM + lane * 16);
#pragma unroll 1
    for (int e0 = 0; e0 < 64; e0 += PEER_DV) {
#pragma unroll
        for (int i = 0; i < PEER_DV; ++i) {
            const float a = __int_as_float(__builtin_amdgcn_readlane(__float_as_int(actv), e0 + i));
            const f32x2 a2 = {a, a};
            const u32x4 w = rb[i];
#pragma unroll
            for (int k = 0; k < 4; ++k) {
                o[2 * k] = __builtin_amdgcn_cvt_pk_f32_fp8(w[k], false) * a2 + o[2 * k];
                o[2 * k + 1] = __builtin_amdgcn_cvt_pk_f32_fp8(w[k], true) * a2 + o[2 * k + 1];
            }
            if (e0 + PEER_DV < 64) rb[i] = *(const u32x4*)(v8 + (size_t)__builtin_amdgcn_readlane(idv, e0 + PEER_DV + i) * DM + lane * 16);
        }
    }
}
__device__ __forceinline__ float gelu_gate(float h, float g) { return 0.5f * h * (1.0f + erff(h * 0.70710678118654752f)) * g; }

__device__ void ph_peer(const Params& p, const int vb) {
    const int lane = threadIdx.x & 63;
    const int wid = __builtin_amdgcn_readfirstlane(threadIdx.x >> 6);
    for (int t = vb * 4 + wid; t < T_TOK; t += gridDim.x * 4) {
        const int id0 = p.ids[(size_t)t * 128 + lane], id1 = p.ids[(size_t)t * 128 + 64 + lane];
        const float g0 = p.gates[(size_t)t * 128 + lane], g1 = p.gates[(size_t)t * 128 + 64 + lane];
        const float su0 = p.su[id0], su1 = p.su[id1], sv0 = p.sv[id0], sv1 = p.sv[id1];
        const float* xr = p.x1 + (size_t)t * DM + lane * 16;
        f32x2 x[8];
        {
            const f32x4 a = *(const f32x4*)(xr), b = *(const f32x4*)(xr + 4), c = *(const f32x4*)(xr + 8), d = *(const f32x4*)(xr + 12);
            x[0] = (f32x2){a[0], a[1]}; x[1] = (f32x2){a[2], a[3]}; x[2] = (f32x2){b[0], b[1]}; x[3] = (f32x2){b[2], b[3]};
            x[4] = (f32x2){c[0], c[1]}; x[5] = (f32x2){c[2], c[3]}; x[6] = (f32x2){d[0], d[1]}; x[7] = (f32x2){d[2], d[3]};
        }
        const float h0 = peer_u_round(p.u8, id0, x, lane) * su0;
        const float h1 = peer_u_round(p.u8, id1, x, lane) * su1;
        const float a0 = gelu_gate(h0, g0) * sv0, a1 = gelu_gate(h1, g1) * sv1;
        f32x2 o[8];
#pragma unroll
        for (int i = 0; i < 8; ++i) o[i] = (f32x2){0.f, 0.f};
        peer_v_round(p.v8, id0, a0, o, lane);
        peer_v_round(p.v8, id1, a1, o, lane);
        float r[16];
#pragma unroll
        for (int i = 0; i < 8; ++i) { r[2 * i] = ALPHA * x[i].x + o[i].x; r[2 * i + 1] = ALPHA * x[i].y + o[i].y; }
        float* rr = p.y1 + (size_t)t * DM + lane * 16;
        *(f32x4*)(rr) = (f32x4){r[0], r[1], r[2], r[3]};
        *(f32x4*)(rr + 4) = (f32x4){r[4], r[5], r[6], r[7]};
        *(f32x4*)(rr + 8) = (f32x4){r[8], r[9], r[10], r[11]};
        *(f32x4*)(rr + 12) = (f32x4){r[12], r[13], r[14], r[15]};
        bf16_t* rbp = p.rb + (size_t)t * DM + lane * 16;
        u32x4 w0, w1;
        w0[0] = pack2(r[0], r[1]); w0[1] = pack2(r[2], r[3]); w0[2] = pack2(r[4], r[5]); w0[3] = pack2(r[6], r[7]);
        w1[0] = pack2(r[8], r[9]); w1[1] = pack2(r[10], r[11]); w1[2] = pack2(r[12], r[13]); w1[3] = pack2(r[14], r[15]);
        *(u32x4*)(rbp) = w0; *(u32x4*)(rbp + 8) = w1;
    }
}

__device__ __forceinline__ void ld_ids16(const int* __restrict__ q, int (&idv)[16]) {
    const int4* idp = (const int4*)q;
#pragma unroll
    for (int k = 0; k < 4; ++k) { const int4 v = idp[k]; idv[4 * k] = v.x; idv[4 * k + 1] = v.y; idv[4 * k + 2] = v.z; idv[4 * k + 3] = v.w; }
}
__device__ __forceinline__ void ld_f16(const float* __restrict__ q, float (&a)[16]) {
    const f32x4* ap = (const f32x4*)q;
#pragma unroll
    for (int k = 0; k < 4; ++k) { const f32x4 v = ap[k]; a[4 * k] = v[0]; a[4 * k + 1] = v[1]; a[4 * k + 2] = v[2]; a[4 * k + 3] = v[3]; }
}
__device__ void ph_peer_u(const Params& p, unsigned char* smem, const int vb) {
    const int lane = threadIdx.x & 63, wid = threadIdx.x >> 6, g = lane >> 3, c = lane & 7;
    const int nlb = gridDim.x >> 3, s = vb / nlb, lb = vb - s * nlb;
    const bool b2 = (lane & 4) != 0, b1 = (lane & 2) != 0, b0 = (lane & 1) != 0;
    const int cc = (b0 ? 2 : 0) + (b1 ? 4 : 0) + (b2 ? 8 : 0);
    const unsigned char* ubase = p.u8 + (size_t)s * (16384 * 128) + c * 16;
    const int stride = nlb * 4, t0 = lb * 4 + wid;
    const int ntok = (T_TOK - t0 + stride - 1) / stride;
    if (ntok <= 0) return;
    LDS_AS unsigned char* ring = (LDS_AS unsigned char*)smem + wid * 2048;
    const int* idg = p.ids + 2 * lane;
    const bf16_t* xg = p.x1b + s * 128 + 2 * lane;
#define PU_TOK(n) (t0 + ((n) < ntok ? (n) : ntok - 1) * stride)
#define PU_RAW_LD(n, ri, rx) do { const int _t = PU_TOK(n); ri = *(const u32x2*)(idg + (size_t)_t * 128); const unsigned _w = *(const unsigned*)(xg + (size_t)_t * DM); rx = (u32x2){_w << 16, _w & 0xffff0000u}; } while (0)
#define PU_RAW_ST(n, ri, rx) do { LDS_AS unsigned char* _b = ring + ((n) & 1) * 1024; *(LDS_AS u32x2*)(_b + lane * 8) = ri; *(LDS_AS u32x2*)(_b + 512 + lane * 8) = rx; } while (0)
#define PU_IDS(n, idv) do { const LDS_AS u32x4* _q = (const LDS_AS u32x4*)(ring + ((n) & 1) * 1024 + g * 64); \
        _Pragma("unroll") for (int _k = 0; _k < 4; ++_k) { const u32x4 _v = _q[_k]; idv[4 * _k] = (int)_v[0]; idv[4 * _k + 1] = (int)_v[1]; idv[4 * _k + 2] = (int)_v[2]; idv[4 * _k + 3] = (int)_v[3]; } } while (0)
    u32x4 wA[8], wB[8]; u32x2 ri, rx;
    {
        u32x2 i0, x0, i1, x1v;
        PU_RAW_LD(0, i0, x0); PU_RAW_LD(1, i1, x1v); PU_RAW_LD(2, ri, rx);
        PU_RAW_ST(0, i0, x0); PU_RAW_ST(1, i1, x1v);
        int id0[16]; PU_IDS(0, id0);
#pragma unroll
        for (int i = 0; i < 8; ++i) wA[i] = *(const u32x4*)(ubase + (size_t)id0[i] * 128);
#pragma unroll
        for (int i = 0; i < 8; ++i) wB[i] = *(const u32x4*)(ubase + (size_t)id0[8 + i] * 128);
    }
#pragma unroll 1
    for (int n = 0; n < ntok; ++n) {
        const int t = t0 + n * stride;
        f32x2 x[8];
        {
            const LDS_AS f32x4* q = (const LDS_AS f32x4*)(ring + (n & 1) * 1024 + 512 + c * 64);
#pragma unroll
            for (int k = 0; k < 4; ++k) { const f32x4 v4 = q[k]; x[2 * k] = (f32x2){v4[0], v4[1]}; x[2 * k + 1] = (f32x2){v4[2], v4[3]}; }
        }
        int idn[16]; PU_IDS(n + 1, idn);
        float v[16];
#pragma unroll
        for (int i = 0; i < 8; ++i) { const f32x2 a = row_dot(wA[i], x, (f32x2){0.f, 0.f}); v[i] = a.x + a.y; }
#pragma unroll
        for (int i = 0; i < 8; ++i) wA[i] = *(const u32x4*)(ubase + (size_t)idn[i] * 128);
#pragma unroll
        for (int i = 0; i < 8; ++i) { const f32x2 a = row_dot(wB[i], x, (f32x2){0.f, 0.f}); v[8 + i] = a.x + a.y; }
#pragma unroll
        for (int i = 0; i < 8; ++i) wB[i] = *(const u32x4*)(ubase + (size_t)idn[8 + i] * 128);
        PU_RAW_ST(n + 2, ri, rx);
        PU_RAW_LD(n + 3, ri, rx);
#pragma unroll
        for (int i = 0; i < 8; ++i) { const float keep = b2 ? v[i + 8] : v[i], send = b2 ? v[i] : v[i + 8]; v[i] = keep + __shfl_xor(send, 4); }
#pragma unroll
        for (int i = 0; i < 4; ++i) { const float keep = b1 ? v[i + 4] : v[i], send = b1 ? v[i] : v[i + 4]; v[i] = keep + __shfl_xor(send, 2); }
#pragma unroll
        for (int i = 0; i < 2; ++i) { const float keep = b0 ? v[i + 2] : v[i], send = b0 ? v[i] : v[i + 2]; v[i] = keep + __shfl_xor(send, 1); }
        *(unsigned*)(p.hp + ((size_t)t * 8 + s) * 128 + g * 16 + cc) = pack2(v[0], v[1]);
    }
}
__device__ void ph_peer_act(const Params& p, const int vb) {
    const int lane = threadIdx.x & 63, wid = threadIdx.x >> 6;
    for (int t = vb * 4 + wid; t < T_TOK; t += gridDim.x * 4) {
        f32x2 h = {0.f, 0.f};
#pragma unroll
        for (int s = 0; s < 8; ++s) { const unsigned w = *(const unsigned*)(p.hp + ((size_t)t * 8 + s) * 128 + 2 * lane); h += (f32x2){bflo(w), bfhi(w)}; }
        const int2 id = *(const int2*)(p.ids + (size_t)t * 128 + 2 * lane);
        const f32x2 gt = *(const f32x2*)(p.gates + (size_t)t * 128 + 2 * lane);
        f32x2 a;
        a.x = gelu_gate(h.x * p.su[id.x], gt.x) * p.sv[id.x];
        a.y = gelu_gate(h.y * p.su[id.y], gt.y) * p.sv[id.y];
        *(f32x2*)(p.gates + (size_t)t * 128 + 2 * lane) = a;
    }
}
__device__ void ph_peer_v(const Params& p, unsigned char* smem, const int vb) {
    const int lane = threadIdx.x & 63, wid = threadIdx.x >> 6, g = lane >> 3, c = lane & 7;
    const int nlb = gridDim.x >> 3, s = vb / nlb, lb = vb - s * nlb;
    const bool b4 = (lane & 16) != 0, b3 = (lane & 8) != 0;
    const unsigned char* vbase = p.v8 + (size_t)s * (16384 * 128) + c * 16;
    const int stride = nlb * 4, t0 = lb * 4 + wid;
    const int ntok = (T_TOK - t0 + stride - 1) / stride;
    if (ntok <= 0) return;
    const int d0 = s * 128 + c * 16 + 2 * g;
    LDS_AS unsigned char* ring = (LDS_AS unsigned char*)smem + wid * 2048;
    const int* idg = p.ids + 2 * lane;
    const float* ag = p.gates + 2 * lane;
#define PV_RAW_LD(n, ri, rx) do { const int _t = PU_TOK(n); ri = *(const u32x2*)(idg + (size_t)_t * 128); rx = *(const u32x2*)(ag + (size_t)_t * 128); } while (0)
    u32x4 wA[8], wB[8]; u32x2 ri, rx;
    {
        u32x2 i0, x0, i1, x1v;
        PV_RAW_LD(0, i0, x0); PV_RAW_LD(1, i1, x1v); PV_RAW_LD(2, ri, rx);
        PU_RAW_ST(0, i0, x0); PU_RAW_ST(1, i1, x1v);
        int id0[16]; PU_IDS(0, id0);
#pragma unroll
        for (int i = 0; i < 8; ++i) wA[i] = *(const u32x4*)(vbase + (size_t)id0[i] * 128);
#pragma unroll
        for (int i = 0; i < 8; ++i) wB[i] = *(const u32x4*)(vbase + (size_t)id0[8 + i] * 128);
    }
#pragma unroll 1
    for (int n = 0; n < ntok; ++n) {
        const int t = t0 + n * stride;
        const unsigned xw = *(const unsigned*)(p.x1b + (size_t)t * DM + d0);
        const f32x2 xv = {bflo(xw), bfhi(xw)};
        float ac[16];
        {
            const LDS_AS f32x4* q = (const LDS_AS f32x4*)(ring + (n & 1) * 1024 + 512 + g * 64);
#pragma unroll
            for (int k = 0; k < 4; ++k) { const f32x4 v4 = q[k]; ac[4 * k] = v4[0]; ac[4 * k + 1] = v4[1]; ac[4 * k + 2] = v4[2]; ac[4 * k + 3] = v4[3]; }
        }
        int idn[16]; PU_IDS(n + 1, idn);
        f32x2 acc[8];
#pragma unroll
        for (int k = 0; k < 8; ++k) acc[k] = (f32x2){0.f, 0.f};
#pragma unroll
        for (int i = 0; i < 8; ++i) {
            const f32x2 a2 = {ac[i], ac[i]};
#pragma unroll
            for (int k = 0; k < 4; ++k) {
                acc[2 * k] = __builtin_amdgcn_cvt_pk_f32_fp8(wA[i][k], false) * a2 + acc[2 * k];
                acc[2 * k + 1] = __builtin_amdgcn_cvt_pk_f32_fp8(wA[i][k], true) * a2 + acc[2 * k + 1];
            }
        }
#pragma unroll
        for (int i = 0; i < 8; ++i) wA[i] = *(const u32x4*)(vbase + (size_t)idn[i] * 128);
#pragma unroll
        for (int i = 0; i < 8; ++i) {
            const f32x2 a2 = {ac[8 + i], ac[8 + i]};
#pragma unroll
            for (int k = 0; k < 4; ++k) {
                acc[2 * k] = __builtin_amdgcn_cvt_pk_f32_fp8(wB[i][k], false) * a2 + acc[2 * k];
                acc[2 * k + 1] = __builtin_amdgcn_cvt_pk_f32_fp8(wB[i][k], true) * a2 + acc[2 * k + 1];
            }
        }
#pragma unroll
        for (int i = 0; i < 8; ++i) wB[i] = *(const u32x4*)(vbase + (size_t)idn[8 + i] * 128);
        PU_RAW_ST(n + 2, ri, rx);
        PV_RAW_LD(n + 3, ri, rx);
        float v[16];
#pragma unroll
        for (int k = 0; k < 8; ++k) { v[2 * k] = acc[k].x; v[2 * k + 1] = acc[k].y; }
#pragma unroll
        for (int j2 = 0; j2 < 8; ++j2) {
            auto r = __builtin_amdgcn_permlane32_swap(__float_as_uint(v[j2]), __float_as_uint(v[j2 + 8]), false, false);
            v[j2] = __uint_as_float(r[0]) + __uint_as_float(r[1]);
        }
#pragma unroll
        for (int j2 = 0; j2 < 4; ++j2) { const float keep = b4 ? v[j2 + 4] : v[j2], send = b4 ? v[j2] : v[j2 + 4]; v[j2] = keep + __shfl_xor(send, 16); }
#pragma unroll
        for (int j2 = 0; j2 < 2; ++j2) { const float keep = b3 ? v[j2 + 2] : v[j2], send = b3 ? v[j2] : v[j2 + 2]; v[j2] = keep + __shfl_xor(send, 8); }
        const float r0 = ALPHA * xv.x + v[0], r1 = ALPHA * xv.y + v[1];
        *(unsigned*)(p.rb + (size_t)t * DM + d0) = pack2(r0, r1);
    }
}

__device__ void ph_gemm_ple(const Params& p, unsigned char* smem, const int vb) {
    const int ntn = DM / 128;
    const int tid = threadIdx.x, lane = tid & 63, wid = tid >> 6, wr = wid >> 1, wc = wid & 1, fr = lane & 15, fq = lane >> 4;
    for (int t = vb; t < (T_TOK / 128) * ntn; t += gridDim.x) {
        const int m0 = (t / ntn) * 128, n0 = (t % ntn) * 128;
        f32x4 acc[4][4], acc2[4][4]; zero_acc(acc); zero_acc(acc2);
        gemm128(p.pb + (size_t)m0 * 256, 256, p.WpT + (size_t)n0 * 256, 256, 256, smem, acc2);
        gemm128(p.rb + (size_t)m0 * DM, DM, p.WgT + (size_t)n0 * DM, DM, DM, smem, acc);
#pragma unroll
        for (int mi = 0; mi < 4; ++mi) {
            const int row = m0 + wr * 64 + mi * 16 + fr;
#pragma unroll
            for (int ni = 0; ni < 4; ++ni) {
                const int col = n0 + wc * 64 + ni * 16 + fq * 4;
                const u32x2 rw = *(const u32x2*)(p.rb + (size_t)row * DM + col);
                f32x4 rv = {bflo(rw[0]), bfhi(rw[0]), bflo(rw[1]), bfhi(rw[1])};
#pragma unroll
                for (int r = 0; r < 4; ++r) rv[r] += sigmul(acc2[mi][ni][r], acc[mi][ni][r]);
                *(f32x4*)(p.out + (size_t)row * DM + col) = rv;
            }
        }
    }
}

#define XB_TMO      128
#define XB_XCNT(j)  (256  + 64 * (j))
#define XB_XSUB(j)  (1280 + 64 * (j))
#define XB_XGEN(j)  (2304 + 64 * (j))
#define XB_TOP      3328
#define XB_TOPGEN   3392
#define XCD_BAR_WORDS 3456
#define XB_SPIN_CAP (1u << 20)
__device__ __forceinline__ unsigned xb_ld(unsigned* p)              { return __hip_atomic_load(p, __ATOMIC_RELAXED, __HIP_MEMORY_SCOPE_AGENT); }
__device__ __forceinline__ unsigned xb_add(unsigned* p, unsigned v) { return __hip_atomic_fetch_add(p, v, __ATOMIC_RELAXED, __HIP_MEMORY_SCOPE_AGENT); }
__device__ __forceinline__ unsigned xb_xcc_id() { return (unsigned)__builtin_amdgcn_s_getreg((3 << 11) | 20) & 0xFu; }
#define XB_SPIN(cond, bar) do { unsigned _sp = 0; while (cond) { __builtin_amdgcn_s_sleep(1); \
    if ((++_sp & 255u) == 0u) { if (xb_ld(&(bar)[XB_TMO])) break; if (_sp > XB_SPIN_CAP) { atomicAdd(&(bar)[XB_TMO], 1u); break; } } } } while (0)
struct XcdBarrier { unsigned* bar; unsigned x; volatile LDS_AS unsigned* st; };
__device__ __forceinline__ XcdBarrier xcd_barrier_post(unsigned* bar, volatile LDS_AS unsigned* st) {
    XcdBarrier b; b.bar = bar; b.x = xb_xcc_id(); b.st = st;
    if (threadIdx.x == 0) st[3] = xb_add(&bar[XB_XCNT(b.x)], 1u);
    return b;
}
__device__ __forceinline__ void xcd_barrier_complete(unsigned* bar, unsigned x, unsigned rank, unsigned& nloc, unsigned& nx, unsigned& vb) {
    const unsigned G = gridDim.x;
    unsigned sum, cnt, mine, sp = 0u; bool even;
    for (;;) {
        sum = 0u; cnt = 0u; mine = 0u; even = true;
#pragma unroll
        for (unsigned j = 0; j < 16; ++j) {
            const unsigned c = xb_ld(&bar[XB_XCNT(j)]); sum += c; cnt += (c > 0u) ? 1u : 0u; mine = (j == x) ? c : mine;
            even = even && (c == ((j < 8u) ? (G >> 3) : 0u));
        }
        if (sum == G) break;
        __builtin_amdgcn_s_sleep(1);
        if ((++sp & 255u) == 0u) { if (xb_ld(&bar[XB_TMO])) break; if (sp > XB_SPIN_CAP) { atomicAdd(&bar[XB_TMO], 1u); break; } }
    }
    nloc = mine > 0u ? mine : 1u; nx = cnt > 0u ? cnt : 1u;
    vb = (even && sum == G && (G & 7u) == 0u) ? (x * (G >> 3) + rank) : blockIdx.x;
}
__device__ __forceinline__ void xcd_barrier(const XcdBarrier& b) {
    asm volatile("s_waitcnt vmcnt(0)" ::: "memory");
    __syncthreads();
    if (threadIdx.x == 0) {
        unsigned* bar = b.bar;
        __builtin_amdgcn_s_waitcnt(0);
        unsigned nloc = b.st[0], nx = b.st[1];
        if (nloc == 0u) { unsigned vb; xcd_barrier_complete(bar, b.x, b.st[3], nloc, nx, vb); b.st[0] = nloc; b.st[1] = nx; b.st[2] = vb; }
        const unsigned old = xb_add(&bar[XB_XSUB(b.x)], 1u);
        const unsigned gen = old / nloc;
        if (old + 1u == (gen + 1u) * nloc) {
            __builtin_amdgcn_fence(__ATOMIC_RELEASE, "agent");
            asm volatile("s_waitcnt vmcnt(0)" ::: "memory");
            const unsigned og = xb_add(&bar[XB_TOP], 1u);
            const unsigned tg = og / nx;
            if (og + 1u == (tg + 1u) * nx) xb_add(&bar[XB_TOPGEN], 1u);
            else XB_SPIN(xb_ld(&bar[XB_TOPGEN]) == tg, bar);
            __builtin_amdgcn_fence(__ATOMIC_ACQUIRE, "agent");
            xb_add(&bar[XB_XGEN(b.x)], 1u);
            asm volatile("s_waitcnt vmcnt(0)" ::: "memory");
        } else {
            XB_SPIN(xb_ld(&bar[XB_XGEN(b.x)]) == gen, bar);
            __builtin_amdgcn_fence(__ATOMIC_ACQUIRE, "agent");
            asm volatile("s_waitcnt vmcnt(0)" ::: "memory");
        }
    }
    __syncthreads();
}

#define SMEM_PHASE (256 * ASTR * 2 * 2)
#define SMEM_BYTES (SMEM_PHASE + 16)
__global__ void __launch_bounds__(256, 2) mega(Params p) {
    __shared__ __attribute__((aligned(16))) unsigned char smem[SMEM_BYTES];
    volatile LDS_AS unsigned* st = (volatile LDS_AS unsigned*)(LDS_AS unsigned char*)(smem + SMEM_PHASE);
    if (threadIdx.x < 4) st[threadIdx.x] = 0u;
    __syncthreads();
    const XcdBarrier gb = xcd_barrier_post(p.bar, st);
    ph_prep(p, smem);            xcd_barrier(gb);
    const int vb = (int)st[2];
    ph_gemm_in(p, smem, vb);     xcd_barrier(gb);
    ph_attn(p, smem, vb);
    ph_conv(p, smem, vb);        xcd_barrier(gb);
    ph_gemm_out(p, smem, vb);    xcd_barrier(gb);
    ph_ln1(p, vb);               xcd_barrier(gb);
    ph_route(p, smem, vb);       xcd_barrier(gb);
    ph_peer_u(p, smem, vb);      xcd_barrier(gb);
    ph_peer_act(p, vb);          xcd_barrier(gb);
    ph_peer_v(p, smem, vb);      xcd_barrier(gb);
    ph_gemm_ple(p, smem, vb);    xcd_barrier(gb);
    ph_ln2(p, vb);
}

extern "C" void kernel_launch(void* const* d_in, const int* in_sizes, int n_in, void* d_out, int out_size, void* d_ws, size_t ws_size,
                              hipStream_t stream) {
    Params p{};
    p.x = (const float*)d_in[0]; p.p = (const float*)d_in[1]; p.pos = (const int*)d_in[2];
    p.w_in = (const float*)d_in[3]; p.sinks = (const float*)d_in[4]; p.conv_w = (const float*)d_in[5]; p.conv_b = (const float*)d_in[6];
    p.cln_g = (const float*)d_in[7]; p.cln_b = (const float*)d_in[8]; p.w_out = (const float*)d_in[9]; p.ln1_g = (const float*)d_in[10];
    p.ln1_b = (const float*)d_in[11]; p.wq = (const float*)d_in[12]; p.keys = (const float*)d_in[13]; p.pu = (const float*)d_in[14];
    p.pv = (const float*)d_in[15]; p.ple_proj = (const float*)d_in[16]; p.ple_gate = (const float*)d_in[17]; p.ln2_g = (const float*)d_in[18];
    p.ln2_b = (const float*)d_in[19];
    p.out = (float*)d_out;
    unsigned char* ws = (unsigned char*)d_ws;
    const size_t MiB = 1024 * 1024;
    p.y1 = (float*)(ws + 0 * MiB);
    p.hb = (bf16_t*)(ws + 128 * MiB);
    p.qb = (bf16_t*)(ws + 128 * MiB);
    p.hp = (bf16_t*)(ws + 128 * MiB);
    p.xb = (bf16_t*)(ws + 256 * MiB);
    p.x1b = (bf16_t*)(ws + 256 * MiB);
    p.mixb = (bf16_t*)(ws + 320 * MiB);
    p.tops = (float*)(ws + 320 * MiB);
    p.topi = (int*)(ws + 352 * MiB);
    p.rb = (bf16_t*)(ws + 320 * MiB);
    p.pb = (bf16_t*)(ws + 384 * MiB);
    p.ub = (bf16_t*)(ws + 400 * MiB);
    p.vb = (bf16_t*)(ws + 432 * MiB);
    p.u8 = (unsigned char*)(ws + 400 * MiB);
    p.v8 = (unsigned char*)(ws + 416 * MiB);
    p.su = (float*)(ws + 432 * MiB);
    p.sv = (float*)(ws + 433 * MiB);
    p.ids = (int*)(ws + 464 * MiB);
    p.gates = (float*)(ws + 480 * MiB);
    unsigned char* wb = ws + 496 * MiB;
    p.WinT = (bf16_t*)wb; wb += (size_t)INW * DM * 2;
    p.WoutT = (bf16_t*)wb; wb += (size_t)DM * DM * 2;
    p.WqT = (bf16_t*)wb; wb += (size_t)2048 * DM * 2;
    p.WgT = (bf16_t*)wb; wb += (size_t)DM * DM * 2;
    p.WpT = (bf16_t*)wb; wb += (size_t)DM * 256 * 2;
    p.keysb = (bf16_t*)wb; wb += (size_t)16 * 128 * 128 * 2;
    p.bar = (unsigned*)(ws + 510 * MiB);
    p.x1 = (float*)d_out;

    static int grid_blocks = 0;
    if (!grid_blocks) {
        int dev = 0, cus = 0, per_cu = 0;
        (void)hipGetDevice(&dev);
        (void)hipDeviceGetAttribute(&cus, hipDeviceAttributeMultiprocessorCount, dev);
        (void)hipOccupancyMaxActiveBlocksPerMultiprocessor(&per_cu, mega, 256, 0);
        if (per_cu > 2) per_cu = 2;
        grid_blocks = cus * per_cu;
    }
    (void)hipMemsetAsync(p.bar, 0, XCD_BAR_WORDS * sizeof(unsigned), stream);
    void* args[] = {&p};
    hipError_t e = hipLaunchCooperativeKernel((void*)mega, dim3(grid_blocks), dim3(256), args, 0, stream);
    if (e != hipSuccess) fprintf(stderr, "cooperative launch failed: %s (grid %d)\n", hipGetErrorString(e), grid_blocks);
}
```

```cpp
#include <hip/hip_runtime.h>
#include <hip/hip_cooperative_groups.h>
#include <stdint.h>
#include <cstdio>
namespace cg = cooperative_groups;

typedef unsigned short bf16_t;
typedef short bf16x8 __attribute__((ext_vector_type(8)));
typedef float f32x4 __attribute__((ext_vector_type(4)));
typedef unsigned u32x4 __attribute__((ext_vector_type(4)));
typedef float f32x2 __attribute__((ext_vector_type(2)));

#define T_TOK 32768
#define SEQ 2048
#define DM 1024
#define INW 1792
#define ALPHA 1.189207115002721f
#define LN_EPS 1e-5f

__device__ __forceinline__ bf16_t f2bf(float f) {
    unsigned u = __float_as_uint(f);
    u += 0x7fffu + ((u >> 16) & 1u);
    return (bf16_t)(u >> 16);
}
__device__ __forceinline__ float bf2f(bf16_t b) { return __uint_as_float(((unsigned)b) << 16); }
__device__ __forceinline__ float bflo(unsigned w) { return __uint_as_float(w << 16); }
__device__ __forceinline__ float bfhi(unsigned w) { return __uint_as_float(w & 0xffff0000u); }
__device__ __forceinline__ unsigned pack2(float a, float b) { return (unsigned)f2bf(a) | ((unsigned)f2bf(b) << 16); }

__device__ __forceinline__ float sigmul(float x, float g) { return x * __builtin_amdgcn_rcpf(1.0f + __expf(-g)); }
__device__ __forceinline__ float wave_sum(float v) {
#pragma unroll
    for (int o = 32; o >= 1; o >>= 1) v += __shfl_xor(v, o);
    return v;
}

struct Params {
    const float *x, *p; const int* pos;
    const float *w_in, *sinks, *conv_w, *conv_b, *cln_g, *cln_b, *w_out, *ln1_g, *ln1_b;
    const float *wq, *keys, *pu, *pv, *ple_proj, *ple_gate, *ln2_g, *ln2_b;
    float* out;
    bf16_t *xb, *pb, *WinT, *WoutT, *WqT, *WgT, *WpT, *keysb, *Wqb, *MT, *ub, *vb, *hb, *mixb, *x1b, *qb, *rb;
    float *y1, *x1, *tops, *gates, *su, *sv;
    bf16_t* hp;
    int *topi, *ids;
    unsigned char *u8, *v8;
    unsigned* bar;
};

__device__ void cvt_rows(const float* __restrict__ src, bf16_t* __restrict__ dst, size_t n) {
    const size_t nv = n / 8, gs = (size_t)gridDim.x * blockDim.x;
    for (size_t i = (size_t)blockIdx.x * blockDim.x + threadIdx.x; i < nv; i += 4 * gs) {
        f32x4 a[4], b[4];
#pragma unroll
        for (int q = 0; q < 4; ++q) { const size_t k = (i + q * gs < nv) ? i + q * gs : i; a[q] = ((const f32x4*)src)[2 * k]; b[q] = ((const f32x4*)src)[2 * k + 1]; }
#pragma unroll
        for (int q = 0; q < 4; ++q) {
            if (i + q * gs < nv) {
                u32x4 o; o[0] = pack2(a[q][0], a[q][1]); o[1] = pack2(a[q][2], a[q][3]); o[2] = pack2(b[q][0], b[q][1]); o[3] = pack2(b[q][2], b[q][3]);
                ((u32x4*)dst)[i + q * gs] = o;
            }
        }
    }
}
__device__ void transpose_cvt(const float* __restrict__ W, bf16_t* __restrict__ Wt, int K, int N, float* tile  ) {
    const int tk = K / 64, tn = N / 64;
    const int tid = threadIdx.x;
    for (int t = blockIdx.x; t < tk * tn; t += gridDim.x) {
        const int k0 = (t / tn) * 64, n0 = (t % tn) * 64;
        f32x4 v[4];
#pragma unroll
        for (int i = 0; i < 4; ++i) v[i] = *(const f32x4*)(W + (size_t)(k0 + (tid >> 4) + 16 * i) * N + n0 + (tid & 15) * 4);
        __syncthreads();
#pragma unroll
        for (int i = 0; i < 4; ++i)
#pragma unroll
            for (int j = 0; j < 4; ++j) tile[((tid >> 4) + 16 * i) * 65 + (tid & 15) * 4 + j] = v[i][j];
        __syncthreads();
        const int n = tid >> 2, kc = (tid & 3) * 16;
        u32x4 o0, o1;
#pragma unroll
        for (int q = 0; q < 4; ++q) {
            o0[q] = pack2(tile[(kc + 2 * q) * 65 + n], tile[(kc + 2 * q + 1) * 65 + n]);
            o1[q] = pack2(tile[(kc + 8 + 2 * q) * 65 + n], tile[(kc + 8 + 2 * q + 1) * 65 + n]);
        }
        *(u32x4*)(Wt + (size_t)(n0 + n) * K + k0 + kc) = o0;
        *(u32x4*)(Wt + (size_t)(n0 + n) * K + k0 + kc + 8) = o1;
    }
}
__device__ void cvt_table_fp8(const float* __restrict__ src, unsigned char* __restrict__ dst, float* __restrict__ scl, int rows) {
    const int lane = threadIdx.x & 63, wid = threadIdx.x >> 6;
    const int nw = gridDim.x * 4;
    for (int r0 = blockIdx.x * 4 + wid; r0 < rows; r0 += 4 * nw) {
        f32x4 v[4][4];
#pragma unroll
        for (int q = 0; q < 4; ++q) {
            const int r = (r0 + q * nw < rows) ? r0 + q * nw : r0;
            const float* sr = src + (size_t)r * DM + lane * 16;
#pragma unroll
            for (int k = 0; k < 4; ++k) v[q][k] = *(const f32x4*)(sr + 4 * k);
        }
#pragma unroll
        for (int q = 0; q < 4; ++q) {
            const int r = r0 + q * nw;
            float m = 0.f;
#pragma unroll
            for (int k = 0; k < 4; ++k)
#pragma unroll
                for (int i = 0; i < 4; ++i) m = fmaxf(m, fabsf(v[q][k][i]));
#pragma unroll
            for (int o = 32; o >= 1; o >>= 1) m = fmaxf(m, __shfl_xor(m, o));
            const float sc = (m > 0.f) ? 448.0f / m : 1.0f;
            u32x4 w;
#pragma unroll
            for (int k = 0; k < 4; ++k)
                w[k] = __builtin_amdgcn_cvt_pk_fp8_f32(v[q][k][2] * sc, v[q][k][3] * sc, __builtin_amdgcn_cvt_pk_fp8_f32(v[q][k][0] * sc, v[q][k][1] * sc, 0, false), true);
            if (r < rows) {
                *(u32x4*)(dst + (size_t)(lane >> 3) * (16384 * 128) + (size_t)r * 128 + (lane & 7) * 16) = w;
                if (lane == 0) scl[r] = (m > 0.f) ? m * (1.0f / 448.0f) : 1.0f;
            }
        }
    }
}
__device__ void ph_prep(const Params& p, unsigned char* smem) {
    float* tile = (float*)smem;
    cvt_rows(p.x, p.xb, (size_t)T_TOK * DM);
    cvt_rows(p.p, p.pb, (size_t)T_TOK * 256);
    cvt_table_fp8(p.pu, p.u8, p.su, 16384);
    cvt_table_fp8(p.pv, p.v8, p.sv, 16384);
    cvt_rows(p.keys, p.keysb, (size_t)16 * 128 * 128);
    transpose_cvt(p.w_in, p.WinT, DM, INW, tile);
    transpose_cvt(p.w_out, p.WoutT, DM, DM, tile);
    cvt_rows(p.wq, p.Wqb, (size_t)DM * 2048);
    transpose_cvt(p.ple_gate, p.WgT, DM, DM, tile);
    transpose_cvt(p.ple_proj, p.WpT, 256, DM, tile);
}

#define LDS_AS __attribute__((address_space(3)))
#define GEMM_STAGE 32768
__device__ __forceinline__ void gemm128(const bf16_t* __restrict__ A, int lda, const bf16_t* __restrict__ Bt, int ldb, int K,
                                        unsigned char* smem, f32x4 (&acc)[4][4]) {
    LDS_AS unsigned char* lds = (LDS_AS unsigned char*)smem;
    const int tid = threadIdx.x, lane = tid & 63, wid = __builtin_amdgcn_readfirstlane(tid >> 6);
    const int wr = wid >> 1, wc = wid & 1, fr = lane & 15, fq = lane >> 4;
    const int nk = K / 64;
    const int prow = lane >> 3, pc = (lane & 7) ^ prow;
    const bf16_t* gA = A + (size_t)(wid * 32 + prow) * lda + pc * 8;
    const bf16_t* gB = Bt + (size_t)(wid * 32 + prow) * ldb + pc * 8;
    const size_t a8 = (size_t)8 * lda, b8 = (size_t)8 * ldb;
#define GEMM_ISSUE(kt, st) do { \
        _Pragma("unroll") for (int _i = 0; _i < 4; ++_i) { \
            __builtin_amdgcn_global_load_lds((const unsigned*)(gA + _i * a8 + (size_t)(kt) * 64), (LDS_AS unsigned*)(lds + (st) * GEMM_STAGE + (wid * 4 + _i) * 1024), 16, 0, 0); \
            __builtin_amdgcn_global_load_lds((const unsigned*)(gB + _i * b8 + (size_t)(kt) * 64), (LDS_AS unsigned*)(lds + (st) * GEMM_STAGE + 16384 + (wid * 4 + _i) * 1024), 16, 0, 0); \
        } } while (0)
    const int swz0 = ((0 * 4 + fq) ^ (fr & 7)) * 16, swz1 = ((1 * 4 + fq) ^ (fr & 7)) * 16;
    const int aoff = (wr * 64 + fr) * 128, boff = 16384 + (wc * 64 + fr) * 128;
    GEMM_ISSUE(0, 0);
#pragma unroll 1
    for (int kt = 0; kt < nk; ++kt) {
        const int st = kt & 1;
        asm volatile("s_waitcnt vmcnt(0)" ::: "memory");
        __builtin_amdgcn_s_barrier();
        asm volatile("" ::: "memory");
        if (kt + 1 < nk) GEMM_ISSUE(kt + 1, st ^ 1);
        const LDS_AS unsigned char* sb = lds + st * GEMM_STAGE;
        bf16x8 af0[4], bf0[4], af1[4], bf1[4];
#pragma unroll
        for (int mi = 0; mi < 4; ++mi) af0[mi] = *(const LDS_AS bf16x8*)(sb + aoff + mi * 2048 + swz0);
#pragma unroll
        for (int ni = 0; ni < 4; ++ni) bf0[ni] = *(const LDS_AS bf16x8*)(sb + boff + ni * 2048 + swz0);
#pragma unroll
        for (int mi = 0; mi < 4; ++mi) af1[mi] = *(const LDS_AS bf16x8*)(sb + aoff + mi * 2048 + swz1);
#pragma unroll
        for (int ni = 0; ni < 4; ++ni) bf1[ni] = *(const LDS_AS bf16x8*)(sb + boff + ni * 2048 + swz1);
#pragma unroll
        for (int mi = 0; mi < 4; ++mi)
#pragma unroll
            for (int ni = 0; ni < 4; ++ni)
                acc[mi][ni] = __builtin_amdgcn_mfma_f32_16x16x32_bf16(bf0[ni], af0[mi], acc[mi][ni], 0, 0, 0);
#pragma unroll
        for (int mi = 0; mi < 4; ++mi)
#pragma unroll
            for (int ni = 0; ni < 4; ++ni)
                acc[mi][ni] = __builtin_amdgcn_mfma_f32_16x16x32_bf16(bf1[ni], af1[mi], acc[mi][ni], 0, 0, 0);
        __builtin_amdgcn_sched_group_barrier(0x100, 8, 0);
#pragma unroll
        for (int q = 0; q < 8; ++q) { __builtin_amdgcn_sched_group_barrier(0x008, 2, 0); __builtin_amdgcn_sched_group_barrier(0x100, 1, 0); }
        __builtin_amdgcn_sched_group_barrier(0x008, 16, 0);
        asm volatile("s_waitcnt lgkmcnt(0)" ::: "memory");
        __builtin_amdgcn_s_barrier();
        asm volatile("" ::: "memory");
    }
#undef GEMM_ISSUE
}
#define GW_STAGE 24576
__device__ __forceinline__ void gemmW(const bf16_t* __restrict__ A, int lda, const bf16_t* __restrict__ Bt, int ldb, int K,
                                      unsigned char* smem, f32x4 (&acc)[4][8]) {
    LDS_AS unsigned char* lds = (LDS_AS unsigned char*)smem;
    const int tid = threadIdx.x, lane = tid & 63, wid = __builtin_amdgcn_readfirstlane(tid >> 6);
    const int wr = wid >> 1, wc = wid & 1, fr = lane & 15, fq = lane >> 4;
    const int nk = K / 32;
    const int prow = lane >> 2, pc = (lane & 3) ^ ((4 - ((prow >> 2) & 3)) & 3);
    const bf16_t* gA = A + (size_t)(wid * 32 + prow) * lda + pc * 8;
    const bf16_t* gB = Bt + (size_t)(wid * 64 + prow) * ldb + pc * 8;
    const size_t a16 = (size_t)16 * lda, b16 = (size_t)16 * ldb;
#define GW_ISSUE(kt, st) do { \
        _Pragma("unroll") for (int _i = 0; _i < 2; ++_i) \
            __builtin_amdgcn_global_load_lds((const unsigned*)(gA + _i * a16 + (size_t)(kt) * 32), (LDS_AS unsigned*)(lds + (st) * GW_STAGE + (wid * 2 + _i) * 1024), 16, 0, 0); \
        _Pragma("unroll") for (int _i = 0; _i < 4; ++_i) \
            __builtin_amdgcn_global_load_lds((const unsigned*)(gB + _i * b16 + (size_t)(kt) * 32), (LDS_AS unsigned*)(lds + (st) * GW_STAGE + 8192 + (wid * 4 + _i) * 1024), 16, 0, 0); \
        } while (0)
    const int swz = (fq ^ ((4 - ((fr >> 2) & 3)) & 3)) * 16;
    const int aoff = (wr * 64 + fr) * 64 + swz, boff = 8192 + (wc * 128 + fr) * 64 + swz;
    GW_ISSUE(0, 0);
#pragma unroll 1
    for (int kt = 0; kt < nk; ++kt) {
        const int st = kt & 1;
        asm volatile("s_waitcnt vmcnt(0)" ::: "memory");
        __builtin_amdgcn_s_barrier();
        asm volatile("" ::: "memory");
        if (kt + 1 < nk) GW_ISSUE(kt + 1, st ^ 1);
        const LDS_AS unsigned char* sb = lds + st * GW_STAGE;
        bf16x8 af[4], bfr[8];
#pragma unroll
        for (int mi = 0; mi < 4; ++mi) af[mi] = *(const LDS_AS bf16x8*)(sb + aoff + mi * 1024);
#pragma unroll
        for (int ni = 0; ni < 8; ++ni) bfr[ni] = *(const LDS_AS bf16x8*)(sb + boff + ni * 1024);
#pragma unroll
        for (int ni = 0; ni < 8; ++ni)
#pragma unroll
            for (int mi = 0; mi < 4; ++mi)
                acc[mi][ni] = __builtin_amdgcn_mfma_f32_16x16x32_bf16(bfr[ni], af[mi], acc[mi][ni], 0, 0, 0);
        asm volatile("s_waitcnt lgkmcnt(0)" ::: "memory");
        __builtin_amdgcn_s_barrier();
        asm volatile("" ::: "memory");
    }
#undef GW_ISSUE
}
__device__ __forceinline__ void zero_accw(f32x4 (&acc)[4][8]) {
#pragma unroll
    for (int a = 0; a < 4; ++a)
#pragma unroll
        for (int b = 0; b < 8; ++b) acc[a][b] = (f32x4){0.f, 0.f, 0.f, 0.f};
}
__device__ __forceinline__ void zero_acc(f32x4 (&acc)[4][4]) {
#pragma unroll
    for (int a = 0; a < 4; ++a)
#pragma unroll
        for (int b = 0; b < 4; ++b) acc[a][b] = (f32x4){0.f, 0.f, 0.f, 0.f};
}
#define GEMM_SMEM (2 * GEMM_STAGE)

__device__ void ph_gemm_in(const Params& p, unsigned char* smem, const int vb) {
    const int ntn = INW / 128;
    const int tid = threadIdx.x, lane = tid & 63, wid = tid >> 6, wr = wid >> 1, wc = wid & 1, fr = lane & 15, fq = lane >> 4;
    for (int t = vb; t < (T_TOK / 128) * ntn; t += gridDim.x) {
        const int m0 = (t / ntn) * 128, n0 = (t % ntn) * 128;
        f32x4 acc[4][4]; zero_acc(acc);
        gemm128(p.xb + (size_t)m0 * DM, DM, p.WinT + (size_t)n0 * DM, DM, DM, smem, acc);
#pragma unroll
        for (int mi = 0; mi < 4; ++mi) {
            const int row = m0 + wr * 64 + mi * 16 + fr;
            const float posf = (float)p.pos[row];
#pragma unroll
            for (int ni = 0; ni < 4; ++ni) {
                const int col0 = n0 + wc * 64 + ni * 16;
                f32x4 v = acc[mi][ni];
                if (col0 < 640 && (col0 & 63) == 0) {
#pragma unroll
                    for (int r = 0; r < 4; ++r) {
                        const float other = __shfl_xor(v[r], 32);
                        const int j = (fq & 1) * 4 + r;
                        const float inv = powf(500000.0f, -(float)j * 0.125f);
                        float sn, cs; sincosf(posf * inv, &sn, &cs);
                        v[r] = (fq < 2) ? (v[r] * cs - other * sn) : (v[r] * cs + other * sn);
                    }
                }
                uint2 o; o.x = pack2(v[0], v[1]); o.y = pack2(v[2], v[3]);
                *(uint2*)(p.hb + (size_t)row * INW + col0 + fq * 4) = o;
            }
        }
    }
}

#define ASTR 72
#define VSTR 260
typedef float f32x16 __attribute__((ext_vector_type(16)));
typedef unsigned u32x2 __attribute__((ext_vector_type(2)));
__device__ void ph_attn(const Params& p, unsigned char* smem, const int vb) {
    bf16_t* sK = (bf16_t*)smem;
    bf16_t* sVt = sK + 256 * ASTR;
    const int tid = threadIdx.x, lane = tid & 63, wid = tid >> 6, r32 = lane & 31, hh = lane >> 5;
    const float C1 = 0.125f * 1.4426950408889634f, LOG2E = 1.4426950408889634f;
    for (int u = vb; u < 16 * 16 * 2; u += gridDim.x) {
        const int kvh = u & 1, nb = (u >> 1) & 15, b = u >> 5;
        __syncthreads();
        for (int c = tid; c < 256 * 8; c += 256) {
            const int li = c >> 3, kc = c & 7;
            const int pos = nb * 128 - 128 + li;
            u32x4 kv = {0u, 0u, 0u, 0u}, vv = {0u, 0u, 0u, 0u};
            if (pos >= 0) {
                const bf16_t* base = p.hb + (size_t)(b * SEQ + pos) * INW;
                kv = *(const u32x4*)(base + 512 + kvh * 64 + kc * 8);
                vv = *(const u32x4*)(base + 640 + kvh * 64 + kc * 8);
            }
            *(u32x4*)(sK + li * ASTR + kc * 8) = kv;
#pragma unroll
            for (int i = 0; i < 4; ++i) {
                sVt[(kc * 8 + 2 * i) * VSTR + li] = (bf16_t)(vv[i] & 0xffffu);
                sVt[(kc * 8 + 2 * i + 1) * VSTR + li] = (bf16_t)(vv[i] >> 16);
            }
        }
        __syncthreads();
        const int hq = kvh * 4 + wid;
        const float sink2 = p.sinks[hq] * LOG2E;
#pragma unroll 1
        for (int qt = 0; qt < 4; ++qt) {
            const size_t trow = (size_t)(b * SEQ + nb * 128 + qt * 32 + r32);
            bf16x8 qf[4];
#pragma unroll
            for (int ks = 0; ks < 4; ++ks) qf[ks] = *(const bf16x8*)(p.hb + trow * INW + hq * 64 + ks * 16 + hh * 8);
            f32x16 S[5];
#pragma unroll
            for (int j = 0; j < 5; ++j) {
#pragma unroll
                for (int r = 0; r < 16; ++r) S[j][r] = 0.f;
#pragma unroll
                for (int ks = 0; ks < 4; ++ks) {
                    const bf16x8 a = *(const bf16x8*)(sK + ((qt + j) * 32 + r32) * ASTR + ks * 16 + hh * 8);
                    S[j] = __builtin_amdgcn_mfma_f32_32x32x16_bf16(a, qf[ks], S[j], 0, 0, 0);
                }
            }
            float m2 = sink2;
#pragma unroll
            for (int j = 0; j < 5; ++j) {
                const bool tile_ok = (nb > 0) || (qt + j >= 4);
#pragma unroll
                for (int r = 0; r < 16; ++r) {
                    const int kl = (r & 3) + 8 * (r >> 2) + 4 * hh;
                    bool ok = tile_ok;
                    if (j == 0) ok = ok && (kl > r32);
                    if (j == 4) ok = ok && (kl <= r32);
                    const float t = ok ? S[j][r] * C1 : -1.0e30f;
                    S[j][r] = t;
                    m2 = fmaxf(m2, t);
                }
            }
            m2 = fmaxf(m2, __shfl_xor(m2, 32));
            float l = 0.f;
#pragma unroll
            for (int j = 0; j < 5; ++j)
#pragma unroll
                for (int r = 0; r < 16; ++r) { const float e = __builtin_amdgcn_exp2f(S[j][r] - m2); S[j][r] = e; l += e; }
            l += __shfl_xor(l, 32);
            l += __builtin_amdgcn_exp2f(sink2 - m2);
            f32x16 O[2];
#pragma unroll
            for (int dt = 0; dt < 2; ++dt)
#pragma unroll
                for (int r = 0; r < 16; ++r) O[dt][r] = 0.f;
#pragma unroll
            for (int j = 0; j < 5; ++j)
#pragma unroll
                for (int s2 = 0; s2 < 2; ++s2) {
                    u32x4 pw;
#pragma unroll
                    for (int k = 0; k < 4; ++k) pw[k] = pack2(S[j][8 * s2 + 2 * k], S[j][8 * s2 + 2 * k + 1]);
                    const bf16x8 pf = __builtin_bit_cast(bf16x8, pw);
                    const int kbase = (qt + j) * 32 + 16 * s2 + 4 * hh;
#pragma unroll
                    for (int dt = 0; dt < 2; ++dt) {
                        const bf16_t* vp = sVt + (dt * 32 + r32) * VSTR + kbase;
                        const u32x2 v0 = *(const u32x2*)(vp), v1 = *(const u32x2*)(vp + 8);
                        const u32x4 vw = {v0[0], v0[1], v1[0], v1[1]};
                        O[dt] = __builtin_amdgcn_mfma_f32_32x32x16_bf16(__builtin_bit_cast(bf16x8, vw), pf, O[dt], 0, 0, 0);
                    }
                }
            const float il = __builtin_amdgcn_rcpf(l);
#pragma unroll
            for (int dt = 0; dt < 2; ++dt)
#pragma unroll
                for (int g = 0; g < 4; ++g) {
                    u32x2 w;
                    w[0] = pack2(O[dt][4 * g] * il, O[dt][4 * g + 1] * il);
                    w[1] = pack2(O[dt][4 * g + 2] * il, O[dt][4 * g + 3] * il);
                    *(u32x2*)(p.mixb + trow * DM + hq * 64 + dt * 32 + 8 * g + 4 * hh) = w;
                }
        }
    }
}

#define CV_ROWS 62
__device__ void ph_conv(const Params& p, unsigned char* smem, const int vb) {
    bf16_t* gl = (bf16_t*)smem;
    float* red = (float*)(smem + CV_ROWS * 1024);
    const int tid = threadIdx.x, lane = tid & 63, wid = tid >> 6;
    const f32x2 lg = *(const f32x2*)(p.cln_g + 2 * tid), lb = *(const f32x2*)(p.cln_b + 2 * tid);
    for (int u = vb; u < T_TOK / 32; u += gridDim.x) {
        const int tok0 = u * 32, s0 = tok0 & (SEQ - 1);
        __syncthreads();
#pragma unroll 1
        for (int bt = 0; bt < 2; ++bt) {
            u32x4 av[8], gv[8];
#pragma unroll
            for (int it = 0; it < 8; ++it) {
                const int ch = tid + (bt * 8 + it) * 256, row = min(ch >> 6, CV_ROWS - 1), k = ch & 63;
                const int rr = (s0 - 30 + row >= 0) ? row : 30;
                const bf16_t* base = p.hb + (size_t)(tok0 - 30 + rr) * INW + k * 8;
                av[it] = *(const u32x4*)(base + 768); gv[it] = *(const u32x4*)(base + 1280);
            }
#pragma unroll
            for (int it = 0; it < 8; ++it) {
                const int ch = tid + (bt * 8 + it) * 256, row = ch >> 6, k = ch & 63;
                const bool ok = (s0 - 30 + row >= 0);
                u32x4 o;
#pragma unroll
                for (int q = 0; q < 4; ++q) {
                    const float g0 = sigmul(bflo(av[it][q]), bflo(gv[it][q])), g1 = sigmul(bfhi(av[it][q]), bfhi(gv[it][q]));
                    o[q] = ok ? pack2(g0, g1) : 0u;
                }
                if (row < CV_ROWS) *(u32x4*)(gl + row * 512 + k * 8) = o;
            }
        }
        __syncthreads();
        float w0[31], w1[31];
#pragma unroll
        for (int k = 0; k < 31; ++k) { const f32x2 wv = *(const f32x2*)(p.conv_w + k * 512 + 2 * tid); w0[k] = wv.x; w1[k] = wv.y; }
        const f32x2 bias = *(const f32x2*)(p.conv_b + 2 * tid);
#pragma unroll 1
        for (int jh = 0; jh < 2; ++jh) {
            float a0[16], a1[16];
#pragma unroll
            for (int jl = 0; jl < 16; ++jl) { a0[jl] = bias.x; a1[jl] = bias.y; }
            const bf16_t* gp = gl + (jh * 16) * 512 + 2 * tid;
#pragma unroll
            for (int il = 0; il < 46; ++il) {
                const unsigned gw = *(const unsigned*)(gp + il * 512);
                const float g0 = bflo(gw), g1 = bfhi(gw);
#pragma unroll
                for (int jl = 0; jl < 16; ++jl)
                    if (il - jl >= 0 && il - jl <= 30) { a0[jl] += w0[il - jl] * g0; a1[jl] += w1[il - jl] * g1; }
                if ((il & 3) == 3) __builtin_amdgcn_sched_barrier(0);
            }
            float v[32];
#pragma unroll
            for (int jl = 0; jl < 16; ++jl) { v[jl] = a0[jl] + a1[jl]; v[16 + jl] = a0[jl] * a0[jl] + a1[jl] * a1[jl]; }
#pragma unroll
            for (int st = 16; st >= 1; st >>= 1) {
                const bool up = (lane & st) != 0;
#pragma unroll
                for (int i2 = 0; i2 < st; ++i2) {
                    const float keep = up ? v[i2 + st] : v[i2], send = up ? v[i2] : v[i2 + st];
                    v[i2] = keep + __shfl_xor(send, st);
                }
            }
            const float tot = v[0] + __shfl_xor(v[0], 32);
            __syncthreads();
            if (lane < 32) red[wid * 32 + lane] = tot;
            __syncthreads();
#pragma unroll
            for (int jl = 0; jl < 16; ++jl) {
                const float sm = (red[jl] + red[32 + jl]) + (red[64 + jl] + red[96 + jl]);
                const float sq = (red[16 + jl] + red[48 + jl]) + (red[80 + jl] + red[112 + jl]);
                const float mu = sm * (1.0f / 512.0f);
                const float rstd = rsqrtf(fmaxf(sq * (1.0f / 512.0f) - mu * mu, 0.f) + LN_EPS);
                const float y0 = (a0[jl] - mu) * rstd * lg.x + lb.x, y1 = (a1[jl] - mu) * rstd * lg.y + lb.y;
                *(unsigned*)(p.mixb + (size_t)(tok0 + jh * 16 + jl) * DM + 512 + 2 * tid) = pack2(sigmul(y0, y0), sigmul(y1, y1));
            }
        }
    }
}

__device__ void ph_gemm_out(const Params& p, unsigned char* smem, const int vb) {
    const int ntn = DM / 256;
    const int tid = threadIdx.x, lane = tid & 63, wid = tid >> 6, wr = wid >> 1, wc = wid & 1, fr = lane & 15, fq = lane >> 4;
    for (int t = vb; t < (T_TOK / 128) * ntn; t += gridDim.x) {
        const int m0 = (t / ntn) * 128, n0 = (t % ntn) * 256;
        f32x4 acc[4][8]; zero_accw(acc);
        gemmW(p.mixb + (size_t)m0 * DM, DM, p.WoutT + (size_t)n0 * DM, DM, DM, smem, acc);
#pragma unroll
        for (int mi = 0; mi < 4; ++mi) {
            const int row = m0 + wr * 64 + mi * 16 + fr;
#pragma unroll
            for (int ni = 0; ni < 8; ++ni) {
                const int col = n0 + wc * 128 + ni * 16 + fq * 4;
                const f32x4 xv = *(const f32x4*)(p.x + (size_t)row * DM + col);
                *(f32x4*)(p.y1 + (size_t)row * DM + col) = xv * ALPHA + acc[mi][ni];
            }
        }
    }
}

__device__ __forceinline__ void ln_row(const float* __restrict__ src, const float* __restrict__ g, const float* __restrict__ bta,
                                       float* __restrict__ dstf, bf16_t* __restrict__ dstb, int lane) {
    f32x4 v[4]; float s = 0.f;
#pragma unroll
    for (int i = 0; i < 4; ++i) { v[i] = *(const f32x4*)(src + i * 256 + lane * 4); s += (v[i][0] + v[i][1]) + (v[i][2] + v[i][3]); }
    const float mu = wave_sum(s) * (1.0f / 1024.0f);
    float q = 0.f;
#pragma unroll
    for (int i = 0; i < 4; ++i) { const f32x4 d = v[i] - mu; q += (d[0] * d[0] + d[1] * d[1]) + (d[2] * d[2] + d[3] * d[3]); }
    const float rstd = rsqrtf(wave_sum(q) * (1.0f / 1024.0f) + LN_EPS);
#pragma unroll
    for (int i = 0; i < 4; ++i) {
        const f32x4 gg = *(const f32x4*)(g + i * 256 + lane * 4), bb = *(const f32x4*)(bta + i * 256 + lane * 4);
        const f32x4 y = (v[i] - mu) * rstd * gg + bb;
        if (dstf) *(f32x4*)(dstf + i * 256 + lane * 4) = y;
        if (dstb) { uint2 o; o.x = pack2(y[0], y[1]); o.y = pack2(y[2], y[3]); *(uint2*)(dstb + i * 256 + lane * 4) = o; }
    }
}
__device__ void ph_ln1(const Params& p, const int vb) {
    const int lane = threadIdx.x & 63, wid = threadIdx.x >> 6;
    for (int r = vb * 4 + wid; r < T_TOK; r += gridDim.x * 4)
        ln_row(p.y1 + (size_t)r * DM, p.ln1_g, p.ln1_b, (float*)nullptr, p.x1b + (size_t)r * DM, lane);
}
__device__ void ph_ln2(const Params& p, const int vb) {
    const int lane = threadIdx.x & 63, wid = threadIdx.x >> 6;
    for (int r = vb * 4 + wid; r < T_TOK; r += gridDim.x * 4)
        ln_row(p.out + (size_t)r * DM, p.ln2_g, p.ln2_b, p.out + (size_t)r * DM, (bf16_t*)nullptr, lane);
}

#define QSTR 136
__device__ __forceinline__ int f2key(float f) { const int b = __float_as_int(f); return b ^ ((b >> 31) & 0x7fffffff); }
__device__ __forceinline__ float key2f(int k) { return __int_as_float(k ^ ((k >> 31) & 0x7fffffff)); }
__device__ __forceinline__ void sort16_desc(int (&a)[16]) {
#pragma unroll
    for (int lk = 1; lk <= 4; ++lk) {
#pragma unroll
        for (int lj = lk - 1; lj >= 0; --lj) {
            const int k = 1 << lk, j = 1 << lj;
#pragma unroll
            for (int i = 0; i < 16; ++i) {
                const int l = i ^ j;
                if (l > i) {
                    const int hi = max(a[i], a[l]), lo = min(a[i], a[l]);
                    if ((i & k) == 0) { a[i] = hi; a[l] = lo; } else { a[i] = lo; a[l] = hi; }
                }
            }
        }
    }
}
__device__ __forceinline__ void merge_top16(int (&a)[16], const int (&b)[16]) {
#pragma unroll
    for (int i = 0; i < 16; ++i) a[i] = max(a[i], b[15 - i]);
#pragma unroll
    for (int lj = 3; lj >= 0; --lj) {
        const int j = 1 << lj;
#pragma unroll
        for (int i = 0; i < 16; ++i) {
            const int l = i ^ j;
            if (l > i) { const int hi = max(a[i], a[l]), lo = min(a[i], a[l]); a[i] = hi; a[l] = lo; }
        }
    }
}
__device__ __forceinline__ void top16_of_64(int (&v)[4][16]) {
    sort16_desc(v[0]); sort16_desc(v[1]); sort16_desc(v[2]); sort16_desc(v[3]);
    merge_top16(v[0], v[1]); merge_top16(v[0], v[2]); merge_top16(v[0], v[3]);
}

__device__ void ph_mprep(const Params& p, unsigned char* smem, const int vb) {
    const int tid = threadIdx.x, lane = tid & 63, wid = tid >> 6, wr = wid >> 1, wc = wid & 1, fr = lane & 15, fq = lane >> 4;
    for (int t = vb; t < 16 * 8; t += gridDim.x) {
        const int hp = t >> 3, d0 = (t & 7) * 128;
        f32x4 acc[4][4]; zero_acc(acc);
        gemm128(p.keysb + (size_t)hp * 128 * 128, 128, p.Wqb + (size_t)d0 * 2048 + hp * 128, 2048, 128, smem, acc);
#pragma unroll
        for (int mi = 0; mi < 4; ++mi)
#pragma unroll
            for (int ni = 0; ni < 4; ++ni) {
                uint2 o; o.x = pack2(acc[mi][ni][0], acc[mi][ni][1]); o.y = pack2(acc[mi][ni][2], acc[mi][ni][3]);
                *(uint2*)(p.MT + (size_t)(hp * 128 + wr * 64 + mi * 16 + fr) * DM + d0 + wc * 64 + ni * 16 + fq * 4) = o;
            }
    }
}

__device__ __forceinline__ void route_half(const Params& p, unsigned char* smem, int m0, int hp, int (&K)[16]) {
    LDS_AS unsigned char* lds = (LDS_AS unsigned char*)smem;
    const int tid = threadIdx.x, lane = tid & 63, wid = __builtin_amdgcn_readfirstlane(tid >> 6);
    const int r32 = lane & 31, hh = lane >> 5;
    const int prow = lane >> 3, pc = (lane & 7) ^ prow;
    const bf16_t* gA = p.x1b + (size_t)(m0 + wid * 32 + prow) * DM + pc * 8;
    const bf16_t* gB = p.MT + (size_t)(hp * 128 + wid * 32 + prow) * DM + pc * 8;
    const size_t r8 = (size_t)8 * DM;
#define RT_ISSUE(kt, st) do { \
        _Pragma("unroll") for (int _i = 0; _i < 4; ++_i) { \
            __builtin_amdgcn_global_load_lds((const unsigned*)(gA + _i * r8 + (size_t)(kt) * 64), (LDS_AS unsigned*)(lds + (st) * GEMM_STAGE + (wid * 4 + _i) * 1024), 16, 0, 0); \
            __builtin_amdgcn_global_load_lds((const unsigned*)(gB + _i * r8 + (size_t)(kt) * 64), (LDS_AS unsigned*)(lds + (st) * GEMM_STAGE + 16384 + (wid * 4 + _i) * 1024), 16, 0, 0); \
        } } while (0)
    f32x16 S[4];
#pragma unroll
    for (int mt = 0; mt < 4; ++mt)
#pragma unroll
        for (int r = 0; r < 16; ++r) S[mt][r] = 0.f;
    const int toff = (wid * 32 + r32) * 128, koff = 16384 + r32 * 128, x7 = r32 & 7;
    RT_ISSUE(0, 0);
#pragma unroll 1
    for (int kt = 0; kt < DM / 64; ++kt) {
        const int st = kt & 1;
        asm volatile("s_waitcnt vmcnt(0)" ::: "memory");
        __builtin_amdgcn_s_barrier();
        asm volatile("" ::: "memory");
        if (kt + 1 < DM / 64) RT_ISSUE(kt + 1, st ^ 1);
        const LDS_AS unsigned char* sb = lds + st * GEMM_STAGE;
        bf16x8 bq[4], aq[4][4];
#pragma unroll
        for (int k16 = 0; k16 < 4; ++k16) {
            const int sw = ((k16 * 2 + hh) ^ x7) * 16;
            bq[k16] = *(const LDS_AS bf16x8*)(sb + toff + sw);
#pragma unroll
            for (int mt = 0; mt < 4; ++mt) aq[k16][mt] = *(const LDS_AS bf16x8*)(sb + koff + mt * 4096 + sw);
        }
#pragma unroll
        for (int k16 = 0; k16 < 4; ++k16)
#pragma unroll
            for (int mt = 0; mt < 4; ++mt) S[mt] = __builtin_amdgcn_mfma_f32_32x32x16_bf16(aq[k16][mt], bq[k16], S[mt], 0, 0, 0);
        __builtin_amdgcn_sched_group_barrier(0x100, 5, 0);
#pragma unroll
        for (int q = 0; q < 15; ++q) { __builtin_amdgcn_sched_group_barrier(0x008, 1, 0); __builtin_amdgcn_sched_group_barrier(0x100, 1, 0); }
        __builtin_amdgcn_sched_group_barrier(0x008, 1, 0);
        asm volatile("s_waitcnt lgkmcnt(0)" ::: "memory");
        __builtin_amdgcn_s_barrier();
        asm volatile("" ::: "memory");
    }
#undef RT_ISSUE
    int v[4][16];
#pragma unroll
    for (int mt = 0; mt < 4; ++mt)
#pragma unroll
        for (int r = 0; r < 16; ++r) {
            const int n = mt * 32 + (r & 3) + 8 * (r >> 2) + 4 * hh;
            v[mt][r] = (f2key(S[mt][r]) & ~0x7F) | (127 - n);
        }
    top16_of_64(v);
    int o[16];
#pragma unroll
    for (int i = 0; i < 16; ++i) o[i] = __shfl_xor(v[0][i], 32);
    merge_top16(v[0], o);
#pragma unroll
    for (int i = 0; i < 16; ++i) K[i] = v[0][i];
}

__device__ __forceinline__ void route_topk(const f32x16 (&S)[8], int pp, int hh, int (&K)[16]) {
    int v[4][16];
#pragma unroll
    for (int mt = 0; mt < 4; ++mt)
#pragma unroll
        for (int r = 0; r < 16; ++r) {
            const int n = mt * 32 + (r & 3) + 8 * (r >> 2) + 4 * hh;
            v[mt][r] = (f2key(S[pp * 4 + mt][r]) & ~0x7F) | (127 - n);
        }
    top16_of_64(v);
    int o[16];
#pragma unroll
    for (int i = 0; i < 16; ++i) o[i] = __shfl_xor(v[0][i], 32);
    merge_top16(v[0], o);
#pragma unroll
    for (int i = 0; i < 16; ++i) K[i] = v[0][i];
}
__device__ __forceinline__ void route_head(const Params& p, unsigned char* smem, int m0, int h, int (&K0)[16], int (&K1)[16]) {
    LDS_AS unsigned char* lds = (LDS_AS unsigned char*)smem;
    const int tid = threadIdx.x, lane = tid & 63, wid = __builtin_amdgcn_readfirstlane(tid >> 6);
    const int r32 = lane & 31, hh = lane >> 5;
    const int prow = lane >> 2, pc = (lane & 3) ^ ((4 - ((prow >> 2) & 3)) & 3);
    const bf16_t* gA = p.x1b + (size_t)(m0 + wid * 32 + prow) * DM + pc * 8;
    const bf16_t* gB = p.MT + (size_t)(h * 256 + wid * 64 + prow) * DM + pc * 8;
    const size_t r16 = (size_t)16 * DM;
#define RH_ISSUE(kt, st) do { \
        _Pragma("unroll") for (int _i = 0; _i < 2; ++_i) \
            __builtin_amdgcn_global_load_lds((const unsigned*)(gA + _i * r16 + (size_t)(kt) * 32), (LDS_AS unsigned*)(lds + (st) * GW_STAGE + (wid * 2 + _i) * 1024), 16, 0, 0); \
        _Pragma("unroll") for (int _i = 0; _i < 4; ++_i) \
            __builtin_amdgcn_global_load_lds((const unsigned*)(gB + _i * r16 + (size_t)(kt) * 32), (LDS_AS unsigned*)(lds + (st) * GW_STAGE + 8192 + (wid * 4 + _i) * 1024), 16, 0, 0); \
        } while (0)
    f32x16 S[8];
#pragma unroll
    for (int mt = 0; mt < 8; ++mt)
#pragma unroll
        for (int r = 0; r < 16; ++r) S[mt][r] = 0.f;
    const int fx = (4 - ((r32 >> 2) & 3)) & 3;
    const int toff = (wid * 32 + r32) * 64, koff = 8192 + r32 * 64;
    RH_ISSUE(0, 0);
#pragma unroll 1
    for (int kt = 0; kt < DM / 32; ++kt) {
        const int st = kt & 1;
        asm volatile("s_waitcnt vmcnt(0)" ::: "memory");
        __builtin_amdgcn_s_barrier();
        asm volatile("" ::: "memory");
        if (kt + 1 < DM / 32) RH_ISSUE(kt + 1, st ^ 1);
        const LDS_AS unsigned char* sb = lds + st * GW_STAGE;
#pragma unroll
        for (int k16 = 0; k16 < 2; ++k16) {
            const int sw = ((k16 * 2 + hh) ^ fx) * 16;
            const bf16x8 b = *(const LDS_AS bf16x8*)(sb + toff + sw);
#pragma unroll
            for (int mt = 0; mt < 8; ++mt) {
                const bf16x8 a = *(const LDS_AS bf16x8*)(sb + koff + mt * 2048 + sw);
                S[mt] = __builtin_amdgcn_mfma_f32_32x32x16_bf16(a, b, S[mt], 0, 0, 0);
            }
        }
        asm volatile("s_waitcnt lgkmcnt(0)" ::: "memory");
        __builtin_amdgcn_s_barrier();
        asm volatile("" ::: "memory");
    }
#undef RH_ISSUE
    route_topk(S, 0, hh, K0);
    route_topk(S, 1, hh, K1);
}

__device__ void ph_route(const Params& p, unsigned char* smem, const int vb) {
    const int tid = threadIdx.x, lane = tid & 63, wid = tid >> 6;
    const int r32 = lane & 31, hh = lane >> 5;
    const int hmask = -hh;
    int* KL = (int*)(smem + (size_t)wid * 32 * QSTR * 2);
    for (int u = vb; u < (T_TOK / 128) * 8; u += gridDim.x) {
        const int m0 = (u >> 3) * 128, h = u & 7;
        __syncthreads();
        int K0[16], K1[16];
        route_head(p, smem, m0, h, K0, K1);
#pragma unroll
        for (int i = 0; i < 16; ++i) KL[r32 * 33 + hh * 16 + i] = K0[i] ^ ((K0[i] ^ K1[i]) & hmask);
        float s1[16], s2[16];
#pragma unroll
        for (int i = 0; i < 16; ++i) { s1[i] = key2f(K0[i] & ~0x7F); s2[i] = key2f(K1[i] & ~0x7F); }
        int c[4][16];
#pragma unroll
        for (int i = 0; i < 16; ++i)
#pragma unroll
            for (int j = 0; j < 16; ++j)
                if ((i + 1) * (j + 1) <= 16) {
                    constexpr int OFFS[16] = {0, 16, 24, 29, 33, 36, 38, 40, 42, 43, 44, 45, 46, 47, 48, 49};
                    const int q = OFFS[i] + j;
                    c[q >> 4][q & 15] = (f2key(s1[i] + s2[j]) & ~0xFF) | (255 - (i * 16 + j));
                }
#pragma unroll
        for (int qq = 50; qq < 64; ++qq) c[qq >> 4][qq & 15] = (int)0x80000000;
        top16_of_64(c);
        const float mx = key2f(c[0][0] & ~0xFF);
        float e[16]; float den = 0.f;
#pragma unroll
        for (int i = 0; i < 16; ++i) { e[i] = __expf(key2f(c[0][i] & ~0xFF) - mx); den += e[i]; }
        const float inv = __builtin_amdgcn_rcpf(den);
        const size_t ob = (size_t)(m0 + wid * 32 + r32) * 128 + h * 16 + hh * 8;
        int idv[8]; float gv[8];
#pragma unroll
        for (int qq = 0; qq < 8; ++qq) {
            const int F = c[0][qq] ^ ((c[0][qq] ^ c[0][8 + qq]) & hmask);
            gv[qq] = __int_as_float(__float_as_int(e[qq]) ^ ((__float_as_int(e[qq]) ^ __float_as_int(e[8 + qq])) & hmask)) * inv;
            const int idx = 255 - (F & 0xFF);
            const int k0 = KL[r32 * 33 + (idx >> 4)], k1 = KL[r32 * 33 + 16 + (idx & 15)];
            idv[qq] = (127 - (k0 & 0x7F)) * 128 + (127 - (k1 & 0x7F));
        }
        *(int4*)(p.ids + ob) = make_int4(idv[0], idv[1], idv[2], idv[3]);
        *(int4*)(p.ids + ob + 4) = make_int4(idv[4], idv[5], idv[6], idv[7]);
        *(float4*)(p.gates + ob) = make_float4(gv[0], gv[1], gv[2], gv[3]);
        *(float4*)(p.gates + ob + 4) = make_float4(gv[4], gv[5], gv[6], gv[7]);
    }
}

typedef __bf16 bf16x2_t __attribute__((ext_vector_type(2)));
__device__ __forceinline__ float dot2bf(unsigned a, unsigned b, float acc) {
    return __builtin_amdgcn_fdot2_f32_bf16(__builtin_bit_cast(bf16x2_t, a), __builtin_bit_cast(bf16x2_t, b), acc, false);
}
__device__ __forceinline__ f32x2 row_dot(const u32x4 w, const f32x2 (&x)[8], f32x2 acc) {
#pragma unroll
    for (int k = 0; k < 4; ++k) {
        acc = __builtin_amdgcn_cvt_pk_f32_fp8(w[k], false) * x[2 * k] + acc;
        acc = __builtin_amdgcn_cvt_pk_f32_fp8(w[k], true) * x[2 * k + 1] + acc;
    }
    return acc;
}
__device__ __forceinline__ float gelu_gate(float h, float g) { return 0.5f * h * (1.0f + erff(h * 0.70710678118654752f)) * g; }

__device__ __forceinline__ void ld_ids16(const int* __restrict__ q, int (&idv)[16]) {
    const int4* idp = (const int4*)q;
#pragma unroll
    for (int k = 0; k < 4; ++k) { const int4 v = idp[k]; idv[4 * k] = v.x; idv[4 * k + 1] = v.y; idv[4 * k + 2] = v.z; idv[4 * k + 3] = v.w; }
}
__device__ __forceinline__ void ld_f16(const float* __restrict__ q, float (&a)[16]) {
    const f32x4* ap = (const f32x4*)q;
#pragma unroll
    for (int k = 0; k < 4; ++k) { const f32x4 v = ap[k]; a[4 * k] = v[0]; a[4 * k + 1] = v[1]; a[4 * k + 2] = v[2]; a[4 * k + 3] = v[3]; }
}
__device__ void ph_peer_u(const Params& p, unsigned char* smem, const int vb) {
    const int lane = threadIdx.x & 63, wid = threadIdx.x >> 6, g = lane >> 3, c = lane & 7;
    const int nlb = gridDim.x >> 3, s = vb / nlb, lb = vb - s * nlb;
    const bool b2 = (lane & 4) != 0, b1 = (lane & 2) != 0, b0 = (lane & 1) != 0;
    const int cc = (b0 ? 2 : 0) + (b1 ? 4 : 0) + (b2 ? 8 : 0);
    const unsigned char* ubase = p.u8 + (size_t)s * (16384 * 128) + c * 16;
    const int stride = nlb * 4, t0 = lb * 4 + wid;
    const int ntok = (T_TOK - t0 + stride - 1) / stride;
    if (ntok <= 0) return;
    LDS_AS unsigned char* ring = (LDS_AS unsigned char*)smem + wid * 2048;
    const int* idg = p.ids + 2 * lane;
    const bf16_t* xg = p.x1b + s * 128 + 2 * lane;
#define PU_TOK(n) (t0 + ((n) < ntok ? (n) : ntok - 1) * stride)
#define PU_RAW_LD(n, ri, rx) do { const int _t = PU_TOK(n); ri = *(const u32x2*)(idg + (size_t)_t * 128); const unsigned _w = *(const unsigned*)(xg + (size_t)_t * DM); rx = (u32x2){_w << 16, _w & 0xffff0000u}; } while (0)
#define PU_RAW_ST(n, ri, rx) do { LDS_AS unsigned char* _b = ring + ((n) & 1) * 1024; *(LDS_AS u32x2*)(_b + lane * 8) = ri; *(LDS_AS u32x2*)(_b + 512 + lane * 8) = rx; } while (0)
#define PU_IDS(n, idv) do { const LDS_AS u32x4* _q = (const LDS_AS u32x4*)(ring + ((n) & 1) * 1024 + g * 64); \
        _Pragma("unroll") for (int _k = 0; _k < 4; ++_k) { const u32x4 _v = _q[_k]; idv[4 * _k] = (int)_v[0]; idv[4 * _k + 1] = (int)_v[1]; idv[4 * _k + 2] = (int)_v[2]; idv[4 * _k + 3] = (int)_v[3]; } } while (0)
    u32x4 wA[8], wB[8]; u32x2 ri, rx;
    {
        u32x2 i0, x0, i1, x1v;
        PU_RAW_LD(0, i0, x0); PU_RAW_LD(1, i1, x1v); PU_RAW_LD(2, ri, rx);
        PU_RAW_ST(0, i0, x0); PU_RAW_ST(1, i1, x1v);
        int id0[16]; PU_IDS(0, id0);
#pragma unroll
        for (int i = 0; i < 8; ++i) wA[i] = *(const u32x4*)(ubase + (size_t)id0[i] * 128);
#pragma unroll
        for (int i = 0; i < 8; ++i) wB[i] = *(const u32x4*)(ubase + (size_t)id0[8 + i] * 128);
    }
#pragma unroll 1
    for (int n = 0; n < ntok; ++n) {
        const int t = t0 + n * stride;
        f32x2 x[8];
        {
            const LDS_AS f32x4* q = (const LDS_AS f32x4*)(ring + (n & 1) * 1024 + 512 + c * 64);
#pragma unroll
            for (int k = 0; k < 4; ++k) { const f32x4 v4 = q[k]; x[2 * k] = (f32x2){v4[0], v4[1]}; x[2 * k + 1] = (f32x2){v4[2], v4[3]}; }
        }
        int idn[16]; PU_IDS(n + 1, idn);
        float v[16];
#pragma unroll
        for (int i = 0; i < 8; ++i) { const f32x2 a = row_dot(wA[i], x, (f32x2){0.f, 0.f}); v[i] = a.x + a.y; }
#pragma unroll
        for (int i = 0; i < 8; ++i) wA[i] = *(const u32x4*)(ubase + (size_t)idn[i] * 128);
#pragma unroll
        for (int i = 0; i < 8; ++i) { const f32x2 a = row_dot(wB[i], x, (f32x2){0.f, 0.f}); v[8 + i] = a.x + a.y; }
#pragma unroll
        for (int i = 0; i < 8; ++i) wB[i] = *(const u32x4*)(ubase + (size_t)idn[8 + i] * 128);
        PU_RAW_ST(n + 2, ri, rx);
        PU_RAW_LD(n + 3, ri, rx);
#pragma unroll
        for (int i = 0; i < 8; ++i) { const float keep = b2 ? v[i + 8] : v[i], send = b2 ? v[i] : v[i + 8]; v[i] = keep + __shfl_xor(send, 4); }
#pragma unroll
        for (int i = 0; i < 4; ++i) { const float keep = b1 ? v[i + 4] : v[i], send = b1 ? v[i] : v[i + 4]; v[i] = keep + __shfl_xor(send, 2); }
#pragma unroll
        for (int i = 0; i < 2; ++i) { const float keep = b0 ? v[i + 2] : v[i], send = b0 ? v[i] : v[i + 2]; v[i] = keep + __shfl_xor(send, 1); }
        *(unsigned*)(p.hp + ((size_t)t * 8 + s) * 128 + g * 16 + cc) = pack2(v[0], v[1]);
    }
}
__device__ void ph_peer_act(const Params& p, const int vb) {
    const int lane = threadIdx.x & 63, wid = threadIdx.x >> 6;
    for (int t = vb * 4 + wid; t < T_TOK; t += gridDim.x * 4) {
        f32x2 h = {0.f, 0.f};
#pragma unroll
        for (int s = 0; s < 8; ++s) { const unsigned w = *(const unsigned*)(p.hp + ((size_t)t * 8 + s) * 128 + 2 * lane); h += (f32x2){bflo(w), bfhi(w)}; }
        const int2 id = *(const int2*)(p.ids + (size_t)t * 128 + 2 * lane);
        const f32x2 gt = *(const f32x2*)(p.gates + (size_t)t * 128 + 2 * lane);
        f32x2 a;
        a.x = gelu_gate(h.x * p.su[id.x], gt.x) * p.sv[id.x];
        a.y = gelu_gate(h.y * p.su[id.y], gt.y) * p.sv[id.y];
        *(f32x2*)(p.gates + (size_t)t * 128 + 2 * lane) = a;
    }
}
__device__ void ph_peer_v(const Params& p, unsigned char* smem, const int vb) {
    const int lane = threadIdx.x & 63, wid = threadIdx.x >> 6, g = lane >> 3, c = lane & 7;
    const int nlb = gridDim.x >> 3, s = vb / nlb, lb = vb - s * nlb;
    const bool b4 = (lane & 16) != 0, b3 = (lane & 8) != 0;
    const unsigned char* vbase = p.v8 + (size_t)s * (16384 * 128) + c * 16;
    const int stride = nlb * 4, t0 = lb * 4 + wid;
    const int ntok = (T_TOK - t0 + stride - 1) / stride;
    if (ntok <= 0) return;
    const int d0 = s * 128 + c * 16 + 2 * g;
    LDS_AS unsigned char* ring = (LDS_AS unsigned char*)smem + wid * 2048;
    const int* idg = p.ids + 2 * lane;
    const float* ag = p.gates + 2 * lane;
#define PV_RAW_LD(n, ri, rx) do { const int _t = PU_TOK(n); ri = *(const u32x2*)(idg + (size_t)_t * 128); rx = *(const u32x2*)(ag + (size_t)_t * 128); } while (0)
    u32x4 wA[8], wB[8]; u32x2 ri, rx;
    {
        u32x2 i0, x0, i1, x1v;
        PV_RAW_LD(0, i0, x0); PV_RAW_LD(1, i1, x1v); PV_RAW_LD(2, ri, rx);
        PU_RAW_ST(0, i0, x0); PU_RAW_ST(1, i1, x1v);
        int id0[16]; PU_IDS(0, id0);
#pragma unroll
        for (int i = 0; i < 8; ++i) wA[i] = *(const u32x4*)(vbase + (size_t)id0[i] * 128);
#pragma unroll
        for (int i = 0; i < 8; ++i) wB[i] = *(const u32x4*)(vbase + (size_t)id0[8 + i] * 128);
    }
#pragma unroll 1
    for (int n = 0; n < ntok; ++n) {
        const int t = t0 + n * stride;
        const unsigned xw = *(const unsigned*)(p.x1b + (size_t)t * DM + d0);
        const f32x2 xv = {bflo(xw), bfhi(xw)};
        float ac[16];
        {
            const LDS_AS f32x4* q = (const LDS_AS f32x4*)(ring + (n & 1) * 1024 + 512 + g * 64);
#pragma unroll
            for (int k = 0; k < 4; ++k) { const f32x4 v4 = q[k]; ac[4 * k] = v4[0]; ac[4 * k + 1] = v4[1]; ac[4 * k + 2] = v4[2]; ac[4 * k + 3] = v4[3]; }
        }
        int idn[16]; PU_IDS(n + 1, idn);
        f32x2 acc[8];
#pragma unroll
        for (int k = 0; k < 8; ++k) acc[k] = (f32x2){0.f, 0.f};
#pragma unroll
        for (int i = 0; i < 8; ++i) {
            const f32x2 a2 = {ac[i], ac[i]};
#pragma unroll
            for (int k = 0; k < 4; ++k) {
                acc[2 * k] = __builtin_amdgcn_cvt_pk_f32_fp8(wA[i][k], false) * a2 + acc[2 * k];
                acc[2 * k + 1] = __builtin_amdgcn_cvt_pk_f32_fp8(wA[i][k], true) * a2 + acc[2 * k + 1];
            }
        }
#pragma unroll
        for (int i = 0; i < 8; ++i) wA[i] = *(const u32x4*)(vbase + (size_t)idn[i] * 128);
#pragma unroll
        for (int i = 0; i < 8; ++i) {
            const f32x2 a2 = {ac[8 + i], ac[8 + i]};
#pragma unroll
            for (int k = 0; k < 4; ++k) {
                acc[2 * k] = __builtin_amdgcn_cvt_pk_f32_fp8(wB[i][k], false) * a2 + acc[2 * k];
                acc[2 * k + 1] = __builtin_amdgcn_cvt_pk_f32_fp8(wB[i][k], true) * a2 + acc[2 * k + 1];
            }
        }
#pragma unroll
        for (int i = 0; i < 8; ++i) wB[i] = *(const u32x4*)(vbase + (size_t)idn[8 + i] * 128);
        PU_RAW_ST(n + 2, ri, rx);
        PV_RAW_LD(n + 3, ri, rx);
        float v[16];
#pragma unroll
        for (int k = 0; k < 8; ++k) { v[2 * k] = acc[k].x; v[2 * k + 1] = acc[k].y; }
#pragma unroll
        for (int j2 = 0; j2 < 8; ++j2) {
            auto r = __builtin_amdgcn_permlane32_swap(__float_as_uint(v[j2]), __float_as_uint(v[j2 + 8]), false, false);
            v[j2] = __uint_as_float(r[0]) + __uint_as_float(r[1]);
        }
#pragma unroll
        for (int j2 = 0; j2 < 4; ++j2) { const float keep = b4 ? v[j2 + 4] : v[j2], send = b4 ? v[j2] : v[j2 + 4]; v[j2] = keep + __shfl_xor(send, 16); }
#pragma unroll
        for (int j2 = 0; j2 < 2; ++j2) { const float keep = b3 ? v[j2 + 2] : v[j2], send = b3 ? v[j2] : v[j2 + 2]; v[j2] = keep + __shfl_xor(send, 8); }
        const float r0 = ALPHA * xv.x + v[0], r1 = ALPHA * xv.y + v[1];
        *(unsigned*)(p.rb + (size_t)t * DM + d0) = pack2(r0, r1);
    }
}

__device__ void ph_gemm_ple(const Params& p, unsigned char* smem, const int vb) {
    const int ntn = DM / 128;
    const int tid = threadIdx.x, lane = tid & 63, wid = tid >> 6, wr = wid >> 1, wc = wid & 1, fr = lane & 15, fq = lane >> 4;
    for (int t = vb; t < (T_TOK / 128) * ntn; t += gridDim.x) {
        const int m0 = (t / ntn) * 128, n0 = (t % ntn) * 128;
        f32x4 acc[4][4], acc2[4][4]; zero_acc(acc); zero_acc(acc2);
        gemm128(p.pb + (size_t)m0 * 256, 256, p.WpT + (size_t)n0 * 256, 256, 256, smem, acc2);
        gemm128(p.rb + (size_t)m0 * DM, DM, p.WgT + (size_t)n0 * DM, DM, DM, smem, acc);
#pragma unroll
        for (int mi = 0; mi < 4; ++mi) {
            const int row = m0 + wr * 64 + mi * 16 + fr;
#pragma unroll
            for (int ni = 0; ni < 4; ++ni) {
                const int col = n0 + wc * 64 + ni * 16 + fq * 4;
                const u32x2 rw = *(const u32x2*)(p.rb + (size_t)row * DM + col);
                f32x4 rv = {bflo(rw[0]), bfhi(rw[0]), bflo(rw[1]), bfhi(rw[1])};
#pragma unroll
                for (int r = 0; r < 4; ++r) rv[r] += sigmul(acc2[mi][ni][r], acc[mi][ni][r]);
                *(f32x4*)(p.out + (size_t)row * DM + col) = rv;
            }
        }
    }
}

#define XB_TMO      128
#define XB_XCNT(j)  (256  + 64 * (j))
#define XB_XSUB(j)  (1280 + 64 * (j))
#define XB_XGEN(j)  (2304 + 64 * (j))
#define XB_TOP      3328
#define XB_TOPGEN   3392
#define XCD_BAR_WORDS 3456
#define XB_SPIN_CAP (1u << 20)
__device__ __forceinline__ unsigned xb_ld(unsigned* p)              { return __hip_atomic_load(p, __ATOMIC_RELAXED, __HIP_MEMORY_SCOPE_AGENT); }
__device__ __forceinline__ unsigned xb_add(unsigned* p, unsigned v) { return __hip_atomic_fetch_add(p, v, __ATOMIC_RELAXED, __HIP_MEMORY_SCOPE_AGENT); }
__device__ __forceinline__ unsigned xb_xcc_id() { return (unsigned)__builtin_amdgcn_s_getreg((3 << 11) | 20) & 0xFu; }
#define XB_SPIN(cond, bar) do { unsigned _sp = 0; while (cond) { __builtin_amdgcn_s_sleep(1); \
    if ((++_sp & 255u) == 0u) { if (xb_ld(&(bar)[XB_TMO])) break; if (_sp > XB_SPIN_CAP) { atomicAdd(&(bar)[XB_TMO], 1u); break; } } } } while (0)
struct XcdBarrier { unsigned* bar; unsigned x; volatile LDS_AS unsigned* st; };
__device__ __forceinline__ XcdBarrier xcd_barrier_post(unsigned* bar, volatile LDS_AS unsigned* st) {
    XcdBarrier b; b.bar = bar; b.x = xb_xcc_id(); b.st = st;
    if (threadIdx.x == 0) st[3] = xb_add(&bar[XB_XCNT(b.x)], 1u);
    return b;
}
__device__ __forceinline__ void xcd_barrier_complete(unsigned* bar, unsigned x, unsigned rank, unsigned& nloc, unsigned& nx, unsigned& vb) {
    const unsigned G = gridDim.x;
    unsigned sum, cnt, mine, sp = 0u; bool even;
    for (;;) {
        sum = 0u; cnt = 0u; mine = 0u; even = true;
#pragma unroll
        for (unsigned j = 0; j < 16; ++j) {
            const unsigned c = xb_ld(&bar[XB_XCNT(j)]); sum += c; cnt += (c > 0u) ? 1u : 0u; mine = (j == x) ? c : mine;
            even = even && (c == ((j < 8u) ? (G >> 3) : 0u));
        }
        if (sum == G) break;
        __builtin_amdgcn_s_sleep(1);
        if ((++sp & 255u) == 0u) { if (xb_ld(&bar[XB_TMO])) break; if (sp > XB_SPIN_CAP) { atomicAdd(&bar[XB_TMO], 1u); break; } }
    }
    nloc = mine > 0u ? mine : 1u; nx = cnt > 0u ? cnt : 1u;
    vb = (even && sum == G && (G & 7u) == 0u) ? (x * (G >> 3) + rank) : blockIdx.x;
}
__device__ __forceinline__ void xcd_barrier(const XcdBarrier& b) {
    asm volatile("s_waitcnt vmcnt(0)" ::: "memory");
    __syncthreads();
    if (threadIdx.x == 0) {
        unsigned* bar = b.bar;
        __builtin_amdgcn_s_waitcnt(0);
        unsigned nloc = b.st[0], nx = b.st[1];
        if (nloc == 0u) { unsigned vb; xcd_barrier_complete(bar, b.x, b.st[3], nloc, nx, vb); b.st[0] = nloc; b.st[1] = nx; b.st[2] = vb; }
        const unsigned old = xb_add(&bar[XB_XSUB(b.x)], 1u);
        const unsigned gen = old / nloc;
        if (old + 1u == (gen + 1u) * nloc) {
            __builtin_amdgcn_fence(__ATOMIC_RELEASE, "agent");
            asm volatile("s_waitcnt vmcnt(0)" ::: "memory");
            const unsigned og = xb_add(&bar[XB_TOP], 1u);
            const unsigned tg = og / nx;
            if (og + 1u == (tg + 1u) * nx) xb_add(&bar[XB_TOPGEN], 1u);
            else XB_SPIN(xb_ld(&bar[XB_TOPGEN]) == tg, bar);
            __builtin_amdgcn_fence(__ATOMIC_ACQUIRE, "agent");
            xb_add(&bar[XB_XGEN(b.x)], 1u);
            asm volatile("s_waitcnt vmcnt(0)" ::: "memory");
        } else {
            XB_SPIN(xb_ld(&bar[XB_XGEN(b.x)]) == gen, bar);
            __builtin_amdgcn_fence(__ATOMIC_ACQUIRE, "agent");
            asm volatile("s_waitcnt vmcnt(0)" ::: "memory");
        }
    }
    __syncthreads();
}

#define SMEM_PHASE (256 * ASTR * 2 * 2)
#define SMEM_BYTES (SMEM_PHASE + 16)
__global__ void __launch_bounds__(256, 2) mega(Params p) {
    __shared__ __attribute__((aligned(16))) unsigned char smem[SMEM_BYTES];
    volatile LDS_AS unsigned* st = (volatile LDS_AS unsigned*)(LDS_AS unsigned char*)(smem + SMEM_PHASE);
    if (threadIdx.x < 4) st[threadIdx.x] = 0u;
    __syncthreads();
    const XcdBarrier gb = xcd_barrier_post(p.bar, st);
    ph_prep(p, smem);            xcd_barrier(gb);
    const int vb = (int)st[2];
    ph_mprep(p, smem, vb);
    ph_gemm_in(p, smem, vb);     xcd_barrier(gb);
    ph_attn(p, smem, vb);
    ph_conv(p, smem, vb);        xcd_barrier(gb);
    ph_gemm_out(p, smem, vb);    xcd_barrier(gb);
    ph_ln1(p, vb);               xcd_barrier(gb);
    ph_route(p, smem, vb);       xcd_barrier(gb);
    ph_peer_u(p, smem, vb);      xcd_barrier(gb);
    ph_peer_act(p, vb);          xcd_barrier(gb);
    ph_peer_v(p, smem, vb);      xcd_barrier(gb);
    ph_gemm_ple(p, smem, vb);    xcd_barrier(gb);
    ph_ln2(p, vb);
}

extern "C" void kernel_launch(void* const* d_in, const int* in_sizes, int n_in, void* d_out, int out_size, void* d_ws, size_t ws_size,
                              hipStream_t stream) {
    Params p{};
    p.x = (const float*)d_in[0]; p.p = (const float*)d_in[1]; p.pos = (const int*)d_in[2];
    p.w_in = (const float*)d_in[3]; p.sinks = (const float*)d_in[4]; p.conv_w = (const float*)d_in[5]; p.conv_b = (const float*)d_in[6];
    p.cln_g = (const float*)d_in[7]; p.cln_b = (const float*)d_in[8]; p.w_out = (const float*)d_in[9]; p.ln1_g = (const float*)d_in[10];
    p.ln1_b = (const float*)d_in[11]; p.wq = (const float*)d_in[12]; p.keys = (const float*)d_in[13]; p.pu = (const float*)d_in[14];
    p.pv = (const float*)d_in[15]; p.ple_proj = (const float*)d_in[16]; p.ple_gate = (const float*)d_in[17]; p.ln2_g = (const float*)d_in[18];
    p.ln2_b = (const float*)d_in[19];
    p.out = (float*)d_out;
    unsigned char* ws = (unsigned char*)d_ws;
    const size_t MiB = 1024 * 1024;
    p.y1 = (float*)(ws + 0 * MiB);
    p.hb = (bf16_t*)(ws + 128 * MiB);
    p.qb = (bf16_t*)(ws + 128 * MiB);
    p.hp = (bf16_t*)(ws + 128 * MiB);
    p.xb = (bf16_t*)(ws + 256 * MiB);
    p.x1b = (bf16_t*)(ws + 256 * MiB);
    p.mixb = (bf16_t*)(ws + 320 * MiB);
    p.tops = (float*)(ws + 320 * MiB);
    p.topi = (int*)(ws + 352 * MiB);
    p.rb = (bf16_t*)(ws + 320 * MiB);
    p.pb = (bf16_t*)(ws + 384 * MiB);
    p.ub = (bf16_t*)(ws + 400 * MiB);
    p.vb = (bf16_t*)(ws + 432 * MiB);
    p.u8 = (unsigned char*)(ws + 400 * MiB);
    p.v8 = (unsigned char*)(ws + 416 * MiB);
    p.su = (float*)(ws + 432 * MiB);
    p.sv = (float*)(ws + 433 * MiB);
    p.ids = (int*)(ws + 464 * MiB);
    p.gates = (float*)(ws + 480 * MiB);
    unsigned char* wb = ws + 496 * MiB;
    p.WinT = (bf16_t*)wb; wb += (size_t)INW * DM * 2;
    p.WoutT = (bf16_t*)wb; wb += (size_t)DM * DM * 2;
    p.WqT = (bf16_t*)wb; wb += (size_t)2048 * DM * 2;
    p.WgT = (bf16_t*)wb; wb += (size_t)DM * DM * 2;
    p.WpT = (bf16_t*)wb; wb += (size_t)DM * 256 * 2;
    p.keysb = (bf16_t*)wb; wb += (size_t)16 * 128 * 128 * 2;
    p.Wqb = (bf16_t*)(ws + 240 * MiB);
    p.MT = (bf16_t*)(ws + 244 * MiB);
    p.bar = (unsigned*)(ws + 510 * MiB);
    p.x1 = (float*)d_out;

    static int grid_blocks = 0;
    if (!grid_blocks) {
        int dev = 0, cus = 0, per_cu = 0;
        (void)hipGetDevice(&dev);
        (void)hipDeviceGetAttribute(&cus, hipDeviceAttributeMultiprocessorCount, dev);
        (void)hipOccupancyMaxActiveBlocksPerMultiprocessor(&per_cu, mega, 256, 0);
        if (per_cu > 2) per_cu = 2;
        grid_blocks = cus * per_cu;
    }
    (void)hipMemsetAsync(p.bar, 0, XCD_BAR_WORDS * sizeof(unsigned), stream);
    void* args[] = {&p};
    hipError_t e = hipLaunchCooperativeKernel((void*)mega, dim3(grid_blocks), dim3(256), args, 0, stream);
    if (e != hipSuccess) fprintf(stderr, "cooperative launch failed: %s (grid %d)\n", hipGetErrorString(e), grid_blocks);
}
```

```cpp
#include <hip/hip_runtime.h>
#include <stdint.h>
#include <cstdio>

typedef unsigned short bf16_t;
typedef short bf16x8 __attribute__((ext_vector_type(8)));
typedef float f32x4 __attribute__((ext_vector_type(4)));
typedef unsigned u32x4 __attribute__((ext_vector_type(4)));
typedef float f32x2 __attribute__((ext_vector_type(2)));

#define T_TOK 32768
#define SEQ 2048
#define DM 1024
#define INW 1792
#define ALPHA 1.189207115002721f
#define LN_EPS 1e-5f

__device__ __forceinline__ bf16_t f2bf(float f) {
    unsigned u = __float_as_uint(f);
    u += 0x7fffu + ((u >> 16) & 1u);
    return (bf16_t)(u >> 16);
}
__device__ __forceinline__ float bf2f(bf16_t b) { return __uint_as_float(((unsigned)b) << 16); }
__device__ __forceinline__ float bflo(unsigned w) { return __uint_as_float(w << 16); }
__device__ __forceinline__ float bfhi(unsigned w) { return __uint_as_float(w & 0xffff0000u); }
__device__ __forceinline__ unsigned pack2(float a, float b) { return (unsigned)f2bf(a) | ((unsigned)f2bf(b) << 16); }

__device__ __forceinline__ float sigmul(float x, float g) { return x * __builtin_amdgcn_rcpf(1.0f + __expf(-g)); }
__device__ __forceinline__ float wave_sum(float v) {
#pragma unroll
    for (int o = 32; o >= 1; o >>= 1) v += __shfl_xor(v, o);
    return v;
}

struct Params {
    const float *x, *p; const int* pos;
    const float *w_in, *sinks, *conv_w, *conv_b, *cln_g, *cln_b, *w_out, *ln1_g, *ln1_b;
    const float *wq, *keys, *pu, *pv, *ple_proj, *ple_gate, *ln2_g, *ln2_b;
    float* out;
    bf16_t *xb, *pb, *WinT, *WoutT, *WgT, *WpT, *keysb, *Wqb, *MT, *hb, *mixb, *x1b, *rb;
    float *y1, *gates, *su, *sv;
    bf16_t* hp;
    int *ids;
    unsigned char *u8, *v8;
    unsigned* bar;
};

__device__ void cvt_rows(const float* __restrict__ src, bf16_t* __restrict__ dst, size_t n) {
    const size_t nv = n / 8, gs = (size_t)gridDim.x * blockDim.x;
    for (size_t i = (size_t)blockIdx.x * blockDim.x + threadIdx.x; i < nv; i += 4 * gs) {
        f32x4 a[4], b[4];
#pragma unroll
        for (int q = 0; q < 4; ++q) { const size_t k = (i + q * gs < nv) ? i + q * gs : i; a[q] = ((const f32x4*)src)[2 * k]; b[q] = ((const f32x4*)src)[2 * k + 1]; }
#pragma unroll
        for (int q = 0; q < 4; ++q) {
            if (i + q * gs < nv) {
                u32x4 o; o[0] = pack2(a[q][0], a[q][1]); o[1] = pack2(a[q][2], a[q][3]); o[2] = pack2(b[q][0], b[q][1]); o[3] = pack2(b[q][2], b[q][3]);
                ((u32x4*)dst)[i + q * gs] = o;
            }
        }
    }
}
__device__ void transpose_cvt(const float* __restrict__ W, bf16_t* __restrict__ Wt, int K, int N, float* tile  ) {
    const int tk = K / 64, tn = N / 64;
    const int tid = threadIdx.x;
    for (int t = blockIdx.x; t < tk * tn; t += gridDim.x) {
        const int k0 = (t / tn) * 64, n0 = (t % tn) * 64;
        f32x4 v[4];
#pragma unroll
        for (int i = 0; i < 4; ++i) v[i] = *(const f32x4*)(W + (size_t)(k0 + (tid >> 4) + 16 * i) * N + n0 + (tid & 15) * 4);
        __syncthreads();
#pragma unroll
        for (int i = 0; i < 4; ++i)
#pragma unroll
            for (int j = 0; j < 4; ++j) tile[((tid >> 4) + 16 * i) * 65 + (tid & 15) * 4 + j] = v[i][j];
        __syncthreads();
        const int n = tid >> 2, kc = (tid & 3) * 16;
        u32x4 o0, o1;
#pragma unroll
        for (int q = 0; q < 4; ++q) {
            o0[q] = pack2(tile[(kc + 2 * q) * 65 + n], tile[(kc + 2 * q + 1) * 65 + n]);
            o1[q] = pack2(tile[(kc + 8 + 2 * q) * 65 + n], tile[(kc + 8 + 2 * q + 1) * 65 + n]);
        }
        *(u32x4*)(Wt + (size_t)(n0 + n) * K + k0 + kc) = o0;
        *(u32x4*)(Wt + (size_t)(n0 + n) * K + k0 + kc + 8) = o1;
    }
}
__device__ void cvt_table_fp8(const float* __restrict__ src, unsigned char* __restrict__ dst, float* __restrict__ scl, int rows) {
    const int lane = threadIdx.x & 63, wid = threadIdx.x >> 6;
    const int nw = gridDim.x * 4;
    for (int r0 = blockIdx.x * 4 + wid; r0 < rows; r0 += 4 * nw) {
        f32x4 v[4][4];
#pragma unroll
        for (int q = 0; q < 4; ++q) {
            const int r = (r0 + q * nw < rows) ? r0 + q * nw : r0;
            const float* sr = src + (size_t)r * DM + lane * 16;
#pragma unroll
            for (int k = 0; k < 4; ++k) v[q][k] = *(const f32x4*)(sr + 4 * k);
        }
#pragma unroll
        for (int q = 0; q < 4; ++q) {
            const int r = r0 + q * nw;
            float m = 0.f;
#pragma unroll
            for (int k = 0; k < 4; ++k)
#pragma unroll
                for (int i = 0; i < 4; ++i) m = fmaxf(m, fabsf(v[q][k][i]));
#pragma unroll
            for (int o = 32; o >= 1; o >>= 1) m = fmaxf(m, __shfl_xor(m, o));
            const float sc = (m > 0.f) ? 448.0f / m : 1.0f;
            u32x4 w;
#pragma unroll
            for (int k = 0; k < 4; ++k)
                w[k] = __builtin_amdgcn_cvt_pk_fp8_f32(v[q][k][2] * sc, v[q][k][3] * sc, __builtin_amdgcn_cvt_pk_fp8_f32(v[q][k][0] * sc, v[q][k][1] * sc, 0, false), true);
            if (r < rows) {
                *(u32x4*)(dst + (size_t)(lane >> 3) * (16384 * 128) + (size_t)r * 128 + (lane & 7) * 16) = w;
                if (lane == 0) scl[r] = (m > 0.f) ? m * (1.0f / 448.0f) : 1.0f;
            }
        }
    }
}
__device__ void ph_prep(const Params& p, unsigned char* smem) {
    float* tile = (float*)smem;
    cvt_rows(p.x, p.xb, (size_t)T_TOK * DM);
    cvt_rows(p.p, p.pb, (size_t)T_TOK * 256);
    cvt_table_fp8(p.pu, p.u8, p.su, 16384);
    cvt_table_fp8(p.pv, p.v8, p.sv, 16384);
    cvt_rows(p.keys, p.keysb, (size_t)16 * 128 * 128);
    transpose_cvt(p.w_in, p.WinT, DM, INW, tile);
    transpose_cvt(p.w_out, p.WoutT, DM, DM, tile);
    cvt_rows(p.wq, p.Wqb, (size_t)DM * 2048);
    transpose_cvt(p.ple_gate, p.WgT, DM, DM, tile);
    transpose_cvt(p.ple_proj, p.WpT, 256, DM, tile);
}

#define LDS_AS __attribute__((address_space(3)))
#define GEMM_STAGE 32768
__device__ __forceinline__ void gemm128(const bf16_t* __restrict__ A, int lda, const bf16_t* __restrict__ Bt, int ldb, int K,
                                        unsigned char* smem, f32x4 (&acc)[4][4]) {
    LDS_AS unsigned char* lds = (LDS_AS unsigned char*)smem;
    const int tid = threadIdx.x, lane = tid & 63, wid = __builtin_amdgcn_readfirstlane(tid >> 6);
    const int wr = wid >> 1, wc = wid & 1, fr = lane & 15, fq = lane >> 4;
    const int nk = K / 64;
    const int prow = lane >> 3, pc = (lane & 7) ^ prow;
    const bf16_t* gA = A + (size_t)(wid * 32 + prow) * lda + pc * 8;
    const bf16_t* gB = Bt + (size_t)(wid * 32 + prow) * ldb + pc * 8;
    const size_t a8 = (size_t)8 * lda, b8 = (size_t)8 * ldb;
#define GEMM_ISSUE(kt, st) do { \
        _Pragma("unroll") for (int _i = 0; _i < 4; ++_i) { \
            __builtin_amdgcn_global_load_lds((const unsigned*)(gA + _i * a8 + (size_t)(kt) * 64), (LDS_AS unsigned*)(lds + (st) * GEMM_STAGE + (wid * 4 + _i) * 1024), 16, 0, 0); \
            __builtin_amdgcn_global_load_lds((const unsigned*)(gB + _i * b8 + (size_t)(kt) * 64), (LDS_AS unsigned*)(lds + (st) * GEMM_STAGE + 16384 + (wid * 4 + _i) * 1024), 16, 0, 0); \
        } } while (0)
    const int swz0 = ((0 * 4 + fq) ^ (fr & 7)) * 16, swz1 = ((1 * 4 + fq) ^ (fr & 7)) * 16;
    const int aoff = (wr * 64 + fr) * 128, boff = 16384 + (wc * 64 + fr) * 128;
    GEMM_ISSUE(0, 0);
#pragma unroll 1
    for (int kt = 0; kt < nk; ++kt) {
        const int st = kt & 1;
        asm volatile("s_waitcnt vmcnt(0)" ::: "memory");
        __builtin_amdgcn_s_barrier();
        asm volatile("" ::: "memory");
        if (kt + 1 < nk) GEMM_ISSUE(kt + 1, st ^ 1);
        const LDS_AS unsigned char* sb = lds + st * GEMM_STAGE;
        bf16x8 af0[4], bf0[4], af1[4], bf1[4];
#pragma unroll
        for (int mi = 0; mi < 4; ++mi) af0[mi] = *(const LDS_AS bf16x8*)(sb + aoff + mi * 2048 + swz0);
#pragma unroll
        for (int ni = 0; ni < 4; ++ni) bf0[ni] = *(const LDS_AS bf16x8*)(sb + boff + ni * 2048 + swz0);
#pragma unroll
        for (int mi = 0; mi < 4; ++mi) af1[mi] = *(const LDS_AS bf16x8*)(sb + aoff + mi * 2048 + swz1);
#pragma unroll
        for (int ni = 0; ni < 4; ++ni) bf1[ni] = *(const LDS_AS bf16x8*)(sb + boff + ni * 2048 + swz1);
#pragma unroll
        for (int mi = 0; mi < 4; ++mi)
#pragma unroll
            for (int ni = 0; ni < 4; ++ni)
                acc[mi][ni] = __builtin_amdgcn_mfma_f32_16x16x32_bf16(bf0[ni], af0[mi], acc[mi][ni], 0, 0, 0);
#pragma unroll
        for (int mi = 0; mi < 4; ++mi)
#pragma unroll
            for (int ni = 0; ni < 4; ++ni)
                acc[mi][ni] = __builtin_amdgcn_mfma_f32_16x16x32_bf16(bf1[ni], af1[mi], acc[mi][ni], 0, 0, 0);
        __builtin_amdgcn_sched_group_barrier(0x100, 8, 0);
#pragma unroll
        for (int q = 0; q < 8; ++q) { __builtin_amdgcn_sched_group_barrier(0x008, 2, 0); __builtin_amdgcn_sched_group_barrier(0x100, 1, 0); }
        __builtin_amdgcn_sched_group_barrier(0x008, 16, 0);
        asm volatile("s_waitcnt lgkmcnt(0)" ::: "memory");
        __builtin_amdgcn_s_barrier();
        asm volatile("" ::: "memory");
    }
#undef GEMM_ISSUE
}
#define GW_STAGE 24576
__device__ __forceinline__ void gemmW(const bf16_t* __restrict__ A, int lda, const bf16_t* __restrict__ Bt, int ldb, int K,
                                      unsigned char* smem, f32x4 (&acc)[4][8]) {
    LDS_AS unsigned char* lds = (LDS_AS unsigned char*)smem;
    const int tid = threadIdx.x, lane = tid & 63, wid = __builtin_amdgcn_readfirstlane(tid >> 6);
    const int wr = wid >> 1, wc = wid & 1, fr = lane & 15, fq = lane >> 4;
    const int nk = K / 32;
    const int prow = lane >> 2, pc = (lane & 3) ^ ((4 - ((prow >> 2) & 3)) & 3);
    const bf16_t* gA = A + (size_t)(wid * 32 + prow) * lda + pc * 8;
    const bf16_t* gB = Bt + (size_t)(wid * 64 + prow) * ldb + pc * 8;
    const size_t a16 = (size_t)16 * lda, b16 = (size_t)16 * ldb;
#define GW_ISSUE(kt, st) do { \
        _Pragma("unroll") for (int _i = 0; _i < 2; ++_i) \
            __builtin_amdgcn_global_load_lds((const unsigned*)(gA + _i * a16 + (size_t)(kt) * 32), (LDS_AS unsigned*)(lds + (st) * GW_STAGE + (wid * 2 + _i) * 1024), 16, 0, 0); \
        _Pragma("unroll") for (int _i = 0; _i < 4; ++_i) \
            __builtin_amdgcn_global_load_lds((const unsigned*)(gB + _i * b16 + (size_t)(kt) * 32), (LDS_AS unsigned*)(lds + (st) * GW_STAGE + 8192 + (wid * 4 + _i) * 1024), 16, 0, 0); \
        } while (0)
    const int swz = (fq ^ ((4 - ((fr >> 2) & 3)) & 3)) * 16;
    const int aoff = (wr * 64 + fr) * 64 + swz, boff = 8192 + (wc * 128 + fr) * 64 + swz;
    GW_ISSUE(0, 0);
#pragma unroll 1
    for (int kt = 0; kt < nk; ++kt) {
        const int st = kt & 1;
        asm volatile("s_waitcnt vmcnt(0)" ::: "memory");
        __builtin_amdgcn_s_barrier();
        asm volatile("" ::: "memory");
        if (kt + 1 < nk) GW_ISSUE(kt + 1, st ^ 1);
        const LDS_AS unsigned char* sb = lds + st * GW_STAGE;
        bf16x8 af[4], bfr[8];
#pragma unroll
        for (int mi = 0; mi < 4; ++mi) af[mi] = *(const LDS_AS bf16x8*)(sb + aoff + mi * 1024);
#pragma unroll
        for (int ni = 0; ni < 8; ++ni) bfr[ni] = *(const LDS_AS bf16x8*)(sb + boff + ni * 1024);
#pragma unroll
        for (int ni = 0; ni < 8; ++ni)
#pragma unroll
            for (int mi = 0; mi < 4; ++mi)
                acc[mi][ni] = __builtin_amdgcn_mfma_f32_16x16x32_bf16(bfr[ni], af[mi], acc[mi][ni], 0, 0, 0);
        asm volatile("s_waitcnt lgkmcnt(0)" ::: "memory");
        __builtin_amdgcn_s_barrier();
        asm volatile("" ::: "memory");
    }
#undef GW_ISSUE
}
__device__ __forceinline__ void zero_accw(f32x4 (&acc)[4][8]) {
#pragma unroll
    for (int a = 0; a < 4; ++a)
#pragma unroll
        for (int b = 0; b < 8; ++b) acc[a][b] = (f32x4){0.f, 0.f, 0.f, 0.f};
}
__device__ __forceinline__ void zero_acc(f32x4 (&acc)[4][4]) {
#pragma unroll
    for (int a = 0; a < 4; ++a)
#pragma unroll
        for (int b = 0; b < 4; ++b) acc[a][b] = (f32x4){0.f, 0.f, 0.f, 0.f};
}
#define GEMM_SMEM (2 * GEMM_STAGE)

__device__ void ph_gemm_in(const Params& p, unsigned char* smem, const int vb) {
    const int ntn = INW / 128;
    const int tid = threadIdx.x, lane = tid & 63, wid = tid >> 6, wr = wid >> 1, wc = wid & 1, fr = lane & 15, fq = lane >> 4;
    for (int t = vb; t < (T_TOK / 128) * ntn; t += gridDim.x) {
        const int m0 = (t / ntn) * 128, n0 = (t % ntn) * 128;
        f32x4 acc[4][4]; zero_acc(acc);
        gemm128(p.xb + (size_t)m0 * DM, DM, p.WinT + (size_t)n0 * DM, DM, DM, smem, acc);
#pragma unroll
        for (int mi = 0; mi < 4; ++mi) {
            const int row = m0 + wr * 64 + mi * 16 + fr;
            const float posf = (float)p.pos[row];
#pragma unroll
            for (int ni = 0; ni < 4; ++ni) {
                const int col0 = n0 + wc * 64 + ni * 16;
                f32x4 v = acc[mi][ni];
                if (col0 < 640 && (col0 & 63) == 0) {
#pragma unroll
                    for (int r = 0; r < 4; ++r) {
                        const float other = __shfl_xor(v[r], 32);
                        const int j = (fq & 1) * 4 + r;
                        const float inv = powf(500000.0f, -(float)j * 0.125f);
                        float sn, cs; sincosf(posf * inv, &sn, &cs);
                        v[r] = (fq < 2) ? (v[r] * cs - other * sn) : (v[r] * cs + other * sn);
                    }
                }
                uint2 o; o.x = pack2(v[0], v[1]); o.y = pack2(v[2], v[3]);
                *(uint2*)(p.hb + (size_t)row * INW + col0 + fq * 4) = o;
            }
        }
    }
}

#define ASTR 72
#define VSTR 260
typedef float f32x16 __attribute__((ext_vector_type(16)));
typedef unsigned u32x2 __attribute__((ext_vector_type(2)));
__device__ void ph_attn(const Params& p, unsigned char* smem, const int vb) {
    bf16_t* sK = (bf16_t*)smem;
    bf16_t* sVt = sK + 256 * ASTR;
    const int tid = threadIdx.x, lane = tid & 63, wid = tid >> 6, r32 = lane & 31, hh = lane >> 5;
    const float C1 = 0.125f * 1.4426950408889634f, LOG2E = 1.4426950408889634f;
    for (int u = vb; u < 16 * 16 * 2; u += gridDim.x) {
        const int kvh = u & 1, nb = (u >> 1) & 15, b = u >> 5;
        __syncthreads();
        for (int c = tid; c < 256 * 8; c += 256) {
            const int li = c >> 3, kc = c & 7;
            const int pos = nb * 128 - 128 + li;
            u32x4 kv = {0u, 0u, 0u, 0u}, vv = {0u, 0u, 0u, 0u};
            if (pos >= 0) {
                const bf16_t* base = p.hb + (size_t)(b * SEQ + pos) * INW;
                kv = *(const u32x4*)(base + 512 + kvh * 64 + kc * 8);
                vv = *(const u32x4*)(base + 640 + kvh * 64 + kc * 8);
            }
            *(u32x4*)(sK + li * ASTR + kc * 8) = kv;
#pragma unroll
            for (int i = 0; i < 4; ++i) {
                sVt[(kc * 8 + 2 * i) * VSTR + li] = (bf16_t)(vv[i] & 0xffffu);
                sVt[(kc * 8 + 2 * i + 1) * VSTR + li] = (bf16_t)(vv[i] >> 16);
            }
        }
        __syncthreads();
        const int hq = kvh * 4 + wid;
        const float sink2 = p.sinks[hq] * LOG2E;
#pragma unroll 1
        for (int qt = 0; qt < 4; ++qt) {
            const size_t trow = (size_t)(b * SEQ + nb * 128 + qt * 32 + r32);
            bf16x8 qf[4];
#pragma unroll
            for (int ks = 0; ks < 4; ++ks) qf[ks] = *(const bf16x8*)(p.hb + trow * INW + hq * 64 + ks * 16 + hh * 8);
            f32x16 S[5];
#pragma unroll
            for (int j = 0; j < 5; ++j) {
#pragma unroll
                for (int r = 0; r < 16; ++r) S[j][r] = 0.f;
#pragma unroll
                for (int ks = 0; ks < 4; ++ks) {
                    const bf16x8 a = *(const bf16x8*)(sK + ((qt + j) * 32 + r32) * ASTR + ks * 16 + hh * 8);
                    S[j] = __builtin_amdgcn_mfma_f32_32x32x16_bf16(a, qf[ks], S[j], 0, 0, 0);
                }
            }
            float m2 = sink2;
#pragma unroll
            for (int j = 0; j < 5; ++j) {
                const bool tile_ok = (nb > 0) || (qt + j >= 4);
#pragma unroll
                for (int r = 0; r < 16; ++r) {
                    const int kl = (r & 3) + 8 * (r >> 2) + 4 * hh;
                    bool ok = tile_ok;
                    if (j == 0) ok = ok && (kl > r32);
                    if (j == 4) ok = ok && (kl <= r32);
                    const float t = ok ? S[j][r] * C1 : -1.0e30f;
                    S[j][r] = t;
                    m2 = fmaxf(m2, t);
                }
            }
            m2 = fmaxf(m2, __shfl_xor(m2, 32));
            float l = 0.f;
#pragma unroll
            for (int j = 0; j < 5; ++j)
#pragma unroll
                for (int r = 0; r < 16; ++r) { const float e = __builtin_amdgcn_exp2f(S[j][r] - m2); S[j][r] = e; l += e; }
            l += __shfl_xor(l, 32);
            l += __builtin_amdgcn_exp2f(sink2 - m2);
            f32x16 O[2];
#pragma unroll
            for (int dt = 0; dt < 2; ++dt)
#pragma unroll
                for (int r = 0; r < 16; ++r) O[dt][r] = 0.f;
#pragma unroll
            for (int j = 0; j < 5; ++j)
#pragma unroll
                for (int s2 = 0; s2 < 2; ++s2) {
                    u32x4 pw;
#pragma unroll
                    for (int k = 0; k < 4; ++k) pw[k] = pack2(S[j][8 * s2 + 2 * k], S[j][8 * s2 + 2 * k + 1]);
                    const bf16x8 pf = __builtin_bit_cast(bf16x8, pw);
                    const int kbase = (qt + j) * 32 + 16 * s2 + 4 * hh;
#pragma unroll
                    for (int dt = 0; dt < 2; ++dt) {
                        const bf16_t* vp = sVt + (dt * 32 + r32) * VSTR + kbase;
                        const u32x2 v0 = *(const u32x2*)(vp), v1 = *(const u32x2*)(vp + 8);
                        const u32x4 vw = {v0[0], v0[1], v1[0], v1[1]};
                        O[dt] = __builtin_amdgcn_mfma_f32_32x32x16_bf16(__builtin_bit_cast(bf16x8, vw), pf, O[dt], 0, 0, 0);
                    }
                }
            const float il = __builtin_amdgcn_rcpf(l);
#pragma unroll
            for (int dt = 0; dt < 2; ++dt)
#pragma unroll
                for (int g = 0; g < 4; ++g) {
                    u32x2 w;
                    w[0] = pack2(O[dt][4 * g] * il, O[dt][4 * g + 1] * il);
                    w[1] = pack2(O[dt][4 * g + 2] * il, O[dt][4 * g + 3] * il);
                    *(u32x2*)(p.mixb + trow * DM + hq * 64 + dt * 32 + 8 * g + 4 * hh) = w;
                }
        }
    }
}

#define CV_ROWS 62
__device__ void ph_conv(const Params& p, unsigned char* smem, const int vb) {
    bf16_t* gl = (bf16_t*)smem;
    float* red = (float*)(smem + CV_ROWS * 1024);
    const int tid = threadIdx.x, lane = tid & 63, wid = tid >> 6;
    const f32x2 lg = *(const f32x2*)(p.cln_g + 2 * tid), lb = *(const f32x2*)(p.cln_b + 2 * tid);
    for (int u = vb; u < T_TOK / 32; u += gridDim.x) {
        const int tok0 = u * 32, s0 = tok0 & (SEQ - 1);
        __syncthreads();
#pragma unroll 1
        for (int bt = 0; bt < 2; ++bt) {
            u32x4 av[8], gv[8];
#pragma unroll
            for (int it = 0; it < 8; ++it) {
                const int ch = tid + (bt * 8 + it) * 256, row = min(ch >> 6, CV_ROWS - 1), k = ch & 63;
                const int rr = (s0 - 30 + row >= 0) ? row : 30;
                const bf16_t* base = p.hb + (size_t)(tok0 - 30 + rr) * INW + k * 8;
                av[it] = *(const u32x4*)(base + 768); gv[it] = *(const u32x4*)(base + 1280);
            }
#pragma unroll
            for (int it = 0; it < 8; ++it) {
                const int ch = tid + (bt * 8 + it) * 256, row = ch >> 6, k = ch & 63;
                const bool ok = (s0 - 30 + row >= 0);
                u32x4 o;
#pragma unroll
                for (int q = 0; q < 4; ++q) {
                    const float g0 = sigmul(bflo(av[it][q]), bflo(gv[it][q])), g1 = sigmul(bfhi(av[it][q]), bfhi(gv[it][q]));
                    o[q] = ok ? pack2(g0, g1) : 0u;
                }
                if (row < CV_ROWS) *(u32x4*)(gl + row * 512 + k * 8) = o;
            }
        }
        __syncthreads();
        float w0[31], w1[31];
#pragma unroll
        for (int k = 0; k < 31; ++k) { const f32x2 wv = *(const f32x2*)(p.conv_w + k * 512 + 2 * tid); w0[k] = wv.x; w1[k] = wv.y; }
        const f32x2 bias = *(const f32x2*)(p.conv_b + 2 * tid);
#pragma unroll 1
        for (int jh = 0; jh < 2; ++jh) {
            float a0[16], a1[16];
#pragma unroll
            for (int jl = 0; jl < 16; ++jl) { a0[jl] = bias.x; a1[jl] = bias.y; }
            const bf16_t* gp = gl + (jh * 16) * 512 + 2 * tid;
#pragma unroll
            for (int il = 0; il < 46; ++il) {
                const unsigned gw = *(const unsigned*)(gp + il * 512);
                const float g0 = bflo(gw), g1 = bfhi(gw);
#pragma unroll
                for (int jl = 0; jl < 16; ++jl)
                    if (il - jl >= 0 && il - jl <= 30) { a0[jl] += w0[il - jl] * g0; a1[jl] += w1[il - jl] * g1; }
                if ((il & 3) == 3) __builtin_amdgcn_sched_barrier(0);
            }
            float v[32];
#pragma unroll
            for (int jl = 0; jl < 16; ++jl) { v[jl] = a0[jl] + a1[jl]; v[16 + jl] = a0[jl] * a0[jl] + a1[jl] * a1[jl]; }
#pragma unroll
            for (int st = 16; st >= 1; st >>= 1) {
                const bool up = (lane & st) != 0;
#pragma unroll
                for (int i2 = 0; i2 < st; ++i2) {
                    const float keep = up ? v[i2 + st] : v[i2], send = up ? v[i2] : v[i2 + st];
                    v[i2] = keep + __shfl_xor(send, st);
                }
            }
            const float tot = v[0] + __shfl_xor(v[0], 32);
            __syncthreads();
            if (lane < 32) red[wid * 32 + lane] = tot;
            __syncthreads();
#pragma unroll
            for (int jl = 0; jl < 16; ++jl) {
                const float sm = (red[jl] + red[32 + jl]) + (red[64 + jl] + red[96 + jl]);
                const float sq = (red[16 + jl] + red[48 + jl]) + (red[80 + jl] + red[112 + jl]);
                const float mu = sm * (1.0f / 512.0f);
                const float rstd = rsqrtf(fmaxf(sq * (1.0f / 512.0f) - mu * mu, 0.f) + LN_EPS);
                const float y0 = (a0[jl] - mu) * rstd * lg.x + lb.x, y1 = (a1[jl] - mu) * rstd * lg.y + lb.y;
                *(unsigned*)(p.mixb + (size_t)(tok0 + jh * 16 + jl) * DM + 512 + 2 * tid) = pack2(sigmul(y0, y0), sigmul(y1, y1));
            }
        }
    }
}

__device__ void ph_gemm_out(const Params& p, unsigned char* smem, const int vb) {
    const int ntn = DM / 256;
    const int tid = threadIdx.x, lane = tid & 63, wid = tid >> 6, wr = wid >> 1, wc = wid & 1, fr = lane & 15, fq = lane >> 4;
    for (int t = vb; t < (T_TOK / 128) * ntn; t += gridDim.x) {
        const int m0 = (t / ntn) * 128, n0 = (t % ntn) * 256;
        f32x4 acc[4][8]; zero_accw(acc);
        gemmW(p.mixb + (size_t)m0 * DM, DM, p.WoutT + (size_t)n0 * DM, DM, DM, smem, acc);
#pragma unroll
        for (int mi = 0; mi < 4; ++mi) {
            const int row = m0 + wr * 64 + mi * 16 + fr;
#pragma unroll
            for (int ni = 0; ni < 8; ++ni) {
                const int col = n0 + wc * 128 + ni * 16 + fq * 4;
                const f32x4 xv = *(const f32x4*)(p.x + (size_t)row * DM + col);
                *(f32x4*)(p.y1 + (size_t)row * DM + col) = xv * ALPHA + acc[mi][ni];
            }
        }
    }
}

__device__ __forceinline__ void ln_row(const float* __restrict__ src, const float* __restrict__ g, const float* __restrict__ bta,
                                       float* __restrict__ dstf, bf16_t* __restrict__ dstb, int lane) {
    f32x4 v[4]; float s = 0.f;
#pragma unroll
    for (int i = 0; i < 4; ++i) { v[i] = *(const f32x4*)(src + i * 256 + lane * 4); s += (v[i][0] + v[i][1]) + (v[i][2] + v[i][3]); }
    const float mu = wave_sum(s) * (1.0f / 1024.0f);
    float q = 0.f;
#pragma unroll
    for (int i = 0; i < 4; ++i) { const f32x4 d = v[i] - mu; q += (d[0] * d[0] + d[1] * d[1]) + (d[2] * d[2] + d[3] * d[3]); }
    const float rstd = rsqrtf(wave_sum(q) * (1.0f / 1024.0f) + LN_EPS);
#pragma unroll
    for (int i = 0; i < 4; ++i) {
        const f32x4 gg = *(const f32x4*)(g + i * 256 + lane * 4), bb = *(const f32x4*)(bta + i * 256 + lane * 4);
        const f32x4 y = (v[i] - mu) * rstd * gg + bb;
        if (dstf) *(f32x4*)(dstf + i * 256 + lane * 4) = y;
        if (dstb) { uint2 o; o.x = pack2(y[0], y[1]); o.y = pack2(y[2], y[3]); *(uint2*)(dstb + i * 256 + lane * 4) = o; }
    }
}
__device__ void ph_ln1(const Params& p, const int vb) {
    const int lane = threadIdx.x & 63, wid = threadIdx.x >> 6;
    for (int r = vb * 4 + wid; r < T_TOK; r += gridDim.x * 4)
        ln_row(p.y1 + (size_t)r * DM, p.ln1_g, p.ln1_b, (float*)nullptr, p.x1b + (size_t)r * DM, lane);
}
__device__ void ph_ln2(const Params& p, const int vb) {
    const int lane = threadIdx.x & 63, wid = threadIdx.x >> 6;
    for (int r = vb * 4 + wid; r < T_TOK; r += gridDim.x * 4)
        ln_row(p.out + (size_t)r * DM, p.ln2_g, p.ln2_b, p.out + (size_t)r * DM, (bf16_t*)nullptr, lane);
}

#define QSTR 136
__device__ __forceinline__ int f2key(float f) { const int b = __float_as_int(f); return b ^ ((b >> 31) & 0x7fffffff); }
__device__ __forceinline__ float key2f(int k) { return __int_as_float(k ^ ((k >> 31) & 0x7fffffff)); }
__device__ __forceinline__ void sort16_desc(int (&a)[16]) {
#pragma unroll
    for (int lk = 1; lk <= 4; ++lk) {
#pragma unroll
        for (int lj = lk - 1; lj >= 0; --lj) {
            const int k = 1 << lk, j = 1 << lj;
#pragma unroll
            for (int i = 0; i < 16; ++i) {
                const int l = i ^ j;
                if (l > i) {
                    const int hi = max(a[i], a[l]), lo = min(a[i], a[l]);
                    if ((i & k) == 0) { a[i] = hi; a[l] = lo; } else { a[i] = lo; a[l] = hi; }
                }
            }
        }
    }
}
__device__ __forceinline__ void merge_top16(int (&a)[16], const int (&b)[16]) {
#pragma unroll
    for (int i = 0; i < 16; ++i) a[i] = max(a[i], b[15 - i]);
#pragma unroll
    for (int lj = 3; lj >= 0; --lj) {
        const int j = 1 << lj;
#pragma unroll
        for (int i = 0; i < 16; ++i) {
            const int l = i ^ j;
            if (l > i) { const int hi = max(a[i], a[l]), lo = min(a[i], a[l]); a[i] = hi; a[l] = lo; }
        }
    }
}
__device__ __forceinline__ void top16_of_64(int (&v)[4][16]) {
    sort16_desc(v[0]); sort16_desc(v[1]); sort16_desc(v[2]); sort16_desc(v[3]);
    merge_top16(v[0], v[1]); merge_top16(v[0], v[2]); merge_top16(v[0], v[3]);
}

__device__ void ph_mprep(const Params& p, unsigned char* smem, const int vb) {
    const int tid = threadIdx.x, lane = tid & 63, wid = tid >> 6, wr = wid >> 1, wc = wid & 1, fr = lane & 15, fq = lane >> 4;
    for (int t = vb; t < 16 * 8; t += gridDim.x) {
        const int hp = t >> 3, d0 = (t & 7) * 128;
        f32x4 acc[4][4]; zero_acc(acc);
        gemm128(p.keysb + (size_t)hp * 128 * 128, 128, p.Wqb + (size_t)d0 * 2048 + hp * 128, 2048, 128, smem, acc);
#pragma unroll
        for (int mi = 0; mi < 4; ++mi)
#pragma unroll
            for (int ni = 0; ni < 4; ++ni) {
                uint2 o; o.x = pack2(acc[mi][ni][0], acc[mi][ni][1]); o.y = pack2(acc[mi][ni][2], acc[mi][ni][3]);
                *(uint2*)(p.MT + (size_t)(hp * 128 + wr * 64 + mi * 16 + fr) * DM + d0 + wc * 64 + ni * 16 + fq * 4) = o;
            }
    }
}

__device__ __forceinline__ void route_half(const Params& p, unsigned char* smem, int m0, int hp, int (&K)[16]) {
    LDS_AS unsigned char* lds = (LDS_AS unsigned char*)smem;
    const int tid = threadIdx.x, lane = tid & 63, wid = __builtin_amdgcn_readfirstlane(tid >> 6);
    const int r32 = lane & 31, hh = lane >> 5;
    const int prow = lane >> 3, pc = (lane & 7) ^ prow;
    const bf16_t* gA = p.x1b + (size_t)(m0 + wid * 32 + prow) * DM + pc * 8;
    const bf16_t* gB = p.MT + (size_t)(hp * 128 + wid * 32 + prow) * DM + pc * 8;
    const size_t r8 = (size_t)8 * DM;
#define RT_ISSUE(kt, st) do { \
        _Pragma("unroll") for (int _i = 0; _i < 4; ++_i) { \
            __builtin_amdgcn_global_load_lds((const unsigned*)(gA + _i * r8 + (size_t)(kt) * 64), (LDS_AS unsigned*)(lds + (st) * GEMM_STAGE + (wid * 4 + _i) * 1024), 16, 0, 0); \
            __builtin_amdgcn_global_load_lds((const unsigned*)(gB + _i * r8 + (size_t)(kt) * 64), (LDS_AS unsigned*)(lds + (st) * GEMM_STAGE + 16384 + (wid * 4 + _i) * 1024), 16, 0, 0); \
        } } while (0)
    f32x16 S[4];
#pragma unroll
    for (int mt = 0; mt < 4; ++mt)
#pragma unroll
        for (int r = 0; r < 16; ++r) S[mt][r] = 0.f;
    const int toff = (wid * 32 + r32) * 128, koff = 16384 + r32 * 128, x7 = r32 & 7;
    RT_ISSUE(0, 0);
#pragma unroll 1
    for (int kt = 0; kt < DM / 64; ++kt) {
        const int st = kt & 1;
        asm volatile("s_waitcnt vmcnt(0)" ::: "memory");
        __builtin_amdgcn_s_barrier();
        asm volatile("" ::: "memory");
        if (kt + 1 < DM / 64) RT_ISSUE(kt + 1, st ^ 1);
        const LDS_AS unsigned char* sb = lds + st * GEMM_STAGE;
        bf16x8 bq[4], aq[4][4];
#pragma unroll
        for (int k16 = 0; k16 < 4; ++k16) {
            const int sw = ((k16 * 2 + hh) ^ x7) * 16;
            bq[k16] = *(const LDS_AS bf16x8*)(sb + toff + sw);
#pragma unroll
            for (int mt = 0; mt < 4; ++mt) aq[k16][mt] = *(const LDS_AS bf16x8*)(sb + koff + mt * 4096 + sw);
        }
#pragma unroll
        for (int k16 = 0; k16 < 4; ++k16)
#pragma unroll
            for (int mt = 0; mt < 4; ++mt) S[mt] = __builtin_amdgcn_mfma_f32_32x32x16_bf16(aq[k16][mt], bq[k16], S[mt], 0, 0, 0);
        __builtin_amdgcn_sched_group_barrier(0x100, 5, 0);
#pragma unroll
        for (int q = 0; q < 15; ++q) { __builtin_amdgcn_sched_group_barrier(0x008, 1, 0); __builtin_amdgcn_sched_group_barrier(0x100, 1, 0); }
        __builtin_amdgcn_sched_group_barrier(0x008, 1, 0);
        asm volatile("s_waitcnt lgkmcnt(0)" ::: "memory");
        __builtin_amdgcn_s_barrier();
        asm volatile("" ::: "memory");
    }
#undef RT_ISSUE
    int v[4][16];
#pragma unroll
    for (int mt = 0; mt < 4; ++mt)
#pragma unroll
        for (int r = 0; r < 16; ++r) {
            const int n = mt * 32 + (r & 3) + 8 * (r >> 2) + 4 * hh;
            v[mt][r] = (f2key(S[mt][r]) & ~0x7F) | (127 - n);
        }
    top16_of_64(v);
    int o[16];
#pragma unroll
    for (int i = 0; i < 16; ++i) o[i] = __shfl_xor(v[0][i], 32);
    merge_top16(v[0], o);
#pragma unroll
    for (int i = 0; i < 16; ++i) K[i] = v[0][i];
}

__device__ __forceinline__ void route_topk(const f32x16 (&S)[8], int pp, int hh, int (&K)[16]) {
    int v[4][16];
#pragma unroll
    for (int mt = 0; mt < 4; ++mt)
#pragma unroll
        for (int r = 0; r < 16; ++r) {
            const int n = mt * 32 + (r & 3) + 8 * (r >> 2) + 4 * hh;
            v[mt][r] = (f2key(S[pp * 4 + mt][r]) & ~0x7F) | (127 - n);
        }
    top16_of_64(v);
    int o[16];
#pragma unroll
    for (int i = 0; i < 16; ++i) o[i] = __shfl_xor(v[0][i], 32);
    merge_top16(v[0], o);
#pragma unroll
    for (int i = 0; i < 16; ++i) K[i] = v[0][i];
}
__device__ __forceinline__ void route_head(const Params& p, unsigned char* smem, int m0, int h, int (&K0)[16], int (&K1)[16]) {
    LDS_AS unsigned char* lds = (LDS_AS unsigned char*)smem;
    const int tid = threadIdx.x, lane = tid & 63, wid = __builtin_amdgcn_readfirstlane(tid >> 6);
    const int r32 = lane & 31, hh = lane >> 5;
    const int prow = lane >> 2, pc = (lane & 3) ^ ((4 - ((prow >> 2) & 3)) & 3);
    const bf16_t* gA = p.x1b + (size_t)(m0 + wid * 32 + prow) * DM + pc * 8;
    const bf16_t* gB = p.MT + (size_t)(h * 256 + wid * 64 + prow) * DM + pc * 8;
    const size_t r16 = (size_t)16 * DM;
#define RH_ISSUE(kt, st) do { \
        _Pragma("unroll") for (int _i = 0; _i < 2; ++_i) \
            __builtin_amdgcn_global_load_lds((const unsigned*)(gA + _i * r16 + (size_t)(kt) * 32), (LDS_AS unsigned*)(lds + (st) * GW_STAGE + (wid * 2 + _i) * 1024), 16, 0, 0); \
        _Pragma("unroll") for (int _i = 0; _i < 4; ++_i) \
            __builtin_amdgcn_global_load_lds((const unsigned*)(gB + _i * r16 + (size_t)(kt) * 32), (LDS_AS unsigned*)(lds + (st) * GW_STAGE + 8192 + (wid * 4 + _i) * 1024), 16, 0, 0); \
        } while (0)
    f32x16 S[8];
#pragma unroll
    for (int mt = 0; mt < 8; ++mt)
#pragma unroll
        for (int r = 0; r < 16; ++r) S[mt][r] = 0.f;
    const int fx = (4 - ((r32 >> 2) & 3)) & 3;
    const int toff = (wid * 32 + r32) * 64, koff = 8192 + r32 * 64;
    RH_ISSUE(0, 0);
#pragma unroll 1
    for (int kt = 0; kt < DM / 32; ++kt) {
        const int st = kt & 1;
        asm volatile("s_waitcnt vmcnt(0)" ::: "memory");
        __builtin_amdgcn_s_barrier();
        asm volatile("" ::: "memory");
        if (kt + 1 < DM / 32) RH_ISSUE(kt + 1, st ^ 1);
        const LDS_AS unsigned char* sb = lds + st * GW_STAGE;
#pragma unroll
        for (int k16 = 0; k16 < 2; ++k16) {
            const int sw = ((k16 * 2 + hh) ^ fx) * 16;
            const bf16x8 b = *(const LDS_AS bf16x8*)(sb + toff + sw);
#pragma unroll
            for (int mt = 0; mt < 8; ++mt) {
                const bf16x8 a = *(const LDS_AS bf16x8*)(sb + koff + mt * 2048 + sw);
                S[mt] = __builtin_amdgcn_mfma_f32_32x32x16_bf16(a, b, S[mt], 0, 0, 0);
            }
        }
        asm volatile("s_waitcnt lgkmcnt(0)" ::: "memory");
        __builtin_amdgcn_s_barrier();
        asm volatile("" ::: "memory");
    }
#undef RH_ISSUE
    route_topk(S, 0, hh, K0);
    route_topk(S, 1, hh, K1);
}

__device__ void ph_route(const Params& p, unsigned char* smem, const int vb) {
    const int tid = threadIdx.x, lane = tid & 63, wid = tid >> 6;
    const int r32 = lane & 31, hh = lane >> 5;
    const int hmask = -hh;
    int* KL = (int*)(smem + (size_t)wid * 32 * QSTR * 2);
    for (int u = vb; u < (T_TOK / 128) * 8; u += gridDim.x) {
        const int m0 = (u >> 3) * 128, h = u & 7;
        __syncthreads();
        int K0[16], K1[16];
        route_head(p, smem, m0, h, K0, K1);
#pragma unroll
        for (int i = 0; i < 16; ++i) KL[r32 * 33 + hh * 16 + i] = K0[i] ^ ((K0[i] ^ K1[i]) & hmask);
        float s1[16], s2[16];
#pragma unroll
        for (int i = 0; i < 16; ++i) { s1[i] = key2f(K0[i] & ~0x7F); s2[i] = key2f(K1[i] & ~0x7F); }
        int c[4][16];
#pragma unroll
        for (int i = 0; i < 16; ++i)
#pragma unroll
            for (int j = 0; j < 16; ++j)
                if ((i + 1) * (j + 1) <= 16) {
                    constexpr int OFFS[16] = {0, 16, 24, 29, 33, 36, 38, 40, 42, 43, 44, 45, 46, 47, 48, 49};
                    const int q = OFFS[i] + j;
                    c[q >> 4][q & 15] = (f2key(s1[i] + s2[j]) & ~0xFF) | (255 - (i * 16 + j));
                }
#pragma unroll
        for (int qq = 50; qq < 64; ++qq) c[qq >> 4][qq & 15] = (int)0x80000000;
        top16_of_64(c);
        const float mx = key2f(c[0][0] & ~0xFF);
        float e[16]; float den = 0.f;
#pragma unroll
        for (int i = 0; i < 16; ++i) { e[i] = __expf(key2f(c[0][i] & ~0xFF) - mx); den += e[i]; }
        const float inv = __builtin_amdgcn_rcpf(den);
        const size_t ob = (size_t)(m0 + wid * 32 + r32) * 128 + h * 16 + hh * 8;
        int idv[8]; float gv[8];
#pragma unroll
        for (int qq = 0; qq < 8; ++qq) {
            const int F = c[0][qq] ^ ((c[0][qq] ^ c[0][8 + qq]) & hmask);
            gv[qq] = __int_as_float(__float_as_int(e[qq]) ^ ((__float_as_int(e[qq]) ^ __float_as_int(e[8 + qq])) & hmask)) * inv;
            const int idx = 255 - (F & 0xFF);
            const int k0 = KL[r32 * 33 + (idx >> 4)], k1 = KL[r32 * 33 + 16 + (idx & 15)];
            idv[qq] = (127 - (k0 & 0x7F)) * 128 + (127 - (k1 & 0x7F));
        }
        *(int4*)(p.ids + ob) = make_int4(idv[0], idv[1], idv[2], idv[3]);
        *(int4*)(p.ids + ob + 4) = make_int4(idv[4], idv[5], idv[6], idv[7]);
        *(float4*)(p.gates + ob) = make_float4(gv[0], gv[1], gv[2], gv[3]);
        *(float4*)(p.gates + ob + 4) = make_float4(gv[4], gv[5], gv[6], gv[7]);
    }
}

__device__ __forceinline__ f32x2 row_dot(const u32x4 w, const f32x2 (&x)[8], f32x2 acc) {
#pragma unroll
    for (int k = 0; k < 4; ++k) {
        acc = __builtin_amdgcn_cvt_pk_f32_fp8(w[k], false) * x[2 * k] + acc;
        acc = __builtin_amdgcn_cvt_pk_f32_fp8(w[k], true) * x[2 * k + 1] + acc;
    }
    return acc;
}
__device__ __forceinline__ float gelu_gate(float h, float g) { return 0.5f * h * (1.0f + erff(h * 0.70710678118654752f)) * g; }

__device__ __forceinline__ void ld_ids16(const int* __restrict__ q, int (&idv)[16]) {
    const int4* idp = (const int4*)q;
#pragma unroll
    for (int k = 0; k < 4; ++k) { const int4 v = idp[k]; idv[4 * k] = v.x; idv[4 * k + 1] = v.y; idv[4 * k + 2] = v.z; idv[4 * k + 3] = v.w; }
}
__device__ __forceinline__ void ld_f16(const float* __restrict__ q, float (&a)[16]) {
    const f32x4* ap = (const f32x4*)q;
#pragma unroll
    for (int k = 0; k < 4; ++k) { const f32x4 v = ap[k]; a[4 * k] = v[0]; a[4 * k + 1] = v[1]; a[4 * k + 2] = v[2]; a[4 * k + 3] = v[3]; }
}
__device__ void ph_peer_u(const Params& p, unsigned char* smem, const int vb) {
    const int lane = threadIdx.x & 63, wid = __builtin_amdgcn_readfirstlane(threadIdx.x >> 6), g = lane >> 3, c = lane & 7;
    const int nlb = gridDim.x >> 3, s = vb / nlb, lb = vb - s * nlb;
    const bool b2 = (lane & 4) != 0, b1 = (lane & 2) != 0, b0 = (lane & 1) != 0;
    const int cc = (b0 ? 2 : 0) + (b1 ? 4 : 0) + (b2 ? 8 : 0);
    const unsigned char* ubase = p.u8 + (size_t)s * (16384 * 128) + c * 16;
    const int stride = nlb * 4, t0 = lb * 4 + wid;
    const int ntok = (T_TOK - t0 + stride - 1) / stride;
    if (ntok <= 0) return;
    LDS_AS unsigned char* ring = (LDS_AS unsigned char*)smem + wid * 2048;
    const int* idg = p.ids + 2 * lane;
    const bf16_t* xg = p.x1b + s * 128 + 2 * lane;
#define PU_TOK(n) (t0 + ((n) < ntok ? (n) : ntok - 1) * stride)
#define PU_RAW_LD(n, ri, rx) do { const int _t = PU_TOK(n); ri = *(const u32x2*)(idg + (size_t)_t * 128); const unsigned _w = *(const unsigned*)(xg + (size_t)_t * DM); rx = (u32x2){_w << 16, _w & 0xffff0000u}; } while (0)
#define PU_RAW_ST(n, ri, rx) do { LDS_AS unsigned char* _b = ring + ((n) & 1) * 1024; *(LDS_AS u32x2*)(_b + lane * 8) = ri; *(LDS_AS u32x2*)(_b + 512 + lane * 8) = rx; } while (0)
#define PU_IDS(n, idv) do { const LDS_AS u32x4* _q = (const LDS_AS u32x4*)(ring + ((n) & 1) * 1024 + g * 64); \
        _Pragma("unroll") for (int _k = 0; _k < 4; ++_k) { const u32x4 _v = _q[_k]; idv[4 * _k] = (int)_v[0]; idv[4 * _k + 1] = (int)_v[1]; idv[4 * _k + 2] = (int)_v[2]; idv[4 * _k + 3] = (int)_v[3]; } } while (0)
    u32x4 wA[8], wB[8]; u32x2 ri, rx;
    {
        u32x2 i0, x0, i1, x1v;
        PU_RAW_LD(0, i0, x0); PU_RAW_LD(1, i1, x1v); PU_RAW_LD(2, ri, rx);
        PU_RAW_ST(0, i0, x0); PU_RAW_ST(1, i1, x1v);
        int id0[16]; PU_IDS(0, id0);
#pragma unroll
        for (int i = 0; i < 8; ++i) wA[i] = *(const u32x4*)(ubase + (size_t)id0[i] * 128);
#pragma unroll
        for (int i = 0; i < 8; ++i) wB[i] = *(const u32x4*)(ubase + (size_t)id0[8 + i] * 128);
    }
#pragma unroll 1
    for (int n = 0; n < ntok; ++n) {
        const int t = t0 + n * stride;
        f32x2 x[8];
        {
            const LDS_AS f32x4* q = (const LDS_AS f32x4*)(ring + (n & 1) * 1024 + 512 + c * 64);
#pragma unroll
            for (int k = 0; k < 4; ++k) { const f32x4 v4 = q[k]; x[2 * k] = (f32x2){v4[0], v4[1]}; x[2 * k + 1] = (f32x2){v4[2], v4[3]}; }
        }
        int idn[16]; PU_IDS(n + 1, idn);
        float v[16];
#pragma unroll
        for (int i = 0; i < 8; ++i) { const f32x2 a = row_dot(wA[i], x, (f32x2){0.f, 0.f}); v[i] = a.x + a.y; }
#pragma unroll
        for (int i = 0; i < 8; ++i) wA[i] = *(const u32x4*)(ubase + (size_t)idn[i] * 128);
#pragma unroll
        for (int i = 0; i < 8; ++i) { const f32x2 a = row_dot(wB[i], x, (f32x2){0.f, 0.f}); v[8 + i] = a.x + a.y; }
#pragma unroll
        for (int i = 0; i < 8; ++i) wB[i] = *(const u32x4*)(ubase + (size_t)idn[8 + i] * 128);
        PU_RAW_ST(n + 2, ri, rx);
        PU_RAW_LD(n + 3, ri, rx);
#pragma unroll
        for (int i = 0; i < 8; ++i) { const float keep = b2 ? v[i + 8] : v[i], send = b2 ? v[i] : v[i + 8]; v[i] = keep + __shfl_xor(send, 4); }
#pragma unroll
        for (int i = 0; i < 4; ++i) { const float keep = b1 ? v[i + 4] : v[i], send = b1 ? v[i] : v[i + 4]; v[i] = keep + __shfl_xor(send, 2); }
#pragma unroll
        for (int i = 0; i < 2; ++i) { const float keep = b0 ? v[i + 2] : v[i], send = b0 ? v[i] : v[i + 2]; v[i] = keep + __shfl_xor(send, 1); }
        *(unsigned*)(p.hp + ((size_t)t * 8 + s) * 128 + g * 16 + cc) = pack2(v[0], v[1]);
    }
}
__device__ void ph_peer_act(const Params& p, const int vb) {
    const int lane = threadIdx.x & 63, wid = threadIdx.x >> 6;
    for (int t = vb * 4 + wid; t < T_TOK; t += gridDim.x * 4) {
        f32x2 h = {0.f, 0.f};
#pragma unroll
        for (int s = 0; s < 8; ++s) { const unsigned w = *(const unsigned*)(p.hp + ((size_t)t * 8 + s) * 128 + 2 * lane); h += (f32x2){bflo(w), bfhi(w)}; }
        const int2 id = *(const int2*)(p.ids + (size_t)t * 128 + 2 * lane);
        const f32x2 gt = *(const f32x2*)(p.gates + (size_t)t * 128 + 2 * lane);
        f32x2 a;
        a.x = gelu_gate(h.x * p.su[id.x], gt.x) * p.sv[id.x];
        a.y = gelu_gate(h.y * p.su[id.y], gt.y) * p.sv[id.y];
        *(f32x2*)(p.gates + (size_t)t * 128 + 2 * lane) = a;
    }
}
__device__ void ph_peer_v(const Params& p, unsigned char* smem, const int vb) {
    const int lane = threadIdx.x & 63, wid = __builtin_amdgcn_readfirstlane(threadIdx.x >> 6), g = lane >> 3, c = lane & 7;
    const int nlb = gridDim.x >> 3, s = vb / nlb, lb = vb - s * nlb;
    const bool b4 = (lane & 16) != 0, b3 = (lane & 8) != 0;
    const unsigned char* vbase = p.v8 + (size_t)s * (16384 * 128) + c * 16;
    const int stride = nlb * 4, t0 = lb * 4 + wid;
    const int ntok = (T_TOK - t0 + stride - 1) / stride;
    if (ntok <= 0) return;
    const int d0 = s * 128 + c * 16 + 2 * g;
    LDS_AS unsigned char* ring = (LDS_AS unsigned char*)smem + wid * 2048;
    const int* idg = p.ids + 2 * lane;
    const float* ag = p.gates + 2 * lane;
#define PV_RAW_LD(n, ri, rx) do { const int _t = PU_TOK(n); ri = *(const u32x2*)(idg + (size_t)_t * 128); rx = *(const u32x2*)(ag + (size_t)_t * 128); } while (0)
    u32x4 wA[8], wB[8]; u32x2 ri, rx;
    {
        u32x2 i0, x0, i1, x1v;
        PV_RAW_LD(0, i0, x0); PV_RAW_LD(1, i1, x1v); PV_RAW_LD(2, ri, rx);
        PU_RAW_ST(0, i0, x0); PU_RAW_ST(1, i1, x1v);
        int id0[16]; PU_IDS(0, id0);
#pragma unroll
        for (int i = 0; i < 8; ++i) wA[i] = *(const u32x4*)(vbase + (size_t)id0[i] * 128);
#pragma unroll
        for (int i = 0; i < 8; ++i) wB[i] = *(const u32x4*)(vbase + (size_t)id0[8 + i] * 128);
    }
#pragma unroll 1
    for (int n = 0; n < ntok; ++n) {
        const int t = t0 + n * stride;
        const unsigned xw = *(const unsigned*)(p.x1b + (size_t)t * DM + d0);
        const f32x2 xv = {bflo(xw), bfhi(xw)};
        float ac[16];
        {
            const LDS_AS f32x4* q = (const LDS_AS f32x4*)(ring + (n & 1) * 1024 + 512 + g * 64);
#pragma unroll
            for (int k = 0; k < 4; ++k) { const f32x4 v4 = q[k]; ac[4 * k] = v4[0]; ac[4 * k + 1] = v4[1]; ac[4 * k + 2] = v4[2]; ac[4 * k + 3] = v4[3]; }
        }
        int idn[16]; PU_IDS(n + 1, idn);
        f32x2 acc[8];
#pragma unroll
        for (int k = 0; k < 8; ++k) acc[k] = (f32x2){0.f, 0.f};
#pragma unroll
        for (int i = 0; i < 8; ++i) {
            const f32x2 a2 = {ac[i], ac[i]};
#pragma unroll
            for (int k = 0; k < 4; ++k) {
                acc[2 * k] = __builtin_amdgcn_cvt_pk_f32_fp8(wA[i][k], false) * a2 + acc[2 * k];
                acc[2 * k + 1] = __builtin_amdgcn_cvt_pk_f32_fp8(wA[i][k], true) * a2 + acc[2 * k + 1];
            }
        }
#pragma unroll
        for (int i = 0; i < 8; ++i) wA[i] = *(const u32x4*)(vbase + (size_t)idn[i] * 128);
#pragma unroll
        for (int i = 0; i < 8; ++i) {
            const f32x2 a2 = {ac[8 + i], ac[8 + i]};
#pragma unroll
            for (int k = 0; k < 4; ++k) {
                acc[2 * k] = __builtin_amdgcn_cvt_pk_f32_fp8(wB[i][k], false) * a2 + acc[2 * k];
                acc[2 * k + 1] = __builtin_amdgcn_cvt_pk_f32_fp8(wB[i][k], true) * a2 + acc[2 * k + 1];
            }
        }
#pragma unroll
        for (int i = 0; i < 8; ++i) wB[i] = *(const u32x4*)(vbase + (size_t)idn[8 + i] * 128);
        PU_RAW_ST(n + 2, ri, rx);
        PV_RAW_LD(n + 3, ri, rx);
        float v[16];
#pragma unroll
        for (int k = 0; k < 8; ++k) { v[2 * k] = acc[k].x; v[2 * k + 1] = acc[k].y; }
#pragma unroll
        for (int j2 = 0; j2 < 8; ++j2) {
            auto r = __builtin_amdgcn_permlane32_swap(__float_as_uint(v[j2]), __float_as_uint(v[j2 + 8]), false, false);
            v[j2] = __uint_as_float(r[0]) + __uint_as_float(r[1]);
        }
#pragma unroll
        for (int j2 = 0; j2 < 4; ++j2) { const float keep = b4 ? v[j2 + 4] : v[j2], send = b4 ? v[j2] : v[j2 + 4]; v[j2] = keep + __shfl_xor(send, 16); }
#pragma unroll
        for (int j2 = 0; j2 < 2; ++j2) { const float keep = b3 ? v[j2 + 2] : v[j2], send = b3 ? v[j2] : v[j2 + 2]; v[j2] = keep + __shfl_xor(send, 8); }
        const float r0 = ALPHA * xv.x + v[0], r1 = ALPHA * xv.y + v[1];
        *(unsigned*)(p.rb + (size_t)t * DM + d0) = pack2(r0, r1);
    }
}

__device__ void ph_gemm_ple(const Params& p, unsigned char* smem, const int vb) {
    const int ntn = DM / 128;
    const int tid = threadIdx.x, lane = tid & 63, wid = tid >> 6, wr = wid >> 1, wc = wid & 1, fr = lane & 15, fq = lane >> 4;
    for (int t = vb; t < (T_TOK / 128) * ntn; t += gridDim.x) {
        const int m0 = (t / ntn) * 128, n0 = (t % ntn) * 128;
        f32x4 acc[4][4], acc2[4][4]; zero_acc(acc); zero_acc(acc2);
        gemm128(p.pb + (size_t)m0 * 256, 256, p.WpT + (size_t)n0 * 256, 256, 256, smem, acc2);
        gemm128(p.rb + (size_t)m0 * DM, DM, p.WgT + (size_t)n0 * DM, DM, DM, smem, acc);
#pragma unroll
        for (int mi = 0; mi < 4; ++mi) {
            const int row = m0 + wr * 64 + mi * 16 + fr;
#pragma unroll
            for (int ni = 0; ni < 4; ++ni) {
                const int col = n0 + wc * 64 + ni * 16 + fq * 4;
                const u32x2 rw = *(const u32x2*)(p.rb + (size_t)row * DM + col);
                f32x4 rv = {bflo(rw[0]), bfhi(rw[0]), bflo(rw[1]), bfhi(rw[1])};
#pragma unroll
                for (int r = 0; r < 4; ++r) rv[r] += sigmul(acc2[mi][ni][r], acc[mi][ni][r]);
                *(f32x4*)(p.out + (size_t)row * DM + col) = rv;
            }
        }
    }
}

#define XB_TMO      128
#define XB_XCNT(j)  (256  + 64 * (j))
#define XB_XSUB(j)  (1280 + 64 * (j))
#define XB_XGEN(j)  (2304 + 64 * (j))
#define XB_TOP      3328
#define XB_TOPGEN   3392
#define XCD_BAR_WORDS 3456
#define XB_SPIN_CAP (1u << 20)
__device__ __forceinline__ unsigned xb_ld(unsigned* p)              { return __hip_atomic_load(p, __ATOMIC_RELAXED, __HIP_MEMORY_SCOPE_AGENT); }
__device__ __forceinline__ unsigned xb_add(unsigned* p, unsigned v) { return __hip_atomic_fetch_add(p, v, __ATOMIC_RELAXED, __HIP_MEMORY_SCOPE_AGENT); }
__device__ __forceinline__ unsigned xb_xcc_id() { return (unsigned)__builtin_amdgcn_s_getreg((3 << 11) | 20) & 0xFu; }
#define XB_SPIN(cond, bar) do { unsigned _sp = 0; while (cond) { __builtin_amdgcn_s_sleep(1); \
    if ((++_sp & 255u) == 0u) { if (xb_ld(&(bar)[XB_TMO])) break; if (_sp > XB_SPIN_CAP) { atomicAdd(&(bar)[XB_TMO], 1u); break; } } } } while (0)
struct XcdBarrier { unsigned* bar; unsigned x; volatile LDS_AS unsigned* st; };
__device__ __forceinline__ XcdBarrier xcd_barrier_post(unsigned* bar, volatile LDS_AS unsigned* st) {
    XcdBarrier b; b.bar = bar; b.x = xb_xcc_id(); b.st = st;
    if (threadIdx.x == 0) st[3] = xb_add(&bar[XB_XCNT(b.x)], 1u);
    return b;
}
__device__ __forceinline__ void xcd_barrier_complete(unsigned* bar, unsigned x, unsigned rank, unsigned& nloc, unsigned& nx, unsigned& vb) {
    const unsigned G = gridDim.x;
    unsigned sum, cnt, mine, sp = 0u; bool even;
    for (;;) {
        sum = 0u; cnt = 0u; mine = 0u; even = true;
#pragma unroll
        for (unsigned j = 0; j < 16; ++j) {
            const unsigned c = xb_ld(&bar[XB_XCNT(j)]); sum += c; cnt += (c > 0u) ? 1u : 0u; mine = (j == x) ? c : mine;
            even = even && (c == ((j < 8u) ? (G >> 3) : 0u));
        }
        if (sum == G) break;
        __builtin_amdgcn_s_sleep(1);
        if ((++sp & 255u) == 0u) { if (xb_ld(&bar[XB_TMO])) break; if (sp > XB_SPIN_CAP) { atomicAdd(&bar[XB_TMO], 1u); break; } }
    }
    nloc = mine > 0u ? mine : 1u; nx = cnt > 0u ? cnt : 1u;
    vb = (even && sum == G && (G & 7u) == 0u) ? (x * (G >> 3) + rank) : blockIdx.x;
}
__device__ __forceinline__ void xcd_barrier(const XcdBarrier& b) {
    asm volatile("s_waitcnt vmcnt(0)" ::: "memory");
    __syncthreads();
    if (threadIdx.x == 0) {
        unsigned* bar = b.bar;
        __builtin_amdgcn_s_waitcnt(0);
        unsigned nloc = b.st[0], nx = b.st[1];
        if (nloc == 0u) { unsigned vb; xcd_barrier_complete(bar, b.x, b.st[3], nloc, nx, vb); b.st[0] = nloc; b.st[1] = nx; b.st[2] = vb; }
        const unsigned old = xb_add(&bar[XB_XSUB(b.x)], 1u);
        const unsigned gen = old / nloc;
        if (old + 1u == (gen + 1u) * nloc) {
            __builtin_amdgcn_fence(__ATOMIC_RELEASE, "agent");
            asm volatile("s_waitcnt vmcnt(0)" ::: "memory");
            const unsigned og = xb_add(&bar[XB_TOP], 1u);
            const unsigned tg = og / nx;
            if (og + 1u == (tg + 1u) * nx) xb_add(&bar[XB_TOPGEN], 1u);
            else XB_SPIN(xb_ld(&bar[XB_TOPGEN]) == tg, bar);
            __builtin_amdgcn_fence(__ATOMIC_ACQUIRE, "agent");
            xb_add(&bar[XB_XGEN(b.x)], 1u);
            asm volatile("s_waitcnt vmcnt(0)" ::: "memory");
        } else {
            XB_SPIN(xb_ld(&bar[XB_XGEN(b.x)]) == gen, bar);
            __builtin_amdgcn_fence(__ATOMIC_ACQUIRE, "agent");
            asm volatile("s_waitcnt vmcnt(0)" ::: "memory");
        }
    }
    __syncthreads();
}

#define SMEM_PHASE (256 * ASTR * 2 * 2)
#define SMEM_BYTES (SMEM_PHASE + 16)
__global__ void __launch_bounds__(256, 2) mega(Params p) {
    __shared__ __attribute__((aligned(16))) unsigned char smem[SMEM_BYTES];
    volatile LDS_AS unsigned* st = (volatile LDS_AS unsigned*)(LDS_AS unsigned char*)(smem + SMEM_PHASE);
    if (threadIdx.x < 4) st[threadIdx.x] = 0u;
    __syncthreads();
    const XcdBarrier gb = xcd_barrier_post(p.bar, st);
    ph_prep(p, smem);            xcd_barrier(gb);
    const int vb = (int)st[2];
    ph_gemm_in(p, smem, vb);     xcd_barrier(gb);
    ph_attn(p, smem, vb);
    ph_conv(p, smem, vb);        xcd_barrier(gb);
    ph_gemm_out(p, smem, vb);    xcd_barrier(gb);
    ph_mprep(p, smem, vb);
    ph_ln1(p, vb);               xcd_barrier(gb);
    ph_route(p, smem, vb);       xcd_barrier(gb);
    ph_peer_u(p, smem, vb);      xcd_barrier(gb);
    ph_peer_act(p, vb);          xcd_barrier(gb);
    ph_peer_v(p, smem, vb);      xcd_barrier(gb);
    ph_gemm_ple(p, smem, vb);    xcd_barrier(gb);
    ph_ln2(p, vb);
}

extern "C" void kernel_launch(void* const* d_in, const int* in_sizes, int n_in, void* d_out, int out_size, void* d_ws, size_t ws_size,
                              hipStream_t stream) {
    Params p{};
    p.x = (const float*)d_in[0]; p.p = (const float*)d_in[1]; p.pos = (const int*)d_in[2];
    p.w_in = (const float*)d_in[3]; p.sinks = (const float*)d_in[4]; p.conv_w = (const float*)d_in[5]; p.conv_b = (const float*)d_in[6];
    p.cln_g = (const float*)d_in[7]; p.cln_b = (const float*)d_in[8]; p.w_out = (const float*)d_in[9]; p.ln1_g = (const float*)d_in[10];
    p.ln1_b = (const float*)d_in[11]; p.wq = (const float*)d_in[12]; p.keys = (const float*)d_in[13]; p.pu = (const float*)d_in[14];
    p.pv = (const float*)d_in[15]; p.ple_proj = (const float*)d_in[16]; p.ple_gate = (const float*)d_in[17]; p.ln2_g = (const float*)d_in[18];
    p.ln2_b = (const float*)d_in[19];
    p.out = (float*)d_out;
    unsigned char* ws = (unsigned char*)d_ws;
    const size_t MiB = 1024 * 1024;
    p.y1 = (float*)(ws + 0 * MiB);
    p.hb = (bf16_t*)(ws + 128 * MiB);
    p.hp = (bf16_t*)(ws + 128 * MiB);
    p.xb = (bf16_t*)(ws + 256 * MiB);
    p.x1b = (bf16_t*)(ws + 256 * MiB);
    p.mixb = (bf16_t*)(ws + 320 * MiB);
    p.rb = (bf16_t*)(ws + 320 * MiB);
    p.pb = (bf16_t*)(ws + 384 * MiB);
    p.u8 = (unsigned char*)(ws + 400 * MiB);
    p.v8 = (unsigned char*)(ws + 416 * MiB);
    p.su = (float*)(ws + 432 * MiB);
    p.sv = (float*)(ws + 433 * MiB);
    p.ids = (int*)(ws + 464 * MiB);
    p.gates = (float*)(ws + 480 * MiB);
    unsigned char* wb = ws + 496 * MiB;
    p.WinT = (bf16_t*)wb; wb += (size_t)INW * DM * 2;
    p.WoutT = (bf16_t*)wb; wb += (size_t)DM * DM * 2;
    p.WgT = (bf16_t*)wb; wb += (size_t)DM * DM * 2;
    p.WpT = (bf16_t*)wb; wb += (size_t)DM * 256 * 2;
    p.keysb = (bf16_t*)wb; wb += (size_t)16 * 128 * 128 * 2;
    p.Wqb = (bf16_t*)(ws + 240 * MiB);
    p.MT = (bf16_t*)(ws + 244 * MiB);
    p.bar = (unsigned*)(ws + 510 * MiB);

    static int grid_blocks = 0;
    if (!grid_blocks) {
        int dev = 0, cus = 0, per_cu = 0;
        (void)hipGetDevice(&dev);
        (void)hipDeviceGetAttribute(&cus, hipDeviceAttributeMultiprocessorCount, dev);
        (void)hipOccupancyMaxActiveBlocksPerMultiprocessor(&per_cu, mega, 256, 0);
        if (per_cu > 2) per_cu = 2;
        grid_blocks = cus * per_cu;
    }
    (void)hipMemsetAsync(p.bar, 0, XCD_BAR_WORDS * sizeof(unsigned), stream);
    void* args[] = {&p};
    hipError_t e = hipLaunchCooperativeKernel((void*)mega, dim3(grid_blocks), dim3(256), args, 0, stream);
    if (e != hipSuccess) fprintf(stderr, "cooperative launch failed: %s (grid %d)\n", hipGetErrorString(e), grid_blocks);
}
```

```cpp
#include <hip/hip_runtime.h>
#include <stdint.h>
#include <cstdio>

typedef unsigned short bf16_t;
typedef short bf16x8 __attribute__((ext_vector_type(8)));
typedef float f32x4 __attribute__((ext_vector_type(4)));
typedef unsigned u32x4 __attribute__((ext_vector_type(4)));
typedef float f32x2 __attribute__((ext_vector_type(2)));

#define T_TOK 32768
#define SEQ 2048
#define DM 1024
#define INW 1792
#define ALPHA 1.189207115002721f
#define LN_EPS 1e-5f

__device__ __forceinline__ bf16_t f2bf(float f) {
    unsigned u = __float_as_uint(f);
    u += 0x7fffu + ((u >> 16) & 1u);
    return (bf16_t)(u >> 16);
}
__device__ __forceinline__ float bf2f(bf16_t b) { return __uint_as_float(((unsigned)b) << 16); }
__device__ __forceinline__ float bflo(unsigned w) { return __uint_as_float(w << 16); }
__device__ __forceinline__ float bfhi(unsigned w) { return __uint_as_float(w & 0xffff0000u); }
__device__ __forceinline__ unsigned pack2(float a, float b) { return (unsigned)f2bf(a) | ((unsigned)f2bf(b) << 16); }

__device__ __forceinline__ float sigmul(float x, float g) { return x * __builtin_amdgcn_rcpf(1.0f + __expf(-g)); }
__device__ __forceinline__ float wave_sum(float v) {
#pragma unroll
    for (int o = 32; o >= 1; o >>= 1) v += __shfl_xor(v, o);
    return v;
}

struct Params {
    const float *x, *p; const int* pos;
    const float *w_in, *sinks, *conv_w, *conv_b, *cln_g, *cln_b, *w_out, *ln1_g, *ln1_b;
    const float *wq, *keys, *pu, *pv, *ple_proj, *ple_gate, *ln2_g, *ln2_b;
    float* out;
    bf16_t *xb, *pb, *WinT, *WoutT, *WgT, *WpT, *keysb, *Wqb, *MT, *hb, *mixb, *x1b, *rb;
    float *y1, *gates, *su, *sv;
    bf16_t* hp;
    int *ids;
    unsigned char *u8, *v8;
    unsigned* bar;
};

__device__ void cvt_rows(const float* __restrict__ src, bf16_t* __restrict__ dst, size_t n) {
    const size_t nv = n / 8, gs = (size_t)gridDim.x * blockDim.x;
    for (size_t i = (size_t)blockIdx.x * blockDim.x + threadIdx.x; i < nv; i += 4 * gs) {
        f32x4 a[4], b[4];
#pragma unroll
        for (int q = 0; q < 4; ++q) { const size_t k = (i + q * gs < nv) ? i + q * gs : i; a[q] = ((const f32x4*)src)[2 * k]; b[q] = ((const f32x4*)src)[2 * k + 1]; }
#pragma unroll
        for (int q = 0; q < 4; ++q) {
            if (i + q * gs < nv) {
                u32x4 o; o[0] = pack2(a[q][0], a[q][1]); o[1] = pack2(a[q][2], a[q][3]); o[2] = pack2(b[q][0], b[q][1]); o[3] = pack2(b[q][2], b[q][3]);
                ((u32x4*)dst)[i + q * gs] = o;
            }
        }
    }
}
__device__ void transpose_cvt(const float* __restrict__ W, bf16_t* __restrict__ Wt, int K, int N, float* tile  ) {
    const int tk = K / 64, tn = N / 64;
    const int tid = threadIdx.x;
    for (int t = blockIdx.x; t < tk * tn; t += gridDim.x) {
        const int k0 = (t / tn) * 64, n0 = (t % tn) * 64;
        f32x4 v[4];
#pragma unroll
        for (int i = 0; i < 4; ++i) v[i] = *(const f32x4*)(W + (size_t)(k0 + (tid >> 4) + 16 * i) * N + n0 + (tid & 15) * 4);
        __syncthreads();
#pragma unroll
        for (int i = 0; i < 4; ++i)
#pragma unroll
            for (int j = 0; j < 4; ++j) tile[((tid >> 4) + 16 * i) * 65 + (tid & 15) * 4 + j] = v[i][j];
        __syncthreads();
        const int n = tid >> 2, kc = (tid & 3) * 16;
        u32x4 o0, o1;
#pragma unroll
        for (int q = 0; q < 4; ++q) {
            o0[q] = pack2(tile[(kc + 2 * q) * 65 + n], tile[(kc + 2 * q + 1) * 65 + n]);
            o1[q] = pack2(tile[(kc + 8 + 2 * q) * 65 + n], tile[(kc + 8 + 2 * q + 1) * 65 + n]);
        }
        *(u32x4*)(Wt + (size_t)(n0 + n) * K + k0 + kc) = o0;
        *(u32x4*)(Wt + (size_t)(n0 + n) * K + k0 + kc + 8) = o1;
    }
}
__device__ void cvt_table_fp8(const float* __restrict__ src, unsigned char* __restrict__ dst, float* __restrict__ scl, int rows) {
    const int lane = threadIdx.x & 63, wid = threadIdx.x >> 6;
    const int nw = gridDim.x * 4;
    for (int r0 = blockIdx.x * 4 + wid; r0 < rows; r0 += 4 * nw) {
        f32x4 v[4][4];
#pragma unroll
        for (int q = 0; q < 4; ++q) {
            const int r = (r0 + q * nw < rows) ? r0 + q * nw : r0;
            const float* sr = src + (size_t)r * DM + lane * 16;
#pragma unroll
            for (int k = 0; k < 4; ++k) v[q][k] = *(const f32x4*)(sr + 4 * k);
        }
#pragma unroll
        for (int q = 0; q < 4; ++q) {
            const int r = r0 + q * nw;
            float m = 0.f;
#pragma unroll
            for (int k = 0; k < 4; ++k)
#pragma unroll
                for (int i = 0; i < 4; ++i) m = fmaxf(m, fabsf(v[q][k][i]));
#pragma unroll
            for (int o = 32; o >= 1; o >>= 1) m = fmaxf(m, __shfl_xor(m, o));
            const float sc = (m > 0.f) ? 448.0f / m : 1.0f;
            u32x4 w;
#pragma unroll
            for (int k = 0; k < 4; ++k)
                w[k] = __builtin_amdgcn_cvt_pk_fp8_f32(v[q][k][2] * sc, v[q][k][3] * sc, __builtin_amdgcn_cvt_pk_fp8_f32(v[q][k][0] * sc, v[q][k][1] * sc, 0, false), true);
            if (r < rows) {
                *(u32x4*)(dst + (size_t)(lane >> 3) * (16384 * 128) + (size_t)r * 128 + (lane & 7) * 16) = w;
                if (lane == 0) scl[r] = (m > 0.f) ? m * (1.0f / 448.0f) : 1.0f;
            }
        }
    }
}
__device__ void ph_prep(const Params& p, unsigned char* smem) {
    float* tile = (float*)smem;
    cvt_rows(p.x, p.xb, (size_t)T_TOK * DM);
    cvt_rows(p.p, p.pb, (size_t)T_TOK * 256);
    cvt_table_fp8(p.pu, p.u8, p.su, 16384);
    cvt_table_fp8(p.pv, p.v8, p.sv, 16384);
    cvt_rows(p.keys, p.keysb, (size_t)16 * 128 * 128);
    transpose_cvt(p.w_in, p.WinT, DM, INW, tile);
    transpose_cvt(p.w_out, p.WoutT, DM, DM, tile);
    cvt_rows(p.wq, p.Wqb, (size_t)DM * 2048);
    transpose_cvt(p.ple_gate, p.WgT, DM, DM, tile);
    transpose_cvt(p.ple_proj, p.WpT, 256, DM, tile);
}

#define LDS_AS __attribute__((address_space(3)))
#define GEMM_STAGE 32768
template <bool PRE = false, bool NEXT = false>
__device__ __forceinline__ void gemm128(const bf16_t* __restrict__ A, int lda, const bf16_t* __restrict__ Bt, int ldb, int K,
                                        unsigned char* smem, f32x4 (&acc)[4][4],
                                        const bf16_t* __restrict__ nA = nullptr, int nlda = 0, const bf16_t* __restrict__ nB = nullptr, int nldb = 0) {
    LDS_AS unsigned char* lds = (LDS_AS unsigned char*)smem;
    const int tid = threadIdx.x, lane = tid & 63, wid = __builtin_amdgcn_readfirstlane(tid >> 6);
    const int wr = wid >> 1, wc = wid & 1, fr = lane & 15, fq = lane >> 4;
    const int nk = K / 64;
    const int prow = lane >> 3, pc = (lane & 7) ^ prow;
    const bf16_t* gA = A + (size_t)(wid * 32 + prow) * lda + pc * 8;
    const bf16_t* gB = Bt + (size_t)(wid * 32 + prow) * ldb + pc * 8;
    const size_t a8 = (size_t)8 * lda, b8 = (size_t)8 * ldb;
#define GEMM_ISSUE(kt, st) do { \
        _Pragma("unroll") for (int _i = 0; _i < 4; ++_i) { \
            __builtin_amdgcn_global_load_lds((const unsigned*)(gA + _i * a8 + (size_t)(kt) * 64), (LDS_AS unsigned*)(lds + (st) * GEMM_STAGE + (wid * 4 + _i) * 1024), 16, 0, 0); \
            __builtin_amdgcn_global_load_lds((const unsigned*)(gB + _i * b8 + (size_t)(kt) * 64), (LDS_AS unsigned*)(lds + (st) * GEMM_STAGE + 16384 + (wid * 4 + _i) * 1024), 16, 0, 0); \
        } } while (0)
    const int swz0 = ((0 * 4 + fq) ^ (fr & 7)) * 16, swz1 = ((1 * 4 + fq) ^ (fr & 7)) * 16;
    const int aoff = (wr * 64 + fr) * 128, boff = 16384 + (wc * 64 + fr) * 128;
    if (!PRE) GEMM_ISSUE(0, 0);
#pragma unroll 1
    for (int kt = 0; kt < nk; ++kt) {
        const int st = kt & 1;
        asm volatile("s_waitcnt vmcnt(0)" ::: "memory");
        __builtin_amdgcn_s_barrier();
        asm volatile("" ::: "memory");
        if (kt + 1 < nk) GEMM_ISSUE(kt + 1, st ^ 1);
        else if (NEXT) {
            const bf16_t* qA = nA + (size_t)(wid * 32 + prow) * nlda + pc * 8;
            const bf16_t* qB = nB + (size_t)(wid * 32 + prow) * nldb + pc * 8;
#pragma unroll
            for (int _i = 0; _i < 4; ++_i) {
                __builtin_amdgcn_global_load_lds((const unsigned*)(qA + (size_t)(_i * 8) * nlda), (LDS_AS unsigned*)(lds + (wid * 4 + _i) * 1024), 16, 0, 0);
                __builtin_amdgcn_global_load_lds((const unsigned*)(qB + (size_t)(_i * 8) * nldb), (LDS_AS unsigned*)(lds + 16384 + (wid * 4 + _i) * 1024), 16, 0, 0);
            }
        }
        const LDS_AS unsigned char* sb = lds + st * GEMM_STAGE;
        bf16x8 af0[4], bf0[4], af1[4], bf1[4];
#pragma unroll
        for (int mi = 0; mi < 4; ++mi) af0[mi] = *(const LDS_AS bf16x8*)(sb + aoff + mi * 2048 + swz0);
#pragma unroll
        for (int ni = 0; ni < 4; ++ni) bf0[ni] = *(const LDS_AS bf16x8*)(sb + boff + ni * 2048 + swz0);
#pragma unroll
        for (int mi = 0; mi < 4; ++mi) af1[mi] = *(const LDS_AS bf16x8*)(sb + aoff + mi * 2048 + swz1);
#pragma unroll
        for (int ni = 0; ni < 4; ++ni) bf1[ni] = *(const LDS_AS bf16x8*)(sb + boff + ni * 2048 + swz1);
#pragma unroll
        for (int mi = 0; mi < 4; ++mi)
#pragma unroll
            for (int ni = 0; ni < 4; ++ni)
                acc[mi][ni] = __builtin_amdgcn_mfma_f32_16x16x32_bf16(bf0[ni], af0[mi], acc[mi][ni], 0, 0, 0);
#pragma unroll
        for (int mi = 0; mi < 4; ++mi)
#pragma unroll
            for (int ni = 0; ni < 4; ++ni)
                acc[mi][ni] = __builtin_amdgcn_mfma_f32_16x16x32_bf16(bf1[ni], af1[mi], acc[mi][ni], 0, 0, 0);
        __builtin_amdgcn_sched_group_barrier(0x100, 8, 0);
#pragma unroll
        for (int q = 0; q < 8; ++q) { __builtin_amdgcn_sched_group_barrier(0x008, 2, 0); __builtin_amdgcn_sched_group_barrier(0x100, 1, 0); }
        __builtin_amdgcn_sched_group_barrier(0x008, 16, 0);
        asm volatile("s_waitcnt lgkmcnt(0)" ::: "memory");
        __builtin_amdgcn_s_barrier();
        asm volatile("" ::: "memory");
    }
#undef GEMM_ISSUE
}
#define GW_STAGE 24576
__device__ __forceinline__ void gemmW(const bf16_t* __restrict__ A, int lda, const bf16_t* __restrict__ Bt, int ldb, int K,
                                      unsigned char* smem, f32x4 (&acc)[4][8]) {
    LDS_AS unsigned char* lds = (LDS_AS unsigned char*)smem;
    const int tid = threadIdx.x, lane = tid & 63, wid = __builtin_amdgcn_readfirstlane(tid >> 6);
    const int wr = wid >> 1, wc = wid & 1, fr = lane & 15, fq = lane >> 4;
    const int nk = K / 32;
    const int prow = lane >> 2, pc = (lane & 3) ^ ((4 - ((prow >> 2) & 3)) & 3);
    const bf16_t* gA = A + (size_t)(wid * 32 + prow) * lda + pc * 8;
    const bf16_t* gB = Bt + (size_t)(wid * 64 + prow) * ldb + pc * 8;
    const size_t a16 = (size_t)16 * lda, b16 = (size_t)16 * ldb;
#define GW_ISSUE(kt, st) do { \
        _Pragma("unroll") for (int _i = 0; _i < 2; ++_i) \
            __builtin_amdgcn_global_load_lds((const unsigned*)(gA + _i * a16 + (size_t)(kt) * 32), (LDS_AS unsigned*)(lds + (st) * GW_STAGE + (wid * 2 + _i) * 1024), 16, 0, 0); \
        _Pragma("unroll") for (int _i = 0; _i < 4; ++_i) \
            __builtin_amdgcn_global_load_lds((const unsigned*)(gB + _i * b16 + (size_t)(kt) * 32), (LDS_AS unsigned*)(lds + (st) * GW_STAGE + 8192 + (wid * 4 + _i) * 1024), 16, 0, 0); \
        } while (0)
    const int swz = (fq ^ ((4 - ((fr >> 2) & 3)) & 3)) * 16;
    const int aoff = (wr * 64 + fr) * 64 + swz, boff = 8192 + (wc * 128 + fr) * 64 + swz;
    GW_ISSUE(0, 0);
#pragma unroll 1
    for (int kt = 0; kt < nk; ++kt) {
        const int st = kt & 1;
        asm volatile("s_waitcnt vmcnt(0)" ::: "memory");
        __builtin_amdgcn_s_barrier();
        asm volatile("" ::: "memory");
        if (kt + 1 < nk) GW_ISSUE(kt + 1, st ^ 1);
        const LDS_AS unsigned char* sb = lds + st * GW_STAGE;
        bf16x8 af[4], bfr[8];
#pragma unroll
        for (int mi = 0; mi < 4; ++mi) af[mi] = *(const LDS_AS bf16x8*)(sb + aoff + mi * 1024);
#pragma unroll
        for (int ni = 0; ni < 8; ++ni) bfr[ni] = *(const LDS_AS bf16x8*)(sb + boff + ni * 1024);
#pragma unroll
        for (int ni = 0; ni < 8; ++ni)
#pragma unroll
            for (int mi = 0; mi < 4; ++mi)
                acc[mi][ni] = __builtin_amdgcn_mfma_f32_16x16x32_bf16(bfr[ni], af[mi], acc[mi][ni], 0, 0, 0);
        asm volatile("s_waitcnt lgkmcnt(0)" ::: "memory");
        __builtin_amdgcn_s_barrier();
        asm volatile("" ::: "memory");
    }
#undef GW_ISSUE
}
__device__ __forceinline__ void zero_accw(f32x4 (&acc)[4][8]) {
#pragma unroll
    for (int a = 0; a < 4; ++a)
#pragma unroll
        for (int b = 0; b < 8; ++b) acc[a][b] = (f32x4){0.f, 0.f, 0.f, 0.f};
}
__device__ __forceinline__ void zero_acc(f32x4 (&acc)[4][4]) {
#pragma unroll
    for (int a = 0; a < 4; ++a)
#pragma unroll
        for (int b = 0; b < 4; ++b) acc[a][b] = (f32x4){0.f, 0.f, 0.f, 0.f};
}
#define GEMM_SMEM (2 * GEMM_STAGE)

__device__ void ph_gemm_in(const Params& p, unsigned char* smem, const int vb) {
    const int ntn = INW / 128;
    const int tid = threadIdx.x, lane = tid & 63, wid = tid >> 6, wr = wid >> 1, wc = wid & 1, fr = lane & 15, fq = lane >> 4;
    const int ntiles = (T_TOK / 128) * ntn;
    bool pre = false;
    for (int t = vb; t < ntiles; t += gridDim.x) {
        const int m0 = (t / ntn) * 128, n0 = (t % ntn) * 128;
        const int tn = t + gridDim.x;
        const bool has_next = tn < ntiles;
        const bf16_t* nA = p.xb + (size_t)((has_next ? tn : t) / ntn) * 128 * DM;
        const bf16_t* nB = p.WinT + (size_t)((has_next ? tn : t) % ntn) * 128 * DM;
        f32x4 acc[4][4]; zero_acc(acc);
        if (pre) { if (has_next) gemm128<true, true>(p.xb + (size_t)m0 * DM, DM, p.WinT + (size_t)n0 * DM, DM, DM, smem, acc, nA, DM, nB, DM);
                   else          gemm128<true, false>(p.xb + (size_t)m0 * DM, DM, p.WinT + (size_t)n0 * DM, DM, DM, smem, acc); }
        else     { if (has_next) gemm128<false, true>(p.xb + (size_t)m0 * DM, DM, p.WinT + (size_t)n0 * DM, DM, DM, smem, acc, nA, DM, nB, DM);
                   else          gemm128<false, false>(p.xb + (size_t)m0 * DM, DM, p.WinT + (size_t)n0 * DM, DM, DM, smem, acc); }
        pre = has_next;
#pragma unroll
        for (int mi = 0; mi < 4; ++mi) {
            const int row = m0 + wr * 64 + mi * 16 + fr;
            const float posf = (float)p.pos[row];
#pragma unroll
            for (int ni = 0; ni < 4; ++ni) {
                const int col0 = n0 + wc * 64 + ni * 16;
                f32x4 v = acc[mi][ni];
                if (col0 < 640 && (col0 & 63) == 0) {
#pragma unroll
                    for (int r = 0; r < 4; ++r) {
                        const float other = __shfl_xor(v[r], 32);
                        const int j = (fq & 1) * 4 + r;
                        const float inv = powf(500000.0f, -(float)j * 0.125f);
                        float sn, cs; sincosf(posf * inv, &sn, &cs);
                        v[r] = (fq < 2) ? (v[r] * cs - other * sn) : (v[r] * cs + other * sn);
                    }
                }
                uint2 o; o.x = pack2(v[0], v[1]); o.y = pack2(v[2], v[3]);
                *(uint2*)(p.hb + (size_t)row * INW + col0 + fq * 4) = o;
            }
        }
    }
}

#define ASTR 72
#define VSTR 260
typedef float f32x16 __attribute__((ext_vector_type(16)));
typedef unsigned u32x2 __attribute__((ext_vector_type(2)));
__device__ void ph_attn(const Params& p, unsigned char* smem, const int vb) {
    bf16_t* sK = (bf16_t*)smem;
    bf16_t* sVt = sK + 256 * ASTR;
    const int tid = threadIdx.x, lane = tid & 63, wid = tid >> 6, r32 = lane & 31, hh = lane >> 5;
    const float C1 = 0.125f * 1.4426950408889634f, LOG2E = 1.4426950408889634f;
    for (int u = vb; u < 16 * 16 * 2; u += gridDim.x) {
        const int kvh = u & 1, nb = (u >> 1) & 15, b = u >> 5;
        __syncthreads();
        for (int c = tid; c < 256 * 8; c += 256) {
            const int li = c >> 3, kc = c & 7;
            const int pos = nb * 128 - 128 + li;
            u32x4 kv = {0u, 0u, 0u, 0u}, vv = {0u, 0u, 0u, 0u};
            if (pos >= 0) {
                const bf16_t* base = p.hb + (size_t)(b * SEQ + pos) * INW;
                kv = *(const u32x4*)(base + 512 + kvh * 64 + kc * 8);
                vv = *(const u32x4*)(base + 640 + kvh * 64 + kc * 8);
            }
            *(u32x4*)(sK + li * ASTR + kc * 8) = kv;
#pragma unroll
            for (int i = 0; i < 4; ++i) {
                sVt[(kc * 8 + 2 * i) * VSTR + li] = (bf16_t)(vv[i] & 0xffffu);
                sVt[(kc * 8 + 2 * i + 1) * VSTR + li] = (bf16_t)(vv[i] >> 16);
            }
        }
        __syncthreads();
        const int hq = kvh * 4 + wid;
        const float sink2 = p.sinks[hq] * LOG2E;
#pragma unroll 1
        for (int qt = 0; qt < 4; ++qt) {
            const size_t trow = (size_t)(b * SEQ + nb * 128 + qt * 32 + r32);
            bf16x8 qf[4];
#pragma unroll
            for (int ks = 0; ks < 4; ++ks) qf[ks] = *(const bf16x8*)(p.hb + trow * INW + hq * 64 + ks * 16 + hh * 8);
            f32x16 S[5];
#pragma unroll
            for (int j = 0; j < 5; ++j) {
#pragma unroll
                for (int r = 0; r < 16; ++r) S[j][r] = 0.f;
#pragma unroll
                for (int ks = 0; ks < 4; ++ks) {
                    const bf16x8 a = *(const bf16x8*)(sK + ((qt + j) * 32 + r32) * ASTR + ks * 16 + hh * 8);
                    S[j] = __builtin_amdgcn_mfma_f32_32x32x16_bf16(a, qf[ks], S[j], 0, 0, 0);
                }
            }
            float m2 = sink2;
#pragma unroll
            for (int j = 0; j < 5; ++j) {
                const bool tile_ok = (nb > 0) || (qt + j >= 4);
#pragma unroll
                for (int r = 0; r < 16; ++r) {
                    const int kl = (r & 3) + 8 * (r >> 2) + 4 * hh;
                    bool ok = tile_ok;
                    if (j == 0) ok = ok && (kl > r32);
                    if (j == 4) ok = ok && (kl <= r32);
                    const float t = ok ? S[j][r] * C1 : -1.0e30f;
                    S[j][r] = t;
                    m2 = fmaxf(m2, t);
                }
            }
            m2 = fmaxf(m2, __shfl_xor(m2, 32));
            float l = 0.f;
#pragma unroll
            for (int j = 0; j < 5; ++j)
#pragma unroll
                for (int r = 0; r < 16; ++r) { const float e = __builtin_amdgcn_exp2f(S[j][r] - m2); S[j][r] = e; l += e; }
            l += __shfl_xor(l, 32);
            l += __builtin_amdgcn_exp2f(sink2 - m2);
            f32x16 O[2];
#pragma unroll
            for (int dt = 0; dt < 2; ++dt)
#pragma unroll
                for (int r = 0; r < 16; ++r) O[dt][r] = 0.f;
#pragma unroll
            for (int j = 0; j < 5; ++j)
#pragma unroll
                for (int s2 = 0; s2 < 2; ++s2) {
                    u32x4 pw;
#pragma unroll
                    for (int k = 0; k < 4; ++k) pw[k] = pack2(S[j][8 * s2 + 2 * k], S[j][8 * s2 + 2 * k + 1]);
                    const bf16x8 pf = __builtin_bit_cast(bf16x8, pw);
                    const int kbase = (qt + j) * 32 + 16 * s2 + 4 * hh;
#pragma unroll
                    for (int dt = 0; dt < 2; ++dt) {
                        const bf16_t* vp = sVt + (dt * 32 + r32) * VSTR + kbase;
                        const u32x2 v0 = *(const u32x2*)(vp), v1 = *(const u32x2*)(vp + 8);
                        const u32x4 vw = {v0[0], v0[1], v1[0], v1[1]};
                        O[dt] = __builtin_amdgcn_mfma_f32_32x32x16_bf16(__builtin_bit_cast(bf16x8, vw), pf, O[dt], 0, 0, 0);
                    }
                }
            const float il = __builtin_amdgcn_rcpf(l);
#pragma unroll
            for (int dt = 0; dt < 2; ++dt)
#pragma unroll
                for (int g = 0; g < 4; ++g) {
                    u32x2 w;
                    w[0] = pack2(O[dt][4 * g] * il, O[dt][4 * g + 1] * il);
                    w[1] = pack2(O[dt][4 * g + 2] * il, O[dt][4 * g + 3] * il);
                    *(u32x2*)(p.mixb + trow * DM + hq * 64 + dt * 32 + 8 * g + 4 * hh) = w;
                }
        }
    }
}

#define CV_ROWS 62
__device__ void ph_conv(const Params& p, unsigned char* smem, const int vb) {
    bf16_t* gl = (bf16_t*)smem;
    float* red = (float*)(smem + CV_ROWS * 1024);
    const int tid = threadIdx.x, lane = tid & 63, wid = tid >> 6;
    const f32x2 lg = *(const f32x2*)(p.cln_g + 2 * tid), lb = *(const f32x2*)(p.cln_b + 2 * tid);
    for (int u = vb; u < T_TOK / 32; u += gridDim.x) {
        const int tok0 = u * 32, s0 = tok0 & (SEQ - 1);
        __syncthreads();
#pragma unroll 1
        for (int bt = 0; bt < 2; ++bt) {
            u32x4 av[8], gv[8];
#pragma unroll
            for (int it = 0; it < 8; ++it) {
                const int ch = tid + (bt * 8 + it) * 256, row = min(ch >> 6, CV_ROWS - 1), k = ch & 63;
                const int rr = (s0 - 30 + row >= 0) ? row : 30;
                const bf16_t* base = p.hb + (size_t)(tok0 - 30 + rr) * INW + k * 8;
                av[it] = *(const u32x4*)(base + 768); gv[it] = *(const u32x4*)(base + 1280);
            }
#pragma unroll
            for (int it = 0; it < 8; ++it) {
                const int ch = tid + (bt * 8 + it) * 256, row = ch >> 6, k = ch & 63;
                const bool ok = (s0 - 30 + row >= 0);
                u32x4 o;
#pragma unroll
                for (int q = 0; q < 4; ++q) {
                    const float g0 = sigmul(bflo(av[it][q]), bflo(gv[it][q])), g1 = sigmul(bfhi(av[it][q]), bfhi(gv[it][q]));
                    o[q] = ok ? pack2(g0, g1) : 0u;
                }
                if (row < CV_ROWS) *(u32x4*)(gl + row * 512 + k * 8) = o;
            }
        }
        __syncthreads();
        float w0[31], w1[31];
#pragma unroll
        for (int k = 0; k < 31; ++k) { const f32x2 wv = *(const f32x2*)(p.conv_w + k * 512 + 2 * tid); w0[k] = wv.x; w1[k] = wv.y; }
        const f32x2 bias = *(const f32x2*)(p.conv_b + 2 * tid);
#pragma unroll 1
        for (int jh = 0; jh < 2; ++jh) {
            float a0[16], a1[16];
#pragma unroll
            for (int jl = 0; jl < 16; ++jl) { a0[jl] = bias.x; a1[jl] = bias.y; }
            const bf16_t* gp = gl + (jh * 16) * 512 + 2 * tid;
#pragma unroll
            for (int il = 0; il < 46; ++il) {
                const unsigned gw = *(const unsigned*)(gp + il * 512);
                const float g0 = bflo(gw), g1 = bfhi(gw);
#pragma unroll
                for (int jl = 0; jl < 16; ++jl)
                    if (il - jl >= 0 && il - jl <= 30) { a0[jl] += w0[il - jl] * g0; a1[jl] += w1[il - jl] * g1; }
                if ((il & 3) == 3) __builtin_amdgcn_sched_barrier(0);
            }
            float v[32];
#pragma unroll
            for (int jl = 0; jl < 16; ++jl) { v[jl] = a0[jl] + a1[jl]; v[16 + jl] = a0[jl] * a0[jl] + a1[jl] * a1[jl]; }
#pragma unroll
            for (int st = 16; st >= 1; st >>= 1) {
                const bool up = (lane & st) != 0;
#pragma unroll
                for (int i2 = 0; i2 < st; ++i2) {
                    const float keep = up ? v[i2 + st] : v[i2], send = up ? v[i2] : v[i2 + st];
                    v[i2] = keep + __shfl_xor(send, st);
                }
            }
            const float tot = v[0] + __shfl_xor(v[0], 32);
            __syncthreads();
            if (lane < 32) red[wid * 32 + lane] = tot;
            __syncthreads();
#pragma unroll
            for (int jl = 0; jl < 16; ++jl) {
                const float sm = (red[jl] + red[32 + jl]) + (red[64 + jl] + red[96 + jl]);
                const float sq = (red[16 + jl] + red[48 + jl]) + (red[80 + jl] + red[112 + jl]);
                const float mu = sm * (1.0f / 512.0f);
                const float rstd = rsqrtf(fmaxf(sq * (1.0f / 512.0f) - mu * mu, 0.f) + LN_EPS);
                const float y0 = (a0[jl] - mu) * rstd * lg.x + lb.x, y1 = (a1[jl] - mu) * rstd * lg.y + lb.y;
                *(unsigned*)(p.mixb + (size_t)(tok0 + jh * 16 + jl) * DM + 512 + 2 * tid) = pack2(sigmul(y0, y0), sigmul(y1, y1));
            }
        }
    }
}

__device__ void ph_gemm_out(const Params& p, unsigned char* smem, const int vb) {
    const int ntn = DM / 256;
    const int tid = threadIdx.x, lane = tid & 63, wid = tid >> 6, wr = wid >> 1, wc = wid & 1, fr = lane & 15, fq = lane >> 4;
    for (int t = vb; t < (T_TOK / 128) * ntn; t += gridDim.x) {
        const int m0 = (t / ntn) * 128, n0 = (t % ntn) * 256;
        f32x4 acc[4][8]; zero_accw(acc);
        gemmW(p.mixb + (size_t)m0 * DM, DM, p.WoutT + (size_t)n0 * DM, DM, DM, smem, acc);
#pragma unroll
        for (int mi = 0; mi < 4; ++mi) {
            const int row = m0 + wr * 64 + mi * 16 + fr;
#pragma unroll
            for (int ni = 0; ni < 8; ++ni) {
                const int col = n0 + wc * 128 + ni * 16 + fq * 4;
                const f32x4 xv = *(const f32x4*)(p.x + (size_t)row * DM + col);
                *(f32x4*)(p.y1 + (size_t)row * DM + col) = xv * ALPHA + acc[mi][ni];
            }
        }
    }
}

__device__ __forceinline__ void ln_row(const float* __restrict__ src, const float* __restrict__ g, const float* __restrict__ bta,
                                       float* __restrict__ dstf, bf16_t* __restrict__ dstb, int lane) {
    f32x4 v[4]; float s = 0.f;
#pragma unroll
    for (int i = 0; i < 4; ++i) { v[i] = *(const f32x4*)(src + i * 256 + lane * 4); s += (v[i][0] + v[i][1]) + (v[i][2] + v[i][3]); }
    const float mu = wave_sum(s) * (1.0f / 1024.0f);
    float q = 0.f;
#pragma unroll
    for (int i = 0; i < 4; ++i) { const f32x4 d = v[i] - mu; q += (d[0] * d[0] + d[1] * d[1]) + (d[2] * d[2] + d[3] * d[3]); }
    const float rstd = rsqrtf(wave_sum(q) * (1.0f / 1024.0f) + LN_EPS);
#pragma unroll
    for (int i = 0; i < 4; ++i) {
        const f32x4 gg = *(const f32x4*)(g + i * 256 + lane * 4), bb = *(const f32x4*)(bta + i * 256 + lane * 4);
        const f32x4 y = (v[i] - mu) * rstd * gg + bb;
        if (dstf) *(f32x4*)(dstf + i * 256 + lane * 4) = y;
        if (dstb) { uint2 o; o.x = pack2(y[0], y[1]); o.y = pack2(y[2], y[3]); *(uint2*)(dstb + i * 256 + lane * 4) = o; }
    }
}
__device__ void ph_ln1(const Params& p, const int vb) {
    const int lane = threadIdx.x & 63, wid = threadIdx.x >> 6;
    for (int r = vb * 4 + wid; r < T_TOK; r += gridDim.x * 4)
        ln_row(p.y1 + (size_t)r * DM, p.ln1_g, p.ln1_b, (float*)nullptr, p.x1b + (size_t)r * DM, lane);
}
__device__ void ph_ln2(const Params& p, const int vb) {
    const int lane = threadIdx.x & 63, wid = threadIdx.x >> 6;
    for (int r = vb * 4 + wid; r < T_TOK; r += gridDim.x * 4)
        ln_row(p.out + (size_t)r * DM, p.ln2_g, p.ln2_b, p.out + (size_t)r * DM, (bf16_t*)nullptr, lane);
}

#define QSTR 136
__device__ __forceinline__ int f2key(float f) { const int b = __float_as_int(f); return b ^ ((b >> 31) & 0x7fffffff); }
__device__ __forceinline__ float key2f(int k) { return __int_as_float(k ^ ((k >> 31) & 0x7fffffff)); }
__device__ __forceinline__ void sort16_desc(int (&a)[16]) {
#pragma unroll
    for (int lk = 1; lk <= 4; ++lk) {
#pragma unroll
        for (int lj = lk - 1; lj >= 0; --lj) {
            const int k = 1 << lk, j = 1 << lj;
#pragma unroll
            for (int i = 0; i < 16; ++i) {
                const int l = i ^ j;
                if (l > i) {
                    const int hi = max(a[i], a[l]), lo = min(a[i], a[l]);
                    if ((i & k) == 0) { a[i] = hi; a[l] = lo; } else { a[i] = lo; a[l] = hi; }
                }
            }
        }
    }
}
__device__ __forceinline__ void merge_top16(int (&a)[16], const int (&b)[16]) {
#pragma unroll
    for (int i = 0; i < 16; ++i) a[i] = max(a[i], b[15 - i]);
#pragma unroll
    for (int lj = 3; lj >= 0; --lj) {
        const int j = 1 << lj;
#pragma unroll
        for (int i = 0; i < 16; ++i) {
            const int l = i ^ j;
            if (l > i) { const int hi = max(a[i], a[l]), lo = min(a[i], a[l]); a[i] = hi; a[l] = lo; }
        }
    }
}
__device__ __forceinline__ void top16_of_64(int (&v)[4][16]) {
    sort16_desc(v[0]); sort16_desc(v[1]); sort16_desc(v[2]); sort16_desc(v[3]);
    merge_top16(v[0], v[1]); merge_top16(v[0], v[2]); merge_top16(v[0], v[3]);
}

__device__ void ph_mprep(const Params& p, unsigned char* smem, const int vb) {
    const int tid = threadIdx.x, lane = tid & 63, wid = tid >> 6, wr = wid >> 1, wc = wid & 1, fr = lane & 15, fq = lane >> 4;
    for (int t = vb; t < 16 * 8; t += gridDim.x) {
        const int hp = t >> 3, d0 = (t & 7) * 128;
        f32x4 acc[4][4]; zero_acc(acc);
        gemm128(p.keysb + (size_t)hp * 128 * 128, 128, p.Wqb + (size_t)d0 * 2048 + hp * 128, 2048, 128, smem, acc);
#pragma unroll
        for (int mi = 0; mi < 4; ++mi)
#pragma unroll
            for (int ni = 0; ni < 4; ++ni) {
                uint2 o; o.x = pack2(acc[mi][ni][0], acc[mi][ni][1]); o.y = pack2(acc[mi][ni][2], acc[mi][ni][3]);
                *(uint2*)(p.MT + (size_t)(hp * 128 + wr * 64 + mi * 16 + fr) * DM + d0 + wc * 64 + ni * 16 + fq * 4) = o;
            }
    }
}

__device__ __forceinline__ void route_half(const Params& p, unsigned char* smem, int m0, int hp, int (&K)[16]) {
    LDS_AS unsigned char* lds = (LDS_AS unsigned char*)smem;
    const int tid = threadIdx.x, lane = tid & 63, wid = __builtin_amdgcn_readfirstlane(tid >> 6);
    const int r32 = lane & 31, hh = lane >> 5;
    const int prow = lane >> 3, pc = (lane & 7) ^ prow;
    const bf16_t* gA = p.x1b + (size_t)(m0 + wid * 32 + prow) * DM + pc * 8;
    const bf16_t* gB = p.MT + (size_t)(hp * 128 + wid * 32 + prow) * DM + pc * 8;
    const size_t r8 = (size_t)8 * DM;
#define RT_ISSUE(kt, st) do { \
        _Pragma("unroll") for (int _i = 0; _i < 4; ++_i) { \
            __builtin_amdgcn_global_load_lds((const unsigned*)(gA + _i * r8 + (size_t)(kt) * 64), (LDS_AS unsigned*)(lds + (st) * GEMM_STAGE + (wid * 4 + _i) * 1024), 16, 0, 0); \
            __builtin_amdgcn_global_load_lds((const unsigned*)(gB + _i * r8 + (size_t)(kt) * 64), (LDS_AS unsigned*)(lds + (st) * GEMM_STAGE + 16384 + (wid * 4 + _i) * 1024), 16, 0, 0); \
        } } while (0)
    f32x16 S[4];
#pragma unroll
    for (int mt = 0; mt < 4; ++mt)
#pragma unroll
        for (int r = 0; r < 16; ++r) S[mt][r] = 0.f;
    const int toff = (wid * 32 + r32) * 128, koff = 16384 + r32 * 128, x7 = r32 & 7;
    RT_ISSUE(0, 0);
#pragma unroll 1
    for (int kt = 0; kt < DM / 64; ++kt) {
        const int st = kt & 1;
        asm volatile("s_waitcnt vmcnt(0)" ::: "memory");
        __builtin_amdgcn_s_barrier();
        asm volatile("" ::: "memory");
        if (kt + 1 < DM / 64) RT_ISSUE(kt + 1, st ^ 1);
        const LDS_AS unsigned char* sb = lds + st * GEMM_STAGE;
        bf16x8 bq[4], aq[4][4];
#pragma unroll
        for (int k16 = 0; k16 < 4; ++k16) {
            const int sw = ((k16 * 2 + hh) ^ x7) * 16;
            bq[k16] = *(const LDS_AS bf16x8*)(sb + toff + sw);
#pragma unroll
            for (int mt = 0; mt < 4; ++mt) aq[k16][mt] = *(const LDS_AS bf16x8*)(sb + koff + mt * 4096 + sw);
        }
#pragma unroll
        for (int k16 = 0; k16 < 4; ++k16)
#pragma unroll
            for (int mt = 0; mt < 4; ++mt) S[mt] = __builtin_amdgcn_mfma_f32_32x32x16_bf16(aq[k16][mt], bq[k16], S[mt], 0, 0, 0);
        __builtin_amdgcn_sched_group_barrier(0x100, 5, 0);
#pragma unroll
        for (int q = 0; q < 15; ++q) { __builtin_amdgcn_sched_group_barrier(0x008, 1, 0); __builtin_amdgcn_sched_group_barrier(0x100, 1, 0); }
        __builtin_amdgcn_sched_group_barrier(0x008, 1, 0);
        asm volatile("s_waitcnt lgkmcnt(0)" ::: "memory");
        __builtin_amdgcn_s_barrier();
        asm volatile("" ::: "memory");
    }
#undef RT_ISSUE
    int v[4][16];
#pragma unroll
    for (int mt = 0; mt < 4; ++mt)
#pragma unroll
        for (int r = 0; r < 16; ++r) {
            const int n = mt * 32 + (r & 3) + 8 * (r >> 2) + 4 * hh;
            v[mt][r] = (f2key(S[mt][r]) & ~0x7F) | (127 - n);
        }
    top16_of_64(v);
    int o[16];
#pragma unroll
    for (int i = 0; i < 16; ++i) o[i] = __shfl_xor(v[0][i], 32);
    merge_top16(v[0], o);
#pragma unroll
    for (int i = 0; i < 16; ++i) K[i] = v[0][i];
}

__device__ __forceinline__ void route_topk(const f32x16 (&S)[8], int pp, int hh, int (&K)[16]) {
    int v[4][16];
#pragma unroll
    for (int mt = 0; mt < 4; ++mt)
#pragma unroll
        for (int r = 0; r < 16; ++r) {
            const int n = mt * 32 + (r & 3) + 8 * (r >> 2) + 4 * hh;
            v[mt][r] = (f2key(S[pp * 4 + mt][r]) & ~0x7F) | (127 - n);
        }
    top16_of_64(v);
    int o[16];
#pragma unroll
    for (int i = 0; i < 16; ++i) o[i] = __shfl_xor(v[0][i], 32);
    merge_top16(v[0], o);
#pragma unroll
    for (int i = 0; i < 16; ++i) K[i] = v[0][i];
}
__device__ __forceinline__ void route_head(const Params& p, unsigned char* smem, int m0, int h, int (&K0)[16], int (&K1)[16]) {
    LDS_AS unsigned char* lds = (LDS_AS unsigned char*)smem;
    const int tid = threadIdx.x, lane = tid & 63, wid = __builtin_amdgcn_readfirstlane(tid >> 6);
    const int r32 = lane & 31, hh = lane >> 5;
    const int prow = lane >> 2, pc = (lane & 3) ^ ((4 - ((prow >> 2) & 3)) & 3);
    const bf16_t* gA = p.x1b + (size_t)(m0 + wid * 32 + prow) * DM + pc * 8;
    const bf16_t* gB = p.MT + (size_t)(h * 256 + wid * 64 + prow) * DM + pc * 8;
    const size_t r16 = (size_t)16 * DM;
#define RH_ISSUE(kt, st) do { \
        _Pragma("unroll") for (int _i = 0; _i < 2; ++_i) \
            __builtin_amdgcn_global_load_lds((const unsigned*)(gA + _i * r16 + (size_t)(kt) * 32), (LDS_AS unsigned*)(lds + (st) * GW_STAGE + (wid * 2 + _i) * 1024), 16, 0, 0); \
        _Pragma("unroll") for (int _i = 0; _i < 4; ++_i) \
            __builtin_amdgcn_global_load_lds((const unsigned*)(gB + _i * r16 + (size_t)(kt) * 32), (LDS_AS unsigned*)(lds + (st) * GW_STAGE + 8192 + (wid * 4 + _i) * 1024), 16, 0, 0); \
        } while (0)
    f32x16 S[8];
#pragma unroll
    for (int mt = 0; mt < 8; ++mt)
#pragma unroll
        for (int r = 0; r < 16; ++r) S[mt][r] = 0.f;
    const int fx = (4 - ((r32 >> 2) & 3)) & 3;
    const int toff = (wid * 32 + r32) * 64, koff = 8192 + r32 * 64;
    RH_ISSUE(0, 0);
#pragma unroll 1
    for (int kt = 0; kt < DM / 32; ++kt) {
        const int st = kt & 1;
        asm volatile("s_waitcnt vmcnt(0)" ::: "memory");
        __builtin_amdgcn_s_barrier();
        asm volatile("" ::: "memory");
        if (kt + 1 < DM / 32) RH_ISSUE(kt + 1, st ^ 1);
        const LDS_AS unsigned char* sb = lds + st * GW_STAGE;
#pragma unroll
        for (int k16 = 0; k16 < 2; ++k16) {
            const int sw = ((k16 * 2 + hh) ^ fx) * 16;
            const bf16x8 b = *(const LDS_AS bf16x8*)(sb + toff + sw);
#pragma unroll
            for (int mt = 0; mt < 8; ++mt) {
                const bf16x8 a = *(const LDS_AS bf16x8*)(sb + koff + mt * 2048 + sw);
                S[mt] = __builtin_amdgcn_mfma_f32_32x32x16_bf16(a, b, S[mt], 0, 0, 0);
            }
        }
        asm volatile("s_waitcnt lgkmcnt(0)" ::: "memory");
        __builtin_amdgcn_s_barrier();
        asm volatile("" ::: "memory");
    }
#undef RH_ISSUE
    route_topk(S, 0, hh, K0);
    route_topk(S, 1, hh, K1);
}

__device__ void ph_route(const Params& p, unsigned char* smem, const int vb) {
    const int tid = threadIdx.x, lane = tid & 63, wid = tid >> 6;
    const int r32 = lane & 31, hh = lane >> 5;
    const int hmask = -hh;
    int* KL = (int*)(smem + (size_t)wid * 32 * QSTR * 2);
    for (int u = vb; u < (T_TOK / 128) * 8; u += gridDim.x) {
        const int m0 = (u >> 3) * 128, h = u & 7;
        __syncthreads();
        int K0[16], K1[16];
        route_head(p, smem, m0, h, K0, K1);
#pragma unroll
        for (int i = 0; i < 16; ++i) KL[r32 * 33 + hh * 16 + i] = K0[i] ^ ((K0[i] ^ K1[i]) & hmask);
        float s1[16], s2[16];
#pragma unroll
        for (int i = 0; i < 16; ++i) { s1[i] = key2f(K0[i] & ~0x7F); s2[i] = key2f(K1[i] & ~0x7F); }
        int c[4][16];
#pragma unroll
        for (int i = 0; i < 16; ++i)
#pragma unroll
            for (int j = 0; j < 16; ++j)
                if ((i + 1) * (j + 1) <= 16) {
                    constexpr int OFFS[16] = {0, 16, 24, 29, 33, 36, 38, 40, 42, 43, 44, 45, 46, 47, 48, 49};
                    const int q = OFFS[i] + j;
                    c[q >> 4][q & 15] = (f2key(s1[i] + s2[j]) & ~0xFF) | (255 - (i * 16 + j));
                }
#pragma unroll
        for (int qq = 50; qq < 64; ++qq) c[qq >> 4][qq & 15] = (int)0x80000000;
        top16_of_64(c);
        const float mx = key2f(c[0][0] & ~0xFF);
        float e[16]; float den = 0.f;
#pragma unroll
        for (int i = 0; i < 16; ++i) { e[i] = __expf(key2f(c[0][i] & ~0xFF) - mx); den += e[i]; }
        const float inv = __builtin_amdgcn_rcpf(den);
        const size_t ob = (size_t)(m0 + wid * 32 + r32) * 128 + h * 16 + hh * 8;
        int idv[8]; float gv[8];
#pragma unroll
        for (int qq = 0; qq < 8; ++qq) {
            const int F = c[0][qq] ^ ((c[0][qq] ^ c[0][8 + qq]) & hmask);
            gv[qq] = __int_as_float(__float_as_int(e[qq]) ^ ((__float_as_int(e[qq]) ^ __float_as_int(e[8 + qq])) & hmask)) * inv;
            const int idx = 255 - (F & 0xFF);
            const int k0 = KL[r32 * 33 + (idx >> 4)], k1 = KL[r32 * 33 + 16 + (idx & 15)];
            idv[qq] = (127 - (k0 & 0x7F)) * 128 + (127 - (k1 & 0x7F));
        }
        *(int4*)(p.ids + ob) = make_int4(idv[0], idv[1], idv[2], idv[3]);
        *(int4*)(p.ids + ob + 4) = make_int4(idv[4], idv[5], idv[6], idv[7]);
        *(float4*)(p.gates + ob) = make_float4(gv[0], gv[1], gv[2], gv[3]);
        *(float4*)(p.gates + ob + 4) = make_float4(gv[4], gv[5], gv[6], gv[7]);
    }
}

__device__ __forceinline__ f32x2 row_dot(const u32x4 w, const f32x2 (&x)[8], f32x2 acc) {
#pragma unroll
    for (int k = 0; k < 4; ++k) {
        acc = __builtin_amdgcn_cvt_pk_f32_fp8(w[k], false) * x[2 * k] + acc;
        acc = __builtin_amdgcn_cvt_pk_f32_fp8(w[k], true) * x[2 * k + 1] + acc;
    }
    return acc;
}
__device__ __forceinline__ float gelu_gate(float h, float g) { return 0.5f * h * (1.0f + erff(h * 0.70710678118654752f)) * g; }

__device__ __forceinline__ void ld_ids16(const int* __restrict__ q, int (&idv)[16]) {
    const int4* idp = (const int4*)q;
#pragma unroll
    for (int k = 0; k < 4; ++k) { const int4 v = idp[k]; idv[4 * k] = v.x; idv[4 * k + 1] = v.y; idv[4 * k + 2] = v.z; idv[4 * k + 3] = v.w; }
}
__device__ __forceinline__ void ld_f16(const float* __restrict__ q, float (&a)[16]) {
    const f32x4* ap = (const f32x4*)q;
#pragma unroll
    for (int k = 0; k < 4; ++k) { const f32x4 v = ap[k]; a[4 * k] = v[0]; a[4 * k + 1] = v[1]; a[4 * k + 2] = v[2]; a[4 * k + 3] = v[3]; }
}
__device__ void ph_peer_u(const Params& p, unsigned char* smem, const int vb) {
    const int lane = threadIdx.x & 63, wid = __builtin_amdgcn_readfirstlane(threadIdx.x >> 6), g = lane >> 3, c = lane & 7;
    const int nlb = gridDim.x >> 3, s = vb / nlb, lb = vb - s * nlb;
    const bool b2 = (lane & 4) != 0, b1 = (lane & 2) != 0, b0 = (lane & 1) != 0;
    const int cc = (b0 ? 2 : 0) + (b1 ? 4 : 0) + (b2 ? 8 : 0);
    const unsigned char* ubase = p.u8 + (size_t)s * (16384 * 128) + c * 16;
    const int stride = nlb * 4, t0 = lb * 4 + wid;
    const int ntok = (T_TOK - t0 + stride - 1) / stride;
    if (ntok <= 0) return;
    LDS_AS unsigned char* ring = (LDS_AS unsigned char*)smem + wid * 2048;
    const int* idg = p.ids + 2 * lane;
    const bf16_t* xg = p.x1b + s * 128 + 2 * lane;
#define PU_TOK(n) (t0 + ((n) < ntok ? (n) : ntok - 1) * stride)
#define PU_RAW_LD(n, ri, rx) do { const int _t = PU_TOK(n); ri = *(const u32x2*)(idg + (size_t)_t * 128); const unsigned _w = *(const unsigned*)(xg + (size_t)_t * DM); rx = (u32x2){_w << 16, _w & 0xffff0000u}; } while (0)
#define PU_RAW_ST(n, ri, rx) do { LDS_AS unsigned char* _b = ring + ((n) & 1) * 1024; *(LDS_AS u32x2*)(_b + lane * 8) = ri; *(LDS_AS u32x2*)(_b + 512 + lane * 8) = rx; } while (0)
#define PU_IDS(n, idv) do { const LDS_AS u32x4* _q = (const LDS_AS u32x4*)(ring + ((n) & 1) * 1024 + g * 64); \
        _Pragma("unroll") for (int _k = 0; _k < 4; ++_k) { const u32x4 _v = _q[_k]; idv[4 * _k] = (int)_v[0]; idv[4 * _k + 1] = (int)_v[1]; idv[4 * _k + 2] = (int)_v[2]; idv[4 * _k + 3] = (int)_v[3]; } } while (0)
    u32x4 wA[8], wB[8]; u32x2 ri, rx;
    {
        u32x2 i0, x0, i1, x1v;
        PU_RAW_LD(0, i0, x0); PU_RAW_LD(1, i1, x1v); PU_RAW_LD(2, ri, rx);
        PU_RAW_ST(0, i0, x0); PU_RAW_ST(1, i1, x1v);
        int id0[16]; PU_IDS(0, id0);
#pragma unroll
        for (int i = 0; i < 8; ++i) wA[i] = *(const u32x4*)(ubase + (size_t)id0[i] * 128);
#pragma unroll
        for (int i = 0; i < 8; ++i) wB[i] = *(const u32x4*)(ubase + (size_t)id0[8 + i] * 128);
    }
#pragma unroll 1
    for (int n = 0; n < ntok; ++n) {
        const int t = t0 + n * stride;
        f32x2 x[8];
        {
            const LDS_AS f32x4* q = (const LDS_AS f32x4*)(ring + (n & 1) * 1024 + 512 + c * 64);
#pragma unroll
            for (int k = 0; k < 4; ++k) { const f32x4 v4 = q[k]; x[2 * k] = (f32x2){v4[0], v4[1]}; x[2 * k + 1] = (f32x2){v4[2], v4[3]}; }
        }
        int idn[16]; PU_IDS(n + 1, idn);
        float v[16];
#pragma unroll
        for (int i = 0; i < 8; ++i) { const f32x2 a = row_dot(wA[i], x, (f32x2){0.f, 0.f}); v[i] = a.x + a.y; }
#pragma unroll
        for (int i = 0; i < 8; ++i) wA[i] = *(const u32x4*)(ubase + (size_t)idn[i] * 128);
#pragma unroll
        for (int i = 0; i < 8; ++i) { const f32x2 a = row_dot(wB[i], x, (f32x2){0.f, 0.f}); v[8 + i] = a.x + a.y; }
#pragma unroll
        for (int i = 0; i < 8; ++i) wB[i] = *(const u32x4*)(ubase + (size_t)idn[8 + i] * 128);
        PU_RAW_ST(n + 2, ri, rx);
        PU_RAW_LD(n + 3, ri, rx);
#pragma unroll
        for (int i = 0; i < 8; ++i) { const float keep = b2 ? v[i + 8] : v[i], send = b2 ? v[i] : v[i + 8]; v[i] = keep + __shfl_xor(send, 4); }
#pragma unroll
        for (int i = 0; i < 4; ++i) { const float keep = b1 ? v[i + 4] : v[i], send = b1 ? v[i] : v[i + 4]; v[i] = keep + __shfl_xor(send, 2); }
#pragma unroll
        for (int i = 0; i < 2; ++i) { const float keep = b0 ? v[i + 2] : v[i], send = b0 ? v[i] : v[i + 2]; v[i] = keep + __shfl_xor(send, 1); }
        *(unsigned*)(p.hp + ((size_t)t * 8 + s) * 128 + g * 16 + cc) = pack2(v[0], v[1]);
    }
}
__device__ void ph_peer_act(const Params& p, const int vb) {
    const int lane = threadIdx.x & 63, wid = threadIdx.x >> 6;
    for (int t = vb * 4 + wid; t < T_TOK; t += gridDim.x * 4) {
        f32x2 h = {0.f, 0.f};
#pragma unroll
        for (int s = 0; s < 8; ++s) { const unsigned w = *(const unsigned*)(p.hp + ((size_t)t * 8 + s) * 128 + 2 * lane); h += (f32x2){bflo(w), bfhi(w)}; }
        const int2 id = *(const int2*)(p.ids + (size_t)t * 128 + 2 * lane);
        const f32x2 gt = *(const f32x2*)(p.gates + (size_t)t * 128 + 2 * lane);
        f32x2 a;
        a.x = gelu_gate(h.x * p.su[id.x], gt.x) * p.sv[id.x];
        a.y = gelu_gate(h.y * p.su[id.y], gt.y) * p.sv[id.y];
        *(f32x2*)(p.gates + (size_t)t * 128 + 2 * lane) = a;
    }
}
__device__ void ph_peer_v(const Params& p, unsigned char* smem, const int vb) {
    const int lane = threadIdx.x & 63, wid = __builtin_amdgcn_readfirstlane(threadIdx.x >> 6), g = lane >> 3, c = lane & 7;
    const int nlb = gridDim.x >> 3, s = vb / nlb, lb = vb - s * nlb;
    const bool b4 = (lane & 16) != 0, b3 = (lane & 8) != 0;
    const unsigned char* vbase = p.v8 + (size_t)s * (16384 * 128) + c * 16;
    const int stride = nlb * 4, t0 = lb * 4 + wid;
    const int ntok = (T_TOK - t0 + stride - 1) / stride;
    if (ntok <= 0) return;
    const int d0 = s * 128 + c * 16 + 2 * g;
    LDS_AS unsigned char* ring = (LDS_AS unsigned char*)smem + wid * 2048;
    const int* idg = p.ids + 2 * lane;
    const float* ag = p.gates + 2 * lane;
#define PV_RAW_LD(n, ri, rx) do { const int _t = PU_TOK(n); ri = *(const u32x2*)(idg + (size_t)_t * 128); rx = *(const u32x2*)(ag + (size_t)_t * 128); } while (0)
    u32x4 wA[8], wB[8]; u32x2 ri, rx;
    {
        u32x2 i0, x0, i1, x1v;
        PV_RAW_LD(0, i0, x0); PV_RAW_LD(1, i1, x1v); PV_RAW_LD(2, ri, rx);
        PU_RAW_ST(0, i0, x0); PU_RAW_ST(1, i1, x1v);
        int id0[16]; PU_IDS(0, id0);
#pragma unroll
        for (int i = 0; i < 8; ++i) wA[i] = *(const u32x4*)(vbase + (size_t)id0[i] * 128);
#pragma unroll
        for (int i = 0; i < 8; ++i) wB[i] = *(const u32x4*)(vbase + (size_t)id0[8 + i] * 128);
    }
#pragma unroll 1
    for (int n = 0; n < ntok; ++n) {
        const int t = t0 + n * stride;
        const unsigned xw = *(const unsigned*)(p.x1b + (size_t)t * DM + d0);
        const f32x2 xv = {bflo(xw), bfhi(xw)};
        float ac[16];
        {
            const LDS_AS f32x4* q = (const LDS_AS f32x4*)(ring + (n & 1) * 1024 + 512 + g * 64);
#pragma unroll
            for (int k = 0; k < 4; ++k) { const f32x4 v4 = q[k]; ac[4 * k] = v4[0]; ac[4 * k + 1] = v4[1]; ac[4 * k + 2] = v4[2]; ac[4 * k + 3] = v4[3]; }
        }
        int idn[16]; PU_IDS(n + 1, idn);
        f32x2 acc[8];
#pragma unroll
        for (int k = 0; k < 8; ++k) acc[k] = (f32x2){0.f, 0.f};
#pragma unroll
        for (int i = 0; i < 8; ++i) {
            const f32x2 a2 = {ac[i], ac[i]};
#pragma unroll
            for (int k = 0; k < 4; ++k) {
                acc[2 * k] = __builtin_amdgcn_cvt_pk_f32_fp8(wA[i][k], false) * a2 + acc[2 * k];
                acc[2 * k + 1] = __builtin_amdgcn_cvt_pk_f32_fp8(wA[i][k], true) * a2 + acc[2 * k + 1];
            }
        }
#pragma unroll
        for (int i = 0; i < 8; ++i) wA[i] = *(const u32x4*)(vbase + (size_t)idn[i] * 128);
#pragma unroll
        for (int i = 0; i < 8; ++i) {
            const f32x2 a2 = {ac[8 + i], ac[8 + i]};
#pragma unroll
            for (int k = 0; k < 4; ++k) {
                acc[2 * k] = __builtin_amdgcn_cvt_pk_f32_fp8(wB[i][k], false) * a2 + acc[2 * k];
                acc[2 * k + 1] = __builtin_amdgcn_cvt_pk_f32_fp8(wB[i][k], true) * a2 + acc[2 * k + 1];
            }
        }
#pragma unroll
        for (int i = 0; i < 8; ++i) wB[i] = *(const u32x4*)(vbase + (size_t)idn[8 + i] * 128);
        PU_RAW_ST(n + 2, ri, rx);
        PV_RAW_LD(n + 3, ri, rx);
        float v[16];
#pragma unroll
        for (int k = 0; k < 8; ++k) { v[2 * k] = acc[k].x; v[2 * k + 1] = acc[k].y; }
#pragma unroll
        for (int j2 = 0; j2 < 8; ++j2) {
            auto r = __builtin_amdgcn_permlane32_swap(__float_as_uint(v[j2]), __float_as_uint(v[j2 + 8]), false, false);
            v[j2] = __uint_as_float(r[0]) + __uint_as_float(r[1]);
        }
#pragma unroll
        for (int j2 = 0; j2 < 4; ++j2) { const float keep = b4 ? v[j2 + 4] : v[j2], send = b4 ? v[j2] : v[j2 + 4]; v[j2] = keep + __shfl_xor(send, 16); }
#pragma unroll
        for (int j2 = 0; j2 < 2; ++j2) { const float keep = b3 ? v[j2 + 2] : v[j2], send = b3 ? v[j2] : v[j2 + 2]; v[j2] = keep + __shfl_xor(send, 8); }
        const float r0 = ALPHA * xv.x + v[0], r1 = ALPHA * xv.y + v[1];
        *(unsigned*)(p.rb + (size_t)t * DM + d0) = pack2(r0, r1);
    }
}

__device__ void ph_gemm_ple(const Params& p, unsigned char* smem, const int vb) {
    const int ntn = DM / 128;
    const int tid = threadIdx.x, lane = tid & 63, wid = tid >> 6, wr = wid >> 1, wc = wid & 1, fr = lane & 15, fq = lane >> 4;
    const int ntiles = (T_TOK / 128) * ntn;
    bool pre = false;
    for (int t = vb; t < ntiles; t += gridDim.x) {
        const int m0 = (t / ntn) * 128, n0 = (t % ntn) * 128;
        const int tn = t + gridDim.x;
        const bool has_next = tn < ntiles;
        const bf16_t* nA = p.pb + (size_t)((has_next ? tn : t) / ntn) * 128 * 256;
        const bf16_t* nB = p.WpT + (size_t)((has_next ? tn : t) % ntn) * 128 * 256;
        const bf16_t* gA = p.rb + (size_t)m0 * DM; const bf16_t* gB = p.WgT + (size_t)n0 * DM;
        f32x4 acc[4][4], acc2[4][4]; zero_acc(acc); zero_acc(acc2);
        if (pre) gemm128<true, true>(p.pb + (size_t)m0 * 256, 256, p.WpT + (size_t)n0 * 256, 256, 256, smem, acc2, gA, DM, gB, DM);
        else     gemm128<false, true>(p.pb + (size_t)m0 * 256, 256, p.WpT + (size_t)n0 * 256, 256, 256, smem, acc2, gA, DM, gB, DM);
        if (has_next) gemm128<true, true>(gA, DM, gB, DM, DM, smem, acc, nA, 256, nB, 256);
        else          gemm128<true, false>(gA, DM, gB, DM, DM, smem, acc);
        pre = has_next;
#pragma unroll
        for (int mi = 0; mi < 4; ++mi) {
            const int row = m0 + wr * 64 + mi * 16 + fr;
#pragma unroll
            for (int ni = 0; ni < 4; ++ni) {
                const int col = n0 + wc * 64 + ni * 16 + fq * 4;
                const u32x2 rw = *(const u32x2*)(p.rb + (size_t)row * DM + col);
                f32x4 rv = {bflo(rw[0]), bfhi(rw[0]), bflo(rw[1]), bfhi(rw[1])};
#pragma unroll
                for (int r = 0; r < 4; ++r) rv[r] += sigmul(acc2[mi][ni][r], acc[mi][ni][r]);
                *(f32x4*)(p.out + (size_t)row * DM + col) = rv;
            }
        }
    }
}

#define XB_TMO      128
#define XB_XCNT(j)  (256  + 64 * (j))
#define XB_XSUB(j)  (1280 + 64 * (j))
#define XB_XGEN(j)  (2304 + 64 * (j))
#define XB_TOP      3328
#define XB_TOPGEN   3392
#define XCD_BAR_WORDS 3456
#define XB_SPIN_CAP (1u << 20)
__device__ __forceinline__ unsigned xb_ld(unsigned* p)              { return __hip_atomic_load(p, __ATOMIC_RELAXED, __HIP_MEMORY_SCOPE_AGENT); }
__device__ __forceinline__ unsigned xb_add(unsigned* p, unsigned v) { return __hip_atomic_fetch_add(p, v, __ATOMIC_RELAXED, __HIP_MEMORY_SCOPE_AGENT); }
__device__ __forceinline__ unsigned xb_xcc_id() { return (unsigned)__builtin_amdgcn_s_getreg((3 << 11) | 20) & 0xFu; }
#define XB_SPIN(cond, bar) do { unsigned _sp = 0; while (cond) { __builtin_amdgcn_s_sleep(1); \
    if ((++_sp & 255u) == 0u) { if (xb_ld(&(bar)[XB_TMO])) break; if (_sp > XB_SPIN_CAP) { atomicAdd(&(bar)[XB_TMO], 1u); break; } } } } while (0)
struct XcdBarrier { unsigned* bar; unsigned x; volatile LDS_AS unsigned* st; };
__device__ __forceinline__ XcdBarrier xcd_barrier_post(unsigned* bar, volatile LDS_AS unsigned* st) {
    XcdBarrier b; b.bar = bar; b.x = xb_xcc_id(); b.st = st;
    if (threadIdx.x == 0) st[3] = xb_add(&bar[XB_XCNT(b.x)], 1u);
    return b;
}
__device__ __forceinline__ void xcd_barrier_complete(unsigned* bar, unsigned x, unsigned rank, unsigned& nloc, unsigned& nx, unsigned& vb) {
    const unsigned G = gridDim.x;
    unsigned sum, cnt, mine, sp = 0u; bool even;
    for (;;) {
        sum = 0u; cnt = 0u; mine = 0u; even = true;
#pragma unroll
        for (unsigned j = 0; j < 16; ++j) {
            const unsigned c = xb_ld(&bar[XB_XCNT(j)]); sum += c; cnt += (c > 0u) ? 1u : 0u; mine = (j == x) ? c : mine;
            even = even && (c == ((j < 8u) ? (G >> 3) : 0u));
        }
        if (sum == G) break;
        __builtin_amdgcn_s_sleep(1);
        if ((++sp & 255u) == 0u) { if (xb_ld(&bar[XB_TMO])) break; if (sp > XB_SPIN_CAP) { atomicAdd(&bar[XB_TMO], 1u); break; } }
    }
    nloc = mine > 0u ? mine : 1u; nx = cnt > 0u ? cnt : 1u;
    vb = (even && sum == G && (G & 7u) == 0u) ? (x * (G >> 3) + rank) : blockIdx.x;
}
__device__ __forceinline__ void xcd_barrier(const XcdBarrier& b) {
    asm volatile("s_waitcnt vmcnt(0)" ::: "memory");
    __syncthreads();
    if (threadIdx.x == 0) {
        unsigned* bar = b.bar;
        __builtin_amdgcn_s_waitcnt(0);
        unsigned nloc = b.st[0], nx = b.st[1];
        if (nloc == 0u) { unsigned vb; xcd_barrier_complete(bar, b.x, b.st[3], nloc, nx, vb); b.st[0] = nloc; b.st[1] = nx; b.st[2] = vb; }
        const unsigned old = xb_add(&bar[XB_XSUB(b.x)], 1u);
        const unsigned gen = old / nloc;
        if (old + 1u == (gen + 1u) * nloc) {
            __builtin_amdgcn_fence(__ATOMIC_RELEASE, "agent");
            asm volatile("s_waitcnt vmcnt(0)" ::: "memory");
            const unsigned og = xb_add(&bar[XB_TOP], 1u);
            const unsigned tg = og / nx;
            if (og + 1u == (tg + 1u) * nx) xb_add(&bar[XB_TOPGEN], 1u);
            else XB_SPIN(xb_ld(&bar[XB_TOPGEN]) == tg, bar);
            __builtin_amdgcn_fence(__ATOMIC_ACQUIRE, "agent");
            xb_add(&bar[XB_XGEN(b.x)], 1u);
            asm volatile("s_waitcnt vmcnt(0)" ::: "memory");
        } else {
            XB_SPIN(xb_ld(&bar[XB_XGEN(b.x)]) == gen, bar);
            __builtin_amdgcn_fence(__ATOMIC_ACQUIRE, "agent");
            asm volatile("s_waitcnt vmcnt(0)" ::: "memory");
        }
    }
    __syncthreads();
}

#define SMEM_PHASE (256 * ASTR * 2 * 2)
#define SMEM_BYTES (SMEM_PHASE + 16)
__global__ void __launch_bounds__(256, 2) mega(Params p) {
    __shared__ __attribute__((aligned(16))) unsigned char smem[SMEM_BYTES];
    volatile LDS_AS unsigned* st = (volatile LDS_AS unsigned*)(LDS_AS unsigned char*)(smem + SMEM_PHASE);
    if (threadIdx.x < 4) st[threadIdx.x] = 0u;
    __syncthreads();
    const XcdBarrier gb = xcd_barrier_post(p.bar, st);
    ph_prep(p, smem);            xcd_barrier(gb);
    const int vb = (int)st[2];
    ph_gemm_in(p, smem, vb);     xcd_barrier(gb);
    ph_attn(p, smem, vb);
    ph_conv(p, smem, vb);        xcd_barrier(gb);
    ph_gemm_out(p, smem, vb);    xcd_barrier(gb);
    ph_mprep(p, smem, vb);
    ph_ln1(p, vb);               xcd_barrier(gb);
    ph_route(p, smem, vb);       xcd_barrier(gb);
    ph_peer_u(p, smem, vb);      xcd_barrier(gb);
    ph_peer_act(p, vb);          xcd_barrier(gb);
    ph_peer_v(p, smem, vb);      xcd_barrier(gb);
    ph_gemm_ple(p, smem, vb);    xcd_barrier(gb);
    ph_ln2(p, vb);
}

extern "C" void kernel_launch(void* const* d_in, const int* in_sizes, int n_in, void* d_out, int out_size, void* d_ws, size_t ws_size,
                              hipStream_t stream) {
    Params p{};
    p.x = (const float*)d_in[0]; p.p = (const float*)d_in[1]; p.pos = (const int*)d_in[2];
    p.w_in = (const float*)d_in[3]; p.sinks = (const float*)d_in[4]; p.conv_w = (const float*)d_in[5]; p.conv_b = (const float*)d_in[6];
    p.cln_g = (const float*)d_in[7]; p.cln_b = (const float*)d_in[8]; p.w_out = (const float*)d_in[9]; p.ln1_g = (const float*)d_in[10];
    p.ln1_b = (const float*)d_in[11]; p.wq = (const float*)d_in[12]; p.keys = (const float*)d_in[13]; p.pu = (const float*)d_in[14];
    p.pv = (const float*)d_in[15]; p.ple_proj = (const float*)d_in[16]; p.ple_gate = (const float*)d_in[17]; p.ln2_g = (const float*)d_in[18];
    p.ln2_b = (const float*)d_in[19];
    p.out = (float*)d_out;
    unsigned char* ws = (unsigned char*)d_ws;
    const size_t MiB = 1024 * 1024;
    p.y1 = (float*)(ws + 0 * MiB);
    p.hb = (bf16_t*)(ws + 128 * MiB);
    p.hp = (bf16_t*)(ws + 128 * MiB);
    p.xb = (bf16_t*)(ws + 256 * MiB);
    p.x1b = (bf16_t*)(ws + 256 * MiB);
    p.mixb = (bf16_t*)(ws + 320 * MiB);
    p.rb = (bf16_t*)(ws + 320 * MiB);
    p.pb = (bf16_t*)(ws + 384 * MiB);
    p.u8 = (unsigned char*)(ws + 400 * MiB);
    p.v8 = (unsigned char*)(ws + 416 * MiB);
    p.su = (float*)(ws + 432 * MiB);
    p.sv = (float*)(ws + 433 * MiB);
    p.ids = (int*)(ws + 464 * MiB);
    p.gates = (float*)(ws + 480 * MiB);
    unsigned char* wb = ws + 496 * MiB;
    p.WinT = (bf16_t*)wb; wb += (size_t)INW * DM * 2;
    p.WoutT = (bf16_t*)wb; wb += (size_t)DM * DM * 2;
    p.WgT = (bf16_t*)wb; wb += (size_t)DM * DM * 2;
    p.WpT = (bf16_t*)wb; wb += (size_t)DM * 256 * 2;
    p.keysb = (bf16_t*)wb; wb += (size_t)16 * 128 * 128 * 2;
    p.Wqb = (bf16_t*)(ws + 240 * MiB);
    p.MT = (bf16_t*)(ws + 244 * MiB);
    p.bar = (unsigned*)(ws + 510 * MiB);

    static int grid_blocks = 0;
    if (!grid_blocks) {
        int dev = 0, cus = 0, per_cu = 0;
        (void)hipGetDevice(&dev);
        (void)hipDeviceGetAttribute(&cus, hipDeviceAttributeMultiprocessorCount, dev);
        (void)hipOccupancyMaxActiveBlocksPerMultiprocessor(&per_cu, mega, 256, 0);
        if (per_cu > 2) per_cu = 2;
        grid_blocks = cus * per_cu;
    }
    (void)hipMemsetAsync(p.bar, 0, XCD_BAR_WORDS * sizeof(unsigned), stream);
    void* args[] = {&p};
    hipError_t e = hipLaunchCooperativeKernel((void*)mega, dim3(grid_blocks), dim3(256), args, 0, stream);
    if (e != hipSuccess) fprintf(stderr, "cooperative launch failed: %s (grid %d)\n", hipGetErrorString(e), grid_blocks);
}
```

```cpp
#include <hip/hip_runtime.h>
#include <stdint.h>
#include <cstdio>

typedef unsigned short bf16_t;
typedef short bf16x8 __attribute__((ext_vector_type(8)));
typedef float f32x4 __attribute__((ext_vector_type(4)));
typedef unsigned u32x4 __attribute__((ext_vector_type(4)));
typedef float f32x2 __attribute__((ext_vector_type(2)));

#define T_TOK 32768
#define SEQ 2048
#define DM 1024
#define INW 1792
#define ALPHA 1.189207115002721f
#define LN_EPS 1e-5f

__device__ __forceinline__ bf16_t f2bf(float f) {
    unsigned u = __float_as_uint(f);
    u += 0x7fffu + ((u >> 16) & 1u);
    return (bf16_t)(u >> 16);
}
__device__ __forceinline__ float bf2f(bf16_t b) { return __uint_as_float(((unsigned)b) << 16); }
__device__ __forceinline__ float bflo(unsigned w) { return __uint_as_float(w << 16); }
__device__ __forceinline__ float bfhi(unsigned w) { return __uint_as_float(w & 0xffff0000u); }
__device__ __forceinline__ unsigned pack2(float a, float b) { return (unsigned)f2bf(a) | ((unsigned)f2bf(b) << 16); }

__device__ __forceinline__ float sigmul(float x, float g) { return x * __builtin_amdgcn_rcpf(1.0f + __expf(-g)); }
__device__ __forceinline__ float wave_sum(float v) {
#pragma unroll
    for (int o = 32; o >= 1; o >>= 1) v += __shfl_xor(v, o);
    return v;
}

struct Params {
    const float *x, *p; const int* pos;
    const float *w_in, *sinks, *conv_w, *conv_b, *cln_g, *cln_b, *w_out, *ln1_g, *ln1_b;
    const float *wq, *keys, *pu, *pv, *ple_proj, *ple_gate, *ln2_g, *ln2_b;
    float* out;
    bf16_t *xb, *pb, *WinT, *WoutT, *WgT, *WpT, *keysb, *Wqb, *MT, *hb, *mixb, *rb;
    float *y1, *gates, *rope, *stats, *wgb;
    bf16_t *y1b, *yext, *mext; unsigned* cb2;
    bf16_t* sc2;
    bf16_t* hp;
    int *ids;
    unsigned char *u8, *v8;
    unsigned* bar;
};

__device__ void cvt_rows(const float* __restrict__ src, bf16_t* __restrict__ dst, size_t n) {
    const size_t nv = n / 8, gs = (size_t)gridDim.x * blockDim.x;
    for (size_t i = (size_t)blockIdx.x * blockDim.x + threadIdx.x; i < nv; i += 4 * gs) {
        f32x4 a[4], b[4];
#pragma unroll
        for (int q = 0; q < 4; ++q) { const size_t k = (i + q * gs < nv) ? i + q * gs : i; a[q] = ((const f32x4*)src)[2 * k]; b[q] = ((const f32x4*)src)[2 * k + 1]; }
#pragma unroll
        for (int q = 0; q < 4; ++q) {
            if (i + q * gs < nv) {
                u32x4 o; o[0] = pack2(a[q][0], a[q][1]); o[1] = pack2(a[q][2], a[q][3]); o[2] = pack2(b[q][0], b[q][1]); o[3] = pack2(b[q][2], b[q][3]);
                ((u32x4*)dst)[i + q * gs] = o;
            }
        }
    }
}
__device__ __forceinline__ int win_row(int n) {
    if (n < 768) return n;
    const int isg = n >= 1280 ? 1 : 0, c = n - (isg ? 1280 : 768);
    const int tt = c >> 6, wc = (c >> 5) & 1, k2 = (c >> 4) & 1, rest = c & 15;
    return 768 + 128 * tt + wc * 64 + (k2 * 2 + isg) * 16 + rest;
}
template <bool WIN = false>
__device__ void transpose_cvt(const float* __restrict__ W, bf16_t* __restrict__ Wt, int K, int N, float* tile  ) {
    const int tk = K / 64, tn = N / 64;
    const int tid = threadIdx.x;
    for (int t = blockIdx.x; t < tk * tn; t += gridDim.x) {
        const int k0 = (t / tn) * 64, n0 = (t % tn) * 64;
        f32x4 v[4];
#pragma unroll
        for (int i = 0; i < 4; ++i) v[i] = *(const f32x4*)(W + (size_t)(k0 + (tid >> 4) + 16 * i) * N + n0 + (tid & 15) * 4);
        __syncthreads();
#pragma unroll
        for (int i = 0; i < 4; ++i)
#pragma unroll
            for (int j = 0; j < 4; ++j) tile[((tid >> 4) + 16 * i) * 65 + (tid & 15) * 4 + j] = v[i][j];
        __syncthreads();
        const int n = tid >> 2, kc = (tid & 3) * 16;
        u32x4 o0, o1;
#pragma unroll
        for (int q = 0; q < 4; ++q) {
            o0[q] = pack2(tile[(kc + 2 * q) * 65 + n], tile[(kc + 2 * q + 1) * 65 + n]);
            o1[q] = pack2(tile[(kc + 8 + 2 * q) * 65 + n], tile[(kc + 8 + 2 * q + 1) * 65 + n]);
        }
        const int nd = WIN ? win_row(n0 + n) : n0 + n;
        *(u32x4*)(Wt + (size_t)nd * K + k0 + kc) = o0;
        *(u32x4*)(Wt + (size_t)nd * K + k0 + kc + 8) = o1;
    }
}
__device__ void cvt_wq_fold(const Params& p, unsigned char* smem) {
    for (int i = blockIdx.x * 256 + threadIdx.x; i < DM * 256; i += gridDim.x * 256) {
        const int d = i >> 8, c8 = (i & 255) * 8;
        const float gd = p.ln1_g[d];
        const f32x4 a = *(const f32x4*)(p.wq + (size_t)d * 2048 + c8), b = *(const f32x4*)(p.wq + (size_t)d * 2048 + c8 + 4);
        u32x4 o; o[0] = pack2(a[0] * gd, a[1] * gd); o[1] = pack2(a[2] * gd, a[3] * gd); o[2] = pack2(b[0] * gd, b[1] * gd); o[3] = pack2(b[2] * gd, b[3] * gd);
        *(u32x4*)(p.Wqb + (size_t)d * 2048 + c8) = o;
    }
    float* red = (float*)smem;
    const int lane = threadIdx.x & 63, wid = threadIdx.x >> 6;
    for (int cb = blockIdx.x; cb < 512; cb += gridDim.x) {
        f32x4 sg = {0.f, 0.f, 0.f, 0.f}, sb = {0.f, 0.f, 0.f, 0.f};
#pragma unroll
        for (int q = 0; q < 4; ++q) {
            const int d = threadIdx.x * 4 + q;
            const f32x4 v = *(const f32x4*)(p.wq + (size_t)d * 2048 + cb * 4);
            sg += v * p.ln1_g[d]; sb += v * p.ln1_b[d];
        }
        __syncthreads();
#pragma unroll
        for (int q = 0; q < 4; ++q) {
            const float a = wave_sum(sg[q]), b = wave_sum(sb[q]);
            if (lane == 0) { red[wid * 8 + q] = a; red[wid * 8 + 4 + q] = b; }
        }
        __syncthreads();
        if (threadIdx.x < 8) {
            const float t = (red[threadIdx.x] + red[8 + threadIdx.x]) + (red[16 + threadIdx.x] + red[24 + threadIdx.x]);
            p.wgb[(threadIdx.x >> 2) * 2048 + cb * 4 + (threadIdx.x & 3)] = t;
        }
    }
}
template <bool FOLD>
__device__ void cvt_table_fp8(const Params& p, const float* __restrict__ src, unsigned char* __restrict__ dst, bf16_t* __restrict__ scl, int rows) {
    const int lane = threadIdx.x & 63, wid = threadIdx.x >> 6;
    const int nw = gridDim.x * 4;
    for (int r0 = blockIdx.x * 4 + wid; r0 < rows; r0 += 4 * nw) {
        f32x4 v[4][4];
#pragma unroll
        for (int q = 0; q < 4; ++q) {
            const int r = (r0 + q * nw < rows) ? r0 + q * nw : r0;
            const float* sr = src + (size_t)r * DM + lane * 16;
#pragma unroll
            for (int k = 0; k < 4; ++k) v[q][k] = *(const f32x4*)(sr + 4 * k);
        }
        f32x4 gv[4], bv[4];
        if (FOLD) {
#pragma unroll
            for (int k = 0; k < 4; ++k) { gv[k] = *(const f32x4*)(p.ln1_g + lane * 16 + 4 * k); bv[k] = *(const f32x4*)(p.ln1_b + lane * 16 + 4 * k); }
        }
#pragma unroll
        for (int q = 0; q < 4; ++q) {
            const int r = r0 + q * nw;
            if (FOLD) {
                float cu = 0.f, bu = 0.f;
#pragma unroll
                for (int k = 0; k < 4; ++k) { bu += (bv[k][0] * v[q][k][0] + bv[k][1] * v[q][k][1]) + (bv[k][2] * v[q][k][2] + bv[k][3] * v[q][k][3]); v[q][k] = v[q][k] * gv[k]; cu += (v[q][k][0] + v[q][k][1]) + (v[q][k][2] + v[q][k][3]); }
                cu = wave_sum(cu); bu = wave_sum(bu);
                if (lane == 0 && r < rows) p.cb2[r] = pack2(cu, bu);
            }
            float m = 0.f;
#pragma unroll
            for (int k = 0; k < 4; ++k)
#pragma unroll
                for (int i = 0; i < 4; ++i) m = fmaxf(m, fabsf(v[q][k][i]));
#pragma unroll
            for (int o = 32; o >= 1; o >>= 1) m = fmaxf(m, __shfl_xor(m, o));
            int ex = (m > 0.f) ? (8 - (int)((__float_as_uint(m) >> 23) & 0xffu) + 127 - ((__float_as_uint(m) & 0x7fffffu) > 0x600000u ? 1 : 0)) : 0;
            ex = min(max(ex, -100), 100);
            const float sc = __uint_as_float((unsigned)(127 + ex) << 23);
            u32x4 w;
#pragma unroll
            for (int k = 0; k < 4; ++k)
                w[k] = __builtin_amdgcn_cvt_pk_fp8_f32(v[q][k][2] * sc, v[q][k][3] * sc, __builtin_amdgcn_cvt_pk_fp8_f32(v[q][k][0] * sc, v[q][k][1] * sc, 0, false), true);
            if (r < rows) {
                *(u32x4*)(dst + (size_t)(lane >> 3) * (16384 * 128) + (size_t)r * 128 + (lane & 7) * 16) = w;
                if (lane == 0) scl[2 * r] = (bf16_t)(((unsigned)(127 - ex) << 23) >> 16);
            }
        }
    }
}
__device__ void ph_prep(const Params& p, unsigned char* smem) {
    float* tile = (float*)smem;
    cvt_rows(p.x, p.xb, (size_t)T_TOK * DM);
    cvt_rows(p.p, p.pb, (size_t)T_TOK * 256);
    cvt_table_fp8<true>(p, p.pu, p.u8, p.sc2, 16384);
    cvt_table_fp8<false>(p, p.pv, p.v8, p.sc2 + 1, 16384);
    cvt_rows(p.keys, p.keysb, (size_t)16 * 128 * 128);
    for (int i = blockIdx.x * 256 + threadIdx.x; i < T_TOK * 8; i += gridDim.x * 256) {
        const int t = i >> 3, j = i & 7;
        const float inv = powf(500000.0f, -(float)j * 0.125f);
        float sn, cs; sincosf((float)p.pos[t] * inv, &sn, &cs);
        p.rope[t * 16 + j] = cs; p.rope[t * 16 + 8 + j] = sn;
    }
    transpose_cvt<true>(p.w_in, p.WinT, DM, INW, tile);
    transpose_cvt(p.w_out, p.WoutT, DM, DM, tile);
    cvt_wq_fold(p, smem);
    transpose_cvt(p.ple_gate, p.WgT, DM, DM, tile);
    transpose_cvt(p.ple_proj, p.WpT, 256, DM, tile);
}

#define LDS_AS __attribute__((address_space(3)))
#define GEMM_STAGE 32768
template <bool PRE = false, bool NEXT = false>
__device__ __forceinline__ void gemm128(const bf16_t* __restrict__ A, int lda, const bf16_t* __restrict__ Bt, int ldb, int K,
                                        unsigned char* smem, f32x4 (&acc)[4][4],
                                        const bf16_t* __restrict__ nA = nullptr, int nlda = 0, const bf16_t* __restrict__ nB = nullptr, int nldb = 0) {
    LDS_AS unsigned char* lds = (LDS_AS unsigned char*)smem;
    const int tid = threadIdx.x, lane = tid & 63, wid = __builtin_amdgcn_readfirstlane(tid >> 6);
    const int wr = wid >> 1, wc = wid & 1, fr = lane & 15, fq = lane >> 4;
    const int nk = K / 64;
    const int prow = lane >> 3, pc = (lane & 7) ^ prow;
    const bf16_t* gA = A + (size_t)(wid * 32 + prow) * lda + pc * 8;
    const bf16_t* gB = Bt + (size_t)(wid * 32 + prow) * ldb + pc * 8;
    const size_t a8 = (size_t)8 * lda, b8 = (size_t)8 * ldb;
#define GEMM_ISSUE(kt, st) do { \
        _Pragma("unroll") for (int _i = 0; _i < 4; ++_i) { \
            __builtin_amdgcn_global_load_lds((const unsigned*)(gA + _i * a8 + (size_t)(kt) * 64), (LDS_AS unsigned*)(lds + (st) * GEMM_STAGE + (wid * 4 + _i) * 1024), 16, 0, 0); \
            __builtin_amdgcn_global_load_lds((const unsigned*)(gB + _i * b8 + (size_t)(kt) * 64), (LDS_AS unsigned*)(lds + (st) * GEMM_STAGE + 16384 + (wid * 4 + _i) * 1024), 16, 0, 0); \
        } } while (0)
    const int swz0 = ((0 * 4 + fq) ^ (fr & 7)) * 16, swz1 = ((1 * 4 + fq) ^ (fr & 7)) * 16;
    const int aoff = (wr * 64 + fr) * 128, boff = 16384 + (wc * 64 + fr) * 128;
    if (!PRE) GEMM_ISSUE(0, 0);
#pragma unroll 1
    for (int kt = 0; kt < nk; ++kt) {
        const int st = kt & 1;
        asm volatile("s_waitcnt vmcnt(0)" ::: "memory");
        __builtin_amdgcn_s_barrier();
        asm volatile("" ::: "memory");
        if (kt + 1 < nk) GEMM_ISSUE(kt + 1, st ^ 1);
        else if (NEXT) {
            const bf16_t* qA = nA + (size_t)(wid * 32 + prow) * nlda + pc * 8;
            const bf16_t* qB = nB + (size_t)(wid * 32 + prow) * nldb + pc * 8;
#pragma unroll
            for (int _i = 0; _i < 4; ++_i) {
                __builtin_amdgcn_global_load_lds((const unsigned*)(qA + (size_t)(_i * 8) * nlda), (LDS_AS unsigned*)(lds + (wid * 4 + _i) * 1024), 16, 0, 0);
                __builtin_amdgcn_global_load_lds((const unsigned*)(qB + (size_t)(_i * 8) * nldb), (LDS_AS unsigned*)(lds + 16384 + (wid * 4 + _i) * 1024), 16, 0, 0);
            }
        }
        const LDS_AS unsigned char* sb = lds + st * GEMM_STAGE;
        bf16x8 af0[4], bf0[4], af1[4], bf1[4];
#pragma unroll
        for (int mi = 0; mi < 4; ++mi) af0[mi] = *(const LDS_AS bf16x8*)(sb + aoff + mi * 2048 + swz0);
#pragma unroll
        for (int ni = 0; ni < 4; ++ni) bf0[ni] = *(const LDS_AS bf16x8*)(sb + boff + ni * 2048 + swz0);
#pragma unroll
        for (int mi = 0; mi < 4; ++mi) af1[mi] = *(const LDS_AS bf16x8*)(sb + aoff + mi * 2048 + swz1);
#pragma unroll
        for (int ni = 0; ni < 4; ++ni) bf1[ni] = *(const LDS_AS bf16x8*)(sb + boff + ni * 2048 + swz1);
#pragma unroll
        for (int mi = 0; mi < 4; ++mi)
#pragma unroll
            for (int ni = 0; ni < 4; ++ni)
                acc[mi][ni] = __builtin_amdgcn_mfma_f32_16x16x32_bf16(bf0[ni], af0[mi], acc[mi][ni], 0, 0, 0);
#pragma unroll
        for (int mi = 0; mi < 4; ++mi)
#pragma unroll
            for (int ni = 0; ni < 4; ++ni)
                acc[mi][ni] = __builtin_amdgcn_mfma_f32_16x16x32_bf16(bf1[ni], af1[mi], acc[mi][ni], 0, 0, 0);
        __builtin_amdgcn_sched_group_barrier(0x100, 8, 0);
#pragma unroll
        for (int q = 0; q < 8; ++q) { __builtin_amdgcn_sched_group_barrier(0x008, 2, 0); __builtin_amdgcn_sched_group_barrier(0x100, 1, 0); }
        __builtin_amdgcn_sched_group_barrier(0x008, 16, 0);
        asm volatile("s_waitcnt lgkmcnt(0)" ::: "memory");
        __builtin_amdgcn_s_barrier();
        asm volatile("" ::: "memory");
    }
#undef GEMM_ISSUE
}
#define GW_STAGE 24576
__device__ __forceinline__ void gemmW(const bf16_t* __restrict__ A, int lda, const bf16_t* __restrict__ Bt, int ldb, int K,
                                      unsigned char* smem, f32x4 (&acc)[4][8]) {
    LDS_AS unsigned char* lds = (LDS_AS unsigned char*)smem;
    const int tid = threadIdx.x, lane = tid & 63, wid = __builtin_amdgcn_readfirstlane(tid >> 6);
    const int wr = wid >> 1, wc = wid & 1, fr = lane & 15, fq = lane >> 4;
    const int nk = K / 32;
    const int prow = lane >> 2, pc = (lane & 3) ^ ((4 - ((prow >> 2) & 3)) & 3);
    const bf16_t* gA = A + (size_t)(wid * 32 + prow) * lda + pc * 8;
    const bf16_t* gB = Bt + (size_t)(wid * 64 + prow) * ldb + pc * 8;
    const size_t a16 = (size_t)16 * lda, b16 = (size_t)16 * ldb;
#define GW_ISSUE(kt, st) do { \
        _Pragma("unroll") for (int _i = 0; _i < 2; ++_i) \
            __builtin_amdgcn_global_load_lds((const unsigned*)(gA + _i * a16 + (size_t)(kt) * 32), (LDS_AS unsigned*)(lds + (st) * GW_STAGE + (wid * 2 + _i) * 1024), 16, 0, 0); \
        _Pragma("unroll") for (int _i = 0; _i < 4; ++_i) \
            __builtin_amdgcn_global_load_lds((const unsigned*)(gB + _i * b16 + (size_t)(kt) * 32), (LDS_AS unsigned*)(lds + (st) * GW_STAGE + 8192 + (wid * 4 + _i) * 1024), 16, 0, 0); \
        } while (0)
    const int swz = (fq ^ ((4 - ((fr >> 2) & 3)) & 3)) * 16;
    const int aoff = (wr * 64 + fr) * 64 + swz, boff = 8192 + (wc * 128 + fr) * 64 + swz;
    GW_ISSUE(0, 0);
#pragma unroll 1
    for (int kt = 0; kt < nk; ++kt) {
        const int st = kt & 1;
        asm volatile("s_waitcnt vmcnt(0)" ::: "memory");
        __builtin_amdgcn_s_barrier();
        asm volatile("" ::: "memory");
        if (kt + 1 < nk) GW_ISSUE(kt + 1, st ^ 1);
        const LDS_AS unsigned char* sb = lds + st * GW_STAGE;
        bf16x8 af[4], bfr[8];
#pragma unroll
        for (int mi = 0; mi < 4; ++mi) af[mi] = *(const LDS_AS bf16x8*)(sb + aoff + mi * 1024);
#pragma unroll
        for (int ni = 0; ni < 8; ++ni) bfr[ni] = *(const LDS_AS bf16x8*)(sb + boff + ni * 1024);
#pragma unroll
        for (int ni = 0; ni < 8; ++ni)
#pragma unroll
            for (int mi = 0; mi < 4; ++mi)
                acc[mi][ni] = __builtin_amdgcn_mfma_f32_16x16x32_bf16(bfr[ni], af[mi], acc[mi][ni], 0, 0, 0);
        asm volatile("s_waitcnt lgkmcnt(0)" ::: "memory");
        __builtin_amdgcn_s_barrier();
        asm volatile("" ::: "memory");
    }
#undef GW_ISSUE
}
__device__ __forceinline__ void zero_accw(f32x4 (&acc)[4][8]) {
#pragma unroll
    for (int a = 0; a < 4; ++a)
#pragma unroll
        for (int b = 0; b < 8; ++b) acc[a][b] = (f32x4){0.f, 0.f, 0.f, 0.f};
}
__device__ __forceinline__ void zero_acc(f32x4 (&acc)[4][4]) {
#pragma unroll
    for (int a = 0; a < 4; ++a)
#pragma unroll
        for (int b = 0; b < 4; ++b) acc[a][b] = (f32x4){0.f, 0.f, 0.f, 0.f};
}
#define GEMM_SMEM (2 * GEMM_STAGE)

__device__ void ph_gemm_in(const Params& p, unsigned char* smem, const int vb) {
    const int ntn = INW / 128;
    const int tid = threadIdx.x, lane = tid & 63, wid = tid >> 6, wr = wid >> 1, wc = wid & 1, fr = lane & 15, fq = lane >> 4;
    const int ntiles = (T_TOK / 128) * ntn;
    bool pre = false;
    for (int t = vb; t < ntiles; t += gridDim.x) {
        const int m0 = (t / ntn) * 128, n0 = (t % ntn) * 128;
        const int tn = t + gridDim.x;
        const bool has_next = tn < ntiles;
        const bf16_t* nA = p.xb + (size_t)((has_next ? tn : t) / ntn) * 128 * DM;
        const bf16_t* nB = p.WinT + (size_t)((has_next ? tn : t) % ntn) * 128 * DM;
        f32x4 acc[4][4]; zero_acc(acc);
        if (pre) { if (has_next) gemm128<true, true>(p.xb + (size_t)m0 * DM, DM, p.WinT + (size_t)n0 * DM, DM, DM, smem, acc, nA, DM, nB, DM);
                   else          gemm128<true, false>(p.xb + (size_t)m0 * DM, DM, p.WinT + (size_t)n0 * DM, DM, DM, smem, acc); }
        else     { if (has_next) gemm128<false, true>(p.xb + (size_t)m0 * DM, DM, p.WinT + (size_t)n0 * DM, DM, DM, smem, acc, nA, DM, nB, DM);
                   else          gemm128<false, false>(p.xb + (size_t)m0 * DM, DM, p.WinT + (size_t)n0 * DM, DM, DM, smem, acc); }
        pre = has_next;
        if (n0 >= 768) {
            const int cb = ((n0 - 768) >> 7) * 64 + wc * 32 + fq * 4;
#pragma unroll
            for (int mi = 0; mi < 4; ++mi) {
                const int row = m0 + wr * 64 + mi * 16 + fr;
#pragma unroll
                for (int k2 = 0; k2 < 2; ++k2) {
                    const f32x4 a = acc[mi][2 * k2], gt = acc[mi][2 * k2 + 1];
                    uint2 o; o.x = pack2(sigmul(a[0], gt[0]), sigmul(a[1], gt[1])); o.y = pack2(sigmul(a[2], gt[2]), sigmul(a[3], gt[3]));
                    *(uint2*)(p.hb + (size_t)row * INW + 768 + cb + k2 * 16) = o;
                }
            }
        } else {
#pragma unroll
        for (int mi = 0; mi < 4; ++mi) {
            const int row = m0 + wr * 64 + mi * 16 + fr;
#pragma unroll
            for (int ni = 0; ni < 4; ++ni) {
                const int col0 = n0 + wc * 64 + ni * 16;
                f32x4 v = acc[mi][ni];
                if (col0 < 640 && (col0 & 63) == 0) {
                    const f32x4 cs = *(const f32x4*)(p.rope + (size_t)row * 16 + (fq & 1) * 4), sn = *(const f32x4*)(p.rope + (size_t)row * 16 + 8 + (fq & 1) * 4);
#pragma unroll
                    for (int r = 0; r < 4; ++r) {
                        const float other = __shfl_xor(v[r], 32);
                        v[r] = (fq < 2) ? (v[r] * cs[r] - other * sn[r]) : (v[r] * cs[r] + other * sn[r]);
                    }
                }
                uint2 o; o.x = pack2(v[0], v[1]); o.y = pack2(v[2], v[3]);
                *(uint2*)(p.hb + (size_t)row * INW + col0 + fq * 4) = o;
            }
        }
        }
    }
}

#define ASTR 72
#define VSTR 260
typedef float f32x16 __attribute__((ext_vector_type(16)));
typedef unsigned u32x2 __attribute__((ext_vector_type(2)));
__device__ void ph_attn(const Params& p, unsigned char* smem, const int vb) {
    bf16_t* sK = (bf16_t*)smem;
    bf16_t* sVt = sK + 256 * ASTR;
    const int tid = threadIdx.x, lane = tid & 63, wid = tid >> 6, r32 = lane & 31, hh = lane >> 5;
    const float C1 = 0.125f * 1.4426950408889634f, LOG2E = 1.4426950408889634f;
    for (int u = vb; u < 16 * 16 * 2; u += gridDim.x) {
        const int kvh = u & 1, nb = (u >> 1) & 15, b = u >> 5;
        __syncthreads();
        for (int c = tid; c < 256 * 8; c += 256) {
            const int li = c >> 3, kc = c & 7;
            const int pos = nb * 128 - 128 + li;
            u32x4 kv = {0u, 0u, 0u, 0u}, vv = {0u, 0u, 0u, 0u};
            if (pos >= 0) {
                const bf16_t* base = p.hb + (size_t)(b * SEQ + pos) * INW;
                kv = *(const u32x4*)(base + 512 + kvh * 64 + kc * 8);
                vv = *(const u32x4*)(base + 640 + kvh * 64 + kc * 8);
            }
            *(u32x4*)(sK + li * ASTR + kc * 8) = kv;
#pragma unroll
            for (int i = 0; i < 4; ++i) {
                sVt[(kc * 8 + 2 * i) * VSTR + li] = (bf16_t)(vv[i] & 0xffffu);
                sVt[(kc * 8 + 2 * i + 1) * VSTR + li] = (bf16_t)(vv[i] >> 16);
            }
        }
        __syncthreads();
        const int hq = kvh * 4 + wid;
        const float sink2 = p.sinks[hq] * LOG2E;
#pragma unroll 1
        for (int qt = 0; qt < 4; ++qt) {
            const size_t trow = (size_t)(b * SEQ + nb * 128 + qt * 32 + r32);
            bf16x8 qf[4];
#pragma unroll
            for (int ks = 0; ks < 4; ++ks) qf[ks] = *(const bf16x8*)(p.hb + trow * INW + hq * 64 + ks * 16 + hh * 8);
            f32x16 S[5];
#pragma unroll
            for (int j = 0; j < 5; ++j) {
#pragma unroll
                for (int r = 0; r < 16; ++r) S[j][r] = 0.f;
#pragma unroll
                for (int ks = 0; ks < 4; ++ks) {
                    const bf16x8 a = *(const bf16x8*)(sK + ((qt + j) * 32 + r32) * ASTR + ks * 16 + hh * 8);
                    S[j] = __builtin_amdgcn_mfma_f32_32x32x16_bf16(a, qf[ks], S[j], 0, 0, 0);
                }
            }
            float m2 = sink2;
#pragma unroll
            for (int j = 0; j < 5; ++j) {
                const bool tile_ok = (nb > 0) || (qt + j >= 4);
#pragma unroll
                for (int r = 0; r < 16; ++r) {
                    const int kl = (r & 3) + 8 * (r >> 2) + 4 * hh;
                    bool ok = tile_ok;
                    if (j == 0) ok = ok && (kl > r32);
                    if (j == 4) ok = ok && (kl <= r32);
                    const float t = ok ? S[j][r] * C1 : -1.0e30f;
                    S[j][r] = t;
                    m2 = fmaxf(m2, t);
                }
            }
            m2 = fmaxf(m2, __shfl_xor(m2, 32));
            float l = 0.f;
#pragma unroll
            for (int j = 0; j < 5; ++j)
#pragma unroll
                for (int r = 0; r < 16; ++r) { const float e = __builtin_amdgcn_exp2f(S[j][r] - m2); S[j][r] = e; l += e; }
            l += __shfl_xor(l, 32);
            l += __builtin_amdgcn_exp2f(sink2 - m2);
            f32x16 O[2];
#pragma unroll
            for (int dt = 0; dt < 2; ++dt)
#pragma unroll
                for (int r = 0; r < 16; ++r) O[dt][r] = 0.f;
#pragma unroll
            for (int j = 0; j < 5; ++j)
#pragma unroll
                for (int s2 = 0; s2 < 2; ++s2) {
                    u32x4 pw;
#pragma unroll
                    for (int k = 0; k < 4; ++k) pw[k] = pack2(S[j][8 * s2 + 2 * k], S[j][8 * s2 + 2 * k + 1]);
                    const bf16x8 pf = __builtin_bit_cast(bf16x8, pw);
                    const int kbase = (qt + j) * 32 + 16 * s2 + 4 * hh;
#pragma unroll
                    for (int dt = 0; dt < 2; ++dt) {
                        const bf16_t* vp = sVt + (dt * 32 + r32) * VSTR + kbase;
                        const u32x2 v0 = *(const u32x2*)(vp), v1 = *(const u32x2*)(vp + 8);
                        const u32x4 vw = {v0[0], v0[1], v1[0], v1[1]};
                        O[dt] = __builtin_amdgcn_mfma_f32_32x32x16_bf16(__builtin_bit_cast(bf16x8, vw), pf, O[dt], 0, 0, 0);
                    }
                }
            const float il = __builtin_amdgcn_rcpf(l);
#pragma unroll
            for (int dt = 0; dt < 2; ++dt)
#pragma unroll
                for (int g = 0; g < 4; ++g) {
                    u32x2 w;
                    w[0] = pack2(O[dt][4 * g] * il, O[dt][4 * g + 1] * il);
                    w[1] = pack2(O[dt][4 * g + 2] * il, O[dt][4 * g + 3] * il);
                    *(u32x2*)(p.mixb + trow * DM + hq * 64 + dt * 32 + 8 * g + 4 * hh) = w;
                }
        }
    }
}

#define CV_ROWS 62
__device__ void ph_conv(const Params& p, unsigned char* smem, const int vb) {
    bf16_t* gl = (bf16_t*)smem;
    float* red = (float*)(smem + CV_ROWS * 1024);
    const int tid = threadIdx.x, lane = tid & 63, wid = tid >> 6;
    const f32x2 lg = *(const f32x2*)(p.cln_g + 2 * tid), lb = *(const f32x2*)(p.cln_b + 2 * tid);
    for (int u = vb; u < T_TOK / 32; u += gridDim.x) {
        const int tok0 = u * 32, s0 = tok0 & (SEQ - 1);
        __syncthreads();
#pragma unroll 1
        for (int bt = 0; bt < 2; ++bt) {
            u32x4 av[8];
#pragma unroll
            for (int it = 0; it < 8; ++it) {
                const int ch = tid + (bt * 8 + it) * 256, row = min(ch >> 6, CV_ROWS - 1), k = ch & 63;
                const int rr = (s0 - 30 + row >= 0) ? row : 30;
                av[it] = *(const u32x4*)(p.hb + (size_t)(tok0 - 30 + rr) * INW + 768 + k * 8);
            }
#pragma unroll
            for (int it = 0; it < 8; ++it) {
                const int ch = tid + (bt * 8 + it) * 256, row = ch >> 6, k = ch & 63;
                const bool ok = (s0 - 30 + row >= 0);
                const u32x4 o = ok ? av[it] : (u32x4){0u, 0u, 0u, 0u};
                if (row < CV_ROWS) *(u32x4*)(gl + row * 512 + k * 8) = o;
            }
        }
        __syncthreads();
        float w0[31], w1[31];
#pragma unroll
        for (int k = 0; k < 31; ++k) { const f32x2 wv = *(const f32x2*)(p.conv_w + k * 512 + 2 * tid); w0[k] = wv.x; w1[k] = wv.y; }
        const f32x2 bias = *(const f32x2*)(p.conv_b + 2 * tid);
#pragma unroll 1
        for (int jh = 0; jh < 2; ++jh) {
            float a0[16], a1[16];
#pragma unroll
            for (int jl = 0; jl < 16; ++jl) { a0[jl] = bias.x; a1[jl] = bias.y; }
            const bf16_t* gp = gl + (jh * 16) * 512 + 2 * tid;
#pragma unroll
            for (int il = 0; il < 46; ++il) {
                const unsigned gw = *(const unsigned*)(gp + il * 512);
                const float g0 = bflo(gw), g1 = bfhi(gw);
#pragma unroll
                for (int jl = 0; jl < 16; ++jl)
                    if (il - jl >= 0 && il - jl <= 30) { a0[jl] += w0[il - jl] * g0; a1[jl] += w1[il - jl] * g1; }
                if ((il & 3) == 3) __builtin_amdgcn_sched_barrier(0);
            }
            float v[32];
#pragma unroll
            for (int jl = 0; jl < 16; ++jl) { v[jl] = a0[jl] + a1[jl]; v[16 + jl] = a0[jl] * a0[jl] + a1[jl] * a1[jl]; }
#pragma unroll
            for (int st = 16; st >= 1; st >>= 1) {
                const bool up = (lane & st) != 0;
#pragma unroll
                for (int i2 = 0; i2 < st; ++i2) {
                    const float keep = up ? v[i2 + st] : v[i2], send = up ? v[i2] : v[i2 + st];
                    v[i2] = keep + __shfl_xor(send, st);
                }
            }
            const float tot = v[0] + __shfl_xor(v[0], 32);
            __syncthreads();
            if (lane < 32) red[wid * 32 + lane] = tot;
            __syncthreads();
#pragma unroll
            for (int jl = 0; jl < 16; ++jl) {
                const float sm = (red[jl] + red[32 + jl]) + (red[64 + jl] + red[96 + jl]);
                const float sq = (red[16 + jl] + red[48 + jl]) + (red[80 + jl] + red[112 + jl]);
                const float mu = sm * (1.0f / 512.0f);
                const float rstd = rsqrtf(fmaxf(sq * (1.0f / 512.0f) - mu * mu, 0.f) + LN_EPS);
                const float y0 = (a0[jl] - mu) * rstd * lg.x + lb.x, y1 = (a1[jl] - mu) * rstd * lg.y + lb.y;
                *(unsigned*)(p.mixb + (size_t)(tok0 + jh * 16 + jl) * DM + 512 + 2 * tid) = pack2(sigmul(y0, y0), sigmul(y1, y1));
            }
        }
    }
}

__device__ void ph_gemm_out(const Params& p, unsigned char* smem, const int vb) {
    const int ntn = DM / 256;
    const int tid = threadIdx.x, lane = tid & 63, wid = tid >> 6, wr = wid >> 1, wc = wid & 1, fr = lane & 15, fq = lane >> 4;
    for (int t = vb; t < (T_TOK / 128) * ntn; t += gridDim.x) {
        const int m0 = (t / ntn) * 128, n0 = (t % ntn) * 256;
        f32x4 acc[4][8]; zero_accw(acc);
        gemmW(p.mixb + (size_t)m0 * DM, DM, p.WoutT + (size_t)n0 * DM, DM, DM, smem, acc);
#pragma unroll
        for (int mi = 0; mi < 4; ++mi) {
            const int row = m0 + wr * 64 + mi * 16 + fr;
            float sm = 0.f, sq = 0.f;
#pragma unroll
            for (int ni = 0; ni < 8; ++ni) {
                const int col = n0 + wc * 128 + ni * 16 + fq * 4;
                const f32x4 xv = *(const f32x4*)(p.x + (size_t)row * DM + col);
                const f32x4 y = xv * ALPHA + acc[mi][ni];
                sm += (y[0] + y[1]) + (y[2] + y[3]); sq += (y[0] * y[0] + y[1] * y[1]) + (y[2] * y[2] + y[3] * y[3]);
                u32x2 o; o[0] = pack2(y[0], y[1]); o[1] = pack2(y[2], y[3]);
                *(u32x2*)(p.y1b + (size_t)row * DM + col) = o;
            }
            sm += __shfl_xor(sm, 16); sq += __shfl_xor(sq, 16); sm += __shfl_xor(sm, 32); sq += __shfl_xor(sq, 32);
            if (fq == 0) *(f32x2*)(p.stats + (size_t)row * 16 + ((n0 >> 8) * 2 + wc) * 2) = (f32x2){sm, sq};
        }
    }
}

__device__ __forceinline__ void ln_row(const float* __restrict__ src, const float* __restrict__ g, const float* __restrict__ bta,
                                       float* __restrict__ dstf, bf16_t* __restrict__ dstb, int lane) {
    f32x4 v[4]; float s = 0.f;
#pragma unroll
    for (int i = 0; i < 4; ++i) { v[i] = *(const f32x4*)(src + i * 256 + lane * 4); s += (v[i][0] + v[i][1]) + (v[i][2] + v[i][3]); }
    const float mu = wave_sum(s) * (1.0f / 1024.0f);
    float q = 0.f;
#pragma unroll
    for (int i = 0; i < 4; ++i) { const f32x4 d = v[i] - mu; q += (d[0] * d[0] + d[1] * d[1]) + (d[2] * d[2] + d[3] * d[3]); }
    const float rstd = rsqrtf(wave_sum(q) * (1.0f / 1024.0f) + LN_EPS);
#pragma unroll
    for (int i = 0; i < 4; ++i) {
        const f32x4 gg = *(const f32x4*)(g + i * 256 + lane * 4), bb = *(const f32x4*)(bta + i * 256 + lane * 4);
        const f32x4 y = (v[i] - mu) * rstd * gg + bb;
        if (dstf) *(f32x4*)(dstf + i * 256 + lane * 4) = y;
        if (dstb) { uint2 o; o.x = pack2(y[0], y[1]); o.y = pack2(y[2], y[3]); *(uint2*)(dstb + i * 256 + lane * 4) = o; }
    }
}
__device__ void ph_ln2(const Params& p, const int vb) {
    const int lane = threadIdx.x & 63, wid = threadIdx.x >> 6;
    for (int r = vb * 4 + wid; r < T_TOK; r += gridDim.x * 4)
        ln_row(p.out + (size_t)r * DM, p.ln2_g, p.ln2_b, p.out + (size_t)r * DM, (bf16_t*)nullptr, lane);
}

#define QSTR 136
__device__ __forceinline__ int f2key(float f) { const int b = __float_as_int(f); return b ^ ((b >> 31) & 0x7fffffff); }
__device__ __forceinline__ float key2f(int k) { return __int_as_float(k ^ ((k >> 31) & 0x7fffffff)); }
__device__ __forceinline__ void sort16_desc(int (&a)[16]) {
#pragma unroll
    for (int lk = 1; lk <= 4; ++lk) {
#pragma unroll
        for (int lj = lk - 1; lj >= 0; --lj) {
            const int k = 1 << lk, j = 1 << lj;
#pragma unroll
            for (int i = 0; i < 16; ++i) {
                const int l = i ^ j;
                if (l > i) {
                    const int hi = max(a[i], a[l]), lo = min(a[i], a[l]);
                    if ((i & k) == 0) { a[i] = hi; a[l] = lo; } else { a[i] = lo; a[l] = hi; }
                }
            }
        }
    }
}
__device__ __forceinline__ void merge_top16(int (&a)[16], const int (&b)[16]) {
#pragma unroll
    for (int i = 0; i < 16; ++i) a[i] = max(a[i], b[15 - i]);
#pragma unroll
    for (int lj = 3; lj >= 0; --lj) {
        const int j = 1 << lj;
#pragma unroll
        for (int i = 0; i < 16; ++i) {
            const int l = i ^ j;
            if (l > i) { const int hi = max(a[i], a[l]), lo = min(a[i], a[l]); a[i] = hi; a[l] = lo; }
        }
    }
}
__device__ __forceinline__ void top16_of_64(int (&v)[4][16]) {
    sort16_desc(v[0]); sort16_desc(v[1]); sort16_desc(v[2]); sort16_desc(v[3]);
    merge_top16(v[0], v[1]); merge_top16(v[0], v[2]); merge_top16(v[0], v[3]);
}

__device__ void ph_mprep(const Params& p, unsigned char* smem, const int vb) {
    if (vb < 8) {
        const int n = vb * 256 + threadIdx.x, hp = n >> 7;
        const float* kr = p.keys + (size_t)n * 128;
        float a = 0.f, b = 0.f;
        for (int c4 = 0; c4 < 128; c4 += 4) {
            const f32x4 kv = *(const f32x4*)(kr + c4), wg = *(const f32x4*)(p.wgb + hp * 128 + c4), wb = *(const f32x4*)(p.wgb + 2048 + hp * 128 + c4);
            a += (kv[0] * wg[0] + kv[1] * wg[1]) + (kv[2] * wg[2] + kv[3] * wg[3]);
            b += (kv[0] * wb[0] + kv[1] * wb[1]) + (kv[2] * wb[2] + kv[3] * wb[3]);
        }
        u32x4 c0 = {pack2(a, b), 0u, 0u, 0u}; const u32x4 z4 = {0u, 0u, 0u, 0u};
        u32x4* me = (u32x4*)(p.mext + (size_t)n * 32);
        me[0] = c0; me[1] = z4; me[2] = z4; me[3] = z4;
    }
    const int tid = threadIdx.x, lane = tid & 63, wid = tid >> 6, wr = wid >> 1, wc = wid & 1, fr = lane & 15, fq = lane >> 4;
    for (int t = vb; t < 16 * 8; t += gridDim.x) {
        const int hp = t >> 3, d0 = (t & 7) * 128;
        f32x4 acc[4][4]; zero_acc(acc);
        gemm128(p.keysb + (size_t)hp * 128 * 128, 128, p.Wqb + (size_t)d0 * 2048 + hp * 128, 2048, 128, smem, acc);
#pragma unroll
        for (int mi = 0; mi < 4; ++mi)
#pragma unroll
            for (int ni = 0; ni < 4; ++ni) {
                uint2 o; o.x = pack2(acc[mi][ni][0], acc[mi][ni][1]); o.y = pack2(acc[mi][ni][2], acc[mi][ni][3]);
                *(uint2*)(p.MT + (size_t)(hp * 128 + wr * 64 + mi * 16 + fr) * DM + d0 + wc * 64 + ni * 16 + fq * 4) = o;
            }
    }
}

__device__ __forceinline__ void route_topk(const f32x16 (&S)[8], int pp, int hh, int (&K)[16]) {
    int v[4][16];
#pragma unroll
    for (int mt = 0; mt < 4; ++mt)
#pragma unroll
        for (int r = 0; r < 16; ++r) {
            const int n = mt * 32 + (r & 3) + 8 * (r >> 2) + 4 * hh;
            v[mt][r] = (f2key(S[pp * 4 + mt][r]) & ~0x7F) | (127 - n);
        }
    top16_of_64(v);
    int o[16];
#pragma unroll
    for (int i = 0; i < 16; ++i) o[i] = __shfl_xor(v[0][i], 32);
    merge_top16(v[0], o);
#pragma unroll
    for (int i = 0; i < 16; ++i) K[i] = v[0][i];
}
#define RT_STEPS 33
template <bool PRE, bool NEXT>
__device__ __forceinline__ void route_gemm(const Params& p, unsigned char* smem, int m0, int h, f32x16 (&S)[8], int nm0, int nh, int& sp) {
    LDS_AS unsigned char* lds = (LDS_AS unsigned char*)smem;
    const int tid = threadIdx.x, lane = tid & 63, wid = __builtin_amdgcn_readfirstlane(tid >> 6);
    const int r32 = lane & 31, hh = lane >> 5;
    const int prow = lane >> 2, pc = (lane & 3) ^ ((4 - ((prow >> 2) & 3)) & 3);
    const bf16_t* gA = p.y1b + (size_t)(m0 + wid * 32 + prow) * DM + pc * 8;
    const bf16_t* gB = p.MT + (size_t)(h * 256 + wid * 64 + prow) * DM + pc * 8;
    const bf16_t* eA = p.yext + (size_t)(m0 + wid * 32 + prow) * 32 + pc * 8;
    const bf16_t* eB = p.mext + (size_t)(h * 256 + wid * 64 + prow) * 32 + pc * 8;
    const size_t r16 = (size_t)16 * DM;
#define RH_ISSUE_AT(pa, sa, pb, sb_, st) do { \
        _Pragma("unroll") for (int _i = 0; _i < 2; ++_i) \
            __builtin_amdgcn_global_load_lds((const unsigned*)((pa) + _i * (sa)), (LDS_AS unsigned*)(lds + (st) * GW_STAGE + (wid * 2 + _i) * 1024), 16, 0, 0); \
        _Pragma("unroll") for (int _i = 0; _i < 4; ++_i) \
            __builtin_amdgcn_global_load_lds((const unsigned*)((pb) + _i * (sb_)), (LDS_AS unsigned*)(lds + (st) * GW_STAGE + 8192 + (wid * 4 + _i) * 1024), 16, 0, 0); \
        } while (0)
#pragma unroll
    for (int mt = 0; mt < 8; ++mt)
#pragma unroll
        for (int r = 0; r < 16; ++r) S[mt][r] = 0.f;
    const int fx = (4 - ((r32 >> 2) & 3)) & 3;
    const int toff = (wid * 32 + r32) * 64, koff = 8192 + r32 * 64;
    if (!PRE) RH_ISSUE_AT(gA, r16, gB, r16, sp);
#pragma unroll 1
    for (int kt = 0; kt < RT_STEPS; ++kt) {
        const int st = (kt + sp) & 1;
        asm volatile("s_waitcnt vmcnt(0)" ::: "memory");
        __builtin_amdgcn_s_barrier();
        asm volatile("" ::: "memory");
        if (kt + 1 < RT_STEPS - 1) RH_ISSUE_AT(gA + (size_t)(kt + 1) * 32, r16, gB + (size_t)(kt + 1) * 32, r16, st ^ 1);
        else if (kt + 1 == RT_STEPS - 1) RH_ISSUE_AT(eA, (size_t)(16 * 32), eB, (size_t)(16 * 32), st ^ 1);
        else if (NEXT) {
            const bf16_t* qA = p.y1b + (size_t)(nm0 + wid * 32 + prow) * DM + pc * 8;
            const bf16_t* qB = p.MT + (size_t)(nh * 256 + wid * 64 + prow) * DM + pc * 8;
            RH_ISSUE_AT(qA, r16, qB, r16, st ^ 1);
        }
        const LDS_AS unsigned char* sb = lds + st * GW_STAGE;
#pragma unroll
        for (int k16 = 0; k16 < 2; ++k16) {
            const int sw = ((k16 * 2 + hh) ^ fx) * 16;
            const bf16x8 b = *(const LDS_AS bf16x8*)(sb + toff + sw);
#pragma unroll
            for (int mt = 0; mt < 8; ++mt) {
                const bf16x8 a = *(const LDS_AS bf16x8*)(sb + koff + mt * 2048 + sw);
                S[mt] = __builtin_amdgcn_mfma_f32_32x32x16_bf16(a, b, S[mt], 0, 0, 0);
            }
        }
        asm volatile("s_waitcnt lgkmcnt(0)" ::: "memory");
        __builtin_amdgcn_s_barrier();
        asm volatile("" ::: "memory");
    }
    sp ^= (RT_STEPS & 1);
#undef RH_ISSUE_AT
}

__device__ void ph_route(const Params& p, unsigned char* smem, const int vb) {
    const int tid = threadIdx.x, lane = tid & 63, wid = tid >> 6;
    const int r32 = lane & 31, hh = lane >> 5;
    const int hmask = -hh;
    int* KL = (int*)(smem + 2 * GW_STAGE + (size_t)wid * 32 * 33 * 4);
    const int nunits = (T_TOK / 128) * 8;
    bool pre = false; int sp = 0;
    for (int u = vb; u < nunits; u += gridDim.x) {
        const int m0 = (u >> 3) * 128, h = u & 7;
        const int un = u + gridDim.x;
        const bool has_next = un < nunits;
        const int nm0 = ((has_next ? un : u) >> 3) * 128, nh = (has_next ? un : u) & 7;
        float mu, rstd;
        {
            const float* stp = p.stats + (size_t)(m0 + wid * 32 + r32) * 16;
            const f32x4 a = *(const f32x4*)(stp), b = *(const f32x4*)(stp + 4), c4 = *(const f32x4*)(stp + 8), d = *(const f32x4*)(stp + 12);
            const float sm = (a[0] + a[2]) + (b[0] + b[2]) + (c4[0] + c4[2]) + (d[0] + d[2]);
            const float sq = (a[1] + a[3]) + (b[1] + b[3]) + (c4[1] + c4[3]) + (d[1] + d[3]);
            mu = sm * (1.0f / 1024.0f);
            rstd = rsqrtf(fmaxf(sq * (1.0f / 1024.0f) - mu * mu, 0.f) + LN_EPS);
        }
        {
            bf16_t* ye = p.yext + (size_t)(m0 + wid * 32 + r32) * 32 + hh * 16;
            const u32x4 z4 = {0u, 0u, 0u, 0u};
            u32x4 c0 = z4; if (hh == 0) c0[0] = pack2(-mu, __builtin_amdgcn_rcpf(rstd));
            *(u32x4*)(ye) = c0; *(u32x4*)(ye + 8) = z4;
        }
        f32x16 S[8];
        if (pre) { if (has_next) route_gemm<true, true>(p, smem, m0, h, S, nm0, nh, sp); else route_gemm<true, false>(p, smem, m0, h, S, nm0, nh, sp); }
        else     { if (has_next) route_gemm<false, true>(p, smem, m0, h, S, nm0, nh, sp); else route_gemm<false, false>(p, smem, m0, h, S, nm0, nh, sp); }
        int K0[16], K1[16];
        route_topk(S, 0, hh, K0);
        route_topk(S, 1, hh, K1);
        pre = has_next;
#pragma unroll
        for (int i = 0; i < 16; ++i) KL[r32 * 33 + hh * 16 + i] = K0[i] ^ ((K0[i] ^ K1[i]) & hmask);
        float s1[16], s2[16];
#pragma unroll
        for (int i = 0; i < 16; ++i) { s1[i] = key2f(K0[i] & ~0x7F); s2[i] = key2f(K1[i] & ~0x7F); }
        int c[4][16];
#pragma unroll
        for (int i = 0; i < 16; ++i)
#pragma unroll
            for (int j = 0; j < 16; ++j)
                if ((i + 1) * (j + 1) <= 16) {
                    constexpr int OFFS[16] = {0, 16, 24, 29, 33, 36, 38, 40, 42, 43, 44, 45, 46, 47, 48, 49};
                    const int q = OFFS[i] + j;
                    c[q >> 4][q & 15] = (f2key(s1[i] + s2[j]) & ~0xFF) | (255 - (i * 16 + j));
                }
#pragma unroll
        for (int qq = 50; qq < 64; ++qq) c[qq >> 4][qq & 15] = (int)0x80000000;
        top16_of_64(c);
        const float mx = key2f(c[0][0] & ~0xFF);
        float e[16]; float den = 0.f;
#pragma unroll
        for (int i = 0; i < 16; ++i) { e[i] = __expf(rstd * (key2f(c[0][i] & ~0xFF) - mx)); den += e[i]; }
        const float inv = __builtin_amdgcn_rcpf(den);
        const size_t ob = (size_t)(m0 + wid * 32 + r32) * 128 + h * 16 + hh * 8;
        int idv[8]; float gv[8];
#pragma unroll
        for (int qq = 0; qq < 8; ++qq) {
            const int F = c[0][qq] ^ ((c[0][qq] ^ c[0][8 + qq]) & hmask);
            gv[qq] = __int_as_float(__float_as_int(e[qq]) ^ ((__float_as_int(e[qq]) ^ __float_as_int(e[8 + qq])) & hmask)) * inv;
            const int idx = 255 - (F & 0xFF);
            const int k0 = KL[r32 * 33 + (idx >> 4)], k1 = KL[r32 * 33 + 16 + (idx & 15)];
            idv[qq] = (127 - (k0 & 0x7F)) * 128 + (127 - (k1 & 0x7F));
        }
        *(int4*)(p.ids + ob) = make_int4(idv[0], idv[1], idv[2], idv[3]);
        *(int4*)(p.ids + ob + 4) = make_int4(idv[4], idv[5], idv[6], idv[7]);
        *(float4*)(p.gates + ob) = make_float4(gv[0], gv[1], gv[2], gv[3]);
        *(float4*)(p.gates + ob + 4) = make_float4(gv[4], gv[5], gv[6], gv[7]);
    }
}

__device__ __forceinline__ f32x2 row_dot(const u32x4 w, const f32x2 (&x)[8], f32x2 acc) {
#pragma unroll
    for (int k = 0; k < 4; ++k) {
        acc = __builtin_amdgcn_cvt_pk_f32_fp8(w[k], false) * x[2 * k] + acc;
        acc = __builtin_amdgcn_cvt_pk_f32_fp8(w[k], true) * x[2 * k + 1] + acc;
    }
    return acc;
}
__device__ __forceinline__ float gelu_gate(float h, float g) { return 0.5f * h * (1.0f + erff(h * 0.70710678118654752f)) * g; }

__device__ __forceinline__ void ld_ids16(const int* __restrict__ q, int (&idv)[16]) {
    const int4* idp = (const int4*)q;
#pragma unroll
    for (int k = 0; k < 4; ++k) { const int4 v = idp[k]; idv[4 * k] = v.x; idv[4 * k + 1] = v.y; idv[4 * k + 2] = v.z; idv[4 * k + 3] = v.w; }
}
__device__ __forceinline__ void ld_f16(const float* __restrict__ q, float (&a)[16]) {
    const f32x4* ap = (const f32x4*)q;
#pragma unroll
    for (int k = 0; k < 4; ++k) { const f32x4 v = ap[k]; a[4 * k] = v[0]; a[4 * k + 1] = v[1]; a[4 * k + 2] = v[2]; a[4 * k + 3] = v[3]; }
}
__device__ void ph_peer_u(const Params& p, unsigned char* smem, const int vb) {
    const int lane = threadIdx.x & 63, wid = __builtin_amdgcn_readfirstlane(threadIdx.x >> 6), g = lane >> 3, c = lane & 7;
    const int nlb = gridDim.x >> 3, s = vb / nlb, lb = vb - s * nlb;
    const bool b2 = (lane & 4) != 0, b1 = (lane & 2) != 0, b0 = (lane & 1) != 0;
    const int cc = (b0 ? 2 : 0) + (b1 ? 4 : 0) + (b2 ? 8 : 0);
    const unsigned char* ubase = p.u8 + (size_t)s * (16384 * 128) + c * 16;
    const int stride = nlb * 4, t0 = lb * 4 + wid;
    const int ntok = (T_TOK - t0 + stride - 1) / stride;
    if (ntok <= 0) return;
    LDS_AS unsigned char* ring = (LDS_AS unsigned char*)smem + wid * 2048;
    const int* idg = p.ids + 2 * lane;
    const bf16_t* xg = p.y1b + s * 128 + 2 * lane;
#define PU_TOK(n) (t0 + ((n) < ntok ? (n) : ntok - 1) * stride)
#define PU_RAW_LD(n, ri, rx) do { const int _t = PU_TOK(n); ri = *(const u32x2*)(idg + (size_t)_t * 128); const unsigned _w = *(const unsigned*)(xg + (size_t)_t * DM); rx = (u32x2){_w << 16, _w & 0xffff0000u}; } while (0)
#define PU_RAW_ST(n, ri, rx) do { LDS_AS unsigned char* _b = ring + ((n) & 1) * 1024; *(LDS_AS u32x2*)(_b + lane * 8) = ri; *(LDS_AS u32x2*)(_b + 512 + lane * 8) = rx; } while (0)
#define PU_IDS(n, idv) do { const LDS_AS u32x4* _q = (const LDS_AS u32x4*)(ring + ((n) & 1) * 1024 + g * 64); \
        _Pragma("unroll") for (int _k = 0; _k < 4; ++_k) { const u32x4 _v = _q[_k]; idv[4 * _k] = (int)_v[0]; idv[4 * _k + 1] = (int)_v[1]; idv[4 * _k + 2] = (int)_v[2]; idv[4 * _k + 3] = (int)_v[3]; } } while (0)
    u32x4 wA[8], wB[8]; u32x2 ri, rx;
    {
        u32x2 i0, x0, i1, x1v;
        PU_RAW_LD(0, i0, x0); PU_RAW_LD(1, i1, x1v); PU_RAW_LD(2, ri, rx);
        PU_RAW_ST(0, i0, x0); PU_RAW_ST(1, i1, x1v);
        int id0[16]; PU_IDS(0, id0);
#pragma unroll
        for (int i = 0; i < 8; ++i) wA[i] = *(const u32x4*)(ubase + (size_t)id0[i] * 128);
#pragma unroll
        for (int i = 0; i < 8; ++i) wB[i] = *(const u32x4*)(ubase + (size_t)id0[8 + i] * 128);
    }
#pragma unroll 1
    for (int n = 0; n < ntok; ++n) {
        const int t = t0 + n * stride;
        f32x2 x[8];
        {
            const LDS_AS f32x4* q = (const LDS_AS f32x4*)(ring + (n & 1) * 1024 + 512 + c * 64);
#pragma unroll
            for (int k = 0; k < 4; ++k) { const f32x4 v4 = q[k]; x[2 * k] = (f32x2){v4[0], v4[1]}; x[2 * k + 1] = (f32x2){v4[2], v4[3]}; }
        }
        int idn[16]; PU_IDS(n + 1, idn);
        float v[16];
#pragma unroll
        for (int i = 0; i < 8; ++i) { const f32x2 a = row_dot(wA[i], x, (f32x2){0.f, 0.f}); v[i] = a.x + a.y; }
#pragma unroll
        for (int i = 0; i < 8; ++i) wA[i] = *(const u32x4*)(ubase + (size_t)idn[i] * 128);
#pragma unroll
        for (int i = 0; i < 8; ++i) { const f32x2 a = row_dot(wB[i], x, (f32x2){0.f, 0.f}); v[8 + i] = a.x + a.y; }
#pragma unroll
        for (int i = 0; i < 8; ++i) wB[i] = *(const u32x4*)(ubase + (size_t)idn[8 + i] * 128);
        PU_RAW_ST(n + 2, ri, rx);
        PU_RAW_LD(n + 3, ri, rx);
#pragma unroll
        for (int i = 0; i < 8; ++i) { const float keep = b2 ? v[i + 8] : v[i], send = b2 ? v[i] : v[i + 8]; v[i] = keep + __shfl_xor(send, 4); }
#pragma unroll
        for (int i = 0; i < 4; ++i) { const float keep = b1 ? v[i + 4] : v[i], send = b1 ? v[i] : v[i + 4]; v[i] = keep + __shfl_xor(send, 2); }
#pragma unroll
        for (int i = 0; i < 2; ++i) { const float keep = b0 ? v[i + 2] : v[i], send = b0 ? v[i] : v[i + 2]; v[i] = keep + __shfl_xor(send, 1); }
        *(unsigned*)(p.hp + ((size_t)t * 8 + s) * 128 + g * 16 + cc) = pack2(v[0], v[1]);
    }
}
__device__ void ph_peer_act(const Params& p, unsigned char* smem, const int vb) {
    const int lane = threadIdx.x & 63, wid = threadIdx.x >> 6;
    unsigned* lsc = (unsigned*)smem;
    __syncthreads();
    for (int i = threadIdx.x; i < 16384 / 4; i += 256) *(u32x4*)(lsc + 4 * i) = *(const u32x4*)((const unsigned*)p.sc2 + 4 * i);
    __syncthreads();
    for (int t = vb * 4 + wid; t < T_TOK; t += gridDim.x * 4) {
        f32x2 h = {0.f, 0.f};
#pragma unroll
        for (int s = 0; s < 8; ++s) { const unsigned w = *(const unsigned*)(p.hp + ((size_t)t * 8 + s) * 128 + 2 * lane); h += (f32x2){bflo(w), bfhi(w)}; }
        f32x2 pq = *(const f32x2*)(p.stats + (size_t)t * 16 + (lane & 7) * 2);
        pq.x += __shfl_xor(pq.x, 1); pq.y += __shfl_xor(pq.y, 1); pq.x += __shfl_xor(pq.x, 2); pq.y += __shfl_xor(pq.y, 2); pq.x += __shfl_xor(pq.x, 4); pq.y += __shfl_xor(pq.y, 4);
        const float mu = pq.x * (1.0f / 1024.0f), rstd = rsqrtf(fmaxf(pq.y * (1.0f / 1024.0f) - mu * mu, 0.f) + LN_EPS);
        int2 id = *(const int2*)(p.ids + (size_t)t * 128 + 2 * lane);
        id.x &= 0x3fff; id.y &= 0x3fff;
        const f32x2 gt = *(const f32x2*)(p.gates + (size_t)t * 128 + 2 * lane);
        const unsigned s0 = lsc[id.x], s1 = lsc[id.y];
        const unsigned c0 = p.cb2[id.x], c1 = p.cb2[id.y];
        f32x2 a;
        a.x = gelu_gate(rstd * (h.x * bflo(s0) - mu * bflo(c0)) + bfhi(c0), gt.x) * bfhi(s0);
        a.y = gelu_gate(rstd * (h.y * bflo(s1) - mu * bflo(c1)) + bfhi(c1), gt.y) * bfhi(s1);
        *(f32x2*)(p.gates + (size_t)t * 128 + 2 * lane) = a;
        if (lane < 2) {
            const unsigned pb = __float_as_uint(lane ? rstd : mu);
            *(int2*)(p.ids + (size_t)t * 128 + 2 * lane) = make_int2(id.x | (int)(pb & 0xffff0000u), id.y | (int)(pb << 16));
        }
    }
}
__device__ void ph_peer_v(const Params& p, unsigned char* smem, const int vb) {
    const int lane = threadIdx.x & 63, wid = __builtin_amdgcn_readfirstlane(threadIdx.x >> 6), g = lane >> 3, c = lane & 7;
    const int nlb = gridDim.x >> 3, s = vb / nlb, lb = vb - s * nlb;
    const bool b4 = (lane & 16) != 0, b3 = (lane & 8) != 0;
    const unsigned char* vbase = p.v8 + (size_t)s * (16384 * 128) + c * 16;
    const int stride = nlb * 4, t0 = lb * 4 + wid;
    const int ntok = (T_TOK - t0 + stride - 1) / stride;
    if (ntok <= 0) return;
    const int d0 = s * 128 + c * 16 + 2 * g;
    LDS_AS unsigned char* ring = (LDS_AS unsigned char*)smem + wid * 2048;
    const int* idg = p.ids + 2 * lane;
    const float* ag = p.gates + 2 * lane;
#define PV_RAW_LD(n, ri, rx) do { const int _t = PU_TOK(n); ri = *(const u32x2*)(idg + (size_t)_t * 128); rx = *(const u32x2*)(ag + (size_t)_t * 128); } while (0)
    u32x4 wA[8], wB[8]; u32x2 ri, rx;
    float mu_c, rs_c;
    const f32x2 g2 = *(const f32x2*)(p.ln1_g + d0), b2 = *(const f32x2*)(p.ln1_b + d0);
    {
        u32x2 i0, x0, i1, x1v;
        PV_RAW_LD(0, i0, x0); PV_RAW_LD(1, i1, x1v); PV_RAW_LD(2, ri, rx);
        PU_RAW_ST(0, i0, x0); PU_RAW_ST(1, i1, x1v);
        int id0[16]; PU_IDS(0, id0);
        mu_c = __uint_as_float(((unsigned)__builtin_amdgcn_readlane(id0[0], 0) & 0xffff0000u) | ((unsigned)__builtin_amdgcn_readlane(id0[1], 0) >> 16));
        rs_c = __uint_as_float(((unsigned)__builtin_amdgcn_readlane(id0[2], 0) & 0xffff0000u) | ((unsigned)__builtin_amdgcn_readlane(id0[3], 0) >> 16));
#pragma unroll
        for (int i = 0; i < 16; ++i) id0[i] &= 0x3fff;
#pragma unroll
        for (int i = 0; i < 8; ++i) wA[i] = *(const u32x4*)(vbase + (size_t)id0[i] * 128);
#pragma unroll
        for (int i = 0; i < 8; ++i) wB[i] = *(const u32x4*)(vbase + (size_t)id0[8 + i] * 128);
    }
#pragma unroll 1
    for (int n = 0; n < ntok; ++n) {
        const int t = t0 + n * stride;
        const unsigned yw = *(const unsigned*)(p.y1b + (size_t)t * DM + d0);
        const float mu = mu_c, rs = rs_c;
        const f32x2 xv = {(bflo(yw) - mu) * rs * g2.x + b2.x, (bfhi(yw) - mu) * rs * g2.y + b2.y};
        float ac[16];
        {
            const LDS_AS f32x4* q = (const LDS_AS f32x4*)(ring + (n & 1) * 1024 + 512 + g * 64);
#pragma unroll
            for (int k = 0; k < 4; ++k) { const f32x4 v4 = q[k]; ac[4 * k] = v4[0]; ac[4 * k + 1] = v4[1]; ac[4 * k + 2] = v4[2]; ac[4 * k + 3] = v4[3]; }
        }
        int idn[16]; PU_IDS(n + 1, idn);
        mu_c = __uint_as_float(((unsigned)__builtin_amdgcn_readlane(idn[0], 0) & 0xffff0000u) | ((unsigned)__builtin_amdgcn_readlane(idn[1], 0) >> 16));
        rs_c = __uint_as_float(((unsigned)__builtin_amdgcn_readlane(idn[2], 0) & 0xffff0000u) | ((unsigned)__builtin_amdgcn_readlane(idn[3], 0) >> 16));
#pragma unroll
        for (int i = 0; i < 16; ++i) idn[i] &= 0x3fff;
        f32x2 acc[8];
#pragma unroll
        for (int k = 0; k < 8; ++k) acc[k] = (f32x2){0.f, 0.f};
#pragma unroll
        for (int i = 0; i < 8; ++i) {
            const f32x2 a2 = {ac[i], ac[i]};
#pragma unroll
            for (int k = 0; k < 4; ++k) {
                acc[2 * k] = __builtin_amdgcn_cvt_pk_f32_fp8(wA[i][k], false) * a2 + acc[2 * k];
                acc[2 * k + 1] = __builtin_amdgcn_cvt_pk_f32_fp8(wA[i][k], true) * a2 + acc[2 * k + 1];
            }
        }
#pragma unroll
        for (int i = 0; i < 8; ++i) wA[i] = *(const u32x4*)(vbase + (size_t)idn[i] * 128);
#pragma unroll
        for (int i = 0; i < 8; ++i) {
            const f32x2 a2 = {ac[8 + i], ac[8 + i]};
#pragma unroll
            for (int k = 0; k < 4; ++k) {
                acc[2 * k] = __builtin_amdgcn_cvt_pk_f32_fp8(wB[i][k], false) * a2 + acc[2 * k];
                acc[2 * k + 1] = __builtin_amdgcn_cvt_pk_f32_fp8(wB[i][k], true) * a2 + acc[2 * k + 1];
            }
        }
#pragma unroll
        for (int i = 0; i < 8; ++i) wB[i] = *(const u32x4*)(vbase + (size_t)idn[8 + i] * 128);
        PU_RAW_ST(n + 2, ri, rx);
        PV_RAW_LD(n + 3, ri, rx);
        float v[16];
#pragma unroll
        for (int k = 0; k < 8; ++k) { v[2 * k] = acc[k].x; v[2 * k + 1] = acc[k].y; }
#pragma unroll
        for (int j2 = 0; j2 < 8; ++j2) {
            auto r = __builtin_amdgcn_permlane32_swap(__float_as_uint(v[j2]), __float_as_uint(v[j2 + 8]), false, false);
            v[j2] = __uint_as_float(r[0]) + __uint_as_float(r[1]);
        }
#pragma unroll
        for (int j2 = 0; j2 < 4; ++j2) { const float keep = b4 ? v[j2 + 4] : v[j2], send = b4 ? v[j2] : v[j2 + 4]; v[j2] = keep + __shfl_xor(send, 16); }
#pragma unroll
        for (int j2 = 0; j2 < 2; ++j2) { const float keep = b3 ? v[j2 + 2] : v[j2], send = b3 ? v[j2] : v[j2 + 2]; v[j2] = keep + __shfl_xor(send, 8); }
        const float r0 = ALPHA * xv.x + v[0], r1 = ALPHA * xv.y + v[1];
        *(unsigned*)(p.rb + (size_t)t * DM + d0) = pack2(r0, r1);
    }
}

__device__ void ph_gemm_ple(const Params& p, unsigned char* smem, const int vb) {
    const int ntn = DM / 128;
    const int tid = threadIdx.x, lane = tid & 63, wid = tid >> 6, wr = wid >> 1, wc = wid & 1, fr = lane & 15, fq = lane >> 4;
    const int ntiles = (T_TOK / 128) * ntn;
    bool pre = false;
    for (int t = vb; t < ntiles; t += gridDim.x) {
        const int m0 = (t / ntn) * 128, n0 = (t % ntn) * 128;
        const int tn = t + gridDim.x;
        const bool has_next = tn < ntiles;
        const bf16_t* nA = p.pb + (size_t)((has_next ? tn : t) / ntn) * 128 * 256;
        const bf16_t* nB = p.WpT + (size_t)((has_next ? tn : t) % ntn) * 128 * 256;
        const bf16_t* gA = p.rb + (size_t)m0 * DM; const bf16_t* gB = p.WgT + (size_t)n0 * DM;
        f32x4 acc[4][4], acc2[4][4]; zero_acc(acc); zero_acc(acc2);
        if (pre) gemm128<true, true>(p.pb + (size_t)m0 * 256, 256, p.WpT + (size_t)n0 * 256, 256, 256, smem, acc2, gA, DM, gB, DM);
        else     gemm128<false, true>(p.pb + (size_t)m0 * 256, 256, p.WpT + (size_t)n0 * 256, 256, 256, smem, acc2, gA, DM, gB, DM);
        if (has_next) gemm128<true, true>(gA, DM, gB, DM, DM, smem, acc, nA, 256, nB, 256);
        else          gemm128<true, false>(gA, DM, gB, DM, DM, smem, acc);
        pre = has_next;
#pragma unroll
        for (int mi = 0; mi < 4; ++mi) {
            const int row = m0 + wr * 64 + mi * 16 + fr;
#pragma unroll
            for (int ni = 0; ni < 4; ++ni) {
                const int col = n0 + wc * 64 + ni * 16 + fq * 4;
                const u32x2 rw = *(const u32x2*)(p.rb + (size_t)row * DM + col);
                f32x4 rv = {bflo(rw[0]), bfhi(rw[0]), bflo(rw[1]), bfhi(rw[1])};
#pragma unroll
                for (int r = 0; r < 4; ++r) rv[r] += sigmul(acc2[mi][ni][r], acc[mi][ni][r]);
                *(f32x4*)(p.out + (size_t)row * DM + col) = rv;
            }
        }
    }
}

#define XB_TMO      128
#define XB_XCNT(j)  (256  + 64 * (j))
#define XB_XSUB(j)  (1280 + 64 * (j))
#define XB_XGEN(j)  (2304 + 64 * (j))
#define XB_TOP      3328
#define XB_TOPGEN   3392
#define XCD_BAR_WORDS 3456
#define XB_SPIN_CAP (1u << 20)
__device__ __forceinline__ unsigned xb_ld(unsigned* p)              { return __hip_atomic_load(p, __ATOMIC_RELAXED, __HIP_MEMORY_SCOPE_AGENT); }
__device__ __forceinline__ unsigned xb_add(unsigned* p, unsigned v) { return __hip_atomic_fetch_add(p, v, __ATOMIC_RELAXED, __HIP_MEMORY_SCOPE_AGENT); }
__device__ __forceinline__ unsigned xb_xcc_id() { return (unsigned)__builtin_amdgcn_s_getreg((3 << 11) | 20) & 0xFu; }
#define XB_SPIN(cond, bar) do { unsigned _sp = 0; while (cond) { __builtin_amdgcn_s_sleep(1); \
    if ((++_sp & 255u) == 0u) { if (xb_ld(&(bar)[XB_TMO])) break; if (_sp > XB_SPIN_CAP) { atomicAdd(&(bar)[XB_TMO], 1u); break; } } } } while (0)
struct XcdBarrier { unsigned* bar; unsigned x; volatile LDS_AS unsigned* st; };
__device__ __forceinline__ XcdBarrier xcd_barrier_post(unsigned* bar, volatile LDS_AS unsigned* st) {
    XcdBarrier b; b.bar = bar; b.x = xb_xcc_id(); b.st = st;
    if (threadIdx.x == 0) st[3] = xb_add(&bar[XB_XCNT(b.x)], 1u);
    return b;
}
__device__ __forceinline__ void xcd_barrier_complete(unsigned* bar, unsigned x, unsigned rank, unsigned& nloc, unsigned& nx, unsigned& vb) {
    const unsigned G = gridDim.x;
    unsigned sum, cnt, mine, sp = 0u; bool even;
    for (;;) {
        sum = 0u; cnt = 0u; mine = 0u; even = true;
#pragma unroll
        for (unsigned j = 0; j < 16; ++j) {
            const unsigned c = xb_ld(&bar[XB_XCNT(j)]); sum += c; cnt += (c > 0u) ? 1u : 0u; mine = (j == x) ? c : mine;
            even = even && (c == ((j < 8u) ? (G >> 3) : 0u));
        }
        if (sum == G) break;
        __builtin_amdgcn_s_sleep(1);
        if ((++sp & 255u) == 0u) { if (xb_ld(&bar[XB_TMO])) break; if (sp > XB_SPIN_CAP) { atomicAdd(&bar[XB_TMO], 1u); break; } }
    }
    nloc = mine > 0u ? mine : 1u; nx = cnt > 0u ? cnt : 1u;
    vb = (even && sum == G && (G & 7u) == 0u) ? (x * (G >> 3) + rank) : blockIdx.x;
}
__device__ __forceinline__ void xcd_barrier(const XcdBarrier& b) {
    asm volatile("s_waitcnt vmcnt(0)" ::: "memory");
    __syncthreads();
    if (threadIdx.x == 0) {
        unsigned* bar = b.bar;
        __builtin_amdgcn_s_waitcnt(0);
        unsigned nloc = b.st[0], nx = b.st[1];
        if (nloc == 0u) { unsigned vb; xcd_barrier_complete(bar, b.x, b.st[3], nloc, nx, vb); b.st[0] = nloc; b.st[1] = nx; b.st[2] = vb; }
        const unsigned old = xb_add(&bar[XB_XSUB(b.x)], 1u);
        const unsigned gen = old / nloc;
        if (old + 1u == (gen + 1u) * nloc) {
            __builtin_amdgcn_fence(__ATOMIC_RELEASE, "agent");
            asm volatile("s_waitcnt vmcnt(0)" ::: "memory");
            const unsigned og = xb_add(&bar[XB_TOP], 1u);
            const unsigned tg = og / nx;
            if (og + 1u == (tg + 1u) * nx) xb_add(&bar[XB_TOPGEN], 1u);
            else XB_SPIN(xb_ld(&bar[XB_TOPGEN]) == tg, bar);
            __builtin_amdgcn_fence(__ATOMIC_ACQUIRE, "agent");
            xb_add(&bar[XB_XGEN(b.x)], 1u);
            asm volatile("s_waitcnt vmcnt(0)" ::: "memory");
        } else {
            XB_SPIN(xb_ld(&bar[XB_XGEN(b.x)]) == gen, bar);
            __builtin_amdgcn_fence(__ATOMIC_ACQUIRE, "agent");
            asm volatile("s_waitcnt vmcnt(0)" ::: "memory");
        }
    }
    __syncthreads();
}

#define SMEM_PHASE (256 * ASTR * 2 * 2)
#define SMEM_BYTES (SMEM_PHASE + 16)
__global__ void __launch_bounds__(256, 2) mega(Params p) {
    __shared__ __attribute__((aligned(16))) unsigned char smem[SMEM_BYTES];
    volatile LDS_AS unsigned* st = (volatile LDS_AS unsigned*)(LDS_AS unsigned char*)(smem + SMEM_PHASE);
    if (threadIdx.x < 4) st[threadIdx.x] = 0u;
    __syncthreads();
    const XcdBarrier gb = xcd_barrier_post(p.bar, st);
    ph_prep(p, smem);            xcd_barrier(gb);
    const int vb = (int)st[2];
    ph_gemm_in(p, smem, vb);     xcd_barrier(gb);
    ph_attn(p, smem, vb);
    ph_conv(p, smem, vb);        xcd_barrier(gb);
    ph_mprep(p, smem, vb);
    ph_gemm_out(p, smem, vb);    xcd_barrier(gb);
    ph_route(p, smem, vb);       xcd_barrier(gb);
    ph_peer_u(p, smem, vb);      xcd_barrier(gb);
    ph_peer_act(p, smem, vb);    xcd_barrier(gb);
    ph_peer_v(p, smem, vb);      xcd_barrier(gb);
    ph_gemm_ple(p, smem, vb);    xcd_barrier(gb);
    ph_ln2(p, vb);
}

extern "C" void kernel_launch(void* const* d_in, const int* in_sizes, int n_in, void* d_out, int out_size, void* d_ws, size_t ws_size,
                              hipStream_t stream) {
    Params p{};
    p.x = (const float*)d_in[0]; p.p = (const float*)d_in[1]; p.pos = (const int*)d_in[2];
    p.w_in = (const float*)d_in[3]; p.sinks = (const float*)d_in[4]; p.conv_w = (const float*)d_in[5]; p.conv_b = (const float*)d_in[6];
    p.cln_g = (const float*)d_in[7]; p.cln_b = (const float*)d_in[8]; p.w_out = (const float*)d_in[9]; p.ln1_g = (const float*)d_in[10];
    p.ln1_b = (const float*)d_in[11]; p.wq = (const float*)d_in[12]; p.keys = (const float*)d_in[13]; p.pu = (const float*)d_in[14];
    p.pv = (const float*)d_in[15]; p.ple_proj = (const float*)d_in[16]; p.ple_gate = (const float*)d_in[17]; p.ln2_g = (const float*)d_in[18];
    p.ln2_b = (const float*)d_in[19];
    p.out = (float*)d_out;
    unsigned char* ws = (unsigned char*)d_ws;
    const size_t MiB = 1024 * 1024;
    p.y1 = (float*)(ws + 0 * MiB);
    p.hb = (bf16_t*)(ws + 128 * MiB);
    p.hp = (bf16_t*)(ws + 128 * MiB);
    p.xb = (bf16_t*)(ws + 256 * MiB);
    p.mixb = (bf16_t*)(ws + 320 * MiB);
    p.rb = (bf16_t*)(ws + 320 * MiB);
    p.pb = (bf16_t*)(ws + 384 * MiB);
    p.u8 = (unsigned char*)(ws + 400 * MiB);
    p.v8 = (unsigned char*)(ws + 416 * MiB);
    p.sc2 = (bf16_t*)(ws + 432 * MiB);
    p.rope = (float*)(ws + 434 * MiB);
    p.stats = (float*)(ws + 436 * MiB);
    p.cb2 = (unsigned*)(ws + 438 * MiB);
    p.mext = (bf16_t*)(ws + 440 * MiB);
    p.yext = (bf16_t*)(ws + 442 * MiB);
    p.y1b = (bf16_t*)(ws + 0 * MiB);
    p.ids = (int*)(ws + 464 * MiB);
    p.gates = (float*)(ws + 480 * MiB);
    unsigned char* wb = ws + 496 * MiB;
    p.WinT = (bf16_t*)wb; wb += (size_t)INW * DM * 2;
    p.WoutT = (bf16_t*)wb; wb += (size_t)DM * DM * 2;
    p.WgT = (bf16_t*)wb; wb += (size_t)DM * DM * 2;
    p.WpT = (bf16_t*)wb; wb += (size_t)DM * 256 * 2;
    p.keysb = (bf16_t*)wb; wb += (size_t)16 * 128 * 128 * 2;
    p.Wqb = (bf16_t*)(ws + 240 * MiB);
    p.MT = (bf16_t*)(ws + 244 * MiB);
    p.bar = (unsigned*)(ws + 510 * MiB);
    p.wgb = (float*)(p.bar + XCD_BAR_WORDS + 640);

    static int grid_blocks = 0;
    if (!grid_blocks) {
        int dev = 0, cus = 0, per_cu = 0;
        (void)hipGetDevice(&dev);
        (void)hipDeviceGetAttribute(&cus, hipDeviceAttributeMultiprocessorCount, dev);
        (void)hipOccupancyMaxActiveBlocksPerMultiprocessor(&per_cu, mega, 256, 0);
        if (per_cu > 2) per_cu = 2;
        grid_blocks = cus * per_cu;
    }
    (void)hipMemsetAsync(p.bar, 0, (XCD_BAR_WORDS + 640 + 4096) * sizeof(unsigned), stream);
    void* args[] = {&p};
    hipError_t e = hipLaunchCooperativeKernel((void*)mega, dim3(grid_blocks), dim3(256), args, 0, stream);
    if (e != hipSuccess) fprintf(stderr, "cooperative launch failed: %s (grid %d)\n", hipGetErrorString(e), grid_blocks);
}
```

```cpp
#include <hip/hip_runtime.h>
#include <stdint.h>
#include <cstdio>

typedef unsigned short bf16_t;
typedef short bf16x8 __attribute__((ext_vector_type(8)));
typedef float f32x4 __attribute__((ext_vector_type(4)));
typedef unsigned u32x4 __attribute__((ext_vector_type(4)));
typedef float f32x2 __attribute__((ext_vector_type(2)));

#define T_TOK 32768
#define SEQ 2048
#define DM 1024
#define INW 1792
#define ALPHA 1.189207115002721f
#define LN_EPS 1e-5f

__device__ __forceinline__ bf16_t f2bf(float f) {
    unsigned u = __float_as_uint(f);
    u += 0x7fffu + ((u >> 16) & 1u);
    return (bf16_t)(u >> 16);
}
__device__ __forceinline__ float bf2f(bf16_t b) { return __uint_as_float(((unsigned)b) << 16); }
__device__ __forceinline__ float bflo(unsigned w) { return __uint_as_float(w << 16); }
__device__ __forceinline__ float bfhi(unsigned w) { return __uint_as_float(w & 0xffff0000u); }
__device__ __forceinline__ unsigned pack2(float a, float b) { return (unsigned)f2bf(a) | ((unsigned)f2bf(b) << 16); }

__device__ __forceinline__ float sigmul(float x, float g) { return x * __builtin_amdgcn_rcpf(1.0f + __expf(-g)); }
__device__ __forceinline__ float wave_sum(float v) {
#pragma unroll
    for (int o = 32; o >= 1; o >>= 1) v += __shfl_xor(v, o);
    return v;
}

struct Params {
    const float *x, *p; const int* pos;
    const float *w_in, *sinks, *conv_w, *conv_b, *cln_g, *cln_b, *w_out, *ln1_g, *ln1_b;
    const float *wq, *keys, *pu, *pv, *ple_proj, *ple_gate, *ln2_g, *ln2_b;
    float* out;
    bf16_t *xb, *pb, *WinT, *WoutT, *WgT, *WpT, *keysb, *Wqb, *MT, *hb, *mixb, *rb;
    float *y1, *gates, *rope, *stats, *wgb;
    bf16_t *y1b, *yext, *mext; unsigned* cb2;
    bf16_t* sc2;
    bf16_t* hp;
    int *ids;
    unsigned char *u8, *v8;
    unsigned* bar;
};

__device__ void cvt_rows(const float* __restrict__ src, bf16_t* __restrict__ dst, size_t n) {
    const size_t nv = n / 8, gs = (size_t)gridDim.x * blockDim.x;
    for (size_t i = (size_t)blockIdx.x * blockDim.x + threadIdx.x; i < nv; i += 4 * gs) {
        f32x4 a[4], b[4];
#pragma unroll
        for (int q = 0; q < 4; ++q) { const size_t k = (i + q * gs < nv) ? i + q * gs : i; a[q] = ((const f32x4*)src)[2 * k]; b[q] = ((const f32x4*)src)[2 * k + 1]; }
#pragma unroll
        for (int q = 0; q < 4; ++q) {
            if (i + q * gs < nv) {
                u32x4 o; o[0] = pack2(a[q][0], a[q][1]); o[1] = pack2(a[q][2], a[q][3]); o[2] = pack2(b[q][0], b[q][1]); o[3] = pack2(b[q][2], b[q][3]);
                ((u32x4*)dst)[i + q * gs] = o;
            }
        }
    }
}
__device__ __forceinline__ int win_row(int n) {
    if (n < 768) return n;
    const int isg = n >= 1280 ? 1 : 0, c = n - (isg ? 1280 : 768);
    const int tt = c >> 6, wc = (c >> 5) & 1, k2 = (c >> 4) & 1, rest = c & 15;
    return 768 + 128 * tt + wc * 64 + (k2 * 2 + isg) * 16 + rest;
}
template <bool WIN = false>
__device__ void transpose_cvt(const float* __restrict__ W, bf16_t* __restrict__ Wt, int K, int N, float* tile  ) {
    const int tk = K / 64, tn = N / 64;
    const int tid = threadIdx.x;
    for (int t = blockIdx.x; t < tk * tn; t += gridDim.x) {
        const int k0 = (t / tn) * 64, n0 = (t % tn) * 64;
        f32x4 v[4];
#pragma unroll
        for (int i = 0; i < 4; ++i) v[i] = *(const f32x4*)(W + (size_t)(k0 + (tid >> 4) + 16 * i) * N + n0 + (tid & 15) * 4);
        __syncthreads();
#pragma unroll
        for (int i = 0; i < 4; ++i)
#pragma unroll
            for (int j = 0; j < 4; ++j) tile[((tid >> 4) + 16 * i) * 65 + (tid & 15) * 4 + j] = v[i][j];
        __syncthreads();
        const int n = tid >> 2, kc = (tid & 3) * 16;
        u32x4 o0, o1;
#pragma unroll
        for (int q = 0; q < 4; ++q) {
            o0[q] = pack2(tile[(kc + 2 * q) * 65 + n], tile[(kc + 2 * q + 1) * 65 + n]);
            o1[q] = pack2(tile[(kc + 8 + 2 * q) * 65 + n], tile[(kc + 8 + 2 * q + 1) * 65 + n]);
        }
        const int nd = WIN ? win_row(n0 + n) : n0 + n;
        *(u32x4*)(Wt + (size_t)nd * K + k0 + kc) = o0;
        *(u32x4*)(Wt + (size_t)nd * K + k0 + kc + 8) = o1;
    }
}
__device__ void cvt_wq_fold(const Params& p, unsigned char* smem) {
    for (int i = blockIdx.x * 256 + threadIdx.x; i < DM * 256; i += gridDim.x * 256) {
        const int d = i >> 8, c8 = (i & 255) * 8;
        const float gd = p.ln1_g[d];
        const f32x4 a = *(const f32x4*)(p.wq + (size_t)d * 2048 + c8), b = *(const f32x4*)(p.wq + (size_t)d * 2048 + c8 + 4);
        u32x4 o; o[0] = pack2(a[0] * gd, a[1] * gd); o[1] = pack2(a[2] * gd, a[3] * gd); o[2] = pack2(b[0] * gd, b[1] * gd); o[3] = pack2(b[2] * gd, b[3] * gd);
        *(u32x4*)(p.Wqb + (size_t)d * 2048 + c8) = o;
    }
    float* red = (float*)smem;
    const int lane = threadIdx.x & 63, wid = threadIdx.x >> 6;
    for (int cb = blockIdx.x; cb < 512; cb += gridDim.x) {
        f32x4 sg = {0.f, 0.f, 0.f, 0.f}, sb = {0.f, 0.f, 0.f, 0.f};
#pragma unroll
        for (int q = 0; q < 4; ++q) {
            const int d = threadIdx.x * 4 + q;
            const f32x4 v = *(const f32x4*)(p.wq + (size_t)d * 2048 + cb * 4);
            sg += v * p.ln1_g[d]; sb += v * p.ln1_b[d];
        }
        __syncthreads();
#pragma unroll
        for (int q = 0; q < 4; ++q) {
            const float a = wave_sum(sg[q]), b = wave_sum(sb[q]);
            if (lane == 0) { red[wid * 8 + q] = a; red[wid * 8 + 4 + q] = b; }
        }
        __syncthreads();
        if (threadIdx.x < 8) {
            const float t = (red[threadIdx.x] + red[8 + threadIdx.x]) + (red[16 + threadIdx.x] + red[24 + threadIdx.x]);
            p.wgb[(threadIdx.x >> 2) * 2048 + cb * 4 + (threadIdx.x & 3)] = t;
        }
    }
}
template <bool FOLD>
__device__ void cvt_table_fp8(const Params& p, const float* __restrict__ src, unsigned char* __restrict__ dst, bf16_t* __restrict__ scl, int rows) {
    const int lane = threadIdx.x & 63, wid = threadIdx.x >> 6;
    const int nw = gridDim.x * 4;
    for (int r0 = blockIdx.x * 4 + wid; r0 < rows; r0 += 4 * nw) {
        f32x4 v[4][4];
#pragma unroll
        for (int q = 0; q < 4; ++q) {
            const int r = (r0 + q * nw < rows) ? r0 + q * nw : r0;
            const float* sr = src + (size_t)r * DM + lane * 16;
#pragma unroll
            for (int k = 0; k < 4; ++k) v[q][k] = *(const f32x4*)(sr + 4 * k);
        }
        f32x4 gv[4], bv[4];
        if (FOLD) {
#pragma unroll
            for (int k = 0; k < 4; ++k) { gv[k] = *(const f32x4*)(p.ln1_g + lane * 16 + 4 * k); bv[k] = *(const f32x4*)(p.ln1_b + lane * 16 + 4 * k); }
        }
#pragma unroll
        for (int q = 0; q < 4; ++q) {
            const int r = r0 + q * nw;
            if (FOLD) {
                float cu = 0.f, bu = 0.f;
#pragma unroll
                for (int k = 0; k < 4; ++k) { bu += (bv[k][0] * v[q][k][0] + bv[k][1] * v[q][k][1]) + (bv[k][2] * v[q][k][2] + bv[k][3] * v[q][k][3]); v[q][k] = v[q][k] * gv[k]; cu += (v[q][k][0] + v[q][k][1]) + (v[q][k][2] + v[q][k][3]); }
                cu = wave_sum(cu); bu = wave_sum(bu);
                if (lane == 0 && r < rows) p.cb2[r] = pack2(cu, bu);
            }
            float m = 0.f;
#pragma unroll
            for (int k = 0; k < 4; ++k)
#pragma unroll
                for (int i = 0; i < 4; ++i) m = fmaxf(m, fabsf(v[q][k][i]));
#pragma unroll
            for (int o = 32; o >= 1; o >>= 1) m = fmaxf(m, __shfl_xor(m, o));
            int ex = (m > 0.f) ? (8 - (int)((__float_as_uint(m) >> 23) & 0xffu) + 127 - ((__float_as_uint(m) & 0x7fffffu) > 0x600000u ? 1 : 0)) : 0;
            ex = min(max(ex, -100), 100);
            const float sc = __uint_as_float((unsigned)(127 + ex) << 23);
            u32x4 w;
#pragma unroll
            for (int k = 0; k < 4; ++k)
                w[k] = __builtin_amdgcn_cvt_pk_fp8_f32(v[q][k][2] * sc, v[q][k][3] * sc, __builtin_amdgcn_cvt_pk_fp8_f32(v[q][k][0] * sc, v[q][k][1] * sc, 0, false), true);
            if (r < rows) {
                *(u32x4*)(dst + (size_t)(lane >> 3) * (16384 * 128) + (size_t)r * 128 + (lane & 7) * 16) = w;
                if (lane == 0) scl[2 * r] = (bf16_t)(((unsigned)(127 - ex) << 23) >> 16);
            }
        }
    }
}
__device__ void ph_prep(const Params& p, unsigned char* smem) {
    float* tile = (float*)smem;
    cvt_rows(p.x, p.xb, (size_t)T_TOK * DM);
    cvt_rows(p.p, p.pb, (size_t)T_TOK * 256);
    cvt_table_fp8<true>(p, p.pu, p.u8, p.sc2, 16384);
    cvt_table_fp8<false>(p, p.pv, p.v8, p.sc2 + 1, 16384);
    cvt_rows(p.keys, p.keysb, (size_t)16 * 128 * 128);
    for (int i = blockIdx.x * 256 + threadIdx.x; i < T_TOK * 8; i += gridDim.x * 256) {
        const int t = i >> 3, j = i & 7;
        const float inv = powf(500000.0f, -(float)j * 0.125f);
        float sn, cs; sincosf((float)p.pos[t] * inv, &sn, &cs);
        p.rope[t * 16 + j] = cs; p.rope[t * 16 + 8 + j] = sn;
    }
    transpose_cvt<true>(p.w_in, p.WinT, DM, INW, tile);
    transpose_cvt(p.w_out, p.WoutT, DM, DM, tile);
    cvt_wq_fold(p, smem);
    transpose_cvt(p.ple_gate, p.WgT, DM, DM, tile);
    transpose_cvt(p.ple_proj, p.WpT, 256, DM, tile);
}

#define LDS_AS __attribute__((address_space(3)))
#define GEMM_STAGE 32768
template <bool PRE = false, bool NEXT = false>
__device__ __forceinline__ void gemm128(const bf16_t* __restrict__ A, int lda, const bf16_t* __restrict__ Bt, int ldb, int K,
                                        unsigned char* smem, f32x4 (&acc)[4][4],
                                        const bf16_t* __restrict__ nA = nullptr, int nlda = 0, const bf16_t* __restrict__ nB = nullptr, int nldb = 0) {
    LDS_AS unsigned char* lds = (LDS_AS unsigned char*)smem;
    const int tid = threadIdx.x, lane = tid & 63, wid = __builtin_amdgcn_readfirstlane(tid >> 6);
    const int wr = wid >> 1, wc = wid & 1, fr = lane & 15, fq = lane >> 4;
    const int nk = K / 64;
    const int prow = lane >> 3, pc = (lane & 7) ^ prow;
    const bf16_t* gA = A + (size_t)(wid * 32 + prow) * lda + pc * 8;
    const bf16_t* gB = Bt + (size_t)(wid * 32 + prow) * ldb + pc * 8;
    const size_t a8 = (size_t)8 * lda, b8 = (size_t)8 * ldb;
#define GEMM_ISSUE(kt, st) do { \
        _Pragma("unroll") for (int _i = 0; _i < 4; ++_i) { \
            __builtin_amdgcn_global_load_lds((const unsigned*)(gA + _i * a8 + (size_t)(kt) * 64), (LDS_AS unsigned*)(lds + (st) * GEMM_STAGE + (wid * 4 + _i) * 1024), 16, 0, 0); \
            __builtin_amdgcn_global_load_lds((const unsigned*)(gB + _i * b8 + (size_t)(kt) * 64), (LDS_AS unsigned*)(lds + (st) * GEMM_STAGE + 16384 + (wid * 4 + _i) * 1024), 16, 0, 0); \
        } } while (0)
    const int swz0 = ((0 * 4 + fq) ^ (fr & 7)) * 16, swz1 = ((1 * 4 + fq) ^ (fr & 7)) * 16;
    const int aoff = (wr * 64 + fr) * 128, boff = 16384 + (wc * 64 + fr) * 128;
    if (!PRE) GEMM_ISSUE(0, 0);
#pragma unroll 1
    for (int kt = 0; kt < nk; ++kt) {
        const int st = kt & 1;
        asm volatile("s_waitcnt vmcnt(0)" ::: "memory");
        __builtin_amdgcn_s_barrier();
        asm volatile("" ::: "memory");
        if (kt + 1 < nk) GEMM_ISSUE(kt + 1, st ^ 1);
        else if (NEXT) {
            const bf16_t* qA = nA + (size_t)(wid * 32 + prow) * nlda + pc * 8;
            const bf16_t* qB = nB + (size_t)(wid * 32 + prow) * nldb + pc * 8;
#pragma unroll
            for (int _i = 0; _i < 4; ++_i) {
                __builtin_amdgcn_global_load_lds((const unsigned*)(qA + (size_t)(_i * 8) * nlda), (LDS_AS unsigned*)(lds + (wid * 4 + _i) * 1024), 16, 0, 0);
                __builtin_amdgcn_global_load_lds((const unsigned*)(qB + (size_t)(_i * 8) * nldb), (LDS_AS unsigned*)(lds + 16384 + (wid * 4 + _i) * 1024), 16, 0, 0);
            }
        }
        const LDS_AS unsigned char* sb = lds + st * GEMM_STAGE;
        bf16x8 af0[4], bf0[4], af1[4], bf1[4];
#pragma unroll
        for (int mi = 0; mi < 4; ++mi) af0[mi] = *(const LDS_AS bf16x8*)(sb + aoff + mi * 2048 + swz0);
#pragma unroll
        for (int ni = 0; ni < 4; ++ni) bf0[ni] = *(const LDS_AS bf16x8*)(sb + boff + ni * 2048 + swz0);
#pragma unroll
        for (int mi = 0; mi < 4; ++mi) af1[mi] = *(const LDS_AS bf16x8*)(sb + aoff + mi * 2048 + swz1);
#pragma unroll
        for (int ni = 0; ni < 4; ++ni) bf1[ni] = *(const LDS_AS bf16x8*)(sb + boff + ni * 2048 + swz1);
#pragma unroll
        for (int mi = 0; mi < 4; ++mi)
#pragma unroll
            for (int ni = 0; ni < 4; ++ni)
                acc[mi][ni] = __builtin_amdgcn_mfma_f32_16x16x32_bf16(bf0[ni], af0[mi], acc[mi][ni], 0, 0, 0);
#pragma unroll
        for (int mi = 0; mi < 4; ++mi)
#pragma unroll
            for (int ni = 0; ni < 4; ++ni)
                acc[mi][ni] = __builtin_amdgcn_mfma_f32_16x16x32_bf16(bf1[ni], af1[mi], acc[mi][ni], 0, 0, 0);
        __builtin_amdgcn_sched_group_barrier(0x100, 8, 0);
#pragma unroll
        for (int q = 0; q < 8; ++q) { __builtin_amdgcn_sched_group_barrier(0x008, 2, 0); __builtin_amdgcn_sched_group_barrier(0x100, 1, 0); }
        __builtin_amdgcn_sched_group_barrier(0x008, 16, 0);
        asm volatile("s_waitcnt lgkmcnt(0)" ::: "memory");
        __builtin_amdgcn_s_barrier();
        asm volatile("" ::: "memory");
    }
#undef GEMM_ISSUE
}
#define GW_STAGE 24576
__device__ __forceinline__ void gemmW(const bf16_t* __restrict__ A, int lda, const bf16_t* __restrict__ Bt, int ldb, int K,
                                      unsigned char* smem, f32x4 (&acc)[4][8]) {
    LDS_AS unsigned char* lds = (LDS_AS unsigned char*)smem;
    const int tid = threadIdx.x, lane = tid & 63, wid = __builtin_amdgcn_readfirstlane(tid >> 6);
    const int wr = wid >> 1, wc = wid & 1, fr = lane & 15, fq = lane >> 4;
    const int nk = K / 32;
    const int prow = lane >> 2, pc = (lane & 3) ^ ((4 - ((prow >> 2) & 3)) & 3);
    const bf16_t* gA = A + (size_t)(wid * 32 + prow) * lda + pc * 8;
    const bf16_t* gB = Bt + (size_t)(wid * 64 + prow) * ldb + pc * 8;
    const size_t a16 = (size_t)16 * lda, b16 = (size_t)16 * ldb;
#define GW_ISSUE(kt, st) do { \
        _Pragma("unroll") for (int _i = 0; _i < 2; ++_i) \
            __builtin_amdgcn_global_load_lds((const unsigned*)(gA + _i * a16 + (size_t)(kt) * 32), (LDS_AS unsigned*)(lds + (st) * GW_STAGE + (wid * 2 + _i) * 1024), 16, 0, 0); \
        _Pragma("unroll") for (int _i = 0; _i < 4; ++_i) \
            __builtin_amdgcn_global_load_lds((const unsigned*)(gB + _i * b16 + (size_t)(kt) * 32), (LDS_AS unsigned*)(lds + (st) * GW_STAGE + 8192 + (wid * 4 + _i) * 1024), 16, 0, 0); \
        } while (0)
    const int swz = (fq ^ ((4 - ((fr >> 2) & 3)) & 3)) * 16;
    const int aoff = (wr * 64 + fr) * 64 + swz, boff = 8192 + (wc * 128 + fr) * 64 + swz;
    GW_ISSUE(0, 0);
#pragma unroll 1
    for (int kt = 0; kt < nk; ++kt) {
        const int st = kt & 1;
        asm volatile("s_waitcnt vmcnt(0)" ::: "memory");
        __builtin_amdgcn_s_barrier();
        asm volatile("" ::: "memory");
        if (kt + 1 < nk) GW_ISSUE(kt + 1, st ^ 1);
        const LDS_AS unsigned char* sb = lds + st * GW_STAGE;
        bf16x8 af[4], bfr[8];
#pragma unroll
        for (int mi = 0; mi < 4; ++mi) af[mi] = *(const LDS_AS bf16x8*)(sb + aoff + mi * 1024);
#pragma unroll
        for (int ni = 0; ni < 8; ++ni) bfr[ni] = *(const LDS_AS bf16x8*)(sb + boff + ni * 1024);
#pragma unroll
        for (int ni = 0; ni < 8; ++ni)
#pragma unroll
            for (int mi = 0; mi < 4; ++mi)
                acc[mi][ni] = __builtin_amdgcn_mfma_f32_16x16x32_bf16(bfr[ni], af[mi], acc[mi][ni], 0, 0, 0);
        asm volatile("s_waitcnt lgkmcnt(0)" ::: "memory");
        __builtin_amdgcn_s_barrier();
        asm volatile("" ::: "memory");
    }
#undef GW_ISSUE
}
__device__ __forceinline__ void zero_accw(f32x4 (&acc)[4][8]) {
#pragma unroll
    for (int a = 0; a < 4; ++a)
#pragma unroll
        for (int b = 0; b < 8; ++b) acc[a][b] = (f32x4){0.f, 0.f, 0.f, 0.f};
}
__device__ __forceinline__ void zero_acc(f32x4 (&acc)[4][4]) {
#pragma unroll
    for (int a = 0; a < 4; ++a)
#pragma unroll
        for (int b = 0; b < 4; ++b) acc[a][b] = (f32x4){0.f, 0.f, 0.f, 0.f};
}
#define GEMM_SMEM (2 * GEMM_STAGE)

__device__ void ph_gemm_in(const Params& p, unsigned char* smem, const int vb) {
    const int ntn = INW / 128;
    const int tid = threadIdx.x, lane = tid & 63, wid = tid >> 6, wr = wid >> 1, wc = wid & 1, fr = lane & 15, fq = lane >> 4;
    const int ntiles = (T_TOK / 128) * ntn;
    bool pre = false;
    for (int t = vb; t < ntiles; t += gridDim.x) {
        const int m0 = (t / ntn) * 128, n0 = (t % ntn) * 128;
        const int tn = t + gridDim.x;
        const bool has_next = tn < ntiles;
        const bf16_t* nA = p.xb + (size_t)((has_next ? tn : t) / ntn) * 128 * DM;
        const bf16_t* nB = p.WinT + (size_t)((has_next ? tn : t) % ntn) * 128 * DM;
        f32x4 acc[4][4]; zero_acc(acc);
        if (pre) { if (has_next) gemm128<true, true>(p.xb + (size_t)m0 * DM, DM, p.WinT + (size_t)n0 * DM, DM, DM, smem, acc, nA, DM, nB, DM);
                   else          gemm128<true, false>(p.xb + (size_t)m0 * DM, DM, p.WinT + (size_t)n0 * DM, DM, DM, smem, acc); }
        else     { if (has_next) gemm128<false, true>(p.xb + (size_t)m0 * DM, DM, p.WinT + (size_t)n0 * DM, DM, DM, smem, acc, nA, DM, nB, DM);
                   else          gemm128<false, false>(p.xb + (size_t)m0 * DM, DM, p.WinT + (size_t)n0 * DM, DM, DM, smem, acc); }
        pre = has_next;
        if (n0 >= 768) {
            const int cb = ((n0 - 768) >> 7) * 64 + wc * 32 + fq * 4;
#pragma unroll
            for (int mi = 0; mi < 4; ++mi) {
                const int row = m0 + wr * 64 + mi * 16 + fr;
#pragma unroll
                for (int k2 = 0; k2 < 2; ++k2) {
                    const f32x4 a = acc[mi][2 * k2], gt = acc[mi][2 * k2 + 1];
                    uint2 o; o.x = pack2(sigmul(a[0], gt[0]), sigmul(a[1], gt[1])); o.y = pack2(sigmul(a[2], gt[2]), sigmul(a[3], gt[3]));
                    *(uint2*)(p.hb + (size_t)row * INW + 768 + cb + k2 * 16) = o;
                }
            }
        } else {
#pragma unroll
        for (int mi = 0; mi < 4; ++mi) {
            const int row = m0 + wr * 64 + mi * 16 + fr;
#pragma unroll
            for (int ni = 0; ni < 4; ++ni) {
                const int col0 = n0 + wc * 64 + ni * 16;
                f32x4 v = acc[mi][ni];
                if (col0 < 640 && (col0 & 63) == 0) {
                    const f32x4 cs = *(const f32x4*)(p.rope + (size_t)row * 16 + (fq & 1) * 4), sn = *(const f32x4*)(p.rope + (size_t)row * 16 + 8 + (fq & 1) * 4);
#pragma unroll
                    for (int r = 0; r < 4; ++r) {
                        const float other = __shfl_xor(v[r], 32);
                        v[r] = (fq < 2) ? (v[r] * cs[r] - other * sn[r]) : (v[r] * cs[r] + other * sn[r]);
                    }
                }
                uint2 o; o.x = pack2(v[0], v[1]); o.y = pack2(v[2], v[3]);
                *(uint2*)(p.hb + (size_t)row * INW + col0 + fq * 4) = o;
            }
        }
        }
    }
}

#define ASTR 72
#define VSTR 260
typedef float f32x16 __attribute__((ext_vector_type(16)));
typedef unsigned u32x2 __attribute__((ext_vector_type(2)));
__device__ void ph_attn(const Params& p, unsigned char* smem, const int vb) {
    bf16_t* sK = (bf16_t*)smem;
    bf16_t* sVt = sK + 256 * ASTR;
    const int tid = threadIdx.x, lane = tid & 63, wid = tid >> 6, r32 = lane & 31, hh = lane >> 5;
    const float C1 = 0.125f * 1.4426950408889634f, LOG2E = 1.4426950408889634f;
    for (int u = vb; u < 16 * 16 * 2; u += gridDim.x) {
        const int kvh = u & 1, nb = (u >> 1) & 15, b = u >> 5;
        __syncthreads();
        for (int c = tid; c < 256 * 8; c += 256) {
            const int li = c >> 3, kc = c & 7;
            const int pos = nb * 128 - 128 + li;
            u32x4 kv = {0u, 0u, 0u, 0u}, vv = {0u, 0u, 0u, 0u};
            if (pos >= 0) {
                const bf16_t* base = p.hb + (size_t)(b * SEQ + pos) * INW;
                kv = *(const u32x4*)(base + 512 + kvh * 64 + kc * 8);
                vv = *(const u32x4*)(base + 640 + kvh * 64 + kc * 8);
            }
            *(u32x4*)(sK + li * ASTR + kc * 8) = kv;
#pragma unroll
            for (int i = 0; i < 4; ++i) {
                sVt[(kc * 8 + 2 * i) * VSTR + li] = (bf16_t)(vv[i] & 0xffffu);
                sVt[(kc * 8 + 2 * i + 1) * VSTR + li] = (bf16_t)(vv[i] >> 16);
            }
        }
        __syncthreads();
        const int hq = kvh * 4 + wid;
        const float sink2 = p.sinks[hq] * LOG2E;
        bf16x8 qn[4];
        {
            const size_t tr0 = (size_t)(b * SEQ + nb * 128 + r32);
#pragma unroll
            for (int ks = 0; ks < 4; ++ks) qn[ks] = *(const bf16x8*)(p.hb + tr0 * INW + hq * 64 + ks * 16 + hh * 8);
        }
#pragma unroll 1
        for (int qt = 0; qt < 4; ++qt) {
            const size_t trow = (size_t)(b * SEQ + nb * 128 + qt * 32 + r32);
            bf16x8 qf[4];
#pragma unroll
            for (int ks = 0; ks < 4; ++ks) qf[ks] = qn[ks];
            {
                const size_t trn = (size_t)(b * SEQ + nb * 128 + (qt < 3 ? qt + 1 : qt) * 32 + r32);
#pragma unroll
                for (int ks = 0; ks < 4; ++ks) qn[ks] = *(const bf16x8*)(p.hb + trn * INW + hq * 64 + ks * 16 + hh * 8);
            }
            f32x16 S[5];
#pragma unroll
            for (int j = 0; j < 5; ++j) {
#pragma unroll
                for (int r = 0; r < 16; ++r) S[j][r] = 0.f;
#pragma unroll
                for (int ks = 0; ks < 4; ++ks) {
                    const bf16x8 a = *(const bf16x8*)(sK + ((qt + j) * 32 + r32) * ASTR + ks * 16 + hh * 8);
                    S[j] = __builtin_amdgcn_mfma_f32_32x32x16_bf16(a, qf[ks], S[j], 0, 0, 0);
                }
            }
            float m2 = sink2;
#pragma unroll
            for (int j = 0; j < 5; ++j) {
                const bool tile_ok = (nb > 0) || (qt + j >= 4);
#pragma unroll
                for (int r = 0; r < 16; ++r) {
                    const int kl = (r & 3) + 8 * (r >> 2) + 4 * hh;
                    bool ok = tile_ok;
                    if (j == 0) ok = ok && (kl > r32);
                    if (j == 4) ok = ok && (kl <= r32);
                    const float t = ok ? S[j][r] * C1 : -1.0e30f;
                    S[j][r] = t;
                    m2 = fmaxf(m2, t);
                }
            }
            m2 = fmaxf(m2, __shfl_xor(m2, 32));
            float l = 0.f;
#pragma unroll
            for (int j = 0; j < 5; ++j)
#pragma unroll
                for (int r = 0; r < 16; ++r) { const float e = __builtin_amdgcn_exp2f(S[j][r] - m2); S[j][r] = e; l += e; }
            l += __shfl_xor(l, 32);
            l += __builtin_amdgcn_exp2f(sink2 - m2);
            f32x16 O[2];
#pragma unroll
            for (int dt = 0; dt < 2; ++dt)
#pragma unroll
                for (int r = 0; r < 16; ++r) O[dt][r] = 0.f;
#pragma unroll
            for (int j = 0; j < 5; ++j)
#pragma unroll
                for (int s2 = 0; s2 < 2; ++s2) {
                    u32x4 pw;
#pragma unroll
                    for (int k = 0; k < 4; ++k) pw[k] = pack2(S[j][8 * s2 + 2 * k], S[j][8 * s2 + 2 * k + 1]);
                    const bf16x8 pf = __builtin_bit_cast(bf16x8, pw);
                    const int kbase = (qt + j) * 32 + 16 * s2 + 4 * hh;
#pragma unroll
                    for (int dt = 0; dt < 2; ++dt) {
                        const bf16_t* vp = sVt + (dt * 32 + r32) * VSTR + kbase;
                        const u32x2 v0 = *(const u32x2*)(vp), v1 = *(const u32x2*)(vp + 8);
                        const u32x4 vw = {v0[0], v0[1], v1[0], v1[1]};
                        O[dt] = __builtin_amdgcn_mfma_f32_32x32x16_bf16(__builtin_bit_cast(bf16x8, vw), pf, O[dt], 0, 0, 0);
                    }
                }
            const float il = __builtin_amdgcn_rcpf(l);
#pragma unroll
            for (int dt = 0; dt < 2; ++dt)
#pragma unroll
                for (int g = 0; g < 4; ++g) {
                    u32x2 w;
                    w[0] = pack2(O[dt][4 * g] * il, O[dt][4 * g + 1] * il);
                    w[1] = pack2(O[dt][4 * g + 2] * il, O[dt][4 * g + 3] * il);
                    *(u32x2*)(p.mixb + trow * DM + hq * 64 + dt * 32 + 8 * g + 4 * hh) = w;
                }
        }
    }
}

#define CV_ROWS 62
__device__ void ph_conv(const Params& p, unsigned char* smem, const int vb) {
    bf16_t* gl = (bf16_t*)smem;
    float* red = (float*)(smem + CV_ROWS * 1024);
    const int tid = threadIdx.x, lane = tid & 63, wid = tid >> 6;
    const f32x2 lg = *(const f32x2*)(p.cln_g + 2 * tid), lb = *(const f32x2*)(p.cln_b + 2 * tid);
    for (int u = vb; u < T_TOK / 32; u += gridDim.x) {
        const int tok0 = u * 32, s0 = tok0 & (SEQ - 1);
        __syncthreads();
#pragma unroll 1
        for (int bt = 0; bt < 2; ++bt) {
            u32x4 av[8];
#pragma unroll
            for (int it = 0; it < 8; ++it) {
                const int ch = tid + (bt * 8 + it) * 256, row = min(ch >> 6, CV_ROWS - 1), k = ch & 63;
                const int rr = (s0 - 30 + row >= 0) ? row : 30;
                av[it] = *(const u32x4*)(p.hb + (size_t)(tok0 - 30 + rr) * INW + 768 + k * 8);
            }
#pragma unroll
            for (int it = 0; it < 8; ++it) {
                const int ch = tid + (bt * 8 + it) * 256, row = ch >> 6, k = ch & 63;
                const bool ok = (s0 - 30 + row >= 0);
                const u32x4 o = ok ? av[it] : (u32x4){0u, 0u, 0u, 0u};
                if (row < CV_ROWS) *(u32x4*)(gl + row * 512 + k * 8) = o;
            }
        }
        __syncthreads();
        float w0[31], w1[31];
#pragma unroll
        for (int k = 0; k < 31; ++k) { const f32x2 wv = *(const f32x2*)(p.conv_w + k * 512 + 2 * tid); w0[k] = wv.x; w1[k] = wv.y; }
        const f32x2 bias = *(const f32x2*)(p.conv_b + 2 * tid);
#pragma unroll 1
        for (int jh = 0; jh < 2; ++jh) {
            float a0[16], a1[16];
#pragma unroll
            for (int jl = 0; jl < 16; ++jl) { a0[jl] = bias.x; a1[jl] = bias.y; }
            const bf16_t* gp = gl + (jh * 16) * 512 + 2 * tid;
#pragma unroll
            for (int il = 0; il < 46; ++il) {
                const unsigned gw = *(const unsigned*)(gp + il * 512);
                const float g0 = bflo(gw), g1 = bfhi(gw);
#pragma unroll
                for (int jl = 0; jl < 16; ++jl)
                    if (il - jl >= 0 && il - jl <= 30) { a0[jl] += w0[il - jl] * g0; a1[jl] += w1[il - jl] * g1; }
                if ((il & 3) == 3) __builtin_amdgcn_sched_barrier(0);
            }
            float v[32];
#pragma unroll
            for (int jl = 0; jl < 16; ++jl) { v[jl] = a0[jl] + a1[jl]; v[16 + jl] = a0[jl] * a0[jl] + a1[jl] * a1[jl]; }
#pragma unroll
            for (int st = 16; st >= 1; st >>= 1) {
                const bool up = (lane & st) != 0;
#pragma unroll
                for (int i2 = 0; i2 < st; ++i2) {
                    const float keep = up ? v[i2 + st] : v[i2], send = up ? v[i2] : v[i2 + st];
                    v[i2] = keep + __shfl_xor(send, st);
                }
            }
            const float tot = v[0] + __shfl_xor(v[0], 32);
            __syncthreads();
            if (lane < 32) red[wid * 32 + lane] = tot;
            __syncthreads();
#pragma unroll
            for (int jl = 0; jl < 16; ++jl) {
                const float sm = (red[jl] + red[32 + jl]) + (red[64 + jl] + red[96 + jl]);
                const float sq = (red[16 + jl] + red[48 + jl]) + (red[80 + jl] + red[112 + jl]);
                const float mu = sm * (1.0f / 512.0f);
                const float rstd = rsqrtf(fmaxf(sq * (1.0f / 512.0f) - mu * mu, 0.f) + LN_EPS);
                const float y0 = (a0[jl] - mu) * rstd * lg.x + lb.x, y1 = (a1[jl] - mu) * rstd * lg.y + lb.y;
                *(unsigned*)(p.mixb + (size_t)(tok0 + jh * 16 + jl) * DM + 512 + 2 * tid) = pack2(sigmul(y0, y0), sigmul(y1, y1));
            }
        }
    }
}

__device__ void ph_gemm_out(const Params& p, unsigned char* smem, const int vb) {
    const int ntn = DM / 256;
    const int tid = threadIdx.x, lane = tid & 63, wid = tid >> 6, wr = wid >> 1, wc = wid & 1, fr = lane & 15, fq = lane >> 4;
    for (int t = vb; t < (T_TOK / 128) * ntn; t += gridDim.x) {
        const int m0 = (t / ntn) * 128, n0 = (t % ntn) * 256;
        f32x4 acc[4][8]; zero_accw(acc);
        gemmW(p.mixb + (size_t)m0 * DM, DM, p.WoutT + (size_t)n0 * DM, DM, DM, smem, acc);
#pragma unroll
        for (int mi = 0; mi < 4; ++mi) {
            const int row = m0 + wr * 64 + mi * 16 + fr;
            float sm = 0.f, sq = 0.f;
#pragma unroll
            for (int ni = 0; ni < 8; ++ni) {
                const int col = n0 + wc * 128 + ni * 16 + fq * 4;
                const f32x4 xv = *(const f32x4*)(p.x + (size_t)row * DM + col);
                const f32x4 y = xv * ALPHA + acc[mi][ni];
                sm += (y[0] + y[1]) + (y[2] + y[3]); sq += (y[0] * y[0] + y[1] * y[1]) + (y[2] * y[2] + y[3] * y[3]);
                u32x2 o; o[0] = pack2(y[0], y[1]); o[1] = pack2(y[2], y[3]);
                *(u32x2*)(p.y1b + (size_t)row * DM + col) = o;
            }
            sm += __shfl_xor(sm, 16); sq += __shfl_xor(sq, 16); sm += __shfl_xor(sm, 32); sq += __shfl_xor(sq, 32);
            if (fq == 0) *(f32x2*)(p.stats + (size_t)row * 16 + ((n0 >> 8) * 2 + wc) * 2) = (f32x2){sm, sq};
        }
    }
}

__device__ __forceinline__ void ln_row(const float* __restrict__ src, const float* __restrict__ g, const float* __restrict__ bta,
                                       float* __restrict__ dstf, bf16_t* __restrict__ dstb, int lane) {
    f32x4 v[4]; float s = 0.f;
#pragma unroll
    for (int i = 0; i < 4; ++i) { v[i] = *(const f32x4*)(src + i * 256 + lane * 4); s += (v[i][0] + v[i][1]) + (v[i][2] + v[i][3]); }
    const float mu = wave_sum(s) * (1.0f / 1024.0f);
    float q = 0.f;
#pragma unroll
    for (int i = 0; i < 4; ++i) { const f32x4 d = v[i] - mu; q += (d[0] * d[0] + d[1] * d[1]) + (d[2] * d[2] + d[3] * d[3]); }
    const float rstd = rsqrtf(wave_sum(q) * (1.0f / 1024.0f) + LN_EPS);
#pragma unroll
    for (int i = 0; i < 4; ++i) {
        const f32x4 gg = *(const f32x4*)(g + i * 256 + lane * 4), bb = *(const f32x4*)(bta + i * 256 + lane * 4);
        const f32x4 y = (v[i] - mu) * rstd * gg + bb;
        if (dstf) *(f32x4*)(dstf + i * 256 + lane * 4) = y;
        if (dstb) { uint2 o; o.x = pack2(y[0], y[1]); o.y = pack2(y[2], y[3]); *(uint2*)(dstb + i * 256 + lane * 4) = o; }
    }
}
__device__ void ph_ln2(const Params& p, const int vb) {
    const int lane = threadIdx.x & 63, wid = threadIdx.x >> 6;
    for (int r = vb * 4 + wid; r < T_TOK; r += gridDim.x * 4)
        ln_row(p.out + (size_t)r * DM, p.ln2_g, p.ln2_b, p.out + (size_t)r * DM, (bf16_t*)nullptr, lane);
}

#define QSTR 136
__device__ __forceinline__ int f2key(float f) { const int b = __float_as_int(f); return b ^ ((b >> 31) & 0x7fffffff); }
__device__ __forceinline__ float key2f(int k) { return __int_as_float(k ^ ((k >> 31) & 0x7fffffff)); }
__device__ __forceinline__ void sort16_desc(int (&a)[16]) {
#pragma unroll
    for (int lk = 1; lk <= 4; ++lk) {
#pragma unroll
        for (int lj = lk - 1; lj >= 0; --lj) {
            const int k = 1 << lk, j = 1 << lj;
#pragma unroll
            for (int i = 0; i < 16; ++i) {
                const int l = i ^ j;
                if (l > i) {
                    const int hi = max(a[i], a[l]), lo = min(a[i], a[l]);
                    if ((i & k) == 0) { a[i] = hi; a[l] = lo; } else { a[i] = lo; a[l] = hi; }
                }
            }
        }
    }
}
__device__ __forceinline__ void merge_top16(int (&a)[16], const int (&b)[16]) {
#pragma unroll
    for (int i = 0; i < 16; ++i) a[i] = max(a[i], b[15 - i]);
#pragma unroll
    for (int lj = 3; lj >= 0; --lj) {
        const int j = 1 << lj;
#pragma unroll
        for (int i = 0; i < 16; ++i) {
            const int l = i ^ j;
            if (l > i) { const int hi = max(a[i], a[l]), lo = min(a[i], a[l]); a[i] = hi; a[l] = lo; }
        }
    }
}
__device__ __forceinline__ void top16_of_64(int (&v)[4][16]) {
    sort16_desc(v[0]); sort16_desc(v[1]); sort16_desc(v[2]); sort16_desc(v[3]);
    merge_top16(v[0], v[1]); merge_top16(v[0], v[2]); merge_top16(v[0], v[3]);
}

__device__ void ph_mprep(const Params& p, unsigned char* smem, const int vb) {
    if (vb < 8) {
        const int n = vb * 256 + threadIdx.x, hp = n >> 7;
        const float* kr = p.keys + (size_t)n * 128;
        float a = 0.f, b = 0.f;
        for (int c4 = 0; c4 < 128; c4 += 4) {
            const f32x4 kv = *(const f32x4*)(kr + c4), wg = *(const f32x4*)(p.wgb + hp * 128 + c4), wb = *(const f32x4*)(p.wgb + 2048 + hp * 128 + c4);
            a += (kv[0] * wg[0] + kv[1] * wg[1]) + (kv[2] * wg[2] + kv[3] * wg[3]);
            b += (kv[0] * wb[0] + kv[1] * wb[1]) + (kv[2] * wb[2] + kv[3] * wb[3]);
        }
        u32x4 c0 = {pack2(a, b), 0u, 0u, 0u}; const u32x4 z4 = {0u, 0u, 0u, 0u};
        u32x4* me = (u32x4*)(p.mext + (size_t)n * 32);
        me[0] = c0; me[1] = z4; me[2] = z4; me[3] = z4;
    }
    const int tid = threadIdx.x, lane = tid & 63, wid = tid >> 6, wr = wid >> 1, wc = wid & 1, fr = lane & 15, fq = lane >> 4;
    for (int t = vb; t < 16 * 8; t += gridDim.x) {
        const int hp = t >> 3, d0 = (t & 7) * 128;
        f32x4 acc[4][4]; zero_acc(acc);
        gemm128(p.keysb + (size_t)hp * 128 * 128, 128, p.Wqb + (size_t)d0 * 2048 + hp * 128, 2048, 128, smem, acc);
#pragma unroll
        for (int mi = 0; mi < 4; ++mi)
#pragma unroll
            for (int ni = 0; ni < 4; ++ni) {
                uint2 o; o.x = pack2(acc[mi][ni][0], acc[mi][ni][1]); o.y = pack2(acc[mi][ni][2], acc[mi][ni][3]);
                *(uint2*)(p.MT + (size_t)(hp * 128 + wr * 64 + mi * 16 + fr) * DM + d0 + wc * 64 + ni * 16 + fq * 4) = o;
            }
    }
}

__device__ __forceinline__ void route_topk(const f32x16 (&S)[8], int pp, int hh, int (&K)[16]) {
    int v[4][16];
#pragma unroll
    for (int mt = 0; mt < 4; ++mt)
#pragma unroll
        for (int r = 0; r < 16; ++r) {
            const int n = mt * 32 + (r & 3) + 8 * (r >> 2) + 4 * hh;
            v[mt][r] = (f2key(S[pp * 4 + mt][r]) & ~0x7F) | (127 - n);
        }
    top16_of_64(v);
    int o[16];
#pragma unroll
    for (int i = 0; i < 16; ++i) o[i] = __shfl_xor(v[0][i], 32);
    merge_top16(v[0], o);
#pragma unroll
    for (int i = 0; i < 16; ++i) K[i] = v[0][i];
}
#define RT_STEPS 33
template <bool PRE, bool NEXT>
__device__ __forceinline__ void route_gemm(const Params& p, unsigned char* smem, int m0, int h, f32x16 (&S)[8], int nm0, int nh, int& sp) {
    LDS_AS unsigned char* lds = (LDS_AS unsigned char*)smem;
    const int tid = threadIdx.x, lane = tid & 63, wid = __builtin_amdgcn_readfirstlane(tid >> 6);
    const int r32 = lane & 31, hh = lane >> 5;
    const int prow = lane >> 2, pc = (lane & 3) ^ ((4 - ((prow >> 2) & 3)) & 3);
    const bf16_t* gA = p.y1b + (size_t)(m0 + wid * 32 + prow) * DM + pc * 8;
    const bf16_t* gB = p.MT + (size_t)(h * 256 + wid * 64 + prow) * DM + pc * 8;
    const bf16_t* eA = p.yext + (size_t)(m0 + wid * 32 + prow) * 32 + pc * 8;
    const bf16_t* eB = p.mext + (size_t)(h * 256 + wid * 64 + prow) * 32 + pc * 8;
    const size_t r16 = (size_t)16 * DM;
#define RH_ISSUE_AT(pa, sa, pb, sb_, st) do { \
        _Pragma("unroll") for (int _i = 0; _i < 2; ++_i) \
            __builtin_amdgcn_global_load_lds((const unsigned*)((pa) + _i * (sa)), (LDS_AS unsigned*)(lds + (st) * GW_STAGE + (wid * 2 + _i) * 1024), 16, 0, 0); \
        _Pragma("unroll") for (int _i = 0; _i < 4; ++_i) \
            __builtin_amdgcn_global_load_lds((const unsigned*)((pb) + _i * (sb_)), (LDS_AS unsigned*)(lds + (st) * GW_STAGE + 8192 + (wid * 4 + _i) * 1024), 16, 0, 0); \
        } while (0)
#pragma unroll
    for (int mt = 0; mt < 8; ++mt)
#pragma unroll
        for (int r = 0; r < 16; ++r) S[mt][r] = 0.f;
    const int fx = (4 - ((r32 >> 2) & 3)) & 3;
    const int toff = (wid * 32 + r32) * 64, koff = 8192 + r32 * 64;
    if (!PRE) RH_ISSUE_AT(gA, r16, gB, r16, sp);
#pragma unroll 1
    for (int kt = 0; kt < RT_STEPS; ++kt) {
        const int st = (kt + sp) & 1;
        asm volatile("s_waitcnt vmcnt(0)" ::: "memory");
        __builtin_amdgcn_s_barrier();
        asm volatile("" ::: "memory");
        if (kt + 1 < RT_STEPS - 1) RH_ISSUE_AT(gA + (size_t)(kt + 1) * 32, r16, gB + (size_t)(kt + 1) * 32, r16, st ^ 1);
        else if (kt + 1 == RT_STEPS - 1) RH_ISSUE_AT(eA, (size_t)(16 * 32), eB, (size_t)(16 * 32), st ^ 1);
        else if (NEXT) {
            const bf16_t* qA = p.y1b + (size_t)(nm0 + wid * 32 + prow) * DM + pc * 8;
            const bf16_t* qB = p.MT + (size_t)(nh * 256 + wid * 64 + prow) * DM + pc * 8;
            RH_ISSUE_AT(qA, r16, qB, r16, st ^ 1);
        }
        const LDS_AS unsigned char* sb = lds + st * GW_STAGE;
#pragma unroll
        for (int k16 = 0; k16 < 2; ++k16) {
            const int sw = ((k16 * 2 + hh) ^ fx) * 16;
            const bf16x8 b = *(const LDS_AS bf16x8*)(sb + toff + sw);
#pragma unroll
            for (int mt = 0; mt < 8; ++mt) {
                const bf16x8 a = *(const LDS_AS bf16x8*)(sb + koff + mt * 2048 + sw);
                S[mt] = __builtin_amdgcn_mfma_f32_32x32x16_bf16(a, b, S[mt], 0, 0, 0);
            }
        }
        asm volatile("s_waitcnt lgkmcnt(0)" ::: "memory");
        __builtin_amdgcn_s_barrier();
        asm volatile("" ::: "memory");
    }
    sp ^= (RT_STEPS & 1);
#undef RH_ISSUE_AT
}

__device__ void ph_route(const Params& p, unsigned char* smem, const int vb) {
    const int tid = threadIdx.x, lane = tid & 63, wid = tid >> 6;
    const int r32 = lane & 31, hh = lane >> 5;
    const int hmask = -hh;
    int* KL = (int*)(smem + 2 * GW_STAGE + (size_t)wid * 32 * 33 * 4);
    const int nunits = (T_TOK / 128) * 8;
    bool pre = false; int sp = 0;
    for (int u = vb; u < nunits; u += gridDim.x) {
        const int m0 = (u >> 3) * 128, h = u & 7;
        const int un = u + gridDim.x;
        const bool has_next = un < nunits;
        const int nm0 = ((has_next ? un : u) >> 3) * 128, nh = (has_next ? un : u) & 7;
        float mu, rstd;
        {
            const float* stp = p.stats + (size_t)(m0 + wid * 32 + r32) * 16;
            const f32x4 a = *(const f32x4*)(stp), b = *(const f32x4*)(stp + 4), c4 = *(const f32x4*)(stp + 8), d = *(const f32x4*)(stp + 12);
            const float sm = (a[0] + a[2]) + (b[0] + b[2]) + (c4[0] + c4[2]) + (d[0] + d[2]);
            const float sq = (a[1] + a[3]) + (b[1] + b[3]) + (c4[1] + c4[3]) + (d[1] + d[3]);
            mu = sm * (1.0f / 1024.0f);
            rstd = rsqrtf(fmaxf(sq * (1.0f / 1024.0f) - mu * mu, 0.f) + LN_EPS);
        }
        {
            bf16_t* ye = p.yext + (size_t)(m0 + wid * 32 + r32) * 32 + hh * 16;
            const u32x4 z4 = {0u, 0u, 0u, 0u};
            u32x4 c0 = z4; if (hh == 0) c0[0] = pack2(-mu, __builtin_amdgcn_rcpf(rstd));
            *(u32x4*)(ye) = c0; *(u32x4*)(ye + 8) = z4;
        }
        f32x16 S[8];
        if (pre) { if (has_next) route_gemm<true, true>(p, smem, m0, h, S, nm0, nh, sp); else route_gemm<true, false>(p, smem, m0, h, S, nm0, nh, sp); }
        else     { if (has_next) route_gemm<false, true>(p, smem, m0, h, S, nm0, nh, sp); else route_gemm<false, false>(p, smem, m0, h, S, nm0, nh, sp); }
        int K0[16], K1[16];
        route_topk(S, 0, hh, K0);
        route_topk(S, 1, hh, K1);
        pre = has_next;
#pragma unroll
        for (int i = 0; i < 16; ++i) KL[r32 * 33 + hh * 16 + i] = K0[i] ^ ((K0[i] ^ K1[i]) & hmask);
        float s1[16], s2[16];
#pragma unroll
        for (int i = 0; i < 16; ++i) { s1[i] = key2f(K0[i] & ~0x7F); s2[i] = key2f(K1[i] & ~0x7F); }
        int c[4][16];
#pragma unroll
        for (int i = 0; i < 16; ++i)
#pragma unroll
            for (int j = 0; j < 16; ++j)
                if ((i + 1) * (j + 1) <= 16) {
                    constexpr int OFFS[16] = {0, 16, 24, 29, 33, 36, 38, 40, 42, 43, 44, 45, 46, 47, 48, 49};
                    const int q = OFFS[i] + j;
                    c[q >> 4][q & 15] = (f2key(s1[i] + s2[j]) & ~0xFF) | (255 - (i * 16 + j));
                }
#pragma unroll
        for (int qq = 50; qq < 64; ++qq) c[qq >> 4][qq & 15] = (int)0x80000000;
        top16_of_64(c);
        const float mx = key2f(c[0][0] & ~0xFF);
        float e[16]; float den = 0.f;
#pragma unroll
        for (int i = 0; i < 16; ++i) { e[i] = __expf(rstd * (key2f(c[0][i] & ~0xFF) - mx)); den += e[i]; }
        const float inv = __builtin_amdgcn_rcpf(den);
        const size_t ob = (size_t)(m0 + wid * 32 + r32) * 128 + h * 16 + hh * 8;
        int idv[8]; float gv[8];
#pragma unroll
        for (int qq = 0; qq < 8; ++qq) {
            const int F = c[0][qq] ^ ((c[0][qq] ^ c[0][8 + qq]) & hmask);
            gv[qq] = __int_as_float(__float_as_int(e[qq]) ^ ((__float_as_int(e[qq]) ^ __float_as_int(e[8 + qq])) & hmask)) * inv;
            const int idx = 255 - (F & 0xFF);
            const int k0 = KL[r32 * 33 + (idx >> 4)], k1 = KL[r32 * 33 + 16 + (idx & 15)];
            idv[qq] = (127 - (k0 & 0x7F)) * 128 + (127 - (k1 & 0x7F));
        }
        *(int4*)(p.ids + ob) = make_int4(idv[0], idv[1], idv[2], idv[3]);
        *(int4*)(p.ids + ob + 4) = make_int4(idv[4], idv[5], idv[6], idv[7]);
        *(float4*)(p.gates + ob) = make_float4(gv[0], gv[1], gv[2], gv[3]);
        *(float4*)(p.gates + ob + 4) = make_float4(gv[4], gv[5], gv[6], gv[7]);
    }
}

__device__ __forceinline__ f32x2 row_dot(const u32x4 w, const f32x2 (&x)[8], f32x2 acc) {
#pragma unroll
    for (int k = 0; k < 4; ++k) {
        acc = __builtin_amdgcn_cvt_pk_f32_fp8(w[k], false) * x[2 * k] + acc;
        acc = __builtin_amdgcn_cvt_pk_f32_fp8(w[k], true) * x[2 * k + 1] + acc;
    }
    return acc;
}
__device__ __forceinline__ float gelu_gate(float h, float g) { return 0.5f * h * (1.0f + erff(h * 0.70710678118654752f)) * g; }

__device__ __forceinline__ void ld_ids16(const int* __restrict__ q, int (&idv)[16]) {
    const int4* idp = (const int4*)q;
#pragma unroll
    for (int k = 0; k < 4; ++k) { const int4 v = idp[k]; idv[4 * k] = v.x; idv[4 * k + 1] = v.y; idv[4 * k + 2] = v.z; idv[4 * k + 3] = v.w; }
}
__device__ __forceinline__ void ld_f16(const float* __restrict__ q, float (&a)[16]) {
    const f32x4* ap = (const f32x4*)q;
#pragma unroll
    for (int k = 0; k < 4; ++k) { const f32x4 v = ap[k]; a[4 * k] = v[0]; a[4 * k + 1] = v[1]; a[4 * k + 2] = v[2]; a[4 * k + 3] = v[3]; }
}
__device__ void ph_peer_u(const Params& p, unsigned char* smem, const int vb) {
    const int lane = threadIdx.x & 63, wid = __builtin_amdgcn_readfirstlane(threadIdx.x >> 6), g = lane >> 3, c = lane & 7;
    const int nlb = gridDim.x >> 3, s = vb / nlb, lb = vb - s * nlb;
    const bool b2 = (lane & 4) != 0, b1 = (lane & 2) != 0, b0 = (lane & 1) != 0;
    const int cc = (b0 ? 2 : 0) + (b1 ? 4 : 0) + (b2 ? 8 : 0);
    const unsigned char* ubase = p.u8 + (size_t)s * (16384 * 128) + c * 16;
    const int stride = nlb * 4, t0 = lb * 4 + wid;
    const int ntok = (T_TOK - t0 + stride - 1) / stride;
    if (ntok <= 0) return;
    LDS_AS unsigned char* ring = (LDS_AS unsigned char*)smem + wid * 2048;
    const int* idg = p.ids + 2 * lane;
    const bf16_t* xg = p.y1b + s * 128 + 2 * lane;
#define PU_TOK(n) (t0 + ((n) < ntok ? (n) : ntok - 1) * stride)
#define PU_RAW_LD(n, ri, rx) do { const int _t = PU_TOK(n); ri = *(const u32x2*)(idg + (size_t)_t * 128); const unsigned _w = *(const unsigned*)(xg + (size_t)_t * DM); rx = (u32x2){_w << 16, _w & 0xffff0000u}; } while (0)
#define PU_RAW_ST(n, ri, rx) do { LDS_AS unsigned char* _b = ring + ((n) & 1) * 1024; *(LDS_AS u32x2*)(_b + lane * 8) = ri; *(LDS_AS u32x2*)(_b + 512 + lane * 8) = rx; } while (0)
#define PU_IDS(n, idv) do { const LDS_AS u32x4* _q = (const LDS_AS u32x4*)(ring + ((n) & 1) * 1024 + g * 64); \
        _Pragma("unroll") for (int _k = 0; _k < 4; ++_k) { const u32x4 _v = _q[_k]; idv[4 * _k] = (int)_v[0]; idv[4 * _k + 1] = (int)_v[1]; idv[4 * _k + 2] = (int)_v[2]; idv[4 * _k + 3] = (int)_v[3]; } } while (0)
    u32x4 wA[8], wB[8]; u32x2 ri, rx;
    {
        u32x2 i0, x0, i1, x1v;
        PU_RAW_LD(0, i0, x0); PU_RAW_LD(1, i1, x1v); PU_RAW_LD(2, ri, rx);
        PU_RAW_ST(0, i0, x0); PU_RAW_ST(1, i1, x1v);
        int id0[16]; PU_IDS(0, id0);
#pragma unroll
        for (int i = 0; i < 8; ++i) wA[i] = *(const u32x4*)(ubase + (size_t)id0[i] * 128);
#pragma unroll
        for (int i = 0; i < 8; ++i) wB[i] = *(const u32x4*)(ubase + (size_t)id0[8 + i] * 128);
    }
#pragma unroll 1
    for (int n = 0; n < ntok; ++n) {
        const int t = t0 + n * stride;
        f32x2 x[8];
        {
            const LDS_AS f32x4* q = (const LDS_AS f32x4*)(ring + (n & 1) * 1024 + 512 + c * 64);
#pragma unroll
            for (int k = 0; k < 4; ++k) { const f32x4 v4 = q[k]; x[2 * k] = (f32x2){v4[0], v4[1]}; x[2 * k + 1] = (f32x2){v4[2], v4[3]}; }
        }
        int idn[16]; PU_IDS(n + 1, idn);
        float v[16];
#pragma unroll
        for (int i = 0; i < 8; ++i) { const f32x2 a = row_dot(wA[i], x, (f32x2){0.f, 0.f}); v[i] = a.x + a.y; }
#pragma unroll
        for (int i = 0; i < 8; ++i) wA[i] = *(const u32x4*)(ubase + (size_t)idn[i] * 128);
#pragma unroll
        for (int i = 0; i < 8; ++i) { const f32x2 a = row_dot(wB[i], x, (f32x2){0.f, 0.f}); v[8 + i] = a.x + a.y; }
#pragma unroll
        for (int i = 0; i < 8; ++i) wB[i] = *(const u32x4*)(ubase + (size_t)idn[8 + i] * 128);
        PU_RAW_ST(n + 2, ri, rx);
        PU_RAW_LD(n + 3, ri, rx);
#pragma unroll
        for (int i = 0; i < 8; ++i) { const float keep = b2 ? v[i + 8] : v[i], send = b2 ? v[i] : v[i + 8]; v[i] = keep + __shfl_xor(send, 4); }
#pragma unroll
        for (int i = 0; i < 4; ++i) { const float keep = b1 ? v[i + 4] : v[i], send = b1 ? v[i] : v[i + 4]; v[i] = keep + __shfl_xor(send, 2); }
#pragma unroll
        for (int i = 0; i < 2; ++i) { const float keep = b0 ? v[i + 2] : v[i], send = b0 ? v[i] : v[i + 2]; v[i] = keep + __shfl_xor(send, 1); }
        *(unsigned*)(p.hp + ((size_t)t * 8 + s) * 128 + g * 16 + cc) = pack2(v[0], v[1]);
    }
}
__device__ void ph_peer_act(const Params& p, unsigned char* smem, const int vb) {
    const int lane = threadIdx.x & 63, wid = threadIdx.x >> 6;
    unsigned* lsc = (unsigned*)smem;
    __syncthreads();
    for (int i = threadIdx.x; i < 16384 / 4; i += 256) *(u32x4*)(lsc + 4 * i) = *(const u32x4*)((const unsigned*)p.sc2 + 4 * i);
    __syncthreads();
    for (int t = vb * 4 + wid; t < T_TOK; t += gridDim.x * 4) {
        f32x2 h = {0.f, 0.f};
#pragma unroll
        for (int s = 0; s < 8; ++s) { const unsigned w = *(const unsigned*)(p.hp + ((size_t)t * 8 + s) * 128 + 2 * lane); h += (f32x2){bflo(w), bfhi(w)}; }
        f32x2 pq = *(const f32x2*)(p.stats + (size_t)t * 16 + (lane & 7) * 2);
        pq.x += __shfl_xor(pq.x, 1); pq.y += __shfl_xor(pq.y, 1); pq.x += __shfl_xor(pq.x, 2); pq.y += __shfl_xor(pq.y, 2); pq.x += __shfl_xor(pq.x, 4); pq.y += __shfl_xor(pq.y, 4);
        const float mu = pq.x * (1.0f / 1024.0f), rstd = rsqrtf(fmaxf(pq.y * (1.0f / 1024.0f) - mu * mu, 0.f) + LN_EPS);
        int2 id = *(const int2*)(p.ids + (size_t)t * 128 + 2 * lane);
        id.x &= 0x3fff; id.y &= 0x3fff;
        const f32x2 gt = *(const f32x2*)(p.gates + (size_t)t * 128 + 2 * lane);
        const unsigned s0 = lsc[id.x], s1 = lsc[id.y];
        const unsigned c0 = p.cb2[id.x], c1 = p.cb2[id.y];
        f32x2 a;
        a.x = gelu_gate(rstd * (h.x * bflo(s0) - mu * bflo(c0)) + bfhi(c0), gt.x) * bfhi(s0);
        a.y = gelu_gate(rstd * (h.y * bflo(s1) - mu * bflo(c1)) + bfhi(c1), gt.y) * bfhi(s1);
        *(f32x2*)(p.gates + (size_t)t * 128 + 2 * lane) = a;
        if (lane < 2) {
            const unsigned pb = __float_as_uint(lane ? rstd : mu);
            *(int2*)(p.ids + (size_t)t * 128 + 2 * lane) = make_int2(id.x | (int)(pb & 0xffff0000u), id.y | (int)(pb << 16));
        }
    }
}
__device__ void ph_peer_v(const Params& p, unsigned char* smem, const int vb) {
    const int lane = threadIdx.x & 63, wid = __builtin_amdgcn_readfirstlane(threadIdx.x >> 6), g = lane >> 3, c = lane & 7;
    const int nlb = gridDim.x >> 3, s = vb / nlb, lb = vb - s * nlb;
    const bool b4 = (lane & 16) != 0, b3 = (lane & 8) != 0;
    const unsigned char* vbase = p.v8 + (size_t)s * (16384 * 128) + c * 16;
    const int stride = nlb * 4, t0 = lb * 4 + wid;
    const int ntok = (T_TOK - t0 + stride - 1) / stride;
    if (ntok <= 0) return;
    const int d0 = s * 128 + c * 16 + 2 * g;
    LDS_AS unsigned char* ring = (LDS_AS unsigned char*)smem + wid * 2048;
    const int* idg = p.ids + 2 * lane;
    const float* ag = p.gates + 2 * lane;
#define PV_RAW_LD(n, ri, rx) do { const int _t = PU_TOK(n); ri = *(const u32x2*)(idg + (size_t)_t * 128); rx = *(const u32x2*)(ag + (size_t)_t * 128); } while (0)
    u32x4 wA[8], wB[8]; u32x2 ri, rx;
    float mu_c, rs_c;
    const f32x2 g2 = *(const f32x2*)(p.ln1_g + d0), b2 = *(const f32x2*)(p.ln1_b + d0);
    {
        u32x2 i0, x0, i1, x1v;
        PV_RAW_LD(0, i0, x0); PV_RAW_LD(1, i1, x1v); PV_RAW_LD(2, ri, rx);
        PU_RAW_ST(0, i0, x0); PU_RAW_ST(1, i1, x1v);
        int id0[16]; PU_IDS(0, id0);
        mu_c = __uint_as_float(((unsigned)__builtin_amdgcn_readlane(id0[0], 0) & 0xffff0000u) | ((unsigned)__builtin_amdgcn_readlane(id0[1], 0) >> 16));
        rs_c = __uint_as_float(((unsigned)__builtin_amdgcn_readlane(id0[2], 0) & 0xffff0000u) | ((unsigned)__builtin_amdgcn_readlane(id0[3], 0) >> 16));
#pragma unroll
        for (int i = 0; i < 16; ++i) id0[i] &= 0x3fff;
#pragma unroll
        for (int i = 0; i < 8; ++i) wA[i] = *(const u32x4*)(vbase + (size_t)id0[i] * 128);
#pragma unroll
        for (int i = 0; i < 8; ++i) wB[i] = *(const u32x4*)(vbase + (size_t)id0[8 + i] * 128);
    }
#pragma unroll 1
    for (int n = 0; n < ntok; ++n) {
        const int t = t0 + n * stride;
        const unsigned yw = *(const unsigned*)(p.y1b + (size_t)t * DM + d0);
        const float mu = mu_c, rs = rs_c;
        const f32x2 xv = {(bflo(yw) - mu) * rs * g2.x + b2.x, (bfhi(yw) - mu) * rs * g2.y + b2.y};
        float ac[16];
        {
            const LDS_AS f32x4* q = (const LDS_AS f32x4*)(ring + (n & 1) * 1024 + 512 + g * 64);
#pragma unroll
            for (int k = 0; k < 4; ++k) { const f32x4 v4 = q[k]; ac[4 * k] = v4[0]; ac[4 * k + 1] = v4[1]; ac[4 * k + 2] = v4[2]; ac[4 * k + 3] = v4[3]; }
        }
        int idn[16]; PU_IDS(n + 1, idn);
        mu_c = __uint_as_float(((unsigned)__builtin_amdgcn_readlane(idn[0], 0) & 0xffff0000u) | ((unsigned)__builtin_amdgcn_readlane(idn[1], 0) >> 16));
        rs_c = __uint_as_float(((unsigned)__builtin_amdgcn_readlane(idn[2], 0) & 0xffff0000u) | ((unsigned)__builtin_amdgcn_readlane(idn[3], 0) >> 16));
#pragma unroll
        for (int i = 0; i < 16; ++i) idn[i] &= 0x3fff;
        f32x2 acc[8];
#pragma unroll
        for (int k = 0; k < 8; ++k) acc[k] = (f32x2){0.f, 0.f};
#pragma unroll
        for (int i = 0; i < 8; ++i) {
            const f32x2 a2 = {ac[i], ac[i]};
#pragma unroll
            for (int k = 0; k < 4; ++k) {
                acc[2 * k] = __builtin_amdgcn_cvt_pk_f32_fp8(wA[i][k], false) * a2 + acc[2 * k];
                acc[2 * k + 1] = __builtin_amdgcn_cvt_pk_f32_fp8(wA[i][k], true) * a2 + acc[2 * k + 1];
            }
        }
#pragma unroll
        for (int i = 0; i < 8; ++i) wA[i] = *(const u32x4*)(vbase + (size_t)idn[i] * 128);
#pragma unroll
        for (int i = 0; i < 8; ++i) {
            const f32x2 a2 = {ac[8 + i], ac[8 + i]};
#pragma unroll
            for (int k = 0; k < 4; ++k) {
                acc[2 * k] = __builtin_amdgcn_cvt_pk_f32_fp8(wB[i][k], false) * a2 + acc[2 * k];
                acc[2 * k + 1] = __builtin_amdgcn_cvt_pk_f32_fp8(wB[i][k], true) * a2 + acc[2 * k + 1];
            }
        }
#pragma unroll
        for (int i = 0; i < 8; ++i) wB[i] = *(const u32x4*)(vbase + (size_t)idn[8 + i] * 128);
        PU_RAW_ST(n + 2, ri, rx);
        PV_RAW_LD(n + 3, ri, rx);
        float v[16];
#pragma unroll
        for (int k = 0; k < 8; ++k) { v[2 * k] = acc[k].x; v[2 * k + 1] = acc[k].y; }
#pragma unroll
        for (int j2 = 0; j2 < 8; ++j2) {
            auto r = __builtin_amdgcn_permlane32_swap(__float_as_uint(v[j2]), __float_as_uint(v[j2 + 8]), false, false);
            v[j2] = __uint_as_float(r[0]) + __uint_as_float(r[1]);
        }
#pragma unroll
        for (int j2 = 0; j2 < 4; ++j2) { const float keep = b4 ? v[j2 + 4] : v[j2], send = b4 ? v[j2] : v[j2 + 4]; v[j2] = keep + __shfl_xor(send, 16); }
#pragma unroll
        for (int j2 = 0; j2 < 2; ++j2) { const float keep = b3 ? v[j2 + 2] : v[j2], send = b3 ? v[j2] : v[j2 + 2]; v[j2] = keep + __shfl_xor(send, 8); }
        const float r0 = ALPHA * xv.x + v[0], r1 = ALPHA * xv.y + v[1];
        *(unsigned*)(p.rb + (size_t)t * DM + d0) = pack2(r0, r1);
    }
}

__device__ void ph_gemm_ple(const Params& p, unsigned char* smem, const int vb) {
    const int ntn = DM / 128;
    const int tid = threadIdx.x, lane = tid & 63, wid = tid >> 6, wr = wid >> 1, wc = wid & 1, fr = lane & 15, fq = lane >> 4;
    const int ntiles = (T_TOK / 128) * ntn;
    bool pre = false;
    for (int t = vb; t < ntiles; t += gridDim.x) {
        const int m0 = (t / ntn) * 128, n0 = (t % ntn) * 128;
        const int tn = t + gridDim.x;
        const bool has_next = tn < ntiles;
        const bf16_t* nA = p.pb + (size_t)((has_next ? tn : t) / ntn) * 128 * 256;
        const bf16_t* nB = p.WpT + (size_t)((has_next ? tn : t) % ntn) * 128 * 256;
        const bf16_t* gA = p.rb + (size_t)m0 * DM; const bf16_t* gB = p.WgT + (size_t)n0 * DM;
        f32x4 acc[4][4], acc2[4][4]; zero_acc(acc); zero_acc(acc2);
        if (pre) gemm128<true, true>(p.pb + (size_t)m0 * 256, 256, p.WpT + (size_t)n0 * 256, 256, 256, smem, acc2, gA, DM, gB, DM);
        else     gemm128<false, true>(p.pb + (size_t)m0 * 256, 256, p.WpT + (size_t)n0 * 256, 256, 256, smem, acc2, gA, DM, gB, DM);
        if (has_next) gemm128<true, true>(gA, DM, gB, DM, DM, smem, acc, nA, 256, nB, 256);
        else          gemm128<true, false>(gA, DM, gB, DM, DM, smem, acc);
        pre = has_next;
#pragma unroll
        for (int mi = 0; mi < 4; ++mi) {
            const int row = m0 + wr * 64 + mi * 16 + fr;
#pragma unroll
            for (int ni = 0; ni < 4; ++ni) {
                const int col = n0 + wc * 64 + ni * 16 + fq * 4;
                const u32x2 rw = *(const u32x2*)(p.rb + (size_t)row * DM + col);
                f32x4 rv = {bflo(rw[0]), bfhi(rw[0]), bflo(rw[1]), bfhi(rw[1])};
#pragma unroll
                for (int r = 0; r < 4; ++r) rv[r] += sigmul(acc2[mi][ni][r], acc[mi][ni][r]);
                *(f32x4*)(p.out + (size_t)row * DM + col) = rv;
            }
        }
    }
}

#define XB_TMO      128
#define XB_XCNT(j)  (256  + 64 * (j))
#define XB_XSUB(j)  (1280 + 64 * (j))
#define XB_XGEN(j)  (2304 + 64 * (j))
#define XB_TOP      3328
#define XB_TOPGEN   3392
#define XCD_BAR_WORDS 3456
#define XB_SPIN_CAP (1u << 20)
__device__ __forceinline__ unsigned xb_ld(unsigned* p)              { return __hip_atomic_load(p, __ATOMIC_RELAXED, __HIP_MEMORY_SCOPE_AGENT); }
__device__ __forceinline__ unsigned xb_add(unsigned* p, unsigned v) { return __hip_atomic_fetch_add(p, v, __ATOMIC_RELAXED, __HIP_MEMORY_SCOPE_AGENT); }
__device__ __forceinline__ unsigned xb_xcc_id() { return (unsigned)__builtin_amdgcn_s_getreg((3 << 11) | 20) & 0xFu; }
#define XB_SPIN(cond, bar) do { unsigned _sp = 0; while (cond) { __builtin_amdgcn_s_sleep(1); \
    if ((++_sp & 255u) == 0u) { if (xb_ld(&(bar)[XB_TMO])) break; if (_sp > XB_SPIN_CAP) { atomicAdd(&(bar)[XB_TMO], 1u); break; } } } } while (0)
struct XcdBarrier { unsigned* bar; unsigned x; volatile LDS_AS unsigned* st; };
__device__ __forceinline__ XcdBarrier xcd_barrier_post(unsigned* bar, volatile LDS_AS unsigned* st) {
    XcdBarrier b; b.bar = bar; b.x = xb_xcc_id(); b.st = st;
    if (threadIdx.x == 0) st[3] = xb_add(&bar[XB_XCNT(b.x)], 1u);
    return b;
}
__device__ __forceinline__ void xcd_barrier_complete(unsigned* bar, unsigned x, unsigned rank, unsigned& nloc, unsigned& nx, unsigned& vb) {
    const unsigned G = gridDim.x;
    unsigned sum, cnt, mine, sp = 0u; bool even;
    for (;;) {
        sum = 0u; cnt = 0u; mine = 0u; even = true;
#pragma unroll
        for (unsigned j = 0; j < 16; ++j) {
            const unsigned c = xb_ld(&bar[XB_XCNT(j)]); sum += c; cnt += (c > 0u) ? 1u : 0u; mine = (j == x) ? c : mine;
            even = even && (c == ((j < 8u) ? (G >> 3) : 0u));
        }
        if (sum == G) break;
        __builtin_amdgcn_s_sleep(1);
        if ((++sp & 255u) == 0u) { if (xb_ld(&bar[XB_TMO])) break; if (sp > XB_SPIN_CAP) { atomicAdd(&bar[XB_TMO], 1u); break; } }
    }
    nloc = mine > 0u ? mine : 1u; nx = cnt > 0u ? cnt : 1u;
    vb = (even && sum == G && (G & 7u) == 0u) ? (x * (G >> 3) + rank) : blockIdx.x;
}
__device__ __forceinline__ void xcd_barrier(const XcdBarrier& b) {
    asm volatile("s_waitcnt vmcnt(0)" ::: "memory");
    __syncthreads();
    if (threadIdx.x == 0) {
        unsigned* bar = b.bar;
        __builtin_amdgcn_s_waitcnt(0);
        unsigned nloc = b.st[0], nx = b.st[1];
        if (nloc == 0u) { unsigned vb; xcd_barrier_complete(bar, b.x, b.st[3], nloc, nx, vb); b.st[0] = nloc; b.st[1] = nx; b.st[2] = vb; }
        const unsigned old = xb_add(&bar[XB_XSUB(b.x)], 1u);
        const unsigned gen = old / nloc;
        if (old + 1u == (gen + 1u) * nloc) {
            __builtin_amdgcn_fence(__ATOMIC_RELEASE, "agent");
            asm volatile("s_waitcnt vmcnt(0)" ::: "memory");
            const unsigned og = xb_add(&bar[XB_TOP], 1u);
            const unsigned tg = og / nx;
            if (og + 1u == (tg + 1u) * nx) xb_add(&bar[XB_TOPGEN], 1u);
            else XB_SPIN(xb_ld(&bar[XB_TOPGEN]) == tg, bar);
            __builtin_amdgcn_fence(__ATOMIC_ACQUIRE, "agent");
            xb_add(&bar[XB_XGEN(b.x)], 1u);
            asm volatile("s_waitcnt vmcnt(0)" ::: "memory");
        } else {
            XB_SPIN(xb_ld(&bar[XB_XGEN(b.x)]) == gen, bar);
            __builtin_amdgcn_fence(__ATOMIC_ACQUIRE, "agent");
            asm volatile("s_waitcnt vmcnt(0)" ::: "memory");
        }
    }
    __syncthreads();
}

#define SMEM_PHASE (256 * ASTR * 2 * 2)
#define SMEM_BYTES (SMEM_PHASE + 16)
__global__ void __launch_bounds__(256, 2) mega(Params p) {
    __shared__ __attribute__((aligned(16))) unsigned char smem[SMEM_BYTES];
    volatile LDS_AS unsigned* st = (volatile LDS_AS unsigned*)(LDS_AS unsigned char*)(smem + SMEM_PHASE);
    if (threadIdx.x < 4) st[threadIdx.x] = 0u;
    __syncthreads();
    const XcdBarrier gb = xcd_barrier_post(p.bar, st);
    ph_prep(p, smem);            xcd_barrier(gb);
    const int vb = (int)st[2];
    ph_gemm_in(p, smem, vb);     xcd_barrier(gb);
    ph_attn(p, smem, vb);
    ph_conv(p, smem, vb);        xcd_barrier(gb);
    ph_mprep(p, smem, vb);
    ph_gemm_out(p, smem, vb);    xcd_barrier(gb);
    ph_route(p, smem, vb);       xcd_barrier(gb);
    ph_peer_u(p, smem, vb);      xcd_barrier(gb);
    ph_peer_act(p, smem, vb);    xcd_barrier(gb);
    ph_peer_v(p, smem, vb);      xcd_barrier(gb);
    ph_gemm_ple(p, smem, vb);    xcd_barrier(gb);
    ph_ln2(p, vb);
}

extern "C" void kernel_launch(void* const* d_in, const int* in_sizes, int n_in, void* d_out, int out_size, void* d_ws, size_t ws_size,
                              hipStream_t stream) {
    Params p{};
    p.x = (const float*)d_in[0]; p.p = (const float*)d_in[1]; p.pos = (const int*)d_in[2];
    p.w_in = (const float*)d_in[3]; p.sinks = (const float*)d_in[4]; p.conv_w = (const float*)d_in[5]; p.conv_b = (const float*)d_in[6];
    p.cln_g = (const float*)d_in[7]; p.cln_b = (const float*)d_in[8]; p.w_out = (const float*)d_in[9]; p.ln1_g = (const float*)d_in[10];
    p.ln1_b = (const float*)d_in[11]; p.wq = (const float*)d_in[12]; p.keys = (const float*)d_in[13]; p.pu = (const float*)d_in[14];
    p.pv = (const float*)d_in[15]; p.ple_proj = (const float*)d_in[16]; p.ple_gate = (const float*)d_in[17]; p.ln2_g = (const float*)d_in[18];
    p.ln2_b = (const float*)d_in[19];
    p.out = (float*)d_out;
    unsigned char* ws = (unsigned char*)d_ws;
    const size_t MiB = 1024 * 1024;
    p.y1 = (float*)(ws + 0 * MiB);
    p.hb = (bf16_t*)(ws + 128 * MiB);
    p.hp = (bf16_t*)(ws + 128 * MiB);
    p.xb = (bf16_t*)(ws + 256 * MiB);
    p.mixb = (bf16_t*)(ws + 320 * MiB);
    p.rb = (bf16_t*)(ws + 320 * MiB);
    p.pb = (bf16_t*)(ws + 384 * MiB);
    p.u8 = (unsigned char*)(ws + 400 * MiB);
    p.v8 = (unsigned char*)(ws + 416 * MiB);
    p.sc2 = (bf16_t*)(ws + 432 * MiB);
    p.rope = (float*)(ws + 434 * MiB);
    p.stats = (float*)(ws + 436 * MiB);
    p.cb2 = (unsigned*)(ws + 438 * MiB);
    p.mext = (bf16_t*)(ws + 440 * MiB);
    p.yext = (bf16_t*)(ws + 442 * MiB);
    p.y1b = (bf16_t*)(ws + 0 * MiB);
    p.ids = (int*)(ws + 464 * MiB);
    p.gates = (float*)(ws + 480 * MiB);
    unsigned char* wb = ws + 496 * MiB;
    p.WinT = (bf16_t*)wb; wb += (size_t)INW * DM * 2;
    p.WoutT = (bf16_t*)wb; wb += (size_t)DM * DM * 2;
    p.WgT = (bf16_t*)wb; wb += (size_t)DM * DM * 2;
    p.WpT = (bf16_t*)wb; wb += (size_t)DM * 256 * 2;
    p.keysb = (bf16_t*)wb; wb += (size_t)16 * 128 * 128 * 2;
    p.Wqb = (bf16_t*)(ws + 240 * MiB);
    p.MT = (bf16_t*)(ws + 244 * MiB);
    p.bar = (unsigned*)(ws + 510 * MiB);
    p.wgb = (float*)(p.bar + XCD_BAR_WORDS + 640);

    static int grid_blocks = 0;
    if (!grid_blocks) {
        int dev = 0, cus = 0, per_cu = 0;
        (void)hipGetDevice(&dev);
        (void)hipDeviceGetAttribute(&cus, hipDeviceAttributeMultiprocessorCount, dev);
        (void)hipOccupancyMaxActiveBlocksPerMultiprocessor(&per_cu, mega, 256, 0);
        if (per_cu > 2) per_cu = 2;
        grid_blocks = cus * per_cu;
    }
    (void)hipMemsetAsync(p.bar, 0, (XCD_BAR_WORDS + 640 + 4096) * sizeof(unsigned), stream);
    void* args[] = {&p};
    hipError_t e = hipLaunchCooperativeKernel((void*)mega, dim3(grid_blocks), dim3(256), args, 0, stream);
    if (e != hipSuccess) fprintf(stderr, "cooperative launch failed: %s (grid %d)\n", hipGetErrorString(e), grid_blocks);
}
```

```cpp
#include <hip/hip_runtime.h>
#include <stdint.h>
#include <cstdio>

typedef unsigned short bf16_t;
typedef short bf16x8 __attribute__((ext_vector_type(8)));
typedef float f32x4 __attribute__((ext_vector_type(4)));
typedef unsigned u32x4 __attribute__((ext_vector_type(4)));
typedef float f32x2 __attribute__((ext_vector_type(2)));
typedef long i64;

#define T_TOK 32768
#define SEQ 2048
#define DM 1024
#define INW 1792
#define ALPHA 1.189207115002721f
#define LN_EPS 1e-5f

__device__ __forceinline__ bf16_t f2bf(float f) {
    unsigned u = __float_as_uint(f);
    u += 0x7fffu + ((u >> 16) & 1u);
    return (bf16_t)(u >> 16);
}
__device__ __forceinline__ float bf2f(bf16_t b) { return __uint_as_float(((unsigned)b) << 16); }
__device__ __forceinline__ float bflo(unsigned w) { return __uint_as_float(w << 16); }
__device__ __forceinline__ float bfhi(unsigned w) { return __uint_as_float(w & 0xffff0000u); }
__device__ __forceinline__ unsigned pack2(float a, float b) { return (unsigned)f2bf(a) | ((unsigned)f2bf(b) << 16); }

__device__ __forceinline__ float sigmul(float x, float g) { return x * __builtin_amdgcn_rcpf(1.0f + __expf(-g)); }
__device__ __forceinline__ float wave_sum(float v) {
#pragma unroll
    for (int o = 32; o >= 1; o >>= 1) v += __shfl_xor(v, o);
    return v;
}

struct Params {
    const float *x, *p; const int* pos;
    const float *w_in, *sinks, *conv_w, *conv_b, *cln_g, *cln_b, *w_out, *ln1_g, *ln1_b;
    const float *wq, *keys, *pu, *pv, *ple_proj, *ple_gate, *ln2_g, *ln2_b;
    float* out;
    bf16_t *xb, *pb, *WinT, *WoutT, *WgT, *WpT, *keysb, *Wqb, *MT, *hb, *mixb, *rb;
    float *y1, *gates, *rope, *stats, *wgb;
    bf16_t *y1b, *yext, *mext; unsigned* cb2;
    bf16_t* sc2;
    bf16_t* hp;
    int *ids;
    unsigned char *u8, *v8;
    unsigned* bar;
};

__device__ void cvt_rows(const float* __restrict__ src, bf16_t* __restrict__ dst, size_t n) {
    const size_t nv = n / 8, gs = (size_t)gridDim.x * blockDim.x;
    for (size_t i = (size_t)blockIdx.x * blockDim.x + threadIdx.x; i < nv; i += 4 * gs) {
        f32x4 a[4], b[4];
#pragma unroll
        for (int q = 0; q < 4; ++q) { const size_t k = (i + q * gs < nv) ? i + q * gs : i; a[q] = ((const f32x4*)src)[2 * k]; b[q] = ((const f32x4*)src)[2 * k + 1]; }
#pragma unroll
        for (int q = 0; q < 4; ++q) {
            if (i + q * gs < nv) {
                u32x4 o; o[0] = pack2(a[q][0], a[q][1]); o[1] = pack2(a[q][2], a[q][3]); o[2] = pack2(b[q][0], b[q][1]); o[3] = pack2(b[q][2], b[q][3]);
                ((u32x4*)dst)[i + q * gs] = o;
            }
        }
    }
}
__device__ __forceinline__ int win_row(int n) {
    if (n < 768) return n;
    const int isg = n >= 1280 ? 1 : 0, c = n - (isg ? 1280 : 768);
    const int tt = c >> 6, wc = (c >> 5) & 1, k2 = (c >> 4) & 1, rest = c & 15;
    return 768 + 128 * tt + wc * 64 + (k2 * 2 + isg) * 16 + rest;
}
template <bool WIN = false>
__device__ void transpose_cvt(const float* __restrict__ W, bf16_t* __restrict__ Wt, int K, int N, float* tile  ) {
    const int tk = K / 64, tn = N / 64;
    const int tid = threadIdx.x;
    for (int t = blockIdx.x; t < tk * tn; t += gridDim.x) {
        const int k0 = (t / tn) * 64, n0 = (t % tn) * 64;
        f32x4 v[4];
#pragma unroll
        for (int i = 0; i < 4; ++i) v[i] = *(const f32x4*)(W + (size_t)(k0 + (tid >> 4) + 16 * i) * N + n0 + (tid & 15) * 4);
        __syncthreads();
#pragma unroll
        for (int i = 0; i < 4; ++i)
#pragma unroll
            for (int j = 0; j < 4; ++j) tile[((tid >> 4) + 16 * i) * 65 + (tid & 15) * 4 + j] = v[i][j];
        __syncthreads();
        const int n = tid >> 2, kc = (tid & 3) * 16;
        u32x4 o0, o1;
#pragma unroll
        for (int q = 0; q < 4; ++q) {
            o0[q] = pack2(tile[(kc + 2 * q) * 65 + n], tile[(kc + 2 * q + 1) * 65 + n]);
            o1[q] = pack2(tile[(kc + 8 + 2 * q) * 65 + n], tile[(kc + 8 + 2 * q + 1) * 65 + n]);
        }
        const int nd = WIN ? win_row(n0 + n) : n0 + n;
        *(u32x4*)(Wt + (size_t)nd * K + k0 + kc) = o0;
        *(u32x4*)(Wt + (size_t)nd * K + k0 + kc + 8) = o1;
    }
}
__device__ void cvt_wq_fold(const Params& p, unsigned char* smem) {
    for (int i = blockIdx.x * 256 + threadIdx.x; i < DM * 256; i += gridDim.x * 256) {
        const int d = i >> 8, c8 = (i & 255) * 8;
        const float gd = p.ln1_g[d];
        const f32x4 a = *(const f32x4*)(p.wq + (size_t)d * 2048 + c8), b = *(const f32x4*)(p.wq + (size_t)d * 2048 + c8 + 4);
        u32x4 o; o[0] = pack2(a[0] * gd, a[1] * gd); o[1] = pack2(a[2] * gd, a[3] * gd); o[2] = pack2(b[0] * gd, b[1] * gd); o[3] = pack2(b[2] * gd, b[3] * gd);
        *(u32x4*)(p.Wqb + (size_t)d * 2048 + c8) = o;
    }
    float* red = (float*)smem;
    const int lane = threadIdx.x & 63, wid = threadIdx.x >> 6;
    for (int cb = blockIdx.x; cb < 512; cb += gridDim.x) {
        f32x4 sg = {0.f, 0.f, 0.f, 0.f}, sb = {0.f, 0.f, 0.f, 0.f};
#pragma unroll
        for (int q = 0; q < 4; ++q) {
            const int d = threadIdx.x * 4 + q;
            const f32x4 v = *(const f32x4*)(p.wq + (size_t)d * 2048 + cb * 4);
            sg += v * p.ln1_g[d]; sb += v * p.ln1_b[d];
        }
        __syncthreads();
#pragma unroll
        for (int q = 0; q < 4; ++q) {
            const float a = wave_sum(sg[q]), b = wave_sum(sb[q]);
            if (lane == 0) { red[wid * 8 + q] = a; red[wid * 8 + 4 + q] = b; }
        }
        __syncthreads();
        if (threadIdx.x < 8) {
            const float t = (red[threadIdx.x] + red[8 + threadIdx.x]) + (red[16 + threadIdx.x] + red[24 + threadIdx.x]);
            p.wgb[(threadIdx.x >> 2) * 2048 + cb * 4 + (threadIdx.x & 3)] = t;
        }
    }
}
template <bool FOLD>
__device__ void cvt_table_fp8(const Params& p, const float* __restrict__ src, unsigned char* __restrict__ dst, bf16_t* __restrict__ scl, int rows) {
    const int lane = threadIdx.x & 63, wid = threadIdx.x >> 6;
    const int nw = gridDim.x * 4;
    for (int r0 = blockIdx.x * 4 + wid; r0 < rows; r0 += 4 * nw) {
        f32x4 v[4][4];
#pragma unroll
        for (int q = 0; q < 4; ++q) {
            const int r = (r0 + q * nw < rows) ? r0 + q * nw : r0;
            const float* sr = src + (size_t)r * DM + lane * 16;
#pragma unroll
            for (int k = 0; k < 4; ++k) v[q][k] = *(const f32x4*)(sr + 4 * k);
        }
        f32x4 gv[4], bv[4];
        if (FOLD) {
#pragma unroll
            for (int k = 0; k < 4; ++k) { gv[k] = *(const f32x4*)(p.ln1_g + lane * 16 + 4 * k); bv[k] = *(const f32x4*)(p.ln1_b + lane * 16 + 4 * k); }
        }
#pragma unroll
        for (int q = 0; q < 4; ++q) {
            const int r = r0 + q * nw;
            if (FOLD) {
                float cu = 0.f, bu = 0.f;
#pragma unroll
                for (int k = 0; k < 4; ++k) { bu += (bv[k][0] * v[q][k][0] + bv[k][1] * v[q][k][1]) + (bv[k][2] * v[q][k][2] + bv[k][3] * v[q][k][3]); v[q][k] = v[q][k] * gv[k]; cu += (v[q][k][0] + v[q][k][1]) + (v[q][k][2] + v[q][k][3]); }
                cu = wave_sum(cu); bu = wave_sum(bu);
                if (lane == 0 && r < rows) p.cb2[r] = pack2(cu, bu);
            }
            float m = 0.f;
#pragma unroll
            for (int k = 0; k < 4; ++k)
#pragma unroll
                for (int i = 0; i < 4; ++i) m = fmaxf(m, fabsf(v[q][k][i]));
#pragma unroll
            for (int o = 32; o >= 1; o >>= 1) m = fmaxf(m, __shfl_xor(m, o));
            int ex = (m > 0.f) ? (8 - (int)((__float_as_uint(m) >> 23) & 0xffu) + 127 - ((__float_as_uint(m) & 0x7fffffu) > 0x600000u ? 1 : 0)) : 0;
            ex = min(max(ex, -100), 100);
            const float sc = __uint_as_float((unsigned)(127 + ex) << 23);
            u32x4 w;
#pragma unroll
            for (int k = 0; k < 4; ++k)
                w[k] = __builtin_amdgcn_cvt_pk_fp8_f32(v[q][k][2] * sc, v[q][k][3] * sc, __builtin_amdgcn_cvt_pk_fp8_f32(v[q][k][0] * sc, v[q][k][1] * sc, 0, false), true);
            if (r < rows) {
                *(u32x4*)(dst + (size_t)(lane >> 3) * (16384 * 128) + (size_t)r * 128 + (lane & 7) * 16) = w;
                if (lane == 0) scl[2 * r] = (bf16_t)(((unsigned)(127 - ex) << 23) >> 16);
            }
        }
    }
}
__device__ void ph_prep(const Params& p, unsigned char* smem) {
    float* tile = (float*)smem;
    cvt_rows(p.x, p.xb, (size_t)T_TOK * DM);
    cvt_rows(p.p, p.pb, (size_t)T_TOK * 256);
    cvt_table_fp8<true>(p, p.pu, p.u8, p.sc2, 16384);
    cvt_table_fp8<false>(p, p.pv, p.v8, p.sc2 + 1, 16384);
    cvt_rows(p.keys, p.keysb, (size_t)16 * 128 * 128);
    for (int i = blockIdx.x * 256 + threadIdx.x; i < T_TOK * 8; i += gridDim.x * 256) {
        const int t = i >> 3, j = i & 7;
        const float inv = powf(500000.0f, -(float)j * 0.125f);
        float sn, cs; sincosf((float)p.pos[t] * inv, &sn, &cs);
        p.rope[t * 16 + j] = cs; p.rope[t * 16 + 8 + j] = sn;
    }
    transpose_cvt<true>(p.w_in, p.WinT, DM, INW, tile);
    transpose_cvt(p.w_out, p.WoutT, DM, DM, tile);
    cvt_wq_fold(p, smem);
    transpose_cvt(p.ple_gate, p.WgT, DM, DM, tile);
    transpose_cvt(p.ple_proj, p.WpT, 256, DM, tile);
}

#define LDS_AS __attribute__((address_space(3)))
#define GEMM_STAGE 32768
template <bool PRE = false, bool NEXT = false>
__device__ __forceinline__ void gemm128(const bf16_t* __restrict__ A, int lda, const bf16_t* __restrict__ Bt, int ldb, int K,
                                        unsigned char* smem, f32x4 (&acc)[4][4],
                                        const bf16_t* __restrict__ nA = nullptr, int nlda = 0, const bf16_t* __restrict__ nB = nullptr, int nldb = 0) {
    LDS_AS unsigned char* lds = (LDS_AS unsigned char*)smem;
    const int tid = threadIdx.x, lane = tid & 63, wid = __builtin_amdgcn_readfirstlane(tid >> 6);
    const int wr = wid >> 1, wc = wid & 1, fr = lane & 15, fq = lane >> 4;
    const int nk = K / 64;
    const int prow = lane >> 3, pc = (lane & 7) ^ prow;
    const bf16_t* gA = A + (size_t)(wid * 32 + prow) * lda + pc * 8;
    const bf16_t* gB = Bt + (size_t)(wid * 32 + prow) * ldb + pc * 8;
    const size_t a8 = (size_t)8 * lda, b8 = (size_t)8 * ldb;
#define GEMM_ISSUE(kt, st) do { \
        _Pragma("unroll") for (int _i = 0; _i < 4; ++_i) { \
            __builtin_amdgcn_global_load_lds((const unsigned*)(gA + _i * a8 + (size_t)(kt) * 64), (LDS_AS unsigned*)(lds + (st) * GEMM_STAGE + (wid * 4 + _i) * 1024), 16, 0, 0); \
            __builtin_amdgcn_global_load_lds((const unsigned*)(gB + _i * b8 + (size_t)(kt) * 64), (LDS_AS unsigned*)(lds + (st) * GEMM_STAGE + 16384 + (wid * 4 + _i) * 1024), 16, 0, 0); \
        } } while (0)
    const int swz0 = ((0 * 4 + fq) ^ (fr & 7)) * 16, swz1 = ((1 * 4 + fq) ^ (fr & 7)) * 16;
    const int aoff = (wr * 64 + fr) * 128, boff = 16384 + (wc * 64 + fr) * 128;
    if (!PRE) GEMM_ISSUE(0, 0);
#pragma unroll 1
    for (int kt = 0; kt < nk; ++kt) {
        const int st = kt & 1;
        asm volatile("s_waitcnt vmcnt(0)" ::: "memory");
        __builtin_amdgcn_s_barrier();
        asm volatile("" ::: "memory");
        if (kt + 1 < nk) GEMM_ISSUE(kt + 1, st ^ 1);
        else if (NEXT) {
            const bf16_t* qA = nA + (size_t)(wid * 32 + prow) * nlda + pc * 8;
            const bf16_t* qB = nB + (size_t)(wid * 32 + prow) * nldb + pc * 8;
#pragma unroll
            for (int _i = 0; _i < 4; ++_i) {
                __builtin_amdgcn_global_load_lds((const unsigned*)(qA + (size_t)(_i * 8) * nlda), (LDS_AS unsigned*)(lds + (wid * 4 + _i) * 1024), 16, 0, 0);
                __builtin_amdgcn_global_load_lds((const unsigned*)(qB + (size_t)(_i * 8) * nldb), (LDS_AS unsigned*)(lds + 16384 + (wid * 4 + _i) * 1024), 16, 0, 0);
            }
        }
        const LDS_AS unsigned char* sb = lds + st * GEMM_STAGE;
        bf16x8 af0[4], bf0[4], af1[4], bf1[4];
#pragma unroll
        for (int mi = 0; mi < 4; ++mi) af0[mi] = *(const LDS_AS bf16x8*)(sb + aoff + mi * 2048 + swz0);
#pragma unroll
        for (int ni = 0; ni < 4; ++ni) bf0[ni] = *(const LDS_AS bf16x8*)(sb + boff + ni * 2048 + swz0);
#pragma unroll
        for (int mi = 0; mi < 4; ++mi) af1[mi] = *(const LDS_AS bf16x8*)(sb + aoff + mi * 2048 + swz1);
#pragma unroll
        for (int ni = 0; ni < 4; ++ni) bf1[ni] = *(const LDS_AS bf16x8*)(sb + boff + ni * 2048 + swz1);
#pragma unroll
        for (int mi = 0; mi < 4; ++mi)
#pragma unroll
            for (int ni = 0; ni < 4; ++ni)
                acc[mi][ni] = __builtin_amdgcn_mfma_f32_16x16x32_bf16(bf0[ni], af0[mi], acc[mi][ni], 0, 0, 0);
#pragma unroll
        for (int mi = 0; mi < 4; ++mi)
#pragma unroll
            for (int ni = 0; ni < 4; ++ni)
                acc[mi][ni] = __builtin_amdgcn_mfma_f32_16x16x32_bf16(bf1[ni], af1[mi], acc[mi][ni], 0, 0, 0);
        __builtin_amdgcn_sched_group_barrier(0x100, 8, 0);
#pragma unroll
        for (int q = 0; q < 8; ++q) { __builtin_amdgcn_sched_group_barrier(0x008, 2, 0); __builtin_amdgcn_sched_group_barrier(0x100, 1, 0); }
        __builtin_amdgcn_sched_group_barrier(0x008, 16, 0);
        asm volatile("s_waitcnt lgkmcnt(0)" ::: "memory");
        __builtin_amdgcn_s_barrier();
        asm volatile("" ::: "memory");
    }
#undef GEMM_ISSUE
}
#define GW_STAGE 24576
__device__ __forceinline__ void gemmW(const bf16_t* __restrict__ A, int lda, const bf16_t* __restrict__ Bt, int ldb, int K,
                                      unsigned char* smem, f32x4 (&acc)[4][8]) {
    LDS_AS unsigned char* lds = (LDS_AS unsigned char*)smem;
    const int tid = threadIdx.x, lane = tid & 63, wid = __builtin_amdgcn_readfirstlane(tid >> 6);
    const int wr = wid >> 1, wc = wid & 1, fr = lane & 15, fq = lane >> 4;
    const int nk = K / 32;
    const int prow = lane >> 2, pc = (lane & 3) ^ ((4 - ((prow >> 2) & 3)) & 3);
    const bf16_t* gA = A + (size_t)(wid * 32 + prow) * lda + pc * 8;
    const bf16_t* gB = Bt + (size_t)(wid * 64 + prow) * ldb + pc * 8;
    const size_t a16 = (size_t)16 * lda, b16 = (size_t)16 * ldb;
#define GW_ISSUE(kt, st) do { \
        _Pragma("unroll") for (int _i = 0; _i < 2; ++_i) \
            __builtin_amdgcn_global_load_lds((const unsigned*)(gA + _i * a16 + (size_t)(kt) * 32), (LDS_AS unsigned*)(lds + (st) * GW_STAGE + (wid * 2 + _i) * 1024), 16, 0, 0); \
        _Pragma("unroll") for (int _i = 0; _i < 4; ++_i) \
            __builtin_amdgcn_global_load_lds((const unsigned*)(gB + _i * b16 + (size_t)(kt) * 32), (LDS_AS unsigned*)(lds + (st) * GW_STAGE + 8192 + (wid * 4 + _i) * 1024), 16, 0, 0); \
        } while (0)
    const int swz = (fq ^ ((4 - ((fr >> 2) & 3)) & 3)) * 16;
    const int aoff = (wr * 64 + fr) * 64 + swz, boff = 8192 + (wc * 128 + fr) * 64 + swz;
    GW_ISSUE(0, 0);
#pragma unroll 1
    for (int kt = 0; kt < nk; ++kt) {
        const int st = kt & 1;
        asm volatile("s_waitcnt vmcnt(0)" ::: "memory");
        __builtin_amdgcn_s_barrier();
        asm volatile("" ::: "memory");
        if (kt + 1 < nk) GW_ISSUE(kt + 1, st ^ 1);
        const LDS_AS unsigned char* sb = lds + st * GW_STAGE;
        bf16x8 af[4], bfr[8];
#pragma unroll
        for (int mi = 0; mi < 4; ++mi) af[mi] = *(const LDS_AS bf16x8*)(sb + aoff + mi * 1024);
#pragma unroll
        for (int ni = 0; ni < 8; ++ni) bfr[ni] = *(const LDS_AS bf16x8*)(sb + boff + ni * 1024);
#pragma unroll
        for (int ni = 0; ni < 8; ++ni)
#pragma unroll
            for (int mi = 0; mi < 4; ++mi)
                acc[mi][ni] = __builtin_amdgcn_mfma_f32_16x16x32_bf16(bfr[ni], af[mi], acc[mi][ni], 0, 0, 0);
        asm volatile("s_waitcnt lgkmcnt(0)" ::: "memory");
        __builtin_amdgcn_s_barrier();
        asm volatile("" ::: "memory");
    }
#undef GW_ISSUE
}
__device__ __forceinline__ void zero_accw(f32x4 (&acc)[4][8]) {
#pragma unroll
    for (int a = 0; a < 4; ++a)
#pragma unroll
        for (int b = 0; b < 8; ++b) acc[a][b] = (f32x4){0.f, 0.f, 0.f, 0.f};
}
__device__ __forceinline__ void zero_acc(f32x4 (&acc)[4][4]) {
#pragma unroll
    for (int a = 0; a < 4; ++a)
#pragma unroll
        for (int b = 0; b < 4; ++b) acc[a][b] = (f32x4){0.f, 0.f, 0.f, 0.f};
}
#define GEMM_SMEM (2 * GEMM_STAGE)

__device__ void ph_gemm_in(const Params& p, unsigned char* smem, const int vb) {
    const int ntn = INW / 128;
    const int tid = threadIdx.x, lane = tid & 63, wid = tid >> 6, wr = wid >> 1, wc = wid & 1, fr = lane & 15, fq = lane >> 4;
    const int ntiles = (T_TOK / 128) * ntn;
    bool pre = false;
    for (int t = vb; t < ntiles; t += gridDim.x) {
        const int m0 = (t / ntn) * 128, n0 = (t % ntn) * 128;
        const int tn = t + gridDim.x;
        const bool has_next = tn < ntiles;
        const bf16_t* nA = p.xb + (size_t)((has_next ? tn : t) / ntn) * 128 * DM;
        const bf16_t* nB = p.WinT + (size_t)((has_next ? tn : t) % ntn) * 128 * DM;
        f32x4 acc[4][4]; zero_acc(acc);
        if (pre) { if (has_next) gemm128<true, true>(p.xb + (size_t)m0 * DM, DM, p.WinT + (size_t)n0 * DM, DM, DM, smem, acc, nA, DM, nB, DM);
                   else          gemm128<true, false>(p.xb + (size_t)m0 * DM, DM, p.WinT + (size_t)n0 * DM, DM, DM, smem, acc); }
        else     { if (has_next) gemm128<false, true>(p.xb + (size_t)m0 * DM, DM, p.WinT + (size_t)n0 * DM, DM, DM, smem, acc, nA, DM, nB, DM);
                   else          gemm128<false, false>(p.xb + (size_t)m0 * DM, DM, p.WinT + (size_t)n0 * DM, DM, DM, smem, acc); }
        pre = has_next;
        if (n0 >= 768) {
            const int cb = ((n0 - 768) >> 7) * 64 + wc * 32 + fq * 4;
#pragma unroll
            for (int mi = 0; mi < 4; ++mi) {
                const int row = m0 + wr * 64 + mi * 16 + fr;
#pragma unroll
                for (int k2 = 0; k2 < 2; ++k2) {
                    const f32x4 a = acc[mi][2 * k2], gt = acc[mi][2 * k2 + 1];
                    uint2 o; o.x = pack2(sigmul(a[0], gt[0]), sigmul(a[1], gt[1])); o.y = pack2(sigmul(a[2], gt[2]), sigmul(a[3], gt[3]));
                    *(uint2*)(p.hb + (size_t)row * INW + 768 + cb + k2 * 16) = o;
                }
            }
        } else {
#pragma unroll
        for (int mi = 0; mi < 4; ++mi) {
            const int row = m0 + wr * 64 + mi * 16 + fr;
#pragma unroll
            for (int ni = 0; ni < 4; ++ni) {
                const int col0 = n0 + wc * 64 + ni * 16;
                f32x4 v = acc[mi][ni];
                if (col0 < 640 && (col0 & 63) == 0) {
                    const f32x4 cs = *(const f32x4*)(p.rope + (size_t)row * 16 + (fq & 1) * 4), sn = *(const f32x4*)(p.rope + (size_t)row * 16 + 8 + (fq & 1) * 4);
#pragma unroll
                    for (int r = 0; r < 4; ++r) {
                        const float other = __shfl_xor(v[r], 32);
                        v[r] = (fq < 2) ? (v[r] * cs[r] - other * sn[r]) : (v[r] * cs[r] + other * sn[r]);
                    }
                }
                uint2 o; o.x = pack2(v[0], v[1]); o.y = pack2(v[2], v[3]);
                *(uint2*)(p.hb + (size_t)row * INW + col0 + fq * 4) = o;
            }
        }
        }
    }
}

#define ASTR 72
#define VSTR 260
typedef float f32x16 __attribute__((ext_vector_type(16)));
typedef unsigned u32x2 __attribute__((ext_vector_type(2)));
__device__ void ph_attn(const Params& p, unsigned char* smem, const int vb) {
    bf16_t* sK = (bf16_t*)smem;
    bf16_t* sVt = sK + 256 * ASTR;
    const int tid = threadIdx.x, lane = tid & 63, wid = tid >> 6, r32 = lane & 31, hh = lane >> 5;
    const float C1 = 0.125f * 1.4426950408889634f, LOG2E = 1.4426950408889634f;
    for (int u = vb; u < 16 * 16 * 2; u += gridDim.x) {
        const int kvh = u & 1, nb = (u >> 1) & 15, b = u >> 5;
        __syncthreads();
        for (int c = tid; c < 256 * 8; c += 256) {
            const int li = c >> 3, kc = c & 7;
            const int pos = nb * 128 - 128 + li;
            u32x4 kv = {0u, 0u, 0u, 0u}, vv = {0u, 0u, 0u, 0u};
            if (pos >= 0) {
                const bf16_t* base = p.hb + (size_t)(b * SEQ + pos) * INW;
                kv = *(const u32x4*)(base + 512 + kvh * 64 + kc * 8);
                vv = *(const u32x4*)(base + 640 + kvh * 64 + kc * 8);
            }
            *(u32x4*)(sK + li * ASTR + kc * 8) = kv;
#pragma unroll
            for (int i = 0; i < 4; ++i) {
                sVt[(kc * 8 + 2 * i) * VSTR + li] = (bf16_t)(vv[i] & 0xffffu);
                sVt[(kc * 8 + 2 * i + 1) * VSTR + li] = (bf16_t)(vv[i] >> 16);
            }
        }
        __syncthreads();
        const int hq = kvh * 4 + wid;
        const float sink2 = p.sinks[hq] * LOG2E;
        bf16x8 qn[4];
        {
            const size_t tr0 = (size_t)(b * SEQ + nb * 128 + r32);
#pragma unroll
            for (int ks = 0; ks < 4; ++ks) qn[ks] = *(const bf16x8*)(p.hb + tr0 * INW + hq * 64 + ks * 16 + hh * 8);
        }
#pragma unroll 1
        for (int qt = 0; qt < 4; ++qt) {
            const size_t trow = (size_t)(b * SEQ + nb * 128 + qt * 32 + r32);
            bf16x8 qf[4];
#pragma unroll
            for (int ks = 0; ks < 4; ++ks) qf[ks] = qn[ks];
            {
                const size_t trn = (size_t)(b * SEQ + nb * 128 + (qt < 3 ? qt + 1 : qt) * 32 + r32);
#pragma unroll
                for (int ks = 0; ks < 4; ++ks) qn[ks] = *(const bf16x8*)(p.hb + trn * INW + hq * 64 + ks * 16 + hh * 8);
            }
            f32x16 S[5];
#pragma unroll
            for (int j = 0; j < 5; ++j) {
#pragma unroll
                for (int r = 0; r < 16; ++r) S[j][r] = 0.f;
#pragma unroll
                for (int ks = 0; ks < 4; ++ks) {
                    const bf16x8 a = *(const bf16x8*)(sK + ((qt + j) * 32 + r32) * ASTR + ks * 16 + hh * 8);
                    S[j] = __builtin_amdgcn_mfma_f32_32x32x16_bf16(a, qf[ks], S[j], 0, 0, 0);
                }
            }
            float m2 = sink2;
#pragma unroll
            for (int j = 0; j < 5; ++j) {
                const bool tile_ok = (nb > 0) || (qt + j >= 4);
#pragma unroll
                for (int r = 0; r < 16; ++r) {
                    const int kl = (r & 3) + 8 * (r >> 2) + 4 * hh;
                    bool ok = tile_ok;
                    if (j == 0) ok = ok && (kl > r32);
                    if (j == 4) ok = ok && (kl <= r32);
                    const float t = ok ? S[j][r] * C1 : -1.0e30f;
                    S[j][r] = t;
                    m2 = fmaxf(m2, t);
                }
            }
            m2 = fmaxf(m2, __shfl_xor(m2, 32));
            float l = 0.f;
#pragma unroll
            for (int j = 0; j < 5; ++j)
#pragma unroll
                for (int r = 0; r < 16; ++r) { const float e = __builtin_amdgcn_exp2f(S[j][r] - m2); S[j][r] = e; l += e; }
            l += __shfl_xor(l, 32);
            l += __builtin_amdgcn_exp2f(sink2 - m2);
            f32x16 O[2];
#pragma unroll
            for (int dt = 0; dt < 2; ++dt)
#pragma unroll
                for (int r = 0; r < 16; ++r) O[dt][r] = 0.f;
#pragma unroll
            for (int j = 0; j < 5; ++j)
#pragma unroll
                for (int s2 = 0; s2 < 2; ++s2) {
                    u32x4 pw;
#pragma unroll
                    for (int k = 0; k < 4; ++k) pw[k] = pack2(S[j][8 * s2 + 2 * k], S[j][8 * s2 + 2 * k + 1]);
                    const bf16x8 pf = __builtin_bit_cast(bf16x8, pw);
                    const int kbase = (qt + j) * 32 + 16 * s2 + 4 * hh;
#pragma unroll
                    for (int dt = 0; dt < 2; ++dt) {
                        const bf16_t* vp = sVt + (dt * 32 + r32) * VSTR + kbase;
                        const u32x2 v0 = *(const u32x2*)(vp), v1 = *(const u32x2*)(vp + 8);
                        const u32x4 vw = {v0[0], v0[1], v1[0], v1[1]};
                        O[dt] = __builtin_amdgcn_mfma_f32_32x32x16_bf16(__builtin_bit_cast(bf16x8, vw), pf, O[dt], 0, 0, 0);
                    }
                }
            const float il = __builtin_amdgcn_rcpf(l);
#pragma unroll
            for (int dt = 0; dt < 2; ++dt)
#pragma unroll
                for (int g = 0; g < 4; ++g) {
                    u32x2 w;
                    w[0] = pack2(O[dt][4 * g] * il, O[dt][4 * g + 1] * il);
                    w[1] = pack2(O[dt][4 * g + 2] * il, O[dt][4 * g + 3] * il);
                    *(u32x2*)(p.mixb + trow * DM + hq * 64 + dt * 32 + 8 * g + 4 * hh) = w;
                }
        }
    }
}

#define CV_ROWS 62
__device__ void ph_conv(const Params& p, unsigned char* smem, const int vb) {
    bf16_t* gl = (bf16_t*)smem;
    float* red = (float*)(smem + CV_ROWS * 1024);
    const int tid = threadIdx.x, lane = tid & 63, wid = tid >> 6;
    const f32x2 lg = *(const f32x2*)(p.cln_g + 2 * tid), lb = *(const f32x2*)(p.cln_b + 2 * tid);
    for (int u = vb; u < T_TOK / 32; u += gridDim.x) {
        const int tok0 = u * 32, s0 = tok0 & (SEQ - 1);
        __syncthreads();
#pragma unroll 1
        for (int bt = 0; bt < 2; ++bt) {
            u32x4 av[8];
#pragma unroll
            for (int it = 0; it < 8; ++it) {
                const int ch = tid + (bt * 8 + it) * 256, row = min(ch >> 6, CV_ROWS - 1), k = ch & 63;
                const int rr = (s0 - 30 + row >= 0) ? row : 30;
                av[it] = *(const u32x4*)(p.hb + (size_t)(tok0 - 30 + rr) * INW + 768 + k * 8);
            }
#pragma unroll
            for (int it = 0; it < 8; ++it) {
                const int ch = tid + (bt * 8 + it) * 256, row = ch >> 6, k = ch & 63;
                const bool ok = (s0 - 30 + row >= 0);
                const u32x4 o = ok ? av[it] : (u32x4){0u, 0u, 0u, 0u};
                if (row < CV_ROWS) *(u32x4*)(gl + row * 512 + k * 8) = o;
            }
        }
        __syncthreads();
        float w0[31], w1[31];
#pragma unroll
        for (int k = 0; k < 31; ++k) { const f32x2 wv = *(const f32x2*)(p.conv_w + k * 512 + 2 * tid); w0[k] = wv.x; w1[k] = wv.y; }
        const f32x2 bias = *(const f32x2*)(p.conv_b + 2 * tid);
#pragma unroll 1
        for (int jh = 0; jh < 2; ++jh) {
            float a0[16], a1[16];
#pragma unroll
            for (int jl = 0; jl < 16; ++jl) { a0[jl] = bias.x; a1[jl] = bias.y; }
            const bf16_t* gp = gl + (jh * 16) * 512 + 2 * tid;
#pragma unroll
            for (int il = 0; il < 46; ++il) {
                const unsigned gw = *(const unsigned*)(gp + il * 512);
                const float g0 = bflo(gw), g1 = bfhi(gw);
#pragma unroll
                for (int jl = 0; jl < 16; ++jl)
                    if (il - jl >= 0 && il - jl <= 30) { a0[jl] += w0[il - jl] * g0; a1[jl] += w1[il - jl] * g1; }
                if ((il & 3) == 3) __builtin_amdgcn_sched_barrier(0);
            }
            float v[32];
#pragma unroll
            for (int jl = 0; jl < 16; ++jl) { v[jl] = a0[jl] + a1[jl]; v[16 + jl] = a0[jl] * a0[jl] + a1[jl] * a1[jl]; }
#pragma unroll
            for (int st = 16; st >= 1; st >>= 1) {
                const bool up = (lane & st) != 0;
#pragma unroll
                for (int i2 = 0; i2 < st; ++i2) {
                    const float keep = up ? v[i2 + st] : v[i2], send = up ? v[i2] : v[i2 + st];
                    v[i2] = keep + __shfl_xor(send, st);
                }
            }
            const float tot = v[0] + __shfl_xor(v[0], 32);
            __syncthreads();
            if (lane < 32) red[wid * 32 + lane] = tot;
            __syncthreads();
#pragma unroll
            for (int jl = 0; jl < 16; ++jl) {
                const float sm = (red[jl] + red[32 + jl]) + (red[64 + jl] + red[96 + jl]);
                const float sq = (red[16 + jl] + red[48 + jl]) + (red[80 + jl] + red[112 + jl]);
                const float mu = sm * (1.0f / 512.0f);
                const float rstd = rsqrtf(fmaxf(sq * (1.0f / 512.0f) - mu * mu, 0.f) + LN_EPS);
                const float y0 = (a0[jl] - mu) * rstd * lg.x + lb.x, y1 = (a1[jl] - mu) * rstd * lg.y + lb.y;
                *(unsigned*)(p.mixb + (size_t)(tok0 + jh * 16 + jl) * DM + 512 + 2 * tid) = pack2(sigmul(y0, y0), sigmul(y1, y1));
            }
        }
    }
}

__device__ void ph_gemm_out(const Params& p, unsigned char* smem, const int vb) {
    const int ntn = DM / 256;
    const int tid = threadIdx.x, lane = tid & 63, wid = tid >> 6, wr = wid >> 1, wc = wid & 1, fr = lane & 15, fq = lane >> 4;
    for (int t = vb; t < (T_TOK / 128) * ntn; t += gridDim.x) {
        const int m0 = (t / ntn) * 128, n0 = (t % ntn) * 256;
        f32x4 acc[4][8]; zero_accw(acc);
        gemmW(p.mixb + (size_t)m0 * DM, DM, p.WoutT + (size_t)n0 * DM, DM, DM, smem, acc);
#pragma unroll
        for (int mi = 0; mi < 4; ++mi) {
            const int row = m0 + wr * 64 + mi * 16 + fr;
            float sm = 0.f, sq = 0.f;
#pragma unroll
            for (int ni = 0; ni < 8; ++ni) {
                const int col = n0 + wc * 128 + ni * 16 + fq * 4;
                const f32x4 xv = *(const f32x4*)(p.x + (size_t)row * DM + col);
                const f32x4 y = xv * ALPHA + acc[mi][ni];
                sm += (y[0] + y[1]) + (y[2] + y[3]); sq += (y[0] * y[0] + y[1] * y[1]) + (y[2] * y[2] + y[3] * y[3]);
                u32x2 o; o[0] = pack2(y[0], y[1]); o[1] = pack2(y[2], y[3]);
                *(u32x2*)(p.y1b + (size_t)row * DM + col) = o;
            }
            sm += __shfl_xor(sm, 16); sq += __shfl_xor(sq, 16); sm += __shfl_xor(sm, 32); sq += __shfl_xor(sq, 32);
            if (fq == 0) *(f32x2*)(p.stats + (size_t)row * 16 + ((n0 >> 8) * 2 + wc) * 2) = (f32x2){sm, sq};
        }
    }
}

__device__ __forceinline__ void ln_row(const float* __restrict__ src, const float* __restrict__ g, const float* __restrict__ bta,
                                       float* __restrict__ dstf, bf16_t* __restrict__ dstb, int lane) {
    f32x4 v[4]; float s = 0.f;
#pragma unroll
    for (int i = 0; i < 4; ++i) { v[i] = *(const f32x4*)(src + i * 256 + lane * 4); s += (v[i][0] + v[i][1]) + (v[i][2] + v[i][3]); }
    const float mu = wave_sum(s) * (1.0f / 1024.0f);
    float q = 0.f;
#pragma unroll
    for (int i = 0; i < 4; ++i) { const f32x4 d = v[i] - mu; q += (d[0] * d[0] + d[1] * d[1]) + (d[2] * d[2] + d[3] * d[3]); }
    const float rstd = rsqrtf(wave_sum(q) * (1.0f / 1024.0f) + LN_EPS);
#pragma unroll
    for (int i = 0; i < 4; ++i) {
        const f32x4 gg = *(const f32x4*)(g + i * 256 + lane * 4), bb = *(const f32x4*)(bta + i * 256 + lane * 4);
        const f32x4 y = (v[i] - mu) * rstd * gg + bb;
        if (dstf) *(f32x4*)(dstf + i * 256 + lane * 4) = y;
        if (dstb) { uint2 o; o.x = pack2(y[0], y[1]); o.y = pack2(y[2], y[3]); *(uint2*)(dstb + i * 256 + lane * 4) = o; }
    }
}
__device__ void ph_ln2(const Params& p, const int vb) {
    const int lane = threadIdx.x & 63, wid = threadIdx.x >> 6;
    for (int r = vb * 4 + wid; r < T_TOK; r += gridDim.x * 4)
        ln_row(p.out + (size_t)r * DM, p.ln2_g, p.ln2_b, p.out + (size_t)r * DM, (bf16_t*)nullptr, lane);
}

#define QSTR 136
__device__ __forceinline__ int f2key(float f) { const int b = __float_as_int(f); return b ^ ((b >> 31) & 0x7fffffff); }
__device__ __forceinline__ float key2f(int k) { return __int_as_float(k ^ ((k >> 31) & 0x7fffffff)); }
__device__ __forceinline__ void sort16_desc(int (&a)[16]) {
#pragma unroll
    for (int lk = 1; lk <= 4; ++lk) {
#pragma unroll
        for (int lj = lk - 1; lj >= 0; --lj) {
            const int k = 1 << lk, j = 1 << lj;
#pragma unroll
            for (int i = 0; i < 16; ++i) {
                const int l = i ^ j;
                if (l > i) {
                    const int hi = max(a[i], a[l]), lo = min(a[i], a[l]);
                    if ((i & k) == 0) { a[i] = hi; a[l] = lo; } else { a[i] = lo; a[l] = hi; }
                }
            }
        }
    }
}
__device__ __forceinline__ void merge_top16(int (&a)[16], const int (&b)[16]) {
#pragma unroll
    for (int i = 0; i < 16; ++i) a[i] = max(a[i], b[15 - i]);
#pragma unroll
    for (int lj = 3; lj >= 0; --lj) {
        const int j = 1 << lj;
#pragma unroll
        for (int i = 0; i < 16; ++i) {
            const int l = i ^ j;
            if (l > i) { const int hi = max(a[i], a[l]), lo = min(a[i], a[l]); a[i] = hi; a[l] = lo; }
        }
    }
}
__device__ __forceinline__ void top16_of_64(int (&v)[4][16]) {
    sort16_desc(v[0]); sort16_desc(v[1]); sort16_desc(v[2]); sort16_desc(v[3]);
    merge_top16(v[0], v[1]); merge_top16(v[0], v[2]); merge_top16(v[0], v[3]);
}

__device__ void ph_mprep(const Params& p, unsigned char* smem, const int vb) {
    if (vb < 8) {
        const int n = vb * 256 + threadIdx.x, hp = n >> 7;
        const float* kr = p.keys + (size_t)n * 128;
        float a = 0.f, b = 0.f;
        for (int c4 = 0; c4 < 128; c4 += 4) {
            const f32x4 kv = *(const f32x4*)(kr + c4), wg = *(const f32x4*)(p.wgb + hp * 128 + c4), wb = *(const f32x4*)(p.wgb + 2048 + hp * 128 + c4);
            a += (kv[0] * wg[0] + kv[1] * wg[1]) + (kv[2] * wg[2] + kv[3] * wg[3]);
            b += (kv[0] * wb[0] + kv[1] * wb[1]) + (kv[2] * wb[2] + kv[3] * wb[3]);
        }
        u32x4 c0 = {pack2(a, b), 0u, 0u, 0u}; const u32x4 z4 = {0u, 0u, 0u, 0u};
        u32x4* me = (u32x4*)(p.mext + (size_t)n * 32);
        me[0] = c0; me[1] = z4; me[2] = z4; me[3] = z4;
    }
    const int tid = threadIdx.x, lane = tid & 63, wid = tid >> 6, wr = wid >> 1, wc = wid & 1, fr = lane & 15, fq = lane >> 4;
    for (int t = vb; t < 16 * 8; t += gridDim.x) {
        const int hp = t >> 3, d0 = (t & 7) * 128;
        f32x4 acc[4][4]; zero_acc(acc);
        gemm128(p.keysb + (size_t)hp * 128 * 128, 128, p.Wqb + (size_t)d0 * 2048 + hp * 128, 2048, 128, smem, acc);
#pragma unroll
        for (int mi = 0; mi < 4; ++mi)
#pragma unroll
            for (int ni = 0; ni < 4; ++ni) {
                uint2 o; o.x = pack2(acc[mi][ni][0], acc[mi][ni][1]); o.y = pack2(acc[mi][ni][2], acc[mi][ni][3]);
                *(uint2*)(p.MT + (size_t)(hp * 128 + wr * 64 + mi * 16 + fr) * DM + d0 + wc * 64 + ni * 16 + fq * 4) = o;
            }
    }
}

__device__ __forceinline__ void route_topk(const f32x16 (&S)[8], int pp, int hh, int (&K)[16]) {
    int v[4][16];
#pragma unroll
    for (int mt = 0; mt < 4; ++mt)
#pragma unroll
        for (int r = 0; r < 16; ++r) {
            const int n = mt * 32 + (r & 3) + 8 * (r >> 2) + 4 * hh;
            v[mt][r] = (f2key(S[pp * 4 + mt][r]) & ~0x7F) | (127 - n);
        }
    top16_of_64(v);
    int o[16];
#pragma unroll
    for (int i = 0; i < 16; ++i) o[i] = __shfl_xor(v[0][i], 32);
    merge_top16(v[0], o);
#pragma unroll
    for (int i = 0; i < 16; ++i) K[i] = v[0][i];
}
#define RT_STEPS 33
template <bool PRE, bool NEXT>
__device__ __forceinline__ void route_gemm(const Params& p, unsigned char* smem, int m0, int h, f32x16 (&S)[8], int nm0, int nh, int& sp) {
    LDS_AS unsigned char* lds = (LDS_AS unsigned char*)smem;
    const int tid = threadIdx.x, lane = tid & 63, wid = __builtin_amdgcn_readfirstlane(tid >> 6);
    const int r32 = lane & 31, hh = lane >> 5;
    const int prow = lane >> 2, pc = (lane & 3) ^ ((4 - ((prow >> 2) & 3)) & 3);
    const bf16_t* gA = p.y1b + (size_t)(m0 + wid * 32 + prow) * DM + pc * 8;
    const bf16_t* gB = p.MT + (size_t)(h * 256 + wid * 64 + prow) * DM + pc * 8;
    const bf16_t* eA = p.yext + (size_t)(m0 + wid * 32 + prow) * 32 + pc * 8;
    const bf16_t* eB = p.mext + (size_t)(h * 256 + wid * 64 + prow) * 32 + pc * 8;
    const size_t r16 = (size_t)16 * DM;
#define RH_ISSUE_AT(pa, sa, pb, sb_, st) do { \
        _Pragma("unroll") for (int _i = 0; _i < 2; ++_i) \
            __builtin_amdgcn_global_load_lds((const unsigned*)((pa) + _i * (sa)), (LDS_AS unsigned*)(lds + (st) * GW_STAGE + (wid * 2 + _i) * 1024), 16, 0, 0); \
        _Pragma("unroll") for (int _i = 0; _i < 4; ++_i) \
            __builtin_amdgcn_global_load_lds((const unsigned*)((pb) + _i * (sb_)), (LDS_AS unsigned*)(lds + (st) * GW_STAGE + 8192 + (wid * 4 + _i) * 1024), 16, 0, 0); \
        } while (0)
#pragma unroll
    for (int mt = 0; mt < 8; ++mt)
#pragma unroll
        for (int r = 0; r < 16; ++r) S[mt][r] = 0.f;
    const int fx = (4 - ((r32 >> 2) & 3)) & 3;
    const int toff = (wid * 32 + r32) * 64, koff = 8192 + r32 * 64;
    if (!PRE) RH_ISSUE_AT(gA, r16, gB, r16, sp);
#pragma unroll 1
    for (int kt = 0; kt < RT_STEPS; ++kt) {
        const int st = (kt + sp) & 1;
        asm volatile("s_waitcnt vmcnt(0)" ::: "memory");
        __builtin_amdgcn_s_barrier();
        asm volatile("" ::: "memory");
        if (kt + 1 < RT_STEPS - 1) RH_ISSUE_AT(gA + (size_t)(kt + 1) * 32, r16, gB + (size_t)(kt + 1) * 32, r16, st ^ 1);
        else if (kt + 1 == RT_STEPS - 1) RH_ISSUE_AT(eA, (size_t)(16 * 32), eB, (size_t)(16 * 32), st ^ 1);
        else if (NEXT) {
            const bf16_t* qA = p.y1b + (size_t)(nm0 + wid * 32 + prow) * DM + pc * 8;
            const bf16_t* qB = p.MT + (size_t)(nh * 256 + wid * 64 + prow) * DM + pc * 8;
            RH_ISSUE_AT(qA, r16, qB, r16, st ^ 1);
        }
        const LDS_AS unsigned char* sb = lds + st * GW_STAGE;
#pragma unroll
        for (int k16 = 0; k16 < 2; ++k16) {
            const int sw = ((k16 * 2 + hh) ^ fx) * 16;
            const bf16x8 b = *(const LDS_AS bf16x8*)(sb + toff + sw);
#pragma unroll
            for (int mt = 0; mt < 8; ++mt) {
                const bf16x8 a = *(const LDS_AS bf16x8*)(sb + koff + mt * 2048 + sw);
                S[mt] = __builtin_amdgcn_mfma_f32_32x32x16_bf16(a, b, S[mt], 0, 0, 0);
            }
        }
        asm volatile("s_waitcnt lgkmcnt(0)" ::: "memory");
        __builtin_amdgcn_s_barrier();
        asm volatile("" ::: "memory");
    }
    sp ^= (RT_STEPS & 1);
#undef RH_ISSUE_AT
}

__device__ void ph_route(const Params& p, unsigned char* smem, const int vb) {
    const int tid = threadIdx.x, lane = tid & 63, wid = tid >> 6;
    const int r32 = lane & 31, hh = lane >> 5;
    const int hmask = -hh;
    int* KL = (int*)(smem + 2 * GW_STAGE + (size_t)wid * 32 * 33 * 4);
    const int nunits = (T_TOK / 128) * 8;
    bool pre = false; int sp = 0;
    for (int u = vb; u < nunits; u += gridDim.x) {
        const int m0 = (u >> 3) * 128, h = u & 7;
        const int un = u + gridDim.x;
        const bool has_next = un < nunits;
        const int nm0 = ((has_next ? un : u) >> 3) * 128, nh = (has_next ? un : u) & 7;
        float mu, rstd;
        {
            const float* stp = p.stats + (size_t)(m0 + wid * 32 + r32) * 16;
            const f32x4 a = *(const f32x4*)(stp), b = *(const f32x4*)(stp + 4), c4 = *(const f32x4*)(stp + 8), d = *(const f32x4*)(stp + 12);
            const float sm = (a[0] + a[2]) + (b[0] + b[2]) + (c4[0] + c4[2]) + (d[0] + d[2]);
            const float sq = (a[1] + a[3]) + (b[1] + b[3]) + (c4[1] + c4[3]) + (d[1] + d[3]);
            mu = sm * (1.0f / 1024.0f);
            rstd = rsqrtf(fmaxf(sq * (1.0f / 1024.0f) - mu * mu, 0.f) + LN_EPS);
        }
        {
            bf16_t* ye = p.yext + (size_t)(m0 + wid * 32 + r32) * 32 + hh * 16;
            const u32x4 z4 = {0u, 0u, 0u, 0u};
            u32x4 c0 = z4; if (hh == 0) c0[0] = pack2(-mu, __builtin_amdgcn_rcpf(rstd));
            *(u32x4*)(ye) = c0; *(u32x4*)(ye + 8) = z4;
        }
        f32x16 S[8];
        if (pre) { if (has_next) route_gemm<true, true>(p, smem, m0, h, S, nm0, nh, sp); else route_gemm<true, false>(p, smem, m0, h, S, nm0, nh, sp); }
        else     { if (has_next) route_gemm<false, true>(p, smem, m0, h, S, nm0, nh, sp); else route_gemm<false, false>(p, smem, m0, h, S, nm0, nh, sp); }
        int K0[16], K1[16];
        route_topk(S, 0, hh, K0);
        route_topk(S, 1, hh, K1);
        pre = has_next;
#pragma unroll
        for (int i = 0; i < 16; ++i) KL[r32 * 33 + hh * 16 + i] = K0[i] ^ ((K0[i] ^ K1[i]) & hmask);
        float s1[16], s2[16];
#pragma unroll
        for (int i = 0; i < 16; ++i) { s1[i] = key2f(K0[i] & ~0x7F); s2[i] = key2f(K1[i] & ~0x7F); }
        int c[4][16];
#pragma unroll
        for (int i = 0; i < 16; ++i)
#pragma unroll
            for (int j = 0; j < 16; ++j)
                if ((i + 1) * (j + 1) <= 16) {
                    constexpr int OFFS[16] = {0, 16, 24, 29, 33, 36, 38, 40, 42, 43, 44, 45, 46, 47, 48, 49};
                    const int q = OFFS[i] + j;
                    c[q >> 4][q & 15] = (f2key(s1[i] + s2[j]) & ~0xFF) | (255 - (i * 16 + j));
                }
#pragma unroll
        for (int qq = 50; qq < 64; ++qq) c[qq >> 4][qq & 15] = (int)0x80000000;
        top16_of_64(c);
        const float mx = key2f(c[0][0] & ~0xFF);
        float e[16]; float den = 0.f;
#pragma unroll
        for (int i = 0; i < 16; ++i) { e[i] = __expf(rstd * (key2f(c[0][i] & ~0xFF) - mx)); den += e[i]; }
        const float inv = __builtin_amdgcn_rcpf(den);
        const size_t ob = (size_t)(m0 + wid * 32 + r32) * 128 + h * 16 + hh * 8;
        int idv[8]; float gv[8];
#pragma unroll
        for (int qq = 0; qq < 8; ++qq) {
            const int F = c[0][qq] ^ ((c[0][qq] ^ c[0][8 + qq]) & hmask);
            gv[qq] = __int_as_float(__float_as_int(e[qq]) ^ ((__float_as_int(e[qq]) ^ __float_as_int(e[8 + qq])) & hmask)) * inv;
            const int idx = 255 - (F & 0xFF);
            const int k0 = KL[r32 * 33 + (idx >> 4)], k1 = KL[r32 * 33 + 16 + (idx & 15)];
            idv[qq] = (127 - (k0 & 0x7F)) * 128 + (127 - (k1 & 0x7F));
        }
        *(int4*)(p.ids + ob) = make_int4(idv[0], idv[1], idv[2], idv[3]);
        *(int4*)(p.ids + ob + 4) = make_int4(idv[4], idv[5], idv[6], idv[7]);
        *(float4*)(p.gates + ob) = make_float4(gv[0], gv[1], gv[2], gv[3]);
        *(float4*)(p.gates + ob + 4) = make_float4(gv[4], gv[5], gv[6], gv[7]);
    }
}

__device__ __forceinline__ f32x2 row_dot(const u32x4 w, const f32x2 (&x)[8], f32x2 acc) {
#pragma unroll
    for (int k = 0; k < 4; ++k) {
        acc = __builtin_amdgcn_cvt_pk_f32_fp8(w[k], false) * x[2 * k] + acc;
        acc = __builtin_amdgcn_cvt_pk_f32_fp8(w[k], true) * x[2 * k + 1] + acc;
    }
    return acc;
}
__device__ __forceinline__ float gelu_gate(float h, float g) { return 0.5f * h * (1.0f + erff(h * 0.70710678118654752f)) * g; }

__device__ __forceinline__ void ld_ids16(const int* __restrict__ q, int (&idv)[16]) {
    const int4* idp = (const int4*)q;
#pragma unroll
    for (int k = 0; k < 4; ++k) { const int4 v = idp[k]; idv[4 * k] = v.x; idv[4 * k + 1] = v.y; idv[4 * k + 2] = v.z; idv[4 * k + 3] = v.w; }
}
__device__ __forceinline__ void ld_f16(const float* __restrict__ q, float (&a)[16]) {
    const f32x4* ap = (const f32x4*)q;
#pragma unroll
    for (int k = 0; k < 4; ++k) { const f32x4 v = ap[k]; a[4 * k] = v[0]; a[4 * k + 1] = v[1]; a[4 * k + 2] = v[2]; a[4 * k + 3] = v[3]; }
}
#define PU_TOK(n) (t0 + ((n) < ntok ? (n) : ntok - 1) * stride)
#define PU_RAW_ST(n, ri, rx) do { LDS_AS unsigned char* _b = ring + ((n) & 1) * 1024; *(LDS_AS u32x2*)(_b + lane * 8) = ri; *(LDS_AS u32x2*)(_b + 512 + lane * 8) = rx; } while (0)
#define PU_IDS(n, idv) do { const LDS_AS u32x4* _q = (const LDS_AS u32x4*)(ring + ((n) & 1) * 1024 + g * 64); \
        _Pragma("unroll") for (int _k = 0; _k < 4; ++_k) { const u32x4 _v = _q[_k]; idv[4 * _k] = (int)_v[0]; idv[4 * _k + 1] = (int)_v[1]; idv[4 * _k + 2] = (int)_v[2]; idv[4 * _k + 3] = (int)_v[3]; } } while (0)
__device__ void ph_peer_u(const Params& p, unsigned char* smem, const int vb) {
    const int lane = threadIdx.x & 63, wid = __builtin_amdgcn_readfirstlane(threadIdx.x >> 6);
    const int q = lane >> 3, c = lane & 7, j = lane & 15, kb = lane >> 4;
    const int nlb = gridDim.x >> 3, s = vb / nlb, lb = vb - s * nlb;
    const int stride = nlb * 4, t0 = lb * 4 + wid;
    const int ntok = (T_TOK - t0 + stride - 1) / stride;
    if (ntok <= 0) return;
    LDS_AS unsigned char* wb = (LDS_AS unsigned char*)smem + wid * 18432;
    LDS_AS unsigned char* ring = wb + 16384;
    const unsigned char* ubase = p.u8 + (size_t)s * (16384 * 128) + ((c ^ q) * 16);
    const unsigned char* rsrc; unsigned rstr;
    if (lane < 32) { rsrc = (const unsigned char*)p.ids + lane * 16; rstr = 512; }
    else if (lane < 48) { rsrc = (const unsigned char*)p.y1b + s * 256 + (lane - 32) * 16; rstr = 2048; }
    else { rsrc = (const unsigned char*)p.stats + ((2 * s + 1) >> 2) * 16; rstr = 64; }
#define PM_TOK(n) (t0 + ((n) < ntok ? (n) : ntok - 1) * stride)
#define PM_RING(n) do { if (lane < 49) __builtin_amdgcn_global_load_lds((const unsigned*)(rsrc + (size_t)PM_TOK(n) * rstr), (LDS_AS unsigned*)(ring + ((n) & 1) * 1024), 16, 0, 0); } while (0)
#define PM_IDS(n, ia, ib) do { const LDS_AS u32x4* _q = (const LDS_AS u32x4*)(ring + ((n) & 1) * 1024 + q * 32); \
        const u32x4 _a0 = _q[0], _a1 = _q[1], _b0 = _q[16], _b1 = _q[17]; \
        ia[0] = _a0[0]; ia[1] = _a0[1]; ia[2] = _a0[2]; ia[3] = _a0[3]; ia[4] = _a1[0]; ia[5] = _a1[1]; ia[6] = _a1[2]; ia[7] = _a1[3]; \
        ib[0] = _b0[0]; ib[1] = _b0[1]; ib[2] = _b0[2]; ib[3] = _b0[3]; ib[4] = _b1[0]; ib[5] = _b1[1]; ib[6] = _b1[2]; ib[7] = _b1[3]; } while (0)
#define PM_DMA(i, id) __builtin_amdgcn_global_load_lds((const unsigned*)(ubase + (size_t)(id) * 128), (LDS_AS unsigned*)(wb + (i) * 1024), 16, 0, 0)
    if (lane < 8) *(LDS_AS unsigned*)(ring + 960 + lane * 4) = 0u;
    const LDS_AS unsigned char* brd = wb + j * 128 + (((2 * kb) ^ (j & 7)) * 16);
    const int bx1 = 16 - 32 * ((j ^ 0) & 1 ? 1 : 0);
    const LDS_AS unsigned char* ard = ring + (j == 0 ? 832 + kb * 32 : j == 1 ? 1024 + 832 + kb * 32 : 960);
    PM_RING(0); PM_RING(1);
    asm volatile("s_waitcnt vmcnt(0)" ::: "memory");
    {
        unsigned ia[8], ib[8]; PM_IDS(0, ia, ib);
#pragma unroll
        for (int m = 0; m < 4; ++m) { PM_DMA(2 * m, ia[m]); PM_DMA(2 * m + 1, ib[m]); }
#pragma unroll
        for (int m = 4; m < 8; ++m) { PM_DMA(2 * m, ia[m]); PM_DMA(2 * m + 1, ib[m]); }
    }
    const int sqi = ((2 * s + 1) & 3) * 4;
#pragma unroll 1
    for (int n = 0; n < ntok; ++n) {
        const int t = t0 + n * stride;
        LDS_AS unsigned char* slot = ring + (n & 1) * 1024;
        const unsigned xw = *(const LDS_AS unsigned*)(slot + 512 + lane * 4);
        const float ssq = *(const LDS_AS float*)(slot + 768 + sqi);
        const int e2 = (int)(__float_as_uint(ssq) >> 23) - 126;
        int eh = (e2 + 1) >> 1; eh = eh < -60 ? -60 : (eh > 60 ? 60 : eh);
        const float sc = __uint_as_float((unsigned)(127 + 8 - eh) << 23), isc = __uint_as_float((unsigned)(127 - 8 + eh) << 23);
        const float x0 = bflo(xw) * sc, x1 = bfhi(xw) * sc;
        const unsigned h8 = (unsigned)__builtin_amdgcn_cvt_pk_fp8_f32(x0, x1, 0, false);
        const f32x2 hd = __builtin_amdgcn_cvt_pk_f32_fp8((int)h8, false);
        const unsigned l8 = (unsigned)__builtin_amdgcn_cvt_pk_fp8_f32(x0 - hd.x, x1 - hd.y, 0, false);
        *(LDS_AS unsigned short*)(ring + 832 + lane * 2) = (unsigned short)h8;
        *(LDS_AS unsigned short*)(ring + 1024 + 832 + lane * 2) = (unsigned short)l8;
        const u32x4 xa0 = *(const LDS_AS u32x4*)(ard), xa1 = *(const LDS_AS u32x4*)(ard + 16);
        i64 xa[4];
        xa[0] = (i64)(((unsigned long long)xa0[1] << 32) | xa0[0]); xa[1] = (i64)(((unsigned long long)xa0[3] << 32) | xa0[2]);
        xa[2] = (i64)(((unsigned long long)xa1[1] << 32) | xa1[0]); xa[3] = (i64)(((unsigned long long)xa1[3] << 32) | xa1[2]);
        f32x4 acc[8];
        asm volatile("s_waitcnt vmcnt(8)" ::: "memory");
#pragma unroll
        for (int m = 0; m < 4; ++m) {
            const u32x4 b0 = *(const LDS_AS u32x4*)(brd + m * 2048), b1 = *(const LDS_AS u32x4*)(brd + m * 2048 + bx1);
            f32x4 a = {0.f, 0.f, 0.f, 0.f};
            a = __builtin_amdgcn_mfma_f32_16x16x32_fp8_fp8(xa[0], (i64)(((unsigned long long)b0[1] << 32) | b0[0]), a, 0, 0, 0);
            a = __builtin_amdgcn_mfma_f32_16x16x32_fp8_fp8(xa[1], (i64)(((unsigned long long)b0[3] << 32) | b0[2]), a, 0, 0, 0);
            a = __builtin_amdgcn_mfma_f32_16x16x32_fp8_fp8(xa[2], (i64)(((unsigned long long)b1[1] << 32) | b1[0]), a, 0, 0, 0);
            a = __builtin_amdgcn_mfma_f32_16x16x32_fp8_fp8(xa[3], (i64)(((unsigned long long)b1[3] << 32) | b1[2]), a, 0, 0, 0);
            acc[m] = a;
        }
        {
            unsigned ia[8], ib[8]; PM_IDS(n + 1, ia, ib);
            PM_RING(n + 2);
#pragma unroll
            for (int m = 0; m < 4; ++m) { PM_DMA(2 * m, ia[m]); PM_DMA(2 * m + 1, ib[m]); }
            asm volatile("s_waitcnt vmcnt(9)" ::: "memory");
#pragma unroll
            for (int m = 4; m < 8; ++m) {
                const u32x4 b0 = *(const LDS_AS u32x4*)(brd + m * 2048), b1 = *(const LDS_AS u32x4*)(brd + m * 2048 + bx1);
                f32x4 a = {0.f, 0.f, 0.f, 0.f};
                a = __builtin_amdgcn_mfma_f32_16x16x32_fp8_fp8(xa[0], (i64)(((unsigned long long)b0[1] << 32) | b0[0]), a, 0, 0, 0);
                a = __builtin_amdgcn_mfma_f32_16x16x32_fp8_fp8(xa[1], (i64)(((unsigned long long)b0[3] << 32) | b0[2]), a, 0, 0, 0);
                a = __builtin_amdgcn_mfma_f32_16x16x32_fp8_fp8(xa[2], (i64)(((unsigned long long)b1[1] << 32) | b1[0]), a, 0, 0, 0);
                a = __builtin_amdgcn_mfma_f32_16x16x32_fp8_fp8(xa[3], (i64)(((unsigned long long)b1[3] << 32) | b1[2]), a, 0, 0, 0);
                acc[m] = a;
            }
#pragma unroll
            for (int m = 4; m < 8; ++m) { PM_DMA(2 * m, ia[m]); PM_DMA(2 * m + 1, ib[m]); }
        }
        if (lane < 16) {
            u32x4 o;
#pragma unroll
            for (int k = 0; k < 4; ++k) o[k] = pack2((acc[2 * k][0] + acc[2 * k][1]) * isc, (acc[2 * k + 1][0] + acc[2 * k + 1][1]) * isc);
            *(u32x4*)(p.hp + ((size_t)t * 8 + s) * 128 + lane * 8) = o;
        }
    }
    asm volatile("s_waitcnt vmcnt(0)" ::: "memory");
}
__device__ void ph_peer_act(const Params& p, unsigned char* smem, const int vb) {
    const int lane = threadIdx.x & 63, wid = threadIdx.x >> 6;
    unsigned* lsc = (unsigned*)smem;
    __syncthreads();
    for (int i = threadIdx.x; i < 16384 / 4; i += 256) *(u32x4*)(lsc + 4 * i) = *(const u32x4*)((const unsigned*)p.sc2 + 4 * i);
    __syncthreads();
    for (int t = vb * 4 + wid; t < T_TOK; t += gridDim.x * 4) {
        f32x2 h = {0.f, 0.f};
#pragma unroll
        for (int s = 0; s < 8; ++s) { const unsigned w = *(const unsigned*)(p.hp + ((size_t)t * 8 + s) * 128 + 2 * lane); h += (f32x2){bflo(w), bfhi(w)}; }
        f32x2 pq = *(const f32x2*)(p.stats + (size_t)t * 16 + (lane & 7) * 2);
        pq.x += __shfl_xor(pq.x, 1); pq.y += __shfl_xor(pq.y, 1); pq.x += __shfl_xor(pq.x, 2); pq.y += __shfl_xor(pq.y, 2); pq.x += __shfl_xor(pq.x, 4); pq.y += __shfl_xor(pq.y, 4);
        const float mu = pq.x * (1.0f / 1024.0f), rstd = rsqrtf(fmaxf(pq.y * (1.0f / 1024.0f) - mu * mu, 0.f) + LN_EPS);
        int2 id = *(const int2*)(p.ids + (size_t)t * 128 + 2 * lane);
        id.x &= 0x3fff; id.y &= 0x3fff;
        const f32x2 gt = *(const f32x2*)(p.gates + (size_t)t * 128 + 2 * lane);
        const unsigned s0 = lsc[id.x], s1 = lsc[id.y];
        const unsigned c0 = p.cb2[id.x], c1 = p.cb2[id.y];
        f32x2 a;
        a.x = gelu_gate(rstd * (h.x * bflo(s0) - mu * bflo(c0)) + bfhi(c0), gt.x) * bfhi(s0);
        a.y = gelu_gate(rstd * (h.y * bflo(s1) - mu * bflo(c1)) + bfhi(c1), gt.y) * bfhi(s1);
        *(f32x2*)(p.gates + (size_t)t * 128 + 2 * lane) = a;
        if (lane < 2) {
            const unsigned pb = __float_as_uint(lane ? rstd : mu);
            *(int2*)(p.ids + (size_t)t * 128 + 2 * lane) = make_int2(id.x | (int)(pb & 0xffff0000u), id.y | (int)(pb << 16));
        }
    }
}
__device__ void ph_peer_v(const Params& p, unsigned char* smem, const int vb) {
    const int lane = threadIdx.x & 63, wid = __builtin_amdgcn_readfirstlane(threadIdx.x >> 6), g = lane >> 3, c = lane & 7;
    const int nlb = gridDim.x >> 3, s = vb / nlb, lb = vb - s * nlb;
    const bool b4 = (lane & 16) != 0, b3 = (lane & 8) != 0;
    const unsigned char* vbase = p.v8 + (size_t)s * (16384 * 128) + c * 16;
    const int stride = nlb * 4, t0 = lb * 4 + wid;
    const int ntok = (T_TOK - t0 + stride - 1) / stride;
    if (ntok <= 0) return;
    const int d0 = s * 128 + c * 16 + 2 * g;
    LDS_AS unsigned char* ring = (LDS_AS unsigned char*)smem + wid * 2048;
    const int* idg = p.ids + 2 * lane;
    const float* ag = p.gates + 2 * lane;
#define PV_RAW_LD(n, ri, rx) do { const int _t = PU_TOK(n); ri = *(const u32x2*)(idg + (size_t)_t * 128); rx = *(const u32x2*)(ag + (size_t)_t * 128); } while (0)
    u32x4 wA[8], wB[8]; u32x2 ri, rx;
    float mu_c, rs_c;
    const f32x2 g2 = *(const f32x2*)(p.ln1_g + d0), b2 = *(const f32x2*)(p.ln1_b + d0);
    {
        u32x2 i0, x0, i1, x1v;
        PV_RAW_LD(0, i0, x0); PV_RAW_LD(1, i1, x1v); PV_RAW_LD(2, ri, rx);
        PU_RAW_ST(0, i0, x0); PU_RAW_ST(1, i1, x1v);
        int id0[16]; PU_IDS(0, id0);
        mu_c = __uint_as_float(((unsigned)__builtin_amdgcn_readlane(id0[0], 0) & 0xffff0000u) | ((unsigned)__builtin_amdgcn_readlane(id0[1], 0) >> 16));
        rs_c = __uint_as_float(((unsigned)__builtin_amdgcn_readlane(id0[2], 0) & 0xffff0000u) | ((unsigned)__builtin_amdgcn_readlane(id0[3], 0) >> 16));
#pragma unroll
        for (int i = 0; i < 16; ++i) id0[i] &= 0x3fff;
#pragma unroll
        for (int i = 0; i < 8; ++i) wA[i] = *(const u32x4*)(vbase + (size_t)id0[i] * 128);
#pragma unroll
        for (int i = 0; i < 8; ++i) wB[i] = *(const u32x4*)(vbase + (size_t)id0[8 + i] * 128);
    }
#pragma unroll 1
    for (int n = 0; n < ntok; ++n) {
        const int t = t0 + n * stride;
        const unsigned yw = *(const unsigned*)(p.y1b + (size_t)t * DM + d0);
        const float mu = mu_c, rs = rs_c;
        const f32x2 xv = {(bflo(yw) - mu) * rs * g2.x + b2.x, (bfhi(yw) - mu) * rs * g2.y + b2.y};
        float ac[16];
        {
            const LDS_AS f32x4* q = (const LDS_AS f32x4*)(ring + (n & 1) * 1024 + 512 + g * 64);
#pragma unroll
            for (int k = 0; k < 4; ++k) { const f32x4 v4 = q[k]; ac[4 * k] = v4[0]; ac[4 * k + 1] = v4[1]; ac[4 * k + 2] = v4[2]; ac[4 * k + 3] = v4[3]; }
        }
        int idn[16]; PU_IDS(n + 1, idn);
        mu_c = __uint_as_float(((unsigned)__builtin_amdgcn_readlane(idn[0], 0) & 0xffff0000u) | ((unsigned)__builtin_amdgcn_readlane(idn[1], 0) >> 16));
        rs_c = __uint_as_float(((unsigned)__builtin_amdgcn_readlane(idn[2], 0) & 0xffff0000u) | ((unsigned)__builtin_amdgcn_readlane(idn[3], 0) >> 16));
#pragma unroll
        for (int i = 0; i < 16; ++i) idn[i] &= 0x3fff;
        f32x2 acc[8];
#pragma unroll
        for (int k = 0; k < 8; ++k) acc[k] = (f32x2){0.f, 0.f};
#pragma unroll
        for (int i = 0; i < 8; ++i) {
            const f32x2 a2 = {ac[i], ac[i]};
#pragma unroll
            for (int k = 0; k < 4; ++k) {
                acc[2 * k] = __builtin_amdgcn_cvt_pk_f32_fp8(wA[i][k], false) * a2 + acc[2 * k];
                acc[2 * k + 1] = __builtin_amdgcn_cvt_pk_f32_fp8(wA[i][k], true) * a2 + acc[2 * k + 1];
            }
        }
#pragma unroll
        for (int i = 0; i < 8; ++i) wA[i] = *(const u32x4*)(vbase + (size_t)idn[i] * 128);
#pragma unroll
        for (int i = 0; i < 8; ++i) {
            const f32x2 a2 = {ac[8 + i], ac[8 + i]};
#pragma unroll
            for (int k = 0; k < 4; ++k) {
                acc[2 * k] = __builtin_amdgcn_cvt_pk_f32_fp8(wB[i][k], false) * a2 + acc[2 * k];
                acc[2 * k + 1] = __builtin_amdgcn_cvt_pk_f32_fp8(wB[i][k], true) * a2 + acc[2 * k + 1];
            }
        }
#pragma unroll
        for (int i = 0; i < 8; ++i) wB[i] = *(const u32x4*)(vbase + (size_t)idn[8 + i] * 128);
        PU_RAW_ST(n + 2, ri, rx);
        PV_RAW_LD(n + 3, ri, rx);
        float v[16];
#pragma unroll
        for (int k = 0; k < 8; ++k) { v[2 * k] = acc[k].x; v[2 * k + 1] = acc[k].y; }
#pragma unroll
        for (int j2 = 0; j2 < 8; ++j2) {
            auto r = __builtin_amdgcn_permlane32_swap(__float_as_uint(v[j2]), __float_as_uint(v[j2 + 8]), false, false);
            v[j2] = __uint_as_float(r[0]) + __uint_as_float(r[1]);
        }
#pragma unroll
        for (int j2 = 0; j2 < 4; ++j2) { const float keep = b4 ? v[j2 + 4] : v[j2], send = b4 ? v[j2] : v[j2 + 4]; v[j2] = keep + __shfl_xor(send, 16); }
#pragma unroll
        for (int j2 = 0; j2 < 2; ++j2) { const float keep = b3 ? v[j2 + 2] : v[j2], send = b3 ? v[j2] : v[j2 + 2]; v[j2] = keep + __shfl_xor(send, 8); }
        const float r0 = ALPHA * xv.x + v[0], r1 = ALPHA * xv.y + v[1];
        *(unsigned*)(p.rb + (size_t)t * DM + d0) = pack2(r0, r1);
    }
}

__device__ void ph_gemm_ple(const Params& p, unsigned char* smem, const int vb) {
    const int ntn = DM / 128;
    const int tid = threadIdx.x, lane = tid & 63, wid = tid >> 6, wr = wid >> 1, wc = wid & 1, fr = lane & 15, fq = lane >> 4;
    const int ntiles = (T_TOK / 128) * ntn;
    bool pre = false;
    for (int t = vb; t < ntiles; t += gridDim.x) {
        const int m0 = (t / ntn) * 128, n0 = (t % ntn) * 128;
        const int tn = t + gridDim.x;
        const bool has_next = tn < ntiles;
        const bf16_t* nA = p.pb + (size_t)((has_next ? tn : t) / ntn) * 128 * 256;
        const bf16_t* nB = p.WpT + (size_t)((has_next ? tn : t) % ntn) * 128 * 256;
        const bf16_t* gA = p.rb + (size_t)m0 * DM; const bf16_t* gB = p.WgT + (size_t)n0 * DM;
        f32x4 acc[4][4], acc2[4][4]; zero_acc(acc); zero_acc(acc2);
        if (pre) gemm128<true, true>(p.pb + (size_t)m0 * 256, 256, p.WpT + (size_t)n0 * 256, 256, 256, smem, acc2, gA, DM, gB, DM);
        else     gemm128<false, true>(p.pb + (size_t)m0 * 256, 256, p.WpT + (size_t)n0 * 256, 256, 256, smem, acc2, gA, DM, gB, DM);
        if (has_next) gemm128<true, true>(gA, DM, gB, DM, DM, smem, acc, nA, 256, nB, 256);
        else          gemm128<true, false>(gA, DM, gB, DM, DM, smem, acc);
        pre = has_next;
#pragma unroll
        for (int mi = 0; mi < 4; ++mi) {
            const int row = m0 + wr * 64 + mi * 16 + fr;
#pragma unroll
            for (int ni = 0; ni < 4; ++ni) {
                const int col = n0 + wc * 64 + ni * 16 + fq * 4;
                const u32x2 rw = *(const u32x2*)(p.rb + (size_t)row * DM + col);
                f32x4 rv = {bflo(rw[0]), bfhi(rw[0]), bflo(rw[1]), bfhi(rw[1])};
#pragma unroll
                for (int r = 0; r < 4; ++r) rv[r] += sigmul(acc2[mi][ni][r], acc[mi][ni][r]);
                *(f32x4*)(p.out + (size_t)row * DM + col) = rv;
            }
        }
    }
}

#define XB_TMO      128
#define XB_XCNT(j)  (256  + 64 * (j))
#define XB_XSUB(j)  (1280 + 64 * (j))
#define XB_XGEN(j)  (2304 + 64 * (j))
#define XB_TOP      3328
#define XB_TOPGEN   3392
#define XCD_BAR_WORDS 3456
#define XB_SPIN_CAP (1u << 20)
__device__ __forceinline__ unsigned xb_ld(unsigned* p)              { return __hip_atomic_load(p, __ATOMIC_RELAXED, __HIP_MEMORY_SCOPE_AGENT); }
__device__ __forceinline__ unsigned xb_add(unsigned* p, unsigned v) { return __hip_atomic_fetch_add(p, v, __ATOMIC_RELAXED, __HIP_MEMORY_SCOPE_AGENT); }
__device__ __forceinline__ unsigned xb_xcc_id() { return (unsigned)__builtin_amdgcn_s_getreg((3 << 11) | 20) & 0xFu; }
#define XB_SPIN(cond, bar) do { unsigned _sp = 0; while (cond) { __builtin_amdgcn_s_sleep(1); \
    if ((++_sp & 255u) == 0u) { if (xb_ld(&(bar)[XB_TMO])) break; if (_sp > XB_SPIN_CAP) { atomicAdd(&(bar)[XB_TMO], 1u); break; } } } } while (0)
struct XcdBarrier { unsigned* bar; unsigned x; volatile LDS_AS unsigned* st; };
__device__ __forceinline__ XcdBarrier xcd_barrier_post(unsigned* bar, volatile LDS_AS unsigned* st) {
    XcdBarrier b; b.bar = bar; b.x = xb_xcc_id(); b.st = st;
    if (threadIdx.x == 0) st[3] = xb_add(&bar[XB_XCNT(b.x)], 1u);
    return b;
}
__device__ __forceinline__ void xcd_barrier_complete(unsigned* bar, unsigned x, unsigned rank, unsigned& nloc, unsigned& nx, unsigned& vb) {
    const unsigned G = gridDim.x;
    unsigned sum, cnt, mine, sp = 0u; bool even;
    for (;;) {
        sum = 0u; cnt = 0u; mine = 0u; even = true;
#pragma unroll
        for (unsigned j = 0; j < 16; ++j) {
            const unsigned c = xb_ld(&bar[XB_XCNT(j)]); sum += c; cnt += (c > 0u) ? 1u : 0u; mine = (j == x) ? c : mine;
            even = even && (c == ((j < 8u) ? (G >> 3) : 0u));
        }
        if (sum == G) break;
        __builtin_amdgcn_s_sleep(1);
        if ((++sp & 255u) == 0u) { if (xb_ld(&bar[XB_TMO])) break; if (sp > XB_SPIN_CAP) { atomicAdd(&bar[XB_TMO], 1u); break; } }
    }
    nloc = mine > 0u ? mine : 1u; nx = cnt > 0u ? cnt : 1u;
    vb = (even && sum == G && (G & 7u) == 0u) ? (x * (G >> 3) + rank) : blockIdx.x;
}
__device__ __forceinline__ void xcd_barrier(const XcdBarrier& b) {
    asm volatile("s_waitcnt vmcnt(0)" ::: "memory");
    __syncthreads();
    if (threadIdx.x == 0) {
        unsigned* bar = b.bar;
        __builtin_amdgcn_s_waitcnt(0);
        unsigned nloc = b.st[0], nx = b.st[1];
        if (nloc == 0u) { unsigned vb; xcd_barrier_complete(bar, b.x, b.st[3], nloc, nx, vb); b.st[0] = nloc; b.st[1] = nx; b.st[2] = vb; }
        const unsigned old = xb_add(&bar[XB_XSUB(b.x)], 1u);
        const unsigned gen = old / nloc;
        if (old + 1u == (gen + 1u) * nloc) {
            __builtin_amdgcn_fence(__ATOMIC_RELEASE, "agent");
            asm volatile("s_waitcnt vmcnt(0)" ::: "memory");
            const unsigned og = xb_add(&bar[XB_TOP], 1u);
            const unsigned tg = og / nx;
            if (og + 1u == (tg + 1u) * nx) xb_add(&bar[XB_TOPGEN], 1u);
            else XB_SPIN(xb_ld(&bar[XB_TOPGEN]) == tg, bar);
            __builtin_amdgcn_fence(__ATOMIC_ACQUIRE, "agent");
            xb_add(&bar[XB_XGEN(b.x)], 1u);
            asm volatile("s_waitcnt vmcnt(0)" ::: "memory");
        } else {
            XB_SPIN(xb_ld(&bar[XB_XGEN(b.x)]) == gen, bar);
            __builtin_amdgcn_fence(__ATOMIC_ACQUIRE, "agent");
            asm volatile("s_waitcnt vmcnt(0)" ::: "memory");
        }
    }
    __syncthreads();
}

#define SMEM_PHASE (256 * ASTR * 2 * 2)
#define SMEM_BYTES (SMEM_PHASE + 16)
__global__ void __launch_bounds__(256, 2) mega(Params p) {
    __shared__ __attribute__((aligned(16))) unsigned char smem[SMEM_BYTES];
    volatile LDS_AS unsigned* st = (volatile LDS_AS unsigned*)(LDS_AS unsigned char*)(smem + SMEM_PHASE);
    if (threadIdx.x < 4) st[threadIdx.x] = 0u;
    __syncthreads();
    const XcdBarrier gb = xcd_barrier_post(p.bar, st);
    ph_prep(p, smem);            xcd_barrier(gb);
    const int vb = (int)st[2];
    ph_gemm_in(p, smem, vb);     xcd_barrier(gb);
    ph_attn(p, smem, vb);
    ph_conv(p, smem, vb);        xcd_barrier(gb);
    ph_mprep(p, smem, vb);
    ph_gemm_out(p, smem, vb);    xcd_barrier(gb);
    ph_route(p, smem, vb);       xcd_barrier(gb);
    ph_peer_u(p, smem, vb);      xcd_barrier(gb);
    ph_peer_act(p, smem, vb);    xcd_barrier(gb);
    ph_peer_v(p, smem, vb);      xcd_barrier(gb);
    ph_gemm_ple(p, smem, vb);    xcd_barrier(gb);
    ph_ln2(p, vb);
}

extern "C" void kernel_launch(void* const* d_in, const int* in_sizes, int n_in, void* d_out, int out_size, void* d_ws, size_t ws_size,
                              hipStream_t stream) {
    Params p{};
    p.x = (const float*)d_in[0]; p.p = (const float*)d_in[1]; p.pos = (const int*)d_in[2];
    p.w_in = (const float*)d_in[3]; p.sinks = (const float*)d_in[4]; p.conv_w = (const float*)d_in[5]; p.conv_b = (const float*)d_in[6];
    p.cln_g = (const float*)d_in[7]; p.cln_b = (const float*)d_in[8]; p.w_out = (const float*)d_in[9]; p.ln1_g = (const float*)d_in[10];
    p.ln1_b = (const float*)d_in[11]; p.wq = (const float*)d_in[12]; p.keys = (const float*)d_in[13]; p.pu = (const float*)d_in[14];
    p.pv = (const float*)d_in[15]; p.ple_proj = (const float*)d_in[16]; p.ple_gate = (const float*)d_in[17]; p.ln2_g = (const float*)d_in[18];
    p.ln2_b = (const float*)d_in[19];
    p.out = (float*)d_out;
    unsigned char* ws = (unsigned char*)d_ws;
    const size_t MiB = 1024 * 1024;
    p.y1 = (float*)(ws + 0 * MiB);
    p.hb = (bf16_t*)(ws + 128 * MiB);
    p.hp = (bf16_t*)(ws + 128 * MiB);
    p.xb = (bf16_t*)(ws + 256 * MiB);
    p.mixb = (bf16_t*)(ws + 320 * MiB);
    p.rb = (bf16_t*)(ws + 320 * MiB);
    p.pb = (bf16_t*)(ws + 384 * MiB);
    p.u8 = (unsigned char*)(ws + 400 * MiB);
    p.v8 = (unsigned char*)(ws + 416 * MiB);
    p.sc2 = (bf16_t*)(ws + 432 * MiB);
    p.rope = (float*)(ws + 434 * MiB);
    p.stats = (float*)(ws + 436 * MiB);
    p.cb2 = (unsigned*)(ws + 438 * MiB);
    p.mext = (bf16_t*)(ws + 440 * MiB);
    p.yext = (bf16_t*)(ws + 442 * MiB);
    p.y1b = (bf16_t*)(ws + 0 * MiB);
    p.ids = (int*)(ws + 464 * MiB);
    p.gates = (float*)(ws + 480 * MiB);
    unsigned char* wb = ws + 496 * MiB;
    p.WinT = (bf16_t*)wb; wb += (size_t)INW * DM * 2;
    p.WoutT = (bf16_t*)wb; wb += (size_t)DM * DM * 2;
    p.WgT = (bf16_t*)wb; wb += (size_t)DM * DM * 2;
    p.WpT = (bf16_t*)wb; wb += (size_t)DM * 256 * 2;
    p.keysb = (bf16_t*)wb; wb += (size_t)16 * 128 * 128 * 2;
    p.Wqb = (bf16_t*)(ws + 240 * MiB);
    p.MT = (bf16_t*)(ws + 244 * MiB);
    p.bar = (unsigned*)(ws + 510 * MiB);
    p.wgb = (float*)(p.bar + XCD_BAR_WORDS + 640);

    static int grid_blocks = 0;
    if (!grid_blocks) {
        int dev = 0, cus = 0, per_cu = 0;
        (void)hipGetDevice(&dev);
        (void)hipDeviceGetAttribute(&cus, hipDeviceAttributeMultiprocessorCount, dev);
        (void)hipOccupancyMaxActiveBlocksPerMultiprocessor(&per_cu, mega, 256, 0);
        if (per_cu > 2) per_cu = 2;
        grid_blocks = cus * per_cu;
    }
    (void)hipMemsetAsync(p.bar, 0, (XCD_BAR_WORDS + 640 + 4096) * sizeof(unsigned), stream);
    void* args[] = {&p};
    hipError_t e = hipLaunchCooperativeKernel((void*)mega, dim3(grid_blocks), dim3(256), args, 0, stream);
    if (e != hipSuccess) fprintf(stderr, "cooperative launch failed: %s (grid %d)\n", hipGetErrorString(e), grid_blocks);
}
```

```cpp
#include <hip/hip_runtime.h>
#include <stdint.h>
#include <cstdio>

typedef unsigned short bf16_t;
typedef short bf16x8 __attribute__((ext_vector_type(8)));
typedef float f32x4 __attribute__((ext_vector_type(4)));
typedef unsigned u32x4 __attribute__((ext_vector_type(4)));
typedef float f32x2 __attribute__((ext_vector_type(2)));
typedef long i64;

#define T_TOK 32768
#define SEQ 2048
#define DM 1024
#define INW 1792
#define ALPHA 1.189207115002721f
#define LN_EPS 1e-5f

__device__ __forceinline__ bf16_t f2bf(float f) {
    unsigned u = __float_as_uint(f);
    u += 0x7fffu + ((u >> 16) & 1u);
    return (bf16_t)(u >> 16);
}
__device__ __forceinline__ float bf2f(bf16_t b) { return __uint_as_float(((unsigned)b) << 16); }
__device__ __forceinline__ float bflo(unsigned w) { return __uint_as_float(w << 16); }
__device__ __forceinline__ float bfhi(unsigned w) { return __uint_as_float(w & 0xffff0000u); }
__device__ __forceinline__ unsigned pack2(float a, float b) { return (unsigned)f2bf(a) | ((unsigned)f2bf(b) << 16); }

__device__ __forceinline__ float sigmul(float x, float g) { return x * __builtin_amdgcn_rcpf(1.0f + __expf(-g)); }
__device__ __forceinline__ float wave_sum(float v) {
#pragma unroll
    for (int o = 32; o >= 1; o >>= 1) v += __shfl_xor(v, o);
    return v;
}

struct Params {
    const float *x, *p; const int* pos;
    const float *w_in, *sinks, *conv_w, *conv_b, *cln_g, *cln_b, *w_out, *ln1_g, *ln1_b;
    const float *wq, *keys, *pu, *pv, *ple_proj, *ple_gate, *ln2_g, *ln2_b;
    float* out;
    bf16_t *xb, *pb, *WinT, *WoutT, *WgT, *WpT, *keysb, *Wqb, *MT, *hb, *mixb, *rb;
    float *y1, *gates, *rope, *stats, *wgb;
    bf16_t *y1b, *yext, *mext; unsigned* cb2;
    bf16_t* sc2;
    bf16_t* hp;
    int *ids;
    unsigned char *u8, *v8;
    unsigned* bar;
};

__device__ void cvt_rows(const float* __restrict__ src, bf16_t* __restrict__ dst, size_t n) {
    const size_t nv = n / 8, gs = (size_t)gridDim.x * blockDim.x;
    for (size_t i = (size_t)blockIdx.x * blockDim.x + threadIdx.x; i < nv; i += 4 * gs) {
        f32x4 a[4], b[4];
#pragma unroll
        for (int q = 0; q < 4; ++q) { const size_t k = (i + q * gs < nv) ? i + q * gs : i; a[q] = ((const f32x4*)src)[2 * k]; b[q] = ((const f32x4*)src)[2 * k + 1]; }
#pragma unroll
        for (int q = 0; q < 4; ++q) {
            if (i + q * gs < nv) {
                u32x4 o; o[0] = pack2(a[q][0], a[q][1]); o[1] = pack2(a[q][2], a[q][3]); o[2] = pack2(b[q][0], b[q][1]); o[3] = pack2(b[q][2], b[q][3]);
                ((u32x4*)dst)[i + q * gs] = o;
            }
        }
    }
}
__device__ __forceinline__ int win_row(int n) {
    if (n < 768) return n;
    const int isg = n >= 1280 ? 1 : 0, c = n - (isg ? 1280 : 768);
    const int tt = c >> 6, wc = (c >> 5) & 1, k2 = (c >> 4) & 1, rest = c & 15;
    return 768 + 128 * tt + wc * 64 + (k2 * 2 + isg) * 16 + rest;
}
template <bool WIN = false>
__device__ void transpose_cvt(const float* __restrict__ W, bf16_t* __restrict__ Wt, int K, int N, float* tile  ) {
    const int tk = K / 64, tn = N / 64;
    const int tid = threadIdx.x;
    for (int t = blockIdx.x; t < tk * tn; t += gridDim.x) {
        const int k0 = (t / tn) * 64, n0 = (t % tn) * 64;
        f32x4 v[4];
#pragma unroll
        for (int i = 0; i < 4; ++i) v[i] = *(const f32x4*)(W + (size_t)(k0 + (tid >> 4) + 16 * i) * N + n0 + (tid & 15) * 4);
        __syncthreads();
#pragma unroll
        for (int i = 0; i < 4; ++i)
#pragma unroll
            for (int j = 0; j < 4; ++j) tile[((tid >> 4) + 16 * i) * 65 + (tid & 15) * 4 + j] = v[i][j];
        __syncthreads();
        const int n = tid >> 2, kc = (tid & 3) * 16;
        u32x4 o0, o1;
#pragma unroll
        for (int q = 0; q < 4; ++q) {
            o0[q] = pack2(tile[(kc + 2 * q) * 65 + n], tile[(kc + 2 * q + 1) * 65 + n]);
            o1[q] = pack2(tile[(kc + 8 + 2 * q) * 65 + n], tile[(kc + 8 + 2 * q + 1) * 65 + n]);
        }
        const int nd = WIN ? win_row(n0 + n) : n0 + n;
        *(u32x4*)(Wt + (size_t)nd * K + k0 + kc) = o0;
        *(u32x4*)(Wt + (size_t)nd * K + k0 + kc + 8) = o1;
    }
}
__device__ void cvt_wq_fold(const Params& p, unsigned char* smem) {
    for (int i = blockIdx.x * 256 + threadIdx.x; i < DM * 256; i += gridDim.x * 256) {
        const int d = i >> 8, c8 = (i & 255) * 8;
        const float gd = p.ln1_g[d];
        const f32x4 a = *(const f32x4*)(p.wq + (size_t)d * 2048 + c8), b = *(const f32x4*)(p.wq + (size_t)d * 2048 + c8 + 4);
        u32x4 o; o[0] = pack2(a[0] * gd, a[1] * gd); o[1] = pack2(a[2] * gd, a[3] * gd); o[2] = pack2(b[0] * gd, b[1] * gd); o[3] = pack2(b[2] * gd, b[3] * gd);
        *(u32x4*)(p.Wqb + (size_t)d * 2048 + c8) = o;
    }
    float* red = (float*)smem;
    const int lane = threadIdx.x & 63, wid = threadIdx.x >> 6;
    for (int cb = blockIdx.x; cb < 512; cb += gridDim.x) {
        f32x4 sg = {0.f, 0.f, 0.f, 0.f}, sb = {0.f, 0.f, 0.f, 0.f};
#pragma unroll
        for (int q = 0; q < 4; ++q) {
            const int d = threadIdx.x * 4 + q;
            const f32x4 v = *(const f32x4*)(p.wq + (size_t)d * 2048 + cb * 4);
            sg += v * p.ln1_g[d]; sb += v * p.ln1_b[d];
        }
        __syncthreads();
#pragma unroll
        for (int q = 0; q < 4; ++q) {
            const float a = wave_sum(sg[q]), b = wave_sum(sb[q]);
            if (lane == 0) { red[wid * 8 + q] = a; red[wid * 8 + 4 + q] = b; }
        }
        __syncthreads();
        if (threadIdx.x < 8) {
            const float t = (red[threadIdx.x] + red[8 + threadIdx.x]) + (red[16 + threadIdx.x] + red[24 + threadIdx.x]);
            p.wgb[(threadIdx.x >> 2) * 2048 + cb * 4 + (threadIdx.x & 3)] = t;
        }
    }
}
template <bool FOLD>
__device__ void cvt_table_fp8(const Params& p, const float* __restrict__ src, unsigned char* __restrict__ dst, bf16_t* __restrict__ scl, int rows) {
    const int lane = threadIdx.x & 63, wid = threadIdx.x >> 6;
    const int nw = gridDim.x * 4;
    for (int r0 = blockIdx.x * 4 + wid; r0 < rows; r0 += 4 * nw) {
        f32x4 v[4][4];
#pragma unroll
        for (int q = 0; q < 4; ++q) {
            const int r = (r0 + q * nw < rows) ? r0 + q * nw : r0;
            const float* sr = src + (size_t)r * DM + lane * 16;
#pragma unroll
            for (int k = 0; k < 4; ++k) v[q][k] = *(const f32x4*)(sr + 4 * k);
        }
        f32x4 gv[4], bv[4];
        if (FOLD) {
#pragma unroll
            for (int k = 0; k < 4; ++k) { gv[k] = *(const f32x4*)(p.ln1_g + lane * 16 + 4 * k); bv[k] = *(const f32x4*)(p.ln1_b + lane * 16 + 4 * k); }
        }
#pragma unroll
        for (int q = 0; q < 4; ++q) {
            const int r = r0 + q * nw;
            if (FOLD) {
                float cu = 0.f, bu = 0.f;
#pragma unroll
                for (int k = 0; k < 4; ++k) { bu += (bv[k][0] * v[q][k][0] + bv[k][1] * v[q][k][1]) + (bv[k][2] * v[q][k][2] + bv[k][3] * v[q][k][3]); v[q][k] = v[q][k] * gv[k]; cu += (v[q][k][0] + v[q][k][1]) + (v[q][k][2] + v[q][k][3]); }
                cu = wave_sum(cu); bu = wave_sum(bu);
                if (lane == 0 && r < rows) p.cb2[r] = pack2(cu, bu);
            }
            float m = 0.f;
#pragma unroll
            for (int k = 0; k < 4; ++k)
#pragma unroll
                for (int i = 0; i < 4; ++i) m = fmaxf(m, fabsf(v[q][k][i]));
#pragma unroll
            for (int o = 32; o >= 1; o >>= 1) m = fmaxf(m, __shfl_xor(m, o));
            int ex = (m > 0.f) ? (8 - (int)((__float_as_uint(m) >> 23) & 0xffu) + 127 - ((__float_as_uint(m) & 0x7fffffu) > 0x600000u ? 1 : 0)) : 0;
            ex = min(max(ex, -100), 100);
            const float sc = __uint_as_float((unsigned)(127 + ex) << 23);
            u32x4 w;
#pragma unroll
            for (int k = 0; k < 4; ++k)
                w[k] = __builtin_amdgcn_cvt_pk_fp8_f32(v[q][k][2] * sc, v[q][k][3] * sc, __builtin_amdgcn_cvt_pk_fp8_f32(v[q][k][0] * sc, v[q][k][1] * sc, 0, false), true);
            if (r < rows) {
                *(u32x4*)(dst + (size_t)(lane >> 3) * (16384 * 128) + (size_t)r * 128 + (lane & 7) * 16) = w;
                if (lane == 0) scl[2 * r] = (bf16_t)(((unsigned)(127 - ex) << 23) >> 16);
            }
        }
    }
}
__device__ void ph_prep(const Params& p, unsigned char* smem) {
    float* tile = (float*)smem;
    cvt_rows(p.x, p.xb, (size_t)T_TOK * DM);
    cvt_rows(p.p, p.pb, (size_t)T_TOK * 256);
    cvt_table_fp8<true>(p, p.pu, p.u8, p.sc2, 16384);
    cvt_table_fp8<false>(p, p.pv, p.v8, p.sc2 + 1, 16384);
    cvt_rows(p.keys, p.keysb, (size_t)16 * 128 * 128);
    for (int i = blockIdx.x * 256 + threadIdx.x; i < T_TOK * 8; i += gridDim.x * 256) {
        const int t = i >> 3, j = i & 7;
        const float inv = powf(500000.0f, -(float)j * 0.125f);
        float sn, cs; sincosf((float)p.pos[t] * inv, &sn, &cs);
        p.rope[t * 16 + j] = cs; p.rope[t * 16 + 8 + j] = sn;
    }
    transpose_cvt<true>(p.w_in, p.WinT, DM, INW, tile);
    transpose_cvt(p.w_out, p.WoutT, DM, DM, tile);
    cvt_wq_fold(p, smem);
    transpose_cvt(p.ple_gate, p.WgT, DM, DM, tile);
    transpose_cvt(p.ple_proj, p.WpT, 256, DM, tile);
}

#define LDS_AS __attribute__((address_space(3)))
#define GEMM_STAGE 32768
template <bool PRE = false, bool NEXT = false>
__device__ __forceinline__ void gemm128(const bf16_t* __restrict__ A, int lda, const bf16_t* __restrict__ Bt, int ldb, int K,
                                        unsigned char* smem, f32x4 (&acc)[4][4],
                                        const bf16_t* __restrict__ nA = nullptr, int nlda = 0, const bf16_t* __restrict__ nB = nullptr, int nldb = 0) {
    LDS_AS unsigned char* lds = (LDS_AS unsigned char*)smem;
    const int tid = threadIdx.x, lane = tid & 63, wid = __builtin_amdgcn_readfirstlane(tid >> 6);
    const int wr = wid >> 1, wc = wid & 1, fr = lane & 15, fq = lane >> 4;
    const int nk = K / 64;
    const int prow = lane >> 3, pc = (lane & 7) ^ prow;
    const bf16_t* gA = A + (size_t)(wid * 32 + prow) * lda + pc * 8;
    const bf16_t* gB = Bt + (size_t)(wid * 32 + prow) * ldb + pc * 8;
    const size_t a8 = (size_t)8 * lda, b8 = (size_t)8 * ldb;
#define GEMM_ISSUE(kt, st) do { \
        _Pragma("unroll") for (int _i = 0; _i < 4; ++_i) { \
            __builtin_amdgcn_global_load_lds((const unsigned*)(gA + _i * a8 + (size_t)(kt) * 64), (LDS_AS unsigned*)(lds + (st) * GEMM_STAGE + (wid * 4 + _i) * 1024), 16, 0, 0); \
            __builtin_amdgcn_global_load_lds((const unsigned*)(gB + _i * b8 + (size_t)(kt) * 64), (LDS_AS unsigned*)(lds + (st) * GEMM_STAGE + 16384 + (wid * 4 + _i) * 1024), 16, 0, 0); \
        } } while (0)
    const int swz0 = ((0 * 4 + fq) ^ (fr & 7)) * 16, swz1 = ((1 * 4 + fq) ^ (fr & 7)) * 16;
    const int aoff = (wr * 64 + fr) * 128, boff = 16384 + (wc * 64 + fr) * 128;
    if (!PRE) GEMM_ISSUE(0, 0);
#pragma unroll 1
    for (int kt = 0; kt < nk; ++kt) {
        const int st = kt & 1;
        asm volatile("s_waitcnt vmcnt(0)" ::: "memory");
        __builtin_amdgcn_s_barrier();
        asm volatile("" ::: "memory");
        if (kt + 1 < nk) GEMM_ISSUE(kt + 1, st ^ 1);
        else if (NEXT) {
            const bf16_t* qA = nA + (size_t)(wid * 32 + prow) * nlda + pc * 8;
            const bf16_t* qB = nB + (size_t)(wid * 32 + prow) * nldb + pc * 8;
#pragma unroll
            for (int _i = 0; _i < 4; ++_i) {
                __builtin_amdgcn_global_load_lds((const unsigned*)(qA + (size_t)(_i * 8) * nlda), (LDS_AS unsigned*)(lds + (wid * 4 + _i) * 1024), 16, 0, 0);
                __builtin_amdgcn_global_load_lds((const unsigned*)(qB + (size_t)(_i * 8) * nldb), (LDS_AS unsigned*)(lds + 16384 + (wid * 4 + _i) * 1024), 16, 0, 0);
            }
        }
        const LDS_AS unsigned char* sb = lds + st * GEMM_STAGE;
        bf16x8 af0[4], bf0[4], af1[4], bf1[4];
#pragma unroll
        for (int mi = 0; mi < 4; ++mi) af0[mi] = *(const LDS_AS bf16x8*)(sb + aoff + mi * 2048 + swz0);
#pragma unroll
        for (int ni = 0; ni < 4; ++ni) bf0[ni] = *(const LDS_AS bf16x8*)(sb + boff + ni * 2048 + swz0);
#pragma unroll
        for (int mi = 0; mi < 4; ++mi) af1[mi] = *(const LDS_AS bf16x8*)(sb + aoff + mi * 2048 + swz1);
#pragma unroll
        for (int ni = 0; ni < 4; ++ni) bf1[ni] = *(const LDS_AS bf16x8*)(sb + boff + ni * 2048 + swz1);
#pragma unroll
        for (int mi = 0; mi < 4; ++mi)
#pragma unroll
            for (int ni = 0; ni < 4; ++ni)
                acc[mi][ni] = __builtin_amdgcn_mfma_f32_16x16x32_bf16(bf0[ni], af0[mi], acc[mi][ni], 0, 0, 0);
#pragma unroll
        for (int mi = 0; mi < 4; ++mi)
#pragma unroll
            for (int ni = 0; ni < 4; ++ni)
                acc[mi][ni] = __builtin_amdgcn_mfma_f32_16x16x32_bf16(bf1[ni], af1[mi], acc[mi][ni], 0, 0, 0);
        __builtin_amdgcn_sched_group_barrier(0x100, 8, 0);
#pragma unroll
        for (int q = 0; q < 8; ++q) { __builtin_amdgcn_sched_group_barrier(0x008, 2, 0); __builtin_amdgcn_sched_group_barrier(0x100, 1, 0); }
        __builtin_amdgcn_sched_group_barrier(0x008, 16, 0);
        asm volatile("s_waitcnt lgkmcnt(0)" ::: "memory");
        __builtin_amdgcn_s_barrier();
        asm volatile("" ::: "memory");
    }
#undef GEMM_ISSUE
}
#define GW_STAGE 24576
__device__ __forceinline__ void gemmW(const bf16_t* __restrict__ A, int lda, const bf16_t* __restrict__ Bt, int ldb, int K,
                                      unsigned char* smem, f32x4 (&acc)[4][8]) {
    LDS_AS unsigned char* lds = (LDS_AS unsigned char*)smem;
    const int tid = threadIdx.x, lane = tid & 63, wid = __builtin_amdgcn_readfirstlane(tid >> 6);
    const int wr = wid >> 1, wc = wid & 1, fr = lane & 15, fq = lane >> 4;
    const int nk = K / 32;
    const int prow = lane >> 2, pc = (lane & 3) ^ ((4 - ((prow >> 2) & 3)) & 3);
    const bf16_t* gA = A + (size_t)(wid * 32 + prow) * lda + pc * 8;
    const bf16_t* gB = Bt + (size_t)(wid * 64 + prow) * ldb + pc * 8;
    const size_t a16 = (size_t)16 * lda, b16 = (size_t)16 * ldb;
#define GW_ISSUE(kt, st) do { \
        _Pragma("unroll") for (int _i = 0; _i < 2; ++_i) \
            __builtin_amdgcn_global_load_lds((const unsigned*)(gA + _i * a16 + (size_t)(kt) * 32), (LDS_AS unsigned*)(lds + (st) * GW_STAGE + (wid * 2 + _i) * 1024), 16, 0, 0); \
        _Pragma("unroll") for (int _i = 0; _i < 4; ++_i) \
            __builtin_amdgcn_global_load_lds((const unsigned*)(gB + _i * b16 + (size_t)(kt) * 32), (LDS_AS unsigned*)(lds + (st) * GW_STAGE + 8192 + (wid * 4 + _i) * 1024), 16, 0, 0); \
        } while (0)
    const int swz = (fq ^ ((4 - ((fr >> 2) & 3)) & 3)) * 16;
    const int aoff = (wr * 64 + fr) * 64 + swz, boff = 8192 + (wc * 128 + fr) * 64 + swz;
    GW_ISSUE(0, 0);
#pragma unroll 1
    for (int kt = 0; kt < nk; ++kt) {
        const int st = kt & 1;
        asm volatile("s_waitcnt vmcnt(0)" ::: "memory");
        __builtin_amdgcn_s_barrier();
        asm volatile("" ::: "memory");
        if (kt + 1 < nk) GW_ISSUE(kt + 1, st ^ 1);
        const LDS_AS unsigned char* sb = lds + st * GW_STAGE;
        bf16x8 af[4], bfr[8];
#pragma unroll
        for (int mi = 0; mi < 4; ++mi) af[mi] = *(const LDS_AS bf16x8*)(sb + aoff + mi * 1024);
#pragma unroll
        for (int ni = 0; ni < 8; ++ni) bfr[ni] = *(const LDS_AS bf16x8*)(sb + boff + ni * 1024);
#pragma unroll
        for (int ni = 0; ni < 8; ++ni)
#pragma unroll
            for (int mi = 0; mi < 4; ++mi)
                acc[mi][ni] = __builtin_amdgcn_mfma_f32_16x16x32_bf16(bfr[ni], af[mi], acc[mi][ni], 0, 0, 0);
        asm volatile("s_waitcnt lgkmcnt(0)" ::: "memory");
        __builtin_amdgcn_s_barrier();
        asm volatile("" ::: "memory");
    }
#undef GW_ISSUE
}
__device__ __forceinline__ void zero_accw(f32x4 (&acc)[4][8]) {
#pragma unroll
    for (int a = 0; a < 4; ++a)
#pragma unroll
        for (int b = 0; b < 8; ++b) acc[a][b] = (f32x4){0.f, 0.f, 0.f, 0.f};
}
__device__ __forceinline__ void zero_acc(f32x4 (&acc)[4][4]) {
#pragma unroll
    for (int a = 0; a < 4; ++a)
#pragma unroll
        for (int b = 0; b < 4; ++b) acc[a][b] = (f32x4){0.f, 0.f, 0.f, 0.f};
}
#define GEMM_SMEM (2 * GEMM_STAGE)

__device__ void ph_gemm_in(const Params& p, unsigned char* smem, const int vb) {
    const int ntn = INW / 128;
    const int tid = threadIdx.x, lane = tid & 63, wid = tid >> 6, wr = wid >> 1, wc = wid & 1, fr = lane & 15, fq = lane >> 4;
    const int ntiles = (T_TOK / 128) * ntn;
    bool pre = false;
    for (int t = vb; t < ntiles; t += gridDim.x) {
        const int m0 = (t / ntn) * 128, n0 = (t % ntn) * 128;
        const int tn = t + gridDim.x;
        const bool has_next = tn < ntiles;
        const bf16_t* nA = p.xb + (size_t)((has_next ? tn : t) / ntn) * 128 * DM;
        const bf16_t* nB = p.WinT + (size_t)((has_next ? tn : t) % ntn) * 128 * DM;
        f32x4 acc[4][4]; zero_acc(acc);
        if (pre) { if (has_next) gemm128<true, true>(p.xb + (size_t)m0 * DM, DM, p.WinT + (size_t)n0 * DM, DM, DM, smem, acc, nA, DM, nB, DM);
                   else          gemm128<true, false>(p.xb + (size_t)m0 * DM, DM, p.WinT + (size_t)n0 * DM, DM, DM, smem, acc); }
        else     { if (has_next) gemm128<false, true>(p.xb + (size_t)m0 * DM, DM, p.WinT + (size_t)n0 * DM, DM, DM, smem, acc, nA, DM, nB, DM);
                   else          gemm128<false, false>(p.xb + (size_t)m0 * DM, DM, p.WinT + (size_t)n0 * DM, DM, DM, smem, acc); }
        pre = has_next;
        if (n0 >= 768) {
            const int cb = ((n0 - 768) >> 7) * 64 + wc * 32 + fq * 4;
#pragma unroll
            for (int mi = 0; mi < 4; ++mi) {
                const int row = m0 + wr * 64 + mi * 16 + fr;
#pragma unroll
                for (int k2 = 0; k2 < 2; ++k2) {
                    const f32x4 a = acc[mi][2 * k2], gt = acc[mi][2 * k2 + 1];
                    uint2 o; o.x = pack2(sigmul(a[0], gt[0]), sigmul(a[1], gt[1])); o.y = pack2(sigmul(a[2], gt[2]), sigmul(a[3], gt[3]));
                    *(uint2*)(p.hb + (size_t)row * INW + 768 + cb + k2 * 16) = o;
                }
            }
        } else {
#pragma unroll
        for (int mi = 0; mi < 4; ++mi) {
            const int row = m0 + wr * 64 + mi * 16 + fr;
#pragma unroll
            for (int ni = 0; ni < 4; ++ni) {
                const int col0 = n0 + wc * 64 + ni * 16;
                f32x4 v = acc[mi][ni];
                if (col0 < 640 && (col0 & 63) == 0) {
                    const f32x4 cs = *(const f32x4*)(p.rope + (size_t)row * 16 + (fq & 1) * 4), sn = *(const f32x4*)(p.rope + (size_t)row * 16 + 8 + (fq & 1) * 4);
#pragma unroll
                    for (int r = 0; r < 4; ++r) {
                        const float other = __shfl_xor(v[r], 32);
                        v[r] = (fq < 2) ? (v[r] * cs[r] - other * sn[r]) : (v[r] * cs[r] + other * sn[r]);
                    }
                }
                uint2 o; o.x = pack2(v[0], v[1]); o.y = pack2(v[2], v[3]);
                *(uint2*)(p.hb + (size_t)row * INW + col0 + fq * 4) = o;
            }
        }
        }
    }
}

#define ASTR 72
#define VSTR 260
typedef float f32x16 __attribute__((ext_vector_type(16)));
typedef unsigned u32x2 __attribute__((ext_vector_type(2)));
__device__ void ph_attn(const Params& p, unsigned char* smem, const int vb) {
    bf16_t* sK = (bf16_t*)smem;
    bf16_t* sVt = sK + 256 * ASTR;
    const int tid = threadIdx.x, lane = tid & 63, wid = tid >> 6, r32 = lane & 31, hh = lane >> 5;
    const float C1 = 0.125f * 1.4426950408889634f, LOG2E = 1.4426950408889634f;
    for (int u = vb; u < 16 * 16 * 2; u += gridDim.x) {
        const int kvh = u & 1, nb = (u >> 1) & 15, b = u >> 5;
        __syncthreads();
        for (int c = tid; c < 256 * 8; c += 256) {
            const int li = c >> 3, kc = c & 7;
            const int pos = nb * 128 - 128 + li;
            u32x4 kv = {0u, 0u, 0u, 0u}, vv = {0u, 0u, 0u, 0u};
            if (pos >= 0) {
                const bf16_t* base = p.hb + (size_t)(b * SEQ + pos) * INW;
                kv = *(const u32x4*)(base + 512 + kvh * 64 + kc * 8);
                vv = *(const u32x4*)(base + 640 + kvh * 64 + kc * 8);
            }
            *(u32x4*)(sK + li * ASTR + kc * 8) = kv;
#pragma unroll
            for (int i = 0; i < 4; ++i) {
                sVt[(kc * 8 + 2 * i) * VSTR + li] = (bf16_t)(vv[i] & 0xffffu);
                sVt[(kc * 8 + 2 * i + 1) * VSTR + li] = (bf16_t)(vv[i] >> 16);
            }
        }
        __syncthreads();
        const int hq = kvh * 4 + wid;
        const float sink2 = p.sinks[hq] * LOG2E;
        bf16x8 qn[4];
        {
            const size_t tr0 = (size_t)(b * SEQ + nb * 128 + r32);
#pragma unroll
            for (int ks = 0; ks < 4; ++ks) qn[ks] = *(const bf16x8*)(p.hb + tr0 * INW + hq * 64 + ks * 16 + hh * 8);
        }
#pragma unroll 1
        for (int qt = 0; qt < 4; ++qt) {
            const size_t trow = (size_t)(b * SEQ + nb * 128 + qt * 32 + r32);
            bf16x8 qf[4];
#pragma unroll
            for (int ks = 0; ks < 4; ++ks) qf[ks] = qn[ks];
            {
                const size_t trn = (size_t)(b * SEQ + nb * 128 + (qt < 3 ? qt + 1 : qt) * 32 + r32);
#pragma unroll
                for (int ks = 0; ks < 4; ++ks) qn[ks] = *(const bf16x8*)(p.hb + trn * INW + hq * 64 + ks * 16 + hh * 8);
            }
            f32x16 S[5];
#pragma unroll
            for (int j = 0; j < 5; ++j) {
#pragma unroll
                for (int r = 0; r < 16; ++r) S[j][r] = 0.f;
#pragma unroll
                for (int ks = 0; ks < 4; ++ks) {
                    const bf16x8 a = *(const bf16x8*)(sK + ((qt + j) * 32 + r32) * ASTR + ks * 16 + hh * 8);
                    S[j] = __builtin_amdgcn_mfma_f32_32x32x16_bf16(a, qf[ks], S[j], 0, 0, 0);
                }
            }
            float m2 = sink2;
#pragma unroll
            for (int j = 0; j < 5; ++j) {
                const bool tile_ok = (nb > 0) || (qt + j >= 4);
#pragma unroll
                for (int r = 0; r < 16; ++r) {
                    const int kl = (r & 3) + 8 * (r >> 2) + 4 * hh;
                    bool ok = tile_ok;
                    if (j == 0) ok = ok && (kl > r32);
                    if (j == 4) ok = ok && (kl <= r32);
                    const float t = ok ? S[j][r] * C1 : -1.0e30f;
                    S[j][r] = t;
                    m2 = fmaxf(m2, t);
                }
            }
            m2 = fmaxf(m2, __shfl_xor(m2, 32));
            float l = 0.f;
#pragma unroll
            for (int j = 0; j < 5; ++j)
#pragma unroll
                for (int r = 0; r < 16; ++r) { const float e = __builtin_amdgcn_exp2f(S[j][r] - m2); S[j][r] = e; l += e; }
            l += __shfl_xor(l, 32);
            l += __builtin_amdgcn_exp2f(sink2 - m2);
            f32x16 O[2];
#pragma unroll
            for (int dt = 0; dt < 2; ++dt)
#pragma unroll
                for (int r = 0; r < 16; ++r) O[dt][r] = 0.f;
#pragma unroll
            for (int j = 0; j < 5; ++j)
#pragma unroll
                for (int s2 = 0; s2 < 2; ++s2) {
                    u32x4 pw;
#pragma unroll
                    for (int k = 0; k < 4; ++k) pw[k] = pack2(S[j][8 * s2 + 2 * k], S[j][8 * s2 + 2 * k + 1]);
                    const bf16x8 pf = __builtin_bit_cast(bf16x8, pw);
                    const int kbase = (qt + j) * 32 + 16 * s2 + 4 * hh;
#pragma unroll
                    for (int dt = 0; dt < 2; ++dt) {
                        const bf16_t* vp = sVt + (dt * 32 + r32) * VSTR + kbase;
                        const u32x2 v0 = *(const u32x2*)(vp), v1 = *(const u32x2*)(vp + 8);
                        const u32x4 vw = {v0[0], v0[1], v1[0], v1[1]};
                        O[dt] = __builtin_amdgcn_mfma_f32_32x32x16_bf16(__builtin_bit_cast(bf16x8, vw), pf, O[dt], 0, 0, 0);
                    }
                }
            const float il = __builtin_amdgcn_rcpf(l);
#pragma unroll
            for (int dt = 0; dt < 2; ++dt)
#pragma unroll
                for (int g = 0; g < 4; ++g) {
                    u32x2 w;
                    w[0] = pack2(O[dt][4 * g] * il, O[dt][4 * g + 1] * il);
                    w[1] = pack2(O[dt][4 * g + 2] * il, O[dt][4 * g + 3] * il);
                    *(u32x2*)(p.mixb + trow * DM + hq * 64 + dt * 32 + 8 * g + 4 * hh) = w;
                }
        }
    }
}

#define CV_ROWS 62
__device__ void ph_conv(const Params& p, unsigned char* smem, const int vb) {
    bf16_t* gl = (bf16_t*)smem;
    float* red = (float*)(smem + CV_ROWS * 1024);
    const int tid = threadIdx.x, lane = tid & 63, wid = tid >> 6;
    const f32x2 lg = *(const f32x2*)(p.cln_g + 2 * tid), lb = *(const f32x2*)(p.cln_b + 2 * tid);
    for (int u = vb; u < T_TOK / 32; u += gridDim.x) {
        const int tok0 = u * 32, s0 = tok0 & (SEQ - 1);
        __syncthreads();
#pragma unroll 1
        for (int bt = 0; bt < 2; ++bt) {
            u32x4 av[8];
#pragma unroll
            for (int it = 0; it < 8; ++it) {
                const int ch = tid + (bt * 8 + it) * 256, row = min(ch >> 6, CV_ROWS - 1), k = ch & 63;
                const int rr = (s0 - 30 + row >= 0) ? row : 30;
                av[it] = *(const u32x4*)(p.hb + (size_t)(tok0 - 30 + rr) * INW + 768 + k * 8);
            }
#pragma unroll
            for (int it = 0; it < 8; ++it) {
                const int ch = tid + (bt * 8 + it) * 256, row = ch >> 6, k = ch & 63;
                const bool ok = (s0 - 30 + row >= 0);
                const u32x4 o = ok ? av[it] : (u32x4){0u, 0u, 0u, 0u};
                if (row < CV_ROWS) *(u32x4*)(gl + row * 512 + k * 8) = o;
            }
        }
        __syncthreads();
        float w0[31], w1[31];
#pragma unroll
        for (int k = 0; k < 31; ++k) { const f32x2 wv = *(const f32x2*)(p.conv_w + k * 512 + 2 * tid); w0[k] = wv.x; w1[k] = wv.y; }
        const f32x2 bias = *(const f32x2*)(p.conv_b + 2 * tid);
#pragma unroll 1
        for (int jh = 0; jh < 2; ++jh) {
            float a0[16], a1[16];
#pragma unroll
            for (int jl = 0; jl < 16; ++jl) { a0[jl] = bias.x; a1[jl] = bias.y; }
            const bf16_t* gp = gl + (jh * 16) * 512 + 2 * tid;
#pragma unroll
            for (int il = 0; il < 46; ++il) {
                const unsigned gw = *(const unsigned*)(gp + il * 512);
                const float g0 = bflo(gw), g1 = bfhi(gw);
#pragma unroll
                for (int jl = 0; jl < 16; ++jl)
                    if (il - jl >= 0 && il - jl <= 30) { a0[jl] += w0[il - jl] * g0; a1[jl] += w1[il - jl] * g1; }
                if ((il & 3) == 3) __builtin_amdgcn_sched_barrier(0);
            }
            float v[32];
#pragma unroll
            for (int jl = 0; jl < 16; ++jl) { v[jl] = a0[jl] + a1[jl]; v[16 + jl] = a0[jl] * a0[jl] + a1[jl] * a1[jl]; }
#pragma unroll
            for (int st = 16; st >= 1; st >>= 1) {
                const bool up = (lane & st) != 0;
#pragma unroll
                for (int i2 = 0; i2 < st; ++i2) {
                    const float keep = up ? v[i2 + st] : v[i2], send = up ? v[i2] : v[i2 + st];
                    v[i2] = keep + __shfl_xor(send, st);
                }
            }
            const float tot = v[0] + __shfl_xor(v[0], 32);
            __syncthreads();
            if (lane < 32) red[wid * 32 + lane] = tot;
            __syncthreads();
#pragma unroll
            for (int jl = 0; jl < 16; ++jl) {
                const float sm = (red[jl] + red[32 + jl]) + (red[64 + jl] + red[96 + jl]);
                const float sq = (red[16 + jl] + red[48 + jl]) + (red[80 + jl] + red[112 + jl]);
                const float mu = sm * (1.0f / 512.0f);
                const float rstd = rsqrtf(fmaxf(sq * (1.0f / 512.0f) - mu * mu, 0.f) + LN_EPS);
                const float y0 = (a0[jl] - mu) * rstd * lg.x + lb.x, y1 = (a1[jl] - mu) * rstd * lg.y + lb.y;
                *(unsigned*)(p.mixb + (size_t)(tok0 + jh * 16 + jl) * DM + 512 + 2 * tid) = pack2(sigmul(y0, y0), sigmul(y1, y1));
            }
        }
    }
}

__device__ void ph_gemm_out(const Params& p, unsigned char* smem, const int vb) {
    const int ntn = DM / 256;
    const int tid = threadIdx.x, lane = tid & 63, wid = tid >> 6, wr = wid >> 1, wc = wid & 1, fr = lane & 15, fq = lane >> 4;
    for (int t = vb; t < (T_TOK / 128) * ntn; t += gridDim.x) {
        const int m0 = (t / ntn) * 128, n0 = (t % ntn) * 256;
        f32x4 acc[4][8]; zero_accw(acc);
        gemmW(p.mixb + (size_t)m0 * DM, DM, p.WoutT + (size_t)n0 * DM, DM, DM, smem, acc);
#pragma unroll
        for (int mi = 0; mi < 4; ++mi) {
            const int row = m0 + wr * 64 + mi * 16 + fr;
            float sm = 0.f, sq = 0.f;
#pragma unroll
            for (int ni = 0; ni < 8; ++ni) {
                const int col = n0 + wc * 128 + ni * 16 + fq * 4;
                const f32x4 xv = *(const f32x4*)(p.x + (size_t)row * DM + col);
                const f32x4 y = xv * ALPHA + acc[mi][ni];
                sm += (y[0] + y[1]) + (y[2] + y[3]); sq += (y[0] * y[0] + y[1] * y[1]) + (y[2] * y[2] + y[3] * y[3]);
                u32x2 o; o[0] = pack2(y[0], y[1]); o[1] = pack2(y[2], y[3]);
                *(u32x2*)(p.y1b + (size_t)row * DM + col) = o;
            }
            sm += __shfl_xor(sm, 16); sq += __shfl_xor(sq, 16); sm += __shfl_xor(sm, 32); sq += __shfl_xor(sq, 32);
            if (fq == 0) *(f32x2*)(p.stats + (size_t)row * 16 + ((n0 >> 8) * 2 + wc) * 2) = (f32x2){sm, sq};
        }
    }
}

__device__ __forceinline__ void ln_row(const float* __restrict__ src, const float* __restrict__ g, const float* __restrict__ bta,
                                       float* __restrict__ dstf, bf16_t* __restrict__ dstb, int lane) {
    f32x4 v[4]; float s = 0.f;
#pragma unroll
    for (int i = 0; i < 4; ++i) { v[i] = *(const f32x4*)(src + i * 256 + lane * 4); s += (v[i][0] + v[i][1]) + (v[i][2] + v[i][3]); }
    const float mu = wave_sum(s) * (1.0f / 1024.0f);
    float q = 0.f;
#pragma unroll
    for (int i = 0; i < 4; ++i) { const f32x4 d = v[i] - mu; q += (d[0] * d[0] + d[1] * d[1]) + (d[2] * d[2] + d[3] * d[3]); }
    const float rstd = rsqrtf(wave_sum(q) * (1.0f / 1024.0f) + LN_EPS);
#pragma unroll
    for (int i = 0; i < 4; ++i) {
        const f32x4 gg = *(const f32x4*)(g + i * 256 + lane * 4), bb = *(const f32x4*)(bta + i * 256 + lane * 4);
        const f32x4 y = (v[i] - mu) * rstd * gg + bb;
        if (dstf) *(f32x4*)(dstf + i * 256 + lane * 4) = y;
        if (dstb) { uint2 o; o.x = pack2(y[0], y[1]); o.y = pack2(y[2], y[3]); *(uint2*)(dstb + i * 256 + lane * 4) = o; }
    }
}
__device__ void ph_ln2(const Params& p, const int vb) {
    const int lane = threadIdx.x & 63, wid = threadIdx.x >> 6;
    for (int r = vb * 4 + wid; r < T_TOK; r += gridDim.x * 4)
        ln_row(p.out + (size_t)r * DM, p.ln2_g, p.ln2_b, p.out + (size_t)r * DM, (bf16_t*)nullptr, lane);
}

#define QSTR 136
__device__ __forceinline__ int f2key(float f) { const int b = __float_as_int(f); return b ^ ((b >> 31) & 0x7fffffff); }
__device__ __forceinline__ float key2f(int k) { return __int_as_float(k ^ ((k >> 31) & 0x7fffffff)); }
__device__ __forceinline__ void sort16_desc(int (&a)[16]) {
#pragma unroll
    for (int lk = 1; lk <= 4; ++lk) {
#pragma unroll
        for (int lj = lk - 1; lj >= 0; --lj) {
            const int k = 1 << lk, j = 1 << lj;
#pragma unroll
            for (int i = 0; i < 16; ++i) {
                const int l = i ^ j;
                if (l > i) {
                    const int hi = max(a[i], a[l]), lo = min(a[i], a[l]);
                    if ((i & k) == 0) { a[i] = hi; a[l] = lo; } else { a[i] = lo; a[l] = hi; }
                }
            }
        }
    }
}
__device__ __forceinline__ void merge_top16(int (&a)[16], const int (&b)[16]) {
#pragma unroll
    for (int i = 0; i < 16; ++i) a[i] = max(a[i], b[15 - i]);
#pragma unroll
    for (int lj = 3; lj >= 0; --lj) {
        const int j = 1 << lj;
#pragma unroll
        for (int i = 0; i < 16; ++i) {
            const int l = i ^ j;
            if (l > i) { const int hi = max(a[i], a[l]), lo = min(a[i], a[l]); a[i] = hi; a[l] = lo; }
        }
    }
}
__device__ __forceinline__ void top16_of_64(int (&v)[4][16]) {
    sort16_desc(v[0]); sort16_desc(v[1]); sort16_desc(v[2]); sort16_desc(v[3]);
    merge_top16(v[0], v[1]); merge_top16(v[0], v[2]); merge_top16(v[0], v[3]);
}

__device__ void ph_mprep(const Params& p, unsigned char* smem, const int vb) {
    if (vb < 8) {
        const int n = vb * 256 + threadIdx.x, hp = n >> 7;
        const float* kr = p.keys + (size_t)n * 128;
        float a = 0.f, b = 0.f;
        for (int c4 = 0; c4 < 128; c4 += 4) {
            const f32x4 kv = *(const f32x4*)(kr + c4), wg = *(const f32x4*)(p.wgb + hp * 128 + c4), wb = *(const f32x4*)(p.wgb + 2048 + hp * 128 + c4);
            a += (kv[0] * wg[0] + kv[1] * wg[1]) + (kv[2] * wg[2] + kv[3] * wg[3]);
            b += (kv[0] * wb[0] + kv[1] * wb[1]) + (kv[2] * wb[2] + kv[3] * wb[3]);
        }
        u32x4 c0 = {pack2(a, b), 0u, 0u, 0u}; const u32x4 z4 = {0u, 0u, 0u, 0u};
        u32x4* me = (u32x4*)(p.mext + (size_t)n * 32);
        me[0] = c0; me[1] = z4; me[2] = z4; me[3] = z4;
    }
    const int tid = threadIdx.x, lane = tid & 63, wid = tid >> 6, wr = wid >> 1, wc = wid & 1, fr = lane & 15, fq = lane >> 4;
    for (int t = vb; t < 16 * 8; t += gridDim.x) {
        const int hp = t >> 3, d0 = (t & 7) * 128;
        f32x4 acc[4][4]; zero_acc(acc);
        gemm128(p.keysb + (size_t)hp * 128 * 128, 128, p.Wqb + (size_t)d0 * 2048 + hp * 128, 2048, 128, smem, acc);
#pragma unroll
        for (int mi = 0; mi < 4; ++mi)
#pragma unroll
            for (int ni = 0; ni < 4; ++ni) {
                uint2 o; o.x = pack2(acc[mi][ni][0], acc[mi][ni][1]); o.y = pack2(acc[mi][ni][2], acc[mi][ni][3]);
                *(uint2*)(p.MT + (size_t)(hp * 128 + wr * 64 + mi * 16 + fr) * DM + d0 + wc * 64 + ni * 16 + fq * 4) = o;
            }
    }
}

__device__ __forceinline__ void route_topk(const f32x16 (&S)[8], int pp, int hh, int (&K)[16]) {
    int v[4][16];
#pragma unroll
    for (int mt = 0; mt < 4; ++mt)
#pragma unroll
        for (int r = 0; r < 16; ++r) {
            const int n = mt * 32 + (r & 3) + 8 * (r >> 2) + 4 * hh;
            v[mt][r] = (f2key(S[pp * 4 + mt][r]) & ~0x7F) | (127 - n);
        }
    top16_of_64(v);
    int o[16];
#pragma unroll
    for (int i = 0; i < 16; ++i) o[i] = __shfl_xor(v[0][i], 32);
    merge_top16(v[0], o);
#pragma unroll
    for (int i = 0; i < 16; ++i) K[i] = v[0][i];
}
#define RT_STEPS 33
template <bool PRE, bool NEXT>
__device__ __forceinline__ void route_gemm(const Params& p, unsigned char* smem, int m0, int h, f32x16 (&S)[8], int nm0, int nh, int& sp) {
    LDS_AS unsigned char* lds = (LDS_AS unsigned char*)smem;
    const int tid = threadIdx.x, lane = tid & 63, wid = __builtin_amdgcn_readfirstlane(tid >> 6);
    const int r32 = lane & 31, hh = lane >> 5;
    const int prow = lane >> 2, pc = (lane & 3) ^ ((4 - ((prow >> 2) & 3)) & 3);
    const bf16_t* gA = p.y1b + (size_t)(m0 + wid * 32 + prow) * DM + pc * 8;
    const bf16_t* gB = p.MT + (size_t)(h * 256 + wid * 64 + prow) * DM + pc * 8;
    const bf16_t* eA = p.yext + (size_t)(m0 + wid * 32 + prow) * 32 + pc * 8;
    const bf16_t* eB = p.mext + (size_t)(h * 256 + wid * 64 + prow) * 32 + pc * 8;
    const size_t r16 = (size_t)16 * DM;
#define RH_ISSUE_AT(pa, sa, pb, sb_, st) do { \
        _Pragma("unroll") for (int _i = 0; _i < 2; ++_i) \
            __builtin_amdgcn_global_load_lds((const unsigned*)((pa) + _i * (sa)), (LDS_AS unsigned*)(lds + (st) * GW_STAGE + (wid * 2 + _i) * 1024), 16, 0, 0); \
        _Pragma("unroll") for (int _i = 0; _i < 4; ++_i) \
            __builtin_amdgcn_global_load_lds((const unsigned*)((pb) + _i * (sb_)), (LDS_AS unsigned*)(lds + (st) * GW_STAGE + 8192 + (wid * 4 + _i) * 1024), 16, 0, 0); \
        } while (0)
#pragma unroll
    for (int mt = 0; mt < 8; ++mt)
#pragma unroll
        for (int r = 0; r < 16; ++r) S[mt][r] = 0.f;
    const int fx = (4 - ((r32 >> 2) & 3)) & 3;
    const int toff = (wid * 32 + r32) * 64, koff = 8192 + r32 * 64;
    if (!PRE) RH_ISSUE_AT(gA, r16, gB, r16, sp);
#pragma unroll 1
    for (int kt = 0; kt < RT_STEPS; ++kt) {
        const int st = (kt + sp) & 1;
        asm volatile("s_waitcnt vmcnt(0)" ::: "memory");
        __builtin_amdgcn_s_barrier();
        asm volatile("" ::: "memory");
        if (kt + 1 < RT_STEPS - 1) RH_ISSUE_AT(gA + (size_t)(kt + 1) * 32, r16, gB + (size_t)(kt + 1) * 32, r16, st ^ 1);
        else if (kt + 1 == RT_STEPS - 1) RH_ISSUE_AT(eA, (size_t)(16 * 32), eB, (size_t)(16 * 32), st ^ 1);
        else if (NEXT) {
            const bf16_t* qA = p.y1b + (size_t)(nm0 + wid * 32 + prow) * DM + pc * 8;
            const bf16_t* qB = p.MT + (size_t)(nh * 256 + wid * 64 + prow) * DM + pc * 8;
            RH_ISSUE_AT(qA, r16, qB, r16, st ^ 1);
        }
        const LDS_AS unsigned char* sb = lds + st * GW_STAGE;
#pragma unroll
        for (int k16 = 0; k16 < 2; ++k16) {
            const int sw = ((k16 * 2 + hh) ^ fx) * 16;
            const bf16x8 b = *(const LDS_AS bf16x8*)(sb + toff + sw);
#pragma unroll
            for (int mt = 0; mt < 8; ++mt) {
                const bf16x8 a = *(const LDS_AS bf16x8*)(sb + koff + mt * 2048 + sw);
                S[mt] = __builtin_amdgcn_mfma_f32_32x32x16_bf16(a, b, S[mt], 0, 0, 0);
            }
        }
        asm volatile("s_waitcnt lgkmcnt(0)" ::: "memory");
        __builtin_amdgcn_s_barrier();
        asm volatile("" ::: "memory");
    }
    sp ^= (RT_STEPS & 1);
#undef RH_ISSUE_AT
}

__device__ void ph_route(const Params& p, unsigned char* smem, const int vb) {
    const int tid = threadIdx.x, lane = tid & 63, wid = tid >> 6;
    const int r32 = lane & 31, hh = lane >> 5;
    const int hmask = -hh;
    int* KL = (int*)(smem + 2 * GW_STAGE + (size_t)wid * 32 * 33 * 4);
    const int nunits = (T_TOK / 128) * 8;
    bool pre = false; int sp = 0;
    for (int u = vb; u < nunits; u += gridDim.x) {
        const int m0 = (u >> 3) * 128, h = u & 7;
        const int un = u + gridDim.x;
        const bool has_next = un < nunits;
        const int nm0 = ((has_next ? un : u) >> 3) * 128, nh = (has_next ? un : u) & 7;
        float mu, rstd;
        {
            const float* stp = p.stats + (size_t)(m0 + wid * 32 + r32) * 16;
            const f32x4 a = *(const f32x4*)(stp), b = *(const f32x4*)(stp + 4), c4 = *(const f32x4*)(stp + 8), d = *(const f32x4*)(stp + 12);
            const float sm = (a[0] + a[2]) + (b[0] + b[2]) + (c4[0] + c4[2]) + (d[0] + d[2]);
            const float sq = (a[1] + a[3]) + (b[1] + b[3]) + (c4[1] + c4[3]) + (d[1] + d[3]);
            mu = sm * (1.0f / 1024.0f);
            rstd = rsqrtf(fmaxf(sq * (1.0f / 1024.0f) - mu * mu, 0.f) + LN_EPS);
        }
        {
            bf16_t* ye = p.yext + (size_t)(m0 + wid * 32 + r32) * 32 + hh * 16;
            const u32x4 z4 = {0u, 0u, 0u, 0u};
            u32x4 c0 = z4; if (hh == 0) c0[0] = pack2(-mu, __builtin_amdgcn_rcpf(rstd));
            *(u32x4*)(ye) = c0; *(u32x4*)(ye + 8) = z4;
        }
        f32x16 S[8];
        if (pre) { if (has_next) route_gemm<true, true>(p, smem, m0, h, S, nm0, nh, sp); else route_gemm<true, false>(p, smem, m0, h, S, nm0, nh, sp); }
        else     { if (has_next) route_gemm<false, true>(p, smem, m0, h, S, nm0, nh, sp); else route_gemm<false, false>(p, smem, m0, h, S, nm0, nh, sp); }
        int K0[16], K1[16];
        route_topk(S, 0, hh, K0);
        route_topk(S, 1, hh, K1);
        pre = has_next;
#pragma unroll
        for (int i = 0; i < 16; ++i) KL[r32 * 33 + hh * 16 + i] = K0[i] ^ ((K0[i] ^ K1[i]) & hmask);
        float s1[16], s2[16];
#pragma unroll
        for (int i = 0; i < 16; ++i) { s1[i] = key2f(K0[i] & ~0x7F); s2[i] = key2f(K1[i] & ~0x7F); }
        int c[4][16];
#pragma unroll
        for (int i = 0; i < 16; ++i)
#pragma unroll
            for (int j = 0; j < 16; ++j)
                if ((i + 1) * (j + 1) <= 16) {
                    constexpr int OFFS[16] = {0, 16, 24, 29, 33, 36, 38, 40, 42, 43, 44, 45, 46, 47, 48, 49};
                    const int q = OFFS[i] + j;
                    c[q >> 4][q & 15] = (f2key(s1[i] + s2[j]) & ~0xFF) | (255 - (i * 16 + j));
                }
#pragma unroll
        for (int qq = 50; qq < 64; ++qq) c[qq >> 4][qq & 15] = (int)0x80000000;
        top16_of_64(c);
        const float mx = key2f(c[0][0] & ~0xFF);
        float e[16]; float den = 0.f;
#pragma unroll
        for (int i = 0; i < 16; ++i) { e[i] = __expf(rstd * (key2f(c[0][i] & ~0xFF) - mx)); den += e[i]; }
        const float inv = __builtin_amdgcn_rcpf(den);
        const size_t ob = (size_t)(m0 + wid * 32 + r32) * 128 + h * 16 + hh * 8;
        int idv[8]; float gv[8];
#pragma unroll
        for (int qq = 0; qq < 8; ++qq) {
            const int F = c[0][qq] ^ ((c[0][qq] ^ c[0][8 + qq]) & hmask);
            gv[qq] = __int_as_float(__float_as_int(e[qq]) ^ ((__float_as_int(e[qq]) ^ __float_as_int(e[8 + qq])) & hmask)) * inv;
            const int idx = 255 - (F & 0xFF);
            const int k0 = KL[r32 * 33 + (idx >> 4)], k1 = KL[r32 * 33 + 16 + (idx & 15)];
            idv[qq] = (127 - (k0 & 0x7F)) * 128 + (127 - (k1 & 0x7F));
        }
        *(int4*)(p.ids + ob) = make_int4(idv[0], idv[1], idv[2], idv[3]);
        *(int4*)(p.ids + ob + 4) = make_int4(idv[4], idv[5], idv[6], idv[7]);
        *(float4*)(p.gates + ob) = make_float4(gv[0], gv[1], gv[2], gv[3]);
        *(float4*)(p.gates + ob + 4) = make_float4(gv[4], gv[5], gv[6], gv[7]);
    }
}

__device__ __forceinline__ f32x2 row_dot(const u32x4 w, const f32x2 (&x)[8], f32x2 acc) {
#pragma unroll
    for (int k = 0; k < 4; ++k) {
        acc = __builtin_amdgcn_cvt_pk_f32_fp8(w[k], false) * x[2 * k] + acc;
        acc = __builtin_amdgcn_cvt_pk_f32_fp8(w[k], true) * x[2 * k + 1] + acc;
    }
    return acc;
}
__device__ __forceinline__ float gelu_gate(float h, float g) { return 0.5f * h * (1.0f + erff(h * 0.70710678118654752f)) * g; }

__device__ __forceinline__ void ld_ids16(const int* __restrict__ q, int (&idv)[16]) {
    const int4* idp = (const int4*)q;
#pragma unroll
    for (int k = 0; k < 4; ++k) { const int4 v = idp[k]; idv[4 * k] = v.x; idv[4 * k + 1] = v.y; idv[4 * k + 2] = v.z; idv[4 * k + 3] = v.w; }
}
__device__ __forceinline__ void ld_f16(const float* __restrict__ q, float (&a)[16]) {
    const f32x4* ap = (const f32x4*)q;
#pragma unroll
    for (int k = 0; k < 4; ++k) { const f32x4 v = ap[k]; a[4 * k] = v[0]; a[4 * k + 1] = v[1]; a[4 * k + 2] = v[2]; a[4 * k + 3] = v[3]; }
}
__device__ void ph_peer_u(const Params& p, unsigned char* smem, const int vb) {
    const int lane = threadIdx.x & 63, wid = __builtin_amdgcn_readfirstlane(threadIdx.x >> 6);
    const int q = lane >> 3, c = lane & 7, j = lane & 15, kb = lane >> 4;
    const int nlb = gridDim.x >> 3, s = vb / nlb, lb = vb - s * nlb;
    const int stride = nlb * 4, t0 = lb * 4 + wid;
    const int ntok = (T_TOK - t0 + stride - 1) / stride;
    if (ntok <= 0) return;
    LDS_AS unsigned char* wb = (LDS_AS unsigned char*)smem + wid * 18432;
    LDS_AS unsigned char* ring = wb + 16384;
    const unsigned char* ubase = p.u8 + (size_t)s * (16384 * 128) + ((c ^ q) * 16);
    const unsigned char* ubase1 = p.u8 + (size_t)s * (16384 * 128) + ((c ^ q ^ 1) * 16);
    const unsigned char* rsrc; unsigned rstr;
    if (lane < 32) { rsrc = (const unsigned char*)p.ids + lane * 16; rstr = 512; }
    else if (lane < 48) { rsrc = (const unsigned char*)p.y1b + s * 256 + (lane - 32) * 16; rstr = 2048; }
    else { rsrc = (const unsigned char*)p.stats + ((2 * s + 1) >> 2) * 16; rstr = 64; }
#define PM_TOK(n) (t0 + ((n) < ntok ? (n) : ntok - 1) * stride)
#define PM_RING(n) do { if (lane < 49) __builtin_amdgcn_global_load_lds((const unsigned*)(rsrc + (size_t)PM_TOK(n) * rstr), (LDS_AS unsigned*)(ring + ((n) & 1) * 1024), 16, 0, 0); } while (0)
#define PM_IDS(n, ia, ib) do { const LDS_AS u32x4* _q = (const LDS_AS u32x4*)(ring + ((n) & 1) * 1024 + q * 32); \
        const u32x4 _a0 = _q[0], _a1 = _q[1], _b0 = _q[16], _b1 = _q[17]; \
        ia[0] = _a0[0]; ia[1] = _a0[1]; ia[2] = _a0[2]; ia[3] = _a0[3]; ia[4] = _a1[0]; ia[5] = _a1[1]; ia[6] = _a1[2]; ia[7] = _a1[3]; \
        ib[0] = _b0[0]; ib[1] = _b0[1]; ib[2] = _b0[2]; ib[3] = _b0[3]; ib[4] = _b1[0]; ib[5] = _b1[1]; ib[6] = _b1[2]; ib[7] = _b1[3]; } while (0)
#define PM_DMA(i, id) __builtin_amdgcn_global_load_lds((const unsigned*)((((i) & 1) ? ubase1 : ubase) + (size_t)(id) * 128), (LDS_AS unsigned*)(wb + (i) * 1024), 16, 0, 0)
    const int key = (j & 7) ^ (j >> 3);
    const LDS_AS unsigned char* brd = wb + j * 128 + (((2 * kb) ^ key) * 16);
    const int bx1 = (key & 1) ? -16 : 16;
    const LDS_AS unsigned char* ard = ring + (j & 1) * 1024 + 832 + kb * 32;
    PM_RING(0); PM_RING(1);
    asm volatile("s_waitcnt vmcnt(0)" ::: "memory");
    {
        unsigned ia[8], ib[8]; PM_IDS(0, ia, ib);
#pragma unroll
        for (int m = 0; m < 4; ++m) { PM_DMA(2 * m, ia[m]); PM_DMA(2 * m + 1, ib[m]); }
#pragma unroll
        for (int m = 4; m < 8; ++m) { PM_DMA(2 * m, ia[m]); PM_DMA(2 * m + 1, ib[m]); }
    }
    const int sqi = ((2 * s + 1) & 3) * 4;
#pragma unroll 1
    for (int n = 0; n < ntok; ++n) {
        const int t = t0 + n * stride;
        LDS_AS unsigned char* slot = ring + (n & 1) * 1024;
        const unsigned xw = *(const LDS_AS unsigned*)(slot + 512 + lane * 4);
        const float ssq = *(const LDS_AS float*)(slot + 768 + sqi);
        const int e2 = (int)(__float_as_uint(ssq) >> 23) - 126;
        int eh = (e2 + 1) >> 1; eh = eh < -60 ? -60 : (eh > 60 ? 60 : eh);
        const float sc = __uint_as_float((unsigned)(127 + 8 - eh) << 23), isc = __uint_as_float((unsigned)(127 - 8 + eh) << 23);
        const float x0 = bflo(xw) * sc, x1 = bfhi(xw) * sc;
        const unsigned h8 = (unsigned)__builtin_amdgcn_cvt_pk_fp8_f32(x0, x1, 0, false);
        const f32x2 hd = __builtin_amdgcn_cvt_pk_f32_fp8((int)h8, false);
        const unsigned l8 = (unsigned)__builtin_amdgcn_cvt_pk_fp8_f32(x0 - hd.x, x1 - hd.y, 0, false);
        *(LDS_AS unsigned short*)(ring + 832 + lane * 2) = (unsigned short)h8;
        *(LDS_AS unsigned short*)(ring + 1024 + 832 + lane * 2) = (unsigned short)l8;
        const u32x4 xa0 = *(const LDS_AS u32x4*)(ard), xa1 = *(const LDS_AS u32x4*)(ard + 16);
        i64 xa[4];
        xa[0] = (i64)(((unsigned long long)xa0[1] << 32) | xa0[0]); xa[1] = (i64)(((unsigned long long)xa0[3] << 32) | xa0[2]);
        xa[2] = (i64)(((unsigned long long)xa1[1] << 32) | xa1[0]); xa[3] = (i64)(((unsigned long long)xa1[3] << 32) | xa1[2]);
        f32x4 acc[8];
        asm volatile("s_waitcnt vmcnt(8)" ::: "memory");
#pragma unroll
        for (int m = 0; m < 4; ++m) {
            const u32x4 b0 = *(const LDS_AS u32x4*)(brd + m * 2048), b1 = *(const LDS_AS u32x4*)(brd + m * 2048 + bx1);
            f32x4 a = {0.f, 0.f, 0.f, 0.f};
            a = __builtin_amdgcn_mfma_f32_16x16x32_fp8_fp8(xa[0], (i64)(((unsigned long long)b0[1] << 32) | b0[0]), a, 0, 0, 0);
            a = __builtin_amdgcn_mfma_f32_16x16x32_fp8_fp8(xa[1], (i64)(((unsigned long long)b0[3] << 32) | b0[2]), a, 0, 0, 0);
            a = __builtin_amdgcn_mfma_f32_16x16x32_fp8_fp8(xa[2], (i64)(((unsigned long long)b1[1] << 32) | b1[0]), a, 0, 0, 0);
            a = __builtin_amdgcn_mfma_f32_16x16x32_fp8_fp8(xa[3], (i64)(((unsigned long long)b1[3] << 32) | b1[2]), a, 0, 0, 0);
            acc[m] = a;
        }
        {
            unsigned ia[8], ib[8]; PM_IDS(n + 1, ia, ib);
            PM_RING(n + 2);
#pragma unroll
            for (int m = 0; m < 4; ++m) { PM_DMA(2 * m, ia[m]); PM_DMA(2 * m + 1, ib[m]); }
            asm volatile("s_waitcnt vmcnt(9)" ::: "memory");
#pragma unroll
            for (int m = 4; m < 8; ++m) {
                const u32x4 b0 = *(const LDS_AS u32x4*)(brd + m * 2048), b1 = *(const LDS_AS u32x4*)(brd + m * 2048 + bx1);
                f32x4 a = {0.f, 0.f, 0.f, 0.f};
                a = __builtin_amdgcn_mfma_f32_16x16x32_fp8_fp8(xa[0], (i64)(((unsigned long long)b0[1] << 32) | b0[0]), a, 0, 0, 0);
                a = __builtin_amdgcn_mfma_f32_16x16x32_fp8_fp8(xa[1], (i64)(((unsigned long long)b0[3] << 32) | b0[2]), a, 0, 0, 0);
                a = __builtin_amdgcn_mfma_f32_16x16x32_fp8_fp8(xa[2], (i64)(((unsigned long long)b1[1] << 32) | b1[0]), a, 0, 0, 0);
                a = __builtin_amdgcn_mfma_f32_16x16x32_fp8_fp8(xa[3], (i64)(((unsigned long long)b1[3] << 32) | b1[2]), a, 0, 0, 0);
                acc[m] = a;
            }
#pragma unroll
            for (int m = 4; m < 8; ++m) { PM_DMA(2 * m, ia[m]); PM_DMA(2 * m + 1, ib[m]); }
        }
        if (lane < 16) {
            u32x4 o;
#pragma unroll
            for (int k = 0; k < 4; ++k) o[k] = pack2((acc[2 * k][0] + acc[2 * k][1]) * isc, (acc[2 * k + 1][0] + acc[2 * k + 1][1]) * isc);
            *(u32x4*)(p.hp + ((size_t)t * 8 + s) * 128 + lane * 8) = o;
        }
    }
    asm volatile("s_waitcnt vmcnt(0)" ::: "memory");
}
__device__ void ph_peer_act(const Params& p, unsigned char* smem, const int vb) {
    const int lane = threadIdx.x & 63, wid = threadIdx.x >> 6;
    unsigned* lsc = (unsigned*)smem;
    LDS_AS unsigned char* img = (LDS_AS unsigned char*)smem + 65536 + wid * 256;
    __syncthreads();
    for (int i = threadIdx.x; i < 16384 / 4; i += 256) *(u32x4*)(lsc + 4 * i) = *(const u32x4*)((const unsigned*)p.sc2 + 4 * i);
    __syncthreads();
    const int e0 = 2 * lane, e1 = e0 + 1;
    const int ix0 = (e0 & 3) * 32 + ((e0 >> 2) & 3) * 8 + (e0 >> 4), ix1 = (e1 & 3) * 32 + ((e1 >> 2) & 3) * 8 + (e1 >> 4);
    for (int t = vb * 4 + wid; t < T_TOK; t += gridDim.x * 4) {
        f32x2 h = {0.f, 0.f};
#pragma unroll
        for (int s = 0; s < 8; ++s) { const unsigned w = *(const unsigned*)(p.hp + ((size_t)t * 8 + s) * 128 + 2 * lane); h += (f32x2){bflo(w), bfhi(w)}; }
        f32x2 pq = *(const f32x2*)(p.stats + (size_t)t * 16 + (lane & 7) * 2);
        pq.x += __shfl_xor(pq.x, 1); pq.y += __shfl_xor(pq.y, 1); pq.x += __shfl_xor(pq.x, 2); pq.y += __shfl_xor(pq.y, 2); pq.x += __shfl_xor(pq.x, 4); pq.y += __shfl_xor(pq.y, 4);
        const float mu = pq.x * (1.0f / 1024.0f), rstd = rsqrtf(fmaxf(pq.y * (1.0f / 1024.0f) - mu * mu, 0.f) + LN_EPS);
        int2 id = *(const int2*)(p.ids + (size_t)t * 128 + 2 * lane);
        id.x &= 0x3fff; id.y &= 0x3fff;
        const f32x2 gt = *(const f32x2*)(p.gates + (size_t)t * 128 + 2 * lane);
        const unsigned s0 = lsc[id.x], s1 = lsc[id.y];
        const unsigned c0 = p.cb2[id.x], c1 = p.cb2[id.y];
        f32x2 a;
        a.x = gelu_gate(rstd * (h.x * bflo(s0) - mu * bflo(c0)) + bfhi(c0), gt.x) * bfhi(s0);
        a.y = gelu_gate(rstd * (h.y * bflo(s1) - mu * bflo(c1)) + bfhi(c1), gt.y) * bfhi(s1);
        float am = fmaxf(fabsf(a.x), fabsf(a.y));
#pragma unroll
        for (int o = 32; o >= 1; o >>= 1) am = fmaxf(am, __shfl_xor(am, o));
        int be = (int)(__float_as_uint(am) >> 23); be = be < 20 ? 20 : (be > 240 ? 240 : be);
        const float sc = __uint_as_float((unsigned)(261 - be) << 23);
        const unsigned iscb = (unsigned)(be - 7) << 23;
        const float x0 = a.x * sc, x1 = a.y * sc;
        const unsigned h8 = (unsigned)__builtin_amdgcn_cvt_pk_fp8_f32(x0, x1, 0, false);
        const f32x2 hd = __builtin_amdgcn_cvt_pk_f32_fp8((int)h8, false);
        const unsigned l8 = (unsigned)__builtin_amdgcn_cvt_pk_fp8_f32(x0 - hd.x, x1 - hd.y, 0, false);
        img[ix0] = (unsigned char)h8; img[ix1] = (unsigned char)(h8 >> 8);
        img[128 + ix0] = (unsigned char)l8; img[128 + ix1] = (unsigned char)(l8 >> 8);
        const unsigned iw = *(const LDS_AS unsigned*)(img + lane * 4);
        *(unsigned*)((unsigned char*)p.gates + (size_t)t * 512 + lane * 4) = iw;
        if (lane < 3) {
            const unsigned pb = lane == 0 ? __float_as_uint(mu) : (lane == 1 ? __float_as_uint(rstd) : iscb);
            *(int2*)(p.ids + (size_t)t * 128 + 2 * lane) = make_int2(id.x | (int)(pb & 0xffff0000u), id.y | (int)(pb << 16));
        }
    }
}
typedef int v2i32 __attribute__((ext_vector_type(2)));
__device__ void ph_peer_v(const Params& p, unsigned char* smem, const int vb) {
    const int lane = threadIdx.x & 63, wid = __builtin_amdgcn_readfirstlane(threadIdx.x >> 6);
    const int q = lane >> 3, c = lane & 7, j = lane & 15, kb = lane >> 4;
    const int nlb = gridDim.x >> 3, s = vb / nlb, lb = vb - s * nlb;
    const int stride = nlb * 4, t0 = lb * 4 + wid;
    const int ntok = (T_TOK - t0 + stride - 1) / stride;
    if (ntok <= 0) return;
    LDS_AS unsigned char* wb = (LDS_AS unsigned char*)smem + wid * 18432;
    LDS_AS unsigned char* ring = wb + 16384;
    const unsigned char* vbase = p.v8 + (size_t)s * (16384 * 128) + ((c ^ q) * 16);
    const unsigned char* vbase1 = p.v8 + (size_t)s * (16384 * 128) + ((c ^ q ^ 1) * 16);
    const unsigned char* rsrc; unsigned rstr;
    if (lane < 32) { rsrc = (const unsigned char*)p.ids + lane * 16; rstr = 512; }
    else if (lane < 48) { rsrc = (const unsigned char*)p.gates + (lane - 32) * 16; rstr = 512; }
    else { rsrc = (const unsigned char*)p.y1b + s * 256 + (lane - 48) * 16; rstr = 2048; }
#define PV_RING(n) __builtin_amdgcn_global_load_lds((const unsigned*)(rsrc + (size_t)PM_TOK(n) * rstr), (LDS_AS unsigned*)(ring + ((n) & 1) * 1024), 16, 0, 0)
#define PV_IDS(n, idv) do { const LDS_AS u32x4* _q = (const LDS_AS u32x4*)(ring + ((n) & 1) * 1024 + q * 64); \
        _Pragma("unroll") for (int _k = 0; _k < 4; ++_k) { const u32x4 _v = _q[_k]; idv[4 * _k] = _v[0] & 0x3fffu; idv[4 * _k + 1] = _v[1] & 0x3fffu; idv[4 * _k + 2] = _v[2] & 0x3fffu; idv[4 * _k + 3] = _v[3] & 0x3fffu; } } while (0)
#define PV_DMA(i, id) __builtin_amdgcn_global_load_lds((const unsigned*)((((i) & 1) ? vbase1 : vbase) + (size_t)(id) * 128), (LDS_AS unsigned*)(wb + (i) * 1024), 16, 0, 0)
    const int key = (j >> 1) ^ (kb & 1);
    const LDS_AS unsigned char* tb = wb + (8 * kb + (j >> 1)) * 128 + (j & 1) * 8;
    const LDS_AS unsigned char* ard = ring + 512 + (j & 1) * 128 + kb * 32;
    const int dl = 32 * kb + (j & 1) * 16 + (j & 14), d0 = s * 128 + dl;
    const f32x2 g2 = *(const f32x2*)(p.ln1_g + d0), b2 = *(const f32x2*)(p.ln1_b + d0);
    PV_RING(0); PV_RING(1);
    asm volatile("s_waitcnt vmcnt(0)" ::: "memory");
    {
        unsigned idv[16]; PV_IDS(0, idv);
#pragma unroll
        for (int i = 0; i < 16; ++i) PV_DMA(i, idv[i]);
    }
#pragma unroll 1
    for (int n = 0; n < ntok; ++n) {
        const int t = t0 + n * stride;
        const LDS_AS unsigned char* slot = ring + (n & 1) * 1024;
        const u32x4 xa0 = *(const LDS_AS u32x4*)(ard + (n & 1) * 1024), xa1 = *(const LDS_AS u32x4*)(ard + (n & 1) * 1024 + 16);
        const u32x4 hd4 = *(const LDS_AS u32x4*)(slot);
        const unsigned hd5 = *(const LDS_AS unsigned*)(slot + 16);
        const unsigned yw = *(const LDS_AS unsigned*)(slot + 768 + dl * 2);
        i64 xa[4];
        xa[0] = (i64)(((unsigned long long)xa0[1] << 32) | xa0[0]); xa[1] = (i64)(((unsigned long long)xa0[3] << 32) | xa0[2]);
        xa[2] = (i64)(((unsigned long long)xa1[1] << 32) | xa1[0]); xa[3] = (i64)(((unsigned long long)xa1[3] << 32) | xa1[2]);
        const float mu = __uint_as_float((hd4[0] & 0xffff0000u) | (hd4[1] >> 16)), rs = __uint_as_float((hd4[2] & 0xffff0000u) | (hd4[3] >> 16));
        const float isc = __uint_as_float(hd5 & 0xffff0000u);
        f32x4 acc[8];
#pragma unroll
        for (int ct = 0; ct < 8; ++ct) acc[ct] = (f32x4){0.f, 0.f, 0.f, 0.f};
        asm volatile("s_waitcnt vmcnt(8)" ::: "memory");
#pragma unroll
        for (int ks = 0; ks < 2; ++ks)
#pragma unroll
            for (int ct = 0; ct < 8; ++ct) {
                const v2i32 bv = __builtin_amdgcn_ds_read_tr8_b64_v2i32((LDS_AS v2i32*)(tb + ks * 4096 + ((ct ^ key) << 4)));
                acc[ct] = __builtin_amdgcn_mfma_f32_16x16x32_fp8_fp8(xa[ks], (i64)(((unsigned long long)(unsigned)bv[1] << 32) | (unsigned)bv[0]), acc[ct], 0, 0, 0);
            }
        {
            unsigned idv[16]; PV_IDS(n + 1, idv);
            PV_RING(n + 2);
#pragma unroll
            for (int i = 0; i < 8; ++i) PV_DMA(i, idv[i]);
            asm volatile("s_waitcnt vmcnt(9)" ::: "memory");
#pragma unroll
            for (int ks = 2; ks < 4; ++ks)
#pragma unroll
                for (int ct = 0; ct < 8; ++ct) {
                    const v2i32 bv = __builtin_amdgcn_ds_read_tr8_b64_v2i32((LDS_AS v2i32*)(tb + ks * 4096 + ((ct ^ key) << 4)));
                    acc[ct] = __builtin_amdgcn_mfma_f32_16x16x32_fp8_fp8(xa[ks], (i64)(((unsigned long long)(unsigned)bv[1] << 32) | (unsigned)bv[0]), acc[ct], 0, 0, 0);
                }
#pragma unroll
            for (int i = 8; i < 16; ++i) PV_DMA(i, idv[i]);
        }
        float va, vc;
        {
            const float w0 = acc[0][0] + acc[0][1], w1 = acc[1][0] + acc[1][1], w2 = acc[2][0] + acc[2][1], w3 = acc[3][0] + acc[3][1];
            const float w4 = acc[4][0] + acc[4][1], w5 = acc[5][0] + acc[5][1], w6 = acc[6][0] + acc[6][1], w7 = acc[7][0] + acc[7][1];
            va = kb == 0 ? w0 : (kb == 1 ? w2 : (kb == 2 ? w4 : w6));
            vc = kb == 0 ? w1 : (kb == 1 ? w3 : (kb == 2 ? w5 : w7));
        }
        const bool od = (j & 1) != 0;
        const float got = __shfl_xor(od ? va : vc, 1);
        const float p0 = (od ? got : va) * isc, p1 = (od ? vc : got) * isc;
        const float r0 = ALPHA * ((bflo(yw) - mu) * rs * g2.x + b2.x) + p0, r1 = ALPHA * ((bfhi(yw) - mu) * rs * g2.y + b2.y) + p1;
        *(unsigned*)(p.rb + (size_t)t * DM + d0) = pack2(r0, r1);
    }
    asm volatile("s_waitcnt vmcnt(0)" ::: "memory");
}

__device__ void ph_gemm_ple(const Params& p, unsigned char* smem, const int vb) {
    const int ntn = DM / 128;
    const int tid = threadIdx.x, lane = tid & 63, wid = tid >> 6, wr = wid >> 1, wc = wid & 1, fr = lane & 15, fq = lane >> 4;
    const int ntiles = (T_TOK / 128) * ntn;
    bool pre = false;
    for (int t = vb; t < ntiles; t += gridDim.x) {
        const int m0 = (t / ntn) * 128, n0 = (t % ntn) * 128;
        const int tn = t + gridDim.x;
        const bool has_next = tn < ntiles;
        const bf16_t* nA = p.pb + (size_t)((has_next ? tn : t) / ntn) * 128 * 256;
        const bf16_t* nB = p.WpT + (size_t)((has_next ? tn : t) % ntn) * 128 * 256;
        const bf16_t* gA = p.rb + (size_t)m0 * DM; const bf16_t* gB = p.WgT + (size_t)n0 * DM;
        f32x4 acc[4][4], acc2[4][4]; zero_acc(acc); zero_acc(acc2);
        if (pre) gemm128<true, true>(p.pb + (size_t)m0 * 256, 256, p.WpT + (size_t)n0 * 256, 256, 256, smem, acc2, gA, DM, gB, DM);
        else     gemm128<false, true>(p.pb + (size_t)m0 * 256, 256, p.WpT + (size_t)n0 * 256, 256, 256, smem, acc2, gA, DM, gB, DM);
        if (has_next) gemm128<true, true>(gA, DM, gB, DM, DM, smem, acc, nA, 256, nB, 256);
        else          gemm128<true, false>(gA, DM, gB, DM, DM, smem, acc);
        pre = has_next;
#pragma unroll
        for (int mi = 0; mi < 4; ++mi) {
            const int row = m0 + wr * 64 + mi * 16 + fr;
#pragma unroll
            for (int ni = 0; ni < 4; ++ni) {
                const int col = n0 + wc * 64 + ni * 16 + fq * 4;
                const u32x2 rw = *(const u32x2*)(p.rb + (size_t)row * DM + col);
                f32x4 rv = {bflo(rw[0]), bfhi(rw[0]), bflo(rw[1]), bfhi(rw[1])};
#pragma unroll
                for (int r = 0; r < 4; ++r) rv[r] += sigmul(acc2[mi][ni][r], acc[mi][ni][r]);
                *(f32x4*)(p.out + (size_t)row * DM + col) = rv;
            }
        }
    }
}

#define XB_TMO      128
#define XB_XCNT(j)  (256  + 64 * (j))
#define XB_XSUB(j)  (1280 + 64 * (j))
#define XB_XGEN(j)  (2304 + 64 * (j))
#define XB_TOP      3328
#define XB_TOPGEN   3392
#define XCD_BAR_WORDS 3456
#define XB_SPIN_CAP (1u << 20)
__device__ __forceinline__ unsigned xb_ld(unsigned* p)              { return __hip_atomic_load(p, __ATOMIC_RELAXED, __HIP_MEMORY_SCOPE_AGENT); }
__device__ __forceinline__ unsigned xb_add(unsigned* p, unsigned v) { return __hip_atomic_fetch_add(p, v, __ATOMIC_RELAXED, __HIP_MEMORY_SCOPE_AGENT); }
__device__ __forceinline__ unsigned xb_xcc_id() { return (unsigned)__builtin_amdgcn_s_getreg((3 << 11) | 20) & 0xFu; }
#define XB_SPIN(cond, bar) do { unsigned _sp = 0; while (cond) { __builtin_amdgcn_s_sleep(1); \
    if ((++_sp & 255u) == 0u) { if (xb_ld(&(bar)[XB_TMO])) break; if (_sp > XB_SPIN_CAP) { atomicAdd(&(bar)[XB_TMO], 1u); break; } } } } while (0)
struct XcdBarrier { unsigned* bar; unsigned x; volatile LDS_AS unsigned* st; };
__device__ __forceinline__ XcdBarrier xcd_barrier_post(unsigned* bar, volatile LDS_AS unsigned* st) {
    XcdBarrier b; b.bar = bar; b.x = xb_xcc_id(); b.st = st;
    if (threadIdx.x == 0) st[3] = xb_add(&bar[XB_XCNT(b.x)], 1u);
    return b;
}
__device__ __forceinline__ void xcd_barrier_complete(unsigned* bar, unsigned x, unsigned rank, unsigned& nloc, unsigned& nx, unsigned& vb) {
    const unsigned G = gridDim.x;
    unsigned sum, cnt, mine, sp = 0u; bool even;
    for (;;) {
        sum = 0u; cnt = 0u; mine = 0u; even = true;
#pragma unroll
        for (unsigned j = 0; j < 16; ++j) {
            const unsigned c = xb_ld(&bar[XB_XCNT(j)]); sum += c; cnt += (c > 0u) ? 1u : 0u; mine = (j == x) ? c : mine;
            even = even && (c == ((j < 8u) ? (G >> 3) : 0u));
        }
        if (sum == G) break;
        __builtin_amdgcn_s_sleep(1);
        if ((++sp & 255u) == 0u) { if (xb_ld(&bar[XB_TMO])) break; if (sp > XB_SPIN_CAP) { atomicAdd(&bar[XB_TMO], 1u); break; } }
    }
    nloc = mine > 0u ? mine : 1u; nx = cnt > 0u ? cnt : 1u;
    vb = (even && sum == G && (G & 7u) == 0u) ? (x * (G >> 3) + rank) : blockIdx.x;
}
__device__ __forceinline__ void xcd_barrier(const XcdBarrier& b) {
    asm volatile("s_waitcnt vmcnt(0)" ::: "memory");
    __syncthreads();
    if (threadIdx.x == 0) {
        unsigned* bar = b.bar;
        __builtin_amdgcn_s_waitcnt(0);
        unsigned nloc = b.st[0], nx = b.st[1];
        if (nloc == 0u) { unsigned vb; xcd_barrier_complete(bar, b.x, b.st[3], nloc, nx, vb); b.st[0] = nloc; b.st[1] = nx; b.st[2] = vb; }
        const unsigned old = xb_add(&bar[XB_XSUB(b.x)], 1u);
        const unsigned gen = old / nloc;
        if (old + 1u == (gen + 1u) * nloc) {
            __builtin_amdgcn_fence(__ATOMIC_RELEASE, "agent");
            asm volatile("s_waitcnt vmcnt(0)" ::: "memory");
            const unsigned og = xb_add(&bar[XB_TOP], 1u);
            const unsigned tg = og / nx;
            if (og + 1u == (tg + 1u) * nx) xb_add(&bar[XB_TOPGEN], 1u);
            else XB_SPIN(xb_ld(&bar[XB_TOPGEN]) == tg, bar);
            __builtin_amdgcn_fence(__ATOMIC_ACQUIRE, "agent");
            xb_add(&bar[XB_XGEN(b.x)], 1u);
            asm volatile("s_waitcnt vmcnt(0)" ::: "memory");
        } else {
            XB_SPIN(xb_ld(&bar[XB_XGEN(b.x)]) == gen, bar);
            __builtin_amdgcn_fence(__ATOMIC_ACQUIRE, "agent");
            asm volatile("s_waitcnt vmcnt(0)" ::: "memory");
        }
    }
    __syncthreads();
}

#define SMEM_PHASE (256 * ASTR * 2 * 2)
#define SMEM_BYTES (SMEM_PHASE + 16)
__global__ void __launch_bounds__(256, 2) mega(Params p) {
    __shared__ __attribute__((aligned(16))) unsigned char smem[SMEM_BYTES];
    volatile LDS_AS unsigned* st = (volatile LDS_AS unsigned*)(LDS_AS unsigned char*)(smem + SMEM_PHASE);
    if (threadIdx.x < 4) st[threadIdx.x] = 0u;
    __syncthreads();
    const XcdBarrier gb = xcd_barrier_post(p.bar, st);
    ph_prep(p, smem);            xcd_barrier(gb);
    const int vb = (int)st[2];
    ph_gemm_in(p, smem, vb);     xcd_barrier(gb);
    ph_attn(p, smem, vb);
    ph_conv(p, smem, vb);        xcd_barrier(gb);
    ph_mprep(p, smem, vb);
    ph_gemm_out(p, smem, vb);    xcd_barrier(gb);
    ph_route(p, smem, vb);       xcd_barrier(gb);
    ph_peer_u(p, smem, vb);      xcd_barrier(gb);
    ph_peer_act(p, smem, vb);    xcd_barrier(gb);
    ph_peer_v(p, smem, vb);      xcd_barrier(gb);
    ph_gemm_ple(p, smem, vb);    xcd_barrier(gb);
    ph_ln2(p, vb);
}

extern "C" void kernel_launch(void* const* d_in, const int* in_sizes, int n_in, void* d_out, int out_size, void* d_ws, size_t ws_size,
                              hipStream_t stream) {
    Params p{};
    p.x = (const float*)d_in[0]; p.p = (const float*)d_in[1]; p.pos = (const int*)d_in[2];
    p.w_in = (const float*)d_in[3]; p.sinks = (const float*)d_in[4]; p.conv_w = (const float*)d_in[5]; p.conv_b = (const float*)d_in[6];
    p.cln_g = (const float*)d_in[7]; p.cln_b = (const float*)d_in[8]; p.w_out = (const float*)d_in[9]; p.ln1_g = (const float*)d_in[10];
    p.ln1_b = (const float*)d_in[11]; p.wq = (const float*)d_in[12]; p.keys = (const float*)d_in[13]; p.pu = (const float*)d_in[14];
    p.pv = (const float*)d_in[15]; p.ple_proj = (const float*)d_in[16]; p.ple_gate = (const float*)d_in[17]; p.ln2_g = (const float*)d_in[18];
    p.ln2_b = (const float*)d_in[19];
    p.out = (float*)d_out;
    unsigned char* ws = (unsigned char*)d_ws;
    const size_t MiB = 1024 * 1024;
    p.y1 = (float*)(ws + 0 * MiB);
    p.hb = (bf16_t*)(ws + 128 * MiB);
    p.hp = (bf16_t*)(ws + 128 * MiB);
    p.xb = (bf16_t*)(ws + 256 * MiB);
    p.mixb = (bf16_t*)(ws + 320 * MiB);
    p.rb = (bf16_t*)(ws + 320 * MiB);
    p.pb = (bf16_t*)(ws + 384 * MiB);
    p.u8 = (unsigned char*)(ws + 400 * MiB);
    p.v8 = (unsigned char*)(ws + 416 * MiB);
    p.sc2 = (bf16_t*)(ws + 432 * MiB);
    p.rope = (float*)(ws + 434 * MiB);
    p.stats = (float*)(ws + 436 * MiB);
    p.cb2 = (unsigned*)(ws + 438 * MiB);
    p.mext = (bf16_t*)(ws + 440 * MiB);
    p.yext = (bf16_t*)(ws + 442 * MiB);
    p.y1b = (bf16_t*)(ws + 0 * MiB);
    p.ids = (int*)(ws + 464 * MiB);
    p.gates = (float*)(ws + 480 * MiB);
    unsigned char* wb = ws + 496 * MiB;
    p.WinT = (bf16_t*)wb; wb += (size_t)INW * DM * 2;
    p.WoutT = (bf16_t*)wb; wb += (size_t)DM * DM * 2;
    p.WgT = (bf16_t*)wb; wb += (size_t)DM * DM * 2;
    p.WpT = (bf16_t*)wb; wb += (size_t)DM * 256 * 2;
    p.keysb = (bf16_t*)wb; wb += (size_t)16 * 128 * 128 * 2;
    p.Wqb = (bf16_t*)(ws + 240 * MiB);
    p.MT = (bf16_t*)(ws + 244 * MiB);
    p.bar = (unsigned*)(ws + 510 * MiB);
    p.wgb = (float*)(p.bar + XCD_BAR_WORDS + 640);

    static int grid_blocks = 0;
    if (!grid_blocks) {
        int dev = 0, cus = 0, per_cu = 0;
        (void)hipGetDevice(&dev);
        (void)hipDeviceGetAttribute(&cus, hipDeviceAttributeMultiprocessorCount, dev);
        (void)hipOccupancyMaxActiveBlocksPerMultiprocessor(&per_cu, mega, 256, 0);
        if (per_cu > 2) per_cu = 2;
        grid_blocks = cus * per_cu;
    }
    (void)hipMemsetAsync(p.bar, 0, (XCD_BAR_WORDS + 640 + 4096) * sizeof(unsigned), stream);
    void* args[] = {&p};
    hipError_t e = hipLaunchCooperativeKernel((void*)mega, dim3(grid_blocks), dim3(256), args, 0, stream);
    if (e != hipSuccess) fprintf(stderr, "cooperative launch failed: %s (grid %d)\n", hipGetErrorString(e), grid_blocks);
}
```

```cpp
#include <hip/hip_runtime.h>
#include <stdint.h>
#include <cstdio>

typedef unsigned short bf16_t;
typedef short bf16x8 __attribute__((ext_vector_type(8)));
typedef float f32x4 __attribute__((ext_vector_type(4)));
typedef unsigned u32x4 __attribute__((ext_vector_type(4)));
typedef float f32x2 __attribute__((ext_vector_type(2)));
typedef long i64;

#define T_TOK 32768
#define SEQ 2048
#define DM 1024
#define INW 1792
#define ALPHA 1.189207115002721f
#define LN_EPS 1e-5f

__device__ __forceinline__ bf16_t f2bf(float f) {
    unsigned u = __float_as_uint(f);
    u += 0x7fffu + ((u >> 16) & 1u);
    return (bf16_t)(u >> 16);
}
__device__ __forceinline__ float bf2f(bf16_t b) { return __uint_as_float(((unsigned)b) << 16); }
__device__ __forceinline__ float bflo(unsigned w) { return __uint_as_float(w << 16); }
__device__ __forceinline__ float bfhi(unsigned w) { return __uint_as_float(w & 0xffff0000u); }
__device__ __forceinline__ unsigned pack2(float a, float b) { return (unsigned)f2bf(a) | ((unsigned)f2bf(b) << 16); }

__device__ __forceinline__ float sigmul(float x, float g) { return x * __builtin_amdgcn_rcpf(1.0f + __expf(-g)); }
__device__ __forceinline__ float wave_sum(float v) {
#pragma unroll
    for (int o = 32; o >= 1; o >>= 1) v += __shfl_xor(v, o);
    return v;
}

struct Params {
    const float *x, *p; const int* pos;
    const float *w_in, *sinks, *conv_w, *conv_b, *cln_g, *cln_b, *w_out, *ln1_g, *ln1_b;
    const float *wq, *keys, *pu, *pv, *ple_proj, *ple_gate, *ln2_g, *ln2_b;
    float* out;
    bf16_t *xb, *pb, *WinT, *WoutT, *WgT, *WpT, *keysb, *Wqb, *MT, *hb, *mixb, *rb;
    float *y1, *gates, *rope, *stats, *wgb;
    bf16_t *y1b, *yext, *mext; unsigned* cb2;
    bf16_t* sc2;
    bf16_t* hp;
    int *ids;
    unsigned char *u8, *v8;
    unsigned* bar;
};

__device__ void cvt_rows(const float* __restrict__ src, bf16_t* __restrict__ dst, size_t n) {
    const size_t nv = n / 8, gs = (size_t)gridDim.x * blockDim.x;
    for (size_t i = (size_t)blockIdx.x * blockDim.x + threadIdx.x; i < nv; i += 4 * gs) {
        f32x4 a[4], b[4];
#pragma unroll
        for (int q = 0; q < 4; ++q) { const size_t k = (i + q * gs < nv) ? i + q * gs : i; a[q] = ((const f32x4*)src)[2 * k]; b[q] = ((const f32x4*)src)[2 * k + 1]; }
#pragma unroll
        for (int q = 0; q < 4; ++q) {
            if (i + q * gs < nv) {
                u32x4 o; o[0] = pack2(a[q][0], a[q][1]); o[1] = pack2(a[q][2], a[q][3]); o[2] = pack2(b[q][0], b[q][1]); o[3] = pack2(b[q][2], b[q][3]);
                ((u32x4*)dst)[i + q * gs] = o;
            }
        }
    }
}
__device__ __forceinline__ int win_row(int n) {
    if (n < 768) return n;
    const int isg = n >= 1280 ? 1 : 0, c = n - (isg ? 1280 : 768);
    const int tt = c >> 6, wc = (c >> 5) & 1, k2 = (c >> 4) & 1, rest = c & 15;
    return 768 + 128 * tt + wc * 64 + (k2 * 2 + isg) * 16 + rest;
}
template <bool WIN = false>
__device__ void transpose_cvt(const float* __restrict__ W, bf16_t* __restrict__ Wt, int K, int N, float* tile  ) {
    const int tk = K / 64, tn = N / 64;
    const int tid = threadIdx.x;
    for (int t = blockIdx.x; t < tk * tn; t += gridDim.x) {
        const int k0 = (t / tn) * 64, n0 = (t % tn) * 64;
        f32x4 v[4];
#pragma unroll
        for (int i = 0; i < 4; ++i) v[i] = *(const f32x4*)(W + (size_t)(k0 + (tid >> 4) + 16 * i) * N + n0 + (tid & 15) * 4);
        __syncthreads();
#pragma unroll
        for (int i = 0; i < 4; ++i)
#pragma unroll
            for (int j = 0; j < 4; ++j) tile[((tid >> 4) + 16 * i) * 65 + (tid & 15) * 4 + j] = v[i][j];
        __syncthreads();
        const int n = tid >> 2, kc = (tid & 3) * 16;
        u32x4 o0, o1;
#pragma unroll
        for (int q = 0; q < 4; ++q) {
            o0[q] = pack2(tile[(kc + 2 * q) * 65 + n], tile[(kc + 2 * q + 1) * 65 + n]);
            o1[q] = pack2(tile[(kc + 8 + 2 * q) * 65 + n], tile[(kc + 8 + 2 * q + 1) * 65 + n]);
        }
        const int nd = WIN ? win_row(n0 + n) : n0 + n;
        *(u32x4*)(Wt + (size_t)nd * K + k0 + kc) = o0;
        *(u32x4*)(Wt + (size_t)nd * K + k0 + kc + 8) = o1;
    }
}
__device__ void cvt_wq_fold(const Params& p, unsigned char* smem) {
    for (int i = blockIdx.x * 256 + threadIdx.x; i < DM * 256; i += gridDim.x * 256) {
        const int d = i >> 8, c8 = (i & 255) * 8;
        const float gd = p.ln1_g[d];
        const f32x4 a = *(const f32x4*)(p.wq + (size_t)d * 2048 + c8), b = *(const f32x4*)(p.wq + (size_t)d * 2048 + c8 + 4);
        u32x4 o; o[0] = pack2(a[0] * gd, a[1] * gd); o[1] = pack2(a[2] * gd, a[3] * gd); o[2] = pack2(b[0] * gd, b[1] * gd); o[3] = pack2(b[2] * gd, b[3] * gd);
        *(u32x4*)(p.Wqb + (size_t)d * 2048 + c8) = o;
    }
    float* red = (float*)smem;
    const int lane = threadIdx.x & 63, wid = threadIdx.x >> 6;
    for (int cb = blockIdx.x; cb < 512; cb += gridDim.x) {
        f32x4 sg = {0.f, 0.f, 0.f, 0.f}, sb = {0.f, 0.f, 0.f, 0.f};
#pragma unroll
        for (int q = 0; q < 4; ++q) {
            const int d = threadIdx.x * 4 + q;
            const f32x4 v = *(const f32x4*)(p.wq + (size_t)d * 2048 + cb * 4);
            sg += v * p.ln1_g[d]; sb += v * p.ln1_b[d];
        }
        __syncthreads();
#pragma unroll
        for (int q = 0; q < 4; ++q) {
            const float a = wave_sum(sg[q]), b = wave_sum(sb[q]);
            if (lane == 0) { red[wid * 8 + q] = a; red[wid * 8 + 4 + q] = b; }
        }
        __syncthreads();
        if (threadIdx.x < 8) {
            const float t = (red[threadIdx.x] + red[8 + threadIdx.x]) + (red[16 + threadIdx.x] + red[24 + threadIdx.x]);
            p.wgb[(threadIdx.x >> 2) * 2048 + cb * 4 + (threadIdx.x & 3)] = t;
        }
    }
}
template <bool FOLD>
__device__ void cvt_table_fp8(const Params& p, const float* __restrict__ src, unsigned char* __restrict__ dst, bf16_t* __restrict__ scl, int rows) {
    const int lane = threadIdx.x & 63, wid = threadIdx.x >> 6;
    const int nw = gridDim.x * 4;
    for (int r0 = blockIdx.x * 4 + wid; r0 < rows; r0 += 4 * nw) {
        f32x4 v[4][4];
#pragma unroll
        for (int q = 0; q < 4; ++q) {
            const int r = (r0 + q * nw < rows) ? r0 + q * nw : r0;
            const float* sr = src + (size_t)r * DM + lane * 16;
#pragma unroll
            for (int k = 0; k < 4; ++k) v[q][k] = *(const f32x4*)(sr + 4 * k);
        }
        f32x4 gv[4], bv[4];
        if (FOLD) {
#pragma unroll
            for (int k = 0; k < 4; ++k) { gv[k] = *(const f32x4*)(p.ln1_g + lane * 16 + 4 * k); bv[k] = *(const f32x4*)(p.ln1_b + lane * 16 + 4 * k); }
        }
#pragma unroll
        for (int q = 0; q < 4; ++q) {
            const int r = r0 + q * nw;
            if (FOLD) {
                float cu = 0.f, bu = 0.f;
#pragma unroll
                for (int k = 0; k < 4; ++k) { bu += (bv[k][0] * v[q][k][0] + bv[k][1] * v[q][k][1]) + (bv[k][2] * v[q][k][2] + bv[k][3] * v[q][k][3]); v[q][k] = v[q][k] * gv[k]; cu += (v[q][k][0] + v[q][k][1]) + (v[q][k][2] + v[q][k][3]); }
                cu = wave_sum(cu); bu = wave_sum(bu);
                if (lane == 0 && r < rows) p.cb2[r] = pack2(cu, bu);
            }
            float m = 0.f;
#pragma unroll
            for (int k = 0; k < 4; ++k)
#pragma unroll
                for (int i = 0; i < 4; ++i) m = fmaxf(m, fabsf(v[q][k][i]));
#pragma unroll
            for (int o = 32; o >= 1; o >>= 1) m = fmaxf(m, __shfl_xor(m, o));
            int ex = (m > 0.f) ? (8 - (int)((__float_as_uint(m) >> 23) & 0xffu) + 127 - ((__float_as_uint(m) & 0x7fffffu) > 0x600000u ? 1 : 0)) : 0;
            ex = min(max(ex, -100), 100);
            const float sc = __uint_as_float((unsigned)(127 + ex) << 23);
            u32x4 w;
#pragma unroll
            for (int k = 0; k < 4; ++k)
                w[k] = __builtin_amdgcn_cvt_pk_fp8_f32(v[q][k][2] * sc, v[q][k][3] * sc, __builtin_amdgcn_cvt_pk_fp8_f32(v[q][k][0] * sc, v[q][k][1] * sc, 0, false), true);
            if (r < rows) {
                *(u32x4*)(dst + (size_t)(lane >> 3) * (16384 * 128) + (size_t)r * 128 + (lane & 7) * 16) = w;
                if (lane == 0) scl[2 * r] = (bf16_t)(((unsigned)(127 - ex) << 23) >> 16);
            }
        }
    }
}
__device__ void ph_prep_b(const Params& p, unsigned char* smem) {
    float* tile = (float*)smem;
    __syncthreads();
    cvt_rows(p.p, p.pb, (size_t)T_TOK * 256);
    cvt_table_fp8<true>(p, p.pu, p.u8, p.sc2, 16384);
    cvt_table_fp8<false>(p, p.pv, p.v8, p.sc2 + 1, 16384);
    cvt_rows(p.keys, p.keysb, (size_t)16 * 128 * 128);
    transpose_cvt(p.w_out, p.WoutT, DM, DM, tile);
    cvt_wq_fold(p, smem);
    transpose_cvt(p.ple_gate, p.WgT, DM, DM, tile);
    transpose_cvt(p.ple_proj, p.WpT, 256, DM, tile);
    __syncthreads();
}
__device__ void ph_prep(const Params& p, unsigned char* smem) {
    float* tile = (float*)smem;
    cvt_rows(p.x, p.xb, (size_t)T_TOK * DM);
    for (int i = blockIdx.x * 256 + threadIdx.x; i < T_TOK * 8; i += gridDim.x * 256) {
        const int t = i >> 3, j = i & 7;
        const float inv = powf(500000.0f, -(float)j * 0.125f);
        float sn, cs; sincosf((float)p.pos[t] * inv, &sn, &cs);
        p.rope[t * 16 + j] = cs; p.rope[t * 16 + 8 + j] = sn;
    }
    transpose_cvt<true>(p.w_in, p.WinT, DM, INW, tile);
}

#define LDS_AS __attribute__((address_space(3)))
#define GEMM_STAGE 32768
template <bool PRE = false, bool NEXT = false>
__device__ __forceinline__ void gemm128(const bf16_t* __restrict__ A, int lda, const bf16_t* __restrict__ Bt, int ldb, int K,
                                        unsigned char* smem, f32x4 (&acc)[4][4],
                                        const bf16_t* __restrict__ nA = nullptr, int nlda = 0, const bf16_t* __restrict__ nB = nullptr, int nldb = 0) {
    LDS_AS unsigned char* lds = (LDS_AS unsigned char*)smem;
    const int tid = threadIdx.x, lane = tid & 63, wid = __builtin_amdgcn_readfirstlane(tid >> 6);
    const int wr = wid >> 1, wc = wid & 1, fr = lane & 15, fq = lane >> 4;
    const int nk = K / 64;
    const int prow = lane >> 3, pc = (lane & 7) ^ prow;
    const bf16_t* gA = A + (size_t)(wid * 32 + prow) * lda + pc * 8;
    const bf16_t* gB = Bt + (size_t)(wid * 32 + prow) * ldb + pc * 8;
    const size_t a8 = (size_t)8 * lda, b8 = (size_t)8 * ldb;
#define GEMM_ISSUE(kt, st) do { \
        _Pragma("unroll") for (int _i = 0; _i < 4; ++_i) { \
            __builtin_amdgcn_global_load_lds((const unsigned*)(gA + _i * a8 + (size_t)(kt) * 64), (LDS_AS unsigned*)(lds + (st) * GEMM_STAGE + (wid * 4 + _i) * 1024), 16, 0, 0); \
            __builtin_amdgcn_global_load_lds((const unsigned*)(gB + _i * b8 + (size_t)(kt) * 64), (LDS_AS unsigned*)(lds + (st) * GEMM_STAGE + 16384 + (wid * 4 + _i) * 1024), 16, 0, 0); \
        } } while (0)
    const int swz0 = ((0 * 4 + fq) ^ (fr & 7)) * 16, swz1 = ((1 * 4 + fq) ^ (fr & 7)) * 16;
    const int aoff = (wr * 64 + fr) * 128, boff = 16384 + (wc * 64 + fr) * 128;
    if (!PRE) GEMM_ISSUE(0, 0);
#pragma unroll 1
    for (int kt = 0; kt < nk; ++kt) {
        const int st = kt & 1;
        asm volatile("s_waitcnt vmcnt(0)" ::: "memory");
        __builtin_amdgcn_s_barrier();
        asm volatile("" ::: "memory");
        if (kt + 1 < nk) GEMM_ISSUE(kt + 1, st ^ 1);
        else if (NEXT) {
            const bf16_t* qA = nA + (size_t)(wid * 32 + prow) * nlda + pc * 8;
            const bf16_t* qB = nB + (size_t)(wid * 32 + prow) * nldb + pc * 8;
#pragma unroll
            for (int _i = 0; _i < 4; ++_i) {
                __builtin_amdgcn_global_load_lds((const unsigned*)(qA + (size_t)(_i * 8) * nlda), (LDS_AS unsigned*)(lds + (wid * 4 + _i) * 1024), 16, 0, 0);
                __builtin_amdgcn_global_load_lds((const unsigned*)(qB + (size_t)(_i * 8) * nldb), (LDS_AS unsigned*)(lds + 16384 + (wid * 4 + _i) * 1024), 16, 0, 0);
            }
        }
        const LDS_AS unsigned char* sb = lds + st * GEMM_STAGE;
        bf16x8 af0[4], bf0[4], af1[4], bf1[4];
#pragma unroll
        for (int mi = 0; mi < 4; ++mi) af0[mi] = *(const LDS_AS bf16x8*)(sb + aoff + mi * 2048 + swz0);
#pragma unroll
        for (int ni = 0; ni < 4; ++ni) bf0[ni] = *(const LDS_AS bf16x8*)(sb + boff + ni * 2048 + swz0);
#pragma unroll
        for (int mi = 0; mi < 4; ++mi) af1[mi] = *(const LDS_AS bf16x8*)(sb + aoff + mi * 2048 + swz1);
#pragma unroll
        for (int ni = 0; ni < 4; ++ni) bf1[ni] = *(const LDS_AS bf16x8*)(sb + boff + ni * 2048 + swz1);
#pragma unroll
        for (int mi = 0; mi < 4; ++mi)
#pragma unroll
            for (int ni = 0; ni < 4; ++ni)
                acc[mi][ni] = __builtin_amdgcn_mfma_f32_16x16x32_bf16(bf0[ni], af0[mi], acc[mi][ni], 0, 0, 0);
#pragma unroll
        for (int mi = 0; mi < 4; ++mi)
#pragma unroll
            for (int ni = 0; ni < 4; ++ni)
                acc[mi][ni] = __builtin_amdgcn_mfma_f32_16x16x32_bf16(bf1[ni], af1[mi], acc[mi][ni], 0, 0, 0);
        __builtin_amdgcn_sched_group_barrier(0x100, 8, 0);
#pragma unroll
        for (int q = 0; q < 8; ++q) { __builtin_amdgcn_sched_group_barrier(0x008, 2, 0); __builtin_amdgcn_sched_group_barrier(0x100, 1, 0); }
        __builtin_amdgcn_sched_group_barrier(0x008, 16, 0);
        asm volatile("s_waitcnt lgkmcnt(0)" ::: "memory");
        __builtin_amdgcn_s_barrier();
        asm volatile("" ::: "memory");
    }
#undef GEMM_ISSUE
}
#define GW_STAGE 24576
__device__ __forceinline__ void gemmW(const bf16_t* __restrict__ A, int lda, const bf16_t* __restrict__ Bt, int ldb, int K,
                                      unsigned char* smem, f32x4 (&acc)[4][8]) {
    LDS_AS unsigned char* lds = (LDS_AS unsigned char*)smem;
    const int tid = threadIdx.x, lane = tid & 63, wid = __builtin_amdgcn_readfirstlane(tid >> 6);
    const int wr = wid >> 1, wc = wid & 1, fr = lane & 15, fq = lane >> 4;
    const int nk = K / 32;
    const int prow = lane >> 2, pc = (lane & 3) ^ ((4 - ((prow >> 2) & 3)) & 3);
    const bf16_t* gA = A + (size_t)(wid * 32 + prow) * lda + pc * 8;
    const bf16_t* gB = Bt + (size_t)(wid * 64 + prow) * ldb + pc * 8;
    const size_t a16 = (size_t)16 * lda, b16 = (size_t)16 * ldb;
#define GW_ISSUE(kt, st) do { \
        _Pragma("unroll") for (int _i = 0; _i < 2; ++_i) \
            __builtin_amdgcn_global_load_lds((const unsigned*)(gA + _i * a16 + (size_t)(kt) * 32), (LDS_AS unsigned*)(lds + (st) * GW_STAGE + (wid * 2 + _i) * 1024), 16, 0, 0); \
        _Pragma("unroll") for (int _i = 0; _i < 4; ++_i) \
            __builtin_amdgcn_global_load_lds((const unsigned*)(gB + _i * b16 + (size_t)(kt) * 32), (LDS_AS unsigned*)(lds + (st) * GW_STAGE + 8192 + (wid * 4 + _i) * 1024), 16, 0, 0); \
        } while (0)
    const int swz = (fq ^ ((4 - ((fr >> 2) & 3)) & 3)) * 16;
    const int aoff = (wr * 64 + fr) * 64 + swz, boff = 8192 + (wc * 128 + fr) * 64 + swz;
    GW_ISSUE(0, 0);
#pragma unroll 1
    for (int kt = 0; kt < nk; ++kt) {
        const int st = kt & 1;
        asm volatile("s_waitcnt vmcnt(0)" ::: "memory");
        __builtin_amdgcn_s_barrier();
        asm volatile("" ::: "memory");
        if (kt + 1 < nk) GW_ISSUE(kt + 1, st ^ 1);
        const LDS_AS unsigned char* sb = lds + st * GW_STAGE;
        bf16x8 af[4], bfr[8];
#pragma unroll
        for (int mi = 0; mi < 4; ++mi) af[mi] = *(const LDS_AS bf16x8*)(sb + aoff + mi * 1024);
#pragma unroll
        for (int ni = 0; ni < 8; ++ni) bfr[ni] = *(const LDS_AS bf16x8*)(sb + boff + ni * 1024);
#pragma unroll
        for (int ni = 0; ni < 8; ++ni)
#pragma unroll
            for (int mi = 0; mi < 4; ++mi)
                acc[mi][ni] = __builtin_amdgcn_mfma_f32_16x16x32_bf16(bfr[ni], af[mi], acc[mi][ni], 0, 0, 0);
        asm volatile("s_waitcnt lgkmcnt(0)" ::: "memory");
        __builtin_amdgcn_s_barrier();
        asm volatile("" ::: "memory");
    }
#undef GW_ISSUE
}
__device__ __forceinline__ void zero_accw(f32x4 (&acc)[4][8]) {
#pragma unroll
    for (int a = 0; a < 4; ++a)
#pragma unroll
        for (int b = 0; b < 8; ++b) acc[a][b] = (f32x4){0.f, 0.f, 0.f, 0.f};
}
__device__ __forceinline__ void zero_acc(f32x4 (&acc)[4][4]) {
#pragma unroll
    for (int a = 0; a < 4; ++a)
#pragma unroll
        for (int b = 0; b < 4; ++b) acc[a][b] = (f32x4){0.f, 0.f, 0.f, 0.f};
}
#define GEMM_SMEM (2 * GEMM_STAGE)

__device__ void ph_gemm_in(const Params& p, unsigned char* smem, const int vb) {
    const int ntn = INW / 128;
    const int tid = threadIdx.x, lane = tid & 63, wid = tid >> 6, wr = wid >> 1, wc = wid & 1, fr = lane & 15, fq = lane >> 4;
    const int ntiles = (T_TOK / 128) * ntn;
    if ((vb & 1) == 0) ph_prep_b(p, smem);
    {
    bool pre = false;
    for (int t = vb; t < ntiles; t += gridDim.x) {
        const int m0 = (t / ntn) * 128, n0 = (t % ntn) * 128;
        const int tn = t + gridDim.x;
        const bool has_next = tn < ntiles;
        const bf16_t* nA = p.xb + (size_t)((has_next ? tn : t) / ntn) * 128 * DM;
        const bf16_t* nB = p.WinT + (size_t)((has_next ? tn : t) % ntn) * 128 * DM;
        f32x4 acc[4][4]; zero_acc(acc);
        if (pre) { if (has_next) gemm128<true, true>(p.xb + (size_t)m0 * DM, DM, p.WinT + (size_t)n0 * DM, DM, DM, smem, acc, nA, DM, nB, DM);
                   else          gemm128<true, false>(p.xb + (size_t)m0 * DM, DM, p.WinT + (size_t)n0 * DM, DM, DM, smem, acc); }
        else     { if (has_next) gemm128<false, true>(p.xb + (size_t)m0 * DM, DM, p.WinT + (size_t)n0 * DM, DM, DM, smem, acc, nA, DM, nB, DM);
                   else          gemm128<false, false>(p.xb + (size_t)m0 * DM, DM, p.WinT + (size_t)n0 * DM, DM, DM, smem, acc); }
        pre = has_next;
        if (n0 >= 768) {
            const int cb = ((n0 - 768) >> 7) * 64 + wc * 32 + fq * 4;
#pragma unroll
            for (int mi = 0; mi < 4; ++mi) {
                const int row = m0 + wr * 64 + mi * 16 + fr;
#pragma unroll
                for (int k2 = 0; k2 < 2; ++k2) {
                    const f32x4 a = acc[mi][2 * k2], gt = acc[mi][2 * k2 + 1];
                    uint2 o; o.x = pack2(sigmul(a[0], gt[0]), sigmul(a[1], gt[1])); o.y = pack2(sigmul(a[2], gt[2]), sigmul(a[3], gt[3]));
                    *(uint2*)(p.hb + (size_t)row * INW + 768 + cb + k2 * 16) = o;
                }
            }
        } else {
#pragma unroll
        for (int mi = 0; mi < 4; ++mi) {
            const int row = m0 + wr * 64 + mi * 16 + fr;
#pragma unroll
            for (int ni = 0; ni < 4; ++ni) {
                const int col0 = n0 + wc * 64 + ni * 16;
                f32x4 v = acc[mi][ni];
                if (col0 < 640 && (col0 & 63) == 0) {
                    const f32x4 cs = *(const f32x4*)(p.rope + (size_t)row * 16 + (fq & 1) * 4), sn = *(const f32x4*)(p.rope + (size_t)row * 16 + 8 + (fq & 1) * 4);
#pragma unroll
                    for (int r = 0; r < 4; ++r) {
                        const float other = __shfl_xor(v[r], 32);
                        v[r] = (fq < 2) ? (v[r] * cs[r] - other * sn[r]) : (v[r] * cs[r] + other * sn[r]);
                    }
                }
                uint2 o; o.x = pack2(v[0], v[1]); o.y = pack2(v[2], v[3]);
                *(uint2*)(p.hb + (size_t)row * INW + col0 + fq * 4) = o;
            }
        }
        }
    }
    }
    if ((vb & 1) != 0) ph_prep_b(p, smem);
}

#define ASTR 72
#define VSTR 260
typedef float f32x16 __attribute__((ext_vector_type(16)));
typedef unsigned u32x2 __attribute__((ext_vector_type(2)));
__device__ void ph_attn(const Params& p, unsigned char* smem, const int vb) {
    bf16_t* sK = (bf16_t*)smem;
    bf16_t* sVt = sK + 256 * ASTR;
    const int tid = threadIdx.x, lane = tid & 63, wid = tid >> 6, r32 = lane & 31, hh = lane >> 5;
    const float C1 = 0.125f * 1.4426950408889634f, LOG2E = 1.4426950408889634f;
    for (int u = vb; u < 16 * 16 * 2; u += gridDim.x) {
        const int kvh = u & 1, nb = (u >> 1) & 15, b = u >> 5;
        __syncthreads();
        for (int c = tid; c < 256 * 8; c += 256) {
            const int li = c >> 3, kc = c & 7;
            const int pos = nb * 128 - 128 + li;
            u32x4 kv = {0u, 0u, 0u, 0u}, vv = {0u, 0u, 0u, 0u};
            if (pos >= 0) {
                const bf16_t* base = p.hb + (size_t)(b * SEQ + pos) * INW;
                kv = *(const u32x4*)(base + 512 + kvh * 64 + kc * 8);
                vv = *(const u32x4*)(base + 640 + kvh * 64 + kc * 8);
            }
            *(u32x4*)(sK + li * ASTR + kc * 8) = kv;
#pragma unroll
            for (int i = 0; i < 4; ++i) {
                sVt[(kc * 8 + 2 * i) * VSTR + li] = (bf16_t)(vv[i] & 0xffffu);
                sVt[(kc * 8 + 2 * i + 1) * VSTR + li] = (bf16_t)(vv[i] >> 16);
            }
        }
        __syncthreads();
        const int hq = kvh * 4 + wid;
        const float sink2 = p.sinks[hq] * LOG2E;
        bf16x8 qn[4];
        {
            const size_t tr0 = (size_t)(b * SEQ + nb * 128 + r32);
#pragma unroll
            for (int ks = 0; ks < 4; ++ks) qn[ks] = *(const bf16x8*)(p.hb + tr0 * INW + hq * 64 + ks * 16 + hh * 8);
        }
#pragma unroll 1
        for (int qt = 0; qt < 4; ++qt) {
            const size_t trow = (size_t)(b * SEQ + nb * 128 + qt * 32 + r32);
            bf16x8 qf[4];
#pragma unroll
            for (int ks = 0; ks < 4; ++ks) qf[ks] = qn[ks];
            {
                const size_t trn = (size_t)(b * SEQ + nb * 128 + (qt < 3 ? qt + 1 : qt) * 32 + r32);
#pragma unroll
                for (int ks = 0; ks < 4; ++ks) qn[ks] = *(const bf16x8*)(p.hb + trn * INW + hq * 64 + ks * 16 + hh * 8);
            }
            f32x16 S[5];
#pragma unroll
            for (int j = 0; j < 5; ++j) {
#pragma unroll
                for (int r = 0; r < 16; ++r) S[j][r] = 0.f;
#pragma unroll
                for (int ks = 0; ks < 4; ++ks) {
                    const bf16x8 a = *(const bf16x8*)(sK + ((qt + j) * 32 + r32) * ASTR + ks * 16 + hh * 8);
                    S[j] = __builtin_amdgcn_mfma_f32_32x32x16_bf16(a, qf[ks], S[j], 0, 0, 0);
                }
            }
            float m2 = sink2;
#pragma unroll
            for (int j = 0; j < 5; ++j) {
                const bool tile_ok = (nb > 0) || (qt + j >= 4);
#pragma unroll
                for (int r = 0; r < 16; ++r) {
                    const int kl = (r & 3) + 8 * (r >> 2) + 4 * hh;
                    bool ok = tile_ok;
                    if (j == 0) ok = ok && (kl > r32);
                    if (j == 4) ok = ok && (kl <= r32);
                    const float t = ok ? S[j][r] * C1 : -1.0e30f;
                    S[j][r] = t;
                    m2 = fmaxf(m2, t);
                }
            }
            m2 = fmaxf(m2, __shfl_xor(m2, 32));
            float l = 0.f;
#pragma unroll
            for (int j = 0; j < 5; ++j)
#pragma unroll
                for (int r = 0; r < 16; ++r) { const float e = __builtin_amdgcn_exp2f(S[j][r] - m2); S[j][r] = e; l += e; }
            l += __shfl_xor(l, 32);
            l += __builtin_amdgcn_exp2f(sink2 - m2);
            f32x16 O[2];
#pragma unroll
            for (int dt = 0; dt < 2; ++dt)
#pragma unroll
                for (int r = 0; r < 16; ++r) O[dt][r] = 0.f;
#pragma unroll
            for (int j = 0; j < 5; ++j)
#pragma unroll
                for (int s2 = 0; s2 < 2; ++s2) {
                    u32x4 pw;
#pragma unroll
                    for (int k = 0; k < 4; ++k) pw[k] = pack2(S[j][8 * s2 + 2 * k], S[j][8 * s2 + 2 * k + 1]);
                    const bf16x8 pf = __builtin_bit_cast(bf16x8, pw);
                    const int kbase = (qt + j) * 32 + 16 * s2 + 4 * hh;
#pragma unroll
                    for (int dt = 0; dt < 2; ++dt) {
                        const bf16_t* vp = sVt + (dt * 32 + r32) * VSTR + kbase;
                        const u32x2 v0 = *(const u32x2*)(vp), v1 = *(const u32x2*)(vp + 8);
                        const u32x4 vw = {v0[0], v0[1], v1[0], v1[1]};
                        O[dt] = __builtin_amdgcn_mfma_f32_32x32x16_bf16(__builtin_bit_cast(bf16x8, vw), pf, O[dt], 0, 0, 0);
                    }
                }
            const float il = __builtin_amdgcn_rcpf(l);
#pragma unroll
            for (int dt = 0; dt < 2; ++dt)
#pragma unroll
                for (int g = 0; g < 4; ++g) {
                    u32x2 w;
                    w[0] = pack2(O[dt][4 * g] * il, O[dt][4 * g + 1] * il);
                    w[1] = pack2(O[dt][4 * g + 2] * il, O[dt][4 * g + 3] * il);
                    *(u32x2*)(p.mixb + trow * DM + hq * 64 + dt * 32 + 8 * g + 4 * hh) = w;
                }
        }
    }
}

#define CV_ROWS 62
__device__ void ph_conv(const Params& p, unsigned char* smem, const int vb) {
    bf16_t* gl = (bf16_t*)smem;
    float* red = (float*)(smem + CV_ROWS * 1024);
    const int tid = threadIdx.x, lane = tid & 63, wid = tid >> 6;
    const f32x2 lg = *(const f32x2*)(p.cln_g + 2 * tid), lb = *(const f32x2*)(p.cln_b + 2 * tid);
    for (int u = vb; u < T_TOK / 32; u += gridDim.x) {
        const int tok0 = u * 32, s0 = tok0 & (SEQ - 1);
        __syncthreads();
#pragma unroll 1
        for (int bt = 0; bt < 2; ++bt) {
            u32x4 av[8];
#pragma unroll
            for (int it = 0; it < 8; ++it) {
                const int ch = tid + (bt * 8 + it) * 256, row = min(ch >> 6, CV_ROWS - 1), k = ch & 63;
                const int rr = (s0 - 30 + row >= 0) ? row : 30;
                av[it] = *(const u32x4*)(p.hb + (size_t)(tok0 - 30 + rr) * INW + 768 + k * 8);
            }
#pragma unroll
            for (int it = 0; it < 8; ++it) {
                const int ch = tid + (bt * 8 + it) * 256, row = ch >> 6, k = ch & 63;
                const bool ok = (s0 - 30 + row >= 0);
                const u32x4 o = ok ? av[it] : (u32x4){0u, 0u, 0u, 0u};
                if (row < CV_ROWS) *(u32x4*)(gl + row * 512 + k * 8) = o;
            }
        }
        __syncthreads();
        float w0[31], w1[31];
#pragma unroll
        for (int k = 0; k < 31; ++k) { const f32x2 wv = *(const f32x2*)(p.conv_w + k * 512 + 2 * tid); w0[k] = wv.x; w1[k] = wv.y; }
        const f32x2 bias = *(const f32x2*)(p.conv_b + 2 * tid);
#pragma unroll 1
        for (int jh = 0; jh < 2; ++jh) {
            float a0[16], a1[16];
#pragma unroll
            for (int jl = 0; jl < 16; ++jl) { a0[jl] = bias.x; a1[jl] = bias.y; }
            const bf16_t* gp = gl + (jh * 16) * 512 + 2 * tid;
#pragma unroll
            for (int il = 0; il < 46; ++il) {
                const unsigned gw = *(const unsigned*)(gp + il * 512);
                const float g0 = bflo(gw), g1 = bfhi(gw);
#pragma unroll
                for (int jl = 0; jl < 16; ++jl)
                    if (il - jl >= 0 && il - jl <= 30) { a0[jl] += w0[il - jl] * g0; a1[jl] += w1[il - jl] * g1; }
                if ((il & 3) == 3) __builtin_amdgcn_sched_barrier(0);
            }
            float v[32];
#pragma unroll
            for (int jl = 0; jl < 16; ++jl) { v[jl] = a0[jl] + a1[jl]; v[16 + jl] = a0[jl] * a0[jl] + a1[jl] * a1[jl]; }
#pragma unroll
            for (int st = 16; st >= 1; st >>= 1) {
                const bool up = (lane & st) != 0;
#pragma unroll
                for (int i2 = 0; i2 < st; ++i2) {
                    const float keep = up ? v[i2 + st] : v[i2], send = up ? v[i2] : v[i2 + st];
                    v[i2] = keep + __shfl_xor(send, st);
                }
            }
            const float tot = v[0] + __shfl_xor(v[0], 32);
            __syncthreads();
            if (lane < 32) red[wid * 32 + lane] = tot;
            __syncthreads();
#pragma unroll
            for (int jl = 0; jl < 16; ++jl) {
                const float sm = (red[jl] + red[32 + jl]) + (red[64 + jl] + red[96 + jl]);
                const float sq = (red[16 + jl] + red[48 + jl]) + (red[80 + jl] + red[112 + jl]);
                const float mu = sm * (1.0f / 512.0f);
                const float rstd = rsqrtf(fmaxf(sq * (1.0f / 512.0f) - mu * mu, 0.f) + LN_EPS);
                const float y0 = (a0[jl] - mu) * rstd * lg.x + lb.x, y1 = (a1[jl] - mu) * rstd * lg.y + lb.y;
                *(unsigned*)(p.mixb + (size_t)(tok0 + jh * 16 + jl) * DM + 512 + 2 * tid) = pack2(sigmul(y0, y0), sigmul(y1, y1));
            }
        }
    }
}

__device__ void ph_gemm_out(const Params& p, unsigned char* smem, const int vb) {
    const int ntn = DM / 256;
    const int tid = threadIdx.x, lane = tid & 63, wid = tid >> 6, wr = wid >> 1, wc = wid & 1, fr = lane & 15, fq = lane >> 4;
    for (int t = vb; t < (T_TOK / 128) * ntn; t += gridDim.x) {
        const int m0 = (t / ntn) * 128, n0 = (t % ntn) * 256;
        f32x4 acc[4][8]; zero_accw(acc);
        gemmW(p.mixb + (size_t)m0 * DM, DM, p.WoutT + (size_t)n0 * DM, DM, DM, smem, acc);
#pragma unroll
        for (int mi = 0; mi < 4; ++mi) {
            const int row = m0 + wr * 64 + mi * 16 + fr;
            float sm = 0.f, sq = 0.f;
#pragma unroll
            for (int ni = 0; ni < 8; ++ni) {
                const int col = n0 + wc * 128 + ni * 16 + fq * 4;
                const f32x4 xv = *(const f32x4*)(p.x + (size_t)row * DM + col);
                const f32x4 y = xv * ALPHA + acc[mi][ni];
                sm += (y[0] + y[1]) + (y[2] + y[3]); sq += (y[0] * y[0] + y[1] * y[1]) + (y[2] * y[2] + y[3] * y[3]);
                u32x2 o; o[0] = pack2(y[0], y[1]); o[1] = pack2(y[2], y[3]);
                *(u32x2*)(p.y1b + (size_t)row * DM + col) = o;
            }
            sm += __shfl_xor(sm, 16); sq += __shfl_xor(sq, 16); sm += __shfl_xor(sm, 32); sq += __shfl_xor(sq, 32);
            if (fq == 0) *(f32x2*)(p.stats + (size_t)row * 16 + ((n0 >> 8) * 2 + wc) * 2) = (f32x2){sm, sq};
        }
    }
}

__device__ __forceinline__ void ln_row(const float* __restrict__ src, const float* __restrict__ g, const float* __restrict__ bta,
                                       float* __restrict__ dstf, bf16_t* __restrict__ dstb, int lane) {
    f32x4 v[4]; float s = 0.f;
#pragma unroll
    for (int i = 0; i < 4; ++i) { v[i] = *(const f32x4*)(src + i * 256 + lane * 4); s += (v[i][0] + v[i][1]) + (v[i][2] + v[i][3]); }
    const float mu = wave_sum(s) * (1.0f / 1024.0f);
    float q = 0.f;
#pragma unroll
    for (int i = 0; i < 4; ++i) { const f32x4 d = v[i] - mu; q += (d[0] * d[0] + d[1] * d[1]) + (d[2] * d[2] + d[3] * d[3]); }
    const float rstd = rsqrtf(wave_sum(q) * (1.0f / 1024.0f) + LN_EPS);
#pragma unroll
    for (int i = 0; i < 4; ++i) {
        const f32x4 gg = *(const f32x4*)(g + i * 256 + lane * 4), bb = *(const f32x4*)(bta + i * 256 + lane * 4);
        const f32x4 y = (v[i] - mu) * rstd * gg + bb;
        if (dstf) *(f32x4*)(dstf + i * 256 + lane * 4) = y;
        if (dstb) { uint2 o; o.x = pack2(y[0], y[1]); o.y = pack2(y[2], y[3]); *(uint2*)(dstb + i * 256 + lane * 4) = o; }
    }
}
__device__ void ph_ln2(const Params& p, const int vb) {
    const int lane = threadIdx.x & 63, wid = threadIdx.x >> 6;
    for (int r = vb * 4 + wid; r < T_TOK; r += gridDim.x * 4)
        ln_row(p.out + (size_t)r * DM, p.ln2_g, p.ln2_b, p.out + (size_t)r * DM, (bf16_t*)nullptr, lane);
}

#define QSTR 136
__device__ __forceinline__ int f2key(float f) { const int b = __float_as_int(f); return b ^ ((b >> 31) & 0x7fffffff); }
__device__ __forceinline__ float key2f(int k) { return __int_as_float(k ^ ((k >> 31) & 0x7fffffff)); }
__device__ __forceinline__ void sort16_desc(int (&a)[16]) {
#pragma unroll
    for (int lk = 1; lk <= 4; ++lk) {
#pragma unroll
        for (int lj = lk - 1; lj >= 0; --lj) {
            const int k = 1 << lk, j = 1 << lj;
#pragma unroll
            for (int i = 0; i < 16; ++i) {
                const int l = i ^ j;
                if (l > i) {
                    const int hi = max(a[i], a[l]), lo = min(a[i], a[l]);
                    if ((i & k) == 0) { a[i] = hi; a[l] = lo; } else { a[i] = lo; a[l] = hi; }
                }
            }
        }
    }
}
__device__ __forceinline__ void merge_top16(int (&a)[16], const int (&b)[16]) {
#pragma unroll
    for (int i = 0; i < 16; ++i) a[i] = max(a[i], b[15 - i]);
#pragma unroll
    for (int lj = 3; lj >= 0; --lj) {
        const int j = 1 << lj;
#pragma unroll
        for (int i = 0; i < 16; ++i) {
            const int l = i ^ j;
            if (l > i) { const int hi = max(a[i], a[l]), lo = min(a[i], a[l]); a[i] = hi; a[l] = lo; }
        }
    }
}
__device__ __forceinline__ void top16_of_64(int (&v)[4][16]) {
    sort16_desc(v[0]); sort16_desc(v[1]); sort16_desc(v[2]); sort16_desc(v[3]);
    merge_top16(v[0], v[1]); merge_top16(v[0], v[2]); merge_top16(v[0], v[3]);
}

__device__ void ph_mprep(const Params& p, unsigned char* smem, const int vb) {
    if (vb < 8) {
        const int n = vb * 256 + threadIdx.x, hp = n >> 7;
        const float* kr = p.keys + (size_t)n * 128;
        float a = 0.f, b = 0.f;
        for (int c4 = 0; c4 < 128; c4 += 4) {
            const f32x4 kv = *(const f32x4*)(kr + c4), wg = *(const f32x4*)(p.wgb + hp * 128 + c4), wb = *(const f32x4*)(p.wgb + 2048 + hp * 128 + c4);
            a += (kv[0] * wg[0] + kv[1] * wg[1]) + (kv[2] * wg[2] + kv[3] * wg[3]);
            b += (kv[0] * wb[0] + kv[1] * wb[1]) + (kv[2] * wb[2] + kv[3] * wb[3]);
        }
        u32x4 c0 = {pack2(a, b), 0u, 0u, 0u}; const u32x4 z4 = {0u, 0u, 0u, 0u};
        u32x4* me = (u32x4*)(p.mext + (size_t)n * 32);
        me[0] = c0; me[1] = z4; me[2] = z4; me[3] = z4;
    }
    const int tid = threadIdx.x, lane = tid & 63, wid = tid >> 6, wr = wid >> 1, wc = wid & 1, fr = lane & 15, fq = lane >> 4;
    for (int t = vb; t < 16 * 8; t += gridDim.x) {
        const int hp = t >> 3, d0 = (t & 7) * 128;
        f32x4 acc[4][4]; zero_acc(acc);
        gemm128(p.keysb + (size_t)hp * 128 * 128, 128, p.Wqb + (size_t)d0 * 2048 + hp * 128, 2048, 128, smem, acc);
#pragma unroll
        for (int mi = 0; mi < 4; ++mi)
#pragma unroll
            for (int ni = 0; ni < 4; ++ni) {
                uint2 o; o.x = pack2(acc[mi][ni][0], acc[mi][ni][1]); o.y = pack2(acc[mi][ni][2], acc[mi][ni][3]);
                *(uint2*)(p.MT + (size_t)(hp * 128 + wr * 64 + mi * 16 + fr) * DM + d0 + wc * 64 + ni * 16 + fq * 4) = o;
            }
    }
}

__device__ __forceinline__ void route_topk(const f32x16 (&S)[8], int pp, int hh, int (&K)[16]) {
    int v[4][16];
#pragma unroll
    for (int mt = 0; mt < 4; ++mt)
#pragma unroll
        for (int r = 0; r < 16; ++r) {
            const int n = mt * 32 + (r & 3) + 8 * (r >> 2) + 4 * hh;
            v[mt][r] = (f2key(S[pp * 4 + mt][r]) & ~0x7F) | (127 - n);
        }
    top16_of_64(v);
    int o[16];
#pragma unroll
    for (int i = 0; i < 16; ++i) o[i] = __shfl_xor(v[0][i], 32);
    merge_top16(v[0], o);
#pragma unroll
    for (int i = 0; i < 16; ++i) K[i] = v[0][i];
}
#define RT_STEPS 33
template <bool PRE, bool NEXT>
__device__ __forceinline__ void route_gemm(const Params& p, unsigned char* smem, int m0, int h, f32x16 (&S)[8], int nm0, int nh, int& sp) {
    LDS_AS unsigned char* lds = (LDS_AS unsigned char*)smem;
    const int tid = threadIdx.x, lane = tid & 63, wid = __builtin_amdgcn_readfirstlane(tid >> 6);
    const int r32 = lane & 31, hh = lane >> 5;
    const int prow = lane >> 2, pc = (lane & 3) ^ ((4 - ((prow >> 2) & 3)) & 3);
    const bf16_t* gA = p.y1b + (size_t)(m0 + wid * 32 + prow) * DM + pc * 8;
    const bf16_t* gB = p.MT + (size_t)(h * 256 + wid * 64 + prow) * DM + pc * 8;
    const bf16_t* eA = p.yext + (size_t)(m0 + wid * 32 + prow) * 32 + pc * 8;
    const bf16_t* eB = p.mext + (size_t)(h * 256 + wid * 64 + prow) * 32 + pc * 8;
    const size_t r16 = (size_t)16 * DM;
#define RH_ISSUE_AT(pa, sa, pb, sb_, st) do { \
        _Pragma("unroll") for (int _i = 0; _i < 2; ++_i) \
            __builtin_amdgcn_global_load_lds((const unsigned*)((pa) + _i * (sa)), (LDS_AS unsigned*)(lds + (st) * GW_STAGE + (wid * 2 + _i) * 1024), 16, 0, 0); \
        _Pragma("unroll") for (int _i = 0; _i < 4; ++_i) \
            __builtin_amdgcn_global_load_lds((const unsigned*)((pb) + _i * (sb_)), (LDS_AS unsigned*)(lds + (st) * GW_STAGE + 8192 + (wid * 4 + _i) * 1024), 16, 0, 0); \
        } while (0)
#pragma unroll
    for (int mt = 0; mt < 8; ++mt)
#pragma unroll
        for (int r = 0; r < 16; ++r) S[mt][r] = 0.f;
    const int fx = (4 - ((r32 >> 2) & 3)) & 3;
    const int toff = (wid * 32 + r32) * 64, koff = 8192 + r32 * 64;
    if (!PRE) RH_ISSUE_AT(gA, r16, gB, r16, sp);
#pragma unroll 1
    for (int kt = 0; kt < RT_STEPS; ++kt) {
        const int st = (kt + sp) & 1;
        asm volatile("s_waitcnt vmcnt(0)" ::: "memory");
        __builtin_amdgcn_s_barrier();
        asm volatile("" ::: "memory");
        if (kt + 1 < RT_STEPS - 1) RH_ISSUE_AT(gA + (size_t)(kt + 1) * 32, r16, gB + (size_t)(kt + 1) * 32, r16, st ^ 1);
        else if (kt + 1 == RT_STEPS - 1) RH_ISSUE_AT(eA, (size_t)(16 * 32), eB, (size_t)(16 * 32), st ^ 1);
        else if (NEXT) {
            const bf16_t* qA = p.y1b + (size_t)(nm0 + wid * 32 + prow) * DM + pc * 8;
            const bf16_t* qB = p.MT + (size_t)(nh * 256 + wid * 64 + prow) * DM + pc * 8;
            RH_ISSUE_AT(qA, r16, qB, r16, st ^ 1);
        }
        const LDS_AS unsigned char* sb = lds + st * GW_STAGE;
#pragma unroll
        for (int k16 = 0; k16 < 2; ++k16) {
            const int sw = ((k16 * 2 + hh) ^ fx) * 16;
            const bf16x8 b = *(const LDS_AS bf16x8*)(sb + toff + sw);
#pragma unroll
            for (int mt = 0; mt < 8; ++mt) {
                const bf16x8 a = *(const LDS_AS bf16x8*)(sb + koff + mt * 2048 + sw);
                S[mt] = __builtin_amdgcn_mfma_f32_32x32x16_bf16(a, b, S[mt], 0, 0, 0);
            }
        }
        asm volatile("s_waitcnt lgkmcnt(0)" ::: "memory");
        __builtin_amdgcn_s_barrier();
        asm volatile("" ::: "memory");
    }
    sp ^= (RT_STEPS & 1);
#undef RH_ISSUE_AT
}

__device__ void ph_route(const Params& p, unsigned char* smem, const int vb) {
    const int tid = threadIdx.x, lane = tid & 63, wid = tid >> 6;
    const int r32 = lane & 31, hh = lane >> 5;
    const int hmask = -hh;
    int* KL = (int*)(smem + 2 * GW_STAGE + (size_t)wid * 32 * 33 * 4);
    const int nunits = (T_TOK / 128) * 8;
    bool pre = false; int sp = 0;
    for (int u = vb; u < nunits; u += gridDim.x) {
        const int m0 = (u >> 3) * 128, h = u & 7;
        const int un = u + gridDim.x;
        const bool has_next = un < nunits;
        const int nm0 = ((has_next ? un : u) >> 3) * 128, nh = (has_next ? un : u) & 7;
        float mu, rstd;
        {
            const float* stp = p.stats + (size_t)(m0 + wid * 32 + r32) * 16;
            const f32x4 a = *(const f32x4*)(stp), b = *(const f32x4*)(stp + 4), c4 = *(const f32x4*)(stp + 8), d = *(const f32x4*)(stp + 12);
            const float sm = (a[0] + a[2]) + (b[0] + b[2]) + (c4[0] + c4[2]) + (d[0] + d[2]);
            const float sq = (a[1] + a[3]) + (b[1] + b[3]) + (c4[1] + c4[3]) + (d[1] + d[3]);
            mu = sm * (1.0f / 1024.0f);
            rstd = rsqrtf(fmaxf(sq * (1.0f / 1024.0f) - mu * mu, 0.f) + LN_EPS);
        }
        {
            bf16_t* ye = p.yext + (size_t)(m0 + wid * 32 + r32) * 32 + hh * 16;
            const u32x4 z4 = {0u, 0u, 0u, 0u};
            u32x4 c0 = z4; if (hh == 0) c0[0] = pack2(-mu, __builtin_amdgcn_rcpf(rstd));
            *(u32x4*)(ye) = c0; *(u32x4*)(ye + 8) = z4;
        }
        f32x16 S[8];
        if (pre) { if (has_next) route_gemm<true, true>(p, smem, m0, h, S, nm0, nh, sp); else route_gemm<true, false>(p, smem, m0, h, S, nm0, nh, sp); }
        else     { if (has_next) route_gemm<false, true>(p, smem, m0, h, S, nm0, nh, sp); else route_gemm<false, false>(p, smem, m0, h, S, nm0, nh, sp); }
        int K0[16], K1[16];
        route_topk(S, 0, hh, K0);
        route_topk(S, 1, hh, K1);
        pre = has_next;
#pragma unroll
        for (int i = 0; i < 16; ++i) KL[r32 * 33 + hh * 16 + i] = K0[i] ^ ((K0[i] ^ K1[i]) & hmask);
        float s1[16], s2[16];
#pragma unroll
        for (int i = 0; i < 16; ++i) { s1[i] = key2f(K0[i] & ~0x7F); s2[i] = key2f(K1[i] & ~0x7F); }
        int c[4][16];
#pragma unroll
        for (int i = 0; i < 16; ++i)
#pragma unroll
            for (int j = 0; j < 16; ++j)
                if ((i + 1) * (j + 1) <= 16) {
                    constexpr int OFFS[16] = {0, 16, 24, 29, 33, 36, 38, 40, 42, 43, 44, 45, 46, 47, 48, 49};
                    const int q = OFFS[i] + j;
                    c[q >> 4][q & 15] = (f2key(s1[i] + s2[j]) & ~0xFF) | (255 - (i * 16 + j));
                }
#pragma unroll
        for (int qq = 50; qq < 64; ++qq) c[qq >> 4][qq & 15] = (int)0x80000000;
        top16_of_64(c);
        const float mx = key2f(c[0][0] & ~0xFF);
        float e[16]; float den = 0.f;
#pragma unroll
        for (int i = 0; i < 16; ++i) { e[i] = __expf(rstd * (key2f(c[0][i] & ~0xFF) - mx)); den += e[i]; }
        const float inv = __builtin_amdgcn_rcpf(den);
        const size_t ob = (size_t)(m0 + wid * 32 + r32) * 128 + h * 16 + hh * 8;
        int idv[8]; float gv[8];
#pragma unroll
        for (int qq = 0; qq < 8; ++qq) {
            const int F = c[0][qq] ^ ((c[0][qq] ^ c[0][8 + qq]) & hmask);
            gv[qq] = __int_as_float(__float_as_int(e[qq]) ^ ((__float_as_int(e[qq]) ^ __float_as_int(e[8 + qq])) & hmask)) * inv;
            const int idx = 255 - (F & 0xFF);
            const int k0 = KL[r32 * 33 + (idx >> 4)], k1 = KL[r32 * 33 + 16 + (idx & 15)];
            idv[qq] = (127 - (k0 & 0x7F)) * 128 + (127 - (k1 & 0x7F));
        }
        *(int4*)(p.ids + ob) = make_int4(idv[0], idv[1], idv[2], idv[3]);
        *(int4*)(p.ids + ob + 4) = make_int4(idv[4], idv[5], idv[6], idv[7]);
        *(float4*)(p.gates + ob) = make_float4(gv[0], gv[1], gv[2], gv[3]);
        *(float4*)(p.gates + ob + 4) = make_float4(gv[4], gv[5], gv[6], gv[7]);
    }
}

__device__ __forceinline__ f32x2 row_dot(const u32x4 w, const f32x2 (&x)[8], f32x2 acc) {
#pragma unroll
    for (int k = 0; k < 4; ++k) {
        acc = __builtin_amdgcn_cvt_pk_f32_fp8(w[k], false) * x[2 * k] + acc;
        acc = __builtin_amdgcn_cvt_pk_f32_fp8(w[k], true) * x[2 * k + 1] + acc;
    }
    return acc;
}
__device__ __forceinline__ float gelu_gate(float h, float g) { return 0.5f * h * (1.0f + erff(h * 0.70710678118654752f)) * g; }

__device__ __forceinline__ void ld_ids16(const int* __restrict__ q, int (&idv)[16]) {
    const int4* idp = (const int4*)q;
#pragma unroll
    for (int k = 0; k < 4; ++k) { const int4 v = idp[k]; idv[4 * k] = v.x; idv[4 * k + 1] = v.y; idv[4 * k + 2] = v.z; idv[4 * k + 3] = v.w; }
}
__device__ __forceinline__ void ld_f16(const float* __restrict__ q, float (&a)[16]) {
    const f32x4* ap = (const f32x4*)q;
#pragma unroll
    for (int k = 0; k < 4; ++k) { const f32x4 v = ap[k]; a[4 * k] = v[0]; a[4 * k + 1] = v[1]; a[4 * k + 2] = v[2]; a[4 * k + 3] = v[3]; }
}
__device__ void ph_peer_u(const Params& p, unsigned char* smem, const int vb) {
    const int lane = threadIdx.x & 63, wid = __builtin_amdgcn_readfirstlane(threadIdx.x >> 6);
    const int q = lane >> 3, c = lane & 7, j = lane & 15, kb = lane >> 4;
    const int nlb = gridDim.x >> 3, s = vb / nlb, lb = vb - s * nlb;
    const int stride = nlb * 4, t0 = lb * 4 + wid;
    const int ntok = (T_TOK - t0 + stride - 1) / stride;
    if (ntok <= 0) return;
    LDS_AS unsigned char* wb = (LDS_AS unsigned char*)smem + wid * 18432;
    LDS_AS unsigned char* ring = wb + 16384;
    const unsigned char* ubase = p.u8 + (size_t)s * (16384 * 128) + ((c ^ q) * 16);
    const unsigned char* ubase1 = p.u8 + (size_t)s * (16384 * 128) + ((c ^ q ^ 1) * 16);
    const unsigned char* rsrc; unsigned rstr;
    if (lane < 32) { rsrc = (const unsigned char*)p.ids + lane * 16; rstr = 512; }
    else if (lane < 48) { rsrc = (const unsigned char*)p.y1b + s * 256 + (lane - 32) * 16; rstr = 2048; }
    else { rsrc = (const unsigned char*)p.stats + ((2 * s + 1) >> 2) * 16; rstr = 64; }
#define PM_TOK(n) (t0 + ((n) < ntok ? (n) : ntok - 1) * stride)
#define PM_RING(n) do { if (lane < 49) __builtin_amdgcn_global_load_lds((const unsigned*)(rsrc + (size_t)PM_TOK(n) * rstr), (LDS_AS unsigned*)(ring + ((n) & 1) * 1024), 16, 0, 0); } while (0)
#define PM_IDS(n, ia, ib) do { const LDS_AS u32x4* _q = (const LDS_AS u32x4*)(ring + ((n) & 1) * 1024 + q * 32); \
        const u32x4 _a0 = _q[0], _a1 = _q[1], _b0 = _q[16], _b1 = _q[17]; \
        ia[0] = _a0[0]; ia[1] = _a0[1]; ia[2] = _a0[2]; ia[3] = _a0[3]; ia[4] = _a1[0]; ia[5] = _a1[1]; ia[6] = _a1[2]; ia[7] = _a1[3]; \
        ib[0] = _b0[0]; ib[1] = _b0[1]; ib[2] = _b0[2]; ib[3] = _b0[3]; ib[4] = _b1[0]; ib[5] = _b1[1]; ib[6] = _b1[2]; ib[7] = _b1[3]; } while (0)
#define PM_DMA(i, id) __builtin_amdgcn_global_load_lds((const unsigned*)((((i) & 1) ? ubase1 : ubase) + (size_t)(id) * 128), (LDS_AS unsigned*)(wb + (i) * 1024), 16, 0, 0)
    const int key = (j & 7) ^ (j >> 3);
    const LDS_AS unsigned char* brd = wb + j * 128 + (((2 * kb) ^ key) * 16);
    const int bx1 = (key & 1) ? -16 : 16;
    const LDS_AS unsigned char* ard = ring + (j & 1) * 1024 + 832 + kb * 32;
    PM_RING(0); PM_RING(1);
    asm volatile("s_waitcnt vmcnt(0)" ::: "memory");
    {
        unsigned ia[8], ib[8]; PM_IDS(0, ia, ib);
#pragma unroll
        for (int m = 0; m < 4; ++m) { PM_DMA(2 * m, ia[m]); PM_DMA(2 * m + 1, ib[m]); }
#pragma unroll
        for (int m = 4; m < 8; ++m) { PM_DMA(2 * m, ia[m]); PM_DMA(2 * m + 1, ib[m]); }
    }
    const int sqi = ((2 * s + 1) & 3) * 4;
#pragma unroll 1
    for (int n = 0; n < ntok; ++n) {
        const int t = t0 + n * stride;
        LDS_AS unsigned char* slot = ring + (n & 1) * 1024;
        const unsigned xw = *(const LDS_AS unsigned*)(slot + 512 + lane * 4);
        const float ssq = *(const LDS_AS float*)(slot + 768 + sqi);
        const int e2 = (int)(__float_as_uint(ssq) >> 23) - 126;
        int eh = (e2 + 1) >> 1; eh = eh < -60 ? -60 : (eh > 60 ? 60 : eh);
        const float sc = __uint_as_float((unsigned)(127 + 8 - eh) << 23), isc = __uint_as_float((unsigned)(127 - 8 + eh) << 23);
        const float x0 = bflo(xw) * sc, x1 = bfhi(xw) * sc;
        const unsigned h8 = (unsigned)__builtin_amdgcn_cvt_pk_fp8_f32(x0, x1, 0, false);
        const f32x2 hd = __builtin_amdgcn_cvt_pk_f32_fp8((int)h8, false);
        const unsigned l8 = (unsigned)__builtin_amdgcn_cvt_pk_fp8_f32(x0 - hd.x, x1 - hd.y, 0, false);
        *(LDS_AS unsigned short*)(ring + 832 + lane * 2) = (unsigned short)h8;
        *(LDS_AS unsigned short*)(ring + 1024 + 832 + lane * 2) = (unsigned short)l8;
        const u32x4 xa0 = *(const LDS_AS u32x4*)(ard), xa1 = *(const LDS_AS u32x4*)(ard + 16);
        i64 xa[4];
        xa[0] = (i64)(((unsigned long long)xa0[1] << 32) | xa0[0]); xa[1] = (i64)(((unsigned long long)xa0[3] << 32) | xa0[2]);
        xa[2] = (i64)(((unsigned long long)xa1[1] << 32) | xa1[0]); xa[3] = (i64)(((unsigned long long)xa1[3] << 32) | xa1[2]);
        f32x4 acc[8];
        asm volatile("s_waitcnt vmcnt(8)" ::: "memory");
#pragma unroll
        for (int m = 0; m < 4; ++m) {
            const u32x4 b0 = *(const LDS_AS u32x4*)(brd + m * 2048), b1 = *(const LDS_AS u32x4*)(brd + m * 2048 + bx1);
            f32x4 a = {0.f, 0.f, 0.f, 0.f};
            a = __builtin_amdgcn_mfma_f32_16x16x32_fp8_fp8(xa[0], (i64)(((unsigned long long)b0[1] << 32) | b0[0]), a, 0, 0, 0);
            a = __builtin_amdgcn_mfma_f32_16x16x32_fp8_fp8(xa[1], (i64)(((unsigned long long)b0[3] << 32) | b0[2]), a, 0, 0, 0);
            a = __builtin_amdgcn_mfma_f32_16x16x32_fp8_fp8(xa[2], (i64)(((unsigned long long)b1[1] << 32) | b1[0]), a, 0, 0, 0);
            a = __builtin_amdgcn_mfma_f32_16x16x32_fp8_fp8(xa[3], (i64)(((unsigned long long)b1[3] << 32) | b1[2]), a, 0, 0, 0);
            acc[m] = a;
        }
        {
            unsigned ia[8], ib[8]; PM_IDS(n + 1, ia, ib);
            PM_RING(n + 2);
#pragma unroll
            for (int m = 0; m < 4; ++m) { PM_DMA(2 * m, ia[m]); PM_DMA(2 * m + 1, ib[m]); }
            asm volatile("s_waitcnt vmcnt(9)" ::: "memory");
#pragma unroll
            for (int m = 4; m < 8; ++m) {
                const u32x4 b0 = *(const LDS_AS u32x4*)(brd + m * 2048), b1 = *(const LDS_AS u32x4*)(brd + m * 2048 + bx1);
                f32x4 a = {0.f, 0.f, 0.f, 0.f};
                a = __builtin_amdgcn_mfma_f32_16x16x32_fp8_fp8(xa[0], (i64)(((unsigned long long)b0[1] << 32) | b0[0]), a, 0, 0, 0);
                a = __builtin_amdgcn_mfma_f32_16x16x32_fp8_fp8(xa[1], (i64)(((unsigned long long)b0[3] << 32) | b0[2]), a, 0, 0, 0);
                a = __builtin_amdgcn_mfma_f32_16x16x32_fp8_fp8(xa[2], (i64)(((unsigned long long)b1[1] << 32) | b1[0]), a, 0, 0, 0);
                a = __builtin_amdgcn_mfma_f32_16x16x32_fp8_fp8(xa[3], (i64)(((unsigned long long)b1[3] << 32) | b1[2]), a, 0, 0, 0);
                acc[m] = a;
            }
#pragma unroll
            for (int m = 4; m < 8; ++m) { PM_DMA(2 * m, ia[m]); PM_DMA(2 * m + 1, ib[m]); }
        }
        if (lane < 16) {
            u32x4 o;
#pragma unroll
            for (int k = 0; k < 4; ++k) o[k] = pack2((acc[2 * k][0] + acc[2 * k][1]) * isc, (acc[2 * k + 1][0] + acc[2 * k + 1][1]) * isc);
            *(u32x4*)(p.hp + ((size_t)t * 8 + s) * 128 + lane * 8) = o;
        }
    }
    asm volatile("s_waitcnt vmcnt(0)" ::: "memory");
}
__device__ void ph_peer_act(const Params& p, unsigned char* smem, const int vb) {
    const int lane = threadIdx.x & 63, wid = threadIdx.x >> 6;
    unsigned* lsc = (unsigned*)smem;
    LDS_AS unsigned char* img = (LDS_AS unsigned char*)smem + 65536 + wid * 256;
    __syncthreads();
    for (int i = threadIdx.x; i < 16384 / 4; i += 256) *(u32x4*)(lsc + 4 * i) = *(const u32x4*)((const unsigned*)p.sc2 + 4 * i);
    __syncthreads();
    const int e0 = 2 * lane, e1 = e0 + 1;
    const int ix0 = (e0 & 3) * 32 + ((e0 >> 2) & 3) * 8 + (e0 >> 4), ix1 = (e1 & 3) * 32 + ((e1 >> 2) & 3) * 8 + (e1 >> 4);
    for (int t = vb * 4 + wid; t < T_TOK; t += gridDim.x * 4) {
        f32x2 h = {0.f, 0.f};
#pragma unroll
        for (int s = 0; s < 8; ++s) { const unsigned w = *(const unsigned*)(p.hp + ((size_t)t * 8 + s) * 128 + 2 * lane); h += (f32x2){bflo(w), bfhi(w)}; }
        f32x2 pq = *(const f32x2*)(p.stats + (size_t)t * 16 + (lane & 7) * 2);
        pq.x += __shfl_xor(pq.x, 1); pq.y += __shfl_xor(pq.y, 1); pq.x += __shfl_xor(pq.x, 2); pq.y += __shfl_xor(pq.y, 2); pq.x += __shfl_xor(pq.x, 4); pq.y += __shfl_xor(pq.y, 4);
        const float mu = pq.x * (1.0f / 1024.0f), rstd = rsqrtf(fmaxf(pq.y * (1.0f / 1024.0f) - mu * mu, 0.f) + LN_EPS);
        int2 id = *(const int2*)(p.ids + (size_t)t * 128 + 2 * lane);
        id.x &= 0x3fff; id.y &= 0x3fff;
        const f32x2 gt = *(const f32x2*)(p.gates + (size_t)t * 128 + 2 * lane);
        const unsigned s0 = lsc[id.x], s1 = lsc[id.y];
        const unsigned c0 = p.cb2[id.x], c1 = p.cb2[id.y];
        f32x2 a;
        a.x = gelu_gate(rstd * (h.x * bflo(s0) - mu * bflo(c0)) + bfhi(c0), gt.x) * bfhi(s0);
        a.y = gelu_gate(rstd * (h.y * bflo(s1) - mu * bflo(c1)) + bfhi(c1), gt.y) * bfhi(s1);
        float am = fmaxf(fabsf(a.x), fabsf(a.y));
#pragma unroll
        for (int o = 32; o >= 1; o >>= 1) am = fmaxf(am, __shfl_xor(am, o));
        int be = (int)(__float_as_uint(am) >> 23); be = be < 20 ? 20 : (be > 240 ? 240 : be);
        const float sc = __uint_as_float((unsigned)(261 - be) << 23);
        const unsigned iscb = (unsigned)(be - 7) << 23;
        const float x0 = a.x * sc, x1 = a.y * sc;
        const unsigned h8 = (unsigned)__builtin_amdgcn_cvt_pk_fp8_f32(x0, x1, 0, false);
        const f32x2 hd = __builtin_amdgcn_cvt_pk_f32_fp8((int)h8, false);
        const unsigned l8 = (unsigned)__builtin_amdgcn_cvt_pk_fp8_f32(x0 - hd.x, x1 - hd.y, 0, false);
        img[ix0] = (unsigned char)h8; img[ix1] = (unsigned char)(h8 >> 8);
        img[128 + ix0] = (unsigned char)l8; img[128 + ix1] = (unsigned char)(l8 >> 8);
        const unsigned iw = *(const LDS_AS unsigned*)(img + lane * 4);
        *(unsigned*)((unsigned char*)p.gates + (size_t)t * 512 + lane * 4) = iw;
        if (lane < 3) {
            const unsigned pb = lane == 0 ? __float_as_uint(mu) : (lane == 1 ? __float_as_uint(rstd) : iscb);
            *(int2*)(p.ids + (size_t)t * 128 + 2 * lane) = make_int2(id.x | (int)(pb & 0xffff0000u), id.y | (int)(pb << 16));
        }
    }
}
typedef int v2i32 __attribute__((ext_vector_type(2)));
__device__ void ph_peer_v(const Params& p, unsigned char* smem, const int vb) {
    const int lane = threadIdx.x & 63, wid = __builtin_amdgcn_readfirstlane(threadIdx.x >> 6);
    const int q = lane >> 3, c = lane & 7, j = lane & 15, kb = lane >> 4;
    const int nlb = gridDim.x >> 3, s = vb / nlb, lb = vb - s * nlb;
    const int stride = nlb * 4, t0 = lb * 4 + wid;
    const int ntok = (T_TOK - t0 + stride - 1) / stride;
    if (ntok <= 0) return;
    LDS_AS unsigned char* wb = (LDS_AS unsigned char*)smem + wid * 18432;
    LDS_AS unsigned char* ring = wb + 16384;
    const unsigned char* vbase = p.v8 + (size_t)s * (16384 * 128) + ((c ^ q) * 16);
    const unsigned char* vbase1 = p.v8 + (size_t)s * (16384 * 128) + ((c ^ q ^ 1) * 16);
    const unsigned char* rsrc; unsigned rstr;
    if (lane < 32) { rsrc = (const unsigned char*)p.ids + lane * 16; rstr = 512; }
    else if (lane < 48) { rsrc = (const unsigned char*)p.gates + (lane - 32) * 16; rstr = 512; }
    else { rsrc = (const unsigned char*)p.y1b + s * 256 + (lane - 48) * 16; rstr = 2048; }
#define PV_RING(n) __builtin_amdgcn_global_load_lds((const unsigned*)(rsrc + (size_t)PM_TOK(n) * rstr), (LDS_AS unsigned*)(ring + ((n) & 1) * 1024), 16, 0, 0)
#define PV_IDS(n, idv) do { const LDS_AS u32x4* _q = (const LDS_AS u32x4*)(ring + ((n) & 1) * 1024 + q * 64); \
        _Pragma("unroll") for (int _k = 0; _k < 4; ++_k) { const u32x4 _v = _q[_k]; idv[4 * _k] = _v[0] & 0x3fffu; idv[4 * _k + 1] = _v[1] & 0x3fffu; idv[4 * _k + 2] = _v[2] & 0x3fffu; idv[4 * _k + 3] = _v[3] & 0x3fffu; } } while (0)
#define PV_DMA(i, id) __builtin_amdgcn_global_load_lds((const unsigned*)((((i) & 1) ? vbase1 : vbase) + (size_t)(id) * 128), (LDS_AS unsigned*)(wb + (i) * 1024), 16, 0, 0)
    const int key = (j >> 1) ^ (kb & 1);
    const LDS_AS unsigned char* tb = wb + (8 * kb + (j >> 1)) * 128 + (j & 1) * 8;
    const LDS_AS unsigned char* ard = ring + 512 + (j & 1) * 128 + kb * 32;
    const int dl = 32 * kb + (j & 1) * 16 + (j & 14), d0 = s * 128 + dl;
    const f32x2 g2 = *(const f32x2*)(p.ln1_g + d0), b2 = *(const f32x2*)(p.ln1_b + d0);
    PV_RING(0); PV_RING(1);
    asm volatile("s_waitcnt vmcnt(0)" ::: "memory");
    {
        unsigned idv[16]; PV_IDS(0, idv);
#pragma unroll
        for (int i = 0; i < 16; ++i) PV_DMA(i, idv[i]);
    }
#pragma unroll 1
    for (int n = 0; n < ntok; ++n) {
        const int t = t0 + n * stride;
        const LDS_AS unsigned char* slot = ring + (n & 1) * 1024;
        const u32x4 xa0 = *(const LDS_AS u32x4*)(ard + (n & 1) * 1024), xa1 = *(const LDS_AS u32x4*)(ard + (n & 1) * 1024 + 16);
        const u32x4 hd4 = *(const LDS_AS u32x4*)(slot);
        const unsigned hd5 = *(const LDS_AS unsigned*)(slot + 16);
        const unsigned yw = *(const LDS_AS unsigned*)(slot + 768 + dl * 2);
        i64 xa[4];
        xa[0] = (i64)(((unsigned long long)xa0[1] << 32) | xa0[0]); xa[1] = (i64)(((unsigned long long)xa0[3] << 32) | xa0[2]);
        xa[2] = (i64)(((unsigned long long)xa1[1] << 32) | xa1[0]); xa[3] = (i64)(((unsigned long long)xa1[3] << 32) | xa1[2]);
        const float mu = __uint_as_float((hd4[0] & 0xffff0000u) | (hd4[1] >> 16)), rs = __uint_as_float((hd4[2] & 0xffff0000u) | (hd4[3] >> 16));
        const float isc = __uint_as_float(hd5 & 0xffff0000u);
        f32x4 acc[8];
#pragma unroll
        for (int ct = 0; ct < 8; ++ct) acc[ct] = (f32x4){0.f, 0.f, 0.f, 0.f};
        asm volatile("s_waitcnt vmcnt(8)" ::: "memory");
#pragma unroll
        for (int ks = 0; ks < 2; ++ks)
#pragma unroll
            for (int ct = 0; ct < 8; ++ct) {
                const v2i32 bv = __builtin_amdgcn_ds_read_tr8_b64_v2i32((LDS_AS v2i32*)(tb + ks * 4096 + ((ct ^ key) << 4)));
                acc[ct] = __builtin_amdgcn_mfma_f32_16x16x32_fp8_fp8(xa[ks], (i64)(((unsigned long long)(unsigned)bv[1] << 32) | (unsigned)bv[0]), acc[ct], 0, 0, 0);
            }
        {
            unsigned idv[16]; PV_IDS(n + 1, idv);
            PV_RING(n + 2);
#pragma unroll
            for (int i = 0; i < 8; ++i) PV_DMA(i, idv[i]);
            asm volatile("s_waitcnt vmcnt(9)" ::: "memory");
#pragma unroll
            for (int ks = 2; ks < 4; ++ks)
#pragma unroll
                for (int ct = 0; ct < 8; ++ct) {
                    const v2i32 bv = __builtin_amdgcn_ds_read_tr8_b64_v2i32((LDS_AS v2i32*)(tb + ks * 4096 + ((ct ^ key) << 4)));
                    acc[ct] = __builtin_amdgcn_mfma_f32_16x16x32_fp8_fp8(xa[ks], (i64)(((unsigned long long)(unsigned)bv[1] << 32) | (unsigned)bv[0]), acc[ct], 0, 0, 0);
                }
#pragma unroll
            for (int i = 8; i < 16; ++i) PV_DMA(i, idv[i]);
        }
        float va, vc;
        {
            const float w0 = acc[0][0] + acc[0][1], w1 = acc[1][0] + acc[1][1], w2 = acc[2][0] + acc[2][1], w3 = acc[3][0] + acc[3][1];
            const float w4 = acc[4][0] + acc[4][1], w5 = acc[5][0] + acc[5][1], w6 = acc[6][0] + acc[6][1], w7 = acc[7][0] + acc[7][1];
            va = kb == 0 ? w0 : (kb == 1 ? w2 : (kb == 2 ? w4 : w6));
            vc = kb == 0 ? w1 : (kb == 1 ? w3 : (kb == 2 ? w5 : w7));
        }
        const bool od = (j & 1) != 0;
        const float got = __shfl_xor(od ? va : vc, 1);
        const float p0 = (od ? got : va) * isc, p1 = (od ? vc : got) * isc;
        const float r0 = ALPHA * ((bflo(yw) - mu) * rs * g2.x + b2.x) + p0, r1 = ALPHA * ((bfhi(yw) - mu) * rs * g2.y + b2.y) + p1;
        *(unsigned*)(p.rb + (size_t)t * DM + d0) = pack2(r0, r1);
    }
    asm volatile("s_waitcnt vmcnt(0)" ::: "memory");
}

__device__ void ph_gemm_ple(const Params& p, unsigned char* smem, const int vb) {
    const int ntn = DM / 128;
    const int tid = threadIdx.x, lane = tid & 63, wid = tid >> 6, wr = wid >> 1, wc = wid & 1, fr = lane & 15, fq = lane >> 4;
    const int ntiles = (T_TOK / 128) * ntn;
    bool pre = false;
    for (int t = vb; t < ntiles; t += gridDim.x) {
        const int m0 = (t / ntn) * 128, n0 = (t % ntn) * 128;
        const int tn = t + gridDim.x;
        const bool has_next = tn < ntiles;
        const bf16_t* nA = p.pb + (size_t)((has_next ? tn : t) / ntn) * 128 * 256;
        const bf16_t* nB = p.WpT + (size_t)((has_next ? tn : t) % ntn) * 128 * 256;
        const bf16_t* gA = p.rb + (size_t)m0 * DM; const bf16_t* gB = p.WgT + (size_t)n0 * DM;
        f32x4 acc[4][4], acc2[4][4]; zero_acc(acc); zero_acc(acc2);
        if (pre) gemm128<true, true>(p.pb + (size_t)m0 * 256, 256, p.WpT + (size_t)n0 * 256, 256, 256, smem, acc2, gA, DM, gB, DM);
        else     gemm128<false, true>(p.pb + (size_t)m0 * 256, 256, p.WpT + (size_t)n0 * 256, 256, 256, smem, acc2, gA, DM, gB, DM);
        if (has_next) gemm128<true, true>(gA, DM, gB, DM, DM, smem, acc, nA, 256, nB, 256);
        else          gemm128<true, false>(gA, DM, gB, DM, DM, smem, acc);
        pre = has_next;
#pragma unroll
        for (int mi = 0; mi < 4; ++mi) {
            const int row = m0 + wr * 64 + mi * 16 + fr;
#pragma unroll
            for (int ni = 0; ni < 4; ++ni) {
                const int col = n0 + wc * 64 + ni * 16 + fq * 4;
                const u32x2 rw = *(const u32x2*)(p.rb + (size_t)row * DM + col);
                f32x4 rv = {bflo(rw[0]), bfhi(rw[0]), bflo(rw[1]), bfhi(rw[1])};
#pragma unroll
                for (int r = 0; r < 4; ++r) rv[r] += sigmul(acc2[mi][ni][r], acc[mi][ni][r]);
                *(f32x4*)(p.out + (size_t)row * DM + col) = rv;
            }
        }
    }
}

#define XB_TMO      128
#define XB_XCNT(j)  (256  + 64 * (j))
#define XB_XSUB(j)  (1280 + 64 * (j))
#define XB_XGEN(j)  (2304 + 64 * (j))
#define XB_TOP      3328
#define XB_TOPGEN   3392
#define XCD_BAR_WORDS 3456
#define XB_CUCNT    (XCD_BAR_WORDS + 640 + 4096)
#define XB_SPIN_CAP (1u << 20)
__device__ __forceinline__ unsigned xb_ld(unsigned* p)              { return __hip_atomic_load(p, __ATOMIC_RELAXED, __HIP_MEMORY_SCOPE_AGENT); }
__device__ __forceinline__ unsigned xb_add(unsigned* p, unsigned v) { return __hip_atomic_fetch_add(p, v, __ATOMIC_RELAXED, __HIP_MEMORY_SCOPE_AGENT); }
__device__ __forceinline__ unsigned xb_xcc_id() { return (unsigned)__builtin_amdgcn_s_getreg((3 << 11) | 20) & 0xFu; }
#define XB_SPIN(cond, bar) do { unsigned _sp = 0; while (cond) { __builtin_amdgcn_s_sleep(1); \
    if ((++_sp & 255u) == 0u) { if (xb_ld(&(bar)[XB_TMO])) break; if (_sp > XB_SPIN_CAP) { atomicAdd(&(bar)[XB_TMO], 1u); break; } } } } while (0)
struct XcdBarrier { unsigned* bar; unsigned x; volatile LDS_AS unsigned* st; };
__device__ __forceinline__ XcdBarrier xcd_barrier_post(unsigned* bar, volatile LDS_AS unsigned* st) {
    XcdBarrier b; b.bar = bar; b.x = xb_xcc_id(); b.st = st;
    if (threadIdx.x == 0) {
        const unsigned key = ((unsigned)__builtin_amdgcn_s_getreg((7 << 11) | (8 << 6) | 4)) & 0xffu;
        st[4] = key;
        st[5] = xb_add(&bar[XB_CUCNT + b.x * 256u + key], 1u);
        asm volatile("s_waitcnt vmcnt(0)" ::: "memory");
        st[3] = xb_add(&bar[XB_XCNT(b.x)], 1u);
    }
    return b;
}
__device__ __forceinline__ void xcd_barrier_complete(unsigned* bar, unsigned x, unsigned rank, unsigned& nloc, unsigned& nx, unsigned& vb, unsigned& ev) {
    const unsigned G = gridDim.x;
    unsigned sum, cnt, mine, sp = 0u; bool even;
    for (;;) {
        sum = 0u; cnt = 0u; mine = 0u; even = true;
#pragma unroll
        for (unsigned j = 0; j < 16; ++j) {
            const unsigned c = xb_ld(&bar[XB_XCNT(j)]); sum += c; cnt += (c > 0u) ? 1u : 0u; mine = (j == x) ? c : mine;
            even = even && (c == ((j < 8u) ? (G >> 3) : 0u));
        }
        if (sum == G) break;
        __builtin_amdgcn_s_sleep(1);
        if ((++sp & 255u) == 0u) { if (xb_ld(&bar[XB_TMO])) break; if (sp > XB_SPIN_CAP) { atomicAdd(&bar[XB_TMO], 1u); break; } }
    }
    nloc = mine > 0u ? mine : 1u; nx = cnt > 0u ? cnt : 1u;
    ev = (even && sum == G && (G & 7u) == 0u) ? 1u : 0u;
    vb = ev ? (x * (G >> 3) + rank) : blockIdx.x;
}
__device__ __forceinline__ void xcd_barrier(const XcdBarrier& b) {
    asm volatile("s_waitcnt vmcnt(0)" ::: "memory");
    __syncthreads();
    if (threadIdx.x == 0) {
        unsigned* bar = b.bar;
        __builtin_amdgcn_s_waitcnt(0);
        unsigned nloc = b.st[0], nx = b.st[1];
        if (nloc == 0u) { unsigned vb, ev; xcd_barrier_complete(bar, b.x, b.st[3], nloc, nx, vb, ev); b.st[0] = nloc; b.st[1] = nx; b.st[2] = vb; b.st[6] = ev; }
        const unsigned old = xb_add(&bar[XB_XSUB(b.x)], 1u);
        const unsigned gen = old / nloc;
        if (old + 1u == (gen + 1u) * nloc) {
            __builtin_amdgcn_fence(__ATOMIC_RELEASE, "agent");
            asm volatile("s_waitcnt vmcnt(0)" ::: "memory");
            const unsigned og = xb_add(&bar[XB_TOP], 1u);
            const unsigned tg = og / nx;
            if (og + 1u == (tg + 1u) * nx) xb_add(&bar[XB_TOPGEN], 1u);
            else XB_SPIN(xb_ld(&bar[XB_TOPGEN]) == tg, bar);
            __builtin_amdgcn_fence(__ATOMIC_ACQUIRE, "agent");
            xb_add(&bar[XB_XGEN(b.x)], 1u);
            asm volatile("s_waitcnt vmcnt(0)" ::: "memory");
        } else {
            XB_SPIN(xb_ld(&bar[XB_XGEN(b.x)]) == gen, bar);
            __builtin_amdgcn_fence(__ATOMIC_ACQUIRE, "agent");
            asm volatile("s_waitcnt vmcnt(0)" ::: "memory");
        }
    }
    __syncthreads();
}

__device__ int cu_pair_vb(unsigned* bar, unsigned x, volatile LDS_AS unsigned* st, unsigned char* smem, int vb_old) {
    const unsigned G = gridDim.x, wid = threadIdx.x >> 6;
    const unsigned c = xb_ld(&bar[XB_CUCNT + x * 256u + threadIdx.x]);
    const unsigned long long has = __ballot(c > 0u), bad = __ballot(c != 0u && c != 2u);
    unsigned long long* m = (unsigned long long*)smem;
    __syncthreads();
    if ((threadIdx.x & 63) == 0) { m[wid] = has; m[4 + wid] = bad; }
    __syncthreads();
    const unsigned key = st[4], slot = st[5], ev = st[6];
    unsigned rank = 0u, npop = 0u; bool anybad = false;
#pragma unroll
    for (unsigned w = 0; w < 4; ++w) {
        const unsigned long long mk = m[w];
        npop += (unsigned)__popcll(mk); anybad = anybad || (m[4 + w] != 0ull);
        if (key >= w * 64u + 64u) rank += (unsigned)__popcll(mk);
        else if (key >= w * 64u) rank += (unsigned)__popcll(mk & ((1ull << (key - w * 64u)) - 1ull));
    }
    __syncthreads();
    const bool valid = ev != 0u && !anybad && npop * 2u == (G >> 3) && slot < 2u;
    return valid ? (int)(x * (G >> 3) + 2u * rank + slot) : vb_old;
}

#define SMEM_PHASE (256 * ASTR * 2 * 2)
#define SMEM_BYTES (SMEM_PHASE + 32)
__global__ void __launch_bounds__(256, 2) mega(Params p) {
    __shared__ __attribute__((aligned(16))) unsigned char smem[SMEM_BYTES];
    volatile LDS_AS unsigned* st = (volatile LDS_AS unsigned*)(LDS_AS unsigned char*)(smem + SMEM_PHASE);
    if (threadIdx.x < 8) st[threadIdx.x] = 0u;
    __syncthreads();
    const XcdBarrier gb = xcd_barrier_post(p.bar, st);
    ph_prep(p, smem);            xcd_barrier(gb);
    const int vb = cu_pair_vb(p.bar, gb.x, st, smem, (int)st[2]);
    ph_gemm_in(p, smem, vb);     xcd_barrier(gb);
    ph_attn(p, smem, vb);
    ph_conv(p, smem, vb);        xcd_barrier(gb);
    ph_mprep(p, smem, vb);
    ph_gemm_out(p, smem, vb);    xcd_barrier(gb);
    ph_route(p, smem, vb);       xcd_barrier(gb);
    ph_peer_u(p, smem, vb);      xcd_barrier(gb);
    ph_peer_act(p, smem, vb);    xcd_barrier(gb);
    ph_peer_v(p, smem, vb);      xcd_barrier(gb);
    ph_gemm_ple(p, smem, vb);    xcd_barrier(gb);
    ph_ln2(p, vb);
}

extern "C" void kernel_launch(void* const* d_in, const int* in_sizes, int n_in, void* d_out, int out_size, void* d_ws, size_t ws_size,
                              hipStream_t stream) {
    Params p{};
    p.x = (const float*)d_in[0]; p.p = (const float*)d_in[1]; p.pos = (const int*)d_in[2];
    p.w_in = (const float*)d_in[3]; p.sinks = (const float*)d_in[4]; p.conv_w = (const float*)d_in[5]; p.conv_b = (const float*)d_in[6];
    p.cln_g = (const float*)d_in[7]; p.cln_b = (const float*)d_in[8]; p.w_out = (const float*)d_in[9]; p.ln1_g = (const float*)d_in[10];
    p.ln1_b = (const float*)d_in[11]; p.wq = (const float*)d_in[12]; p.keys = (const float*)d_in[13]; p.pu = (const float*)d_in[14];
    p.pv = (const float*)d_in[15]; p.ple_proj = (const float*)d_in[16]; p.ple_gate = (const float*)d_in[17]; p.ln2_g = (const float*)d_in[18];
    p.ln2_b = (const float*)d_in[19];
    p.out = (float*)d_out;
    unsigned char* ws = (unsigned char*)d_ws;
    const size_t MiB = 1024 * 1024;
    p.y1 = (float*)(ws + 0 * MiB);
    p.hb = (bf16_t*)(ws + 128 * MiB);
    p.hp = (bf16_t*)(ws + 128 * MiB);
    p.xb = (bf16_t*)(ws + 256 * MiB);
    p.mixb = (bf16_t*)(ws + 320 * MiB);
    p.rb = (bf16_t*)(ws + 320 * MiB);
    p.pb = (bf16_t*)(ws + 384 * MiB);
    p.u8 = (unsigned char*)(ws + 400 * MiB);
    p.v8 = (unsigned char*)(ws + 416 * MiB);
    p.sc2 = (bf16_t*)(ws + 432 * MiB);
    p.rope = (float*)(ws + 434 * MiB);
    p.stats = (float*)(ws + 436 * MiB);
    p.cb2 = (unsigned*)(ws + 438 * MiB);
    p.mext = (bf16_t*)(ws + 440 * MiB);
    p.yext = (bf16_t*)(ws + 442 * MiB);
    p.y1b = (bf16_t*)(ws + 0 * MiB);
    p.ids = (int*)(ws + 464 * MiB);
    p.gates = (float*)(ws + 480 * MiB);
    unsigned char* wb = ws + 496 * MiB;
    p.WinT = (bf16_t*)wb; wb += (size_t)INW * DM * 2;
    p.WoutT = (bf16_t*)wb; wb += (size_t)DM * DM * 2;
    p.WgT = (bf16_t*)wb; wb += (size_t)DM * DM * 2;
    p.WpT = (bf16_t*)wb; wb += (size_t)DM * 256 * 2;
    p.keysb = (bf16_t*)wb; wb += (size_t)16 * 128 * 128 * 2;
    p.Wqb = (bf16_t*)(ws + 240 * MiB);
    p.MT = (bf16_t*)(ws + 244 * MiB);
    p.bar = (unsigned*)(ws + 510 * MiB);
    p.wgb = (float*)(p.bar + XCD_BAR_WORDS + 640);

    static int grid_blocks = 0;
    if (!grid_blocks) {
        int dev = 0, cus = 0, per_cu = 0;
        (void)hipGetDevice(&dev);
        (void)hipDeviceGetAttribute(&cus, hipDeviceAttributeMultiprocessorCount, dev);
        (void)hipOccupancyMaxActiveBlocksPerMultiprocessor(&per_cu, mega, 256, 0);
        if (per_cu > 2) per_cu = 2;
        grid_blocks = cus * per_cu;
    }
    (void)hipMemsetAsync(p.bar, 0, (XCD_BAR_WORDS + 640 + 4096 + 2048) * sizeof(unsigned), stream);
    void* args[] = {&p};
    hipError_t e = hipLaunchCooperativeKernel((void*)mega, dim3(grid_blocks), dim3(256), args, 0, stream);
    if (e != hipSuccess) fprintf(stderr, "cooperative launch failed: %s (grid %d)\n", hipGetErrorString(e), grid_blocks);
}
```

```cpp
#include <hip/hip_runtime.h>
#include <stdint.h>
#include <cstdio>

typedef unsigned short bf16_t;
typedef short bf16x8 __attribute__((ext_vector_type(8)));
typedef float f32x4 __attribute__((ext_vector_type(4)));
typedef unsigned u32x4 __attribute__((ext_vector_type(4)));
typedef float f32x2 __attribute__((ext_vector_type(2)));
typedef long i64;

#define T_TOK 32768
#define SEQ 2048
#define DM 1024
#define INW 1792
#define ALPHA 1.189207115002721f
#define LN_EPS 1e-5f

__device__ __forceinline__ bf16_t f2bf(float f) {
    unsigned u = __float_as_uint(f);
    u += 0x7fffu + ((u >> 16) & 1u);
    return (bf16_t)(u >> 16);
}
__device__ __forceinline__ float bf2f(bf16_t b) { return __uint_as_float(((unsigned)b) << 16); }
__device__ __forceinline__ float bflo(unsigned w) { return __uint_as_float(w << 16); }
__device__ __forceinline__ float bfhi(unsigned w) { return __uint_as_float(w & 0xffff0000u); }
__device__ __forceinline__ unsigned pack2(float a, float b) { return (unsigned)f2bf(a) | ((unsigned)f2bf(b) << 16); }

__device__ __forceinline__ float sigmul(float x, float g) { return x * __builtin_amdgcn_rcpf(1.0f + __expf(-g)); }
__device__ __forceinline__ float wave_sum(float v) {
#pragma unroll
    for (int o = 32; o >= 1; o >>= 1) v += __shfl_xor(v, o);
    return v;
}

struct Params {
    const float *x, *p; const int* pos;
    const float *w_in, *sinks, *conv_w, *conv_b, *cln_g, *cln_b, *w_out, *ln1_g, *ln1_b;
    const float *wq, *keys, *pu, *pv, *ple_proj, *ple_gate, *ln2_g, *ln2_b;
    float* out;
    bf16_t *xb, *pb, *WinT, *WoutT, *WgT, *WpT, *keysb, *Wqb, *MT, *hb, *mixb, *rb;
    float *y1, *gates, *rope, *stats, *wgb;
    bf16_t *y1b, *yext, *mext; unsigned* cb2;
    bf16_t* sc2;
    bf16_t* hp;
    int *ids;
    unsigned char *u8, *v8;
    unsigned* bar;
};

__device__ void cvt_rows(const float* __restrict__ src, bf16_t* __restrict__ dst, size_t n) {
    const size_t nv = n / 8, gs = (size_t)gridDim.x * blockDim.x;
    for (size_t i = (size_t)blockIdx.x * blockDim.x + threadIdx.x; i < nv; i += 4 * gs) {
        f32x4 a[4], b[4];
#pragma unroll
        for (int q = 0; q < 4; ++q) { const size_t k = (i + q * gs < nv) ? i + q * gs : i; a[q] = ((const f32x4*)src)[2 * k]; b[q] = ((const f32x4*)src)[2 * k + 1]; }
#pragma unroll
        for (int q = 0; q < 4; ++q) {
            if (i + q * gs < nv) {
                u32x4 o; o[0] = pack2(a[q][0], a[q][1]); o[1] = pack2(a[q][2], a[q][3]); o[2] = pack2(b[q][0], b[q][1]); o[3] = pack2(b[q][2], b[q][3]);
                ((u32x4*)dst)[i + q * gs] = o;
            }
        }
    }
}
__device__ __forceinline__ int win_row(int n) {
    if (n < 768) return n;
    const int isg = n >= 1280 ? 1 : 0, c = n - (isg ? 1280 : 768);
    const int tt = c >> 6, wc = (c >> 5) & 1, k2 = (c >> 4) & 1, rest = c & 15;
    return 768 + 128 * tt + wc * 64 + (k2 * 2 + isg) * 16 + rest;
}
template <bool WIN = false>
__device__ void transpose_cvt(const float* __restrict__ W, bf16_t* __restrict__ Wt, int K, int N, float* tile  ) {
    const int tk = K / 64, tn = N / 64;
    const int tid = threadIdx.x;
    for (int t = blockIdx.x; t < tk * tn; t += gridDim.x) {
        const int k0 = (t / tn) * 64, n0 = (t % tn) * 64;
        f32x4 v[4];
#pragma unroll
        for (int i = 0; i < 4; ++i) v[i] = *(const f32x4*)(W + (size_t)(k0 + (tid >> 4) + 16 * i) * N + n0 + (tid & 15) * 4);
        __syncthreads();
#pragma unroll
        for (int i = 0; i < 4; ++i)
#pragma unroll
            for (int j = 0; j < 4; ++j) tile[((tid >> 4) + 16 * i) * 65 + (tid & 15) * 4 + j] = v[i][j];
        __syncthreads();
        const int n = tid >> 2, kc = (tid & 3) * 16;
        u32x4 o0, o1;
#pragma unroll
        for (int q = 0; q < 4; ++q) {
            o0[q] = pack2(tile[(kc + 2 * q) * 65 + n], tile[(kc + 2 * q + 1) * 65 + n]);
            o1[q] = pack2(tile[(kc + 8 + 2 * q) * 65 + n], tile[(kc + 8 + 2 * q + 1) * 65 + n]);
        }
        const int nd = WIN ? win_row(n0 + n) : n0 + n;
        *(u32x4*)(Wt + (size_t)nd * K + k0 + kc) = o0;
        *(u32x4*)(Wt + (size_t)nd * K + k0 + kc + 8) = o1;
    }
}
__device__ void cvt_wq_fold(const Params& p, unsigned char* smem) {
    for (int i = blockIdx.x * 256 + threadIdx.x; i < DM * 256; i += gridDim.x * 256) {
        const int d = i >> 8, c8 = (i & 255) * 8;
        const float gd = p.ln1_g[d];
        const f32x4 a = *(const f32x4*)(p.wq + (size_t)d * 2048 + c8), b = *(const f32x4*)(p.wq + (size_t)d * 2048 + c8 + 4);
        u32x4 o; o[0] = pack2(a[0] * gd, a[1] * gd); o[1] = pack2(a[2] * gd, a[3] * gd); o[2] = pack2(b[0] * gd, b[1] * gd); o[3] = pack2(b[2] * gd, b[3] * gd);
        *(u32x4*)(p.Wqb + (size_t)d * 2048 + c8) = o;
    }
    float* red = (float*)smem;
    const int lane = threadIdx.x & 63, wid = threadIdx.x >> 6;
    for (int cb = blockIdx.x; cb < 512; cb += gridDim.x) {
        f32x4 sg = {0.f, 0.f, 0.f, 0.f}, sb = {0.f, 0.f, 0.f, 0.f};
#pragma unroll
        for (int q = 0; q < 4; ++q) {
            const int d = threadIdx.x * 4 + q;
            const f32x4 v = *(const f32x4*)(p.wq + (size_t)d * 2048 + cb * 4);
            sg += v * p.ln1_g[d]; sb += v * p.ln1_b[d];
        }
        __syncthreads();
#pragma unroll
        for (int q = 0; q < 4; ++q) {
            const float a = wave_sum(sg[q]), b = wave_sum(sb[q]);
            if (lane == 0) { red[wid * 8 + q] = a; red[wid * 8 + 4 + q] = b; }
        }
        __syncthreads();
        if (threadIdx.x < 8) {
            const float t = (red[threadIdx.x] + red[8 + threadIdx.x]) + (red[16 + threadIdx.x] + red[24 + threadIdx.x]);
            p.wgb[(threadIdx.x >> 2) * 2048 + cb * 4 + (threadIdx.x & 3)] = t;
        }
    }
}
template <bool FOLD>
__device__ void cvt_table_fp8(const Params& p, const float* __restrict__ src, unsigned char* __restrict__ dst, bf16_t* __restrict__ scl, int rows) {
    const int lane = threadIdx.x & 63, wid = threadIdx.x >> 6;
    const int nw = gridDim.x * 4;
    for (int r0 = blockIdx.x * 4 + wid; r0 < rows; r0 += 4 * nw) {
        f32x4 v[4][4];
#pragma unroll
        for (int q = 0; q < 4; ++q) {
            const int r = (r0 + q * nw < rows) ? r0 + q * nw : r0;
            const float* sr = src + (size_t)r * DM + lane * 16;
#pragma unroll
            for (int k = 0; k < 4; ++k) v[q][k] = *(const f32x4*)(sr + 4 * k);
        }
        f32x4 gv[4], bv[4];
        if (FOLD) {
#pragma unroll
            for (int k = 0; k < 4; ++k) { gv[k] = *(const f32x4*)(p.ln1_g + lane * 16 + 4 * k); bv[k] = *(const f32x4*)(p.ln1_b + lane * 16 + 4 * k); }
        }
#pragma unroll
        for (int q = 0; q < 4; ++q) {
            const int r = r0 + q * nw;
            if (FOLD) {
                float cu = 0.f, bu = 0.f;
#pragma unroll
                for (int k = 0; k < 4; ++k) { bu += (bv[k][0] * v[q][k][0] + bv[k][1] * v[q][k][1]) + (bv[k][2] * v[q][k][2] + bv[k][3] * v[q][k][3]); v[q][k] = v[q][k] * gv[k]; cu += (v[q][k][0] + v[q][k][1]) + (v[q][k][2] + v[q][k][3]); }
                cu = wave_sum(cu); bu = wave_sum(bu);
                if (lane == 0 && r < rows) p.cb2[r] = pack2(cu, bu);
            }
            float m = 0.f;
#pragma unroll
            for (int k = 0; k < 4; ++k)
#pragma unroll
                for (int i = 0; i < 4; ++i) m = fmaxf(m, fabsf(v[q][k][i]));
#pragma unroll
            for (int o = 32; o >= 1; o >>= 1) m = fmaxf(m, __shfl_xor(m, o));
            int ex = (m > 0.f) ? (8 - (int)((__float_as_uint(m) >> 23) & 0xffu) + 127 - ((__float_as_uint(m) & 0x7fffffu) > 0x600000u ? 1 : 0)) : 0;
            ex = min(max(ex, -100), 100);
            const float sc = __uint_as_float((unsigned)(127 + ex) << 23);
            u32x4 w;
#pragma unroll
            for (int k = 0; k < 4; ++k)
                w[k] = __builtin_amdgcn_cvt_pk_fp8_f32(v[q][k][2] * sc, v[q][k][3] * sc, __builtin_amdgcn_cvt_pk_fp8_f32(v[q][k][0] * sc, v[q][k][1] * sc, 0, false), true);
            if (r < rows) {
                *(u32x4*)(dst + (size_t)(lane >> 3) * (16384 * 128) + (size_t)r * 128 + (lane & 7) * 16) = w;
                if (lane == 0) scl[2 * r] = (bf16_t)(((unsigned)(127 - ex) << 23) >> 16);
            }
        }
    }
}
__device__ void ph_prep(const Params& p, unsigned char* smem) {
    float* tile = (float*)smem;
    cvt_rows(p.x, p.xb, (size_t)T_TOK * DM);
    cvt_rows(p.p, p.pb, (size_t)T_TOK * 256);
    cvt_table_fp8<true>(p, p.pu, p.u8, p.sc2, 16384);
    cvt_table_fp8<false>(p, p.pv, p.v8, p.sc2 + 1, 16384);
    cvt_rows(p.keys, p.keysb, (size_t)16 * 128 * 128);
    for (int i = blockIdx.x * 256 + threadIdx.x; i < T_TOK * 8; i += gridDim.x * 256) {
        const int t = i >> 3, j = i & 7;
        const float inv = powf(500000.0f, -(float)j * 0.125f);
        float sn, cs; sincosf((float)p.pos[t] * inv, &sn, &cs);
        p.rope[t * 16 + j] = cs; p.rope[t * 16 + 8 + j] = sn;
    }
    transpose_cvt<true>(p.w_in, p.WinT, DM, INW, tile);
    transpose_cvt(p.w_out, p.WoutT, DM, DM, tile);
    cvt_wq_fold(p, smem);
    transpose_cvt(p.ple_gate, p.WgT, DM, DM, tile);
    transpose_cvt(p.ple_proj, p.WpT, 256, DM, tile);
}

#define LDS_AS __attribute__((address_space(3)))
#define GEMM_STAGE 32768
template <bool PRE = false, bool NEXT = false>
__device__ __forceinline__ void gemm128(const bf16_t* __restrict__ A, int lda, const bf16_t* __restrict__ Bt, int ldb, int K,
                                        unsigned char* smem, f32x4 (&acc)[4][4],
                                        const bf16_t* __restrict__ nA = nullptr, int nlda = 0, const bf16_t* __restrict__ nB = nullptr, int nldb = 0) {
    LDS_AS unsigned char* lds = (LDS_AS unsigned char*)smem;
    const int tid = threadIdx.x, lane = tid & 63, wid = __builtin_amdgcn_readfirstlane(tid >> 6);
    const int wr = wid >> 1, wc = wid & 1, fr = lane & 15, fq = lane >> 4;
    const int nk = K / 64;
    const int prow = lane >> 3, pc = (lane & 7) ^ prow;
    const bf16_t* gA = A + (size_t)(wid * 32 + prow) * lda + pc * 8;
    const bf16_t* gB = Bt + (size_t)(wid * 32 + prow) * ldb + pc * 8;
    const size_t a8 = (size_t)8 * lda, b8 = (size_t)8 * ldb;
#define GEMM_ISSUE(kt, st) do { \
        _Pragma("unroll") for (int _i = 0; _i < 4; ++_i) { \
            __builtin_amdgcn_global_load_lds((const unsigned*)(gA + _i * a8 + (size_t)(kt) * 64), (LDS_AS unsigned*)(lds + (st) * GEMM_STAGE + (wid * 4 + _i) * 1024), 16, 0, 0); \
            __builtin_amdgcn_global_load_lds((const unsigned*)(gB + _i * b8 + (size_t)(kt) * 64), (LDS_AS unsigned*)(lds + (st) * GEMM_STAGE + 16384 + (wid * 4 + _i) * 1024), 16, 0, 0); \
        } } while (0)
    const int swz0 = ((0 * 4 + fq) ^ (fr & 7)) * 16, swz1 = ((1 * 4 + fq) ^ (fr & 7)) * 16;
    const int aoff = (wr * 64 + fr) * 128, boff = 16384 + (wc * 64 + fr) * 128;
    if (!PRE) GEMM_ISSUE(0, 0);
#pragma unroll 1
    for (int kt = 0; kt < nk; ++kt) {
        const int st = kt & 1;
        asm volatile("s_waitcnt vmcnt(0)" ::: "memory");
        __builtin_amdgcn_s_barrier();
        asm volatile("" ::: "memory");
        if (kt + 1 < nk) GEMM_ISSUE(kt + 1, st ^ 1);
        else if (NEXT) {
            const bf16_t* qA = nA + (size_t)(wid * 32 + prow) * nlda + pc * 8;
            const bf16_t* qB = nB + (size_t)(wid * 32 + prow) * nldb + pc * 8;
#pragma unroll
            for (int _i = 0; _i < 4; ++_i) {
                __builtin_amdgcn_global_load_lds((const unsigned*)(qA + (size_t)(_i * 8) * nlda), (LDS_AS unsigned*)(lds + (wid * 4 + _i) * 1024), 16, 0, 0);
                __builtin_amdgcn_global_load_lds((const unsigned*)(qB + (size_t)(_i * 8) * nldb), (LDS_AS unsigned*)(lds + 16384 + (wid * 4 + _i) * 1024), 16, 0, 0);
            }
        }
        const LDS_AS unsigned char* sb = lds + st * GEMM_STAGE;
        bf16x8 af0[4], bf0[4], af1[4], bf1[4];
#pragma unroll
        for (int mi = 0; mi < 4; ++mi) af0[mi] = *(const LDS_AS bf16x8*)(sb + aoff + mi * 2048 + swz0);
#pragma unroll
        for (int ni = 0; ni < 4; ++ni) bf0[ni] = *(const LDS_AS bf16x8*)(sb + boff + ni * 2048 + swz0);
#pragma unroll
        for (int mi = 0; mi < 4; ++mi) af1[mi] = *(const LDS_AS bf16x8*)(sb + aoff + mi * 2048 + swz1);
#pragma unroll
        for (int ni = 0; ni < 4; ++ni) bf1[ni] = *(const LDS_AS bf16x8*)(sb + boff + ni * 2048 + swz1);
#pragma unroll
        for (int mi = 0; mi < 4; ++mi)
#pragma unroll
            for (int ni = 0; ni < 4; ++ni)
                acc[mi][ni] = __builtin_amdgcn_mfma_f32_16x16x32_bf16(bf0[ni], af0[mi], acc[mi][ni], 0, 0, 0);
#pragma unroll
        for (int mi = 0; mi < 4; ++mi)
#pragma unroll
            for (int ni = 0; ni < 4; ++ni)
                acc[mi][ni] = __builtin_amdgcn_mfma_f32_16x16x32_bf16(bf1[ni], af1[mi], acc[mi][ni], 0, 0, 0);
        __builtin_amdgcn_sched_group_barrier(0x100, 8, 0);
#pragma unroll
        for (int q = 0; q < 8; ++q) { __builtin_amdgcn_sched_group_barrier(0x008, 2, 0); __builtin_amdgcn_sched_group_barrier(0x100, 1, 0); }
        __builtin_amdgcn_sched_group_barrier(0x008, 16, 0);
        asm volatile("s_waitcnt lgkmcnt(0)" ::: "memory");
        __builtin_amdgcn_s_barrier();
        asm volatile("" ::: "memory");
    }
#undef GEMM_ISSUE
}
#define GW_STAGE 24576
__device__ __forceinline__ void gemmW(const bf16_t* __restrict__ A, int lda, const bf16_t* __restrict__ Bt, int ldb, int K,
                                      unsigned char* smem, f32x4 (&acc)[4][8]) {
    LDS_AS unsigned char* lds = (LDS_AS unsigned char*)smem;
    const int tid = threadIdx.x, lane = tid & 63, wid = __builtin_amdgcn_readfirstlane(tid >> 6);
    const int wr = wid >> 1, wc = wid & 1, fr = lane & 15, fq = lane >> 4;
    const int nk = K / 32;
    const int prow = lane >> 2, pc = (lane & 3) ^ ((4 - ((prow >> 2) & 3)) & 3);
    const bf16_t* gA = A + (size_t)(wid * 32 + prow) * lda + pc * 8;
    const bf16_t* gB = Bt + (size_t)(wid * 64 + prow) * ldb + pc * 8;
    const size_t a16 = (size_t)16 * lda, b16 = (size_t)16 * ldb;
#define GW_ISSUE(kt, st) do { \
        _Pragma("unroll") for (int _i = 0; _i < 2; ++_i) \
            __builtin_amdgcn_global_load_lds((const unsigned*)(gA + _i * a16 + (size_t)(kt) * 32), (LDS_AS unsigned*)(lds + (st) * GW_STAGE + (wid * 2 + _i) * 1024), 16, 0, 0); \
        _Pragma("unroll") for (int _i = 0; _i < 4; ++_i) \
            __builtin_amdgcn_global_load_lds((const unsigned*)(gB + _i * b16 + (size_t)(kt) * 32), (LDS_AS unsigned*)(lds + (st) * GW_STAGE + 8192 + (wid * 4 + _i) * 1024), 16, 0, 0); \
        } while (0)
    const int swz = (fq ^ ((4 - ((fr >> 2) & 3)) & 3)) * 16;
    const int aoff = (wr * 64 + fr) * 64 + swz, boff = 8192 + (wc * 128 + fr) * 64 + swz;
    GW_ISSUE(0, 0);
#pragma unroll 1
    for (int kt = 0; kt < nk; ++kt) {
        const int st = kt & 1;
        asm volatile("s_waitcnt vmcnt(0)" ::: "memory");
        __builtin_amdgcn_s_barrier();
        asm volatile("" ::: "memory");
        if (kt + 1 < nk) GW_ISSUE(kt + 1, st ^ 1);
        const LDS_AS unsigned char* sb = lds + st * GW_STAGE;
        bf16x8 af[4], bfr[8];
#pragma unroll
        for (int mi = 0; mi < 4; ++mi) af[mi] = *(const LDS_AS bf16x8*)(sb + aoff + mi * 1024);
#pragma unroll
        for (int ni = 0; ni < 8; ++ni) bfr[ni] = *(const LDS_AS bf16x8*)(sb + boff + ni * 1024);
#pragma unroll
        for (int ni = 0; ni < 8; ++ni)
#pragma unroll
            for (int mi = 0; mi < 4; ++mi)
                acc[mi][ni] = __builtin_amdgcn_mfma_f32_16x16x32_bf16(bfr[ni], af[mi], acc[mi][ni], 0, 0, 0);
        asm volatile("s_waitcnt lgkmcnt(0)" ::: "memory");
        __builtin_amdgcn_s_barrier();
        asm volatile("" ::: "memory");
    }
#undef GW_ISSUE
}
__device__ __forceinline__ void zero_accw(f32x4 (&acc)[4][8]) {
#pragma unroll
    for (int a = 0; a < 4; ++a)
#pragma unroll
        for (int b = 0; b < 8; ++b) acc[a][b] = (f32x4){0.f, 0.f, 0.f, 0.f};
}
__device__ __forceinline__ void zero_acc(f32x4 (&acc)[4][4]) {
#pragma unroll
    for (int a = 0; a < 4; ++a)
#pragma unroll
        for (int b = 0; b < 4; ++b) acc[a][b] = (f32x4){0.f, 0.f, 0.f, 0.f};
}
#define GEMM_SMEM (2 * GEMM_STAGE)

__device__ void ph_gemm_in(const Params& p, unsigned char* smem, const int vb) {
    const int ntn = INW / 128;
    const int tid = threadIdx.x, lane = tid & 63, wid = tid >> 6, wr = wid >> 1, wc = wid & 1, fr = lane & 15, fq = lane >> 4;
    const int ntiles = (T_TOK / 128) * ntn;
    bool pre = false;
    for (int t = vb; t < ntiles; t += gridDim.x) {
        const int m0 = (t / ntn) * 128, n0 = (t % ntn) * 128;
        const int tn = t + gridDim.x;
        const bool has_next = tn < ntiles;
        const bf16_t* nA = p.xb + (size_t)((has_next ? tn : t) / ntn) * 128 * DM;
        const bf16_t* nB = p.WinT + (size_t)((has_next ? tn : t) % ntn) * 128 * DM;
        f32x4 acc[4][4]; zero_acc(acc);
        if (pre) { if (has_next) gemm128<true, true>(p.xb + (size_t)m0 * DM, DM, p.WinT + (size_t)n0 * DM, DM, DM, smem, acc, nA, DM, nB, DM);
                   else          gemm128<true, false>(p.xb + (size_t)m0 * DM, DM, p.WinT + (size_t)n0 * DM, DM, DM, smem, acc); }
        else     { if (has_next) gemm128<false, true>(p.xb + (size_t)m0 * DM, DM, p.WinT + (size_t)n0 * DM, DM, DM, smem, acc, nA, DM, nB, DM);
                   else          gemm128<false, false>(p.xb + (size_t)m0 * DM, DM, p.WinT + (size_t)n0 * DM, DM, DM, smem, acc); }
        pre = has_next;
        if (n0 >= 768) {
            const int cb = ((n0 - 768) >> 7) * 64 + wc * 32 + fq * 4;
#pragma unroll
            for (int mi = 0; mi < 4; ++mi) {
                const int row = m0 + wr * 64 + mi * 16 + fr;
#pragma unroll
                for (int k2 = 0; k2 < 2; ++k2) {
                    const f32x4 a = acc[mi][2 * k2], gt = acc[mi][2 * k2 + 1];
                    uint2 o; o.x = pack2(sigmul(a[0], gt[0]), sigmul(a[1], gt[1])); o.y = pack2(sigmul(a[2], gt[2]), sigmul(a[3], gt[3]));
                    *(uint2*)(p.hb + (size_t)row * INW + 768 + cb + k2 * 16) = o;
                }
            }
        } else {
#pragma unroll
        for (int mi = 0; mi < 4; ++mi) {
            const int row = m0 + wr * 64 + mi * 16 + fr;
#pragma unroll
            for (int ni = 0; ni < 4; ++ni) {
                const int col0 = n0 + wc * 64 + ni * 16;
                f32x4 v = acc[mi][ni];
                if (col0 < 640 && (col0 & 63) == 0) {
                    const f32x4 cs = *(const f32x4*)(p.rope + (size_t)row * 16 + (fq & 1) * 4), sn = *(const f32x4*)(p.rope + (size_t)row * 16 + 8 + (fq & 1) * 4);
#pragma unroll
                    for (int r = 0; r < 4; ++r) {
                        const float other = __shfl_xor(v[r], 32);
                        v[r] = (fq < 2) ? (v[r] * cs[r] - other * sn[r]) : (v[r] * cs[r] + other * sn[r]);
                    }
                }
                uint2 o; o.x = pack2(v[0], v[1]); o.y = pack2(v[2], v[3]);
                *(uint2*)(p.hb + (size_t)row * INW + col0 + fq * 4) = o;
            }
        }
        }
    }
}

#define ASTR 72
#define VSTR 260
typedef float f32x16 __attribute__((ext_vector_type(16)));
typedef unsigned u32x2 __attribute__((ext_vector_type(2)));
__device__ void ph_attn(const Params& p, unsigned char* smem, const int vb) {
    bf16_t* sK = (bf16_t*)smem;
    bf16_t* sVt = sK + 256 * ASTR;
    const int tid = threadIdx.x, lane = tid & 63, wid = tid >> 6, r32 = lane & 31, hh = lane >> 5;
    const float C1 = 0.125f * 1.4426950408889634f, LOG2E = 1.4426950408889634f;
    for (int u = vb; u < 16 * 16 * 2; u += gridDim.x) {
        const int kvh = u & 1, nb = (u >> 1) & 15, b = u >> 5;
        __syncthreads();
        for (int c = tid; c < 256 * 8; c += 256) {
            const int li = c >> 3, kc = c & 7;
            const int pos = nb * 128 - 128 + li;
            u32x4 kv = {0u, 0u, 0u, 0u}, vv = {0u, 0u, 0u, 0u};
            if (pos >= 0) {
                const bf16_t* base = p.hb + (size_t)(b * SEQ + pos) * INW;
                kv = *(const u32x4*)(base + 512 + kvh * 64 + kc * 8);
                vv = *(const u32x4*)(base + 640 + kvh * 64 + kc * 8);
            }
            *(u32x4*)(sK + li * ASTR + kc * 8) = kv;
#pragma unroll
            for (int i = 0; i < 4; ++i) {
                sVt[(kc * 8 + 2 * i) * VSTR + li] = (bf16_t)(vv[i] & 0xffffu);
                sVt[(kc * 8 + 2 * i + 1) * VSTR + li] = (bf16_t)(vv[i] >> 16);
            }
        }
        __syncthreads();
        const int hq = kvh * 4 + wid;
        const float sink2 = p.sinks[hq] * LOG2E;
        bf16x8 qn[4];
        {
            const size_t tr0 = (size_t)(b * SEQ + nb * 128 + r32);
#pragma unroll
            for (int ks = 0; ks < 4; ++ks) qn[ks] = *(const bf16x8*)(p.hb + tr0 * INW + hq * 64 + ks * 16 + hh * 8);
        }
#pragma unroll 1
        for (int qt = 0; qt < 4; ++qt) {
            const size_t trow = (size_t)(b * SEQ + nb * 128 + qt * 32 + r32);
            bf16x8 qf[4];
#pragma unroll
            for (int ks = 0; ks < 4; ++ks) qf[ks] = qn[ks];
            {
                const size_t trn = (size_t)(b * SEQ + nb * 128 + (qt < 3 ? qt + 1 : qt) * 32 + r32);
#pragma unroll
                for (int ks = 0; ks < 4; ++ks) qn[ks] = *(const bf16x8*)(p.hb + trn * INW + hq * 64 + ks * 16 + hh * 8);
            }
            f32x16 S[5];
#pragma unroll
            for (int j = 0; j < 5; ++j) {
#pragma unroll
                for (int r = 0; r < 16; ++r) S[j][r] = 0.f;
#pragma unroll
                for (int ks = 0; ks < 4; ++ks) {
                    const bf16x8 a = *(const bf16x8*)(sK + ((qt + j) * 32 + r32) * ASTR + ks * 16 + hh * 8);
                    S[j] = __builtin_amdgcn_mfma_f32_32x32x16_bf16(a, qf[ks], S[j], 0, 0, 0);
                }
            }
            float m2 = sink2;
#pragma unroll
            for (int j = 0; j < 5; ++j) {
                const bool tile_ok = (nb > 0) || (qt + j >= 4);
#pragma unroll
                for (int r = 0; r < 16; ++r) {
                    const int kl = (r & 3) + 8 * (r >> 2) + 4 * hh;
                    bool ok = tile_ok;
                    if (j == 0) ok = ok && (kl > r32);
                    if (j == 4) ok = ok && (kl <= r32);
                    const float t = ok ? S[j][r] * C1 : -1.0e30f;
                    S[j][r] = t;
                    m2 = fmaxf(m2, t);
                }
            }
            m2 = fmaxf(m2, __shfl_xor(m2, 32));
            float l = 0.f;
#pragma unroll
            for (int j = 0; j < 5; ++j)
#pragma unroll
                for (int r = 0; r < 16; ++r) { const float e = __builtin_amdgcn_exp2f(S[j][r] - m2); S[j][r] = e; l += e; }
            l += __shfl_xor(l, 32);
            l += __builtin_amdgcn_exp2f(sink2 - m2);
            f32x16 O[2];
#pragma unroll
            for (int dt = 0; dt < 2; ++dt)
#pragma unroll
                for (int r = 0; r < 16; ++r) O[dt][r] = 0.f;
#pragma unroll
            for (int j = 0; j < 5; ++j)
#pragma unroll
                for (int s2 = 0; s2 < 2; ++s2) {
                    u32x4 pw;
#pragma unroll
                    for (int k = 0; k < 4; ++k) pw[k] = pack2(S[j][8 * s2 + 2 * k], S[j][8 * s2 + 2 * k + 1]);
                    const bf16x8 pf = __builtin_bit_cast(bf16x8, pw);
                    const int kbase = (qt + j) * 32 + 16 * s2 + 4 * hh;
#pragma unroll
                    for (int dt = 0; dt < 2; ++dt) {
                        const bf16_t* vp = sVt + (dt * 32 + r32) * VSTR + kbase;
                        const u32x2 v0 = *(const u32x2*)(vp), v1 = *(const u32x2*)(vp + 8);
                        const u32x4 vw = {v0[0], v0[1], v1[0], v1[1]};
                        O[dt] = __builtin_amdgcn_mfma_f32_32x32x16_bf16(__builtin_bit_cast(bf16x8, vw), pf, O[dt], 0, 0, 0);
                    }
                }
            const float il = __builtin_amdgcn_rcpf(l);
#pragma unroll
            for (int dt = 0; dt < 2; ++dt)
#pragma unroll
                for (int g = 0; g < 4; ++g) {
                    u32x2 w;
                    w[0] = pack2(O[dt][4 * g] * il, O[dt][4 * g + 1] * il);
                    w[1] = pack2(O[dt][4 * g + 2] * il, O[dt][4 * g + 3] * il);
                    *(u32x2*)(p.mixb + trow * DM + hq * 64 + dt * 32 + 8 * g + 4 * hh) = w;
                }
        }
    }
}

#define CV_ROWS 62
__device__ void ph_conv(const Params& p, unsigned char* smem, const int vb) {
    bf16_t* gl = (bf16_t*)smem;
    float* red = (float*)(smem + CV_ROWS * 1024);
    const int tid = threadIdx.x, lane = tid & 63, wid = tid >> 6;
    const f32x2 lg = *(const f32x2*)(p.cln_g + 2 * tid), lb = *(const f32x2*)(p.cln_b + 2 * tid);
    for (int u = vb; u < T_TOK / 32; u += gridDim.x) {
        const int tok0 = u * 32, s0 = tok0 & (SEQ - 1);
        __syncthreads();
#pragma unroll 1
        for (int bt = 0; bt < 2; ++bt) {
            u32x4 av[8];
#pragma unroll
            for (int it = 0; it < 8; ++it) {
                const int ch = tid + (bt * 8 + it) * 256, row = min(ch >> 6, CV_ROWS - 1), k = ch & 63;
                const int rr = (s0 - 30 + row >= 0) ? row : 30;
                av[it] = *(const u32x4*)(p.hb + (size_t)(tok0 - 30 + rr) * INW + 768 + k * 8);
            }
#pragma unroll
            for (int it = 0; it < 8; ++it) {
                const int ch = tid + (bt * 8 + it) * 256, row = ch >> 6, k = ch & 63;
                const bool ok = (s0 - 30 + row >= 0);
                const u32x4 o = ok ? av[it] : (u32x4){0u, 0u, 0u, 0u};
                if (row < CV_ROWS) *(u32x4*)(gl + row * 512 + k * 8) = o;
            }
        }
        __syncthreads();
        float w0[31], w1[31];
#pragma unroll
        for (int k = 0; k < 31; ++k) { const f32x2 wv = *(const f32x2*)(p.conv_w + k * 512 + 2 * tid); w0[k] = wv.x; w1[k] = wv.y; }
        const f32x2 bias = *(const f32x2*)(p.conv_b + 2 * tid);
#pragma unroll 1
        for (int jh = 0; jh < 2; ++jh) {
            float a0[16], a1[16];
#pragma unroll
            for (int jl = 0; jl < 16; ++jl) { a0[jl] = bias.x; a1[jl] = bias.y; }
            const bf16_t* gp = gl + (jh * 16) * 512 + 2 * tid;
#pragma unroll
            for (int il = 0; il < 46; ++il) {
                const unsigned gw = *(const unsigned*)(gp + il * 512);
                const float g0 = bflo(gw), g1 = bfhi(gw);
#pragma unroll
                for (int jl = 0; jl < 16; ++jl)
                    if (il - jl >= 0 && il - jl <= 30) { a0[jl] += w0[il - jl] * g0; a1[jl] += w1[il - jl] * g1; }
                if ((il & 3) == 3) __builtin_amdgcn_sched_barrier(0);
            }
            float v[32];
#pragma unroll
            for (int jl = 0; jl < 16; ++jl) { v[jl] = a0[jl] + a1[jl]; v[16 + jl] = a0[jl] * a0[jl] + a1[jl] * a1[jl]; }
#pragma unroll
            for (int st = 16; st >= 1; st >>= 1) {
                const bool up = (lane & st) != 0;
#pragma unroll
                for (int i2 = 0; i2 < st; ++i2) {
                    const float keep = up ? v[i2 + st] : v[i2], send = up ? v[i2] : v[i2 + st];
                    v[i2] = keep + __shfl_xor(send, st);
                }
            }
            const float tot = v[0] + __shfl_xor(v[0], 32);
            __syncthreads();
            if (lane < 32) red[wid * 32 + lane] = tot;
            __syncthreads();
#pragma unroll
            for (int jl = 0; jl < 16; ++jl) {
                const float sm = (red[jl] + red[32 + jl]) + (red[64 + jl] + red[96 + jl]);
                const float sq = (red[16 + jl] + red[48 + jl]) + (red[80 + jl] + red[112 + jl]);
                const float mu = sm * (1.0f / 512.0f);
                const float rstd = rsqrtf(fmaxf(sq * (1.0f / 512.0f) - mu * mu, 0.f) + LN_EPS);
                const float y0 = (a0[jl] - mu) * rstd * lg.x + lb.x, y1 = (a1[jl] - mu) * rstd * lg.y + lb.y;
                *(unsigned*)(p.mixb + (size_t)(tok0 + jh * 16 + jl) * DM + 512 + 2 * tid) = pack2(sigmul(y0, y0), sigmul(y1, y1));
            }
        }
    }
}

__device__ void ph_gemm_out(const Params& p, unsigned char* smem, const int vb) {
    const int ntn = DM / 256;
    const int tid = threadIdx.x, lane = tid & 63, wid = tid >> 6, wr = wid >> 1, wc = wid & 1, fr = lane & 15, fq = lane >> 4;
    for (int t = vb; t < (T_TOK / 128) * ntn; t += gridDim.x) {
        const int m0 = (t / ntn) * 128, n0 = (t % ntn) * 256;
        f32x4 acc[4][8]; zero_accw(acc);
        u32x2 xq[2][8];
#define GO_XLD(mi, buf) do { const int _row = m0 + wr * 64 + (mi) * 16 + fr; \
            _Pragma("unroll") for (int _ni = 0; _ni < 8; ++_ni) xq[buf][_ni] = *(const u32x2*)(p.xb + (size_t)_row * DM + n0 + wc * 128 + _ni * 16 + fq * 4); } while (0)
        gemmW(p.mixb + (size_t)m0 * DM, DM, p.WoutT + (size_t)n0 * DM, DM, DM, smem, acc);
        GO_XLD(0, 0);
#pragma unroll
        for (int mi = 0; mi < 4; ++mi) {
            const int row = m0 + wr * 64 + mi * 16 + fr;
            if (mi < 3) GO_XLD(mi + 1, (mi + 1) & 1);
            float sm = 0.f, sq = 0.f;
#pragma unroll
            for (int ni = 0; ni < 8; ++ni) {
                const int col = n0 + wc * 128 + ni * 16 + fq * 4;
                const u32x2 xw = xq[mi & 1][ni];
                const f32x4 xv = {bflo(xw[0]), bfhi(xw[0]), bflo(xw[1]), bfhi(xw[1])};
                const f32x4 y = xv * ALPHA + acc[mi][ni];
                sm += (y[0] + y[1]) + (y[2] + y[3]); sq += (y[0] * y[0] + y[1] * y[1]) + (y[2] * y[2] + y[3] * y[3]);
                u32x2 o; o[0] = pack2(y[0], y[1]); o[1] = pack2(y[2], y[3]);
                *(u32x2*)(p.y1b + (size_t)row * DM + col) = o;
            }
            sm += __shfl_xor(sm, 16); sq += __shfl_xor(sq, 16); sm += __shfl_xor(sm, 32); sq += __shfl_xor(sq, 32);
            if (fq == 0) *(f32x2*)(p.stats + (size_t)row * 16 + ((n0 >> 8) * 2 + wc) * 2) = (f32x2){sm, sq};
        }
    }
}

__device__ __forceinline__ void ln_row(const float* __restrict__ src, const float* __restrict__ g, const float* __restrict__ bta,
                                       float* __restrict__ dstf, bf16_t* __restrict__ dstb, int lane) {
    f32x4 v[4]; float s = 0.f;
#pragma unroll
    for (int i = 0; i < 4; ++i) { v[i] = *(const f32x4*)(src + i * 256 + lane * 4); s += (v[i][0] + v[i][1]) + (v[i][2] + v[i][3]); }
    const float mu = wave_sum(s) * (1.0f / 1024.0f);
    float q = 0.f;
#pragma unroll
    for (int i = 0; i < 4; ++i) { const f32x4 d = v[i] - mu; q += (d[0] * d[0] + d[1] * d[1]) + (d[2] * d[2] + d[3] * d[3]); }
    const float rstd = rsqrtf(wave_sum(q) * (1.0f / 1024.0f) + LN_EPS);
#pragma unroll
    for (int i = 0; i < 4; ++i) {
        const f32x4 gg = *(const f32x4*)(g + i * 256 + lane * 4), bb = *(const f32x4*)(bta + i * 256 + lane * 4);
        const f32x4 y = (v[i] - mu) * rstd * gg + bb;
        if (dstf) *(f32x4*)(dstf + i * 256 + lane * 4) = y;
        if (dstb) { uint2 o; o.x = pack2(y[0], y[1]); o.y = pack2(y[2], y[3]); *(uint2*)(dstb + i * 256 + lane * 4) = o; }
    }
}
__device__ void ph_ln2(const Params& p, const int vb) {
    const int lane = threadIdx.x & 63, wid = threadIdx.x >> 6;
    for (int r = vb * 4 + wid; r < T_TOK; r += gridDim.x * 4)
        ln_row(p.out + (size_t)r * DM, p.ln2_g, p.ln2_b, p.out + (size_t)r * DM, (bf16_t*)nullptr, lane);
}

#define QSTR 136
__device__ __forceinline__ int f2key(float f) { const int b = __float_as_int(f); return b ^ ((b >> 31) & 0x7fffffff); }
__device__ __forceinline__ float key2f(int k) { return __int_as_float(k ^ ((k >> 31) & 0x7fffffff)); }
__device__ __forceinline__ void sort16_desc(int (&a)[16]) {
#pragma unroll
    for (int lk = 1; lk <= 4; ++lk) {
#pragma unroll
        for (int lj = lk - 1; lj >= 0; --lj) {
            const int k = 1 << lk, j = 1 << lj;
#pragma unroll
            for (int i = 0; i < 16; ++i) {
                const int l = i ^ j;
                if (l > i) {
                    const int hi = max(a[i], a[l]), lo = min(a[i], a[l]);
                    if ((i & k) == 0) { a[i] = hi; a[l] = lo; } else { a[i] = lo; a[l] = hi; }
                }
            }
        }
    }
}
__device__ __forceinline__ void merge_top16(int (&a)[16], const int (&b)[16]) {
#pragma unroll
    for (int i = 0; i < 16; ++i) a[i] = max(a[i], b[15 - i]);
#pragma unroll
    for (int lj = 3; lj >= 0; --lj) {
        const int j = 1 << lj;
#pragma unroll
        for (int i = 0; i < 16; ++i) {
            const int l = i ^ j;
            if (l > i) { const int hi = max(a[i], a[l]), lo = min(a[i], a[l]); a[i] = hi; a[l] = lo; }
        }
    }
}
__device__ __forceinline__ void top16_of_64(int (&v)[4][16]) {
    sort16_desc(v[0]); sort16_desc(v[1]); sort16_desc(v[2]); sort16_desc(v[3]);
    merge_top16(v[0], v[1]); merge_top16(v[0], v[2]); merge_top16(v[0], v[3]);
}

__device__ void ph_mprep(const Params& p, unsigned char* smem, const int vb) {
    if (vb < 8) {
        const int n = vb * 256 + threadIdx.x, hp = n >> 7;
        const float* kr = p.keys + (size_t)n * 128;
        float a = 0.f, b = 0.f;
        for (int c4 = 0; c4 < 128; c4 += 4) {
            const f32x4 kv = *(const f32x4*)(kr + c4), wg = *(const f32x4*)(p.wgb + hp * 128 + c4), wb = *(const f32x4*)(p.wgb + 2048 + hp * 128 + c4);
            a += (kv[0] * wg[0] + kv[1] * wg[1]) + (kv[2] * wg[2] + kv[3] * wg[3]);
            b += (kv[0] * wb[0] + kv[1] * wb[1]) + (kv[2] * wb[2] + kv[3] * wb[3]);
        }
        u32x4 c0 = {pack2(a, b), 0u, 0u, 0u}; const u32x4 z4 = {0u, 0u, 0u, 0u};
        u32x4* me = (u32x4*)(p.mext + (size_t)n * 32);
        me[0] = c0; me[1] = z4; me[2] = z4; me[3] = z4;
    }
    const int tid = threadIdx.x, lane = tid & 63, wid = tid >> 6, wr = wid >> 1, wc = wid & 1, fr = lane & 15, fq = lane >> 4;
    for (int t = vb; t < 16 * 8; t += gridDim.x) {
        const int hp = t >> 3, d0 = (t & 7) * 128;
        f32x4 acc[4][4]; zero_acc(acc);
        gemm128(p.keysb + (size_t)hp * 128 * 128, 128, p.Wqb + (size_t)d0 * 2048 + hp * 128, 2048, 128, smem, acc);
#pragma unroll
        for (int mi = 0; mi < 4; ++mi)
#pragma unroll
            for (int ni = 0; ni < 4; ++ni) {
                uint2 o; o.x = pack2(acc[mi][ni][0], acc[mi][ni][1]); o.y = pack2(acc[mi][ni][2], acc[mi][ni][3]);
                *(uint2*)(p.MT + (size_t)(hp * 128 + wr * 64 + mi * 16 + fr) * DM + d0 + wc * 64 + ni * 16 + fq * 4) = o;
            }
    }
}

__device__ __forceinline__ void route_topk(const f32x16 (&S)[8], int pp, int hh, int (&K)[16]) {
    int v[4][16];
#pragma unroll
    for (int mt = 0; mt < 4; ++mt)
#pragma unroll
        for (int r = 0; r < 16; ++r) {
            const int n = mt * 32 + (r & 3) + 8 * (r >> 2) + 4 * hh;
            v[mt][r] = (f2key(S[pp * 4 + mt][r]) & ~0x7F) | (127 - n);
        }
    top16_of_64(v);
    int o[16];
#pragma unroll
    for (int i = 0; i < 16; ++i) o[i] = __shfl_xor(v[0][i], 32);
    merge_top16(v[0], o);
#pragma unroll
    for (int i = 0; i < 16; ++i) K[i] = v[0][i];
}
#define RT_STEPS 33
template <bool PRE, bool NEXT>
__device__ __forceinline__ void route_gemm(const Params& p, unsigned char* smem, int m0, int h, f32x16 (&S)[8], int nm0, int nh, int& sp) {
    LDS_AS unsigned char* lds = (LDS_AS unsigned char*)smem;
    const int tid = threadIdx.x, lane = tid & 63, wid = __builtin_amdgcn_readfirstlane(tid >> 6);
    const int r32 = lane & 31, hh = lane >> 5;
    const int prow = lane >> 2, pc = (lane & 3) ^ ((4 - ((prow >> 2) & 3)) & 3);
    const bf16_t* gA = p.y1b + (size_t)(m0 + wid * 32 + prow) * DM + pc * 8;
    const bf16_t* gB = p.MT + (size_t)(h * 256 + wid * 64 + prow) * DM + pc * 8;
    const bf16_t* eA = p.yext + (size_t)(m0 + wid * 32 + prow) * 32 + pc * 8;
    const bf16_t* eB = p.mext + (size_t)(h * 256 + wid * 64 + prow) * 32 + pc * 8;
    const size_t r16 = (size_t)16 * DM;
#define RH_ISSUE_AT(pa, sa, pb, sb_, st) do { \
        _Pragma("unroll") for (int _i = 0; _i < 2; ++_i) \
            __builtin_amdgcn_global_load_lds((const unsigned*)((pa) + _i * (sa)), (LDS_AS unsigned*)(lds + (st) * GW_STAGE + (wid * 2 + _i) * 1024), 16, 0, 0); \
        _Pragma("unroll") for (int _i = 0; _i < 4; ++_i) \
            __builtin_amdgcn_global_load_lds((const unsigned*)((pb) + _i * (sb_)), (LDS_AS unsigned*)(lds + (st) * GW_STAGE + 8192 + (wid * 4 + _i) * 1024), 16, 0, 0); \
        } while (0)
#pragma unroll
    for (int mt = 0; mt < 8; ++mt)
#pragma unroll
        for (int r = 0; r < 16; ++r) S[mt][r] = 0.f;
    const int fx = (4 - ((r32 >> 2) & 3)) & 3;
    const int toff = (wid * 32 + r32) * 64, koff = 8192 + r32 * 64;
    if (!PRE) RH_ISSUE_AT(gA, r16, gB, r16, sp);
#pragma unroll 1
    for (int kt = 0; kt < RT_STEPS; ++kt) {
        const int st = (kt + sp) & 1;
        asm volatile("s_waitcnt vmcnt(0)" ::: "memory");
        __builtin_amdgcn_s_barrier();
        asm volatile("" ::: "memory");
        if (kt + 1 < RT_STEPS - 1) RH_ISSUE_AT(gA + (size_t)(kt + 1) * 32, r16, gB + (size_t)(kt + 1) * 32, r16, st ^ 1);
        else if (kt + 1 == RT_STEPS - 1) RH_ISSUE_AT(eA, (size_t)(16 * 32), eB, (size_t)(16 * 32), st ^ 1);
        else if (NEXT) {
            const bf16_t* qA = p.y1b + (size_t)(nm0 + wid * 32 + prow) * DM + pc * 8;
            const bf16_t* qB = p.MT + (size_t)(nh * 256 + wid * 64 + prow) * DM + pc * 8;
            RH_ISSUE_AT(qA, r16, qB, r16, st ^ 1);
        }
        const LDS_AS unsigned char* sb = lds + st * GW_STAGE;
#pragma unroll
        for (int k16 = 0; k16 < 2; ++k16) {
            const int sw = ((k16 * 2 + hh) ^ fx) * 16;
            const bf16x8 b = *(const LDS_AS bf16x8*)(sb + toff + sw);
#pragma unroll
            for (int mt = 0; mt < 8; ++mt) {
                const bf16x8 a = *(const LDS_AS bf16x8*)(sb + koff + mt * 2048 + sw);
                S[mt] = __builtin_amdgcn_mfma_f32_32x32x16_bf16(a, b, S[mt], 0, 0, 0);
            }
        }
        asm volatile("s_waitcnt lgkmcnt(0)" ::: "memory");
        __builtin_amdgcn_s_barrier();
        asm volatile("" ::: "memory");
    }
    sp ^= (RT_STEPS & 1);
#undef RH_ISSUE_AT
}

__device__ void ph_route(const Params& p, unsigned char* smem, const int vb) {
    const int tid = threadIdx.x, lane = tid & 63, wid = tid >> 6;
    const int r32 = lane & 31, hh = lane >> 5;
    const int hmask = -hh;
    int* KL = (int*)(smem + 2 * GW_STAGE + (size_t)wid * 32 * 33 * 4);
    const int nunits = (T_TOK / 128) * 8;
    bool pre = false; int sp = 0;
    for (int u = vb; u < nunits; u += gridDim.x) {
        const int m0 = (u >> 3) * 128, h = u & 7;
        const int un = u + gridDim.x;
        const bool has_next = un < nunits;
        const int nm0 = ((has_next ? un : u) >> 3) * 128, nh = (has_next ? un : u) & 7;
        float mu, rstd;
        {
            const float* stp = p.stats + (size_t)(m0 + wid * 32 + r32) * 16;
            const f32x4 a = *(const f32x4*)(stp), b = *(const f32x4*)(stp + 4), c4 = *(const f32x4*)(stp + 8), d = *(const f32x4*)(stp + 12);
            const float sm = (a[0] + a[2]) + (b[0] + b[2]) + (c4[0] + c4[2]) + (d[0] + d[2]);
            const float sq = (a[1] + a[3]) + (b[1] + b[3]) + (c4[1] + c4[3]) + (d[1] + d[3]);
            mu = sm * (1.0f / 1024.0f);
            rstd = rsqrtf(fmaxf(sq * (1.0f / 1024.0f) - mu * mu, 0.f) + LN_EPS);
        }
        {
            bf16_t* ye = p.yext + (size_t)(m0 + wid * 32 + r32) * 32 + hh * 16;
            const u32x4 z4 = {0u, 0u, 0u, 0u};
            u32x4 c0 = z4; if (hh == 0) c0[0] = pack2(-mu, __builtin_amdgcn_rcpf(rstd));
            *(u32x4*)(ye) = c0; *(u32x4*)(ye + 8) = z4;
        }
        f32x16 S[8];
        if (pre) { if (has_next) route_gemm<true, true>(p, smem, m0, h, S, nm0, nh, sp); else route_gemm<true, false>(p, smem, m0, h, S, nm0, nh, sp); }
        else     { if (has_next) route_gemm<false, true>(p, smem, m0, h, S, nm0, nh, sp); else route_gemm<false, false>(p, smem, m0, h, S, nm0, nh, sp); }
        int K0[16], K1[16];
        route_topk(S, 0, hh, K0);
        route_topk(S, 1, hh, K1);
        pre = has_next;
#pragma unroll
        for (int i = 0; i < 16; ++i) KL[r32 * 33 + hh * 16 + i] = K0[i] ^ ((K0[i] ^ K1[i]) & hmask);
        float s1[16], s2[16];
#pragma unroll
        for (int i = 0; i < 16; ++i) { s1[i] = key2f(K0[i] & ~0x7F); s2[i] = key2f(K1[i] & ~0x7F); }
        int c[4][16];
#pragma unroll
        for (int i = 0; i < 16; ++i)
#pragma unroll
            for (int j = 0; j < 16; ++j)
                if ((i + 1) * (j + 1) <= 16) {
                    constexpr int OFFS[16] = {0, 16, 24, 29, 33, 36, 38, 40, 42, 43, 44, 45, 46, 47, 48, 49};
                    const int q = OFFS[i] + j;
                    c[q >> 4][q & 15] = (f2key(s1[i] + s2[j]) & ~0xFF) | (255 - (i * 16 + j));
                }
#pragma unroll
        for (int qq = 50; qq < 64; ++qq) c[qq >> 4][qq & 15] = (int)0x80000000;
        top16_of_64(c);
        const float mx = key2f(c[0][0] & ~0xFF);
        float e[16]; float den = 0.f;
#pragma unroll
        for (int i = 0; i < 16; ++i) { e[i] = __expf(rstd * (key2f(c[0][i] & ~0xFF) - mx)); den += e[i]; }
        const float inv = __builtin_amdgcn_rcpf(den);
        const size_t ob = (size_t)(m0 + wid * 32 + r32) * 128 + h * 16 + hh * 8;
        int idv[8]; float gv[8];
#pragma unroll
        for (int qq = 0; qq < 8; ++qq) {
            const int F = c[0][qq] ^ ((c[0][qq] ^ c[0][8 + qq]) & hmask);
            gv[qq] = __int_as_float(__float_as_int(e[qq]) ^ ((__float_as_int(e[qq]) ^ __float_as_int(e[8 + qq])) & hmask)) * inv;
            const int idx = 255 - (F & 0xFF);
            const int k0 = KL[r32 * 33 + (idx >> 4)], k1 = KL[r32 * 33 + 16 + (idx & 15)];
            idv[qq] = (127 - (k0 & 0x7F)) * 128 + (127 - (k1 & 0x7F));
        }
        *(int4*)(p.ids + ob) = make_int4(idv[0], idv[1], idv[2], idv[3]);
        *(int4*)(p.ids + ob + 4) = make_int4(idv[4], idv[5], idv[6], idv[7]);
        *(float4*)(p.gates + ob) = make_float4(gv[0], gv[1], gv[2], gv[3]);
        *(float4*)(p.gates + ob + 4) = make_float4(gv[4], gv[5], gv[6], gv[7]);
    }
}

__device__ __forceinline__ f32x2 row_dot(const u32x4 w, const f32x2 (&x)[8], f32x2 acc) {
#pragma unroll
    for (int k = 0; k < 4; ++k) {
        acc = __builtin_amdgcn_cvt_pk_f32_fp8(w[k], false) * x[2 * k] + acc;
        acc = __builtin_amdgcn_cvt_pk_f32_fp8(w[k], true) * x[2 * k + 1] + acc;
    }
    return acc;
}
__device__ __forceinline__ float gelu_gate(float h, float g) { return 0.5f * h * (1.0f + erff(h * 0.70710678118654752f)) * g; }

__device__ __forceinline__ void ld_ids16(const int* __restrict__ q, int (&idv)[16]) {
    const int4* idp = (const int4*)q;
#pragma unroll
    for (int k = 0; k < 4; ++k) { const int4 v = idp[k]; idv[4 * k] = v.x; idv[4 * k + 1] = v.y; idv[4 * k + 2] = v.z; idv[4 * k + 3] = v.w; }
}
__device__ __forceinline__ void ld_f16(const float* __restrict__ q, float (&a)[16]) {
    const f32x4* ap = (const f32x4*)q;
#pragma unroll
    for (int k = 0; k < 4; ++k) { const f32x4 v = ap[k]; a[4 * k] = v[0]; a[4 * k + 1] = v[1]; a[4 * k + 2] = v[2]; a[4 * k + 3] = v[3]; }
}
__device__ void ph_peer_u(const Params& p, unsigned char* smem, const int vb) {
    const int lane = threadIdx.x & 63, wid = __builtin_amdgcn_readfirstlane(threadIdx.x >> 6);
    const int q = lane >> 3, c = lane & 7, j = lane & 15, kb = lane >> 4;
    const int nlb = gridDim.x >> 3, s = vb / nlb, lb = vb - s * nlb;
    const int stride = nlb * 4, t0 = lb * 4 + wid;
    const int ntok = (T_TOK - t0 + stride - 1) / stride;
    if (ntok <= 0) return;
    LDS_AS unsigned char* wb = (LDS_AS unsigned char*)smem + wid * 18432;
    LDS_AS unsigned char* ring = wb + 16384;
    const unsigned char* ubase = p.u8 + (size_t)s * (16384 * 128) + ((c ^ q) * 16);
    const unsigned char* ubase1 = p.u8 + (size_t)s * (16384 * 128) + ((c ^ q ^ 1) * 16);
    const unsigned char* rsrc; unsigned rstr;
    if (lane < 32) { rsrc = (const unsigned char*)p.ids + lane * 16; rstr = 512; }
    else if (lane < 48) { rsrc = (const unsigned char*)p.y1b + s * 256 + (lane - 32) * 16; rstr = 2048; }
    else { rsrc = (const unsigned char*)p.stats + ((2 * s + 1) >> 2) * 16; rstr = 64; }
#define PM_TOK(n) (t0 + ((n) < ntok ? (n) : ntok - 1) * stride)
#define PM_RING(n) do { if (lane < 49) __builtin_amdgcn_global_load_lds((const unsigned*)(rsrc + (size_t)PM_TOK(n) * rstr), (LDS_AS unsigned*)(ring + ((n) & 1) * 1024), 16, 0, 0); } while (0)
#define PM_IDS(n, ia, ib) do { const LDS_AS u32x4* _q = (const LDS_AS u32x4*)(ring + ((n) & 1) * 1024 + q * 32); \
        const u32x4 _a0 = _q[0], _a1 = _q[1], _b0 = _q[16], _b1 = _q[17]; \
        ia[0] = _a0[0]; ia[1] = _a0[1]; ia[2] = _a0[2]; ia[3] = _a0[3]; ia[4] = _a1[0]; ia[5] = _a1[1]; ia[6] = _a1[2]; ia[7] = _a1[3]; \
        ib[0] = _b0[0]; ib[1] = _b0[1]; ib[2] = _b0[2]; ib[3] = _b0[3]; ib[4] = _b1[0]; ib[5] = _b1[1]; ib[6] = _b1[2]; ib[7] = _b1[3]; } while (0)
#define PM_DMA(i, id) __builtin_amdgcn_global_load_lds((const unsigned*)((((i) & 1) ? ubase1 : ubase) + (size_t)(id) * 128), (LDS_AS unsigned*)(wb + (i) * 1024), 16, 0, 0)
    const int key = (j & 7) ^ (j >> 3);
    const LDS_AS unsigned char* brd = wb + j * 128 + (((2 * kb) ^ key) * 16);
    const int bx1 = (key & 1) ? -16 : 16;
    const LDS_AS unsigned char* ard = ring + (j & 1) * 1024 + 832 + kb * 32;
    PM_RING(0); PM_RING(1);
    asm volatile("s_waitcnt vmcnt(0)" ::: "memory");
    {
        unsigned ia[8], ib[8]; PM_IDS(0, ia, ib);
#pragma unroll
        for (int m = 0; m < 4; ++m) { PM_DMA(2 * m, ia[m]); PM_DMA(2 * m + 1, ib[m]); }
#pragma unroll
        for (int m = 4; m < 8; ++m) { PM_DMA(2 * m, ia[m]); PM_DMA(2 * m + 1, ib[m]); }
    }
    const int sqi = ((2 * s + 1) & 3) * 4;
#pragma unroll 1
    for (int n = 0; n < ntok; ++n) {
        const int t = t0 + n * stride;
        LDS_AS unsigned char* slot = ring + (n & 1) * 1024;
        const unsigned xw = *(const LDS_AS unsigned*)(slot + 512 + lane * 4);
        const float ssq = *(const LDS_AS float*)(slot + 768 + sqi);
        const int e2 = (int)(__float_as_uint(ssq) >> 23) - 126;
        int eh = (e2 + 1) >> 1; eh = eh < -60 ? -60 : (eh > 60 ? 60 : eh);
        const float sc = __uint_as_float((unsigned)(127 + 8 - eh) << 23), isc = __uint_as_float((unsigned)(127 - 8 + eh) << 23);
        const float x0 = bflo(xw) * sc, x1 = bfhi(xw) * sc;
        const unsigned h8 = (unsigned)__builtin_amdgcn_cvt_pk_fp8_f32(x0, x1, 0, false);
        const f32x2 hd = __builtin_amdgcn_cvt_pk_f32_fp8((int)h8, false);
        const unsigned l8 = (unsigned)__builtin_amdgcn_cvt_pk_fp8_f32(x0 - hd.x, x1 - hd.y, 0, false);
        *(LDS_AS unsigned short*)(ring + 832 + lane * 2) = (unsigned short)h8;
        *(LDS_AS unsigned short*)(ring + 1024 + 832 + lane * 2) = (unsigned short)l8;
        const u32x4 xa0 = *(const LDS_AS u32x4*)(ard), xa1 = *(const LDS_AS u32x4*)(ard + 16);
        i64 xa[4];
        xa[0] = (i64)(((unsigned long long)xa0[1] << 32) | xa0[0]); xa[1] = (i64)(((unsigned long long)xa0[3] << 32) | xa0[2]);
        xa[2] = (i64)(((unsigned long long)xa1[1] << 32) | xa1[0]); xa[3] = (i64)(((unsigned long long)xa1[3] << 32) | xa1[2]);
        f32x4 acc[8];
        asm volatile("s_waitcnt vmcnt(8)" ::: "memory");
#pragma unroll
        for (int m = 0; m < 4; ++m) {
            const u32x4 b0 = *(const LDS_AS u32x4*)(brd + m * 2048), b1 = *(const LDS_AS u32x4*)(brd + m * 2048 + bx1);
            f32x4 a = {0.f, 0.f, 0.f, 0.f};
            a = __builtin_amdgcn_mfma_f32_16x16x32_fp8_fp8(xa[0], (i64)(((unsigned long long)b0[1] << 32) | b0[0]), a, 0, 0, 0);
            a = __builtin_amdgcn_mfma_f32_16x16x32_fp8_fp8(xa[1], (i64)(((unsigned long long)b0[3] << 32) | b0[2]), a, 0, 0, 0);
            a = __builtin_amdgcn_mfma_f32_16x16x32_fp8_fp8(xa[2], (i64)(((unsigned long long)b1[1] << 32) | b1[0]), a, 0, 0, 0);
            a = __builtin_amdgcn_mfma_f32_16x16x32_fp8_fp8(xa[3], (i64)(((unsigned long long)b1[3] << 32) | b1[2]), a, 0, 0, 0);
            acc[m] = a;
        }
        {
            unsigned ia[8], ib[8]; PM_IDS(n + 1, ia, ib);
            PM_RING(n + 2);
#pragma unroll
            for (int m = 0; m < 4; ++m) { PM_DMA(2 * m, ia[m]); PM_DMA(2 * m + 1, ib[m]); }
            asm volatile("s_waitcnt vmcnt(9)" ::: "memory");
#pragma unroll
            for (int m = 4; m < 8; ++m) {
                const u32x4 b0 = *(const LDS_AS u32x4*)(brd + m * 2048), b1 = *(const LDS_AS u32x4*)(brd + m * 2048 + bx1);
                f32x4 a = {0.f, 0.f, 0.f, 0.f};
                a = __builtin_amdgcn_mfma_f32_16x16x32_fp8_fp8(xa[0], (i64)(((unsigned long long)b0[1] << 32) | b0[0]), a, 0, 0, 0);
                a = __builtin_amdgcn_mfma_f32_16x16x32_fp8_fp8(xa[1], (i64)(((unsigned long long)b0[3] << 32) | b0[2]), a, 0, 0, 0);
                a = __builtin_amdgcn_mfma_f32_16x16x32_fp8_fp8(xa[2], (i64)(((unsigned long long)b1[1] << 32) | b1[0]), a, 0, 0, 0);
                a = __builtin_amdgcn_mfma_f32_16x16x32_fp8_fp8(xa[3], (i64)(((unsigned long long)b1[3] << 32) | b1[2]), a, 0, 0, 0);
                acc[m] = a;
            }
#pragma unroll
            for (int m = 4; m < 8; ++m) { PM_DMA(2 * m, ia[m]); PM_DMA(2 * m + 1, ib[m]); }
        }
        if (lane < 16) {
            u32x4 o;
#pragma unroll
            for (int k = 0; k < 4; ++k) o[k] = pack2((acc[2 * k][0] + acc[2 * k][1]) * isc, (acc[2 * k + 1][0] + acc[2 * k + 1][1]) * isc);
            *(u32x4*)(p.hp + ((size_t)t * 8 + s) * 128 + lane * 8) = o;
        }
    }
    asm volatile("s_waitcnt vmcnt(0)" ::: "memory");
}
__device__ void ph_peer_act(const Params& p, unsigned char* smem, const int vb) {
    const int lane = threadIdx.x & 63, wid = threadIdx.x >> 6;
    unsigned* lsc = (unsigned*)smem;
    LDS_AS unsigned char* img = (LDS_AS unsigned char*)smem + 65536 + wid * 256;
    __syncthreads();
    for (int i = threadIdx.x; i < 16384 / 4; i += 256) *(u32x4*)(lsc + 4 * i) = *(const u32x4*)((const unsigned*)p.sc2 + 4 * i);
    __syncthreads();
    const int e0 = 2 * lane, e1 = e0 + 1;
    const int ix0 = (e0 & 3) * 32 + ((e0 >> 2) & 3) * 8 + (e0 >> 4), ix1 = (e1 & 3) * 32 + ((e1 >> 2) & 3) * 8 + (e1 >> 4);
    for (int t = vb * 4 + wid; t < T_TOK; t += gridDim.x * 4) {
        f32x2 h = {0.f, 0.f};
#pragma unroll
        for (int s = 0; s < 8; ++s) { const unsigned w = *(const unsigned*)(p.hp + ((size_t)t * 8 + s) * 128 + 2 * lane); h += (f32x2){bflo(w), bfhi(w)}; }
        f32x2 pq = *(const f32x2*)(p.stats + (size_t)t * 16 + (lane & 7) * 2);
        pq.x += __shfl_xor(pq.x, 1); pq.y += __shfl_xor(pq.y, 1); pq.x += __shfl_xor(pq.x, 2); pq.y += __shfl_xor(pq.y, 2); pq.x += __shfl_xor(pq.x, 4); pq.y += __shfl_xor(pq.y, 4);
        const float mu = pq.x * (1.0f / 1024.0f), rstd = rsqrtf(fmaxf(pq.y * (1.0f / 1024.0f) - mu * mu, 0.f) + LN_EPS);
        int2 id = *(const int2*)(p.ids + (size_t)t * 128 + 2 * lane);
        id.x &= 0x3fff; id.y &= 0x3fff;
        const f32x2 gt = *(const f32x2*)(p.gates + (size_t)t * 128 + 2 * lane);
        const unsigned s0 = lsc[id.x], s1 = lsc[id.y];
        const unsigned c0 = p.cb2[id.x], c1 = p.cb2[id.y];
        f32x2 a;
        a.x = gelu_gate(rstd * (h.x * bflo(s0) - mu * bflo(c0)) + bfhi(c0), gt.x) * bfhi(s0);
        a.y = gelu_gate(rstd * (h.y * bflo(s1) - mu * bflo(c1)) + bfhi(c1), gt.y) * bfhi(s1);
        float am = fmaxf(fabsf(a.x), fabsf(a.y));
#pragma unroll
        for (int o = 32; o >= 1; o >>= 1) am = fmaxf(am, __shfl_xor(am, o));
        int be = (int)(__float_as_uint(am) >> 23); be = be < 20 ? 20 : (be > 240 ? 240 : be);
        const float sc = __uint_as_float((unsigned)(261 - be) << 23);
        const unsigned iscb = (unsigned)(be - 7) << 23;
        const float x0 = a.x * sc, x1 = a.y * sc;
        const unsigned h8 = (unsigned)__builtin_amdgcn_cvt_pk_fp8_f32(x0, x1, 0, false);
        const f32x2 hd = __builtin_amdgcn_cvt_pk_f32_fp8((int)h8, false);
        const unsigned l8 = (unsigned)__builtin_amdgcn_cvt_pk_fp8_f32(x0 - hd.x, x1 - hd.y, 0, false);
        img[ix0] = (unsigned char)h8; img[ix1] = (unsigned char)(h8 >> 8);
        img[128 + ix0] = (unsigned char)l8; img[128 + ix1] = (unsigned char)(l8 >> 8);
        const unsigned iw = *(const LDS_AS unsigned*)(img + lane * 4);
        *(unsigned*)((unsigned char*)p.gates + (size_t)t * 512 + lane * 4) = iw;
        if (lane < 3) {
            const unsigned pb = lane == 0 ? __float_as_uint(mu) : (lane == 1 ? __float_as_uint(rstd) : iscb);
            *(int2*)(p.ids + (size_t)t * 128 + 2 * lane) = make_int2(id.x | (int)(pb & 0xffff0000u), id.y | (int)(pb << 16));
        }
    }
}
typedef int v2i32 __attribute__((ext_vector_type(2)));
__device__ void ph_peer_v(const Params& p, unsigned char* smem, const int vb) {
    const int lane = threadIdx.x & 63, wid = __builtin_amdgcn_readfirstlane(threadIdx.x >> 6);
    const int q = lane >> 3, c = lane & 7, j = lane & 15, kb = lane >> 4;
    const int nlb = gridDim.x >> 3, s = vb / nlb, lb = vb - s * nlb;
    const int stride = nlb * 4, t0 = lb * 4 + wid;
    const int ntok = (T_TOK - t0 + stride - 1) / stride;
    if (ntok <= 0) return;
    LDS_AS unsigned char* wb = (LDS_AS unsigned char*)smem + wid * 18432;
    LDS_AS unsigned char* ring = wb + 16384;
    const unsigned char* vbase = p.v8 + (size_t)s * (16384 * 128) + ((c ^ q) * 16);
    const unsigned char* vbase1 = p.v8 + (size_t)s * (16384 * 128) + ((c ^ q ^ 1) * 16);
    const unsigned char* rsrc; unsigned rstr;
    if (lane < 32) { rsrc = (const unsigned char*)p.ids + lane * 16; rstr = 512; }
    else if (lane < 48) { rsrc = (const unsigned char*)p.gates + (lane - 32) * 16; rstr = 512; }
    else { rsrc = (const unsigned char*)p.y1b + s * 256 + (lane - 48) * 16; rstr = 2048; }
#define PV_RING(n) __builtin_amdgcn_global_load_lds((const unsigned*)(rsrc + (size_t)PM_TOK(n) * rstr), (LDS_AS unsigned*)(ring + ((n) & 1) * 1024), 16, 0, 0)
#define PV_IDS(n, idv) do { const LDS_AS u32x4* _q = (const LDS_AS u32x4*)(ring + ((n) & 1) * 1024 + q * 64); \
        _Pragma("unroll") for (int _k = 0; _k < 4; ++_k) { const u32x4 _v = _q[_k]; idv[4 * _k] = _v[0] & 0x3fffu; idv[4 * _k + 1] = _v[1] & 0x3fffu; idv[4 * _k + 2] = _v[2] & 0x3fffu; idv[4 * _k + 3] = _v[3] & 0x3fffu; } } while (0)
#define PV_DMA(i, id) __builtin_amdgcn_global_load_lds((const unsigned*)((((i) & 1) ? vbase1 : vbase) + (size_t)(id) * 128), (LDS_AS unsigned*)(wb + (i) * 1024), 16, 0, 0)
    const int key = (j >> 1) ^ (kb & 1);
    const LDS_AS unsigned char* tb = wb + (8 * kb + (j >> 1)) * 128 + (j & 1) * 8;
    const LDS_AS unsigned char* ard = ring + 512 + (j & 1) * 128 + kb * 32;
    const int dl = 32 * kb + (j & 1) * 16 + (j & 14), d0 = s * 128 + dl;
    const f32x2 g2 = *(const f32x2*)(p.ln1_g + d0), b2 = *(const f32x2*)(p.ln1_b + d0);
    PV_RING(0); PV_RING(1);
    asm volatile("s_waitcnt vmcnt(0)" ::: "memory");
    {
        unsigned idv[16]; PV_IDS(0, idv);
#pragma unroll
        for (int i = 0; i < 16; ++i) PV_DMA(i, idv[i]);
    }
#pragma unroll 1
    for (int n = 0; n < ntok; ++n) {
        const int t = t0 + n * stride;
        const LDS_AS unsigned char* slot = ring + (n & 1) * 1024;
        const u32x4 xa0 = *(const LDS_AS u32x4*)(ard + (n & 1) * 1024), xa1 = *(const LDS_AS u32x4*)(ard + (n & 1) * 1024 + 16);
        const u32x4 hd4 = *(const LDS_AS u32x4*)(slot);
        const unsigned hd5 = *(const LDS_AS unsigned*)(slot + 16);
        const unsigned yw = *(const LDS_AS unsigned*)(slot + 768 + dl * 2);
        i64 xa[4];
        xa[0] = (i64)(((unsigned long long)xa0[1] << 32) | xa0[0]); xa[1] = (i64)(((unsigned long long)xa0[3] << 32) | xa0[2]);
        xa[2] = (i64)(((unsigned long long)xa1[1] << 32) | xa1[0]); xa[3] = (i64)(((unsigned long long)xa1[3] << 32) | xa1[2]);
        const float mu = __uint_as_float((hd4[0] & 0xffff0000u) | (hd4[1] >> 16)), rs = __uint_as_float((hd4[2] & 0xffff0000u) | (hd4[3] >> 16));
        const float isc = __uint_as_float(hd5 & 0xffff0000u);
        f32x4 acc[8];
#pragma unroll
        for (int ct = 0; ct < 8; ++ct) acc[ct] = (f32x4){0.f, 0.f, 0.f, 0.f};
        asm volatile("s_waitcnt vmcnt(8)" ::: "memory");
#pragma unroll
        for (int ks = 0; ks < 2; ++ks)
#pragma unroll
            for (int ct = 0; ct < 8; ++ct) {
                const v2i32 bv = __builtin_amdgcn_ds_read_tr8_b64_v2i32((LDS_AS v2i32*)(tb + ks * 4096 + ((ct ^ key) << 4)));
                acc[ct] = __builtin_amdgcn_mfma_f32_16x16x32_fp8_fp8(xa[ks], (i64)(((unsigned long long)(unsigned)bv[1] << 32) | (unsigned)bv[0]), acc[ct], 0, 0, 0);
            }
        {
            unsigned idv[16]; PV_IDS(n + 1, idv);
            PV_RING(n + 2);
#pragma unroll
            for (int i = 0; i < 8; ++i) PV_DMA(i, idv[i]);
            asm volatile("s_waitcnt vmcnt(9)" ::: "memory");
#pragma unroll
            for (int ks = 2; ks < 4; ++ks)
#pragma unroll
                for (int ct = 0; ct < 8; ++ct) {
                    const v2i32 bv = __builtin_amdgcn_ds_read_tr8_b64_v2i32((LDS_AS v2i32*)(tb + ks * 4096 + ((ct ^ key) << 4)));
                    acc[ct] = __builtin_amdgcn_mfma_f32_16x16x32_fp8_fp8(xa[ks], (i64)(((unsigned long long)(unsigned)bv[1] << 32) | (unsigned)bv[0]), acc[ct], 0, 0, 0);
                }
#pragma unroll
            for (int i = 8; i < 16; ++i) PV_DMA(i, idv[i]);
        }
        float va, vc;
        {
            const float w0 = acc[0][0] + acc[0][1], w1 = acc[1][0] + acc[1][1], w2 = acc[2][0] + acc[2][1], w3 = acc[3][0] + acc[3][1];
            const float w4 = acc[4][0] + acc[4][1], w5 = acc[5][0] + acc[5][1], w6 = acc[6][0] + acc[6][1], w7 = acc[7][0] + acc[7][1];
            va = kb == 0 ? w0 : (kb == 1 ? w2 : (kb == 2 ? w4 : w6));
            vc = kb == 0 ? w1 : (kb == 1 ? w3 : (kb == 2 ? w5 : w7));
        }
        const bool od = (j & 1) != 0;
        const float got = __shfl_xor(od ? va : vc, 1);
        const float p0 = (od ? got : va) * isc, p1 = (od ? vc : got) * isc;
        const float r0 = ALPHA * ((bflo(yw) - mu) * rs * g2.x + b2.x) + p0, r1 = ALPHA * ((bfhi(yw) - mu) * rs * g2.y + b2.y) + p1;
        *(unsigned*)(p.rb + (size_t)t * DM + d0) = pack2(r0, r1);
    }
    asm volatile("s_waitcnt vmcnt(0)" ::: "memory");
}

__device__ void ph_gemm_ple(const Params& p, unsigned char* smem, const int vb) {
    const int ntn = DM / 128;
    const int tid = threadIdx.x, lane = tid & 63, wid = tid >> 6, wr = wid >> 1, wc = wid & 1, fr = lane & 15, fq = lane >> 4;
    const int ntiles = (T_TOK / 128) * ntn;
    bool pre = false;
    for (int t = vb; t < ntiles; t += gridDim.x) {
        const int m0 = (t / ntn) * 128, n0 = (t % ntn) * 128;
        const int tn = t + gridDim.x;
        const bool has_next = tn < ntiles;
        const bf16_t* nA = p.pb + (size_t)((has_next ? tn : t) / ntn) * 128 * 256;
        const bf16_t* nB = p.WpT + (size_t)((has_next ? tn : t) % ntn) * 128 * 256;
        const bf16_t* gA = p.rb + (size_t)m0 * DM; const bf16_t* gB = p.WgT + (size_t)n0 * DM;
        f32x4 acc[4][4], acc2[4][4]; zero_acc(acc); zero_acc(acc2);
        if (pre) gemm128<true, true>(p.pb + (size_t)m0 * 256, 256, p.WpT + (size_t)n0 * 256, 256, 256, smem, acc2, gA, DM, gB, DM);
        else     gemm128<false, true>(p.pb + (size_t)m0 * 256, 256, p.WpT + (size_t)n0 * 256, 256, 256, smem, acc2, gA, DM, gB, DM);
        if (has_next) gemm128<true, true>(gA, DM, gB, DM, DM, smem, acc, nA, 256, nB, 256);
        else          gemm128<true, false>(gA, DM, gB, DM, DM, smem, acc);
        pre = has_next;
#pragma unroll
        for (int mi = 0; mi < 4; ++mi) {
            const int row = m0 + wr * 64 + mi * 16 + fr;
#pragma unroll
            for (int ni = 0; ni < 4; ++ni) {
                const int col = n0 + wc * 64 + ni * 16 + fq * 4;
                const u32x2 rw = *(const u32x2*)(p.rb + (size_t)row * DM + col);
                f32x4 rv = {bflo(rw[0]), bfhi(rw[0]), bflo(rw[1]), bfhi(rw[1])};
#pragma unroll
                for (int r = 0; r < 4; ++r) rv[r] += sigmul(acc2[mi][ni][r], acc[mi][ni][r]);
                *(f32x4*)(p.out + (size_t)row * DM + col) = rv;
            }
        }
    }
}

#define XB_TMO      128
#define XB_XCNT(j)  (256  + 64 * (j))
#define XB_XSUB(j)  (1280 + 64 * (j))
#define XB_XGEN(j)  (2304 + 64 * (j))
#define XB_TOP      3328
#define XB_TOPGEN   3392
#define XCD_BAR_WORDS 3456
#define XB_SPIN_CAP (1u << 20)
__device__ __forceinline__ unsigned xb_ld(unsigned* p)              { return __hip_atomic_load(p, __ATOMIC_RELAXED, __HIP_MEMORY_SCOPE_AGENT); }
__device__ __forceinline__ unsigned xb_add(unsigned* p, unsigned v) { return __hip_atomic_fetch_add(p, v, __ATOMIC_RELAXED, __HIP_MEMORY_SCOPE_AGENT); }
__device__ __forceinline__ unsigned xb_xcc_id() { return (unsigned)__builtin_amdgcn_s_getreg((3 << 11) | 20) & 0xFu; }
#define XB_SPIN(cond, bar) do { unsigned _sp = 0; while (cond) { __builtin_amdgcn_s_sleep(1); \
    if ((++_sp & 255u) == 0u) { if (xb_ld(&(bar)[XB_TMO])) break; if (_sp > XB_SPIN_CAP) { atomicAdd(&(bar)[XB_TMO], 1u); break; } } } } while (0)
struct XcdBarrier { unsigned* bar; unsigned x; volatile LDS_AS unsigned* st; };
__device__ __forceinline__ XcdBarrier xcd_barrier_post(unsigned* bar, volatile LDS_AS unsigned* st) {
    XcdBarrier b; b.bar = bar; b.x = xb_xcc_id(); b.st = st;
    if (threadIdx.x == 0) st[3] = xb_add(&bar[XB_XCNT(b.x)], 1u);
    return b;
}
__device__ __forceinline__ void xcd_barrier_complete(unsigned* bar, unsigned x, unsigned rank, unsigned& nloc, unsigned& nx, unsigned& vb) {
    const unsigned G = gridDim.x;
    unsigned sum, cnt, mine, sp = 0u; bool even;
    for (;;) {
        sum = 0u; cnt = 0u; mine = 0u; even = true;
#pragma unroll
        for (unsigned j = 0; j < 16; ++j) {
            const unsigned c = xb_ld(&bar[XB_XCNT(j)]); sum += c; cnt += (c > 0u) ? 1u : 0u; mine = (j == x) ? c : mine;
            even = even && (c == ((j < 8u) ? (G >> 3) : 0u));
        }
        if (sum == G) break;
        __builtin_amdgcn_s_sleep(1);
        if ((++sp & 255u) == 0u) { if (xb_ld(&bar[XB_TMO])) break; if (sp > XB_SPIN_CAP) { atomicAdd(&bar[XB_TMO], 1u); break; } }
    }
    nloc = mine > 0u ? mine : 1u; nx = cnt > 0u ? cnt : 1u;
    vb = (even && sum == G && (G & 7u) == 0u) ? (x * (G >> 3) + rank) : blockIdx.x;
}
__device__ __forceinline__ void xcd_barrier(const XcdBarrier& b) {
    asm volatile("s_waitcnt vmcnt(0)" ::: "memory");
    __syncthreads();
    if (threadIdx.x == 0) {
        unsigned* bar = b.bar;
        __builtin_amdgcn_s_waitcnt(0);
        unsigned nloc = b.st[0], nx = b.st[1];
        if (nloc == 0u) { unsigned vb; xcd_barrier_complete(bar, b.x, b.st[3], nloc, nx, vb); b.st[0] = nloc; b.st[1] = nx; b.st[2] = vb; }
        const unsigned old = xb_add(&bar[XB_XSUB(b.x)], 1u);
        const unsigned gen = old / nloc;
        if (old + 1u == (gen + 1u) * nloc) {
            __builtin_amdgcn_fence(__ATOMIC_RELEASE, "agent");
            asm volatile("s_waitcnt vmcnt(0)" ::: "memory");
            const unsigned og = xb_add(&bar[XB_TOP], 1u);
            const unsigned tg = og / nx;
            if (og + 1u == (tg + 1u) * nx) xb_add(&bar[XB_TOPGEN], 1u);
            else XB_SPIN(xb_ld(&bar[XB_TOPGEN]) == tg, bar);
            __builtin_amdgcn_fence(__ATOMIC_ACQUIRE, "agent");
            xb_add(&bar[XB_XGEN(b.x)], 1u);
            asm volatile("s_waitcnt vmcnt(0)" ::: "memory");
        } else {
            XB_SPIN(xb_ld(&bar[XB_XGEN(b.x)]) == gen, bar);
            __builtin_amdgcn_fence(__ATOMIC_ACQUIRE, "agent");
            asm volatile("s_waitcnt vmcnt(0)" ::: "memory");
        }
    }
    __syncthreads();
}

#define SMEM_PHASE (256 * ASTR * 2 * 2)
#define SMEM_BYTES (SMEM_PHASE + 16)
__global__ void __launch_bounds__(256, 2) mega(Params p) {
    __shared__ __attribute__((aligned(16))) unsigned char smem[SMEM_BYTES];
    volatile LDS_AS unsigned* st = (volatile LDS_AS unsigned*)(LDS_AS unsigned char*)(smem + SMEM_PHASE);
    if (threadIdx.x < 4) st[threadIdx.x] = 0u;
    __syncthreads();
    const XcdBarrier gb = xcd_barrier_post(p.bar, st);
    ph_prep(p, smem);            xcd_barrier(gb);
    const int vb = (int)st[2];
    ph_gemm_in(p, smem, vb);     xcd_barrier(gb);
    ph_attn(p, smem, vb);
    ph_conv(p, smem, vb);        xcd_barrier(gb);
    ph_mprep(p, smem, vb);
    ph_gemm_out(p, smem, vb);    xcd_barrier(gb);
    ph_route(p, smem, vb);       xcd_barrier(gb);
    ph_peer_u(p, smem, vb);      xcd_barrier(gb);
    ph_peer_act(p, smem, vb);    xcd_barrier(gb);
    ph_peer_v(p, smem, vb);      xcd_barrier(gb);
    ph_gemm_ple(p, smem, vb);    xcd_barrier(gb);
    ph_ln2(p, vb);
}

extern "C" void kernel_launch(void* const* d_in, const int* in_sizes, int n_in, void* d_out, int out_size, void* d_ws, size_t ws_size,
                              hipStream_t stream) {
    Params p{};
    p.x = (const float*)d_in[0]; p.p = (const float*)d_in[1]; p.pos = (const int*)d_in[2];
    p.w_in = (const float*)d_in[3]; p.sinks = (const float*)d_in[4]; p.conv_w = (const float*)d_in[5]; p.conv_b = (const float*)d_in[6];
    p.cln_g = (const float*)d_in[7]; p.cln_b = (const float*)d_in[8]; p.w_out = (const float*)d_in[9]; p.ln1_g = (const float*)d_in[10];
    p.ln1_b = (const float*)d_in[11]; p.wq = (const float*)d_in[12]; p.keys = (const float*)d_in[13]; p.pu = (const float*)d_in[14];
    p.pv = (const float*)d_in[15]; p.ple_proj = (const float*)d_in[16]; p.ple_gate = (const float*)d_in[17]; p.ln2_g = (const float*)d_in[18];
    p.ln2_b = (const float*)d_in[19];
    p.out = (float*)d_out;
    unsigned char* ws = (unsigned char*)d_ws;
    const size_t MiB = 1024 * 1024;
    p.y1 = (float*)(ws + 0 * MiB);
    p.hb = (bf16_t*)(ws + 128 * MiB);
    p.hp = (bf16_t*)(ws + 128 * MiB);
    p.xb = (bf16_t*)(ws + 256 * MiB);
    p.mixb = (bf16_t*)(ws + 320 * MiB);
    p.rb = (bf16_t*)(ws + 320 * MiB);
    p.pb = (bf16_t*)(ws + 384 * MiB);
    p.u8 = (unsigned char*)(ws + 400 * MiB);
    p.v8 = (unsigned char*)(ws + 416 * MiB);
    p.sc2 = (bf16_t*)(ws + 432 * MiB);
    p.rope = (float*)(ws + 434 * MiB);
    p.stats = (float*)(ws + 436 * MiB);
    p.cb2 = (unsigned*)(ws + 438 * MiB);
    p.mext = (bf16_t*)(ws + 440 * MiB);
    p.yext = (bf16_t*)(ws + 442 * MiB);
    p.y1b = (bf16_t*)(ws + 0 * MiB);
    p.ids = (int*)(ws + 464 * MiB);
    p.gates = (float*)(ws + 480 * MiB);
    unsigned char* wb = ws + 496 * MiB;
    p.WinT = (bf16_t*)wb; wb += (size_t)INW * DM * 2;
    p.WoutT = (bf16_t*)wb; wb += (size_t)DM * DM * 2;
    p.WgT = (bf16_t*)wb; wb += (size_t)DM * DM * 2;
    p.WpT = (bf16_t*)wb; wb += (size_t)DM * 256 * 2;
    p.keysb = (bf16_t*)wb; wb += (size_t)16 * 128 * 128 * 2;
    p.Wqb = (bf16_t*)(ws + 240 * MiB);
    p.MT = (bf16_t*)(ws + 244 * MiB);
    p.bar = (unsigned*)(ws + 510 * MiB);
    p.wgb = (float*)(p.bar + XCD_BAR_WORDS + 640);

    static int grid_blocks = 0;
    if (!grid_blocks) {
        int dev = 0, cus = 0, per_cu = 0;
        (void)hipGetDevice(&dev);
        (void)hipDeviceGetAttribute(&cus, hipDeviceAttributeMultiprocessorCount, dev);
        (void)hipOccupancyMaxActiveBlocksPerMultiprocessor(&per_cu, mega, 256, 0);
        if (per_cu > 2) per_cu = 2;
        grid_blocks = cus * per_cu;
    }
    (void)hipMemsetAsync(p.bar, 0, (XCD_BAR_WORDS + 640 + 4096) * sizeof(unsigned), stream);
    void* args[] = {&p};
    hipError_t e = hipLaunchCooperativeKernel((void*)mega, dim3(grid_blocks), dim3(256), args, 0, stream);
    if (e != hipSuccess) fprintf(stderr, "cooperative launch failed: %s (grid %d)\n", hipGetErrorString(e), grid_blocks);
}
```

```cpp
#include <hip/hip_runtime.h>
#include <stdint.h>
#include <cstdio>

typedef unsigned short bf16_t;
typedef short bf16x8 __attribute__((ext_vector_type(8)));
typedef float f32x4 __attribute__((ext_vector_type(4)));
typedef unsigned u32x4 __attribute__((ext_vector_type(4)));
typedef float f32x2 __attribute__((ext_vector_type(2)));
typedef long i64;

#define T_TOK 32768
#define SEQ 2048
#define DM 1024
#define INW 1792
#define ALPHA 1.189207115002721f
#define LN_EPS 1e-5f

__device__ __forceinline__ bf16_t f2bf(float f) {
    unsigned u = __float_as_uint(f);
    u += 0x7fffu + ((u >> 16) & 1u);
    return (bf16_t)(u >> 16);
}
__device__ __forceinline__ float bf2f(bf16_t b) { return __uint_as_float(((unsigned)b) << 16); }
__device__ __forceinline__ float bflo(unsigned w) { return __uint_as_float(w << 16); }
__device__ __forceinline__ float bfhi(unsigned w) { return __uint_as_float(w & 0xffff0000u); }
__device__ __forceinline__ unsigned pack2(float a, float b) { return (unsigned)f2bf(a) | ((unsigned)f2bf(b) << 16); }

__device__ __forceinline__ float sigmul(float x, float g) { return x * __builtin_amdgcn_rcpf(1.0f + __expf(-g)); }
__device__ __forceinline__ float wave_sum(float v) {
#pragma unroll
    for (int o = 32; o >= 1; o >>= 1) v += __shfl_xor(v, o);
    return v;
}

struct Params {
    const float *x, *p; const int* pos;
    const float *w_in, *sinks, *conv_w, *conv_b, *cln_g, *cln_b, *w_out, *ln1_g, *ln1_b;
    const float *wq, *keys, *pu, *pv, *ple_proj, *ple_gate, *ln2_g, *ln2_b;
    float* out;
    bf16_t *xb, *pb, *WinT, *WoutT, *WgT, *WpT, *keysb, *Wqb, *MT, *hb, *mixb, *rb;
    float *y1, *gates, *rope, *stats, *wgb;
    bf16_t *y1b, *yext, *mext; unsigned* cb2;
    bf16_t* sc2;
    bf16_t* hp;
    int *ids;
    unsigned char *u8, *v8;
    unsigned* bar;
};

__device__ void cvt_rows(const float* __restrict__ src, bf16_t* __restrict__ dst, size_t n) {
    const size_t nv = n / 8, gs = (size_t)gridDim.x * blockDim.x;
    for (size_t i = (size_t)blockIdx.x * blockDim.x + threadIdx.x; i < nv; i += 4 * gs) {
        f32x4 a[4], b[4];
#pragma unroll
        for (int q = 0; q < 4; ++q) { const size_t k = (i + q * gs < nv) ? i + q * gs : i; a[q] = ((const f32x4*)src)[2 * k]; b[q] = ((const f32x4*)src)[2 * k + 1]; }
#pragma unroll
        for (int q = 0; q < 4; ++q) {
            if (i + q * gs < nv) {
                u32x4 o; o[0] = pack2(a[q][0], a[q][1]); o[1] = pack2(a[q][2], a[q][3]); o[2] = pack2(b[q][0], b[q][1]); o[3] = pack2(b[q][2], b[q][3]);
                ((u32x4*)dst)[i + q * gs] = o;
            }
        }
    }
}
__device__ __forceinline__ int win_row(int n) {
    if (n < 768) return n;
    const int isg = n >= 1280 ? 1 : 0, c = n - (isg ? 1280 : 768);
    const int tt = c >> 6, wc = (c >> 5) & 1, k2 = (c >> 4) & 1, rest = c & 15;
    return 768 + 128 * tt + wc * 64 + (k2 * 2 + isg) * 16 + rest;
}
template <bool WIN = false>
__device__ void transpose_cvt(const float* __restrict__ W, bf16_t* __restrict__ Wt, int K, int N, float* tile  ) {
    const int tk = K / 64, tn = N / 64;
    const int tid = threadIdx.x;
    for (int t = blockIdx.x; t < tk * tn; t += gridDim.x) {
        const int k0 = (t / tn) * 64, n0 = (t % tn) * 64;
        f32x4 v[4];
#pragma unroll
        for (int i = 0; i < 4; ++i) v[i] = *(const f32x4*)(W + (size_t)(k0 + (tid >> 4) + 16 * i) * N + n0 + (tid & 15) * 4);
        __syncthreads();
#pragma unroll
        for (int i = 0; i < 4; ++i)
#pragma unroll
            for (int j = 0; j < 4; ++j) tile[((tid >> 4) + 16 * i) * 65 + (tid & 15) * 4 + j] = v[i][j];
        __syncthreads();
        const int n = tid >> 2, kc = (tid & 3) * 16;
        u32x4 o0, o1;
#pragma unroll
        for (int q = 0; q < 4; ++q) {
            o0[q] = pack2(tile[(kc + 2 * q) * 65 + n], tile[(kc + 2 * q + 1) * 65 + n]);
            o1[q] = pack2(tile[(kc + 8 + 2 * q) * 65 + n], tile[(kc + 8 + 2 * q + 1) * 65 + n]);
        }
        const int nd = WIN ? win_row(n0 + n) : n0 + n;
        *(u32x4*)(Wt + (size_t)nd * K + k0 + kc) = o0;
        *(u32x4*)(Wt + (size_t)nd * K + k0 + kc + 8) = o1;
    }
}
__device__ void cvt_wq_fold(const Params& p, unsigned char* smem) {
    for (int i = blockIdx.x * 256 + threadIdx.x; i < DM * 256; i += gridDim.x * 256) {
        const int d = i >> 8, c8 = (i & 255) * 8;
        const float gd = p.ln1_g[d];
        const f32x4 a = *(const f32x4*)(p.wq + (size_t)d * 2048 + c8), b = *(const f32x4*)(p.wq + (size_t)d * 2048 + c8 + 4);
        u32x4 o; o[0] = pack2(a[0] * gd, a[1] * gd); o[1] = pack2(a[2] * gd, a[3] * gd); o[2] = pack2(b[0] * gd, b[1] * gd); o[3] = pack2(b[2] * gd, b[3] * gd);
        *(u32x4*)(p.Wqb + (size_t)d * 2048 + c8) = o;
    }
    float* red = (float*)smem;
    const int lane = threadIdx.x & 63, wid = threadIdx.x >> 6;
    for (int cb = blockIdx.x; cb < 512; cb += gridDim.x) {
        f32x4 sg = {0.f, 0.f, 0.f, 0.f}, sb = {0.f, 0.f, 0.f, 0.f};
#pragma unroll
        for (int q = 0; q < 4; ++q) {
            const int d = threadIdx.x * 4 + q;
            const f32x4 v = *(const f32x4*)(p.wq + (size_t)d * 2048 + cb * 4);
            sg += v * p.ln1_g[d]; sb += v * p.ln1_b[d];
        }
        __syncthreads();
#pragma unroll
        for (int q = 0; q < 4; ++q) {
            const float a = wave_sum(sg[q]), b = wave_sum(sb[q]);
            if (lane == 0) { red[wid * 8 + q] = a; red[wid * 8 + 4 + q] = b; }
        }
        __syncthreads();
        if (threadIdx.x < 8) {
            const float t = (red[threadIdx.x] + red[8 + threadIdx.x]) + (red[16 + threadIdx.x] + red[24 + threadIdx.x]);
            p.wgb[(threadIdx.x >> 2) * 2048 + cb * 4 + (threadIdx.x & 3)] = t;
        }
    }
}
template <bool FOLD>
__device__ void cvt_table_fp8(const Params& p, const float* __restrict__ src, unsigned char* __restrict__ dst, bf16_t* __restrict__ scl, int rows) {
    const int lane = threadIdx.x & 63, wid = threadIdx.x >> 6;
    const int nw = gridDim.x * 4;
    for (int r0 = blockIdx.x * 4 + wid; r0 < rows; r0 += 4 * nw) {
        f32x4 v[4][4];
#pragma unroll
        for (int q = 0; q < 4; ++q) {
            const int r = (r0 + q * nw < rows) ? r0 + q * nw : r0;
            const float* sr = src + (size_t)r * DM + lane * 16;
#pragma unroll
            for (int k = 0; k < 4; ++k) v[q][k] = *(const f32x4*)(sr + 4 * k);
        }
        f32x4 gv[4], bv[4];
        if (FOLD) {
#pragma unroll
            for (int k = 0; k < 4; ++k) { gv[k] = *(const f32x4*)(p.ln1_g + lane * 16 + 4 * k); bv[k] = *(const f32x4*)(p.ln1_b + lane * 16 + 4 * k); }
        }
#pragma unroll
        for (int q = 0; q < 4; ++q) {
            const int r = r0 + q * nw;
            if (FOLD) {
                float cu = 0.f, bu = 0.f;
#pragma unroll
                for (int k = 0; k < 4; ++k) { bu += (bv[k][0] * v[q][k][0] + bv[k][1] * v[q][k][1]) + (bv[k][2] * v[q][k][2] + bv[k][3] * v[q][k][3]); v[q][k] = v[q][k] * gv[k]; cu += (v[q][k][0] + v[q][k][1]) + (v[q][k][2] + v[q][k][3]); }
                cu = wave_sum(cu); bu = wave_sum(bu);
                if (lane == 0 && r < rows) p.cb2[r] = pack2(cu, bu);
            }
            float m = 0.f;
#pragma unroll
            for (int k = 0; k < 4; ++k)
#pragma unroll
                for (int i = 0; i < 4; ++i) m = fmaxf(m, fabsf(v[q][k][i]));
#pragma unroll
            for (int o = 32; o >= 1; o >>= 1) m = fmaxf(m, __shfl_xor(m, o));
            int ex = (m > 0.f) ? (8 - (int)((__float_as_uint(m) >> 23) & 0xffu) + 127 - ((__float_as_uint(m) & 0x7fffffu) > 0x600000u ? 1 : 0)) : 0;
            ex = min(max(ex, -100), 100);
            const float sc = __uint_as_float((unsigned)(127 + ex) << 23);
            u32x4 w;
#pragma unroll
            for (int k = 0; k < 4; ++k)
                w[k] = __builtin_amdgcn_cvt_pk_fp8_f32(v[q][k][2] * sc, v[q][k][3] * sc, __builtin_amdgcn_cvt_pk_fp8_f32(v[q][k][0] * sc, v[q][k][1] * sc, 0, false), true);
            if (r < rows) {
                *(u32x4*)(dst + (size_t)(lane >> 3) * (16384 * 128) + (size_t)r * 128 + (lane & 7) * 16) = w;
                if (lane == 0) scl[2 * r] = (bf16_t)(((unsigned)(127 - ex) << 23) >> 16);
            }
        }
    }
}
__device__ void ph_prep(const Params& p, unsigned char* smem) {
    float* tile = (float*)smem;
    cvt_rows(p.x, p.xb, (size_t)T_TOK * DM);
    cvt_rows(p.p, p.pb, (size_t)T_TOK * 256);
    cvt_table_fp8<true>(p, p.pu, p.u8, p.sc2, 16384);
    cvt_table_fp8<false>(p, p.pv, p.v8, p.sc2 + 1, 16384);
    cvt_rows(p.keys, p.keysb, (size_t)16 * 128 * 128);
    for (int i = blockIdx.x * 256 + threadIdx.x; i < T_TOK * 8; i += gridDim.x * 256) {
        const int t = i >> 3, j = i & 7;
        const float inv = powf(500000.0f, -(float)j * 0.125f);
        float sn, cs; sincosf((float)p.pos[t] * inv, &sn, &cs);
        p.rope[t * 16 + j] = cs; p.rope[t * 16 + 8 + j] = sn;
    }
    transpose_cvt<true>(p.w_in, p.WinT, DM, INW, tile);
    transpose_cvt(p.w_out, p.WoutT, DM, DM, tile);
    cvt_wq_fold(p, smem);
    transpose_cvt(p.ple_gate, p.WgT, DM, DM, tile);
    transpose_cvt(p.ple_proj, p.WpT, 256, DM, tile);
}

#define LDS_AS __attribute__((address_space(3)))
#define GEMM_STAGE 32768
template <bool PRE = false, bool NEXT = false>
__device__ __forceinline__ void gemm128(const bf16_t* __restrict__ A, int lda, const bf16_t* __restrict__ Bt, int ldb, int K,
                                        unsigned char* smem, f32x4 (&acc)[4][4],
                                        const bf16_t* __restrict__ nA = nullptr, int nlda = 0, const bf16_t* __restrict__ nB = nullptr, int nldb = 0) {
    LDS_AS unsigned char* lds = (LDS_AS unsigned char*)smem;
    const int tid = threadIdx.x, lane = tid & 63, wid = __builtin_amdgcn_readfirstlane(tid >> 6);
    const int wr = wid >> 1, wc = wid & 1, fr = lane & 15, fq = lane >> 4;
    const int nk = K / 64;
    const int prow = lane >> 3, pc = (lane & 7) ^ prow;
    const bf16_t* gA = A + (size_t)(wid * 32 + prow) * lda + pc * 8;
    const bf16_t* gB = Bt + (size_t)(wid * 32 + prow) * ldb + pc * 8;
    const size_t a8 = (size_t)8 * lda, b8 = (size_t)8 * ldb;
#define GEMM_ISSUE(kt, st) do { \
        _Pragma("unroll") for (int _i = 0; _i < 4; ++_i) { \
            __builtin_amdgcn_global_load_lds((const unsigned*)(gA + _i * a8 + (size_t)(kt) * 64), (LDS_AS unsigned*)(lds + (st) * GEMM_STAGE + (wid * 4 + _i) * 1024), 16, 0, 0); \
            __builtin_amdgcn_global_load_lds((const unsigned*)(gB + _i * b8 + (size_t)(kt) * 64), (LDS_AS unsigned*)(lds + (st) * GEMM_STAGE + 16384 + (wid * 4 + _i) * 1024), 16, 0, 0); \
        } } while (0)
    const int swz0 = ((0 * 4 + fq) ^ (fr & 7)) * 16, swz1 = ((1 * 4 + fq) ^ (fr & 7)) * 16;
    const int aoff = (wr * 64 + fr) * 128, boff = 16384 + (wc * 64 + fr) * 128;
    if (!PRE) GEMM_ISSUE(0, 0);
#pragma unroll 1
    for (int kt = 0; kt < nk; ++kt) {
        const int st = kt & 1;
        asm volatile("s_waitcnt vmcnt(0)" ::: "memory");
        __builtin_amdgcn_s_barrier();
        asm volatile("" ::: "memory");
        if (kt + 1 < nk) GEMM_ISSUE(kt + 1, st ^ 1);
        else if (NEXT) {
            const bf16_t* qA = nA + (size_t)(wid * 32 + prow) * nlda + pc * 8;
            const bf16_t* qB = nB + (size_t)(wid * 32 + prow) * nldb + pc * 8;
#pragma unroll
            for (int _i = 0; _i < 4; ++_i) {
                __builtin_amdgcn_global_load_lds((const unsigned*)(qA + (size_t)(_i * 8) * nlda), (LDS_AS unsigned*)(lds + (wid * 4 + _i) * 1024), 16, 0, 0);
                __builtin_amdgcn_global_load_lds((const unsigned*)(qB + (size_t)(_i * 8) * nldb), (LDS_AS unsigned*)(lds + 16384 + (wid * 4 + _i) * 1024), 16, 0, 0);
            }
        }
        const LDS_AS unsigned char* sb = lds + st * GEMM_STAGE;
        bf16x8 af0[4], bf0[4], af1[4], bf1[4];
#pragma unroll
        for (int mi = 0; mi < 4; ++mi) af0[mi] = *(const LDS_AS bf16x8*)(sb + aoff + mi * 2048 + swz0);
#pragma unroll
        for (int ni = 0; ni < 4; ++ni) bf0[ni] = *(const LDS_AS bf16x8*)(sb + boff + ni * 2048 + swz0);
#pragma unroll
        for (int mi = 0; mi < 4; ++mi) af1[mi] = *(const LDS_AS bf16x8*)(sb + aoff + mi * 2048 + swz1);
#pragma unroll
        for (int ni = 0; ni < 4; ++ni) bf1[ni] = *(const LDS_AS bf16x8*)(sb + boff + ni * 2048 + swz1);
#pragma unroll
        for (int mi = 0; mi < 4; ++mi)
#pragma unroll
            for (int ni = 0; ni < 4; ++ni)
                acc[mi][ni] = __builtin_amdgcn_mfma_f32_16x16x32_bf16(bf0[ni], af0[mi], acc[mi][ni], 0, 0, 0);
#pragma unroll
        for (int mi = 0; mi < 4; ++mi)
#pragma unroll
            for (int ni = 0; ni < 4; ++ni)
                acc[mi][ni] = __builtin_amdgcn_mfma_f32_16x16x32_bf16(bf1[ni], af1[mi], acc[mi][ni], 0, 0, 0);
        __builtin_amdgcn_sched_group_barrier(0x100, 8, 0);
#pragma unroll
        for (int q = 0; q < 8; ++q) { __builtin_amdgcn_sched_group_barrier(0x008, 2, 0); __builtin_amdgcn_sched_group_barrier(0x100, 1, 0); }
        __builtin_amdgcn_sched_group_barrier(0x008, 16, 0);
        asm volatile("s_waitcnt lgkmcnt(0)" ::: "memory");
        __builtin_amdgcn_s_barrier();
        asm volatile("" ::: "memory");
    }
#undef GEMM_ISSUE
}
#define GW_STAGE 24576
__device__ __forceinline__ void gemmW(const bf16_t* __restrict__ A, int lda, const bf16_t* __restrict__ Bt, int ldb, int K,
                                      unsigned char* smem, f32x4 (&acc)[4][8]) {
    LDS_AS unsigned char* lds = (LDS_AS unsigned char*)smem;
    const int tid = threadIdx.x, lane = tid & 63, wid = __builtin_amdgcn_readfirstlane(tid >> 6);
    const int wr = wid >> 1, wc = wid & 1, fr = lane & 15, fq = lane >> 4;
    const int nk = K / 32;
    const int prow = lane >> 2, pc = (lane & 3) ^ ((4 - ((prow >> 2) & 3)) & 3);
    const bf16_t* gA = A + (size_t)(wid * 32 + prow) * lda + pc * 8;
    const bf16_t* gB = Bt + (size_t)(wid * 64 + prow) * ldb + pc * 8;
    const size_t a16 = (size_t)16 * lda, b16 = (size_t)16 * ldb;
#define GW_ISSUE(kt, st) do { \
        _Pragma("unroll") for (int _i = 0; _i < 2; ++_i) \
            __builtin_amdgcn_global_load_lds((const unsigned*)(gA + _i * a16 + (size_t)(kt) * 32), (LDS_AS unsigned*)(lds + (st) * GW_STAGE + (wid * 2 + _i) * 1024), 16, 0, 0); \
        _Pragma("unroll") for (int _i = 0; _i < 4; ++_i) \
            __builtin_amdgcn_global_load_lds((const unsigned*)(gB + _i * b16 + (size_t)(kt) * 32), (LDS_AS unsigned*)(lds + (st) * GW_STAGE + 8192 + (wid * 4 + _i) * 1024), 16, 0, 0); \
        } while (0)
    const int swz = (fq ^ ((4 - ((fr >> 2) & 3)) & 3)) * 16;
    const int aoff = (wr * 64 + fr) * 64 + swz, boff = 8192 + (wc * 128 + fr) * 64 + swz;
    GW_ISSUE(0, 0);
#pragma unroll 1
    for (int kt = 0; kt < nk; ++kt) {
        const int st = kt & 1;
        asm volatile("s_waitcnt vmcnt(0)" ::: "memory");
        __builtin_amdgcn_s_barrier();
        asm volatile("" ::: "memory");
        if (kt + 1 < nk) GW_ISSUE(kt + 1, st ^ 1);
        const LDS_AS unsigned char* sb = lds + st * GW_STAGE;
        bf16x8 af[4], bfr[8];
#pragma unroll
        for (int mi = 0; mi < 4; ++mi) af[mi] = *(const LDS_AS bf16x8*)(sb + aoff + mi * 1024);
#pragma unroll
        for (int ni = 0; ni < 8; ++ni) bfr[ni] = *(const LDS_AS bf16x8*)(sb + boff + ni * 1024);
#pragma unroll
        for (int ni = 0; ni < 8; ++ni)
#pragma unroll
            for (int mi = 0; mi < 4; ++mi)
                acc[mi][ni] = __builtin_amdgcn_mfma_f32_16x16x32_bf16(bfr[ni], af[mi], acc[mi][ni], 0, 0, 0);
        asm volatile("s_waitcnt lgkmcnt(0)" ::: "memory");
        __builtin_amdgcn_s_barrier();
        asm volatile("" ::: "memory");
    }
#undef GW_ISSUE
}
__device__ __forceinline__ void zero_accw(f32x4 (&acc)[4][8]) {
#pragma unroll
    for (int a = 0; a < 4; ++a)
#pragma unroll
        for (int b = 0; b < 8; ++b) acc[a][b] = (f32x4){0.f, 0.f, 0.f, 0.f};
}
__device__ __forceinline__ void zero_acc(f32x4 (&acc)[4][4]) {
#pragma unroll
    for (int a = 0; a < 4; ++a)
#pragma unroll
        for (int b = 0; b < 4; ++b) acc[a][b] = (f32x4){0.f, 0.f, 0.f, 0.f};
}
#define GEMM_SMEM (2 * GEMM_STAGE)

__device__ void ph_gemm_in(const Params& p, unsigned char* smem, const int vb) {
    const int ntn = INW / 128;
    const int tid = threadIdx.x, lane = tid & 63, wid = tid >> 6, wr = wid >> 1, wc = wid & 1, fr = lane & 15, fq = lane >> 4;
    const int ntiles = (T_TOK / 128) * ntn;
    bool pre = false;
    for (int t = vb; t < ntiles; t += gridDim.x) {
        const int m0 = (t / ntn) * 128, n0 = (t % ntn) * 128;
        const int tn = t + gridDim.x;
        const bool has_next = tn < ntiles;
        const bf16_t* nA = p.xb + (size_t)((has_next ? tn : t) / ntn) * 128 * DM;
        const bf16_t* nB = p.WinT + (size_t)((has_next ? tn : t) % ntn) * 128 * DM;
        f32x4 acc[4][4]; zero_acc(acc);
        if (pre) { if (has_next) gemm128<true, true>(p.xb + (size_t)m0 * DM, DM, p.WinT + (size_t)n0 * DM, DM, DM, smem, acc, nA, DM, nB, DM);
                   else          gemm128<true, false>(p.xb + (size_t)m0 * DM, DM, p.WinT + (size_t)n0 * DM, DM, DM, smem, acc); }
        else     { if (has_next) gemm128<false, true>(p.xb + (size_t)m0 * DM, DM, p.WinT + (size_t)n0 * DM, DM, DM, smem, acc, nA, DM, nB, DM);
                   else          gemm128<false, false>(p.xb + (size_t)m0 * DM, DM, p.WinT + (size_t)n0 * DM, DM, DM, smem, acc); }
        pre = has_next;
        if (n0 >= 768) {
            const int cb = ((n0 - 768) >> 7) * 64 + wc * 32 + fq * 4;
#pragma unroll
            for (int mi = 0; mi < 4; ++mi) {
                const int row = m0 + wr * 64 + mi * 16 + fr;
#pragma unroll
                for (int k2 = 0; k2 < 2; ++k2) {
                    const f32x4 a = acc[mi][2 * k2], gt = acc[mi][2 * k2 + 1];
                    uint2 o; o.x = pack2(sigmul(a[0], gt[0]), sigmul(a[1], gt[1])); o.y = pack2(sigmul(a[2], gt[2]), sigmul(a[3], gt[3]));
                    *(uint2*)(p.hb + (size_t)row * INW + 768 + cb + k2 * 16) = o;
                }
            }
        } else {
#pragma unroll
        for (int mi = 0; mi < 4; ++mi) {
            const int row = m0 + wr * 64 + mi * 16 + fr;
#pragma unroll
            for (int ni = 0; ni < 4; ++ni) {
                const int col0 = n0 + wc * 64 + ni * 16;
                f32x4 v = acc[mi][ni];
                if (col0 < 640 && (col0 & 63) == 0) {
                    const f32x4 cs = *(const f32x4*)(p.rope + (size_t)row * 16 + (fq & 1) * 4), sn = *(const f32x4*)(p.rope + (size_t)row * 16 + 8 + (fq & 1) * 4);
#pragma unroll
                    for (int r = 0; r < 4; ++r) {
                        const float other = __shfl_xor(v[r], 32);
                        v[r] = (fq < 2) ? (v[r] * cs[r] - other * sn[r]) : (v[r] * cs[r] + other * sn[r]);
                    }
                }
                uint2 o; o.x = pack2(v[0], v[1]); o.y = pack2(v[2], v[3]);
                *(uint2*)(p.hb + (size_t)row * INW + col0 + fq * 4) = o;
            }
        }
        }
    }
}

#define ASTR 72
#define VSTR 260
typedef float f32x16 __attribute__((ext_vector_type(16)));
typedef unsigned u32x2 __attribute__((ext_vector_type(2)));
__device__ void ph_attn(const Params& p, unsigned char* smem, const int vb) {
    bf16_t* sK = (bf16_t*)smem;
    bf16_t* sVt = sK + 256 * ASTR;
    const int tid = threadIdx.x, lane = tid & 63, wid = tid >> 6, r32 = lane & 31, hh = lane >> 5;
    const float C1 = 0.125f * 1.4426950408889634f, LOG2E = 1.4426950408889634f;
    for (int u = vb; u < 16 * 16 * 2; u += gridDim.x) {
        const int kvh = u & 1, nb = (u >> 1) & 15, b = u >> 5;
        __syncthreads();
        for (int c = tid; c < 256 * 8; c += 256) {
            const int li = c >> 3, kc = c & 7;
            const int pos = nb * 128 - 128 + li;
            u32x4 kv = {0u, 0u, 0u, 0u}, vv = {0u, 0u, 0u, 0u};
            if (pos >= 0) {
                const bf16_t* base = p.hb + (size_t)(b * SEQ + pos) * INW;
                kv = *(const u32x4*)(base + 512 + kvh * 64 + kc * 8);
                vv = *(const u32x4*)(base + 640 + kvh * 64 + kc * 8);
            }
            *(u32x4*)(sK + li * ASTR + kc * 8) = kv;
#pragma unroll
            for (int i = 0; i < 4; ++i) {
                sVt[(kc * 8 + 2 * i) * VSTR + li] = (bf16_t)(vv[i] & 0xffffu);
                sVt[(kc * 8 + 2 * i + 1) * VSTR + li] = (bf16_t)(vv[i] >> 16);
            }
        }
        __syncthreads();
        const int hq = kvh * 4 + wid;
        const float sink2 = p.sinks[hq] * LOG2E;
        bf16x8 qn[4];
        {
            const size_t tr0 = (size_t)(b * SEQ + nb * 128 + r32);
#pragma unroll
            for (int ks = 0; ks < 4; ++ks) qn[ks] = *(const bf16x8*)(p.hb + tr0 * INW + hq * 64 + ks * 16 + hh * 8);
        }
#pragma unroll 1
        for (int qt = 0; qt < 4; ++qt) {
            const size_t trow = (size_t)(b * SEQ + nb * 128 + qt * 32 + r32);
            bf16x8 qf[4];
#pragma unroll
            for (int ks = 0; ks < 4; ++ks) qf[ks] = qn[ks];
            {
                const size_t trn = (size_t)(b * SEQ + nb * 128 + (qt < 3 ? qt + 1 : qt) * 32 + r32);
#pragma unroll
                for (int ks = 0; ks < 4; ++ks) qn[ks] = *(const bf16x8*)(p.hb + trn * INW + hq * 64 + ks * 16 + hh * 8);
            }
            f32x16 S[5];
#pragma unroll
            for (int j = 0; j < 5; ++j) {
#pragma unroll
                for (int r = 0; r < 16; ++r) S[j][r] = 0.f;
#pragma unroll
                for (int ks = 0; ks < 4; ++ks) {
                    const bf16x8 a = *(const bf16x8*)(sK + ((qt + j) * 32 + r32) * ASTR + ks * 16 + hh * 8);
                    S[j] = __builtin_amdgcn_mfma_f32_32x32x16_bf16(a, qf[ks], S[j], 0, 0, 0);
                }
            }
            float m2 = sink2;
#pragma unroll
            for (int j = 0; j < 5; ++j) {
                const bool tile_ok = (nb > 0) || (qt + j >= 4);
#pragma unroll
                for (int r = 0; r < 16; ++r) {
                    const int kl = (r & 3) + 8 * (r >> 2) + 4 * hh;
                    bool ok = tile_ok;
                    if (j == 0) ok = ok && (kl > r32);
                    if (j == 4) ok = ok && (kl <= r32);
                    const float t = ok ? S[j][r] * C1 : -1.0e30f;
                    S[j][r] = t;
                    m2 = fmaxf(m2, t);
                }
            }
            m2 = fmaxf(m2, __shfl_xor(m2, 32));
            float l = 0.f;
#pragma unroll
            for (int j = 0; j < 5; ++j)
#pragma unroll
                for (int r = 0; r < 16; ++r) { const float e = __builtin_amdgcn_exp2f(S[j][r] - m2); S[j][r] = e; l += e; }
            l += __shfl_xor(l, 32);
            l += __builtin_amdgcn_exp2f(sink2 - m2);
            f32x16 O[2];
#pragma unroll
            for (int dt = 0; dt < 2; ++dt)
#pragma unroll
                for (int r = 0; r < 16; ++r) O[dt][r] = 0.f;
#pragma unroll
            for (int j = 0; j < 5; ++j)
#pragma unroll
                for (int s2 = 0; s2 < 2; ++s2) {
                    u32x4 pw;
#pragma unroll
                    for (int k = 0; k < 4; ++k) pw[k] = pack2(S[j][8 * s2 + 2 * k], S[j][8 * s2 + 2 * k + 1]);
                    const bf16x8 pf = __builtin_bit_cast(bf16x8, pw);
                    const int kbase = (qt + j) * 32 + 16 * s2 + 4 * hh;
#pragma unroll
                    for (int dt = 0; dt < 2; ++dt) {
                        const bf16_t* vp = sVt + (dt * 32 + r32) * VSTR + kbase;
                        const u32x2 v0 = *(const u32x2*)(vp), v1 = *(const u32x2*)(vp + 8);
                        const u32x4 vw = {v0[0], v0[1], v1[0], v1[1]};
                        O[dt] = __builtin_amdgcn_mfma_f32_32x32x16_bf16(__builtin_bit_cast(bf16x8, vw), pf, O[dt], 0, 0, 0);
                    }
                }
            const float il = __builtin_amdgcn_rcpf(l);
#pragma unroll
            for (int dt = 0; dt < 2; ++dt)
#pragma unroll
                for (int g = 0; g < 4; ++g) {
                    u32x2 w;
                    w[0] = pack2(O[dt][4 * g] * il, O[dt][4 * g + 1] * il);
                    w[1] = pack2(O[dt][4 * g + 2] * il, O[dt][4 * g + 3] * il);
                    *(u32x2*)(p.mixb + trow * DM + hq * 64 + dt * 32 + 8 * g + 4 * hh) = w;
                }
        }
    }
}

#define CV_ROWS 62
__device__ void ph_conv(const Params& p, unsigned char* smem, const int vb) {
    bf16_t* gl = (bf16_t*)smem;
    float* red = (float*)(smem + CV_ROWS * 1024);
    const int tid = threadIdx.x, lane = tid & 63, wid = tid >> 6;
    const f32x2 lg = *(const f32x2*)(p.cln_g + 2 * tid), lb = *(const f32x2*)(p.cln_b + 2 * tid);
    for (int u = vb; u < T_TOK / 32; u += gridDim.x) {
        const int tok0 = u * 32, s0 = tok0 & (SEQ - 1);
        __syncthreads();
#pragma unroll 1
        for (int bt = 0; bt < 2; ++bt) {
            u32x4 av[8];
#pragma unroll
            for (int it = 0; it < 8; ++it) {
                const int ch = tid + (bt * 8 + it) * 256, row = min(ch >> 6, CV_ROWS - 1), k = ch & 63;
                const int rr = (s0 - 30 + row >= 0) ? row : 30;
                av[it] = *(const u32x4*)(p.hb + (size_t)(tok0 - 30 + rr) * INW + 768 + k * 8);
            }
#pragma unroll
            for (int it = 0; it < 8; ++it) {
                const int ch = tid + (bt * 8 + it) * 256, row = ch >> 6, k = ch & 63;
                const bool ok = (s0 - 30 + row >= 0);
                const u32x4 o = ok ? av[it] : (u32x4){0u, 0u, 0u, 0u};
                if (row < CV_ROWS) *(u32x4*)(gl + row * 512 + k * 8) = o;
            }
        }
        __syncthreads();
        float w0[31], w1[31];
#pragma unroll
        for (int k = 0; k < 31; ++k) { const f32x2 wv = *(const f32x2*)(p.conv_w + k * 512 + 2 * tid); w0[k] = wv.x; w1[k] = wv.y; }
        const f32x2 bias = *(const f32x2*)(p.conv_b + 2 * tid);
#pragma unroll 1
        for (int jh = 0; jh < 2; ++jh) {
            float a0[16], a1[16];
#pragma unroll
            for (int jl = 0; jl < 16; ++jl) { a0[jl] = bias.x; a1[jl] = bias.y; }
            const bf16_t* gp = gl + (jh * 16) * 512 + 2 * tid;
#pragma unroll
            for (int il = 0; il < 46; ++il) {
                const unsigned gw = *(const unsigned*)(gp + il * 512);
                const float g0 = bflo(gw), g1 = bfhi(gw);
#pragma unroll
                for (int jl = 0; jl < 16; ++jl)
                    if (il - jl >= 0 && il - jl <= 30) { a0[jl] += w0[il - jl] * g0; a1[jl] += w1[il - jl] * g1; }
                if ((il & 3) == 3) __builtin_amdgcn_sched_barrier(0);
            }
            float v[32];
#pragma unroll
            for (int jl = 0; jl < 16; ++jl) { v[jl] = a0[jl] + a1[jl]; v[16 + jl] = a0[jl] * a0[jl] + a1[jl] * a1[jl]; }
#pragma unroll
            for (int st = 16; st >= 1; st >>= 1) {
                const bool up = (lane & st) != 0;
#pragma unroll
                for (int i2 = 0; i2 < st; ++i2) {
                    const float keep = up ? v[i2 + st] : v[i2], send = up ? v[i2] : v[i2 + st];
                    v[i2] = keep + __shfl_xor(send, st);
                }
            }
            const float tot = v[0] + __shfl_xor(v[0], 32);
            __syncthreads();
            if (lane < 32) red[wid * 32 + lane] = tot;
            __syncthreads();
#pragma unroll
            for (int jl = 0; jl < 16; ++jl) {
                const float sm = (red[jl] + red[32 + jl]) + (red[64 + jl] + red[96 + jl]);
                const float sq = (red[16 + jl] + red[48 + jl]) + (red[80 + jl] + red[112 + jl]);
                const float mu = sm * (1.0f / 512.0f);
                const float rstd = rsqrtf(fmaxf(sq * (1.0f / 512.0f) - mu * mu, 0.f) + LN_EPS);
                const float y0 = (a0[jl] - mu) * rstd * lg.x + lb.x, y1 = (a1[jl] - mu) * rstd * lg.y + lb.y;
                *(unsigned*)(p.mixb + (size_t)(tok0 + jh * 16 + jl) * DM + 512 + 2 * tid) = pack2(sigmul(y0, y0), sigmul(y1, y1));
            }
        }
    }
}

__device__ void ph_gemm_out(const Params& p, unsigned char* smem, const int vb) {
    const int ntn = DM / 256;
    const int tid = threadIdx.x, lane = tid & 63, wid = tid >> 6, wr = wid >> 1, wc = wid & 1, fr = lane & 15, fq = lane >> 4;
    for (int t = vb; t < (T_TOK / 128) * ntn; t += gridDim.x) {
        const int m0 = (t / ntn) * 128, n0 = (t % ntn) * 256;
        f32x4 acc[4][8]; zero_accw(acc);
        u32x2 xq[2][8];
#define GO_XLD(mi, buf) do { const int _row = m0 + wr * 64 + (mi) * 16 + fr; \
            _Pragma("unroll") for (int _ni = 0; _ni < 8; ++_ni) xq[buf][_ni] = *(const u32x2*)(p.xb + (size_t)_row * DM + n0 + wc * 128 + _ni * 16 + fq * 4); } while (0)
        gemmW(p.mixb + (size_t)m0 * DM, DM, p.WoutT + (size_t)n0 * DM, DM, DM, smem, acc);
        GO_XLD(0, 0);
#pragma unroll
        for (int mi = 0; mi < 4; ++mi) {
            const int row = m0 + wr * 64 + mi * 16 + fr;
            if (mi < 3) GO_XLD(mi + 1, (mi + 1) & 1);
            float sm = 0.f, sq = 0.f;
#pragma unroll
            for (int ni = 0; ni < 8; ++ni) {
                const int col = n0 + wc * 128 + ni * 16 + fq * 4;
                const u32x2 xw = xq[mi & 1][ni];
                const f32x4 xv = {bflo(xw[0]), bfhi(xw[0]), bflo(xw[1]), bfhi(xw[1])};
                const f32x4 y = xv * ALPHA + acc[mi][ni];
                sm += (y[0] + y[1]) + (y[2] + y[3]); sq += (y[0] * y[0] + y[1] * y[1]) + (y[2] * y[2] + y[3] * y[3]);
                u32x2 o; o[0] = pack2(y[0], y[1]); o[1] = pack2(y[2], y[3]);
                *(u32x2*)(p.y1b + (size_t)row * DM + col) = o;
            }
            sm += __shfl_xor(sm, 16); sq += __shfl_xor(sq, 16); sm += __shfl_xor(sm, 32); sq += __shfl_xor(sq, 32);
            if (fq == 0) *(f32x2*)(p.stats + (size_t)row * 16 + ((n0 >> 8) * 2 + wc) * 2) = (f32x2){sm, sq};
        }
    }
}

__device__ __forceinline__ void ln_row(const float* __restrict__ src, const float* __restrict__ g, const float* __restrict__ bta,
                                       float* __restrict__ dstf, bf16_t* __restrict__ dstb, int lane) {
    f32x4 v[4]; float s = 0.f;
#pragma unroll
    for (int i = 0; i < 4; ++i) { v[i] = *(const f32x4*)(src + i * 256 + lane * 4); s += (v[i][0] + v[i][1]) + (v[i][2] + v[i][3]); }
    const float mu = wave_sum(s) * (1.0f / 1024.0f);
    float q = 0.f;
#pragma unroll
    for (int i = 0; i < 4; ++i) { const f32x4 d = v[i] - mu; q += (d[0] * d[0] + d[1] * d[1]) + (d[2] * d[2] + d[3] * d[3]); }
    const float rstd = rsqrtf(wave_sum(q) * (1.0f / 1024.0f) + LN_EPS);
#pragma unroll
    for (int i = 0; i < 4; ++i) {
        const f32x4 gg = *(const f32x4*)(g + i * 256 + lane * 4), bb = *(const f32x4*)(bta + i * 256 + lane * 4);
        const f32x4 y = (v[i] - mu) * rstd * gg + bb;
        if (dstf) *(f32x4*)(dstf + i * 256 + lane * 4) = y;
        if (dstb) { uint2 o; o.x = pack2(y[0], y[1]); o.y = pack2(y[2], y[3]); *(uint2*)(dstb + i * 256 + lane * 4) = o; }
    }
}
__device__ void ph_ln2(const Params& p, const int vb) {
    const int lane = threadIdx.x & 63, wid = threadIdx.x >> 6;
    for (int r = vb * 4 + wid; r < T_TOK; r += gridDim.x * 4)
        ln_row(p.out + (size_t)r * DM, p.ln2_g, p.ln2_b, p.out + (size_t)r * DM, (bf16_t*)nullptr, lane);
}

#define QSTR 136
__device__ __forceinline__ int f2key(float f) { const int b = __float_as_int(f); return b ^ ((b >> 31) & 0x7fffffff); }
__device__ __forceinline__ float key2f(int k) { return __int_as_float(k ^ ((k >> 31) & 0x7fffffff)); }
__device__ __forceinline__ void sort16_desc(int (&a)[16]) {
#pragma unroll
    for (int lk = 1; lk <= 4; ++lk) {
#pragma unroll
        for (int lj = lk - 1; lj >= 0; --lj) {
            const int k = 1 << lk, j = 1 << lj;
#pragma unroll
            for (int i = 0; i < 16; ++i) {
                const int l = i ^ j;
                if (l > i) {
                    const int hi = max(a[i], a[l]), lo = min(a[i], a[l]);
                    if ((i & k) == 0) { a[i] = hi; a[l] = lo; } else { a[i] = lo; a[l] = hi; }
                }
            }
        }
    }
}
__device__ __forceinline__ void merge_top16(int (&a)[16], const int (&b)[16]) {
#pragma unroll
    for (int i = 0; i < 16; ++i) a[i] = max(a[i], b[15 - i]);
#pragma unroll
    for (int lj = 3; lj >= 0; --lj) {
        const int j = 1 << lj;
#pragma unroll
        for (int i = 0; i < 16; ++i) {
            const int l = i ^ j;
            if (l > i) { const int hi = max(a[i], a[l]), lo = min(a[i], a[l]); a[i] = hi; a[l] = lo; }
        }
    }
}
__device__ __forceinline__ void top16_of_64(int (&v)[4][16]) {
    sort16_desc(v[0]); sort16_desc(v[1]); sort16_desc(v[2]); sort16_desc(v[3]);
    merge_top16(v[0], v[1]); merge_top16(v[0], v[2]); merge_top16(v[0], v[3]);
}

__device__ void ph_mprep(const Params& p, unsigned char* smem, const int vb) {
    if (vb < 8) {
        const int n = vb * 256 + threadIdx.x, hp = n >> 7;
        const float* kr = p.keys + (size_t)n * 128;
        float a = 0.f, b = 0.f;
        for (int c4 = 0; c4 < 128; c4 += 4) {
            const f32x4 kv = *(const f32x4*)(kr + c4), wg = *(const f32x4*)(p.wgb + hp * 128 + c4), wb = *(const f32x4*)(p.wgb + 2048 + hp * 128 + c4);
            a += (kv[0] * wg[0] + kv[1] * wg[1]) + (kv[2] * wg[2] + kv[3] * wg[3]);
            b += (kv[0] * wb[0] + kv[1] * wb[1]) + (kv[2] * wb[2] + kv[3] * wb[3]);
        }
        u32x4 c0 = {pack2(a, b), 0u, 0u, 0u}; const u32x4 z4 = {0u, 0u, 0u, 0u};
        u32x4* me = (u32x4*)(p.mext + (size_t)n * 32);
        me[0] = c0; me[1] = z4; me[2] = z4; me[3] = z4;
    }
    const int tid = threadIdx.x, lane = tid & 63, wid = tid >> 6, wr = wid >> 1, wc = wid & 1, fr = lane & 15, fq = lane >> 4;
    for (int t = vb; t < 16 * 8; t += gridDim.x) {
        const int hp = t >> 3, d0 = (t & 7) * 128;
        f32x4 acc[4][4]; zero_acc(acc);
        gemm128(p.keysb + (size_t)hp * 128 * 128, 128, p.Wqb + (size_t)d0 * 2048 + hp * 128, 2048, 128, smem, acc);
#pragma unroll
        for (int mi = 0; mi < 4; ++mi)
#pragma unroll
            for (int ni = 0; ni < 4; ++ni) {
                uint2 o; o.x = pack2(acc[mi][ni][0], acc[mi][ni][1]); o.y = pack2(acc[mi][ni][2], acc[mi][ni][3]);
                *(uint2*)(p.MT + (size_t)(hp * 128 + wr * 64 + mi * 16 + fr) * DM + d0 + wc * 64 + ni * 16 + fq * 4) = o;
            }
    }
}

__device__ __forceinline__ void route_topk(const f32x16 (&S)[8], int pp, int hh, int (&K)[16]) {
    int v[4][16];
#pragma unroll
    for (int mt = 0; mt < 4; ++mt)
#pragma unroll
        for (int r = 0; r < 16; ++r) {
            const int n = mt * 32 + (r & 3) + 8 * (r >> 2) + 4 * hh;
            v[mt][r] = (f2key(S[pp * 4 + mt][r]) & ~0x7F) | (127 - n);
        }
    top16_of_64(v);
    int o[16];
#pragma unroll
    for (int i = 0; i < 16; ++i) o[i] = __shfl_xor(v[0][i], 32);
    merge_top16(v[0], o);
#pragma unroll
    for (int i = 0; i < 16; ++i) K[i] = v[0][i];
}
#define RT_STEPS 33
template <bool PRE, bool NEXT>
__device__ __forceinline__ void route_gemm(const Params& p, unsigned char* smem, int m0, int h, f32x16 (&S)[8], int nm0, int nh, int& sp) {
    LDS_AS unsigned char* lds = (LDS_AS unsigned char*)smem;
    const int tid = threadIdx.x, lane = tid & 63, wid = __builtin_amdgcn_readfirstlane(tid >> 6);
    const int r32 = lane & 31, hh = lane >> 5;
    const int prow = lane >> 2, pc = (lane & 3) ^ ((4 - ((prow >> 2) & 3)) & 3);
    const bf16_t* gA = p.y1b + (size_t)(m0 + wid * 32 + prow) * DM + pc * 8;
    const bf16_t* gB = p.MT + (size_t)(h * 256 + wid * 64 + prow) * DM + pc * 8;
    const bf16_t* eA = p.yext + (size_t)(m0 + wid * 32 + prow) * 32 + pc * 8;
    const bf16_t* eB = p.mext + (size_t)(h * 256 + wid * 64 + prow) * 32 + pc * 8;
    const size_t r16 = (size_t)16 * DM;
#define RH_ISSUE_AT(pa, sa, pb, sb_, st) do { \
        _Pragma("unroll") for (int _i = 0; _i < 2; ++_i) \
            __builtin_amdgcn_global_load_lds((const unsigned*)((pa) + _i * (sa)), (LDS_AS unsigned*)(lds + (st) * GW_STAGE + (wid * 2 + _i) * 1024), 16, 0, 0); \
        _Pragma("unroll") for (int _i = 0; _i < 4; ++_i) \
            __builtin_amdgcn_global_load_lds((const unsigned*)((pb) + _i * (sb_)), (LDS_AS unsigned*)(lds + (st) * GW_STAGE + 8192 + (wid * 4 + _i) * 1024), 16, 0, 0); \
        } while (0)
#pragma unroll
    for (int mt = 0; mt < 8; ++mt)
#pragma unroll
        for (int r = 0; r < 16; ++r) S[mt][r] = 0.f;
    const int fx = (4 - ((r32 >> 2) & 3)) & 3;
    const int toff = (wid * 32 + r32) * 64, koff = 8192 + r32 * 64;
    if (!PRE) RH_ISSUE_AT(gA, r16, gB, r16, sp);
#pragma unroll 1
    for (int kt = 0; kt < RT_STEPS; ++kt) {
        const int st = (kt + sp) & 1;
        asm volatile("s_waitcnt vmcnt(0)" ::: "memory");
        __builtin_amdgcn_s_barrier();
        asm volatile("" ::: "memory");
        if (kt + 1 < RT_STEPS - 1) RH_ISSUE_AT(gA + (size_t)(kt + 1) * 32, r16, gB + (size_t)(kt + 1) * 32, r16, st ^ 1);
        else if (kt + 1 == RT_STEPS - 1) RH_ISSUE_AT(eA, (size_t)(16 * 32), eB, (size_t)(16 * 32), st ^ 1);
        else if (NEXT) {
            const bf16_t* qA = p.y1b + (size_t)(nm0 + wid * 32 + prow) * DM + pc * 8;
            const bf16_t* qB = p.MT + (size_t)(nh * 256 + wid * 64 + prow) * DM + pc * 8;
            RH_ISSUE_AT(qA, r16, qB, r16, st ^ 1);
        }
        const LDS_AS unsigned char* sb = lds + st * GW_STAGE;
#pragma unroll
        for (int k16 = 0; k16 < 2; ++k16) {
            const int sw = ((k16 * 2 + hh) ^ fx) * 16;
            const bf16x8 b = *(const LDS_AS bf16x8*)(sb + toff + sw);
#pragma unroll
            for (int mt = 0; mt < 8; ++mt) {
                const bf16x8 a = *(const LDS_AS bf16x8*)(sb + koff + mt * 2048 + sw);
                S[mt] = __builtin_amdgcn_mfma_f32_32x32x16_bf16(a, b, S[mt], 0, 0, 0);
            }
        }
        asm volatile("s_waitcnt lgkmcnt(0)" ::: "memory");
        __builtin_amdgcn_s_barrier();
        asm volatile("" ::: "memory");
    }
    sp ^= (RT_STEPS & 1);
#undef RH_ISSUE_AT
}

__device__ void ph_route(const Params& p, unsigned char* smem, const int vb) {
    const int tid = threadIdx.x, lane = tid & 63, wid = tid >> 6;
    const int r32 = lane & 31, hh = lane >> 5;
    const int hmask = -hh;
    int* KL = (int*)(smem + 2 * GW_STAGE + (size_t)wid * 32 * 33 * 4);
    const int nunits = (T_TOK / 128) * 8;
    bool pre = false; int sp = 0;
    for (int u = vb; u < nunits; u += gridDim.x) {
        const int m0 = (u >> 3) * 128, h = u & 7;
        const int un = u + gridDim.x;
        const bool has_next = un < nunits;
        const int nm0 = ((has_next ? un : u) >> 3) * 128, nh = (has_next ? un : u) & 7;
        float mu, rstd;
        {
            const float* stp = p.stats + (size_t)(m0 + wid * 32 + r32) * 16;
            const f32x4 a = *(const f32x4*)(stp), b = *(const f32x4*)(stp + 4), c4 = *(const f32x4*)(stp + 8), d = *(const f32x4*)(stp + 12);
            const float sm = (a[0] + a[2]) + (b[0] + b[2]) + (c4[0] + c4[2]) + (d[0] + d[2]);
            const float sq = (a[1] + a[3]) + (b[1] + b[3]) + (c4[1] + c4[3]) + (d[1] + d[3]);
            mu = sm * (1.0f / 1024.0f);
            rstd = rsqrtf(fmaxf(sq * (1.0f / 1024.0f) - mu * mu, 0.f) + LN_EPS);
        }
        {
            bf16_t* ye = p.yext + (size_t)(m0 + wid * 32 + r32) * 32 + hh * 16;
            const u32x4 z4 = {0u, 0u, 0u, 0u};
            u32x4 c0 = z4; if (hh == 0) c0[0] = pack2(-mu, __builtin_amdgcn_rcpf(rstd));
            *(u32x4*)(ye) = c0; *(u32x4*)(ye + 8) = z4;
        }
        f32x16 S[8];
        if (pre) { if (has_next) route_gemm<true, true>(p, smem, m0, h, S, nm0, nh, sp); else route_gemm<true, false>(p, smem, m0, h, S, nm0, nh, sp); }
        else     { if (has_next) route_gemm<false, true>(p, smem, m0, h, S, nm0, nh, sp); else route_gemm<false, false>(p, smem, m0, h, S, nm0, nh, sp); }
        int K0[16], K1[16];
        route_topk(S, 0, hh, K0);
        route_topk(S, 1, hh, K1);
        pre = has_next;
#pragma unroll
        for (int i = 0; i < 16; ++i) KL[r32 * 33 + hh * 16 + i] = K0[i] ^ ((K0[i] ^ K1[i]) & hmask);
        float s1[16], s2[16];
#pragma unroll
        for (int i = 0; i < 16; ++i) { s1[i] = key2f(K0[i] & ~0x7F); s2[i] = key2f(K1[i] & ~0x7F); }
        int c[4][16];
#pragma unroll
        for (int i = 0; i < 16; ++i)
#pragma unroll
            for (int j = 0; j < 16; ++j)
                if ((i + 1) * (j + 1) <= 16) {
                    constexpr int OFFS[16] = {0, 16, 24, 29, 33, 36, 38, 40, 42, 43, 44, 45, 46, 47, 48, 49};
                    const int q = OFFS[i] + j;
                    c[q >> 4][q & 15] = (f2key(s1[i] + s2[j]) & ~0xFF) | (255 - (i * 16 + j));
                }
#pragma unroll
        for (int qq = 50; qq < 64; ++qq) c[qq >> 4][qq & 15] = (int)0x80000000;
        top16_of_64(c);
        const float mx = key2f(c[0][0] & ~0xFF);
        float e[16]; float den = 0.f;
#pragma unroll
        for (int i = 0; i < 16; ++i) { e[i] = __expf(rstd * (key2f(c[0][i] & ~0xFF) - mx)); den += e[i]; }
        const float inv = __builtin_amdgcn_rcpf(den);
        const size_t ob = (size_t)(m0 + wid * 32 + r32) * 128 + h * 16 + hh * 8;
        int idv[8]; float gv[8];
#pragma unroll
        for (int qq = 0; qq < 8; ++qq) {
            const int F = c[0][qq] ^ ((c[0][qq] ^ c[0][8 + qq]) & hmask);
            gv[qq] = __int_as_float(__float_as_int(e[qq]) ^ ((__float_as_int(e[qq]) ^ __float_as_int(e[8 + qq])) & hmask)) * inv;
            const int idx = 255 - (F & 0xFF);
            const int k0 = KL[r32 * 33 + (idx >> 4)], k1 = KL[r32 * 33 + 16 + (idx & 15)];
            idv[qq] = (127 - (k0 & 0x7F)) * 128 + (127 - (k1 & 0x7F));
        }
        *(int4*)(p.ids + ob) = make_int4(idv[0], idv[1], idv[2], idv[3]);
        *(int4*)(p.ids + ob + 4) = make_int4(idv[4], idv[5], idv[6], idv[7]);
        *(float4*)(p.gates + ob) = make_float4(gv[0], gv[1], gv[2], gv[3]);
        *(float4*)(p.gates + ob + 4) = make_float4(gv[4], gv[5], gv[6], gv[7]);
    }
}

__device__ __forceinline__ float gelu_gate(float h, float g) { return 0.5f * h * (1.0f + erff(h * 0.70710678118654752f)) * g; }

__device__ void ph_peer_u(const Params& p, unsigned char* smem, const int vb) {
    const int lane = threadIdx.x & 63, wid = __builtin_amdgcn_readfirstlane(threadIdx.x >> 6);
    const int q = lane >> 3, c = lane & 7, j = lane & 15, kb = lane >> 4;
    const int nlb = gridDim.x >> 3, s = vb / nlb, lb = vb - s * nlb;
    const int stride = nlb * 4, t0 = lb * 4 + wid;
    const int ntok = (T_TOK - t0 + stride - 1) / stride;
    if (ntok <= 0) return;
    LDS_AS unsigned char* wb = (LDS_AS unsigned char*)smem + wid * 18432;
    LDS_AS unsigned char* ring = wb + 16384;
    const unsigned char* ubase = p.u8 + (size_t)s * (16384 * 128) + ((c ^ q) * 16);
    const unsigned char* ubase1 = p.u8 + (size_t)s * (16384 * 128) + ((c ^ q ^ 1) * 16);
    const unsigned char* rsrc; unsigned rstr;
    if (lane < 32) { rsrc = (const unsigned char*)p.ids + lane * 16; rstr = 512; }
    else if (lane < 48) { rsrc = (const unsigned char*)p.y1b + s * 256 + (lane - 32) * 16; rstr = 2048; }
    else { rsrc = (const unsigned char*)p.stats + ((2 * s + 1) >> 2) * 16; rstr = 64; }
#define PM_TOK(n) (t0 + ((n) < ntok ? (n) : ntok - 1) * stride)
#define PM_RING(n) do { if (lane < 49) __builtin_amdgcn_global_load_lds((const unsigned*)(rsrc + (size_t)PM_TOK(n) * rstr), (LDS_AS unsigned*)(ring + ((n) & 1) * 1024), 16, 0, 0); } while (0)
#define PM_IDS(n, ia, ib) do { const LDS_AS u32x4* _q = (const LDS_AS u32x4*)(ring + ((n) & 1) * 1024 + q * 32); \
        const u32x4 _a0 = _q[0], _a1 = _q[1], _b0 = _q[16], _b1 = _q[17]; \
        ia[0] = _a0[0]; ia[1] = _a0[1]; ia[2] = _a0[2]; ia[3] = _a0[3]; ia[4] = _a1[0]; ia[5] = _a1[1]; ia[6] = _a1[2]; ia[7] = _a1[3]; \
        ib[0] = _b0[0]; ib[1] = _b0[1]; ib[2] = _b0[2]; ib[3] = _b0[3]; ib[4] = _b1[0]; ib[5] = _b1[1]; ib[6] = _b1[2]; ib[7] = _b1[3]; } while (0)
#define PM_DMA(i, id) __builtin_amdgcn_global_load_lds((const unsigned*)((((i) & 1) ? ubase1 : ubase) + (size_t)(id) * 128), (LDS_AS unsigned*)(wb + (i) * 1024), 16, 0, 0)
    const int key = (j & 7) ^ (j >> 3);
    const LDS_AS unsigned char* brd = wb + j * 128 + (((2 * kb) ^ key) * 16);
    const int bx1 = (key & 1) ? -16 : 16;
    const LDS_AS unsigned char* ard = ring + (j & 1) * 1024 + 832 + kb * 32;
    PM_RING(0); PM_RING(1);
    asm volatile("s_waitcnt vmcnt(0)" ::: "memory");
    {
        unsigned ia[8], ib[8]; PM_IDS(0, ia, ib);
#pragma unroll
        for (int m = 0; m < 4; ++m) { PM_DMA(2 * m, ia[m]); PM_DMA(2 * m + 1, ib[m]); }
#pragma unroll
        for (int m = 4; m < 8; ++m) { PM_DMA(2 * m, ia[m]); PM_DMA(2 * m + 1, ib[m]); }
    }
    const int sqi = ((2 * s + 1) & 3) * 4;
#pragma unroll 1
    for (int n = 0; n < ntok; ++n) {
        const int t = t0 + n * stride;
        LDS_AS unsigned char* slot = ring + (n & 1) * 1024;
        const unsigned xw = *(const LDS_AS unsigned*)(slot + 512 + lane * 4);
        const float ssq = *(const LDS_AS float*)(slot + 768 + sqi);
        const int e2 = (int)(__float_as_uint(ssq) >> 23) - 126;
        int eh = (e2 + 1) >> 1; eh = eh < -60 ? -60 : (eh > 60 ? 60 : eh);
        const float sc = __uint_as_float((unsigned)(127 + 8 - eh) << 23), isc = __uint_as_float((unsigned)(127 - 8 + eh) << 23);
        const float x0 = bflo(xw) * sc, x1 = bfhi(xw) * sc;
        const unsigned h8 = (unsigned)__builtin_amdgcn_cvt_pk_fp8_f32(x0, x1, 0, false);
        const f32x2 hd = __builtin_amdgcn_cvt_pk_f32_fp8((int)h8, false);
        const unsigned l8 = (unsigned)__builtin_amdgcn_cvt_pk_fp8_f32(x0 - hd.x, x1 - hd.y, 0, false);
        *(LDS_AS unsigned short*)(ring + 832 + lane * 2) = (unsigned short)h8;
        *(LDS_AS unsigned short*)(ring + 1024 + 832 + lane * 2) = (unsigned short)l8;
        const u32x4 xa0 = *(const LDS_AS u32x4*)(ard), xa1 = *(const LDS_AS u32x4*)(ard + 16);
        i64 xa[4];
        xa[0] = (i64)(((unsigned long long)xa0[1] << 32) | xa0[0]); xa[1] = (i64)(((unsigned long long)xa0[3] << 32) | xa0[2]);
        xa[2] = (i64)(((unsigned long long)xa1[1] << 32) | xa1[0]); xa[3] = (i64)(((unsigned long long)xa1[3] << 32) | xa1[2]);
        f32x4 acc[8];
        asm volatile("s_waitcnt vmcnt(8)" ::: "memory");
#pragma unroll
        for (int m = 0; m < 4; ++m) {
            const u32x4 b0 = *(const LDS_AS u32x4*)(brd + m * 2048), b1 = *(const LDS_AS u32x4*)(brd + m * 2048 + bx1);
            f32x4 a = {0.f, 0.f, 0.f, 0.f};
            a = __builtin_amdgcn_mfma_f32_16x16x32_fp8_fp8(xa[0], (i64)(((unsigned long long)b0[1] << 32) | b0[0]), a, 0, 0, 0);
            a = __builtin_amdgcn_mfma_f32_16x16x32_fp8_fp8(xa[1], (i64)(((unsigned long long)b0[3] << 32) | b0[2]), a, 0, 0, 0);
            a = __builtin_amdgcn_mfma_f32_16x16x32_fp8_fp8(xa[2], (i64)(((unsigned long long)b1[1] << 32) | b1[0]), a, 0, 0, 0);
            a = __builtin_amdgcn_mfma_f32_16x16x32_fp8_fp8(xa[3], (i64)(((unsigned long long)b1[3] << 32) | b1[2]), a, 0, 0, 0);
            acc[m] = a;
        }
        {
            unsigned ia[8], ib[8]; PM_IDS(n + 1, ia, ib);
            PM_RING(n + 2);
#pragma unroll
            for (int m = 0; m < 4; ++m) { PM_DMA(2 * m, ia[m]); PM_DMA(2 * m + 1, ib[m]); }
            asm volatile("s_waitcnt vmcnt(9)" ::: "memory");
#pragma unroll
            for (int m = 4; m < 8; ++m) {
                const u32x4 b0 = *(const LDS_AS u32x4*)(brd + m * 2048), b1 = *(const LDS_AS u32x4*)(brd + m * 2048 + bx1);
                f32x4 a = {0.f, 0.f, 0.f, 0.f};
                a = __builtin_amdgcn_mfma_f32_16x16x32_fp8_fp8(xa[0], (i64)(((unsigned long long)b0[1] << 32) | b0[0]), a, 0, 0, 0);
                a = __builtin_amdgcn_mfma_f32_16x16x32_fp8_fp8(xa[1], (i64)(((unsigned long long)b0[3] << 32) | b0[2]), a, 0, 0, 0);
                a = __builtin_amdgcn_mfma_f32_16x16x32_fp8_fp8(xa[2], (i64)(((unsigned long long)b1[1] << 32) | b1[0]), a, 0, 0, 0);
                a = __builtin_amdgcn_mfma_f32_16x16x32_fp8_fp8(xa[3], (i64)(((unsigned long long)b1[3] << 32) | b1[2]), a, 0, 0, 0);
                acc[m] = a;
            }
#pragma unroll
            for (int m = 4; m < 8; ++m) { PM_DMA(2 * m, ia[m]); PM_DMA(2 * m + 1, ib[m]); }
        }
        if (lane < 16) {
            u32x4 o;
#pragma unroll
            for (int k = 0; k < 4; ++k) o[k] = pack2((acc[2 * k][0] + acc[2 * k][1]) * isc, (acc[2 * k + 1][0] + acc[2 * k + 1][1]) * isc);
            *(u32x4*)(p.hp + ((size_t)t * 8 + s) * 128 + lane * 8) = o;
        }
    }
    asm volatile("s_waitcnt vmcnt(0)" ::: "memory");
}
__device__ void ph_peer_act(const Params& p, unsigned char* smem, const int vb) {
    const int lane = threadIdx.x & 63, wid = threadIdx.x >> 6;
    unsigned* lsc = (unsigned*)smem;
    LDS_AS unsigned char* img = (LDS_AS unsigned char*)smem + 65536 + wid * 256;
    __syncthreads();
    for (int i = threadIdx.x; i < 16384 / 4; i += 256) *(u32x4*)(lsc + 4 * i) = *(const u32x4*)((const unsigned*)p.sc2 + 4 * i);
    __syncthreads();
    const int e0 = 2 * lane, e1 = e0 + 1;
    const int ix0 = (e0 & 3) * 32 + ((e0 >> 2) & 3) * 8 + (e0 >> 4), ix1 = (e1 & 3) * 32 + ((e1 >> 2) & 3) * 8 + (e1 >> 4);
    for (int t = vb * 4 + wid; t < T_TOK; t += gridDim.x * 4) {
        f32x2 h = {0.f, 0.f};
#pragma unroll
        for (int s = 0; s < 8; ++s) { const unsigned w = *(const unsigned*)(p.hp + ((size_t)t * 8 + s) * 128 + 2 * lane); h += (f32x2){bflo(w), bfhi(w)}; }
        f32x2 pq = *(const f32x2*)(p.stats + (size_t)t * 16 + (lane & 7) * 2);
        pq.x += __shfl_xor(pq.x, 1); pq.y += __shfl_xor(pq.y, 1); pq.x += __shfl_xor(pq.x, 2); pq.y += __shfl_xor(pq.y, 2); pq.x += __shfl_xor(pq.x, 4); pq.y += __shfl_xor(pq.y, 4);
        const float mu = pq.x * (1.0f / 1024.0f), rstd = rsqrtf(fmaxf(pq.y * (1.0f / 1024.0f) - mu * mu, 0.f) + LN_EPS);
        int2 id = *(const int2*)(p.ids + (size_t)t * 128 + 2 * lane);
        id.x &= 0x3fff; id.y &= 0x3fff;
        const f32x2 gt = *(const f32x2*)(p.gates + (size_t)t * 128 + 2 * lane);
        const unsigned s0 = lsc[id.x], s1 = lsc[id.y];
        const unsigned c0 = p.cb2[id.x], c1 = p.cb2[id.y];
        f32x2 a;
        a.x = gelu_gate(rstd * (h.x * bflo(s0) - mu * bflo(c0)) + bfhi(c0), gt.x) * bfhi(s0);
        a.y = gelu_gate(rstd * (h.y * bflo(s1) - mu * bflo(c1)) + bfhi(c1), gt.y) * bfhi(s1);
        float am = fmaxf(fabsf(a.x), fabsf(a.y));
#pragma unroll
        for (int o = 32; o >= 1; o >>= 1) am = fmaxf(am, __shfl_xor(am, o));
        int be = (int)(__float_as_uint(am) >> 23); be = be < 20 ? 20 : (be > 240 ? 240 : be);
        const float sc = __uint_as_float((unsigned)(261 - be) << 23);
        const unsigned iscb = (unsigned)(be - 7) << 23;
        const float x0 = a.x * sc, x1 = a.y * sc;
        const unsigned h8 = (unsigned)__builtin_amdgcn_cvt_pk_fp8_f32(x0, x1, 0, false);
        const f32x2 hd = __builtin_amdgcn_cvt_pk_f32_fp8((int)h8, false);
        const unsigned l8 = (unsigned)__builtin_amdgcn_cvt_pk_fp8_f32(x0 - hd.x, x1 - hd.y, 0, false);
        img[ix0] = (unsigned char)h8; img[ix1] = (unsigned char)(h8 >> 8);
        img[128 + ix0] = (unsigned char)l8; img[128 + ix1] = (unsigned char)(l8 >> 8);
        const unsigned iw = *(const LDS_AS unsigned*)(img + lane * 4);
        *(unsigned*)((unsigned char*)p.gates + (size_t)t * 512 + lane * 4) = iw;
        if (lane < 3) {
            const unsigned pb = lane == 0 ? __float_as_uint(mu) : (lane == 1 ? __float_as_uint(rstd) : iscb);
            *(int2*)(p.ids + (size_t)t * 128 + 2 * lane) = make_int2(id.x | (int)(pb & 0xffff0000u), id.y | (int)(pb << 16));
        }
    }
}
typedef int v2i32 __attribute__((ext_vector_type(2)));
__device__ void ph_peer_v(const Params& p, unsigned char* smem, const int vb) {
    const int lane = threadIdx.x & 63, wid = __builtin_amdgcn_readfirstlane(threadIdx.x >> 6);
    const int q = lane >> 3, c = lane & 7, j = lane & 15, kb = lane >> 4;
    const int nlb = gridDim.x >> 3, s = vb / nlb, lb = vb - s * nlb;
    const int stride = nlb * 4, t0 = lb * 4 + wid;
    const int ntok = (T_TOK - t0 + stride - 1) / stride;
    if (ntok <= 0) return;
    LDS_AS unsigned char* wb = (LDS_AS unsigned char*)smem + wid * 18432;
    LDS_AS unsigned char* ring = wb + 16384;
    const unsigned char* vbase = p.v8 + (size_t)s * (16384 * 128) + ((c ^ q) * 16);
    const unsigned char* vbase1 = p.v8 + (size_t)s * (16384 * 128) + ((c ^ q ^ 1) * 16);
    const unsigned char* rsrc; unsigned rstr;
    if (lane < 32) { rsrc = (const unsigned char*)p.ids + lane * 16; rstr = 512; }
    else if (lane < 48) { rsrc = (const unsigned char*)p.gates + (lane - 32) * 16; rstr = 512; }
    else { rsrc = (const unsigned char*)p.y1b + s * 256 + (lane - 48) * 16; rstr = 2048; }
#define PV_RING(n) __builtin_amdgcn_global_load_lds((const unsigned*)(rsrc + (size_t)PM_TOK(n) * rstr), (LDS_AS unsigned*)(ring + ((n) & 1) * 1024), 16, 0, 0)
#define PV_IDS(n, idv) do { const LDS_AS u32x4* _q = (const LDS_AS u32x4*)(ring + ((n) & 1) * 1024 + q * 64); \
        _Pragma("unroll") for (int _k = 0; _k < 4; ++_k) { const u32x4 _v = _q[_k]; idv[4 * _k] = _v[0] & 0x3fffu; idv[4 * _k + 1] = _v[1] & 0x3fffu; idv[4 * _k + 2] = _v[2] & 0x3fffu; idv[4 * _k + 3] = _v[3] & 0x3fffu; } } while (0)
#define PV_DMA(i, id) __builtin_amdgcn_global_load_lds((const unsigned*)((((i) & 1) ? vbase1 : vbase) + (size_t)(id) * 128), (LDS_AS unsigned*)(wb + (i) * 1024), 16, 0, 0)
    const int key = (j >> 1) ^ (kb & 1);
    const LDS_AS unsigned char* tb = wb + (8 * kb + (j >> 1)) * 128 + (j & 1) * 8;
    const LDS_AS unsigned char* ard = ring + 512 + (j & 1) * 128 + kb * 32;
    const int dl = 32 * kb + (j & 1) * 16 + (j & 14), d0 = s * 128 + dl;
    const f32x2 g2 = *(const f32x2*)(p.ln1_g + d0), b2 = *(const f32x2*)(p.ln1_b + d0);
    PV_RING(0); PV_RING(1);
    asm volatile("s_waitcnt vmcnt(0)" ::: "memory");
    {
        unsigned idv[16]; PV_IDS(0, idv);
#pragma unroll
        for (int i = 0; i < 16; ++i) PV_DMA(i, idv[i]);
    }
#pragma unroll 1
    for (int n = 0; n < ntok; ++n) {
        const int t = t0 + n * stride;
        const LDS_AS unsigned char* slot = ring + (n & 1) * 1024;
        const u32x4 xa0 = *(const LDS_AS u32x4*)(ard + (n & 1) * 1024), xa1 = *(const LDS_AS u32x4*)(ard + (n & 1) * 1024 + 16);
        const u32x4 hd4 = *(const LDS_AS u32x4*)(slot);
        const unsigned hd5 = *(const LDS_AS unsigned*)(slot + 16);
        const unsigned yw = *(const LDS_AS unsigned*)(slot + 768 + dl * 2);
        i64 xa[4];
        xa[0] = (i64)(((unsigned long long)xa0[1] << 32) | xa0[0]); xa[1] = (i64)(((unsigned long long)xa0[3] << 32) | xa0[2]);
        xa[2] = (i64)(((unsigned long long)xa1[1] << 32) | xa1[0]); xa[3] = (i64)(((unsigned long long)xa1[3] << 32) | xa1[2]);
        const float mu = __uint_as_float((hd4[0] & 0xffff0000u) | (hd4[1] >> 16)), rs = __uint_as_float((hd4[2] & 0xffff0000u) | (hd4[3] >> 16));
        const float isc = __uint_as_float(hd5 & 0xffff0000u);
        f32x4 acc[8];
#pragma unroll
        for (int ct = 0; ct < 8; ++ct) acc[ct] = (f32x4){0.f, 0.f, 0.f, 0.f};
        asm volatile("s_waitcnt vmcnt(8)" ::: "memory");
#pragma unroll
        for (int ks = 0; ks < 2; ++ks)
#pragma unroll
            for (int ct = 0; ct < 8; ++ct) {
                const v2i32 bv = __builtin_amdgcn_ds_read_tr8_b64_v2i32((LDS_AS v2i32*)(tb + ks * 4096 + ((ct ^ key) << 4)));
                acc[ct] = __builtin_amdgcn_mfma_f32_16x16x32_fp8_fp8(xa[ks], (i64)(((unsigned long long)(unsigned)bv[1] << 32) | (unsigned)bv[0]), acc[ct], 0, 0, 0);
            }
        {
            unsigned idv[16]; PV_IDS(n + 1, idv);
            PV_RING(n + 2);
#pragma unroll
            for (int i = 0; i < 8; ++i) PV_DMA(i, idv[i]);
            asm volatile("s_waitcnt vmcnt(9)" ::: "memory");
#pragma unroll
            for (int ks = 2; ks < 4; ++ks)
#pragma unroll
                for (int ct = 0; ct < 8; ++ct) {
                    const v2i32 bv = __builtin_amdgcn_ds_read_tr8_b64_v2i32((LDS_AS v2i32*)(tb + ks * 4096 + ((ct ^ key) << 4)));
                    acc[ct] = __builtin_amdgcn_mfma_f32_16x16x32_fp8_fp8(xa[ks], (i64)(((unsigned long long)(unsigned)bv[1] << 32) | (unsigned)bv[0]), acc[ct], 0, 0, 0);
                }
#pragma unroll
            for (int i = 8; i < 16; ++i) PV_DMA(i, idv[i]);
        }
        float va, vc;
        {
            const float w0 = acc[0][0] + acc[0][1], w1 = acc[1][0] + acc[1][1], w2 = acc[2][0] + acc[2][1], w3 = acc[3][0] + acc[3][1];
            const float w4 = acc[4][0] + acc[4][1], w5 = acc[5][0] + acc[5][1], w6 = acc[6][0] + acc[6][1], w7 = acc[7][0] + acc[7][1];
            va = kb == 0 ? w0 : (kb == 1 ? w2 : (kb == 2 ? w4 : w6));
            vc = kb == 0 ? w1 : (kb == 1 ? w3 : (kb == 2 ? w5 : w7));
        }
        const bool od = (j & 1) != 0;
        const float got = __shfl_xor(od ? va : vc, 1);
        const float p0 = (od ? got : va) * isc, p1 = (od ? vc : got) * isc;
        const float r0 = ALPHA * ((bflo(yw) - mu) * rs * g2.x + b2.x) + p0, r1 = ALPHA * ((bfhi(yw) - mu) * rs * g2.y + b2.y) + p1;
        *(unsigned*)(p.rb + (size_t)t * DM + d0) = pack2(r0, r1);
    }
    asm volatile("s_waitcnt vmcnt(0)" ::: "memory");
}

__device__ void ph_gemm_ple(const Params& p, unsigned char* smem, const int vb) {
    const int ntn = DM / 128;
    const int tid = threadIdx.x, lane = tid & 63, wid = tid >> 6, wr = wid >> 1, wc = wid & 1, fr = lane & 15, fq = lane >> 4;
    const int ntiles = (T_TOK / 128) * ntn;
    bool pre = false;
    for (int t = vb; t < ntiles; t += gridDim.x) {
        const int m0 = (t / ntn) * 128, n0 = (t % ntn) * 128;
        const int tn = t + gridDim.x;
        const bool has_next = tn < ntiles;
        const bf16_t* nA = p.pb + (size_t)((has_next ? tn : t) / ntn) * 128 * 256;
        const bf16_t* nB = p.WpT + (size_t)((has_next ? tn : t) % ntn) * 128 * 256;
        const bf16_t* gA = p.rb + (size_t)m0 * DM; const bf16_t* gB = p.WgT + (size_t)n0 * DM;
        f32x4 acc[4][4], acc2[4][4]; zero_acc(acc); zero_acc(acc2);
        if (pre) gemm128<true, true>(p.pb + (size_t)m0 * 256, 256, p.WpT + (size_t)n0 * 256, 256, 256, smem, acc2, gA, DM, gB, DM);
        else     gemm128<false, true>(p.pb + (size_t)m0 * 256, 256, p.WpT + (size_t)n0 * 256, 256, 256, smem, acc2, gA, DM, gB, DM);
        if (has_next) gemm128<true, true>(gA, DM, gB, DM, DM, smem, acc, nA, 256, nB, 256);
        else          gemm128<true, false>(gA, DM, gB, DM, DM, smem, acc);
        pre = has_next;
#pragma unroll
        for (int mi = 0; mi < 4; ++mi) {
            const int row = m0 + wr * 64 + mi * 16 + fr;
#pragma unroll
            for (int ni = 0; ni < 4; ++ni) {
                const int col = n0 + wc * 64 + ni * 16 + fq * 4;
                const u32x2 rw = *(const u32x2*)(p.rb + (size_t)row * DM + col);
                f32x4 rv = {bflo(rw[0]), bfhi(rw[0]), bflo(rw[1]), bfhi(rw[1])};
#pragma unroll
                for (int r = 0; r < 4; ++r) rv[r] += sigmul(acc2[mi][ni][r], acc[mi][ni][r]);
                *(f32x4*)(p.out + (size_t)row * DM + col) = rv;
            }
        }
    }
}

#define XB_TMO      128
#define XB_XCNT(j)  (256  + 64 * (j))
#define XB_XSUB(j)  (1280 + 64 * (j))
#define XB_XGEN(j)  (2304 + 64 * (j))
#define XB_TOP      3328
#define XB_TOPGEN   3392
#define XCD_BAR_WORDS 3456
#define XB_SPIN_CAP (1u << 20)
__device__ __forceinline__ unsigned xb_ld(unsigned* p)              { return __hip_atomic_load(p, __ATOMIC_RELAXED, __HIP_MEMORY_SCOPE_AGENT); }
__device__ __forceinline__ unsigned xb_add(unsigned* p, unsigned v) { return __hip_atomic_fetch_add(p, v, __ATOMIC_RELAXED, __HIP_MEMORY_SCOPE_AGENT); }
__device__ __forceinline__ unsigned xb_xcc_id() { return (unsigned)__builtin_amdgcn_s_getreg((3 << 11) | 20) & 0xFu; }
#define XB_SPIN(cond, bar) do { unsigned _sp = 0; while (cond) { __builtin_amdgcn_s_sleep(1); \
    if ((++_sp & 255u) == 0u) { if (xb_ld(&(bar)[XB_TMO])) break; if (_sp > XB_SPIN_CAP) { atomicAdd(&(bar)[XB_TMO], 1u); break; } } } } while (0)
struct XcdBarrier { unsigned* bar; unsigned x; volatile LDS_AS unsigned* st; };
__device__ __forceinline__ XcdBarrier xcd_barrier_post(unsigned* bar, volatile LDS_AS unsigned* st) {
    XcdBarrier b; b.bar = bar; b.x = xb_xcc_id(); b.st = st;
    if (threadIdx.x == 0) st[3] = xb_add(&bar[XB_XCNT(b.x)], 1u);
    return b;
}
__device__ __forceinline__ void xcd_barrier_complete(unsigned* bar, unsigned x, unsigned rank, unsigned& nloc, unsigned& nx, unsigned& vb) {
    const unsigned G = gridDim.x;
    unsigned sum, cnt, mine, sp = 0u; bool even;
    for (;;) {
        sum = 0u; cnt = 0u; mine = 0u; even = true;
#pragma unroll
        for (unsigned j = 0; j < 16; ++j) {
            const unsigned c = xb_ld(&bar[XB_XCNT(j)]); sum += c; cnt += (c > 0u) ? 1u : 0u; mine = (j == x) ? c : mine;
            even = even && (c == ((j < 8u) ? (G >> 3) : 0u));
        }
        if (sum == G) break;
        __builtin_amdgcn_s_sleep(1);
        if ((++sp & 255u) == 0u) { if (xb_ld(&bar[XB_TMO])) break; if (sp > XB_SPIN_CAP) { atomicAdd(&bar[XB_TMO], 1u); break; } }
    }
    nloc = mine > 0u ? mine : 1u; nx = cnt > 0u ? cnt : 1u;
    vb = (even && sum == G && (G & 7u) == 0u) ? (x * (G >> 3) + rank) : blockIdx.x;
}
__device__ __forceinline__ void xcd_barrier(const XcdBarrier& b) {
    asm volatile("s_waitcnt vmcnt(0)" ::: "memory");
    __syncthreads();
    if (threadIdx.x == 0) {
        unsigned* bar = b.bar;
        __builtin_amdgcn_s_waitcnt(0);
        unsigned nloc = b.st[0], nx = b.st[1];
        if (nloc == 0u) { unsigned vb; xcd_barrier_complete(bar, b.x, b.st[3], nloc, nx, vb); b.st[0] = nloc; b.st[1] = nx; b.st[2] = vb; }
        const unsigned old = xb_add(&bar[XB_XSUB(b.x)], 1u);
        const unsigned gen = old / nloc;
        if (old + 1u == (gen + 1u) * nloc) {
            __builtin_amdgcn_fence(__ATOMIC_RELEASE, "agent");
            asm volatile("s_waitcnt vmcnt(0)" ::: "memory");
            const unsigned og = xb_add(&bar[XB_TOP], 1u);
            const unsigned tg = og / nx;
            if (og + 1u == (tg + 1u) * nx) xb_add(&bar[XB_TOPGEN], 1u);
            else XB_SPIN(xb_ld(&bar[XB_TOPGEN]) == tg, bar);
            __builtin_amdgcn_fence(__ATOMIC_ACQUIRE, "agent");
            xb_add(&bar[XB_XGEN(b.x)], 1u);
            asm volatile("s_waitcnt vmcnt(0)" ::: "memory");
        } else {
            XB_SPIN(xb_ld(&bar[XB_XGEN(b.x)]) == gen, bar);
            __builtin_amdgcn_fence(__ATOMIC_ACQUIRE, "agent");
            asm volatile("s_waitcnt vmcnt(0)" ::: "memory");
        }
    }
    __syncthreads();
}

#define SMEM_PHASE (256 * ASTR * 2 * 2)
#define SMEM_BYTES (SMEM_PHASE + 16)
__global__ void __launch_bounds__(256, 2) mega(Params p) {
    __shared__ __attribute__((aligned(16))) unsigned char smem[SMEM_BYTES];
    volatile LDS_AS unsigned* st = (volatile LDS_AS unsigned*)(LDS_AS unsigned char*)(smem + SMEM_PHASE);
    if (threadIdx.x < 4) st[threadIdx.x] = 0u;
    __syncthreads();
    const XcdBarrier gb = xcd_barrier_post(p.bar, st);
    ph_prep(p, smem);            xcd_barrier(gb);
    const int vb = (int)st[2];
    ph_gemm_in(p, smem, vb);     xcd_barrier(gb);
    ph_attn(p, smem, vb);
    ph_conv(p, smem, vb);        xcd_barrier(gb);
    ph_mprep(p, smem, vb);
    ph_gemm_out(p, smem, vb);    xcd_barrier(gb);
    ph_route(p, smem, vb);       xcd_barrier(gb);
    ph_peer_u(p, smem, vb);      xcd_barrier(gb);
    ph_peer_act(p, smem, vb);    xcd_barrier(gb);
    ph_peer_v(p, smem, vb);      xcd_barrier(gb);
    ph_gemm_ple(p, smem, vb);    xcd_barrier(gb);
    ph_ln2(p, vb);
}

extern "C" void kernel_launch(void* const* d_in, const int* in_sizes, int n_in, void* d_out, int out_size, void* d_ws, size_t ws_size,
                              hipStream_t stream) {
    Params p{};
    p.x = (const float*)d_in[0]; p.p = (const float*)d_in[1]; p.pos = (const int*)d_in[2];
    p.w_in = (const float*)d_in[3]; p.sinks = (const float*)d_in[4]; p.conv_w = (const float*)d_in[5]; p.conv_b = (const float*)d_in[6];
    p.cln_g = (const float*)d_in[7]; p.cln_b = (const float*)d_in[8]; p.w_out = (const float*)d_in[9]; p.ln1_g = (const float*)d_in[10];
    p.ln1_b = (const float*)d_in[11]; p.wq = (const float*)d_in[12]; p.keys = (const float*)d_in[13]; p.pu = (const float*)d_in[14];
    p.pv = (const float*)d_in[15]; p.ple_proj = (const float*)d_in[16]; p.ple_gate = (const float*)d_in[17]; p.ln2_g = (const float*)d_in[18];
    p.ln2_b = (const float*)d_in[19];
    p.out = (float*)d_out;
    unsigned char* ws = (unsigned char*)d_ws;
    const size_t MiB = 1024 * 1024;
    p.y1 = (float*)(ws + 0 * MiB);
    p.hb = (bf16_t*)(ws + 128 * MiB);
    p.hp = (bf16_t*)(ws + 128 * MiB);
    p.xb = (bf16_t*)(ws + 256 * MiB);
    p.mixb = (bf16_t*)(ws + 320 * MiB);
    p.rb = (bf16_t*)(ws + 320 * MiB);
    p.pb = (bf16_t*)(ws + 384 * MiB);
    p.u8 = (unsigned char*)(ws + 400 * MiB);
    p.v8 = (unsigned char*)(ws + 416 * MiB);
    p.sc2 = (bf16_t*)(ws + 432 * MiB);
    p.rope = (float*)(ws + 434 * MiB);
    p.stats = (float*)(ws + 436 * MiB);
    p.cb2 = (unsigned*)(ws + 438 * MiB);
    p.mext = (bf16_t*)(ws + 440 * MiB);
    p.yext = (bf16_t*)(ws + 442 * MiB);
    p.y1b = (bf16_t*)(ws + 0 * MiB);
    p.ids = (int*)(ws + 464 * MiB);
    p.gates = (float*)(ws + 480 * MiB);
    unsigned char* wb = ws + 496 * MiB;
    p.WinT = (bf16_t*)wb; wb += (size_t)INW * DM * 2;
    p.WoutT = (bf16_t*)wb; wb += (size_t)DM * DM * 2;
    p.WgT = (bf16_t*)wb; wb += (size_t)DM * DM * 2;
    p.WpT = (bf16_t*)wb; wb += (size_t)DM * 256 * 2;
    p.keysb = (bf16_t*)wb; wb += (size_t)16 * 128 * 128 * 2;
    p.Wqb = (bf16_t*)(ws + 240 * MiB);
    p.MT = (bf16_t*)(ws + 244 * MiB);
    p.bar = (unsigned*)(ws + 510 * MiB);
    p.wgb = (float*)(p.bar + XCD_BAR_WORDS + 640);

    static int grid_blocks = 0;
    if (!grid_blocks) {
        int dev = 0, cus = 0, per_cu = 0;
        (void)hipGetDevice(&dev);
        (void)hipDeviceGetAttribute(&cus, hipDeviceAttributeMultiprocessorCount, dev);
        (void)hipOccupancyMaxActiveBlocksPerMultiprocessor(&per_cu, mega, 256, 0);
        if (per_cu > 2) per_cu = 2;
        grid_blocks = cus * per_cu;
    }
    (void)hipMemsetAsync(p.bar, 0, (XCD_BAR_WORDS + 640 + 4096) * sizeof(unsigned), stream);
    void* args[] = {&p};
    hipError_t e = hipLaunchCooperativeKernel((void*)mega, dim3(grid_blocks), dim3(256), args, 0, stream);
    if (e != hipSuccess) fprintf(stderr, "cooperative launch failed: %s (grid %d)\n", hipGetErrorString(e), grid_blocks);
}
```

```cpp
#include <hip/hip_runtime.h>
#include <stdint.h>
#include <cstdio>

typedef unsigned short bf16_t;
typedef short bf16x8 __attribute__((ext_vector_type(8)));
typedef float f32x4 __attribute__((ext_vector_type(4)));
typedef unsigned u32x4 __attribute__((ext_vector_type(4)));
typedef float f32x2 __attribute__((ext_vector_type(2)));
typedef long i64;

#define T_TOK 32768
#define SEQ 2048
#define DM 1024
#define INW 1792
#define ALPHA 1.189207115002721f
#define LN_EPS 1e-5f

__device__ __forceinline__ bf16_t f2bf(float f) {
    unsigned u = __float_as_uint(f);
    u += 0x7fffu + ((u >> 16) & 1u);
    return (bf16_t)(u >> 16);
}
__device__ __forceinline__ float bf2f(bf16_t b) { return __uint_as_float(((unsigned)b) << 16); }
__device__ __forceinline__ float bflo(unsigned w) { return __uint_as_float(w << 16); }
__device__ __forceinline__ float bfhi(unsigned w) { return __uint_as_float(w & 0xffff0000u); }
__device__ __forceinline__ unsigned pack2(float a, float b) { return (unsigned)f2bf(a) | ((unsigned)f2bf(b) << 16); }

__device__ __forceinline__ float sigmul(float x, float g) { return x * __builtin_amdgcn_rcpf(1.0f + __expf(-g)); }
__device__ __forceinline__ float wave_sum(float v) {
#pragma unroll
    for (int o = 32; o >= 1; o >>= 1) v += __shfl_xor(v, o);
    return v;
}

struct Params {
    const float *x, *p; const int* pos;
    const float *w_in, *sinks, *conv_w, *conv_b, *cln_g, *cln_b, *w_out, *ln1_g, *ln1_b;
    const float *wq, *keys, *pu, *pv, *ple_proj, *ple_gate, *ln2_g, *ln2_b;
    float* out;
    bf16_t *xb, *pb, *WinT, *WoutT, *WgT, *WpT, *keysb, *Wqb, *MT, *hb, *mixb, *rb;
    float *y1, *gates, *rope, *stats, *wgb;
    bf16_t *y1b, *yext, *mext; unsigned* cb2;
    bf16_t* sc2;
    bf16_t* hp;
    int *ids;
    unsigned char *u8, *v8;
    unsigned* bar;
};

__device__ void cvt_rows(const float* __restrict__ src, bf16_t* __restrict__ dst, size_t n) {
    const size_t nv = n / 8, gs = (size_t)gridDim.x * blockDim.x;
    for (size_t i = (size_t)blockIdx.x * blockDim.x + threadIdx.x; i < nv; i += 4 * gs) {
        f32x4 a[4], b[4];
#pragma unroll
        for (int q = 0; q < 4; ++q) { const size_t k = (i + q * gs < nv) ? i + q * gs : i; a[q] = ((const f32x4*)src)[2 * k]; b[q] = ((const f32x4*)src)[2 * k + 1]; }
#pragma unroll
        for (int q = 0; q < 4; ++q) {
            if (i + q * gs < nv) {
                u32x4 o; o[0] = pack2(a[q][0], a[q][1]); o[1] = pack2(a[q][2], a[q][3]); o[2] = pack2(b[q][0], b[q][1]); o[3] = pack2(b[q][2], b[q][3]);
                ((u32x4*)dst)[i + q * gs] = o;
            }
        }
    }
}
__device__ __forceinline__ int win_row(int n) {
    if (n < 768) return n;
    const int isg = n >= 1280 ? 1 : 0, c = n - (isg ? 1280 : 768);
    const int tt = c >> 6, wc = (c >> 5) & 1, k2 = (c >> 4) & 1, rest = c & 15;
    return 768 + 128 * tt + wc * 64 + (k2 * 2 + isg) * 16 + rest;
}
template <bool WIN = false>
__device__ void transpose_cvt(const float* __restrict__ W, bf16_t* __restrict__ Wt, int K, int N, float* tile  ) {
    const int tk = K / 64, tn = N / 64;
    const int tid = threadIdx.x;
    for (int t = blockIdx.x; t < tk * tn; t += gridDim.x) {
        const int k0 = (t / tn) * 64, n0 = (t % tn) * 64;
        f32x4 v[4];
#pragma unroll
        for (int i = 0; i < 4; ++i) v[i] = *(const f32x4*)(W + (size_t)(k0 + (tid >> 4) + 16 * i) * N + n0 + (tid & 15) * 4);
        __syncthreads();
#pragma unroll
        for (int i = 0; i < 4; ++i)
#pragma unroll
            for (int j = 0; j < 4; ++j) tile[((tid >> 4) + 16 * i) * 65 + (tid & 15) * 4 + j] = v[i][j];
        __syncthreads();
        const int n = tid >> 2, kc = (tid & 3) * 16;
        u32x4 o0, o1;
#pragma unroll
        for (int q = 0; q < 4; ++q) {
            o0[q] = pack2(tile[(kc + 2 * q) * 65 + n], tile[(kc + 2 * q + 1) * 65 + n]);
            o1[q] = pack2(tile[(kc + 8 + 2 * q) * 65 + n], tile[(kc + 8 + 2 * q + 1) * 65 + n]);
        }
        const int nd = WIN ? win_row(n0 + n) : n0 + n;
        *(u32x4*)(Wt + (size_t)nd * K + k0 + kc) = o0;
        *(u32x4*)(Wt + (size_t)nd * K + k0 + kc + 8) = o1;
    }
}
__device__ void cvt_wq_fold(const Params& p, unsigned char* smem) {
    for (int i = blockIdx.x * 256 + threadIdx.x; i < DM * 256; i += gridDim.x * 256) {
        const int d = i >> 8, c8 = (i & 255) * 8;
        const float gd = p.ln1_g[d];
        const f32x4 a = *(const f32x4*)(p.wq + (size_t)d * 2048 + c8), b = *(const f32x4*)(p.wq + (size_t)d * 2048 + c8 + 4);
        u32x4 o; o[0] = pack2(a[0] * gd, a[1] * gd); o[1] = pack2(a[2] * gd, a[3] * gd); o[2] = pack2(b[0] * gd, b[1] * gd); o[3] = pack2(b[2] * gd, b[3] * gd);
        *(u32x4*)(p.Wqb + (size_t)d * 2048 + c8) = o;
    }
    float* red = (float*)smem;
    const int lane = threadIdx.x & 63, wid = threadIdx.x >> 6;
    for (int cb = blockIdx.x; cb < 512; cb += gridDim.x) {
        f32x4 sg = {0.f, 0.f, 0.f, 0.f}, sb = {0.f, 0.f, 0.f, 0.f};
#pragma unroll
        for (int q = 0; q < 4; ++q) {
            const int d = threadIdx.x * 4 + q;
            const f32x4 v = *(const f32x4*)(p.wq + (size_t)d * 2048 + cb * 4);
            sg += v * p.ln1_g[d]; sb += v * p.ln1_b[d];
        }
        __syncthreads();
#pragma unroll
        for (int q = 0; q < 4; ++q) {
            const float a = wave_sum(sg[q]), b = wave_sum(sb[q]);
            if (lane == 0) { red[wid * 8 + q] = a; red[wid * 8 + 4 + q] = b; }
        }
        __syncthreads();
        if (threadIdx.x < 8) {
            const float t = (red[threadIdx.x] + red[8 + threadIdx.x]) + (red[16 + threadIdx.x] + red[24 + threadIdx.x]);
            p.wgb[(threadIdx.x >> 2) * 2048 + cb * 4 + (threadIdx.x & 3)] = t;
        }
    }
}
template <bool FOLD>
__device__ void cvt_table_fp8(const Params& p, const float* __restrict__ src, unsigned char* __restrict__ dst, bf16_t* __restrict__ scl, int rows) {
    const int lane = threadIdx.x & 63, wid = threadIdx.x >> 6;
    const int nw = gridDim.x * 4;
    for (int r0 = blockIdx.x * 4 + wid; r0 < rows; r0 += 4 * nw) {
        f32x4 v[4][4];
#pragma unroll
        for (int q = 0; q < 4; ++q) {
            const int r = (r0 + q * nw < rows) ? r0 + q * nw : r0;
            const float* sr = src + (size_t)r * DM + lane * 16;
#pragma unroll
            for (int k = 0; k < 4; ++k) v[q][k] = *(const f32x4*)(sr + 4 * k);
        }
        f32x4 gv[4], bv[4];
        if (FOLD) {
#pragma unroll
            for (int k = 0; k < 4; ++k) { gv[k] = *(const f32x4*)(p.ln1_g + lane * 16 + 4 * k); bv[k] = *(const f32x4*)(p.ln1_b + lane * 16 + 4 * k); }
        }
#pragma unroll
        for (int q = 0; q < 4; ++q) {
            const int r = r0 + q * nw;
            if (FOLD) {
                float cu = 0.f, bu = 0.f;
#pragma unroll
                for (int k = 0; k < 4; ++k) { bu += (bv[k][0] * v[q][k][0] + bv[k][1] * v[q][k][1]) + (bv[k][2] * v[q][k][2] + bv[k][3] * v[q][k][3]); v[q][k] = v[q][k] * gv[k]; cu += (v[q][k][0] + v[q][k][1]) + (v[q][k][2] + v[q][k][3]); }
                cu = wave_sum(cu); bu = wave_sum(bu);
                if (lane == 0 && r < rows) p.cb2[r] = pack2(cu, bu);
            }
            float m = 0.f;
#pragma unroll
            for (int k = 0; k < 4; ++k)
#pragma unroll
                for (int i = 0; i < 4; ++i) m = fmaxf(m, fabsf(v[q][k][i]));
#pragma unroll
            for (int o = 32; o >= 1; o >>= 1) m = fmaxf(m, __shfl_xor(m, o));
            int ex = (m > 0.f) ? (8 - (int)((__float_as_uint(m) >> 23) & 0xffu) + 127 - ((__float_as_uint(m) & 0x7fffffu) > 0x600000u ? 1 : 0)) : 0;
            ex = min(max(ex, -100), 100);
            const float sc = __uint_as_float((unsigned)(127 + ex) << 23);
            u32x4 w;
#pragma unroll
            for (int k = 0; k < 4; ++k)
                w[k] = __builtin_amdgcn_cvt_pk_fp8_f32(v[q][k][2] * sc, v[q][k][3] * sc, __builtin_amdgcn_cvt_pk_fp8_f32(v[q][k][0] * sc, v[q][k][1] * sc, 0, false), true);
            if (r < rows) {
                *(u32x4*)(dst + (size_t)(lane >> 3) * (16384 * 128) + (size_t)r * 128 + (lane & 7) * 16) = w;
                if (lane == 0) scl[2 * r] = (bf16_t)(((unsigned)(127 - ex) << 23) >> 16);
            }
        }
    }
}
__device__ void ph_prep(const Params& p, unsigned char* smem) {
    float* tile = (float*)smem;
    cvt_rows(p.x, p.xb, (size_t)T_TOK * DM);
    cvt_rows(p.p, p.pb, (size_t)T_TOK * 256);
    cvt_table_fp8<true>(p, p.pu, p.u8, p.sc2, 16384);
    cvt_table_fp8<false>(p, p.pv, p.v8, p.sc2 + 1, 16384);
    cvt_rows(p.keys, p.keysb, (size_t)16 * 128 * 128);
    for (int i = blockIdx.x * 256 + threadIdx.x; i < T_TOK * 8; i += gridDim.x * 256) {
        const int t = i >> 3, j = i & 7;
        const float inv = powf(500000.0f, -(float)j * 0.125f);
        float sn, cs; sincosf((float)p.pos[t] * inv, &sn, &cs);
        p.rope[t * 16 + j] = cs; p.rope[t * 16 + 8 + j] = sn;
    }
    transpose_cvt<true>(p.w_in, p.WinT, DM, INW, tile);
    transpose_cvt(p.w_out, p.WoutT, DM, DM, tile);
    cvt_wq_fold(p, smem);
    transpose_cvt(p.ple_gate, p.WgT, DM, DM, tile);
    transpose_cvt(p.ple_proj, p.WpT, 256, DM, tile);
}

#define LDS_AS __attribute__((address_space(3)))
#define GEMM_STAGE 32768
template <bool PRE = false, bool NEXT = false>
__device__ __forceinline__ void gemm128(const bf16_t* __restrict__ A, int lda, const bf16_t* __restrict__ Bt, int ldb, int K,
                                        unsigned char* smem, f32x4 (&acc)[4][4],
                                        const bf16_t* __restrict__ nA = nullptr, int nlda = 0, const bf16_t* __restrict__ nB = nullptr, int nldb = 0) {
    LDS_AS unsigned char* lds = (LDS_AS unsigned char*)smem;
    const int tid = threadIdx.x, lane = tid & 63, wid = __builtin_amdgcn_readfirstlane(tid >> 6);
    const int wr = wid >> 1, wc = wid & 1, fr = lane & 15, fq = lane >> 4;
    const int nk = K / 64;
    const int prow = lane >> 3, pc = (lane & 7) ^ prow;
    const bf16_t* gA = A + (size_t)(wid * 32 + prow) * lda + pc * 8;
    const bf16_t* gB = Bt + (size_t)(wid * 32 + prow) * ldb + pc * 8;
    const size_t a8 = (size_t)8 * lda, b8 = (size_t)8 * ldb;
#define GEMM_ISSUE(kt, st) do { \
        _Pragma("unroll") for (int _i = 0; _i < 4; ++_i) { \
            __builtin_amdgcn_global_load_lds((const unsigned*)(gA + _i * a8 + (size_t)(kt) * 64), (LDS_AS unsigned*)(lds + (st) * GEMM_STAGE + (wid * 4 + _i) * 1024), 16, 0, 0); \
            __builtin_amdgcn_global_load_lds((const unsigned*)(gB + _i * b8 + (size_t)(kt) * 64), (LDS_AS unsigned*)(lds + (st) * GEMM_STAGE + 16384 + (wid * 4 + _i) * 1024), 16, 0, 0); \
        } } while (0)
    const int swz0 = ((0 * 4 + fq) ^ (fr & 7)) * 16, swz1 = ((1 * 4 + fq) ^ (fr & 7)) * 16;
    const int aoff = (wr * 64 + fr) * 128, boff = 16384 + (wc * 64 + fr) * 128;
    if (!PRE) GEMM_ISSUE(0, 0);
#pragma unroll 1
    for (int kt = 0; kt < nk; ++kt) {
        const int st = kt & 1;
        asm volatile("s_waitcnt vmcnt(0)" ::: "memory");
        __builtin_amdgcn_s_barrier();
        asm volatile("" ::: "memory");
        if (kt + 1 < nk) GEMM_ISSUE(kt + 1, st ^ 1);
        else if (NEXT) {
            const bf16_t* qA = nA + (size_t)(wid * 32 + prow) * nlda + pc * 8;
            const bf16_t* qB = nB + (size_t)(wid * 32 + prow) * nldb + pc * 8;
#pragma unroll
            for (int _i = 0; _i < 4; ++_i) {
                __builtin_amdgcn_global_load_lds((const unsigned*)(qA + (size_t)(_i * 8) * nlda), (LDS_AS unsigned*)(lds + (wid * 4 + _i) * 1024), 16, 0, 0);
                __builtin_amdgcn_global_load_lds((const unsigned*)(qB + (size_t)(_i * 8) * nldb), (LDS_AS unsigned*)(lds + 16384 + (wid * 4 + _i) * 1024), 16, 0, 0);
            }
        }
        const LDS_AS unsigned char* sb = lds + st * GEMM_STAGE;
        bf16x8 af0[4], bf0[4], af1[4], bf1[4];
#pragma unroll
        for (int mi = 0; mi < 4; ++mi) af0[mi] = *(const LDS_AS bf16x8*)(sb + aoff + mi * 2048 + swz0);
#pragma unroll
        for (int ni = 0; ni < 4; ++ni) bf0[ni] = *(const LDS_AS bf16x8*)(sb + boff + ni * 2048 + swz0);
#pragma unroll
        for (int mi = 0; mi < 4; ++mi) af1[mi] = *(const LDS_AS bf16x8*)(sb + aoff + mi * 2048 + swz1);
#pragma unroll
        for (int ni = 0; ni < 4; ++ni) bf1[ni] = *(const LDS_AS bf16x8*)(sb + boff + ni * 2048 + swz1);
#pragma unroll
        for (int mi = 0; mi < 4; ++mi)
#pragma unroll
            for (int ni = 0; ni < 4; ++ni)
                acc[mi][ni] = __builtin_amdgcn_mfma_f32_16x16x32_bf16(bf0[ni], af0[mi], acc[mi][ni], 0, 0, 0);
#pragma unroll
        for (int mi = 0; mi < 4; ++mi)
#pragma unroll
            for (int ni = 0; ni < 4; ++ni)
                acc[mi][ni] = __builtin_amdgcn_mfma_f32_16x16x32_bf16(bf1[ni], af1[mi], acc[mi][ni], 0, 0, 0);
        __builtin_amdgcn_sched_group_barrier(0x100, 8, 0);
#pragma unroll
        for (int q = 0; q < 8; ++q) { __builtin_amdgcn_sched_group_barrier(0x008, 2, 0); __builtin_amdgcn_sched_group_barrier(0x100, 1, 0); }
        __builtin_amdgcn_sched_group_barrier(0x008, 16, 0);
        asm volatile("s_waitcnt lgkmcnt(0)" ::: "memory");
        __builtin_amdgcn_s_barrier();
        asm volatile("" ::: "memory");
    }
#undef GEMM_ISSUE
}
#define GW_STAGE 24576
__device__ __forceinline__ void gemmW(const bf16_t* __restrict__ A, int lda, const bf16_t* __restrict__ Bt, int ldb, int K,
                                      unsigned char* smem, f32x4 (&acc)[4][8]) {
    LDS_AS unsigned char* lds = (LDS_AS unsigned char*)smem;
    const int tid = threadIdx.x, lane = tid & 63, wid = __builtin_amdgcn_readfirstlane(tid >> 6);
    const int wr = wid >> 1, wc = wid & 1, fr = lane & 15, fq = lane >> 4;
    const int nk = K / 32;
    const int prow = lane >> 2, pc = (lane & 3) ^ ((4 - ((prow >> 2) & 3)) & 3);
    const bf16_t* gA = A + (size_t)(wid * 32 + prow) * lda + pc * 8;
    const bf16_t* gB = Bt + (size_t)(wid * 64 + prow) * ldb + pc * 8;
    const size_t a16 = (size_t)16 * lda, b16 = (size_t)16 * ldb;
#define GW_ISSUE(kt, st) do { \
        _Pragma("unroll") for (int _i = 0; _i < 2; ++_i) \
            __builtin_amdgcn_global_load_lds((const unsigned*)(gA + _i * a16 + (size_t)(kt) * 32), (LDS_AS unsigned*)(lds + (st) * GW_STAGE + (wid * 2 + _i) * 1024), 16, 0, 0); \
        _Pragma("unroll") for (int _i = 0; _i < 4; ++_i) \
            __builtin_amdgcn_global_load_lds((const unsigned*)(gB + _i * b16 + (size_t)(kt) * 32), (LDS_AS unsigned*)(lds + (st) * GW_STAGE + 8192 + (wid * 4 + _i) * 1024), 16, 0, 0); \
        } while (0)
    const int swz = (fq ^ ((4 - ((fr >> 2) & 3)) & 3)) * 16;
    const int aoff = (wr * 64 + fr) * 64 + swz, boff = 8192 + (wc * 128 + fr) * 64 + swz;
    GW_ISSUE(0, 0);
#pragma unroll 1
    for (int kt = 0; kt < nk; ++kt) {
        const int st = kt & 1;
        asm volatile("s_waitcnt vmcnt(0)" ::: "memory");
        __builtin_amdgcn_s_barrier();
        asm volatile("" ::: "memory");
        if (kt + 1 < nk) GW_ISSUE(kt + 1, st ^ 1);
        const LDS_AS unsigned char* sb = lds + st * GW_STAGE;
        bf16x8 af[4], bfr[8];
#pragma unroll
        for (int mi = 0; mi < 4; ++mi) af[mi] = *(const LDS_AS bf16x8*)(sb + aoff + mi * 1024);
#pragma unroll
        for (int ni = 0; ni < 8; ++ni) bfr[ni] = *(const LDS_AS bf16x8*)(sb + boff + ni * 1024);
#pragma unroll
        for (int ni = 0; ni < 8; ++ni)
#pragma unroll
            for (int mi = 0; mi < 4; ++mi)
                acc[mi][ni] = __builtin_amdgcn_mfma_f32_16x16x32_bf16(bfr[ni], af[mi], acc[mi][ni], 0, 0, 0);
        asm volatile("s_waitcnt lgkmcnt(0)" ::: "memory");
        __builtin_amdgcn_s_barrier();
        asm volatile("" ::: "memory");
    }
#undef GW_ISSUE
}
__device__ __forceinline__ void zero_accw(f32x4 (&acc)[4][8]) {
#pragma unroll
    for (int a = 0; a < 4; ++a)
#pragma unroll
        for (int b = 0; b < 8; ++b) acc[a][b] = (f32x4){0.f, 0.f, 0.f, 0.f};
}
__device__ __forceinline__ void zero_acc(f32x4 (&acc)[4][4]) {
#pragma unroll
    for (int a = 0; a < 4; ++a)
#pragma unroll
        for (int b = 0; b < 4; ++b) acc[a][b] = (f32x4){0.f, 0.f, 0.f, 0.f};
}
#define GEMM_SMEM (2 * GEMM_STAGE)

__device__ void ph_gemm_in(const Params& p, unsigned char* smem, const int vb) {
    const int ntn = INW / 128;
    const int tid = threadIdx.x, lane = tid & 63, wid = tid >> 6, wr = wid >> 1, wc = wid & 1, fr = lane & 15, fq = lane >> 4;
    const int ntiles = (T_TOK / 128) * ntn;
    bool pre = false;
    for (int t = vb; t < ntiles; t += gridDim.x) {
        const int m0 = (t / ntn) * 128, n0 = (t % ntn) * 128;
        const int tn = t + gridDim.x;
        const bool has_next = tn < ntiles;
        const bf16_t* nA = p.xb + (size_t)((has_next ? tn : t) / ntn) * 128 * DM;
        const bf16_t* nB = p.WinT + (size_t)((has_next ? tn : t) % ntn) * 128 * DM;
        f32x4 acc[4][4]; zero_acc(acc);
        if (pre) { if (has_next) gemm128<true, true>(p.xb + (size_t)m0 * DM, DM, p.WinT + (size_t)n0 * DM, DM, DM, smem, acc, nA, DM, nB, DM);
                   else          gemm128<true, false>(p.xb + (size_t)m0 * DM, DM, p.WinT + (size_t)n0 * DM, DM, DM, smem, acc); }
        else     { if (has_next) gemm128<false, true>(p.xb + (size_t)m0 * DM, DM, p.WinT + (size_t)n0 * DM, DM, DM, smem, acc, nA, DM, nB, DM);
                   else          gemm128<false, false>(p.xb + (size_t)m0 * DM, DM, p.WinT + (size_t)n0 * DM, DM, DM, smem, acc); }
        pre = has_next;
        if (n0 >= 768) {
            const int cb = ((n0 - 768) >> 7) * 64 + wc * 32 + fq * 4;
#pragma unroll
            for (int mi = 0; mi < 4; ++mi) {
                const int row = m0 + wr * 64 + mi * 16 + fr;
#pragma unroll
                for (int k2 = 0; k2 < 2; ++k2) {
                    const f32x4 a = acc[mi][2 * k2], gt = acc[mi][2 * k2 + 1];
                    uint2 o; o.x = pack2(sigmul(a[0], gt[0]), sigmul(a[1], gt[1])); o.y = pack2(sigmul(a[2], gt[2]), sigmul(a[3], gt[3]));
                    *(uint2*)(p.hb + (size_t)row * INW + 768 + cb + k2 * 16) = o;
                }
            }
        } else {
#pragma unroll
        for (int mi = 0; mi < 4; ++mi) {
            const int row = m0 + wr * 64 + mi * 16 + fr;
#pragma unroll
            for (int ni = 0; ni < 4; ++ni) {
                const int col0 = n0 + wc * 64 + ni * 16;
                f32x4 v = acc[mi][ni];
                if (col0 < 640 && (col0 & 63) == 0) {
                    const f32x4 cs = *(const f32x4*)(p.rope + (size_t)row * 16 + (fq & 1) * 4), sn = *(const f32x4*)(p.rope + (size_t)row * 16 + 8 + (fq & 1) * 4);
#pragma unroll
                    for (int r = 0; r < 4; ++r) {
                        const float other = __shfl_xor(v[r], 32);
                        v[r] = (fq < 2) ? (v[r] * cs[r] - other * sn[r]) : (v[r] * cs[r] + other * sn[r]);
                    }
                }
                uint2 o; o.x = pack2(v[0], v[1]); o.y = pack2(v[2], v[3]);
                *(uint2*)(p.hb + (size_t)row * INW + col0 + fq * 4) = o;
            }
        }
        }
    }
}

#define ASTR 72
#define VSTR 260
typedef float f32x16 __attribute__((ext_vector_type(16)));
typedef unsigned u32x2 __attribute__((ext_vector_type(2)));
__device__ void ph_attn(const Params& p, unsigned char* smem, const int vb) {
    bf16_t* sK = (bf16_t*)smem;
    bf16_t* sVt = sK + 256 * ASTR;
    const int tid = threadIdx.x, lane = tid & 63, wid = tid >> 6, r32 = lane & 31, hh = lane >> 5;
    const float C1 = 0.125f * 1.4426950408889634f, LOG2E = 1.4426950408889634f;
    for (int u = vb; u < 16 * 16 * 2; u += gridDim.x) {
        const int kvh = u & 1, nb = (u >> 1) & 15, b = u >> 5;
        __syncthreads();
        for (int c = tid; c < 256 * 8; c += 256) {
            const int li = c >> 3, kc = c & 7;
            const int pos = nb * 128 - 128 + li;
            u32x4 kv = {0u, 0u, 0u, 0u}, vv = {0u, 0u, 0u, 0u};
            if (pos >= 0) {
                const bf16_t* base = p.hb + (size_t)(b * SEQ + pos) * INW;
                kv = *(const u32x4*)(base + 512 + kvh * 64 + kc * 8);
                vv = *(const u32x4*)(base + 640 + kvh * 64 + kc * 8);
            }
            *(u32x4*)(sK + li * ASTR + kc * 8) = kv;
#pragma unroll
            for (int i = 0; i < 4; ++i) {
                sVt[(kc * 8 + 2 * i) * VSTR + li] = (bf16_t)(vv[i] & 0xffffu);
                sVt[(kc * 8 + 2 * i + 1) * VSTR + li] = (bf16_t)(vv[i] >> 16);
            }
        }
        __syncthreads();
        const int hq = kvh * 4 + wid;
        const float sink2 = p.sinks[hq] * LOG2E;
        bf16x8 qn[4];
        {
            const size_t tr0 = (size_t)(b * SEQ + nb * 128 + r32);
#pragma unroll
            for (int ks = 0; ks < 4; ++ks) qn[ks] = *(const bf16x8*)(p.hb + tr0 * INW + hq * 64 + ks * 16 + hh * 8);
        }
#pragma unroll 1
        for (int qt = 0; qt < 4; ++qt) {
            const size_t trow = (size_t)(b * SEQ + nb * 128 + qt * 32 + r32);
            bf16x8 qf[4];
#pragma unroll
            for (int ks = 0; ks < 4; ++ks) qf[ks] = qn[ks];
            {
                const size_t trn = (size_t)(b * SEQ + nb * 128 + (qt < 3 ? qt + 1 : qt) * 32 + r32);
#pragma unroll
                for (int ks = 0; ks < 4; ++ks) qn[ks] = *(const bf16x8*)(p.hb + trn * INW + hq * 64 + ks * 16 + hh * 8);
            }
            f32x16 S[5];
#pragma unroll
            for (int j = 0; j < 5; ++j) {
#pragma unroll
                for (int r = 0; r < 16; ++r) S[j][r] = 0.f;
#pragma unroll
                for (int ks = 0; ks < 4; ++ks) {
                    const bf16x8 a = *(const bf16x8*)(sK + ((qt + j) * 32 + r32) * ASTR + ks * 16 + hh * 8);
                    S[j] = __builtin_amdgcn_mfma_f32_32x32x16_bf16(a, qf[ks], S[j], 0, 0, 0);
                }
            }
            float m2 = sink2;
#pragma unroll
            for (int j = 0; j < 5; ++j) {
                const bool tile_ok = (nb > 0) || (qt + j >= 4);
#pragma unroll
                for (int r = 0; r < 16; ++r) {
                    const int kl = (r & 3) + 8 * (r >> 2) + 4 * hh;
                    bool ok = tile_ok;
                    if (j == 0) ok = ok && (kl > r32);
                    if (j == 4) ok = ok && (kl <= r32);
                    const float t = ok ? S[j][r] * C1 : -1.0e30f;
                    S[j][r] = t;
                    m2 = fmaxf(m2, t);
                }
            }
            m2 = fmaxf(m2, __shfl_xor(m2, 32));
            float l = 0.f;
#pragma unroll
            for (int j = 0; j < 5; ++j)
#pragma unroll
                for (int r = 0; r < 16; ++r) { const float e = __builtin_amdgcn_exp2f(S[j][r] - m2); S[j][r] = e; l += e; }
            l += __shfl_xor(l, 32);
            l += __builtin_amdgcn_exp2f(sink2 - m2);
            f32x16 O[2];
#pragma unroll
            for (int dt = 0; dt < 2; ++dt)
#pragma unroll
                for (int r = 0; r < 16; ++r) O[dt][r] = 0.f;
#pragma unroll
            for (int j = 0; j < 5; ++j)
#pragma unroll
                for (int s2 = 0; s2 < 2; ++s2) {
                    u32x4 pw;
#pragma unroll
                    for (int k = 0; k < 4; ++k) pw[k] = pack2(S[j][8 * s2 + 2 * k], S[j][8 * s2 + 2 * k + 1]);
                    const bf16x8 pf = __builtin_bit_cast(bf16x8, pw);
                    const int kbase = (qt + j) * 32 + 16 * s2 + 4 * hh;
#pragma unroll
                    for (int dt = 0; dt < 2; ++dt) {
                        const bf16_t* vp = sVt + (dt * 32 + r32) * VSTR + kbase;
                        const u32x2 v0 = *(const u32x2*)(vp), v1 = *(const u32x2*)(vp + 8);
                        const u32x4 vw = {v0[0], v0[1], v1[0], v1[1]};
                        O[dt] = __builtin_amdgcn_mfma_f32_32x32x16_bf16(__builtin_bit_cast(bf16x8, vw), pf, O[dt], 0, 0, 0);
                    }
                }
            const float il = __builtin_amdgcn_rcpf(l);
#pragma unroll
            for (int dt = 0; dt < 2; ++dt)
#pragma unroll
                for (int g = 0; g < 4; ++g) {
                    u32x2 w;
                    w[0] = pack2(O[dt][4 * g] * il, O[dt][4 * g + 1] * il);
                    w[1] = pack2(O[dt][4 * g + 2] * il, O[dt][4 * g + 3] * il);
                    *(u32x2*)(p.mixb + trow * DM + hq * 64 + dt * 32 + 8 * g + 4 * hh) = w;
                }
        }
    }
}

#define CV_ROWS 62
__device__ void ph_conv(const Params& p, unsigned char* smem, const int vb) {
    bf16_t* gl = (bf16_t*)smem;
    float* red = (float*)(smem + CV_ROWS * 1024);
    const int tid = threadIdx.x, lane = tid & 63, wid = tid >> 6;
    const f32x2 lg = *(const f32x2*)(p.cln_g + 2 * tid), lb = *(const f32x2*)(p.cln_b + 2 * tid);
    for (int u = vb; u < T_TOK / 32; u += gridDim.x) {
        const int tok0 = u * 32, s0 = tok0 & (SEQ - 1);
        __syncthreads();
#pragma unroll 1
        for (int bt = 0; bt < 2; ++bt) {
            u32x4 av[8];
#pragma unroll
            for (int it = 0; it < 8; ++it) {
                const int ch = tid + (bt * 8 + it) * 256, row = min(ch >> 6, CV_ROWS - 1), k = ch & 63;
                const int rr = (s0 - 30 + row >= 0) ? row : 30;
                av[it] = *(const u32x4*)(p.hb + (size_t)(tok0 - 30 + rr) * INW + 768 + k * 8);
            }
#pragma unroll
            for (int it = 0; it < 8; ++it) {
                const int ch = tid + (bt * 8 + it) * 256, row = ch >> 6, k = ch & 63;
                const bool ok = (s0 - 30 + row >= 0);
                const u32x4 o = ok ? av[it] : (u32x4){0u, 0u, 0u, 0u};
                if (row < CV_ROWS) *(u32x4*)(gl + row * 512 + k * 8) = o;
            }
        }
        __syncthreads();
        float w0[31], w1[31];
#pragma unroll
        for (int k = 0; k < 31; ++k) { const f32x2 wv = *(const f32x2*)(p.conv_w + k * 512 + 2 * tid); w0[k] = wv.x; w1[k] = wv.y; }
        const f32x2 bias = *(const f32x2*)(p.conv_b + 2 * tid);
#pragma unroll 1
        for (int jh = 0; jh < 2; ++jh) {
            float a0[16], a1[16];
#pragma unroll
            for (int jl = 0; jl < 16; ++jl) { a0[jl] = bias.x; a1[jl] = bias.y; }
            const bf16_t* gp = gl + (jh * 16) * 512 + 2 * tid;
#pragma unroll
            for (int il = 0; il < 46; ++il) {
                const unsigned gw = *(const unsigned*)(gp + il * 512);
                const float g0 = bflo(gw), g1 = bfhi(gw);
#pragma unroll
                for (int jl = 0; jl < 16; ++jl)
                    if (il - jl >= 0 && il - jl <= 30) { a0[jl] += w0[il - jl] * g0; a1[jl] += w1[il - jl] * g1; }
                if ((il & 3) == 3) __builtin_amdgcn_sched_barrier(0);
            }
            float v[32];
#pragma unroll
            for (int jl = 0; jl < 16; ++jl) { v[jl] = a0[jl] + a1[jl]; v[16 + jl] = a0[jl] * a0[jl] + a1[jl] * a1[jl]; }
#pragma unroll
            for (int st = 16; st >= 1; st >>= 1) {
                const bool up = (lane & st) != 0;
#pragma unroll
                for (int i2 = 0; i2 < st; ++i2) {
                    const float keep = up ? v[i2 + st] : v[i2], send = up ? v[i2] : v[i2 + st];
                    v[i2] = keep + __shfl_xor(send, st);
                }
            }
            const float tot = v[0] + __shfl_xor(v[0], 32);
            __syncthreads();
            if (lane < 32) red[wid * 32 + lane] = tot;
            __syncthreads();
#pragma unroll
            for (int jl = 0; jl < 16; ++jl) {
                const float sm = (red[jl] + red[32 + jl]) + (red[64 + jl] + red[96 + jl]);
                const float sq = (red[16 + jl] + red[48 + jl]) + (red[80 + jl] + red[112 + jl]);
                const float mu = sm * (1.0f / 512.0f);
                const float rstd = rsqrtf(fmaxf(sq * (1.0f / 512.0f) - mu * mu, 0.f) + LN_EPS);
                const float y0 = (a0[jl] - mu) * rstd * lg.x + lb.x, y1 = (a1[jl] - mu) * rstd * lg.y + lb.y;
                *(unsigned*)(p.mixb + (size_t)(tok0 + jh * 16 + jl) * DM + 512 + 2 * tid) = pack2(sigmul(y0, y0), sigmul(y1, y1));
            }
        }
    }
}

__device__ void ph_gemm_out(const Params& p, unsigned char* smem, const int vb) {
    const int ntn = DM / 256;
    const int tid = threadIdx.x, lane = tid & 63, wid = tid >> 6, wr = wid >> 1, wc = wid & 1, fr = lane & 15, fq = lane >> 4;
    for (int t = vb; t < (T_TOK / 128) * ntn; t += gridDim.x) {
        const int m0 = (t / ntn) * 128, n0 = (t % ntn) * 256;
        f32x4 acc[4][8]; zero_accw(acc);
        u32x2 xq[2][8];
#define GO_XLD(mi, buf) do { const int _row = m0 + wr * 64 + (mi) * 16 + fr; \
            _Pragma("unroll") for (int _ni = 0; _ni < 8; ++_ni) xq[buf][_ni] = *(const u32x2*)(p.xb + (size_t)_row * DM + n0 + wc * 128 + _ni * 16 + fq * 4); } while (0)
        gemmW(p.mixb + (size_t)m0 * DM, DM, p.WoutT + (size_t)n0 * DM, DM, DM, smem, acc);
        GO_XLD(0, 0);
#pragma unroll
        for (int mi = 0; mi < 4; ++mi) {
            const int row = m0 + wr * 64 + mi * 16 + fr;
            if (mi < 3) GO_XLD(mi + 1, (mi + 1) & 1);
            float sm = 0.f, sq = 0.f;
#pragma unroll
            for (int ni = 0; ni < 8; ++ni) {
                const int col = n0 + wc * 128 + ni * 16 + fq * 4;
                const u32x2 xw = xq[mi & 1][ni];
                const f32x4 xv = {bflo(xw[0]), bfhi(xw[0]), bflo(xw[1]), bfhi(xw[1])};
                const f32x4 y = xv * ALPHA + acc[mi][ni];
                sm += (y[0] + y[1]) + (y[2] + y[3]); sq += (y[0] * y[0] + y[1] * y[1]) + (y[2] * y[2] + y[3] * y[3]);
                u32x2 o; o[0] = pack2(y[0], y[1]); o[1] = pack2(y[2], y[3]);
                *(u32x2*)(p.y1b + (size_t)row * DM + col) = o;
            }
            sm += __shfl_xor(sm, 16); sq += __shfl_xor(sq, 16); sm += __shfl_xor(sm, 32); sq += __shfl_xor(sq, 32);
            if (fq == 0) *(f32x2*)(p.stats + (size_t)row * 16 + ((n0 >> 8) * 2 + wc) * 2) = (f32x2){sm, sq};
        }
    }
}

__device__ __forceinline__ void ln_row(const float* __restrict__ src, const float* __restrict__ g, const float* __restrict__ bta,
                                       float* __restrict__ dstf, bf16_t* __restrict__ dstb, int lane) {
    f32x4 v[4]; float s = 0.f;
#pragma unroll
    for (int i = 0; i < 4; ++i) { v[i] = *(const f32x4*)(src + i * 256 + lane * 4); s += (v[i][0] + v[i][1]) + (v[i][2] + v[i][3]); }
    const float mu = wave_sum(s) * (1.0f / 1024.0f);
    float q = 0.f;
#pragma unroll
    for (int i = 0; i < 4; ++i) { const f32x4 d = v[i] - mu; q += (d[0] * d[0] + d[1] * d[1]) + (d[2] * d[2] + d[3] * d[3]); }
    const float rstd = rsqrtf(wave_sum(q) * (1.0f / 1024.0f) + LN_EPS);
#pragma unroll
    for (int i = 0; i < 4; ++i) {
        const f32x4 gg = *(const f32x4*)(g + i * 256 + lane * 4), bb = *(const f32x4*)(bta + i * 256 + lane * 4);
        const f32x4 y = (v[i] - mu) * rstd * gg + bb;
        if (dstf) *(f32x4*)(dstf + i * 256 + lane * 4) = y;
        if (dstb) { uint2 o; o.x = pack2(y[0], y[1]); o.y = pack2(y[2], y[3]); *(uint2*)(dstb + i * 256 + lane * 4) = o; }
    }
}
__device__ void ph_ln2(const Params& p, const int vb) {
    const int lane = threadIdx.x & 63, wid = threadIdx.x >> 6;
    for (int r = vb * 4 + wid; r < T_TOK; r += gridDim.x * 4)
        ln_row(p.out + (size_t)r * DM, p.ln2_g, p.ln2_b, p.out + (size_t)r * DM, (bf16_t*)nullptr, lane);
}

#define QSTR 136
__device__ __forceinline__ int f2key(float f) { const int b = __float_as_int(f); return b ^ ((b >> 31) & 0x7fffffff); }
__device__ __forceinline__ float key2f(int k) { return __int_as_float(k ^ ((k >> 31) & 0x7fffffff)); }
__device__ __forceinline__ void sort16_desc(int (&a)[16]) {
#pragma unroll
    for (int lk = 1; lk <= 4; ++lk) {
#pragma unroll
        for (int lj = lk - 1; lj >= 0; --lj) {
            const int k = 1 << lk, j = 1 << lj;
#pragma unroll
            for (int i = 0; i < 16; ++i) {
                const int l = i ^ j;
                if (l > i) {
                    const int hi = max(a[i], a[l]), lo = min(a[i], a[l]);
                    if ((i & k) == 0) { a[i] = hi; a[l] = lo; } else { a[i] = lo; a[l] = hi; }
                }
            }
        }
    }
}
__device__ __forceinline__ void merge_top16(int (&a)[16], const int (&b)[16]) {
#pragma unroll
    for (int i = 0; i < 16; ++i) a[i] = max(a[i], b[15 - i]);
#pragma unroll
    for (int lj = 3; lj >= 0; --lj) {
        const int j = 1 << lj;
#pragma unroll
        for (int i = 0; i < 16; ++i) {
            const int l = i ^ j;
            if (l > i) { const int hi = max(a[i], a[l]), lo = min(a[i], a[l]); a[i] = hi; a[l] = lo; }
        }
    }
}
__device__ __forceinline__ void top16_of_64(int (&v)[4][16]) {
    sort16_desc(v[0]); sort16_desc(v[1]); sort16_desc(v[2]); sort16_desc(v[3]);
    merge_top16(v[0], v[1]); merge_top16(v[0], v[2]); merge_top16(v[0], v[3]);
}

__device__ void ph_mprep(const Params& p, unsigned char* smem, const int vb) {
    if (vb < 8) {
        const int n = vb * 256 + threadIdx.x, hp = n >> 7;
        const float* kr = p.keys + (size_t)n * 128;
        float a = 0.f, b = 0.f;
        for (int c4 = 0; c4 < 128; c4 += 4) {
            const f32x4 kv = *(const f32x4*)(kr + c4), wg = *(const f32x4*)(p.wgb + hp * 128 + c4), wb = *(const f32x4*)(p.wgb + 2048 + hp * 128 + c4);
            a += (kv[0] * wg[0] + kv[1] * wg[1]) + (kv[2] * wg[2] + kv[3] * wg[3]);
            b += (kv[0] * wb[0] + kv[1] * wb[1]) + (kv[2] * wb[2] + kv[3] * wb[3]);
        }
        u32x4 c0 = {pack2(a, b), 0u, 0u, 0u}; const u32x4 z4 = {0u, 0u, 0u, 0u};
        u32x4* me = (u32x4*)(p.mext + (size_t)n * 32);
        me[0] = c0; me[1] = z4; me[2] = z4; me[3] = z4;
    }
    const int tid = threadIdx.x, lane = tid & 63, wid = tid >> 6, wr = wid >> 1, wc = wid & 1, fr = lane & 15, fq = lane >> 4;
    for (int t = vb; t < 16 * 8; t += gridDim.x) {
        const int hp = t >> 3, d0 = (t & 7) * 128;
        f32x4 acc[4][4]; zero_acc(acc);
        gemm128(p.keysb + (size_t)hp * 128 * 128, 128, p.Wqb + (size_t)d0 * 2048 + hp * 128, 2048, 128, smem, acc);
#pragma unroll
        for (int mi = 0; mi < 4; ++mi)
#pragma unroll
            for (int ni = 0; ni < 4; ++ni) {
                uint2 o; o.x = pack2(acc[mi][ni][0], acc[mi][ni][1]); o.y = pack2(acc[mi][ni][2], acc[mi][ni][3]);
                *(uint2*)(p.MT + (size_t)(hp * 128 + wr * 64 + mi * 16 + fr) * DM + d0 + wc * 64 + ni * 16 + fq * 4) = o;
            }
    }
}

__device__ __forceinline__ void route_topk(const f32x16 (&S)[8], int pp, int hh, int (&K)[16]) {
    int v[4][16];
#pragma unroll
    for (int mt = 0; mt < 4; ++mt)
#pragma unroll
        for (int r = 0; r < 16; ++r) {
            const int n = mt * 32 + (r & 3) + 8 * (r >> 2) + 4 * hh;
            v[mt][r] = (f2key(S[pp * 4 + mt][r]) & ~0x7F) | (127 - n);
        }
    top16_of_64(v);
    int o[16];
#pragma unroll
    for (int i = 0; i < 16; ++i) o[i] = __shfl_xor(v[0][i], 32);
    merge_top16(v[0], o);
#pragma unroll
    for (int i = 0; i < 16; ++i) K[i] = v[0][i];
}
#define RT_STEPS 33
template <bool PRE, bool NEXT>
__device__ __forceinline__ void route_gemm(const Params& p, unsigned char* smem, int m0, int h, f32x16 (&S)[8], int nm0, int nh, int& sp) {
    LDS_AS unsigned char* lds = (LDS_AS unsigned char*)smem;
    const int tid = threadIdx.x, lane = tid & 63, wid = __builtin_amdgcn_readfirstlane(tid >> 6);
    const int r32 = lane & 31, hh = lane >> 5;
    const int prow = lane >> 2, pc = (lane & 3) ^ ((4 - ((prow >> 2) & 3)) & 3);
    const bf16_t* gA = p.y1b + (size_t)(m0 + wid * 32 + prow) * DM + pc * 8;
    const bf16_t* gB = p.MT + (size_t)(h * 256 + wid * 64 + prow) * DM + pc * 8;
    const bf16_t* eA = p.yext + (size_t)(m0 + wid * 32 + prow) * 32 + pc * 8;
    const bf16_t* eB = p.mext + (size_t)(h * 256 + wid * 64 + prow) * 32 + pc * 8;
    const size_t r16 = (size_t)16 * DM;
#define RH_ISSUE_AT(pa, sa, pb, sb_, st) do { \
        _Pragma("unroll") for (int _i = 0; _i < 2; ++_i) \
            __builtin_amdgcn_global_load_lds((const unsigned*)((pa) + _i * (sa)), (LDS_AS unsigned*)(lds + (st) * GW_STAGE + (wid * 2 + _i) * 1024), 16, 0, 0); \
        _Pragma("unroll") for (int _i = 0; _i < 4; ++_i) \
            __builtin_amdgcn_global_load_lds((const unsigned*)((pb) + _i * (sb_)), (LDS_AS unsigned*)(lds + (st) * GW_STAGE + 8192 + (wid * 4 + _i) * 1024), 16, 0, 0); \
        } while (0)
#pragma unroll
    for (int mt = 0; mt < 8; ++mt)
#pragma unroll
        for (int r = 0; r < 16; ++r) S[mt][r] = 0.f;
    const int fx = (4 - ((r32 >> 2) & 3)) & 3;
    const int toff = (wid * 32 + r32) * 64, koff = 8192 + r32 * 64;
    if (!PRE) RH_ISSUE_AT(gA, r16, gB, r16, sp);
#pragma unroll 1
    for (int kt = 0; kt < RT_STEPS; ++kt) {
        const int st = (kt + sp) & 1;
        asm volatile("s_waitcnt vmcnt(0)" ::: "memory");
        __builtin_amdgcn_s_barrier();
        asm volatile("" ::: "memory");
        if (kt + 1 < RT_STEPS - 1) RH_ISSUE_AT(gA + (size_t)(kt + 1) * 32, r16, gB + (size_t)(kt + 1) * 32, r16, st ^ 1);
        else if (kt + 1 == RT_STEPS - 1) RH_ISSUE_AT(eA, (size_t)(16 * 32), eB, (size_t)(16 * 32), st ^ 1);
        else if (NEXT) {
            const bf16_t* qA = p.y1b + (size_t)(nm0 + wid * 32 + prow) * DM + pc * 8;
            const bf16_t* qB = p.MT + (size_t)(nh * 256 + wid * 64 + prow) * DM + pc * 8;
            RH_ISSUE_AT(qA, r16, qB, r16, st ^ 1);
        }
        const LDS_AS unsigned char* sb = lds + st * GW_STAGE;
#pragma unroll
        for (int k16 = 0; k16 < 2; ++k16) {
            const int sw = ((k16 * 2 + hh) ^ fx) * 16;
            const bf16x8 b = *(const LDS_AS bf16x8*)(sb + toff + sw);
#pragma unroll
            for (int mt = 0; mt < 8; ++mt) {
                const bf16x8 a = *(const LDS_AS bf16x8*)(sb + koff + mt * 2048 + sw);
                S[mt] = __builtin_amdgcn_mfma_f32_32x32x16_bf16(a, b, S[mt], 0, 0, 0);
            }
        }
        asm volatile("s_waitcnt lgkmcnt(0)" ::: "memory");
        __builtin_amdgcn_s_barrier();
        asm volatile("" ::: "memory");
    }
    sp ^= (RT_STEPS & 1);
#undef RH_ISSUE_AT
}

__device__ void ph_route(const Params& p, unsigned char* smem, const int vb) {
    const int tid = threadIdx.x, lane = tid & 63, wid = tid >> 6;
    const int r32 = lane & 31, hh = lane >> 5;
    const int hmask = -hh;
    int* KL = (int*)(smem + 2 * GW_STAGE + (size_t)wid * 32 * 33 * 4);
    const int nunits = (T_TOK / 128) * 8;
    bool pre = false; int sp = 0;
    for (int u = vb; u < nunits; u += gridDim.x) {
        const int m0 = (u >> 3) * 128, h = u & 7;
        const int un = u + gridDim.x;
        const bool has_next = un < nunits;
        const int nm0 = ((has_next ? un : u) >> 3) * 128, nh = (has_next ? un : u) & 7;
        float mu, rstd;
        {
            const float* stp = p.stats + (size_t)(m0 + wid * 32 + r32) * 16;
            const f32x4 a = *(const f32x4*)(stp), b = *(const f32x4*)(stp + 4), c4 = *(const f32x4*)(stp + 8), d = *(const f32x4*)(stp + 12);
            const float sm = (a[0] + a[2]) + (b[0] + b[2]) + (c4[0] + c4[2]) + (d[0] + d[2]);
            const float sq = (a[1] + a[3]) + (b[1] + b[3]) + (c4[1] + c4[3]) + (d[1] + d[3]);
            mu = sm * (1.0f / 1024.0f);
            rstd = rsqrtf(fmaxf(sq * (1.0f / 1024.0f) - mu * mu, 0.f) + LN_EPS);
        }
        {
            bf16_t* ye = p.yext + (size_t)(m0 + wid * 32 + r32) * 32 + hh * 16;
            const u32x4 z4 = {0u, 0u, 0u, 0u};
            u32x4 c0 = z4; if (hh == 0) c0[0] = pack2(-mu, __builtin_amdgcn_rcpf(rstd));
            *(u32x4*)(ye) = c0; *(u32x4*)(ye + 8) = z4;
        }
        f32x16 S[8];
        if (pre) { if (has_next) route_gemm<true, true>(p, smem, m0, h, S, nm0, nh, sp); else route_gemm<true, false>(p, smem, m0, h, S, nm0, nh, sp); }
        else     { if (has_next) route_gemm<false, true>(p, smem, m0, h, S, nm0, nh, sp); else route_gemm<false, false>(p, smem, m0, h, S, nm0, nh, sp); }
        int K0[16], K1[16];
        route_topk(S, 0, hh, K0);
        route_topk(S, 1, hh, K1);
        pre = has_next;
#pragma unroll
        for (int i = 0; i < 16; ++i) KL[r32 * 33 + hh * 16 + i] = K0[i] ^ ((K0[i] ^ K1[i]) & hmask);
        float s1[16], s2[16];
#pragma unroll
        for (int i = 0; i < 16; ++i) { s1[i] = key2f(K0[i] & ~0x7F); s2[i] = key2f(K1[i] & ~0x7F); }
        int c[4][16];
#pragma unroll
        for (int i = 0; i < 16; ++i)
#pragma unroll
            for (int j = 0; j < 16; ++j)
                if ((i + 1) * (j + 1) <= 16) {
                    constexpr int OFFS[16] = {0, 16, 24, 29, 33, 36, 38, 40, 42, 43, 44, 45, 46, 47, 48, 49};
                    const int q = OFFS[i] + j;
                    c[q >> 4][q & 15] = (f2key(s1[i] + s2[j]) & ~0xFF) | (255 - (i * 16 + j));
                }
#pragma unroll
        for (int qq = 50; qq < 64; ++qq) c[qq >> 4][qq & 15] = (int)0x80000000;
        top16_of_64(c);
        const float mx = key2f(c[0][0] & ~0xFF);
        float e[16]; float den = 0.f;
#pragma unroll
        for (int i = 0; i < 16; ++i) { e[i] = __expf(rstd * (key2f(c[0][i] & ~0xFF) - mx)); den += e[i]; }
        const float inv = __builtin_amdgcn_rcpf(den);
        const size_t ob = (size_t)(m0 + wid * 32 + r32) * 128 + h * 16 + hh * 8;
        int idv[8]; float gv[8];
#pragma unroll
        for (int qq = 0; qq < 8; ++qq) {
            const int F = c[0][qq] ^ ((c[0][qq] ^ c[0][8 + qq]) & hmask);
            gv[qq] = __int_as_float(__float_as_int(e[qq]) ^ ((__float_as_int(e[qq]) ^ __float_as_int(e[8 + qq])) & hmask)) * inv;
            const int idx = 255 - (F & 0xFF);
            const int k0 = KL[r32 * 33 + (idx >> 4)], k1 = KL[r32 * 33 + 16 + (idx & 15)];
            idv[qq] = (127 - (k0 & 0x7F)) * 128 + (127 - (k1 & 0x7F));
        }
        *(int4*)(p.ids + ob) = make_int4(idv[0], idv[1], idv[2], idv[3]);
        *(int4*)(p.ids + ob + 4) = make_int4(idv[4], idv[5], idv[6], idv[7]);
        *(float4*)(p.gates + ob) = make_float4(gv[0], gv[1], gv[2], gv[3]);
        *(float4*)(p.gates + ob + 4) = make_float4(gv[4], gv[5], gv[6], gv[7]);
    }
}

__device__ __forceinline__ float gelu_gate(float h, float g) { return 0.5f * h * (1.0f + erff(h * 0.70710678118654752f)) * g; }

__device__ void ph_peer_u(const Params& p, unsigned char* smem, const int vb) {
    const int lane = threadIdx.x & 63, wid = __builtin_amdgcn_readfirstlane(threadIdx.x >> 6);
    const int q = lane >> 3, c = lane & 7, j = lane & 15, kb = lane >> 4;
    const int nlb = gridDim.x >> 3, s = vb / nlb, lb = vb - s * nlb;
    const int stride = nlb * 4, t0 = lb * 4 + wid;
    const int ntok = (T_TOK - t0 + stride - 1) / stride;
    if (ntok <= 0) return;
    LDS_AS unsigned char* wb = (LDS_AS unsigned char*)smem + wid * 18432;
    LDS_AS unsigned char* ring = wb + 16384;
    const unsigned char* ubase = p.u8 + (size_t)s * (16384 * 128) + ((c ^ q) * 16);
    const unsigned char* ubase1 = p.u8 + (size_t)s * (16384 * 128) + ((c ^ q ^ 1) * 16);
    const unsigned char* rsrc; unsigned rstr;
    if (lane < 32) { rsrc = (const unsigned char*)p.ids + lane * 16; rstr = 512; }
    else if (lane < 48) { rsrc = (const unsigned char*)p.y1b + s * 256 + (lane - 32) * 16; rstr = 2048; }
    else { rsrc = (const unsigned char*)p.stats + ((2 * s + 1) >> 2) * 16; rstr = 64; }
#define PM_TOK(n) (t0 + ((n) < ntok ? (n) : ntok - 1) * stride)
#define PM_RING(n) do { if (lane < 49) __builtin_amdgcn_global_load_lds((const unsigned*)(rsrc + (size_t)PM_TOK(n) * rstr), (LDS_AS unsigned*)(ring + ((n) & 1) * 1024), 16, 0, 0); } while (0)
#define PM_IDS(n, ia, ib) do { const LDS_AS u32x4* _q = (const LDS_AS u32x4*)(ring + ((n) & 1) * 1024 + q * 32); \
        const u32x4 _a0 = _q[0], _a1 = _q[1], _b0 = _q[16], _b1 = _q[17]; \
        ia[0] = _a0[0]; ia[1] = _a0[1]; ia[2] = _a0[2]; ia[3] = _a0[3]; ia[4] = _a1[0]; ia[5] = _a1[1]; ia[6] = _a1[2]; ia[7] = _a1[3]; \
        ib[0] = _b0[0]; ib[1] = _b0[1]; ib[2] = _b0[2]; ib[3] = _b0[3]; ib[4] = _b1[0]; ib[5] = _b1[1]; ib[6] = _b1[2]; ib[7] = _b1[3]; } while (0)
#define PM_DMA(i, id) __builtin_amdgcn_global_load_lds((const unsigned*)((((i) & 1) ? ubase1 : ubase) + (size_t)(id) * 128), (LDS_AS unsigned*)(wb + (i) * 1024), 16, 0, 0)
    const int key = (j & 7) ^ (j >> 3);
    const LDS_AS unsigned char* brd = wb + j * 128 + (((2 * kb) ^ key) * 16);
    const int bx1 = (key & 1) ? -16 : 16;
    const LDS_AS unsigned char* ard = ring + (j & 1) * 1024 + 832 + kb * 32;
    PM_RING(0); PM_RING(1);
    asm volatile("s_waitcnt vmcnt(0)" ::: "memory");
    {
        unsigned ia[8], ib[8]; PM_IDS(0, ia, ib);
#pragma unroll
        for (int m = 0; m < 4; ++m) { PM_DMA(2 * m, ia[m]); PM_DMA(2 * m + 1, ib[m]); }
#pragma unroll
        for (int m = 4; m < 8; ++m) { PM_DMA(2 * m, ia[m]); PM_DMA(2 * m + 1, ib[m]); }
    }
    const int sqi = ((2 * s + 1) & 3) * 4;
#pragma unroll 1
    for (int n = 0; n < ntok; ++n) {
        const int t = t0 + n * stride;
        LDS_AS unsigned char* slot = ring + (n & 1) * 1024;
        const unsigned xw = *(const LDS_AS unsigned*)(slot + 512 + lane * 4);
        const float ssq = *(const LDS_AS float*)(slot + 768 + sqi);
        const int e2 = (int)(__float_as_uint(ssq) >> 23) - 126;
        int eh = (e2 + 1) >> 1; eh = eh < -60 ? -60 : (eh > 60 ? 60 : eh);
        const float sc = __uint_as_float((unsigned)(127 + 8 - eh) << 23), isc = __uint_as_float((unsigned)(127 - 8 + eh) << 23);
        const float x0 = bflo(xw) * sc, x1 = bfhi(xw) * sc;
        const unsigned h8 = (unsigned)__builtin_amdgcn_cvt_pk_fp8_f32(x0, x1, 0, false);
        const f32x2 hd = __builtin_amdgcn_cvt_pk_f32_fp8((int)h8, false);
        const unsigned l8 = (unsigned)__builtin_amdgcn_cvt_pk_fp8_f32(x0 - hd.x, x1 - hd.y, 0, false);
        *(LDS_AS unsigned short*)(ring + 832 + lane * 2) = (unsigned short)h8;
        *(LDS_AS unsigned short*)(ring + 1024 + 832 + lane * 2) = (unsigned short)l8;
        const u32x4 xa0 = *(const LDS_AS u32x4*)(ard), xa1 = *(const LDS_AS u32x4*)(ard + 16);
        i64 xa[4];
        xa[0] = (i64)(((unsigned long long)xa0[1] << 32) | xa0[0]); xa[1] = (i64)(((unsigned long long)xa0[3] << 32) | xa0[2]);
        xa[2] = (i64)(((unsigned long long)xa1[1] << 32) | xa1[0]); xa[3] = (i64)(((unsigned long long)xa1[3] << 32) | xa1[2]);
        f32x4 acc[8];
        asm volatile("s_waitcnt vmcnt(16)" ::: "memory");
        unsigned ia[8], ib[8]; PM_IDS(n + 1, ia, ib);
        asm volatile("s_waitcnt lgkmcnt(0)" ::: "memory");
        PM_RING(n + 2);
#pragma unroll
        for (int m = 0; m < 8; ++m) {
            asm volatile("s_waitcnt vmcnt(15)" ::: "memory");
            const u32x4 b0 = *(const LDS_AS u32x4*)(brd + m * 2048), b1 = *(const LDS_AS u32x4*)(brd + m * 2048 + bx1);
            asm volatile("s_waitcnt lgkmcnt(0)" ::: "memory");
            PM_DMA(2 * m, ia[m]); PM_DMA(2 * m + 1, ib[m]);
            f32x4 a = {0.f, 0.f, 0.f, 0.f};
            a = __builtin_amdgcn_mfma_f32_16x16x32_fp8_fp8(xa[0], (i64)(((unsigned long long)b0[1] << 32) | b0[0]), a, 0, 0, 0);
            a = __builtin_amdgcn_mfma_f32_16x16x32_fp8_fp8(xa[1], (i64)(((unsigned long long)b0[3] << 32) | b0[2]), a, 0, 0, 0);
            a = __builtin_amdgcn_mfma_f32_16x16x32_fp8_fp8(xa[2], (i64)(((unsigned long long)b1[1] << 32) | b1[0]), a, 0, 0, 0);
            a = __builtin_amdgcn_mfma_f32_16x16x32_fp8_fp8(xa[3], (i64)(((unsigned long long)b1[3] << 32) | b1[2]), a, 0, 0, 0);
            acc[m] = a;
        }
        if (lane < 16) {
            u32x4 o;
#pragma unroll
            for (int k = 0; k < 4; ++k) o[k] = pack2((acc[2 * k][0] + acc[2 * k][1]) * isc, (acc[2 * k + 1][0] + acc[2 * k + 1][1]) * isc);
            *(u32x4*)(p.hp + ((size_t)t * 8 + s) * 128 + lane * 8) = o;
        }
    }
    asm volatile("s_waitcnt vmcnt(0)" ::: "memory");
}
__device__ void ph_peer_act(const Params& p, unsigned char* smem, const int vb) {
    const int lane = threadIdx.x & 63, wid = threadIdx.x >> 6;
    unsigned* lsc = (unsigned*)smem;
    LDS_AS unsigned char* img = (LDS_AS unsigned char*)smem + 65536 + wid * 256;
    __syncthreads();
    for (int i = threadIdx.x; i < 16384 / 4; i += 256) *(u32x4*)(lsc + 4 * i) = *(const u32x4*)((const unsigned*)p.sc2 + 4 * i);
    __syncthreads();
    const int e0 = 2 * lane, e1 = e0 + 1;
    const int ix0 = (e0 & 3) * 32 + ((e0 >> 2) & 3) * 8 + (e0 >> 4), ix1 = (e1 & 3) * 32 + ((e1 >> 2) & 3) * 8 + (e1 >> 4);
    for (int t = vb * 4 + wid; t < T_TOK; t += gridDim.x * 4) {
        f32x2 h = {0.f, 0.f};
#pragma unroll
        for (int s = 0; s < 8; ++s) { const unsigned w = *(const unsigned*)(p.hp + ((size_t)t * 8 + s) * 128 + 2 * lane); h += (f32x2){bflo(w), bfhi(w)}; }
        f32x2 pq = *(const f32x2*)(p.stats + (size_t)t * 16 + (lane & 7) * 2);
        pq.x += __shfl_xor(pq.x, 1); pq.y += __shfl_xor(pq.y, 1); pq.x += __shfl_xor(pq.x, 2); pq.y += __shfl_xor(pq.y, 2); pq.x += __shfl_xor(pq.x, 4); pq.y += __shfl_xor(pq.y, 4);
        const float mu = pq.x * (1.0f / 1024.0f), rstd = rsqrtf(fmaxf(pq.y * (1.0f / 1024.0f) - mu * mu, 0.f) + LN_EPS);
        int2 id = *(const int2*)(p.ids + (size_t)t * 128 + 2 * lane);
        id.x &= 0x3fff; id.y &= 0x3fff;
        const f32x2 gt = *(const f32x2*)(p.gates + (size_t)t * 128 + 2 * lane);
        const unsigned s0 = lsc[id.x], s1 = lsc[id.y];
        const unsigned c0 = p.cb2[id.x], c1 = p.cb2[id.y];
        f32x2 a;
        a.x = gelu_gate(rstd * (h.x * bflo(s0) - mu * bflo(c0)) + bfhi(c0), gt.x) * bfhi(s0);
        a.y = gelu_gate(rstd * (h.y * bflo(s1) - mu * bflo(c1)) + bfhi(c1), gt.y) * bfhi(s1);
        float am = fmaxf(fabsf(a.x), fabsf(a.y));
#pragma unroll
        for (int o = 32; o >= 1; o >>= 1) am = fmaxf(am, __shfl_xor(am, o));
        int be = (int)(__float_as_uint(am) >> 23); be = be < 20 ? 20 : (be > 240 ? 240 : be);
        const float sc = __uint_as_float((unsigned)(261 - be) << 23);
        const unsigned iscb = (unsigned)(be - 7) << 23;
        const float x0 = a.x * sc, x1 = a.y * sc;
        const unsigned h8 = (unsigned)__builtin_amdgcn_cvt_pk_fp8_f32(x0, x1, 0, false);
        const f32x2 hd = __builtin_amdgcn_cvt_pk_f32_fp8((int)h8, false);
        const unsigned l8 = (unsigned)__builtin_amdgcn_cvt_pk_fp8_f32(x0 - hd.x, x1 - hd.y, 0, false);
        img[ix0] = (unsigned char)h8; img[ix1] = (unsigned char)(h8 >> 8);
        img[128 + ix0] = (unsigned char)l8; img[128 + ix1] = (unsigned char)(l8 >> 8);
        const unsigned iw = *(const LDS_AS unsigned*)(img + lane * 4);
        *(unsigned*)((unsigned char*)p.gates + (size_t)t * 512 + lane * 4) = iw;
        if (lane < 3) {
            const unsigned pb = lane == 0 ? __float_as_uint(mu) : (lane == 1 ? __float_as_uint(rstd) : iscb);
            *(int2*)(p.ids + (size_t)t * 128 + 2 * lane) = make_int2(id.x | (int)(pb & 0xffff0000u), id.y | (int)(pb << 16));
        }
    }
}
typedef int v2i32 __attribute__((ext_vector_type(2)));
__device__ void ph_peer_v(const Params& p, unsigned char* smem, const int vb) {
    const int lane = threadIdx.x & 63, wid = __builtin_amdgcn_readfirstlane(threadIdx.x >> 6);
    const int q = lane >> 3, c = lane & 7, j = lane & 15, kb = lane >> 4;
    const int nlb = gridDim.x >> 3, s = vb / nlb, lb = vb - s * nlb;
    const int stride = nlb * 4, t0 = lb * 4 + wid;
    const int ntok = (T_TOK - t0 + stride - 1) / stride;
    if (ntok <= 0) return;
    LDS_AS unsigned char* wb = (LDS_AS unsigned char*)smem + wid * 18432;
    LDS_AS unsigned char* ring = wb + 16384;
    const unsigned char* vbase = p.v8 + (size_t)s * (16384 * 128) + ((c ^ q) * 16);
    const unsigned char* vbase1 = p.v8 + (size_t)s * (16384 * 128) + ((c ^ q ^ 1) * 16);
    const unsigned char* rsrc; unsigned rstr;
    if (lane < 32) { rsrc = (const unsigned char*)p.ids + lane * 16; rstr = 512; }
    else if (lane < 48) { rsrc = (const unsigned char*)p.gates + (lane - 32) * 16; rstr = 512; }
    else { rsrc = (const unsigned char*)p.y1b + s * 256 + (lane - 48) * 16; rstr = 2048; }
#define PV_RING(n) __builtin_amdgcn_global_load_lds((const unsigned*)(rsrc + (size_t)PM_TOK(n) * rstr), (LDS_AS unsigned*)(ring + ((n) & 1) * 1024), 16, 0, 0)
#define PV_IDS(n, idv) do { const LDS_AS u32x4* _q = (const LDS_AS u32x4*)(ring + ((n) & 1) * 1024 + q * 64); \
        _Pragma("unroll") for (int _k = 0; _k < 4; ++_k) { const u32x4 _v = _q[_k]; idv[4 * _k] = _v[0] & 0x3fffu; idv[4 * _k + 1] = _v[1] & 0x3fffu; idv[4 * _k + 2] = _v[2] & 0x3fffu; idv[4 * _k + 3] = _v[3] & 0x3fffu; } } while (0)
#define PV_DMA(i, id) __builtin_amdgcn_global_load_lds((const unsigned*)((((i) & 1) ? vbase1 : vbase) + (size_t)(id) * 128), (LDS_AS unsigned*)(wb + (i) * 1024), 16, 0, 0)
    const int key = (j >> 1) ^ (kb & 1);
    const LDS_AS unsigned char* tb = wb + (8 * kb + (j >> 1)) * 128 + (j & 1) * 8;
    const LDS_AS unsigned char* ard = ring + 512 + (j & 1) * 128 + kb * 32;
    const int dl = 32 * kb + (j & 1) * 16 + (j & 14), d0 = s * 128 + dl;
    const f32x2 g2 = *(const f32x2*)(p.ln1_g + d0), b2 = *(const f32x2*)(p.ln1_b + d0);
    PV_RING(0); PV_RING(1);
    asm volatile("s_waitcnt vmcnt(0)" ::: "memory");
    {
        unsigned idv[16]; PV_IDS(0, idv);
#pragma unroll
        for (int i = 0; i < 16; ++i) PV_DMA(i, idv[i]);
    }
#pragma unroll 1
    for (int n = 0; n < ntok; ++n) {
        const int t = t0 + n * stride;
        const LDS_AS unsigned char* slot = ring + (n & 1) * 1024;
        const u32x4 xa0 = *(const LDS_AS u32x4*)(ard + (n & 1) * 1024), xa1 = *(const LDS_AS u32x4*)(ard + (n & 1) * 1024 + 16);
        const u32x4 hd4 = *(const LDS_AS u32x4*)(slot);
        const unsigned hd5 = *(const LDS_AS unsigned*)(slot + 16);
        const unsigned yw = *(const LDS_AS unsigned*)(slot + 768 + dl * 2);
        i64 xa[4];
        xa[0] = (i64)(((unsigned long long)xa0[1] << 32) | xa0[0]); xa[1] = (i64)(((unsigned long long)xa0[3] << 32) | xa0[2]);
        xa[2] = (i64)(((unsigned long long)xa1[1] << 32) | xa1[0]); xa[3] = (i64)(((unsigned long long)xa1[3] << 32) | xa1[2]);
        const float mu = __uint_as_float((hd4[0] & 0xffff0000u) | (hd4[1] >> 16)), rs = __uint_as_float((hd4[2] & 0xffff0000u) | (hd4[3] >> 16));
        const float isc = __uint_as_float(hd5 & 0xffff0000u);
        f32x4 acc[8];
#pragma unroll
        for (int ct = 0; ct < 8; ++ct) acc[ct] = (f32x4){0.f, 0.f, 0.f, 0.f};
        asm volatile("s_waitcnt vmcnt(16)" ::: "memory");
        unsigned idv[16]; PV_IDS(n + 1, idv);
        asm volatile("s_waitcnt lgkmcnt(0)" ::: "memory");
        PV_RING(n + 2);
#pragma unroll
        for (int ks = 0; ks < 4; ++ks) {
            asm volatile("s_waitcnt vmcnt(13)" ::: "memory");
            v2i32 bv[8];
#pragma unroll
            for (int ct = 0; ct < 8; ++ct) bv[ct] = __builtin_amdgcn_ds_read_tr8_b64_v2i32((LDS_AS v2i32*)(tb + ks * 4096 + ((ct ^ key) << 4)));
            asm volatile("s_waitcnt lgkmcnt(0)" ::: "memory");
#pragma unroll
            for (int i = 0; i < 4; ++i) PV_DMA(4 * ks + i, idv[4 * ks + i]);
#pragma unroll
            for (int ct = 0; ct < 8; ++ct)
                acc[ct] = __builtin_amdgcn_mfma_f32_16x16x32_fp8_fp8(xa[ks], (i64)(((unsigned long long)(unsigned)bv[ct][1] << 32) | (unsigned)bv[ct][0]), acc[ct], 0, 0, 0);
        }
        float va, vc;
        {
            const float w0 = acc[0][0] + acc[0][1], w1 = acc[1][0] + acc[1][1], w2 = acc[2][0] + acc[2][1], w3 = acc[3][0] + acc[3][1];
            const float w4 = acc[4][0] + acc[4][1], w5 = acc[5][0] + acc[5][1], w6 = acc[6][0] + acc[6][1], w7 = acc[7][0] + acc[7][1];
            va = kb == 0 ? w0 : (kb == 1 ? w2 : (kb == 2 ? w4 : w6));
            vc = kb == 0 ? w1 : (kb == 1 ? w3 : (kb == 2 ? w5 : w7));
        }
        const bool od = (j & 1) != 0;
        const float got = __shfl_xor(od ? va : vc, 1);
        const float p0 = (od ? got : va) * isc, p1 = (od ? vc : got) * isc;
        const float r0 = ALPHA * ((bflo(yw) - mu) * rs * g2.x + b2.x) + p0, r1 = ALPHA * ((bfhi(yw) - mu) * rs * g2.y + b2.y) + p1;
        *(unsigned*)(p.rb + (size_t)t * DM + d0) = pack2(r0, r1);
    }
    asm volatile("s_waitcnt vmcnt(0)" ::: "memory");
}

__device__ void ph_gemm_ple(const Params& p, unsigned char* smem, const int vb) {
    const int ntn = DM / 128;
    const int tid = threadIdx.x, lane = tid & 63, wid = tid >> 6, wr = wid >> 1, wc = wid & 1, fr = lane & 15, fq = lane >> 4;
    const int ntiles = (T_TOK / 128) * ntn;
    bool pre = false;
    for (int t = vb; t < ntiles; t += gridDim.x) {
        const int m0 = (t / ntn) * 128, n0 = (t % ntn) * 128;
        const int tn = t + gridDim.x;
        const bool has_next = tn < ntiles;
        const bf16_t* nA = p.pb + (size_t)((has_next ? tn : t) / ntn) * 128 * 256;
        const bf16_t* nB = p.WpT + (size_t)((has_next ? tn : t) % ntn) * 128 * 256;
        const bf16_t* gA = p.rb + (size_t)m0 * DM; const bf16_t* gB = p.WgT + (size_t)n0 * DM;
        f32x4 acc[4][4], acc2[4][4]; zero_acc(acc); zero_acc(acc2);
        if (pre) gemm128<true, true>(p.pb + (size_t)m0 * 256, 256, p.WpT + (size_t)n0 * 256, 256, 256, smem, acc2, gA, DM, gB, DM);
        else     gemm128<false, true>(p.pb + (size_t)m0 * 256, 256, p.WpT + (size_t)n0 * 256, 256, 256, smem, acc2, gA, DM, gB, DM);
        if (has_next) gemm128<true, true>(gA, DM, gB, DM, DM, smem, acc, nA, 256, nB, 256);
        else          gemm128<true, false>(gA, DM, gB, DM, DM, smem, acc);
        pre = has_next;
#pragma unroll
        for (int mi = 0; mi < 4; ++mi) {
            const int row = m0 + wr * 64 + mi * 16 + fr;
#pragma unroll
            for (int ni = 0; ni < 4; ++ni) {
                const int col = n0 + wc * 64 + ni * 16 + fq * 4;
                const u32x2 rw = *(const u32x2*)(p.rb + (size_t)row * DM + col);
                f32x4 rv = {bflo(rw[0]), bfhi(rw[0]), bflo(rw[1]), bfhi(rw[1])};
#pragma unroll
                for (int r = 0; r < 4; ++r) rv[r] += sigmul(acc2[mi][ni][r], acc[mi][ni][r]);
                *(f32x4*)(p.out + (size_t)row * DM + col) = rv;
            }
        }
    }
}

#define XB_TMO      128
#define XB_XCNT(j)  (256  + 64 * (j))
#define XB_XSUB(j)  (1280 + 64 * (j))
#define XB_XGEN(j)  (2304 + 64 * (j))
#define XB_TOP      3328
#define XB_TOPGEN   3392
#define XCD_BAR_WORDS 3456
#define XB_SPIN_CAP (1u << 20)
__device__ __forceinline__ unsigned xb_ld(unsigned* p)              { return __hip_atomic_load(p, __ATOMIC_RELAXED, __HIP_MEMORY_SCOPE_AGENT); }
__device__ __forceinline__ unsigned xb_add(unsigned* p, unsigned v) { return __hip_atomic_fetch_add(p, v, __ATOMIC_RELAXED, __HIP_MEMORY_SCOPE_AGENT); }
__device__ __forceinline__ unsigned xb_xcc_id() { return (unsigned)__builtin_amdgcn_s_getreg((3 << 11) | 20) & 0xFu; }
#define XB_SPIN(cond, bar) do { unsigned _sp = 0; while (cond) { __builtin_amdgcn_s_sleep(1); \
    if ((++_sp & 255u) == 0u) { if (xb_ld(&(bar)[XB_TMO])) break; if (_sp > XB_SPIN_CAP) { atomicAdd(&(bar)[XB_TMO], 1u); break; } } } } while (0)
struct XcdBarrier { unsigned* bar; unsigned x; volatile LDS_AS unsigned* st; };
__device__ __forceinline__ XcdBarrier xcd_barrier_post(unsigned* bar, volatile LDS_AS unsigned* st) {
    XcdBarrier b; b.bar = bar; b.x = xb_xcc_id(); b.st = st;
    if (threadIdx.x == 0) st[3] = xb_add(&bar[XB_XCNT(b.x)], 1u);
    return b;
}
__device__ __forceinline__ void xcd_barrier_complete(unsigned* bar, unsigned x, unsigned rank, unsigned& nloc, unsigned& nx, unsigned& vb) {
    const unsigned G = gridDim.x;
    unsigned sum, cnt, mine, sp = 0u; bool even;
    for (;;) {
        sum = 0u; cnt = 0u; mine = 0u; even = true;
#pragma unroll
        for (unsigned j = 0; j < 16; ++j) {
            const unsigned c = xb_ld(&bar[XB_XCNT(j)]); sum += c; cnt += (c > 0u) ? 1u : 0u; mine = (j == x) ? c : mine;
            even = even && (c == ((j < 8u) ? (G >> 3) : 0u));
        }
        if (sum == G) break;
        __builtin_amdgcn_s_sleep(1);
        if ((++sp & 255u) == 0u) { if (xb_ld(&bar[XB_TMO])) break; if (sp > XB_SPIN_CAP) { atomicAdd(&bar[XB_TMO], 1u); break; } }
    }
    nloc = mine > 0u ? mine : 1u; nx = cnt > 0u ? cnt : 1u;
    vb = (even && sum == G && (G & 7u) == 0u) ? (x * (G >> 3) + rank) : blockIdx.x;
}
__device__ __forceinline__ void xcd_barrier(const XcdBarrier& b) {
    asm volatile("s_waitcnt vmcnt(0)" ::: "memory");
    __syncthreads();
    if (threadIdx.x == 0) {
        unsigned* bar = b.bar;
        __builtin_amdgcn_s_waitcnt(0);
        unsigned nloc = b.st[0], nx = b.st[1];
        if (nloc == 0u) { unsigned vb; xcd_barrier_complete(bar, b.x, b.st[3], nloc, nx, vb); b.st[0] = nloc; b.st[1] = nx; b.st[2] = vb; }
        const unsigned old = xb_add(&bar[XB_XSUB(b.x)], 1u);
        const unsigned gen = old / nloc;
        if (old + 1u == (gen + 1u) * nloc) {
            __builtin_amdgcn_fence(__ATOMIC_RELEASE, "agent");
            asm volatile("s_waitcnt vmcnt(0)" ::: "memory");
            const unsigned og = xb_add(&bar[XB_TOP], 1u);
            const unsigned tg = og / nx;
            if (og + 1u == (tg + 1u) * nx) xb_add(&bar[XB_TOPGEN], 1u);
            else XB_SPIN(xb_ld(&bar[XB_TOPGEN]) == tg, bar);
            __builtin_amdgcn_fence(__ATOMIC_ACQUIRE, "agent");
            xb_add(&bar[XB_XGEN(b.x)], 1u);
            asm volatile("s_waitcnt vmcnt(0)" ::: "memory");
        } else {
            XB_SPIN(xb_ld(&bar[XB_XGEN(b.x)]) == gen, bar);
            __builtin_amdgcn_fence(__ATOMIC_ACQUIRE, "agent");
            asm volatile("s_waitcnt vmcnt(0)" ::: "memory");
        }
    }
    __syncthreads();
}

#define SMEM_PHASE (256 * ASTR * 2 * 2)
#define SMEM_BYTES (SMEM_PHASE + 16)
__global__ void __launch_bounds__(256, 2) mega(Params p) {
    __shared__ __attribute__((aligned(16))) unsigned char smem[SMEM_BYTES];
    volatile LDS_AS unsigned* st = (volatile LDS_AS unsigned*)(LDS_AS unsigned char*)(smem + SMEM_PHASE);
    if (threadIdx.x < 4) st[threadIdx.x] = 0u;
    __syncthreads();
    const XcdBarrier gb = xcd_barrier_post(p.bar, st);
    ph_prep(p, smem);            xcd_barrier(gb);
    const int vb = (int)st[2];
    ph_gemm_in(p, smem, vb);     xcd_barrier(gb);
    ph_attn(p, smem, vb);
    ph_conv(p, smem, vb);        xcd_barrier(gb);
    ph_mprep(p, smem, vb);
    ph_gemm_out(p, smem, vb);    xcd_barrier(gb);
    ph_route(p, smem, vb);       xcd_barrier(gb);
    ph_peer_u(p, smem, vb);      xcd_barrier(gb);
    ph_peer_act(p, smem, vb);    xcd_barrier(gb);
    ph_peer_v(p, smem, vb);      xcd_barrier(gb);
    ph_gemm_ple(p, smem, vb);    xcd_barrier(gb);
    ph_ln2(p, vb);
}

extern "C" void kernel_launch(void* const* d_in, const int* in_sizes, int n_in, void* d_out, int out_size, void* d_ws, size_t ws_size,
                              hipStream_t stream) {
    Params p{};
    p.x = (const float*)d_in[0]; p.p = (const float*)d_in[1]; p.pos = (const int*)d_in[2];
    p.w_in = (const float*)d_in[3]; p.sinks = (const float*)d_in[4]; p.conv_w = (const float*)d_in[5]; p.conv_b = (const float*)d_in[6];
    p.cln_g = (const float*)d_in[7]; p.cln_b = (const float*)d_in[8]; p.w_out = (const float*)d_in[9]; p.ln1_g = (const float*)d_in[10];
    p.ln1_b = (const float*)d_in[11]; p.wq = (const float*)d_in[12]; p.keys = (const float*)d_in[13]; p.pu = (const float*)d_in[14];
    p.pv = (const float*)d_in[15]; p.ple_proj = (const float*)d_in[16]; p.ple_gate = (const float*)d_in[17]; p.ln2_g = (const float*)d_in[18];
    p.ln2_b = (const float*)d_in[19];
    p.out = (float*)d_out;
    unsigned char* ws = (unsigned char*)d_ws;
    const size_t MiB = 1024 * 1024;
    p.y1 = (float*)(ws + 0 * MiB);
    p.hb = (bf16_t*)(ws + 128 * MiB);
    p.hp = (bf16_t*)(ws + 128 * MiB);
    p.xb = (bf16_t*)(ws + 256 * MiB);
    p.mixb = (bf16_t*)(ws + 320 * MiB);
    p.rb = (bf16_t*)(ws + 320 * MiB);
    p.pb = (bf16_t*)(ws + 384 * MiB);
    p.u8 = (unsigned char*)(ws + 400 * MiB);
    p.v8 = (unsigned char*)(ws + 416 * MiB);
    p.sc2 = (bf16_t*)(ws + 432 * MiB);
    p.rope = (float*)(ws + 434 * MiB);
    p.stats = (float*)(ws + 436 * MiB);
    p.cb2 = (unsigned*)(ws + 438 * MiB);
    p.mext = (bf16_t*)(ws + 440 * MiB);
    p.yext = (bf16_t*)(ws + 442 * MiB);
    p.y1b = (bf16_t*)(ws + 0 * MiB);
    p.ids = (int*)(ws + 464 * MiB);
    p.gates = (float*)(ws + 480 * MiB);
    unsigned char* wb = ws + 496 * MiB;
    p.WinT = (bf16_t*)wb; wb += (size_t)INW * DM * 2;
    p.WoutT = (bf16_t*)wb; wb += (size_t)DM * DM * 2;
    p.WgT = (bf16_t*)wb; wb += (size_t)DM * DM * 2;
    p.WpT = (bf16_t*)wb; wb += (size_t)DM * 256 * 2;
    p.keysb = (bf16_t*)wb; wb += (size_t)16 * 128 * 128 * 2;
    p.Wqb = (bf16_t*)(ws + 240 * MiB);
    p.MT = (bf16_t*)(ws + 244 * MiB);
    p.bar = (unsigned*)(ws + 510 * MiB);
    p.wgb = (float*)(p.bar + XCD_BAR_WORDS + 640);

    static int grid_blocks = 0;
    if (!grid_blocks) {
        int dev = 0, cus = 0, per_cu = 0;
        (void)hipGetDevice(&dev);
        (void)hipDeviceGetAttribute(&cus, hipDeviceAttributeMultiprocessorCount, dev);
        (void)hipOccupancyMaxActiveBlocksPerMultiprocessor(&per_cu, mega, 256, 0);
        if (per_cu > 2) per_cu = 2;
        grid_blocks = cus * per_cu;
    }
    (void)hipMemsetAsync(p.bar, 0, (XCD_BAR_WORDS + 640 + 4096) * sizeof(unsigned), stream);
    void* args[] = {&p};
    hipError_t e = hipLaunchCooperativeKernel((void*)mega, dim3(grid_blocks), dim3(256), args, 0, stream);
    if (e != hipSuccess) fprintf(stderr, "cooperative launch failed: %s (grid %d)\n", hipGetErrorString(e), grid_blocks);
}
```

```cpp
#include <hip/hip_runtime.h>
#include <stdint.h>
#include <cstdio>

typedef unsigned short bf16_t;
typedef short bf16x8 __attribute__((ext_vector_type(8)));
typedef float f32x4 __attribute__((ext_vector_type(4)));
typedef unsigned u32x4 __attribute__((ext_vector_type(4)));
typedef float f32x2 __attribute__((ext_vector_type(2)));
typedef long i64;

#define T_TOK 32768
#define SEQ 2048
#define DM 1024
#define INW 1792
#define ALPHA 1.189207115002721f
#define LN_EPS 1e-5f

__device__ __forceinline__ bf16_t f2bf(float f) {
    unsigned u = __float_as_uint(f);
    u += 0x7fffu + ((u >> 16) & 1u);
    return (bf16_t)(u >> 16);
}
__device__ __forceinline__ float bf2f(bf16_t b) { return __uint_as_float(((unsigned)b) << 16); }
__device__ __forceinline__ float bflo(unsigned w) { return __uint_as_float(w << 16); }
__device__ __forceinline__ float bfhi(unsigned w) { return __uint_as_float(w & 0xffff0000u); }
__device__ __forceinline__ unsigned pack2(float a, float b) { return (unsigned)f2bf(a) | ((unsigned)f2bf(b) << 16); }

__device__ __forceinline__ float sigmul(float x, float g) { return x * __builtin_amdgcn_rcpf(1.0f + __expf(-g)); }
__device__ __forceinline__ float wave_sum(float v) {
#pragma unroll
    for (int o = 32; o >= 1; o >>= 1) v += __shfl_xor(v, o);
    return v;
}

struct Params {
    const float *x, *p; const int* pos;
    const float *w_in, *sinks, *conv_w, *conv_b, *cln_g, *cln_b, *w_out, *ln1_g, *ln1_b;
    const float *wq, *keys, *pu, *pv, *ple_proj, *ple_gate, *ln2_g, *ln2_b;
    float* out;
    bf16_t *xb, *pb, *WinT, *WoutT, *WgT, *WpT, *keysb, *Wqb, *MT, *hb, *mixb, *rb;
    float *y1, *gates, *rope, *stats, *wgb;
    bf16_t *y1b, *yext, *mext; unsigned* cb2;
    bf16_t* sc2;
    bf16_t* hp;
    int *ids;
    unsigned char *u8, *v8;
    unsigned* bar;
};

__device__ void cvt_rows(const float* __restrict__ src, bf16_t* __restrict__ dst, size_t n) {
    const size_t nv = n / 8, gs = (size_t)gridDim.x * blockDim.x;
    for (size_t i = (size_t)blockIdx.x * blockDim.x + threadIdx.x; i < nv; i += 4 * gs) {
        f32x4 a[4], b[4];
#pragma unroll
        for (int q = 0; q < 4; ++q) { const size_t k = (i + q * gs < nv) ? i + q * gs : i; a[q] = ((const f32x4*)src)[2 * k]; b[q] = ((const f32x4*)src)[2 * k + 1]; }
#pragma unroll
        for (int q = 0; q < 4; ++q) {
            if (i + q * gs < nv) {
                u32x4 o; o[0] = pack2(a[q][0], a[q][1]); o[1] = pack2(a[q][2], a[q][3]); o[2] = pack2(b[q][0], b[q][1]); o[3] = pack2(b[q][2], b[q][3]);
                ((u32x4*)dst)[i + q * gs] = o;
            }
        }
    }
}
__device__ __forceinline__ int win_row(int n) {
    if (n < 768) return n;
    const int isg = n >= 1280 ? 1 : 0, c = n - (isg ? 1280 : 768);
    const int tt = c >> 6, wc = (c >> 5) & 1, k2 = (c >> 4) & 1, rest = c & 15;
    return 768 + 128 * tt + wc * 64 + (k2 * 2 + isg) * 16 + rest;
}
template <bool WIN = false>
__device__ void transpose_cvt(const float* __restrict__ W, bf16_t* __restrict__ Wt, int K, int N, float* tile  ) {
    const int tk = K / 64, tn = N / 64;
    const int tid = threadIdx.x;
    for (int t = blockIdx.x; t < tk * tn; t += gridDim.x) {
        const int k0 = (t / tn) * 64, n0 = (t % tn) * 64;
        f32x4 v[4];
#pragma unroll
        for (int i = 0; i < 4; ++i) v[i] = *(const f32x4*)(W + (size_t)(k0 + (tid >> 4) + 16 * i) * N + n0 + (tid & 15) * 4);
        __syncthreads();
#pragma unroll
        for (int i = 0; i < 4; ++i)
#pragma unroll
            for (int j = 0; j < 4; ++j) tile[((tid >> 4) + 16 * i) * 65 + (tid & 15) * 4 + j] = v[i][j];
        __syncthreads();
        const int n = tid >> 2, kc = (tid & 3) * 16;
        u32x4 o0, o1;
#pragma unroll
        for (int q = 0; q < 4; ++q) {
            o0[q] = pack2(tile[(kc + 2 * q) * 65 + n], tile[(kc + 2 * q + 1) * 65 + n]);
            o1[q] = pack2(tile[(kc + 8 + 2 * q) * 65 + n], tile[(kc + 8 + 2 * q + 1) * 65 + n]);
        }
        const int nd = WIN ? win_row(n0 + n) : n0 + n;
        *(u32x4*)(Wt + (size_t)nd * K + k0 + kc) = o0;
        *(u32x4*)(Wt + (size_t)nd * K + k0 + kc + 8) = o1;
    }
}
__device__ void cvt_wq_fold(const Params& p, unsigned char* smem) {
    for (int i = blockIdx.x * 256 + threadIdx.x; i < DM * 256; i += gridDim.x * 256) {
        const int d = i >> 8, c8 = (i & 255) * 8;
        const float gd = p.ln1_g[d];
        const f32x4 a = *(const f32x4*)(p.wq + (size_t)d * 2048 + c8), b = *(const f32x4*)(p.wq + (size_t)d * 2048 + c8 + 4);
        u32x4 o; o[0] = pack2(a[0] * gd, a[1] * gd); o[1] = pack2(a[2] * gd, a[3] * gd); o[2] = pack2(b[0] * gd, b[1] * gd); o[3] = pack2(b[2] * gd, b[3] * gd);
        *(u32x4*)(p.Wqb + (size_t)d * 2048 + c8) = o;
    }
    float* red = (float*)smem;
    const int lane = threadIdx.x & 63, wid = threadIdx.x >> 6;
    for (int cb = blockIdx.x; cb < 512; cb += gridDim.x) {
        f32x4 sg = {0.f, 0.f, 0.f, 0.f}, sb = {0.f, 0.f, 0.f, 0.f};
#pragma unroll
        for (int q = 0; q < 4; ++q) {
            const int d = threadIdx.x * 4 + q;
            const f32x4 v = *(const f32x4*)(p.wq + (size_t)d * 2048 + cb * 4);
            sg += v * p.ln1_g[d]; sb += v * p.ln1_b[d];
        }
        __syncthreads();
#pragma unroll
        for (int q = 0; q < 4; ++q) {
            const float a = wave_sum(sg[q]), b = wave_sum(sb[q]);
            if (lane == 0) { red[wid * 8 + q] = a; red[wid * 8 + 4 + q] = b; }
        }
        __syncthreads();
        if (threadIdx.x < 8) {
            const float t = (red[threadIdx.x] + red[8 + threadIdx.x]) + (red[16 + threadIdx.x] + red[24 + threadIdx.x]);
            p.wgb[(threadIdx.x >> 2) * 2048 + cb * 4 + (threadIdx.x & 3)] = t;
        }
    }
}
template <bool FOLD>
__device__ void cvt_table_fp8(const Params& p, const float* __restrict__ src, unsigned char* __restrict__ dst, bf16_t* __restrict__ scl, int rows) {
    const int lane = threadIdx.x & 63, wid = threadIdx.x >> 6;
    const int nw = gridDim.x * 4;
    for (int r0 = blockIdx.x * 4 + wid; r0 < rows; r0 += 4 * nw) {
        f32x4 v[4][4];
#pragma unroll
        for (int q = 0; q < 4; ++q) {
            const int r = (r0 + q * nw < rows) ? r0 + q * nw : r0;
            const float* sr = src + (size_t)r * DM + lane * 16;
#pragma unroll
            for (int k = 0; k < 4; ++k) v[q][k] = *(const f32x4*)(sr + 4 * k);
        }
        f32x4 gv[4], bv[4];
        if (FOLD) {
#pragma unroll
            for (int k = 0; k < 4; ++k) { gv[k] = *(const f32x4*)(p.ln1_g + lane * 16 + 4 * k); bv[k] = *(const f32x4*)(p.ln1_b + lane * 16 + 4 * k); }
        }
#pragma unroll
        for (int q = 0; q < 4; ++q) {
            const int r = r0 + q * nw;
            if (FOLD) {
                float cu = 0.f, bu = 0.f;
#pragma unroll
                for (int k = 0; k < 4; ++k) { bu += (bv[k][0] * v[q][k][0] + bv[k][1] * v[q][k][1]) + (bv[k][2] * v[q][k][2] + bv[k][3] * v[q][k][3]); v[q][k] = v[q][k] * gv[k]; cu += (v[q][k][0] + v[q][k][1]) + (v[q][k][2] + v[q][k][3]); }
                cu = wave_sum(cu); bu = wave_sum(bu);
                if (lane == 0 && r < rows) p.cb2[r] = pack2(cu, bu);
            }
            float m = 0.f;
#pragma unroll
            for (int k = 0; k < 4; ++k)
#pragma unroll
                for (int i = 0; i < 4; ++i) m = fmaxf(m, fabsf(v[q][k][i]));
#pragma unroll
            for (int o = 32; o >= 1; o >>= 1) m = fmaxf(m, __shfl_xor(m, o));
            int ex = (m > 0.f) ? (8 - (int)((__float_as_uint(m) >> 23) & 0xffu) + 127 - ((__float_as_uint(m) & 0x7fffffu) > 0x600000u ? 1 : 0)) : 0;
            ex = min(max(ex, -100), 100);
            const float sc = __uint_as_float((unsigned)(127 + ex) << 23);
            u32x4 w;
#pragma unroll
            for (int k = 0; k < 4; ++k)
                w[k] = __builtin_amdgcn_cvt_pk_fp8_f32(v[q][k][2] * sc, v[q][k][3] * sc, __builtin_amdgcn_cvt_pk_fp8_f32(v[q][k][0] * sc, v[q][k][1] * sc, 0, false), true);
            if (r < rows) {
                *(u32x4*)(dst + (size_t)(lane >> 3) * (16384 * 128) + (size_t)r * 128 + (lane & 7) * 16) = w;
                if (lane == 0) scl[2 * r] = (bf16_t)(((unsigned)(127 - ex) << 23) >> 16);
            }
        }
    }
}
__device__ void ph_prep(const Params& p, unsigned char* smem) {
    float* tile = (float*)smem;
    cvt_rows(p.x, p.xb, (size_t)T_TOK * DM);
    cvt_rows(p.p, p.pb, (size_t)T_TOK * 256);
    cvt_table_fp8<true>(p, p.pu, p.u8, p.sc2, 16384);
    cvt_table_fp8<false>(p, p.pv, p.v8, p.sc2 + 1, 16384);
    cvt_rows(p.keys, p.keysb, (size_t)16 * 128 * 128);
    for (int i = blockIdx.x * 256 + threadIdx.x; i < T_TOK * 8; i += gridDim.x * 256) {
        const int t = i >> 3, j = i & 7;
        const float inv = powf(500000.0f, -(float)j * 0.125f);
        float sn, cs; sincosf((float)p.pos[t] * inv, &sn, &cs);
        p.rope[t * 16 + j] = cs; p.rope[t * 16 + 8 + j] = sn;
    }
    transpose_cvt<true>(p.w_in, p.WinT, DM, INW, tile);
    transpose_cvt(p.w_out, p.WoutT, DM, DM, tile);
    cvt_wq_fold(p, smem);
    transpose_cvt(p.ple_gate, p.WgT, DM, DM, tile);
    transpose_cvt(p.ple_proj, p.WpT, 256, DM, tile);
}

#define LDS_AS __attribute__((address_space(3)))
#define GEMM_STAGE 32768
template <bool PRE = false, bool NEXT = false>
__device__ __forceinline__ void gemm128(const bf16_t* __restrict__ A, int lda, const bf16_t* __restrict__ Bt, int ldb, int K,
                                        unsigned char* smem, f32x4 (&acc)[4][4],
                                        const bf16_t* __restrict__ nA = nullptr, int nlda = 0, const bf16_t* __restrict__ nB = nullptr, int nldb = 0) {
    LDS_AS unsigned char* lds = (LDS_AS unsigned char*)smem;
    const int tid = threadIdx.x, lane = tid & 63, wid = __builtin_amdgcn_readfirstlane(tid >> 6);
    const int wr = wid >> 1, wc = wid & 1, fr = lane & 15, fq = lane >> 4;
    const int nk = K / 64;
    const int prow = lane >> 3, pc = (lane & 7) ^ prow;
    const bf16_t* gA = A + (size_t)(wid * 32 + prow) * lda + pc * 8;
    const bf16_t* gB = Bt + (size_t)(wid * 32 + prow) * ldb + pc * 8;
    const size_t a8 = (size_t)8 * lda, b8 = (size_t)8 * ldb;
#define GEMM_ISSUE(kt, st) do { \
        _Pragma("unroll") for (int _i = 0; _i < 4; ++_i) { \
            __builtin_amdgcn_global_load_lds((const unsigned*)(gA + _i * a8 + (size_t)(kt) * 64), (LDS_AS unsigned*)(lds + (st) * GEMM_STAGE + (wid * 4 + _i) * 1024), 16, 0, 0); \
            __builtin_amdgcn_global_load_lds((const unsigned*)(gB + _i * b8 + (size_t)(kt) * 64), (LDS_AS unsigned*)(lds + (st) * GEMM_STAGE + 16384 + (wid * 4 + _i) * 1024), 16, 0, 0); \
        } } while (0)
    const int swz0 = ((0 * 4 + fq) ^ (fr & 7)) * 16, swz1 = ((1 * 4 + fq) ^ (fr & 7)) * 16;
    const int aoff = (wr * 64 + fr) * 128, boff = 16384 + (wc * 64 + fr) * 128;
    if (!PRE) GEMM_ISSUE(0, 0);
#pragma unroll 1
    for (int kt = 0; kt < nk; ++kt) {
        const int st = kt & 1;
        asm volatile("s_waitcnt vmcnt(0)" ::: "memory");
        __builtin_amdgcn_s_barrier();
        asm volatile("" ::: "memory");
        if (kt + 1 < nk) GEMM_ISSUE(kt + 1, st ^ 1);
        else if (NEXT) {
            const bf16_t* qA = nA + (size_t)(wid * 32 + prow) * nlda + pc * 8;
            const bf16_t* qB = nB + (size_t)(wid * 32 + prow) * nldb + pc * 8;
#pragma unroll
            for (int _i = 0; _i < 4; ++_i) {
                __builtin_amdgcn_global_load_lds((const unsigned*)(qA + (size_t)(_i * 8) * nlda), (LDS_AS unsigned*)(lds + (wid * 4 + _i) * 1024), 16, 0, 0);
                __builtin_amdgcn_global_load_lds((const unsigned*)(qB + (size_t)(_i * 8) * nldb), (LDS_AS unsigned*)(lds + 16384 + (wid * 4 + _i) * 1024), 16, 0, 0);
            }
        }
        const LDS_AS unsigned char* sb = lds + st * GEMM_STAGE;
        bf16x8 af0[4], bf0[4], af1[4], bf1[4];
#pragma unroll
        for (int mi = 0; mi < 4; ++mi) af0[mi] = *(const LDS_AS bf16x8*)(sb + aoff + mi * 2048 + swz0);
#pragma unroll
        for (int ni = 0; ni < 4; ++ni) bf0[ni] = *(const LDS_AS bf16x8*)(sb + boff + ni * 2048 + swz0);
#pragma unroll
        for (int mi = 0; mi < 4; ++mi) af1[mi] = *(const LDS_AS bf16x8*)(sb + aoff + mi * 2048 + swz1);
#pragma unroll
        for (int ni = 0; ni < 4; ++ni) bf1[ni] = *(const LDS_AS bf16x8*)(sb + boff + ni * 2048 + swz1);
#pragma unroll
        for (int mi = 0; mi < 4; ++mi)
#pragma unroll
            for (int ni = 0; ni < 4; ++ni)
                acc[mi][ni] = __builtin_amdgcn_mfma_f32_16x16x32_bf16(bf0[ni], af0[mi], acc[mi][ni], 0, 0, 0);
#pragma unroll
        for (int mi = 0; mi < 4; ++mi)
#pragma unroll
            for (int ni = 0; ni < 4; ++ni)
                acc[mi][ni] = __builtin_amdgcn_mfma_f32_16x16x32_bf16(bf1[ni], af1[mi], acc[mi][ni], 0, 0, 0);
        __builtin_amdgcn_sched_group_barrier(0x100, 8, 0);
#pragma unroll
        for (int q = 0; q < 8; ++q) { __builtin_amdgcn_sched_group_barrier(0x008, 2, 0); __builtin_amdgcn_sched_group_barrier(0x100, 1, 0); }
        __builtin_amdgcn_sched_group_barrier(0x008, 16, 0);
        asm volatile("s_waitcnt lgkmcnt(0)" ::: "memory");
        __builtin_amdgcn_s_barrier();
        asm volatile("" ::: "memory");
    }
#undef GEMM_ISSUE
}
#define GW_STAGE 24576
__device__ __forceinline__ void gemmW(const bf16_t* __restrict__ A, int lda, const bf16_t* __restrict__ Bt, int ldb, int K,
                                      unsigned char* smem, f32x4 (&acc)[4][8]) {
    LDS_AS unsigned char* lds = (LDS_AS unsigned char*)smem;
    const int tid = threadIdx.x, lane = tid & 63, wid = __builtin_amdgcn_readfirstlane(tid >> 6);
    const int wr = wid >> 1, wc = wid & 1, fr = lane & 15, fq = lane >> 4;
    const int nk = K / 32;
    const int prow = lane >> 2, pc = (lane & 3) ^ ((4 - ((prow >> 2) & 3)) & 3);
    const bf16_t* gA = A + (size_t)(wid * 32 + prow) * lda + pc * 8;
    const bf16_t* gB = Bt + (size_t)(wid * 64 + prow) * ldb + pc * 8;
    const size_t a16 = (size_t)16 * lda, b16 = (size_t)16 * ldb;
#define GW_ISSUE(kt, st) do { \
        _Pragma("unroll") for (int _i = 0; _i < 2; ++_i) \
            __builtin_amdgcn_global_load_lds((const unsigned*)(gA + _i * a16 + (size_t)(kt) * 32), (LDS_AS unsigned*)(lds + (st) * GW_STAGE + (wid * 2 + _i) * 1024), 16, 0, 0); \
        _Pragma("unroll") for (int _i = 0; _i < 4; ++_i) \
            __builtin_amdgcn_global_load_lds((const unsigned*)(gB + _i * b16 + (size_t)(kt) * 32), (LDS_AS unsigned*)(lds + (st) * GW_STAGE + 8192 + (wid * 4 + _i) * 1024), 16, 0, 0); \
        } while (0)
    const int swz = (fq ^ ((4 - ((fr >> 2) & 3)) & 3)) * 16;
    const int aoff = (wr * 64 + fr) * 64 + swz, boff = 8192 + (wc * 128 + fr) * 64 + swz;
    GW_ISSUE(0, 0);
#pragma unroll 1
    for (int kt = 0; kt < nk; ++kt) {
        const int st = kt & 1;
        asm volatile("s_waitcnt vmcnt(0)" ::: "memory");
        __builtin_amdgcn_s_barrier();
        asm volatile("" ::: "memory");
        if (kt + 1 < nk) GW_ISSUE(kt + 1, st ^ 1);
        const LDS_AS unsigned char* sb = lds + st * GW_STAGE;
        bf16x8 af[4], bfr[8];
#pragma unroll
        for (int mi = 0; mi < 4; ++mi) af[mi] = *(const LDS_AS bf16x8*)(sb + aoff + mi * 1024);
#pragma unroll
        for (int ni = 0; ni < 8; ++ni) bfr[ni] = *(const LDS_AS bf16x8*)(sb + boff + ni * 1024);
#pragma unroll
        for (int ni = 0; ni < 8; ++ni)
#pragma unroll
            for (int mi = 0; mi < 4; ++mi)
                acc[mi][ni] = __builtin_amdgcn_mfma_f32_16x16x32_bf16(bfr[ni], af[mi], acc[mi][ni], 0, 0, 0);
        asm volatile("s_waitcnt lgkmcnt(0)" ::: "memory");
        __builtin_amdgcn_s_barrier();
        asm volatile("" ::: "memory");
    }
#undef GW_ISSUE
}
__device__ __forceinline__ void zero_accw(f32x4 (&acc)[4][8]) {
#pragma unroll
    for (int a = 0; a < 4; ++a)
#pragma unroll
        for (int b = 0; b < 8; ++b) acc[a][b] = (f32x4){0.f, 0.f, 0.f, 0.f};
}
__device__ __forceinline__ void zero_acc(f32x4 (&acc)[4][4]) {
#pragma unroll
    for (int a = 0; a < 4; ++a)
#pragma unroll
        for (int b = 0; b < 4; ++b) acc[a][b] = (f32x4){0.f, 0.f, 0.f, 0.f};
}
#define GEMM_SMEM (2 * GEMM_STAGE)

__device__ void ph_gemm_in(const Params& p, unsigned char* smem, const int vb) {
    const int ntn = INW / 128;
    const int tid = threadIdx.x, lane = tid & 63, wid = tid >> 6, wr = wid >> 1, wc = wid & 1, fr = lane & 15, fq = lane >> 4;
    const int ntiles = (T_TOK / 128) * ntn;
    bool pre = false;
    for (int t = vb; t < ntiles; t += gridDim.x) {
        const int m0 = (t / ntn) * 128, n0 = (t % ntn) * 128;
        const int tn = t + gridDim.x;
        const bool has_next = tn < ntiles;
        const bf16_t* nA = p.xb + (size_t)((has_next ? tn : t) / ntn) * 128 * DM;
        const bf16_t* nB = p.WinT + (size_t)((has_next ? tn : t) % ntn) * 128 * DM;
        f32x4 acc[4][4]; zero_acc(acc);
        if (pre) { if (has_next) gemm128<true, true>(p.xb + (size_t)m0 * DM, DM, p.WinT + (size_t)n0 * DM, DM, DM, smem, acc, nA, DM, nB, DM);
                   else          gemm128<true, false>(p.xb + (size_t)m0 * DM, DM, p.WinT + (size_t)n0 * DM, DM, DM, smem, acc); }
        else     { if (has_next) gemm128<false, true>(p.xb + (size_t)m0 * DM, DM, p.WinT + (size_t)n0 * DM, DM, DM, smem, acc, nA, DM, nB, DM);
                   else          gemm128<false, false>(p.xb + (size_t)m0 * DM, DM, p.WinT + (size_t)n0 * DM, DM, DM, smem, acc); }
        pre = has_next;
        if (n0 >= 768) {
            const int cb = ((n0 - 768) >> 7) * 64 + wc * 32 + fq * 4;
#pragma unroll
            for (int mi = 0; mi < 4; ++mi) {
                const int row = m0 + wr * 64 + mi * 16 + fr;
#pragma unroll
                for (int k2 = 0; k2 < 2; ++k2) {
                    const f32x4 a = acc[mi][2 * k2], gt = acc[mi][2 * k2 + 1];
                    uint2 o; o.x = pack2(sigmul(a[0], gt[0]), sigmul(a[1], gt[1])); o.y = pack2(sigmul(a[2], gt[2]), sigmul(a[3], gt[3]));
                    *(uint2*)(p.hb + (size_t)row * INW + 768 + cb + k2 * 16) = o;
                }
            }
        } else {
#pragma unroll
        for (int mi = 0; mi < 4; ++mi) {
            const int row = m0 + wr * 64 + mi * 16 + fr;
#pragma unroll
            for (int ni = 0; ni < 4; ++ni) {
                const int col0 = n0 + wc * 64 + ni * 16;
                f32x4 v = acc[mi][ni];
                if (col0 < 640 && (col0 & 63) == 0) {
                    const f32x4 cs = *(const f32x4*)(p.rope + (size_t)row * 16 + (fq & 1) * 4), sn = *(const f32x4*)(p.rope + (size_t)row * 16 + 8 + (fq & 1) * 4);
#pragma unroll
                    for (int r = 0; r < 4; ++r) {
                        const float other = __shfl_xor(v[r], 32);
                        v[r] = (fq < 2) ? (v[r] * cs[r] - other * sn[r]) : (v[r] * cs[r] + other * sn[r]);
                    }
                }
                uint2 o; o.x = pack2(v[0], v[1]); o.y = pack2(v[2], v[3]);
                *(uint2*)(p.hb + (size_t)row * INW + col0 + fq * 4) = o;
            }
        }
        }
    }
}

#define ASTR 72
#define VSTR 260
typedef float f32x16 __attribute__((ext_vector_type(16)));
typedef unsigned u32x2 __attribute__((ext_vector_type(2)));
__device__ void ph_attn(const Params& p, unsigned char* smem, const int vb) {
    bf16_t* sK = (bf16_t*)smem;
    bf16_t* sVt = sK + 256 * ASTR;
    const int tid = threadIdx.x, lane = tid & 63, wid = tid >> 6, r32 = lane & 31, hh = lane >> 5;
    const float C1 = 0.125f * 1.4426950408889634f, LOG2E = 1.4426950408889634f;
    for (int u = vb; u < 16 * 16 * 2; u += gridDim.x) {
        const int kvh = u & 1, nb = (u >> 1) & 15, b = u >> 5;
        __syncthreads();
        for (int c = tid; c < 256 * 8; c += 256) {
            const int li = c >> 3, kc = c & 7;
            const int pos = nb * 128 - 128 + li;
            u32x4 kv = {0u, 0u, 0u, 0u}, vv = {0u, 0u, 0u, 0u};
            if (pos >= 0) {
                const bf16_t* base = p.hb + (size_t)(b * SEQ + pos) * INW;
                kv = *(const u32x4*)(base + 512 + kvh * 64 + kc * 8);
                vv = *(const u32x4*)(base + 640 + kvh * 64 + kc * 8);
            }
            *(u32x4*)(sK + li * ASTR + kc * 8) = kv;
#pragma unroll
            for (int i = 0; i < 4; ++i) {
                sVt[(kc * 8 + 2 * i) * VSTR + li] = (bf16_t)(vv[i] & 0xffffu);
                sVt[(kc * 8 + 2 * i + 1) * VSTR + li] = (bf16_t)(vv[i] >> 16);
            }
        }
        __syncthreads();
        const int hq = kvh * 4 + wid;
        const float sink2 = p.sinks[hq] * LOG2E;
        bf16x8 qn[4];
        {
            const size_t tr0 = (size_t)(b * SEQ + nb * 128 + r32);
#pragma unroll
            for (int ks = 0; ks < 4; ++ks) qn[ks] = *(const bf16x8*)(p.hb + tr0 * INW + hq * 64 + ks * 16 + hh * 8);
        }
#pragma unroll 1
        for (int qt = 0; qt < 4; ++qt) {
            const size_t trow = (size_t)(b * SEQ + nb * 128 + qt * 32 + r32);
            bf16x8 qf[4];
#pragma unroll
            for (int ks = 0; ks < 4; ++ks) qf[ks] = qn[ks];
            {
                const size_t trn = (size_t)(b * SEQ + nb * 128 + (qt < 3 ? qt + 1 : qt) * 32 + r32);
#pragma unroll
                for (int ks = 0; ks < 4; ++ks) qn[ks] = *(const bf16x8*)(p.hb + trn * INW + hq * 64 + ks * 16 + hh * 8);
            }
            f32x16 S[5];
#pragma unroll
            for (int j = 0; j < 5; ++j) {
#pragma unroll
                for (int r = 0; r < 16; ++r) S[j][r] = 0.f;
#pragma unroll
                for (int ks = 0; ks < 4; ++ks) {
                    const bf16x8 a = *(const bf16x8*)(sK + ((qt + j) * 32 + r32) * ASTR + ks * 16 + hh * 8);
                    S[j] = __builtin_amdgcn_mfma_f32_32x32x16_bf16(a, qf[ks], S[j], 0, 0, 0);
                }
            }
            float m2 = sink2;
#pragma unroll
            for (int j = 0; j < 5; ++j) {
                const bool tile_ok = (nb > 0) || (qt + j >= 4);
#pragma unroll
                for (int r = 0; r < 16; ++r) {
                    const int kl = (r & 3) + 8 * (r >> 2) + 4 * hh;
                    bool ok = tile_ok;
                    if (j == 0) ok = ok && (kl > r32);
                    if (j == 4) ok = ok && (kl <= r32);
                    const float t = ok ? S[j][r] * C1 : -1.0e30f;
                    S[j][r] = t;
                    m2 = fmaxf(m2, t);
                }
            }
            m2 = fmaxf(m2, __shfl_xor(m2, 32));
            float l = 0.f;
#pragma unroll
            for (int j = 0; j < 5; ++j)
#pragma unroll
                for (int r = 0; r < 16; ++r) { const float e = __builtin_amdgcn_exp2f(S[j][r] - m2); S[j][r] = e; l += e; }
            l += __shfl_xor(l, 32);
            l += __builtin_amdgcn_exp2f(sink2 - m2);
            f32x16 O[2];
#pragma unroll
            for (int dt = 0; dt < 2; ++dt)
#pragma unroll
                for (int r = 0; r < 16; ++r) O[dt][r] = 0.f;
#pragma unroll
            for (int j = 0; j < 5; ++j)
#pragma unroll
                for (int s2 = 0; s2 < 2; ++s2) {
                    u32x4 pw;
#pragma unroll
                    for (int k = 0; k < 4; ++k) pw[k] = pack2(S[j][8 * s2 + 2 * k], S[j][8 * s2 + 2 * k + 1]);
                    const bf16x8 pf = __builtin_bit_cast(bf16x8, pw);
                    const int kbase = (qt + j) * 32 + 16 * s2 + 4 * hh;
#pragma unroll
                    for (int dt = 0; dt < 2; ++dt) {
                        const bf16_t* vp = sVt + (dt * 32 + r32) * VSTR + kbase;
                        const u32x2 v0 = *(const u32x2*)(vp), v1 = *(const u32x2*)(vp + 8);
                        const u32x4 vw = {v0[0], v0[1], v1[0], v1[1]};
                        O[dt] = __builtin_amdgcn_mfma_f32_32x32x16_bf16(__builtin_bit_cast(bf16x8, vw), pf, O[dt], 0, 0, 0);
                    }
                }
            const float il = __builtin_amdgcn_rcpf(l);
#pragma unroll
            for (int dt = 0; dt < 2; ++dt)
#pragma unroll
                for (int g = 0; g < 4; ++g) {
                    u32x2 w;
                    w[0] = pack2(O[dt][4 * g] * il, O[dt][4 * g + 1] * il);
                    w[1] = pack2(O[dt][4 * g + 2] * il, O[dt][4 * g + 3] * il);
                    *(u32x2*)(p.mixb + trow * DM + hq * 64 + dt * 32 + 8 * g + 4 * hh) = w;
                }
        }
    }
}

#define CV_ROWS 62
__device__ void ph_conv(const Params& p, unsigned char* smem, const int vb) {
    bf16_t* gl = (bf16_t*)smem;
    float* red = (float*)(smem + CV_ROWS * 1024);
    const int tid = threadIdx.x, lane = tid & 63, wid = tid >> 6;
    const f32x2 lg = *(const f32x2*)(p.cln_g + 2 * tid), lb = *(const f32x2*)(p.cln_b + 2 * tid);
    for (int u = vb; u < T_TOK / 32; u += gridDim.x) {
        const int tok0 = u * 32, s0 = tok0 & (SEQ - 1);
        __syncthreads();
#pragma unroll 1
        for (int bt = 0; bt < 2; ++bt) {
            u32x4 av[8];
#pragma unroll
            for (int it = 0; it < 8; ++it) {
                const int ch = tid + (bt * 8 + it) * 256, row = min(ch >> 6, CV_ROWS - 1), k = ch & 63;
                const int rr = (s0 - 30 + row >= 0) ? row : 30;
                av[it] = *(const u32x4*)(p.hb + (size_t)(tok0 - 30 + rr) * INW + 768 + k * 8);
            }
#pragma unroll
            for (int it = 0; it < 8; ++it) {
                const int ch = tid + (bt * 8 + it) * 256, row = ch >> 6, k = ch & 63;
                const bool ok = (s0 - 30 + row >= 0);
                const u32x4 o = ok ? av[it] : (u32x4){0u, 0u, 0u, 0u};
                if (row < CV_ROWS) *(u32x4*)(gl + row * 512 + k * 8) = o;
            }
        }
        __syncthreads();
        float w0[31], w1[31];
#pragma unroll
        for (int k = 0; k < 31; ++k) { const f32x2 wv = *(const f32x2*)(p.conv_w + k * 512 + 2 * tid); w0[k] = wv.x; w1[k] = wv.y; }
        const f32x2 bias = *(const f32x2*)(p.conv_b + 2 * tid);
#pragma unroll 1
        for (int jh = 0; jh < 2; ++jh) {
            float a0[16], a1[16];
#pragma unroll
            for (int jl = 0; jl < 16; ++jl) { a0[jl] = bias.x; a1[jl] = bias.y; }
            const bf16_t* gp = gl + (jh * 16) * 512 + 2 * tid;
#pragma unroll
            for (int il = 0; il < 46; ++il) {
                const unsigned gw = *(const unsigned*)(gp + il * 512);
                const float g0 = bflo(gw), g1 = bfhi(gw);
#pragma unroll
                for (int jl = 0; jl < 16; ++jl)
                    if (il - jl >= 0 && il - jl <= 30) { a0[jl] += w0[il - jl] * g0; a1[jl] += w1[il - jl] * g1; }
                if ((il & 3) == 3) __builtin_amdgcn_sched_barrier(0);
            }
            float v[32];
#pragma unroll
            for (int jl = 0; jl < 16; ++jl) { v[jl] = a0[jl] + a1[jl]; v[16 + jl] = a0[jl] * a0[jl] + a1[jl] * a1[jl]; }
#pragma unroll
            for (int st = 16; st >= 1; st >>= 1) {
                const bool up = (lane & st) != 0;
#pragma unroll
                for (int i2 = 0; i2 < st; ++i2) {
                    const float keep = up ? v[i2 + st] : v[i2], send = up ? v[i2] : v[i2 + st];
                    v[i2] = keep + __shfl_xor(send, st);
                }
            }
            const float tot = v[0] + __shfl_xor(v[0], 32);
            __syncthreads();
            if (lane < 32) red[wid * 32 + lane] = tot;
            __syncthreads();
#pragma unroll
            for (int jl = 0; jl < 16; ++jl) {
                const float sm = (red[jl] + red[32 + jl]) + (red[64 + jl] + red[96 + jl]);
                const float sq = (red[16 + jl] + red[48 + jl]) + (red[80 + jl] + red[112 + jl]);
                const float mu = sm * (1.0f / 512.0f);
                const float rstd = rsqrtf(fmaxf(sq * (1.0f / 512.0f) - mu * mu, 0.f) + LN_EPS);
                const float y0 = (a0[jl] - mu) * rstd * lg.x + lb.x, y1 = (a1[jl] - mu) * rstd * lg.y + lb.y;
                *(unsigned*)(p.mixb + (size_t)(tok0 + jh * 16 + jl) * DM + 512 + 2 * tid) = pack2(sigmul(y0, y0), sigmul(y1, y1));
            }
        }
    }
}

__device__ void ph_gemm_out(const Params& p, unsigned char* smem, const int vb) {
    const int ntn = DM / 256;
    const int tid = threadIdx.x, lane = tid & 63, wid = tid >> 6, wr = wid >> 1, wc = wid & 1, fr = lane & 15, fq = lane >> 4;
    for (int t = vb; t < (T_TOK / 128) * ntn; t += gridDim.x) {
        const int m0 = (t / ntn) * 128, n0 = (t % ntn) * 256;
        f32x4 acc[4][8]; zero_accw(acc);
        u32x2 xq[2][8];
#define GO_XLD(mi, buf) do { const int _row = m0 + wr * 64 + (mi) * 16 + fr; \
            _Pragma("unroll") for (int _ni = 0; _ni < 8; ++_ni) xq[buf][_ni] = *(const u32x2*)(p.xb + (size_t)_row * DM + n0 + wc * 128 + _ni * 16 + fq * 4); } while (0)
        gemmW(p.mixb + (size_t)m0 * DM, DM, p.WoutT + (size_t)n0 * DM, DM, DM, smem, acc);
        GO_XLD(0, 0);
#pragma unroll
        for (int mi = 0; mi < 4; ++mi) {
            const int row = m0 + wr * 64 + mi * 16 + fr;
            if (mi < 3) GO_XLD(mi + 1, (mi + 1) & 1);
            float sm = 0.f, sq = 0.f;
#pragma unroll
            for (int ni = 0; ni < 8; ++ni) {
                const int col = n0 + wc * 128 + ni * 16 + fq * 4;
                const u32x2 xw = xq[mi & 1][ni];
                const f32x4 xv = {bflo(xw[0]), bfhi(xw[0]), bflo(xw[1]), bfhi(xw[1])};
                const f32x4 y = xv * ALPHA + acc[mi][ni];
                sm += (y[0] + y[1]) + (y[2] + y[3]); sq += (y[0] * y[0] + y[1] * y[1]) + (y[2] * y[2] + y[3] * y[3]);
                u32x2 o; o[0] = pack2(y[0], y[1]); o[1] = pack2(y[2], y[3]);
                *(u32x2*)(p.y1b + (size_t)row * DM + col) = o;
            }
            sm += __shfl_xor(sm, 16); sq += __shfl_xor(sq, 16); sm += __shfl_xor(sm, 32); sq += __shfl_xor(sq, 32);
            if (fq == 0) *(f32x2*)(p.stats + (size_t)row * 16 + ((n0 >> 8) * 2 + wc) * 2) = (f32x2){sm, sq};
        }
    }
}

__device__ __forceinline__ void ln_row(const float* __restrict__ src, const float* __restrict__ g, const float* __restrict__ bta,
                                       float* __restrict__ dstf, bf16_t* __restrict__ dstb, int lane) {
    f32x4 v[4]; float s = 0.f;
#pragma unroll
    for (int i = 0; i < 4; ++i) { v[i] = *(const f32x4*)(src + i * 256 + lane * 4); s += (v[i][0] + v[i][1]) + (v[i][2] + v[i][3]); }
    const float mu = wave_sum(s) * (1.0f / 1024.0f);
    float q = 0.f;
#pragma unroll
    for (int i = 0; i < 4; ++i) { const f32x4 d = v[i] - mu; q += (d[0] * d[0] + d[1] * d[1]) + (d[2] * d[2] + d[3] * d[3]); }
    const float rstd = rsqrtf(wave_sum(q) * (1.0f / 1024.0f) + LN_EPS);
#pragma unroll
    for (int i = 0; i < 4; ++i) {
        const f32x4 gg = *(const f32x4*)(g + i * 256 + lane * 4), bb = *(const f32x4*)(bta + i * 256 + lane * 4);
        const f32x4 y = (v[i] - mu) * rstd * gg + bb;
        if (dstf) *(f32x4*)(dstf + i * 256 + lane * 4) = y;
        if (dstb) { uint2 o; o.x = pack2(y[0], y[1]); o.y = pack2(y[2], y[3]); *(uint2*)(dstb + i * 256 + lane * 4) = o; }
    }
}
__device__ void ph_ln2(const Params& p, const int vb) {
    const int lane = threadIdx.x & 63, wid = threadIdx.x >> 6;
    for (int r = vb * 4 + wid; r < T_TOK; r += gridDim.x * 4)
        ln_row(p.out + (size_t)r * DM, p.ln2_g, p.ln2_b, p.out + (size_t)r * DM, (bf16_t*)nullptr, lane);
}

#define QSTR 136
__device__ __forceinline__ int f2key(float f) { const int b = __float_as_int(f); return b ^ ((b >> 31) & 0x7fffffff); }
__device__ __forceinline__ float key2f(int k) { return __int_as_float(k ^ ((k >> 31) & 0x7fffffff)); }
__device__ __forceinline__ void sort16_desc(int (&a)[16]) {
#pragma unroll
    for (int lk = 1; lk <= 4; ++lk) {
#pragma unroll
        for (int lj = lk - 1; lj >= 0; --lj) {
            const int k = 1 << lk, j = 1 << lj;
#pragma unroll
            for (int i = 0; i < 16; ++i) {
                const int l = i ^ j;
                if (l > i) {
                    const int hi = max(a[i], a[l]), lo = min(a[i], a[l]);
                    if ((i & k) == 0) { a[i] = hi; a[l] = lo; } else { a[i] = lo; a[l] = hi; }
                }
            }
        }
    }
}
__device__ __forceinline__ void merge_top16(int (&a)[16], const int (&b)[16]) {
#pragma unroll
    for (int i = 0; i < 16; ++i) a[i] = max(a[i], b[15 - i]);
#pragma unroll
    for (int lj = 3; lj >= 0; --lj) {
        const int j = 1 << lj;
#pragma unroll
        for (int i = 0; i < 16; ++i) {
            const int l = i ^ j;
            if (l > i) { const int hi = max(a[i], a[l]), lo = min(a[i], a[l]); a[i] = hi; a[l] = lo; }
        }
    }
}
__device__ __forceinline__ void top16_of_64(int (&v)[4][16]) {
    sort16_desc(v[0]); sort16_desc(v[1]); sort16_desc(v[2]); sort16_desc(v[3]);
    merge_top16(v[0], v[1]); merge_top16(v[0], v[2]); merge_top16(v[0], v[3]);
}

__device__ void ph_mprep(const Params& p, unsigned char* smem, const int vb) {
    if (vb < 8) {
        const int n = vb * 256 + threadIdx.x, hp = n >> 7;
        const float* kr = p.keys + (size_t)n * 128;
        float a = 0.f, b = 0.f;
        for (int c4 = 0; c4 < 128; c4 += 4) {
            const f32x4 kv = *(const f32x4*)(kr + c4), wg = *(const f32x4*)(p.wgb + hp * 128 + c4), wb = *(const f32x4*)(p.wgb + 2048 + hp * 128 + c4);
            a += (kv[0] * wg[0] + kv[1] * wg[1]) + (kv[2] * wg[2] + kv[3] * wg[3]);
            b += (kv[0] * wb[0] + kv[1] * wb[1]) + (kv[2] * wb[2] + kv[3] * wb[3]);
        }
        u32x4 c0 = {pack2(a, b), 0u, 0u, 0u}; const u32x4 z4 = {0u, 0u, 0u, 0u};
        u32x4* me = (u32x4*)(p.mext + (size_t)n * 32);
        me[0] = c0; me[1] = z4; me[2] = z4; me[3] = z4;
    }
    const int tid = threadIdx.x, lane = tid & 63, wid = tid >> 6, wr = wid >> 1, wc = wid & 1, fr = lane & 15, fq = lane >> 4;
    for (int t = vb; t < 16 * 8; t += gridDim.x) {
        const int hp = t >> 3, d0 = (t & 7) * 128;
        f32x4 acc[4][4]; zero_acc(acc);
        gemm128(p.keysb + (size_t)hp * 128 * 128, 128, p.Wqb + (size_t)d0 * 2048 + hp * 128, 2048, 128, smem, acc);
#pragma unroll
        for (int mi = 0; mi < 4; ++mi)
#pragma unroll
            for (int ni = 0; ni < 4; ++ni) {
                uint2 o; o.x = pack2(acc[mi][ni][0], acc[mi][ni][1]); o.y = pack2(acc[mi][ni][2], acc[mi][ni][3]);
                *(uint2*)(p.MT + (size_t)(hp * 128 + wr * 64 + mi * 16 + fr) * DM + d0 + wc * 64 + ni * 16 + fq * 4) = o;
            }
    }
}

__device__ __forceinline__ void route_topk(const f32x16 (&S)[8], int pp, int hh, int (&K)[16]) {
    int v[4][16];
#pragma unroll
    for (int mt = 0; mt < 4; ++mt)
#pragma unroll
        for (int r = 0; r < 16; ++r) {
            const int n = mt * 32 + (r & 3) + 8 * (r >> 2) + 4 * hh;
            v[mt][r] = (f2key(S[pp * 4 + mt][r]) & ~0x7F) | (127 - n);
        }
    top16_of_64(v);
    int o[16];
#pragma unroll
    for (int i = 0; i < 16; ++i) o[i] = __shfl_xor(v[0][i], 32);
    merge_top16(v[0], o);
#pragma unroll
    for (int i = 0; i < 16; ++i) K[i] = v[0][i];
}
#define RT_STEPS 33
template <bool PRE, bool NEXT>
__device__ __forceinline__ void route_gemm(const Params& p, unsigned char* smem, int m0, int h, f32x16 (&S)[8], int nm0, int nh, int& sp) {
    LDS_AS unsigned char* lds = (LDS_AS unsigned char*)smem;
    const int tid = threadIdx.x, lane = tid & 63, wid = __builtin_amdgcn_readfirstlane(tid >> 6);
    const int r32 = lane & 31, hh = lane >> 5;
    const int prow = lane >> 2, pc = (lane & 3) ^ ((4 - ((prow >> 2) & 3)) & 3);
    const bf16_t* gA = p.y1b + (size_t)(m0 + wid * 32 + prow) * DM + pc * 8;
    const bf16_t* gB = p.MT + (size_t)(h * 256 + wid * 64 + prow) * DM + pc * 8;
    const bf16_t* eA = p.yext + (size_t)(m0 + wid * 32 + prow) * 32 + pc * 8;
    const bf16_t* eB = p.mext + (size_t)(h * 256 + wid * 64 + prow) * 32 + pc * 8;
    const size_t r16 = (size_t)16 * DM;
#define RH_ISSUE_AT(pa, sa, pb, sb_, st) do { \
        _Pragma("unroll") for (int _i = 0; _i < 2; ++_i) \
            __builtin_amdgcn_global_load_lds((const unsigned*)((pa) + _i * (sa)), (LDS_AS unsigned*)(lds + (st) * GW_STAGE + (wid * 2 + _i) * 1024), 16, 0, 0); \
        _Pragma("unroll") for (int _i = 0; _i < 4; ++_i) \
            __builtin_amdgcn_global_load_lds((const unsigned*)((pb) + _i * (sb_)), (LDS_AS unsigned*)(lds + (st) * GW_STAGE + 8192 + (wid * 4 + _i) * 1024), 16, 0, 0); \
        } while (0)
#pragma unroll
    for (int mt = 0; mt < 8; ++mt)
#pragma unroll
        for (int r = 0; r < 16; ++r) S[mt][r] = 0.f;
    const int fx = (4 - ((r32 >> 2) & 3)) & 3;
    const int toff = (wid * 32 + r32) * 64, koff = 8192 + r32 * 64;
    if (!PRE) RH_ISSUE_AT(gA, r16, gB, r16, sp);
#pragma unroll 1
    for (int kt = 0; kt < RT_STEPS; ++kt) {
        const int st = (kt + sp) & 1;
        asm volatile("s_waitcnt vmcnt(0)" ::: "memory");
        __builtin_amdgcn_s_barrier();
        asm volatile("" ::: "memory");
        if (kt + 1 < RT_STEPS - 1) RH_ISSUE_AT(gA + (size_t)(kt + 1) * 32, r16, gB + (size_t)(kt + 1) * 32, r16, st ^ 1);
        else if (kt + 1 == RT_STEPS - 1) RH_ISSUE_AT(eA, (size_t)(16 * 32), eB, (size_t)(16 * 32), st ^ 1);
        else if (NEXT) {
            const bf16_t* qA = p.y1b + (size_t)(nm0 + wid * 32 + prow) * DM + pc * 8;
            const bf16_t* qB = p.MT + (size_t)(nh * 256 + wid * 64 + prow) * DM + pc * 8;
            RH_ISSUE_AT(qA, r16, qB, r16, st ^ 1);
        }
        const LDS_AS unsigned char* sb = lds + st * GW_STAGE;
#pragma unroll
        for (int k16 = 0; k16 < 2; ++k16) {
            const int sw = ((k16 * 2 + hh) ^ fx) * 16;
            const bf16x8 b = *(const LDS_AS bf16x8*)(sb + toff + sw);
#pragma unroll
            for (int mt = 0; mt < 8; ++mt) {
                const bf16x8 a = *(const LDS_AS bf16x8*)(sb + koff + mt * 2048 + sw);
                S[mt] = __builtin_amdgcn_mfma_f32_32x32x16_bf16(a, b, S[mt], 0, 0, 0);
            }
        }
        asm volatile("s_waitcnt lgkmcnt(0)" ::: "memory");
        __builtin_amdgcn_s_barrier();
        asm volatile("" ::: "memory");
    }
    sp ^= (RT_STEPS & 1);
#undef RH_ISSUE_AT
}

__device__ void ph_route(const Params& p, unsigned char* smem, const int vb) {
    const int tid = threadIdx.x, lane = tid & 63, wid = tid >> 6;
    const int r32 = lane & 31, hh = lane >> 5;
    const int hmask = -hh;
    int* KL = (int*)(smem + 2 * GW_STAGE + (size_t)wid * 32 * 33 * 4);
    const int nunits = (T_TOK / 128) * 8;
    bool pre = false; int sp = 0;
    for (int u = vb; u < nunits; u += gridDim.x) {
        const int m0 = (u >> 3) * 128, h = u & 7;
        const int un = u + gridDim.x;
        const bool has_next = un < nunits;
        const int nm0 = ((has_next ? un : u) >> 3) * 128, nh = (has_next ? un : u) & 7;
        float mu, rstd;
        {
            const float* stp = p.stats + (size_t)(m0 + wid * 32 + r32) * 16;
            const f32x4 a = *(const f32x4*)(stp), b = *(const f32x4*)(stp + 4), c4 = *(const f32x4*)(stp + 8), d = *(const f32x4*)(stp + 12);
            const float sm = (a[0] + a[2]) + (b[0] + b[2]) + (c4[0] + c4[2]) + (d[0] + d[2]);
            const float sq = (a[1] + a[3]) + (b[1] + b[3]) + (c4[1] + c4[3]) + (d[1] + d[3]);
            mu = sm * (1.0f / 1024.0f);
            rstd = rsqrtf(fmaxf(sq * (1.0f / 1024.0f) - mu * mu, 0.f) + LN_EPS);
        }
        {
            bf16_t* ye = p.yext + (size_t)(m0 + wid * 32 + r32) * 32 + hh * 16;
            const u32x4 z4 = {0u, 0u, 0u, 0u};
            u32x4 c0 = z4; if (hh == 0) c0[0] = pack2(-mu, __builtin_amdgcn_rcpf(rstd));
            *(u32x4*)(ye) = c0; *(u32x4*)(ye + 8) = z4;
        }
        f32x16 S[8];
        if (pre) { if (has_next) route_gemm<true, true>(p, smem, m0, h, S, nm0, nh, sp); else route_gemm<true, false>(p, smem, m0, h, S, nm0, nh, sp); }
        else     { if (has_next) route_gemm<false, true>(p, smem, m0, h, S, nm0, nh, sp); else route_gemm<false, false>(p, smem, m0, h, S, nm0, nh, sp); }
        int K0[16], K1[16];
        route_topk(S, 0, hh, K0);
        route_topk(S, 1, hh, K1);
        pre = has_next;
#pragma unroll
        for (int i = 0; i < 16; ++i) KL[r32 * 33 + hh * 16 + i] = K0[i] ^ ((K0[i] ^ K1[i]) & hmask);
        float s1[16], s2[16];
#pragma unroll
        for (int i = 0; i < 16; ++i) { s1[i] = key2f(K0[i] & ~0x7F); s2[i] = key2f(K1[i] & ~0x7F); }
        int c[4][16];
#pragma unroll
        for (int i = 0; i < 16; ++i)
#pragma unroll
            for (int j = 0; j < 16; ++j)
                if ((i + 1) * (j + 1) <= 16) {
                    constexpr int OFFS[16] = {0, 16, 24, 29, 33, 36, 38, 40, 42, 43, 44, 45, 46, 47, 48, 49};
                    const int q = OFFS[i] + j;
                    c[q >> 4][q & 15] = (f2key(s1[i] + s2[j]) & ~0xFF) | (255 - (i * 16 + j));
                }
#pragma unroll
        for (int qq = 50; qq < 64; ++qq) c[qq >> 4][qq & 15] = (int)0x80000000;
        top16_of_64(c);
        const float mx = key2f(c[0][0] & ~0xFF);
        float e[16]; float den = 0.f;
#pragma unroll
        for (int i = 0; i < 16; ++i) { e[i] = __expf(rstd * (key2f(c[0][i] & ~0xFF) - mx)); den += e[i]; }
        const float inv = __builtin_amdgcn_rcpf(den);
        const size_t ob = (size_t)(m0 + wid * 32 + r32) * 128 + h * 16 + hh * 8;
        int idv[8]; float gv[8];
#pragma unroll
        for (int qq = 0; qq < 8; ++qq) {
            const int F = c[0][qq] ^ ((c[0][qq] ^ c[0][8 + qq]) & hmask);
            gv[qq] = __int_as_float(__float_as_int(e[qq]) ^ ((__float_as_int(e[qq]) ^ __float_as_int(e[8 + qq])) & hmask)) * inv;
            const int idx = 255 - (F & 0xFF);
            const int k0 = KL[r32 * 33 + (idx >> 4)], k1 = KL[r32 * 33 + 16 + (idx & 15)];
            idv[qq] = (127 - (k0 & 0x7F)) * 128 + (127 - (k1 & 0x7F));
        }
        *(int4*)(p.ids + ob) = make_int4(idv[0], idv[1], idv[2], idv[3]);
        *(int4*)(p.ids + ob + 4) = make_int4(idv[4], idv[5], idv[6], idv[7]);
        *(float4*)(p.gates + ob) = make_float4(gv[0], gv[1], gv[2], gv[3]);
        *(float4*)(p.gates + ob + 4) = make_float4(gv[4], gv[5], gv[6], gv[7]);
    }
}

__device__ __forceinline__ float gelu_gate(float h, float g) { return 0.5f * h * (1.0f + erff(h * 0.70710678118654752f)) * g; }

__device__ void ph_peer_u(const Params& p, unsigned char* smem, const int vb) {
    const int lane = threadIdx.x & 63, wid = __builtin_amdgcn_readfirstlane(threadIdx.x >> 6);
    const int q = lane >> 3, c = lane & 7, j = lane & 15, kb = lane >> 4;
    const int nlb = gridDim.x >> 3, s = vb / nlb, lb = vb - s * nlb;
    const int stride = nlb * 4, t0 = lb * 4 + wid;
    const int ntok = (T_TOK - t0 + stride - 1) / stride;
    if (ntok <= 0) return;
    LDS_AS unsigned char* wb = (LDS_AS unsigned char*)smem + wid * 18432;
    LDS_AS unsigned char* ring = wb + 16384;
    const unsigned char* ubase = p.u8 + (size_t)s * (16384 * 128) + ((c ^ q) * 16);
    const unsigned char* ubase1 = p.u8 + (size_t)s * (16384 * 128) + ((c ^ q ^ 1) * 16);
    const unsigned char* rsrc; unsigned rstr;
    if (lane < 32) { rsrc = (const unsigned char*)p.ids + lane * 16; rstr = 512; }
    else if (lane < 48) { rsrc = (const unsigned char*)p.y1b + s * 256 + (lane - 32) * 16; rstr = 2048; }
    else { rsrc = (const unsigned char*)p.stats + ((2 * s + 1) >> 2) * 16; rstr = 64; }
#define PM_TOK(n) (t0 + ((n) < ntok ? (n) : ntok - 1) * stride)
#define PM_RING(n) do { if (lane < 49) __builtin_amdgcn_global_load_lds((const unsigned*)(rsrc + (size_t)PM_TOK(n) * rstr), (LDS_AS unsigned*)(ring + ((n) & 1) * 1024), 16, 0, 0); } while (0)
#define PM_IDS(n, ia, ib) do { const LDS_AS u32x4* _q = (const LDS_AS u32x4*)(ring + ((n) & 1) * 1024 + q * 32); \
        const u32x4 _a0 = _q[0], _a1 = _q[1], _b0 = _q[16], _b1 = _q[17]; \
        ia[0] = _a0[0]; ia[1] = _a0[1]; ia[2] = _a0[2]; ia[3] = _a0[3]; ia[4] = _a1[0]; ia[5] = _a1[1]; ia[6] = _a1[2]; ia[7] = _a1[3]; \
        ib[0] = _b0[0]; ib[1] = _b0[1]; ib[2] = _b0[2]; ib[3] = _b0[3]; ib[4] = _b1[0]; ib[5] = _b1[1]; ib[6] = _b1[2]; ib[7] = _b1[3]; } while (0)
#define PM_DMA(i, id) __builtin_amdgcn_global_load_lds((const unsigned*)((((i) & 1) ? ubase1 : ubase) + (size_t)(id) * 128), (LDS_AS unsigned*)(wb + (i) * 1024), 16, 0, 0)
    const int key = (j & 7) ^ (j >> 3);
    const LDS_AS unsigned char* brd = wb + j * 128 + (((2 * kb) ^ key) * 16);
    const int bx1 = (key & 1) ? -16 : 16;
    const LDS_AS unsigned char* ard = ring + (j & 1) * 1024 + 832 + kb * 32;
    PM_RING(0); PM_RING(1);
    asm volatile("s_waitcnt vmcnt(0)" ::: "memory");
    {
        unsigned ia[8], ib[8]; PM_IDS(0, ia, ib);
#pragma unroll
        for (int m = 0; m < 4; ++m) { PM_DMA(2 * m, ia[m]); PM_DMA(2 * m + 1, ib[m]); }
#pragma unroll
        for (int m = 4; m < 8; ++m) { PM_DMA(2 * m, ia[m]); PM_DMA(2 * m + 1, ib[m]); }
    }
    const int sqi = ((2 * s + 1) & 3) * 4;
#define PM_XLOAD(nn, xw, ssq) do { const LDS_AS unsigned char* _sl = ring + ((nn) & 1) * 1024; \
        xw = *(const LDS_AS unsigned*)(_sl + 512 + lane * 4); ssq = *(const LDS_AS float*)(_sl + 768 + sqi); } while (0)
#define PM_XCONV(xw, ssq, xq0, xq1, iscv) do { \
        const int _e2 = (int)(__float_as_uint(ssq) >> 23) - 126;              \
        int _eh = (_e2 + 1) >> 1; _eh = _eh < -60 ? -60 : (_eh > 60 ? 60 : _eh);    \
        const float _sc = __uint_as_float((unsigned)(127 + 8 - _eh) << 23); iscv = __uint_as_float((unsigned)(127 - 8 + _eh) << 23); \
        const float _x0 = bflo(xw) * _sc, _x1 = bfhi(xw) * _sc; \
        const unsigned _h8 = (unsigned)__builtin_amdgcn_cvt_pk_fp8_f32(_x0, _x1, 0, false); \
        const f32x2 _hd = __builtin_amdgcn_cvt_pk_f32_fp8((int)_h8, false); \
        const unsigned _l8 = (unsigned)__builtin_amdgcn_cvt_pk_fp8_f32(_x0 - _hd.x, _x1 - _hd.y, 0, false); \
        *(LDS_AS unsigned short*)(ring + 832 + lane * 2) = (unsigned short)_h8; \
        *(LDS_AS unsigned short*)(ring + 1024 + 832 + lane * 2) = (unsigned short)_l8; \
        xq0 = *(const LDS_AS u32x4*)(ard); xq1 = *(const LDS_AS u32x4*)(ard + 16); } while (0)
    u32x4 xc0, xc1; float isc;
    { unsigned xw; float ssq; PM_XLOAD(0, xw, ssq); PM_XCONV(xw, ssq, xc0, xc1, isc); }
#pragma unroll 1
    for (int n = 0; n < ntok; ++n) {
        const int t = t0 + n * stride;
        i64 xa[4];
        xa[0] = (i64)(((unsigned long long)xc0[1] << 32) | xc0[0]); xa[1] = (i64)(((unsigned long long)xc0[3] << 32) | xc0[2]);
        xa[2] = (i64)(((unsigned long long)xc1[1] << 32) | xc1[0]); xa[3] = (i64)(((unsigned long long)xc1[3] << 32) | xc1[2]);
        const float isc_cur = isc;
        f32x4 acc[8];
        asm volatile("s_waitcnt vmcnt(16)" ::: "memory");
        unsigned ia[8], ib[8]; PM_IDS(n + 1, ia, ib);
        asm volatile("s_waitcnt lgkmcnt(0)" ::: "memory");
        PM_RING(n + 2);
        u32x4 bq[2][2]; unsigned xwn; float ssqn; u32x4 xn0, xn1; float iscn;
        asm volatile("s_waitcnt vmcnt(15)" ::: "memory");
        bq[0][0] = *(const LDS_AS u32x4*)(brd); bq[0][1] = *(const LDS_AS u32x4*)(brd + bx1);
#pragma unroll
        for (int m = 0; m < 8; ++m) {
            if (m < 7) {
                asm volatile("s_waitcnt vmcnt(13)" ::: "memory");
                bq[(m + 1) & 1][0] = *(const LDS_AS u32x4*)(brd + (m + 1) * 2048); bq[(m + 1) & 1][1] = *(const LDS_AS u32x4*)(brd + (m + 1) * 2048 + bx1);
                asm volatile("s_waitcnt lgkmcnt(2)" ::: "memory");
            } else {
                asm volatile("s_waitcnt lgkmcnt(0)" ::: "memory");
            }
            PM_DMA(2 * m, ia[m]); PM_DMA(2 * m + 1, ib[m]);
            const u32x4 b0 = bq[m & 1][0], b1 = bq[m & 1][1];
            f32x4 a = {0.f, 0.f, 0.f, 0.f};
            a = __builtin_amdgcn_mfma_f32_16x16x32_fp8_fp8(xa[0], (i64)(((unsigned long long)b0[1] << 32) | b0[0]), a, 0, 0, 0);
            a = __builtin_amdgcn_mfma_f32_16x16x32_fp8_fp8(xa[1], (i64)(((unsigned long long)b0[3] << 32) | b0[2]), a, 0, 0, 0);
            a = __builtin_amdgcn_mfma_f32_16x16x32_fp8_fp8(xa[2], (i64)(((unsigned long long)b1[1] << 32) | b1[0]), a, 0, 0, 0);
            a = __builtin_amdgcn_mfma_f32_16x16x32_fp8_fp8(xa[3], (i64)(((unsigned long long)b1[3] << 32) | b1[2]), a, 0, 0, 0);
            acc[m] = a;
            if (m == 1) PM_XLOAD(n + 1, xwn, ssqn);
            if (m == 4) PM_XCONV(xwn, ssqn, xn0, xn1, iscn);
        }
        if (lane < 16) {
            u32x4 o;
#pragma unroll
            for (int k = 0; k < 4; ++k) o[k] = pack2((acc[2 * k][0] + acc[2 * k][1]) * isc_cur, (acc[2 * k + 1][0] + acc[2 * k + 1][1]) * isc_cur);
            *(u32x4*)(p.hp + ((size_t)t * 8 + s) * 128 + lane * 8) = o;
        }
        xc0 = xn0; xc1 = xn1; isc = iscn;
    }
    asm volatile("s_waitcnt vmcnt(0)" ::: "memory");
}
__device__ void ph_peer_act(const Params& p, unsigned char* smem, const int vb) {
    const int lane = threadIdx.x & 63, wid = threadIdx.x >> 6;
    unsigned* lsc = (unsigned*)smem;
    LDS_AS unsigned char* img = (LDS_AS unsigned char*)smem + 65536 + wid * 256;
    __syncthreads();
    for (int i = threadIdx.x; i < 16384 / 4; i += 256) *(u32x4*)(lsc + 4 * i) = *(const u32x4*)((const unsigned*)p.sc2 + 4 * i);
    __syncthreads();
    const int e0 = 2 * lane, e1 = e0 + 1;
    const int ix0 = (e0 & 3) * 32 + ((e0 >> 2) & 3) * 8 + (e0 >> 4), ix1 = (e1 & 3) * 32 + ((e1 >> 2) & 3) * 8 + (e1 >> 4);
    for (int t = vb * 4 + wid; t < T_TOK; t += gridDim.x * 4) {
        f32x2 h = {0.f, 0.f};
#pragma unroll
        for (int s = 0; s < 8; ++s) { const unsigned w = *(const unsigned*)(p.hp + ((size_t)t * 8 + s) * 128 + 2 * lane); h += (f32x2){bflo(w), bfhi(w)}; }
        f32x2 pq = *(const f32x2*)(p.stats + (size_t)t * 16 + (lane & 7) * 2);
        pq.x += __shfl_xor(pq.x, 1); pq.y += __shfl_xor(pq.y, 1); pq.x += __shfl_xor(pq.x, 2); pq.y += __shfl_xor(pq.y, 2); pq.x += __shfl_xor(pq.x, 4); pq.y += __shfl_xor(pq.y, 4);
        const float mu = pq.x * (1.0f / 1024.0f), rstd = rsqrtf(fmaxf(pq.y * (1.0f / 1024.0f) - mu * mu, 0.f) + LN_EPS);
        int2 id = *(const int2*)(p.ids + (size_t)t * 128 + 2 * lane);
        id.x &= 0x3fff; id.y &= 0x3fff;
        const f32x2 gt = *(const f32x2*)(p.gates + (size_t)t * 128 + 2 * lane);
        const unsigned s0 = lsc[id.x], s1 = lsc[id.y];
        const unsigned c0 = p.cb2[id.x], c1 = p.cb2[id.y];
        f32x2 a;
        a.x = gelu_gate(rstd * (h.x * bflo(s0) - mu * bflo(c0)) + bfhi(c0), gt.x) * bfhi(s0);
        a.y = gelu_gate(rstd * (h.y * bflo(s1) - mu * bflo(c1)) + bfhi(c1), gt.y) * bfhi(s1);
        float am = fmaxf(fabsf(a.x), fabsf(a.y));
#pragma unroll
        for (int o = 32; o >= 1; o >>= 1) am = fmaxf(am, __shfl_xor(am, o));
        int be = (int)(__float_as_uint(am) >> 23); be = be < 20 ? 20 : (be > 240 ? 240 : be);
        const float sc = __uint_as_float((unsigned)(261 - be) << 23);
        const unsigned iscb = (unsigned)(be - 7) << 23;
        const float x0 = a.x * sc, x1 = a.y * sc;
        const unsigned h8 = (unsigned)__builtin_amdgcn_cvt_pk_fp8_f32(x0, x1, 0, false);
        const f32x2 hd = __builtin_amdgcn_cvt_pk_f32_fp8((int)h8, false);
        const unsigned l8 = (unsigned)__builtin_amdgcn_cvt_pk_fp8_f32(x0 - hd.x, x1 - hd.y, 0, false);
        img[ix0] = (unsigned char)h8; img[ix1] = (unsigned char)(h8 >> 8);
        img[128 + ix0] = (unsigned char)l8; img[128 + ix1] = (unsigned char)(l8 >> 8);
        const unsigned iw = *(const LDS_AS unsigned*)(img + lane * 4);
        *(unsigned*)((unsigned char*)p.gates + (size_t)t * 512 + lane * 4) = iw;
        if (lane < 3) {
            const unsigned pb = lane == 0 ? __float_as_uint(mu) : (lane == 1 ? __float_as_uint(rstd) : iscb);
            *(int2*)(p.ids + (size_t)t * 128 + 2 * lane) = make_int2(id.x | (int)(pb & 0xffff0000u), id.y | (int)(pb << 16));
        }
    }
}
typedef int v2i32 __attribute__((ext_vector_type(2)));
__device__ void ph_peer_v(const Params& p, unsigned char* smem, const int vb) {
    const int lane = threadIdx.x & 63, wid = __builtin_amdgcn_readfirstlane(threadIdx.x >> 6);
    const int q = lane >> 3, c = lane & 7, j = lane & 15, kb = lane >> 4;
    const int nlb = gridDim.x >> 3, s = vb / nlb, lb = vb - s * nlb;
    const int stride = nlb * 4, t0 = lb * 4 + wid;
    const int ntok = (T_TOK - t0 + stride - 1) / stride;
    if (ntok <= 0) return;
    LDS_AS unsigned char* wb = (LDS_AS unsigned char*)smem + wid * 18432;
    LDS_AS unsigned char* ring = wb + 16384;
    const unsigned char* vbase = p.v8 + (size_t)s * (16384 * 128) + ((c ^ q) * 16);
    const unsigned char* vbase1 = p.v8 + (size_t)s * (16384 * 128) + ((c ^ q ^ 1) * 16);
    const unsigned char* rsrc; unsigned rstr;
    if (lane < 32) { rsrc = (const unsigned char*)p.ids + lane * 16; rstr = 512; }
    else if (lane < 48) { rsrc = (const unsigned char*)p.gates + (lane - 32) * 16; rstr = 512; }
    else { rsrc = (const unsigned char*)p.y1b + s * 256 + (lane - 48) * 16; rstr = 2048; }
#define PV_RING(n) __builtin_amdgcn_global_load_lds((const unsigned*)(rsrc + (size_t)PM_TOK(n) * rstr), (LDS_AS unsigned*)(ring + ((n) & 1) * 1024), 16, 0, 0)
#define PV_IDS(n, idv) do { const LDS_AS u32x4* _q = (const LDS_AS u32x4*)(ring + ((n) & 1) * 1024 + q * 64); \
        _Pragma("unroll") for (int _k = 0; _k < 4; ++_k) { const u32x4 _v = _q[_k]; idv[4 * _k] = _v[0] & 0x3fffu; idv[4 * _k + 1] = _v[1] & 0x3fffu; idv[4 * _k + 2] = _v[2] & 0x3fffu; idv[4 * _k + 3] = _v[3] & 0x3fffu; } } while (0)
#define PV_DMA(i, id) __builtin_amdgcn_global_load_lds((const unsigned*)((((i) & 1) ? vbase1 : vbase) + (size_t)(id) * 128), (LDS_AS unsigned*)(wb + (i) * 1024), 16, 0, 0)
    const int key = (j >> 1) ^ (kb & 1);
    const LDS_AS unsigned char* tb = wb + (8 * kb + (j >> 1)) * 128 + (j & 1) * 8;
    const LDS_AS unsigned char* ard = ring + 512 + (j & 1) * 128 + kb * 32;
    const int dl = 32 * kb + (j & 1) * 16 + (j & 14), d0 = s * 128 + dl;
    const f32x2 g2 = *(const f32x2*)(p.ln1_g + d0), b2 = *(const f32x2*)(p.ln1_b + d0);
    PV_RING(0); PV_RING(1);
    asm volatile("s_waitcnt vmcnt(0)" ::: "memory");
    {
        unsigned idv[16]; PV_IDS(0, idv);
#pragma unroll
        for (int i = 0; i < 16; ++i) PV_DMA(i, idv[i]);
    }
#define PV_SLOT(nn, q0, q1, h4, h5, yy) do { const LDS_AS unsigned char* _sl = ring + ((nn) & 1) * 1024; \
        q0 = *(const LDS_AS u32x4*)(ard + ((nn) & 1) * 1024); q1 = *(const LDS_AS u32x4*)(ard + ((nn) & 1) * 1024 + 16); \
        h4 = *(const LDS_AS u32x4*)(_sl); h5 = *(const LDS_AS unsigned*)(_sl + 16); yy = *(const LDS_AS unsigned*)(_sl + 768 + dl * 2); } while (0)
    u32x4 xc0, xc1, hc4; unsigned hc5, ywc;
    PV_SLOT(0, xc0, xc1, hc4, hc5, ywc);
#pragma unroll 1
    for (int n = 0; n < ntok; ++n) {
        const int t = t0 + n * stride;
        const u32x4 hd4 = hc4; const unsigned hd5 = hc5, yw = ywc;
        i64 xa[4];
        xa[0] = (i64)(((unsigned long long)xc0[1] << 32) | xc0[0]); xa[1] = (i64)(((unsigned long long)xc0[3] << 32) | xc0[2]);
        xa[2] = (i64)(((unsigned long long)xc1[1] << 32) | xc1[0]); xa[3] = (i64)(((unsigned long long)xc1[3] << 32) | xc1[2]);
        const float mu = __uint_as_float((hd4[0] & 0xffff0000u) | (hd4[1] >> 16)), rs = __uint_as_float((hd4[2] & 0xffff0000u) | (hd4[3] >> 16));
        const float isc = __uint_as_float(hd5 & 0xffff0000u);
        f32x4 acc[8];
#pragma unroll
        for (int ct = 0; ct < 8; ++ct) acc[ct] = (f32x4){0.f, 0.f, 0.f, 0.f};
        asm volatile("s_waitcnt vmcnt(16)" ::: "memory");
        unsigned idv[16]; PV_IDS(n + 1, idv);
        asm volatile("s_waitcnt lgkmcnt(0)" ::: "memory");
        PV_RING(n + 2);
        v2i32 bv[2][8];
        asm volatile("s_waitcnt vmcnt(13)" ::: "memory");
#pragma unroll
        for (int ct = 0; ct < 8; ++ct) bv[0][ct] = __builtin_amdgcn_ds_read_tr8_b64_v2i32((LDS_AS v2i32*)(tb + ((ct ^ key) << 4)));
#pragma unroll
        for (int ks = 0; ks < 4; ++ks) {
            if (ks < 3) {
                asm volatile("s_waitcnt vmcnt(9)" ::: "memory");
#pragma unroll
                for (int ct = 0; ct < 8; ++ct) bv[(ks + 1) & 1][ct] = __builtin_amdgcn_ds_read_tr8_b64_v2i32((LDS_AS v2i32*)(tb + (ks + 1) * 4096 + ((ct ^ key) << 4)));
                asm volatile("s_waitcnt lgkmcnt(8)" ::: "memory");
            } else {
                asm volatile("s_waitcnt lgkmcnt(0)" ::: "memory");
            }
#pragma unroll
            for (int i = 0; i < 4; ++i) PV_DMA(4 * ks + i, idv[4 * ks + i]);
#pragma unroll
            for (int ct = 0; ct < 8; ++ct)
                acc[ct] = __builtin_amdgcn_mfma_f32_16x16x32_fp8_fp8(xa[ks], (i64)(((unsigned long long)(unsigned)bv[ks & 1][ct][1] << 32) | (unsigned)bv[ks & 1][ct][0]), acc[ct], 0, 0, 0);
            if (ks == 1) PV_SLOT(n + 1, xc0, xc1, hc4, hc5, ywc);
        }
        float va, vc;
        {
            const float w0 = acc[0][0] + acc[0][1], w1 = acc[1][0] + acc[1][1], w2 = acc[2][0] + acc[2][1], w3 = acc[3][0] + acc[3][1];
            const float w4 = acc[4][0] + acc[4][1], w5 = acc[5][0] + acc[5][1], w6 = acc[6][0] + acc[6][1], w7 = acc[7][0] + acc[7][1];
            va = kb == 0 ? w0 : (kb == 1 ? w2 : (kb == 2 ? w4 : w6));
            vc = kb == 0 ? w1 : (kb == 1 ? w3 : (kb == 2 ? w5 : w7));
        }
        const bool od = (j & 1) != 0;
        const float got = __shfl_xor(od ? va : vc, 1);
        const float p0 = (od ? got : va) * isc, p1 = (od ? vc : got) * isc;
        const float r0 = ALPHA * ((bflo(yw) - mu) * rs * g2.x + b2.x) + p0, r1 = ALPHA * ((bfhi(yw) - mu) * rs * g2.y + b2.y) + p1;
        *(unsigned*)(p.rb + (size_t)t * DM + d0) = pack2(r0, r1);
    }
    asm volatile("s_waitcnt vmcnt(0)" ::: "memory");
}

__device__ void ph_gemm_ple(const Params& p, unsigned char* smem, const int vb) {
    const int ntn = DM / 128;
    const int tid = threadIdx.x, lane = tid & 63, wid = tid >> 6, wr = wid >> 1, wc = wid & 1, fr = lane & 15, fq = lane >> 4;
    const int ntiles = (T_TOK / 128) * ntn;
    bool pre = false;
    for (int t = vb; t < ntiles; t += gridDim.x) {
        const int m0 = (t / ntn) * 128, n0 = (t % ntn) * 128;
        const int tn = t + gridDim.x;
        const bool has_next = tn < ntiles;
        const bf16_t* nA = p.pb + (size_t)((has_next ? tn : t) / ntn) * 128 * 256;
        const bf16_t* nB = p.WpT + (size_t)((has_next ? tn : t) % ntn) * 128 * 256;
        const bf16_t* gA = p.rb + (size_t)m0 * DM; const bf16_t* gB = p.WgT + (size_t)n0 * DM;
        f32x4 acc[4][4], acc2[4][4]; zero_acc(acc); zero_acc(acc2);
        if (pre) gemm128<true, true>(p.pb + (size_t)m0 * 256, 256, p.WpT + (size_t)n0 * 256, 256, 256, smem, acc2, gA, DM, gB, DM);
        else     gemm128<false, true>(p.pb + (size_t)m0 * 256, 256, p.WpT + (size_t)n0 * 256, 256, 256, smem, acc2, gA, DM, gB, DM);
        if (has_next) gemm128<true, true>(gA, DM, gB, DM, DM, smem, acc, nA, 256, nB, 256);
        else          gemm128<true, false>(gA, DM, gB, DM, DM, smem, acc);
        pre = has_next;
#pragma unroll
        for (int mi = 0; mi < 4; ++mi) {
            const int row = m0 + wr * 64 + mi * 16 + fr;
#pragma unroll
            for (int ni = 0; ni < 4; ++ni) {
                const int col = n0 + wc * 64 + ni * 16 + fq * 4;
                const u32x2 rw = *(const u32x2*)(p.rb + (size_t)row * DM + col);
                f32x4 rv = {bflo(rw[0]), bfhi(rw[0]), bflo(rw[1]), bfhi(rw[1])};
#pragma unroll
                for (int r = 0; r < 4; ++r) rv[r] += sigmul(acc2[mi][ni][r], acc[mi][ni][r]);
                *(f32x4*)(p.out + (size_t)row * DM + col) = rv;
            }
        }
    }
}

#define XB_TMO      128
#define XB_XCNT(j)  (256  + 64 * (j))
#define XB_XSUB(j)  (1280 + 64 * (j))
#define XB_XGEN(j)  (2304 + 64 * (j))
#define XB_TOP      3328
#define XB_TOPGEN   3392
#define XCD_BAR_WORDS 3456
#define XB_SPIN_CAP (1u << 20)
__device__ __forceinline__ unsigned xb_ld(unsigned* p)              { return __hip_atomic_load(p, __ATOMIC_RELAXED, __HIP_MEMORY_SCOPE_AGENT); }
__device__ __forceinline__ unsigned xb_add(unsigned* p, unsigned v) { return __hip_atomic_fetch_add(p, v, __ATOMIC_RELAXED, __HIP_MEMORY_SCOPE_AGENT); }
__device__ __forceinline__ unsigned xb_xcc_id() { return (unsigned)__builtin_amdgcn_s_getreg((3 << 11) | 20) & 0xFu; }
#define XB_SPIN(cond, bar) do { unsigned _sp = 0; while (cond) { __builtin_amdgcn_s_sleep(1); \
    if ((++_sp & 255u) == 0u) { if (xb_ld(&(bar)[XB_TMO])) break; if (_sp > XB_SPIN_CAP) { atomicAdd(&(bar)[XB_TMO], 1u); break; } } } } while (0)
struct XcdBarrier { unsigned* bar; unsigned x; volatile LDS_AS unsigned* st; };
__device__ __forceinline__ XcdBarrier xcd_barrier_post(unsigned* bar, volatile LDS_AS unsigned* st) {
    XcdBarrier b; b.bar = bar; b.x = xb_xcc_id(); b.st = st;
    if (threadIdx.x == 0) st[3] = xb_add(&bar[XB_XCNT(b.x)], 1u);
    return b;
}
__device__ __forceinline__ void xcd_barrier_complete(unsigned* bar, unsigned x, unsigned rank, unsigned& nloc, unsigned& nx, unsigned& vb) {
    const unsigned G = gridDim.x;
    unsigned sum, cnt, mine, sp = 0u; bool even;
    for (;;) {
        sum = 0u; cnt = 0u; mine = 0u; even = true;
#pragma unroll
        for (unsigned j = 0; j < 16; ++j) {
            const unsigned c = xb_ld(&bar[XB_XCNT(j)]); sum += c; cnt += (c > 0u) ? 1u : 0u; mine = (j == x) ? c : mine;
            even = even && (c == ((j < 8u) ? (G >> 3) : 0u));
        }
        if (sum == G) break;
        __builtin_amdgcn_s_sleep(1);
        if ((++sp & 255u) == 0u) { if (xb_ld(&bar[XB_TMO])) break; if (sp > XB_SPIN_CAP) { atomicAdd(&bar[XB_TMO], 1u); break; } }
    }
    nloc = mine > 0u ? mine : 1u; nx = cnt > 0u ? cnt : 1u;
    vb = (even && sum == G && (G & 7u) == 0u) ? (x * (G >> 3) + rank) : blockIdx.x;
}
__device__ __forceinline__ void xcd_barrier(const XcdBarrier& b) {
    asm volatile("s_waitcnt vmcnt(0)" ::: "memory");
    __syncthreads();
    if (threadIdx.x == 0) {
        unsigned* bar = b.bar;
        __builtin_amdgcn_s_waitcnt(0);
        unsigned nloc = b.st[0], nx = b.st[1];
        if (nloc == 0u) { unsigned vb; xcd_barrier_complete(bar, b.x, b.st[3], nloc, nx, vb); b.st[0] = nloc; b.st[1] = nx; b.st[2] = vb; }
        const unsigned old = xb_add(&bar[XB_XSUB(b.x)], 1u);
        const unsigned gen = old / nloc;
        if (old + 1u == (gen + 1u) * nloc) {
            __builtin_amdgcn_fence(__ATOMIC_RELEASE, "agent");
            asm volatile("s_waitcnt vmcnt(0)" ::: "memory");
            const unsigned og = xb_add(&bar[XB_TOP], 1u);
            const unsigned tg = og / nx;
            if (og + 1u == (tg + 1u) * nx) xb_add(&bar[XB_TOPGEN], 1u);
            else XB_SPIN(xb_ld(&bar[XB_TOPGEN]) == tg, bar);
            __builtin_amdgcn_fence(__ATOMIC_ACQUIRE, "agent");
            xb_add(&bar[XB_XGEN(b.x)], 1u);
            asm volatile("s_waitcnt vmcnt(0)" ::: "memory");
        } else {
            XB_SPIN(xb_ld(&bar[XB_XGEN(b.x)]) == gen, bar);
            __builtin_amdgcn_fence(__ATOMIC_ACQUIRE, "agent");
            asm volatile("s_waitcnt vmcnt(0)" ::: "memory");
        }
    }
    __syncthreads();
}

#define SMEM_PHASE (256 * ASTR * 2 * 2)
#define SMEM_BYTES (SMEM_PHASE + 16)
__global__ void __launch_bounds__(256, 2) mega(Params p) {
    __shared__ __attribute__((aligned(16))) unsigned char smem[SMEM_BYTES];
    volatile LDS_AS unsigned* st = (volatile LDS_AS unsigned*)(LDS_AS unsigned char*)(smem + SMEM_PHASE);
    if (threadIdx.x < 4) st[threadIdx.x] = 0u;
    __syncthreads();
    const XcdBarrier gb = xcd_barrier_post(p.bar, st);
    ph_prep(p, smem);            xcd_barrier(gb);
    const int vb = (int)st[2];
    ph_gemm_in(p, smem, vb);     xcd_barrier(gb);
    ph_attn(p, smem, vb);
    ph_conv(p, smem, vb);        xcd_barrier(gb);
    ph_mprep(p, smem, vb);
    ph_gemm_out(p, smem, vb);    xcd_barrier(gb);
    ph_route(p, smem, vb);       xcd_barrier(gb);
    ph_peer_u(p, smem, vb);      xcd_barrier(gb);
    ph_peer_act(p, smem, vb);    xcd_barrier(gb);
    ph_peer_v(p, smem, vb);      xcd_barrier(gb);
    ph_gemm_ple(p, smem, vb);    xcd_barrier(gb);
    ph_ln2(p, vb);
}

extern "C" void kernel_launch(void* const* d_in, const int* in_sizes, int n_in, void* d_out, int out_size, void* d_ws, size_t ws_size,
                              hipStream_t stream) {
    Params p{};
    p.x = (const float*)d_in[0]; p.p = (const float*)d_in[1]; p.pos = (const int*)d_in[2];
    p.w_in = (const float*)d_in[3]; p.sinks = (const float*)d_in[4]; p.conv_w = (const float*)d_in[5]; p.conv_b = (const float*)d_in[6];
    p.cln_g = (const float*)d_in[7]; p.cln_b = (const float*)d_in[8]; p.w_out = (const float*)d_in[9]; p.ln1_g = (const float*)d_in[10];
    p.ln1_b = (const float*)d_in[11]; p.wq = (const float*)d_in[12]; p.keys = (const float*)d_in[13]; p.pu = (const float*)d_in[14];
    p.pv = (const float*)d_in[15]; p.ple_proj = (const float*)d_in[16]; p.ple_gate = (const float*)d_in[17]; p.ln2_g = (const float*)d_in[18];
    p.ln2_b = (const float*)d_in[19];
    p.out = (float*)d_out;
    unsigned char* ws = (unsigned char*)d_ws;
    const size_t MiB = 1024 * 1024;
    p.y1 = (float*)(ws + 0 * MiB);
    p.hb = (bf16_t*)(ws + 128 * MiB);
    p.hp = (bf16_t*)(ws + 128 * MiB);
    p.xb = (bf16_t*)(ws + 256 * MiB);
    p.mixb = (bf16_t*)(ws + 320 * MiB);
    p.rb = (bf16_t*)(ws + 320 * MiB);
    p.pb = (bf16_t*)(ws + 384 * MiB);
    p.u8 = (unsigned char*)(ws + 400 * MiB);
    p.v8 = (unsigned char*)(ws + 416 * MiB);
    p.sc2 = (bf16_t*)(ws + 432 * MiB);
    p.rope = (float*)(ws + 434 * MiB);
    p.stats = (float*)(ws + 436 * MiB);
    p.cb2 = (unsigned*)(ws + 438 * MiB);
    p.mext = (bf16_t*)(ws + 440 * MiB);
    p.yext = (bf16_t*)(ws + 442 * MiB);
    p.y1b = (bf16_t*)(ws + 0 * MiB);
    p.ids = (int*)(ws + 464 * MiB);
    p.gates = (float*)(ws + 480 * MiB);
    unsigned char* wb = ws + 496 * MiB;
    p.WinT = (bf16_t*)wb; wb += (size_t)INW * DM * 2;
    p.WoutT = (bf16_t*)wb; wb += (size_t)DM * DM * 2;
    p.WgT = (bf16_t*)wb; wb += (size_t)DM * DM * 2;
    p.WpT = (bf16_t*)wb; wb += (size_t)DM * 256 * 2;
    p.keysb = (bf16_t*)wb; wb += (size_t)16 * 128 * 128 * 2;
    p.Wqb = (bf16_t*)(ws + 240 * MiB);
    p.MT = (bf16_t*)(ws + 244 * MiB);
    p.bar = (unsigned*)(ws + 510 * MiB);
    p.wgb = (float*)(p.bar + XCD_BAR_WORDS + 640);

    static int grid_blocks = 0;
    if (!grid_blocks) {
        int dev = 0, cus = 0, per_cu = 0;
        (void)hipGetDevice(&dev);
        (void)hipDeviceGetAttribute(&cus, hipDeviceAttributeMultiprocessorCount, dev);
        (void)hipOccupancyMaxActiveBlocksPerMultiprocessor(&per_cu, mega, 256, 0);
        if (per_cu > 2) per_cu = 2;
        grid_blocks = cus * per_cu;
    }
    (void)hipMemsetAsync(p.bar, 0, (XCD_BAR_WORDS + 640 + 4096) * sizeof(unsigned), stream);
    void* args[] = {&p};
    hipError_t e = hipLaunchCooperativeKernel((void*)mega, dim3(grid_blocks), dim3(256), args, 0, stream);
    if (e != hipSuccess) fprintf(stderr, "cooperative launch failed: %s (grid %d)\n", hipGetErrorString(e), grid_blocks);
}
```

```cpp
#include <hip/hip_runtime.h>
#include <stdint.h>
#include <cstdio>

typedef unsigned short bf16_t;
typedef short bf16x8 __attribute__((ext_vector_type(8)));
typedef float f32x4 __attribute__((ext_vector_type(4)));
typedef unsigned u32x4 __attribute__((ext_vector_type(4)));
typedef float f32x2 __attribute__((ext_vector_type(2)));
typedef long i64;

#define T_TOK 32768
#define SEQ 2048
#define DM 1024
#define INW 1792
#define ALPHA 1.189207115002721f
#define LN_EPS 1e-5f

__device__ __forceinline__ bf16_t f2bf(float f) {
    unsigned u = __float_as_uint(f);
    u += 0x7fffu + ((u >> 16) & 1u);
    return (bf16_t)(u >> 16);
}
__device__ __forceinline__ float bf2f(bf16_t b) { return __uint_as_float(((unsigned)b) << 16); }
__device__ __forceinline__ float bflo(unsigned w) { return __uint_as_float(w << 16); }
__device__ __forceinline__ float bfhi(unsigned w) { return __uint_as_float(w & 0xffff0000u); }
__device__ __forceinline__ unsigned pack2(float a, float b) { unsigned r; asm("v_cvt_pk_bf16_f32 %0, %1, %2" : "=v"(r) : "v"(a), "v"(b)); return r; }

__device__ __forceinline__ float sigmul(float x, float g) { return x * __builtin_amdgcn_rcpf(1.0f + __expf(-g)); }
template <int CTRL> __device__ __forceinline__ float dppf(float v) {
    return __int_as_float(__builtin_amdgcn_update_dpp(0, __float_as_int(v), CTRL, 0xF, 0xF, true));
}
#define DPP_ROR(n) (0x120 + (n))
#define DPP_XOR1 0xB1
#define DPP_XOR2 0x4E
__device__ __forceinline__ float xrow16_sum(float v) { const auto r = __builtin_amdgcn_permlane16_swap(__float_as_uint(v), __float_as_uint(v), false, false); return __uint_as_float(r[0]) + __uint_as_float(r[1]); }
__device__ __forceinline__ float xrow32_sum(float v) { const auto r = __builtin_amdgcn_permlane32_swap(__float_as_uint(v), __float_as_uint(v), false, false); return __uint_as_float(r[0]) + __uint_as_float(r[1]); }
__device__ __forceinline__ float xrow16_max(float v) { const auto r = __builtin_amdgcn_permlane16_swap(__float_as_uint(v), __float_as_uint(v), false, false); return fmaxf(__uint_as_float(r[0]), __uint_as_float(r[1])); }
__device__ __forceinline__ float xrow32_max(float v) { const auto r = __builtin_amdgcn_permlane32_swap(__float_as_uint(v), __float_as_uint(v), false, false); return fmaxf(__uint_as_float(r[0]), __uint_as_float(r[1])); }
__device__ __forceinline__ int xhalf_i(int v, bool upper) { const auto r = __builtin_amdgcn_permlane32_swap((unsigned)v, (unsigned)v, false, false); return (int)(upper ? r[0] : r[1]); }
__device__ __forceinline__ float xhalf_f(float v, bool upper) { return __int_as_float(xhalf_i(__float_as_int(v), upper)); }
__device__ __forceinline__ float wave_sum(float v) {
    v += dppf<DPP_ROR(8)>(v); v += dppf<DPP_ROR(4)>(v); v += dppf<DPP_ROR(2)>(v); v += dppf<DPP_ROR(1)>(v);
    return xrow32_sum(xrow16_sum(v));
}
__device__ __forceinline__ float wave_max(float v) {
    v = fmaxf(v, dppf<DPP_ROR(8)>(v)); v = fmaxf(v, dppf<DPP_ROR(4)>(v)); v = fmaxf(v, dppf<DPP_ROR(2)>(v)); v = fmaxf(v, dppf<DPP_ROR(1)>(v));
    return xrow32_max(xrow16_max(v));
}

struct Params {
    const float *x, *p; const int* pos;
    const float *w_in, *sinks, *conv_w, *conv_b, *cln_g, *cln_b, *w_out, *ln1_g, *ln1_b;
    const float *wq, *keys, *pu, *pv, *ple_proj, *ple_gate, *ln2_g, *ln2_b;
    float* out;
    bf16_t *xb, *pb, *WinT, *WoutT, *WgT, *WpT, *keysb, *Wqb, *MT, *hb, *mixb, *rb;
    float *y1, *gates, *rope, *stats, *wgb;
    bf16_t *y1b, *yext, *mext, *y2b; unsigned* cb2;
    bf16_t* sc2;
    bf16_t* hp;
    int *ids;
    unsigned char *u8, *v8;
    unsigned* bar;
};

__device__ void cvt_rows(const float* __restrict__ src, bf16_t* __restrict__ dst, size_t n) {
    const size_t nv = n / 8, gs = (size_t)gridDim.x * blockDim.x;
    for (size_t i = (size_t)blockIdx.x * blockDim.x + threadIdx.x; i < nv; i += 4 * gs) {
        f32x4 a[4], b[4];
#pragma unroll
        for (int q = 0; q < 4; ++q) { const size_t k = (i + q * gs < nv) ? i + q * gs : i; a[q] = ((const f32x4*)src)[2 * k]; b[q] = ((const f32x4*)src)[2 * k + 1]; }
#pragma unroll
        for (int q = 0; q < 4; ++q) {
            if (i + q * gs < nv) {
                u32x4 o; o[0] = pack2(a[q][0], a[q][1]); o[1] = pack2(a[q][2], a[q][3]); o[2] = pack2(b[q][0], b[q][1]); o[3] = pack2(b[q][2], b[q][3]);
                ((u32x4*)dst)[i + q * gs] = o;
            }
        }
    }
}
__device__ __forceinline__ int win_row(int n) {
    if (n < 768) return n;
    const int isg = n >= 1280 ? 1 : 0, c = n - (isg ? 1280 : 768);
    const int tt = c >> 6, wc = (c >> 5) & 1, k2 = (c >> 4) & 1, rest = c & 15;
    return 768 + 128 * tt + wc * 64 + (k2 * 2 + isg) * 16 + rest;
}
template <bool WIN = false>
__device__ void transpose_cvt(const float* __restrict__ W, bf16_t* __restrict__ Wt, int K, int N, float* tile  ) {
    const int tk = K / 64, tn = N / 64;
    const int tid = threadIdx.x;
    for (int t = blockIdx.x; t < tk * tn; t += gridDim.x) {
        const int k0 = (t / tn) * 64, n0 = (t % tn) * 64;
        f32x4 v[4];
#pragma unroll
        for (int i = 0; i < 4; ++i) v[i] = *(const f32x4*)(W + (size_t)(k0 + (tid >> 4) + 16 * i) * N + n0 + (tid & 15) * 4);
        __syncthreads();
#pragma unroll
        for (int i = 0; i < 4; ++i)
#pragma unroll
            for (int j = 0; j < 4; ++j) tile[((tid >> 4) + 16 * i) * 65 + (tid & 15) * 4 + j] = v[i][j];
        __syncthreads();
        const int n = tid >> 2, kc = (tid & 3) * 16;
        u32x4 o0, o1;
#pragma unroll
        for (int q = 0; q < 4; ++q) {
            o0[q] = pack2(tile[(kc + 2 * q) * 65 + n], tile[(kc + 2 * q + 1) * 65 + n]);
            o1[q] = pack2(tile[(kc + 8 + 2 * q) * 65 + n], tile[(kc + 8 + 2 * q + 1) * 65 + n]);
        }
        const int nd = WIN ? win_row(n0 + n) : n0 + n;
        *(u32x4*)(Wt + (size_t)nd * K + k0 + kc) = o0;
        *(u32x4*)(Wt + (size_t)nd * K + k0 + kc + 8) = o1;
    }
}
__device__ void cvt_wq_fold(const Params& p, unsigned char* smem) {
    for (int i = blockIdx.x * 256 + threadIdx.x; i < DM * 256; i += gridDim.x * 256) {
        const int d = i >> 8, c8 = (i & 255) * 8;
        const float gd = p.ln1_g[d];
        const f32x4 a = *(const f32x4*)(p.wq + (size_t)d * 2048 + c8), b = *(const f32x4*)(p.wq + (size_t)d * 2048 + c8 + 4);
        u32x4 o; o[0] = pack2(a[0] * gd, a[1] * gd); o[1] = pack2(a[2] * gd, a[3] * gd); o[2] = pack2(b[0] * gd, b[1] * gd); o[3] = pack2(b[2] * gd, b[3] * gd);
        *(u32x4*)(p.Wqb + (size_t)d * 2048 + c8) = o;
    }
    float* red = (float*)smem;
    const int lane = threadIdx.x & 63, wid = threadIdx.x >> 6;
    for (int cb = blockIdx.x; cb < 512; cb += gridDim.x) {
        f32x4 sg = {0.f, 0.f, 0.f, 0.f}, sb = {0.f, 0.f, 0.f, 0.f};
#pragma unroll
        for (int q = 0; q < 4; ++q) {
            const int d = threadIdx.x * 4 + q;
            const f32x4 v = *(const f32x4*)(p.wq + (size_t)d * 2048 + cb * 4);
            sg += v * p.ln1_g[d]; sb += v * p.ln1_b[d];
        }
        __syncthreads();
#pragma unroll
        for (int q = 0; q < 4; ++q) {
            const float a = wave_sum(sg[q]), b = wave_sum(sb[q]);
            if (lane == 0) { red[wid * 8 + q] = a; red[wid * 8 + 4 + q] = b; }
        }
        __syncthreads();
        if (threadIdx.x < 8) {
            const float t = (red[threadIdx.x] + red[8 + threadIdx.x]) + (red[16 + threadIdx.x] + red[24 + threadIdx.x]);
            p.wgb[(threadIdx.x >> 2) * 2048 + cb * 4 + (threadIdx.x & 3)] = t;
        }
    }
}
template <bool FOLD>
__device__ void cvt_table_fp8(const Params& p, const float* __restrict__ src, unsigned char* __restrict__ dst, bf16_t* __restrict__ scl, int rows) {
    const int lane = threadIdx.x & 63, wid = threadIdx.x >> 6;
    const int nw = gridDim.x * 4;
    for (int r0 = blockIdx.x * 4 + wid; r0 < rows; r0 += 4 * nw) {
        f32x4 v[4][4];
#pragma unroll
        for (int q = 0; q < 4; ++q) {
            const int r = (r0 + q * nw < rows) ? r0 + q * nw : r0;
            const float* sr = src + (size_t)r * DM + lane * 16;
#pragma unroll
            for (int k = 0; k < 4; ++k) v[q][k] = *(const f32x4*)(sr + 4 * k);
        }
        f32x4 gv[4], bv[4];
        if (FOLD) {
#pragma unroll
            for (int k = 0; k < 4; ++k) { gv[k] = *(const f32x4*)(p.ln1_g + lane * 16 + 4 * k); bv[k] = *(const f32x4*)(p.ln1_b + lane * 16 + 4 * k); }
        }
#pragma unroll
        for (int q = 0; q < 4; ++q) {
            const int r = r0 + q * nw;
            if (FOLD) {
                float cu = 0.f, bu = 0.f;
#pragma unroll
                for (int k = 0; k < 4; ++k) { bu += (bv[k][0] * v[q][k][0] + bv[k][1] * v[q][k][1]) + (bv[k][2] * v[q][k][2] + bv[k][3] * v[q][k][3]); v[q][k] = v[q][k] * gv[k]; cu += (v[q][k][0] + v[q][k][1]) + (v[q][k][2] + v[q][k][3]); }
                cu = wave_sum(cu); bu = wave_sum(bu);
                if (lane == 0 && r < rows) p.cb2[r] = pack2(cu, bu);
            }
            float m = 0.f;
#pragma unroll
            for (int k = 0; k < 4; ++k)
#pragma unroll
                for (int i = 0; i < 4; ++i) m = fmaxf(m, fabsf(v[q][k][i]));
#pragma unroll
            for (int o = 0; o < 1; ++o) m = wave_max(m);
            int ex = (m > 0.f) ? (8 - (int)((__float_as_uint(m) >> 23) & 0xffu) + 127 - ((__float_as_uint(m) & 0x7fffffu) > 0x600000u ? 1 : 0)) : 0;
            ex = min(max(ex, -100), 100);
            const float sc = __uint_as_float((unsigned)(127 + ex) << 23);
            u32x4 w;
#pragma unroll
            for (int k = 0; k < 4; ++k)
                w[k] = __builtin_amdgcn_cvt_pk_fp8_f32(v[q][k][2] * sc, v[q][k][3] * sc, __builtin_amdgcn_cvt_pk_fp8_f32(v[q][k][0] * sc, v[q][k][1] * sc, 0, false), true);
            if (r < rows) {
                *(u32x4*)(dst + (size_t)(lane >> 3) * (16384 * 128) + (size_t)r * 128 + (lane & 7) * 16) = w;
                if (lane == 0) scl[2 * r] = (bf16_t)(((unsigned)(127 - ex) << 23) >> 16);
            }
        }
    }
}
__device__ void ph_tables(const Params& p, unsigned char* smem) {
    float* tile = (float*)smem;
    __syncthreads();
    cvt_table_fp8<true>(p, p.pu, p.u8, p.sc2, 16384);
    cvt_table_fp8<false>(p, p.pv, p.v8, p.sc2 + 1, 16384);
    cvt_rows(p.p, p.pb, (size_t)T_TOK * 256);
    cvt_rows(p.keys, p.keysb, (size_t)16 * 128 * 128);
    transpose_cvt(p.w_out, p.WoutT, DM, DM, tile);
    cvt_wq_fold(p, smem);
    transpose_cvt(p.ple_gate, p.WgT, DM, DM, tile);
    transpose_cvt(p.ple_proj, p.WpT, 256, DM, tile);
    __syncthreads();
}
__device__ void ph_prep(const Params& p, unsigned char* smem) {
    float* tile = (float*)smem;
    cvt_rows(p.x, p.xb, (size_t)T_TOK * DM);
    for (int i = blockIdx.x * 256 + threadIdx.x; i < T_TOK * 8; i += gridDim.x * 256) {
        const int t = i >> 3, j = i & 7;
        const float inv = powf(500000.0f, -(float)j * 0.125f);
        float sn, cs; sincosf((float)p.pos[t] * inv, &sn, &cs);
        p.rope[t * 16 + j] = cs; p.rope[t * 16 + 8 + j] = sn;
    }
    transpose_cvt<true>(p.w_in, p.WinT, DM, INW, tile);
}

#define LDS_AS __attribute__((address_space(3)))
#define GEMM_STAGE 32768
template <bool PRE = false, bool NEXT = false>
__device__ __forceinline__ void gemm128(const bf16_t* __restrict__ A, int lda, const bf16_t* __restrict__ Bt, int ldb, int K,
                                        unsigned char* smem, f32x4 (&acc)[4][4],
                                        const bf16_t* __restrict__ nA = nullptr, int nlda = 0, const bf16_t* __restrict__ nB = nullptr, int nldb = 0) {
    LDS_AS unsigned char* lds = (LDS_AS unsigned char*)smem;
    const int tid = threadIdx.x, lane = tid & 63, wid = __builtin_amdgcn_readfirstlane(tid >> 6);
    const int wr = wid >> 1, wc = wid & 1, fr = lane & 15, fq = lane >> 4;
    const int nk = K / 64;
    const int prow = lane >> 3, pc = (lane & 7) ^ prow;
    const bf16_t* gA = A + (size_t)(wid * 32 + prow) * lda + pc * 8;
    const bf16_t* gB = Bt + (size_t)(wid * 32 + prow) * ldb + pc * 8;
    const size_t a8 = (size_t)8 * lda, b8 = (size_t)8 * ldb;
#define GEMM_ISSUE(kt, st) do {   \
        _Pragma("unroll") for (int _i = 0; _i < 4; ++_i) \
            __builtin_amdgcn_global_load_lds((const unsigned*)(gA + _i * a8 + (size_t)(kt) * 64), (LDS_AS unsigned*)(lds + (st) * GEMM_STAGE + (wid * 4 + _i) * 1024), 16, 0, 0); \
        _Pragma("unroll") for (int _i = 0; _i < 4; ++_i) \
            __builtin_amdgcn_global_load_lds((const unsigned*)(gB + _i * b8 + (size_t)(kt) * 64), (LDS_AS unsigned*)(lds + (st) * GEMM_STAGE + 16384 + (wid * 4 + _i) * 1024), 16, 0, 0); \
        } while (0)
    const int swz0 = ((0 * 4 + fq) ^ (fr & 7)) * 16, swz1 = ((1 * 4 + fq) ^ (fr & 7)) * 16;
    const int aoff = (wr * 64 + fr) * 128, boff = 16384 + (wc * 64 + fr) * 128;
    if (!PRE) GEMM_ISSUE(0, 0);
#pragma unroll 1
    for (int kt = 0; kt < nk; ++kt) {
        const int st = kt & 1;
        asm volatile("s_waitcnt vmcnt(0)" ::: "memory");
        __builtin_amdgcn_s_barrier();
        asm volatile("" ::: "memory");
        if (kt + 1 < nk) GEMM_ISSUE(kt + 1, st ^ 1);
        else if (NEXT) {
            const bf16_t* qA = nA + (size_t)(wid * 32 + prow) * nlda + pc * 8;
            const bf16_t* qB = nB + (size_t)(wid * 32 + prow) * nldb + pc * 8;
#pragma unroll
            for (int _i = 0; _i < 4; ++_i) {
                __builtin_amdgcn_global_load_lds((const unsigned*)(qA + (size_t)(_i * 8) * nlda), (LDS_AS unsigned*)(lds + (wid * 4 + _i) * 1024), 16, 0, 0);
                __builtin_amdgcn_global_load_lds((const unsigned*)(qB + (size_t)(_i * 8) * nldb), (LDS_AS unsigned*)(lds + 16384 + (wid * 4 + _i) * 1024), 16, 0, 0);
            }
        }
        __builtin_amdgcn_s_setprio(1);
        const LDS_AS unsigned char* sb = lds + st * GEMM_STAGE;
        bf16x8 af0[4], bf0[4], af1[4], bf1[4];
#pragma unroll
        for (int mi = 0; mi < 4; ++mi) af0[mi] = *(const LDS_AS bf16x8*)(sb + aoff + mi * 2048 + swz0);
#pragma unroll
        for (int ni = 0; ni < 4; ++ni) bf0[ni] = *(const LDS_AS bf16x8*)(sb + boff + ni * 2048 + swz0);
#pragma unroll
        for (int mi = 0; mi < 4; ++mi) af1[mi] = *(const LDS_AS bf16x8*)(sb + aoff + mi * 2048 + swz1);
#pragma unroll
        for (int ni = 0; ni < 4; ++ni) bf1[ni] = *(const LDS_AS bf16x8*)(sb + boff + ni * 2048 + swz1);
#pragma unroll
        for (int mi = 0; mi < 4; ++mi)
#pragma unroll
            for (int ni = 0; ni < 4; ++ni)
                acc[mi][ni] = __builtin_amdgcn_mfma_f32_16x16x32_bf16(bf0[ni], af0[mi], acc[mi][ni], 0, 0, 0);
#pragma unroll
        for (int mi = 0; mi < 4; ++mi)
#pragma unroll
            for (int ni = 0; ni < 4; ++ni)
                acc[mi][ni] = __builtin_amdgcn_mfma_f32_16x16x32_bf16(bf1[ni], af1[mi], acc[mi][ni], 0, 0, 0);
        __builtin_amdgcn_sched_group_barrier(0x100, 8, 0);
#pragma unroll
        for (int q = 0; q < 8; ++q) { __builtin_amdgcn_sched_group_barrier(0x008, 2, 0); __builtin_amdgcn_sched_group_barrier(0x100, 1, 0); }
        __builtin_amdgcn_sched_group_barrier(0x008, 16, 0);
        __builtin_amdgcn_s_setprio(0);
        asm volatile("s_waitcnt lgkmcnt(0)" ::: "memory");
        __builtin_amdgcn_s_barrier();
        asm volatile("" ::: "memory");
    }
#undef GEMM_ISSUE
}
#define GW_STAGE 24576
__device__ __forceinline__ void gemmW(const bf16_t* __restrict__ A, int lda, const bf16_t* __restrict__ Bt, int ldb, int K,
                                      unsigned char* smem, f32x4 (&acc)[4][8]) {
    LDS_AS unsigned char* lds = (LDS_AS unsigned char*)smem;
    const int tid = threadIdx.x, lane = tid & 63, wid = __builtin_amdgcn_readfirstlane(tid >> 6);
    const int wr = wid >> 1, wc = wid & 1, fr = lane & 15, fq = lane >> 4;
    const int nk = K / 32;
    const int prow = lane >> 2, pc = (lane & 3) ^ ((4 - ((prow >> 2) & 3)) & 3);
    const bf16_t* gA = A + (size_t)(wid * 32 + prow) * lda + pc * 8;
    const bf16_t* gB = Bt + (size_t)(wid * 64 + prow) * ldb + pc * 8;
    const size_t a16 = (size_t)16 * lda, b16 = (size_t)16 * ldb;
#define GW_ISSUE(kt, st) do { \
        _Pragma("unroll") for (int _i = 0; _i < 2; ++_i) \
            __builtin_amdgcn_global_load_lds((const unsigned*)(gA + _i * a16 + (size_t)(kt) * 32), (LDS_AS unsigned*)(lds + (st) * GW_STAGE + (wid * 2 + _i) * 1024), 16, 0, 0); \
        _Pragma("unroll") for (int _i = 0; _i < 4; ++_i) \
            __builtin_amdgcn_global_load_lds((const unsigned*)(gB + _i * b16 + (size_t)(kt) * 32), (LDS_AS unsigned*)(lds + (st) * GW_STAGE + 8192 + (wid * 4 + _i) * 1024), 16, 0, 0); \
        } while (0)
    const int swz = (fq ^ ((4 - ((fr >> 2) & 3)) & 3)) * 16;
    const int aoff = (wr * 64 + fr) * 64 + swz, boff = 8192 + (wc * 128 + fr) * 64 + swz;
    GW_ISSUE(0, 0);
#pragma unroll 1
    for (int kt = 0; kt < nk; ++kt) {
        const int st = kt & 1;
        asm volatile("s_waitcnt vmcnt(0)" ::: "memory");
        __builtin_amdgcn_s_barrier();
        asm volatile("" ::: "memory");
        if (kt + 1 < nk) GW_ISSUE(kt + 1, st ^ 1);
        const LDS_AS unsigned char* sb = lds + st * GW_STAGE;
        __builtin_amdgcn_s_setprio(1);
        bf16x8 af[4], bfr[8];
#pragma unroll
        for (int mi = 0; mi < 4; ++mi) af[mi] = *(const LDS_AS bf16x8*)(sb + aoff + mi * 1024);
#pragma unroll
        for (int ni = 0; ni < 8; ++ni) bfr[ni] = *(const LDS_AS bf16x8*)(sb + boff + ni * 1024);
#pragma unroll
        for (int ni = 0; ni < 8; ++ni)
#pragma unroll
            for (int mi = 0; mi < 4; ++mi)
                acc[mi][ni] = __builtin_amdgcn_mfma_f32_16x16x32_bf16(bfr[ni], af[mi], acc[mi][ni], 0, 0, 0);
        __builtin_amdgcn_s_setprio(0);
        asm volatile("s_waitcnt lgkmcnt(0)" ::: "memory");
        __builtin_amdgcn_s_barrier();
        asm volatile("" ::: "memory");
    }
#undef GW_ISSUE
}
__device__ __forceinline__ void zero_accw(f32x4 (&acc)[4][8]) {
#pragma unroll
    for (int a = 0; a < 4; ++a)
#pragma unroll
        for (int b = 0; b < 8; ++b) acc[a][b] = (f32x4){0.f, 0.f, 0.f, 0.f};
}
__device__ __forceinline__ void zero_acc(f32x4 (&acc)[4][4]) {
#pragma unroll
    for (int a = 0; a < 4; ++a)
#pragma unroll
        for (int b = 0; b < 4; ++b) acc[a][b] = (f32x4){0.f, 0.f, 0.f, 0.f};
}
#define GEMM_SMEM (2 * GEMM_STAGE)

__device__ void ph_gemm_in(const Params& p, unsigned char* smem, const int vb) {
    const int ntn = INW / 128;
    const int tid = threadIdx.x, lane = tid & 63, wid = tid >> 6, wr = wid >> 1, wc = wid & 1, fr = lane & 15, fq = lane >> 4;
    const int ntiles = (T_TOK / 128) * ntn;
    bool pre = false;
    for (int t = vb; t < ntiles; t += gridDim.x) {
        const int m0 = (t / ntn) * 128, n0 = (t % ntn) * 128;
        const int tn = t + gridDim.x;
        const bool has_next = tn < ntiles;
        const bf16_t* nA = p.xb + (size_t)((has_next ? tn : t) / ntn) * 128 * DM;
        const bf16_t* nB = p.WinT + (size_t)((has_next ? tn : t) % ntn) * 128 * DM;
        f32x4 acc[4][4]; zero_acc(acc);
        if (pre) { if (has_next) gemm128<true, true>(p.xb + (size_t)m0 * DM, DM, p.WinT + (size_t)n0 * DM, DM, DM, smem, acc, nA, DM, nB, DM);
                   else          gemm128<true, false>(p.xb + (size_t)m0 * DM, DM, p.WinT + (size_t)n0 * DM, DM, DM, smem, acc); }
        else     { if (has_next) gemm128<false, true>(p.xb + (size_t)m0 * DM, DM, p.WinT + (size_t)n0 * DM, DM, DM, smem, acc, nA, DM, nB, DM);
                   else          gemm128<false, false>(p.xb + (size_t)m0 * DM, DM, p.WinT + (size_t)n0 * DM, DM, DM, smem, acc); }
        pre = has_next;
        if (n0 >= 768) {
            const int cb = ((n0 - 768) >> 7) * 64 + wc * 32 + (fq & 1) * 16 + (fq & 2) * 4;
#pragma unroll
            for (int mi = 0; mi < 4; ++mi) {
                const int row = m0 + wr * 64 + mi * 16 + fr;
                uint2 o[2];
#pragma unroll
                for (int k2 = 0; k2 < 2; ++k2) {
                    const f32x4 a = acc[mi][2 * k2], gt = acc[mi][2 * k2 + 1];
                    o[k2].x = pack2(sigmul(a[0], gt[0]), sigmul(a[1], gt[1])); o[k2].y = pack2(sigmul(a[2], gt[2]), sigmul(a[3], gt[3]));
                }
                const auto t0 = __builtin_amdgcn_permlane16_swap(o[0].x, o[1].x, false, false), t1 = __builtin_amdgcn_permlane16_swap(o[0].y, o[1].y, false, false);
                *(u32x4*)(p.hb + (size_t)row * INW + 768 + cb) = (u32x4){t0[0], t1[0], t0[1], t1[1]};
            }
        } else {
#pragma unroll
        for (int mi = 0; mi < 4; ++mi) {
            const int row = m0 + wr * 64 + mi * 16 + fr;
            uint2 og[4];
#pragma unroll
            for (int ni = 0; ni < 4; ++ni) {
                const int col0 = n0 + wc * 64 + ni * 16;
                f32x4 v = acc[mi][ni];
                if (col0 < 640 && (col0 & 63) == 0) {
                    const f32x4 cs = *(const f32x4*)(p.rope + (size_t)row * 16 + (fq & 1) * 4), sn = *(const f32x4*)(p.rope + (size_t)row * 16 + 8 + (fq & 1) * 4);
#pragma unroll
                    for (int r = 0; r < 4; ++r) {
                        const float other = xhalf_f(v[r], fq >= 2);
                        v[r] = (fq < 2) ? (v[r] * cs[r] - other * sn[r]) : (v[r] * cs[r] + other * sn[r]);
                    }
                }
                og[ni].x = pack2(v[0], v[1]); og[ni].y = pack2(v[2], v[3]);
            }
#pragma unroll
            for (int k = 0; k < 2; ++k) {
                const auto t0 = __builtin_amdgcn_permlane16_swap(og[2 * k].x, og[2 * k + 1].x, false, false), t1 = __builtin_amdgcn_permlane16_swap(og[2 * k].y, og[2 * k + 1].y, false, false);
                *(u32x4*)(p.hb + (size_t)row * INW + n0 + wc * 64 + k * 32 + (fq & 1) * 16 + (fq & 2) * 4) = (u32x4){t0[0], t1[0], t0[1], t1[1]};
            }
        }
        }
    }
}

#define ASTR 72
#define VSTR 260
typedef float f32x16 __attribute__((ext_vector_type(16)));
typedef unsigned u32x2 __attribute__((ext_vector_type(2)));
__device__ void ph_attn(const Params& p, unsigned char* smem, const int vb) {
    bf16_t* sK = (bf16_t*)smem;
    bf16_t* sVt = sK + 256 * ASTR;
    const int tid = threadIdx.x, lane = tid & 63, wid = tid >> 6, r32 = lane & 31, hh = lane >> 5;
    const float C1 = 0.125f * 1.4426950408889634f, LOG2E = 1.4426950408889634f;
    for (int u = vb; u < 16 * 16 * 2; u += gridDim.x) {
        const int kvh = u & 1, nb = (u >> 1) & 15, b = u >> 5;
        __syncthreads();
        {
            u32x4 kv[8], vv[8];
#pragma unroll
            for (int it = 0; it < 8; ++it) {
                const int c = tid + it * 256, li = c >> 3, kc = c & 7;
                const int pos = nb * 128 - 128 + li;
                const bf16_t* base = p.hb + (size_t)(b * SEQ + (pos >= 0 ? pos : 0)) * INW;
                kv[it] = *(const u32x4*)(base + 512 + kvh * 64 + kc * 8);
                vv[it] = *(const u32x4*)(base + 640 + kvh * 64 + kc * 8);
            }
#pragma unroll
            for (int it = 0; it < 8; ++it) {
                const int c = tid + it * 256, li = c >> 3, kc = c & 7;
                const bool ok = nb * 128 - 128 + li >= 0;
                const u32x4 z = {0u, 0u, 0u, 0u};
                const u32x4 kq = ok ? kv[it] : z, vq = ok ? vv[it] : z;
                *(u32x4*)(sK + li * ASTR + kc * 8) = kq;
#pragma unroll
                for (int i = 0; i < 4; ++i) {
                    sVt[(kc * 8 + 2 * i) * VSTR + li] = (bf16_t)(vq[i] & 0xffffu);
                    sVt[(kc * 8 + 2 * i + 1) * VSTR + li] = (bf16_t)(vq[i] >> 16);
                }
            }
        }
        __syncthreads();
        const int hq = kvh * 4 + wid;
        const float sink2 = p.sinks[hq] * LOG2E;
        bf16x8 qn[4];
        {
            const size_t tr0 = (size_t)(b * SEQ + nb * 128 + r32);
#pragma unroll
            for (int ks = 0; ks < 4; ++ks) qn[ks] = *(const bf16x8*)(p.hb + tr0 * INW + hq * 64 + ks * 16 + hh * 8);
        }
#pragma unroll 1
        for (int qt = 0; qt < 4; ++qt) {
            const size_t trow = (size_t)(b * SEQ + nb * 128 + qt * 32 + r32);
            bf16x8 qf[4];
#pragma unroll
            for (int ks = 0; ks < 4; ++ks) qf[ks] = qn[ks];
            {
                const size_t trn = (size_t)(b * SEQ + nb * 128 + (qt < 3 ? qt + 1 : qt) * 32 + r32);
#pragma unroll
                for (int ks = 0; ks < 4; ++ks) qn[ks] = *(const bf16x8*)(p.hb + trn * INW + hq * 64 + ks * 16 + hh * 8);
            }
            f32x16 S[5];
#pragma unroll
            for (int j = 0; j < 5; ++j) {
#pragma unroll
                for (int r = 0; r < 16; ++r) S[j][r] = 0.f;
#pragma unroll
                for (int ks = 0; ks < 4; ++ks) {
                    const bf16x8 a = *(const bf16x8*)(sK + ((qt + j) * 32 + r32) * ASTR + ks * 16 + hh * 8);
                    S[j] = __builtin_amdgcn_mfma_f32_32x32x16_bf16(a, qf[ks], S[j], 0, 0, 0);
                }
            }
            float mr = -3.0e38f;
#pragma unroll
            for (int j = 0; j < 5; ++j) {
                const bool tile_ok = (nb > 0) || (qt + j >= 4);
#pragma unroll
                for (int r = 0; r < 16; ++r) {
                    if (j == 0 || j == 4) {
                        const int kl = (r & 3) + 8 * (r >> 2) + 4 * hh;
                        const bool ok = tile_ok && (j == 0 ? (kl > r32) : (kl <= r32));
                        S[j][r] = ok ? S[j][r] : -3.0e38f;
                    } else if (!tile_ok) S[j][r] = -3.0e38f;
                    mr = fmaxf(mr, S[j][r]);
                }
            }
            mr = xrow32_max(mr);
            const float m2 = fmaxf(mr * C1, sink2);
            float l = 0.f;
#pragma unroll
            for (int j = 0; j < 5; ++j)
#pragma unroll
                for (int r = 0; r < 16; ++r) { const float e = __builtin_amdgcn_exp2f(fmaf(S[j][r], C1, -m2)); S[j][r] = e; l += e; }
            l = xrow32_sum(l);
            l += __builtin_amdgcn_exp2f(sink2 - m2);
            f32x16 O[2];
#pragma unroll
            for (int dt = 0; dt < 2; ++dt)
#pragma unroll
                for (int r = 0; r < 16; ++r) O[dt][r] = 0.f;
#pragma unroll
            for (int j = 0; j < 5; ++j)
#pragma unroll
                for (int s2 = 0; s2 < 2; ++s2) {
                    u32x4 pw;
#pragma unroll
                    for (int k = 0; k < 4; ++k) pw[k] = pack2(S[j][8 * s2 + 2 * k], S[j][8 * s2 + 2 * k + 1]);
                    const bf16x8 pf = __builtin_bit_cast(bf16x8, pw);
                    const int kbase = (qt + j) * 32 + 16 * s2 + 4 * hh;
#pragma unroll
                    for (int dt = 0; dt < 2; ++dt) {
                        const bf16_t* vp = sVt + (dt * 32 + r32) * VSTR + kbase;
                        const u32x2 v0 = *(const u32x2*)(vp), v1 = *(const u32x2*)(vp + 8);
                        const u32x4 vw = {v0[0], v0[1], v1[0], v1[1]};
                        O[dt] = __builtin_amdgcn_mfma_f32_32x32x16_bf16(__builtin_bit_cast(bf16x8, vw), pf, O[dt], 0, 0, 0);
                    }
                }
            const float il = __builtin_amdgcn_rcpf(l);
#pragma unroll
            for (int dt = 0; dt < 2; ++dt)
#pragma unroll
                for (int g = 0; g < 4; ++g) {
                    u32x2 w;
                    w[0] = pack2(O[dt][4 * g] * il, O[dt][4 * g + 1] * il);
                    w[1] = pack2(O[dt][4 * g + 2] * il, O[dt][4 * g + 3] * il);
                    *(u32x2*)(p.mixb + trow * DM + hq * 64 + dt * 32 + 8 * g + 4 * hh) = w;
                }
        }
    }
}

#define CV_ROWS 62
__device__ void ph_conv(const Params& p, unsigned char* smem, const int vb) {
    bf16_t* gl = (bf16_t*)smem;
    float* red = (float*)(smem + CV_ROWS * 1024);
    const int tid = threadIdx.x, lane = tid & 63, wid = tid >> 6;
    const f32x2 lg = *(const f32x2*)(p.cln_g + 2 * tid), lb = *(const f32x2*)(p.cln_b + 2 * tid);
    for (int u = vb; u < T_TOK / 32; u += gridDim.x) {
        const int tok0 = u * 32, s0 = tok0 & (SEQ - 1);
        __syncthreads();
#pragma unroll 1
        for (int bt = 0; bt < 2; ++bt) {
            u32x4 av[8];
#pragma unroll
            for (int it = 0; it < 8; ++it) {
                const int ch = tid + (bt * 8 + it) * 256, row = min(ch >> 6, CV_ROWS - 1), k = ch & 63;
                const int rr = (s0 - 30 + row >= 0) ? row : 30;
                av[it] = *(const u32x4*)(p.hb + (size_t)(tok0 - 30 + rr) * INW + 768 + k * 8);
            }
#pragma unroll
            for (int it = 0; it < 8; ++it) {
                const int ch = tid + (bt * 8 + it) * 256, row = ch >> 6, k = ch & 63;
                const bool ok = (s0 - 30 + row >= 0);
                const u32x4 o = ok ? av[it] : (u32x4){0u, 0u, 0u, 0u};
                if (row < CV_ROWS) *(u32x4*)(gl + row * 512 + k * 8) = o;
            }
        }
        __syncthreads();
        float w0[31], w1[31];
#pragma unroll
        for (int k = 0; k < 31; ++k) { const f32x2 wv = *(const f32x2*)(p.conv_w + k * 512 + 2 * tid); w0[k] = wv.x; w1[k] = wv.y; }
        const f32x2 bias = *(const f32x2*)(p.conv_b + 2 * tid);
#pragma unroll 1
        for (int jh = 0; jh < 2; ++jh) {
            float a0[16], a1[16];
#pragma unroll
            for (int jl = 0; jl < 16; ++jl) { a0[jl] = bias.x; a1[jl] = bias.y; }
            const bf16_t* gp = gl + (jh * 16) * 512 + 2 * tid;
            unsigned gq[2][4];
#pragma unroll
            for (int q = 0; q < 4; ++q) gq[0][q] = *(const unsigned*)(gp + q * 512);
#pragma unroll
            for (int g = 0; g < 12; ++g) {
                if (g < 11) {
#pragma unroll
                    for (int q = 0; q < 4; ++q) { const int il = (g + 1) * 4 + q; if (il < 46) gq[(g + 1) & 1][q] = *(const unsigned*)(gp + il * 512); }
                }
                __builtin_amdgcn_sched_barrier(0);
#pragma unroll
                for (int q = 0; q < 4; ++q) {
                    const int il = g * 4 + q;
                    if (il < 46) {
                        const unsigned gw = gq[g & 1][q];
                        const float g0 = bflo(gw), g1 = bfhi(gw);
#pragma unroll
                        for (int jl = 0; jl < 16; ++jl)
                            if (il - jl >= 0 && il - jl <= 30) { a0[jl] += w0[il - jl] * g0; a1[jl] += w1[il - jl] * g1; }
                    }
                }
                __builtin_amdgcn_sched_barrier(0);
            }
            float v[32];
#pragma unroll
            for (int jl = 0; jl < 16; ++jl) { v[jl] = a0[jl] + a1[jl]; v[16 + jl] = a0[jl] * a0[jl] + a1[jl] * a1[jl]; }
#pragma unroll
            for (int i2 = 0; i2 < 16; ++i2) {
                const auto r = __builtin_amdgcn_permlane16_swap(__float_as_uint(v[i2]), __float_as_uint(v[i2 + 16]), false, false);
                v[i2] = __uint_as_float(r[0]) + __uint_as_float(r[1]);
            }
#pragma unroll
            for (int st = 8; st >= 1; st >>= 1) {
                const bool up = (lane & st) != 0;
#pragma unroll
                for (int i2 = 0; i2 < st; ++i2) {
                    const float keep = up ? v[i2 + st] : v[i2], send = up ? v[i2] : v[i2 + st];
                    const float got = st == 8 ? dppf<DPP_ROR(8)>(send) : (st == 2 ? dppf<DPP_XOR2>(send) : (st == 1 ? dppf<DPP_XOR1>(send) : dppf<0x1B>(dppf<0x141>(send))));
                    v[i2] = keep + got;
                }
            }
            const float tot = xrow32_sum(v[0]);
            __syncthreads();
            if (lane < 32) red[wid * 32 + lane] = tot;
            __syncthreads();
#pragma unroll
            for (int jl = 0; jl < 16; ++jl) {
                const float sm = (red[jl] + red[32 + jl]) + (red[64 + jl] + red[96 + jl]);
                const float sq = (red[16 + jl] + red[48 + jl]) + (red[80 + jl] + red[112 + jl]);
                const float mu = sm * (1.0f / 512.0f);
                const float rstd = rsqrtf(fmaxf(sq * (1.0f / 512.0f) - mu * mu, 0.f) + LN_EPS);
                const float y0 = (a0[jl] - mu) * rstd * lg.x + lb.x, y1 = (a1[jl] - mu) * rstd * lg.y + lb.y;
                *(unsigned*)(p.mixb + (size_t)(tok0 + jh * 16 + jl) * DM + 512 + 2 * tid) = pack2(sigmul(y0, y0), sigmul(y1, y1));
            }
        }
    }
}

__device__ void ph_gemm_out(const Params& p, unsigned char* smem, const int vb) {
    const int ntn = DM / 256;
    const int tid = threadIdx.x, lane = tid & 63, wid = tid >> 6, wr = wid >> 1, wc = wid & 1, fr = lane & 15, fq = lane >> 4;
    for (int t = vb; t < (T_TOK / 128) * ntn; t += gridDim.x) {
        const int m0 = (t / ntn) * 128, n0 = (t % ntn) * 256;
        f32x4 acc[4][8]; zero_accw(acc);
        u32x4 xq[2][4];
        const int cpair = (fq & 1) * 16 + (fq & 2) * 4;
#define GO_XLD(mi, buf) do { const int _row = m0 + wr * 64 + (mi) * 16 + fr; \
            _Pragma("unroll") for (int _k = 0; _k < 4; ++_k) xq[buf][_k] = *(const u32x4*)(p.xb + (size_t)_row * DM + n0 + wc * 128 + _k * 32 + cpair); } while (0)
        gemmW(p.mixb + (size_t)m0 * DM, DM, p.WoutT + (size_t)n0 * DM, DM, DM, smem, acc);
        GO_XLD(0, 0);
#pragma unroll
        for (int mi = 0; mi < 4; ++mi) {
            const int row = m0 + wr * 64 + mi * 16 + fr;
            if (mi < 3) GO_XLD(mi + 1, (mi + 1) & 1);
            float sm = 0.f, sq = 0.f;
#pragma unroll
            for (int k = 0; k < 4; ++k) {
                const u32x4 xl = xq[mi & 1][k];
                const auto s0 = __builtin_amdgcn_permlane16_swap(xl[0], xl[2], false, false), s1 = __builtin_amdgcn_permlane16_swap(xl[1], xl[3], false, false);
                const f32x4 xa = {bflo(s0[0]), bfhi(s0[0]), bflo(s1[0]), bfhi(s1[0])}, xb2 = {bflo(s0[1]), bfhi(s0[1]), bflo(s1[1]), bfhi(s1[1])};
                const f32x4 ya = xa * ALPHA + acc[mi][2 * k], yb = xb2 * ALPHA + acc[mi][2 * k + 1];
                sm += ((ya[0] + ya[1]) + (ya[2] + ya[3])) + ((yb[0] + yb[1]) + (yb[2] + yb[3]));
                sq += ((ya[0] * ya[0] + ya[1] * ya[1]) + (ya[2] * ya[2] + ya[3] * ya[3])) + ((yb[0] * yb[0] + yb[1] * yb[1]) + (yb[2] * yb[2] + yb[3] * yb[3]));
                const auto t0 = __builtin_amdgcn_permlane16_swap(pack2(ya[0], ya[1]), pack2(yb[0], yb[1]), false, false);
                const auto t1 = __builtin_amdgcn_permlane16_swap(pack2(ya[2], ya[3]), pack2(yb[2], yb[3]), false, false);
                *(u32x4*)(p.y1b + (size_t)row * DM + n0 + wc * 128 + k * 32 + cpair) = (u32x4){t0[0], t1[0], t0[1], t1[1]};
            }
            sm = xrow32_sum(xrow16_sum(sm)); sq = xrow32_sum(xrow16_sum(sq));
            if (fq == 0) *(f32x2*)(p.stats + (size_t)row * 16 + ((n0 >> 8) * 2 + wc) * 2) = (f32x2){sm, sq};
        }
    }
}

__device__ __forceinline__ void ln_row(const float* __restrict__ src, const float* __restrict__ g, const float* __restrict__ bta,
                                       float* __restrict__ dstf, bf16_t* __restrict__ dstb, int lane) {
    f32x4 v[4]; float s = 0.f;
#pragma unroll
    for (int i = 0; i < 4; ++i) { v[i] = *(const f32x4*)(src + i * 256 + lane * 4); s += (v[i][0] + v[i][1]) + (v[i][2] + v[i][3]); }
    const float mu = wave_sum(s) * (1.0f / 1024.0f);
    float q = 0.f;
#pragma unroll
    for (int i = 0; i < 4; ++i) { const f32x4 d = v[i] - mu; q += (d[0] * d[0] + d[1] * d[1]) + (d[2] * d[2] + d[3] * d[3]); }
    const float rstd = rsqrtf(wave_sum(q) * (1.0f / 1024.0f) + LN_EPS);
#pragma unroll
    for (int i = 0; i < 4; ++i) {
        const f32x4 gg = *(const f32x4*)(g + i * 256 + lane * 4), bb = *(const f32x4*)(bta + i * 256 + lane * 4);
        const f32x4 y = (v[i] - mu) * rstd * gg + bb;
        if (dstf) *(f32x4*)(dstf + i * 256 + lane * 4) = y;
        if (dstb) { uint2 o; o.x = pack2(y[0], y[1]); o.y = pack2(y[2], y[3]); *(uint2*)(dstb + i * 256 + lane * 4) = o; }
    }
}
__device__ void ph_ln2(const Params& p, const int vb) {
    const int lane = threadIdx.x & 63, wid = threadIdx.x >> 6;
    for (int r = vb * 4 + wid; r < T_TOK; r += gridDim.x * 4) {
        const bf16_t* src = p.y2b + (size_t)r * DM;
        f32x4 v[4]; float s = 0.f;
#pragma unroll
        for (int i = 0; i < 4; ++i) {
            const u32x2 w = *(const u32x2*)(src + i * 256 + lane * 4);
            v[i] = (f32x4){bflo(w[0]), bfhi(w[0]), bflo(w[1]), bfhi(w[1])};
            s += (v[i][0] + v[i][1]) + (v[i][2] + v[i][3]);
        }
        const float mu = wave_sum(s) * (1.0f / 1024.0f);
        float q = 0.f;
#pragma unroll
        for (int i = 0; i < 4; ++i) { const f32x4 d = v[i] - mu; q += (d[0] * d[0] + d[1] * d[1]) + (d[2] * d[2] + d[3] * d[3]); }
        const float rstd = rsqrtf(wave_sum(q) * (1.0f / 1024.0f) + LN_EPS);
        float* dst = p.out + (size_t)r * DM;
#pragma unroll
        for (int i = 0; i < 4; ++i) {
            const f32x4 gg = *(const f32x4*)(p.ln2_g + i * 256 + lane * 4), bb = *(const f32x4*)(p.ln2_b + i * 256 + lane * 4);
            __builtin_nontemporal_store((v[i] - mu) * rstd * gg + bb, (f32x4*)(dst + i * 256 + lane * 4));
        }
    }
}

#define QSTR 136
__device__ __forceinline__ int f2key(float f) { return __float_as_int(f); }
__device__ __forceinline__ float key2f(int k) { return __int_as_float(k); }
__device__ __forceinline__ int kmax(int a, int b) { return __float_as_int(fmaxf(__int_as_float(a), __int_as_float(b))); }
__device__ __forceinline__ int kmin(int a, int b) { return __float_as_int(fminf(__int_as_float(a), __int_as_float(b))); }
#define KPAD ((int)0xFF800000)
#define S16_CE(i, j) { const int _hi = kmax(a[i], a[j]), _lo = kmin(a[i], a[j]); a[i] = _hi; a[j] = _lo; }
__device__ __forceinline__ void sort16_desc(int (&a)[16]) {
    S16_CE(0, 13) S16_CE(1, 12) S16_CE(2, 15) S16_CE(3, 14) S16_CE(4, 8) S16_CE(5, 6) S16_CE(7, 11) S16_CE(9, 10)
    S16_CE(0, 5) S16_CE(1, 7) S16_CE(2, 9) S16_CE(3, 4) S16_CE(6, 13) S16_CE(8, 14) S16_CE(10, 15) S16_CE(11, 12)
    S16_CE(0, 1) S16_CE(2, 3) S16_CE(4, 5) S16_CE(6, 8) S16_CE(7, 9) S16_CE(10, 11) S16_CE(12, 13) S16_CE(14, 15)
    S16_CE(0, 2) S16_CE(1, 3) S16_CE(4, 10) S16_CE(5, 11) S16_CE(6, 7) S16_CE(8, 9) S16_CE(12, 14) S16_CE(13, 15)
    S16_CE(1, 2) S16_CE(3, 12) S16_CE(4, 6) S16_CE(5, 7) S16_CE(8, 10) S16_CE(9, 11) S16_CE(13, 14)
    S16_CE(1, 4) S16_CE(2, 6) S16_CE(5, 8) S16_CE(7, 10) S16_CE(9, 13) S16_CE(11, 14)
    S16_CE(2, 4) S16_CE(3, 6) S16_CE(9, 12) S16_CE(11, 13)
    S16_CE(3, 5) S16_CE(6, 8) S16_CE(7, 9) S16_CE(10, 12)
    S16_CE(3, 4) S16_CE(5, 6) S16_CE(7, 8) S16_CE(9, 10) S16_CE(11, 12)
    S16_CE(6, 7) S16_CE(8, 9)
}
#undef S16_CE
__device__ __forceinline__ void merge_top16(int (&a)[16], const int (&b)[16]) {
#pragma unroll
    for (int i = 0; i < 16; ++i) a[i] = kmax(a[i], b[15 - i]);
#pragma unroll
    for (int lj = 3; lj >= 0; --lj) {
        const int j = 1 << lj;
#pragma unroll
        for (int i = 0; i < 16; ++i) {
            const int l = i ^ j;
            if (l > i) { const int hi = kmax(a[i], a[l]), lo = kmin(a[i], a[l]); a[i] = hi; a[l] = lo; }
        }
    }
}
__device__ __forceinline__ void top16_of_64(int (&v)[4][16]) {
    sort16_desc(v[0]); sort16_desc(v[1]); sort16_desc(v[2]); sort16_desc(v[3]);
    merge_top16(v[0], v[1]); merge_top16(v[0], v[2]); merge_top16(v[0], v[3]);
}

__device__ void ph_mprep(const Params& p, unsigned char* smem, const int vb) {
    {
        const int ln = threadIdx.x & 63, wv = threadIdx.x >> 6;
        for (int n = vb * 4 + wv; n < 2048; n += gridDim.x * 4) {
            const int hp = n >> 7;
            const f32x2 kv = *(const f32x2*)(p.keys + (size_t)n * 128 + 2 * ln);
            const f32x2 wg = *(const f32x2*)(p.wgb + hp * 128 + 2 * ln), wb = *(const f32x2*)(p.wgb + 2048 + hp * 128 + 2 * ln);
            const float a = wave_sum(kv.x * wg.x + kv.y * wg.y), b = wave_sum(kv.x * wb.x + kv.y * wb.y);
            if (ln < 4) {
                const u32x4 c0 = {pack2(a, b), 0u, 0u, 0u}; const u32x4 z4 = {0u, 0u, 0u, 0u};
                *((u32x4*)(p.mext + (size_t)n * 32) + ln) = ln == 0 ? c0 : z4;
            }
        }
    }
    const int tid = threadIdx.x, lane = tid & 63, wid = tid >> 6, wr = wid >> 1, wc = wid & 1, fr = lane & 15, fq = lane >> 4;
    for (int t = vb; t < 16 * 8; t += gridDim.x) {
        const int hp = t >> 3, d0 = (t & 7) * 128;
        f32x4 acc[4][4]; zero_acc(acc);
        gemm128(p.keysb + (size_t)hp * 128 * 128, 128, p.Wqb + (size_t)d0 * 2048 + hp * 128, 2048, 128, smem, acc);
#pragma unroll
        for (int mi = 0; mi < 4; ++mi)
#pragma unroll
            for (int ni = 0; ni < 4; ++ni) {
                uint2 o; o.x = pack2(acc[mi][ni][0], acc[mi][ni][1]); o.y = pack2(acc[mi][ni][2], acc[mi][ni][3]);
                *(uint2*)(p.MT + (size_t)(hp * 128 + wr * 64 + mi * 16 + fr) * DM + d0 + wc * 64 + ni * 16 + fq * 4) = o;
            }
    }
}

__device__ __forceinline__ void route_topk(const f32x16 (&S)[8], int pp, int hh, int (&K)[16]) {
    int v[4][16];
#pragma unroll
    for (int mt = 0; mt < 4; ++mt)
#pragma unroll
        for (int r = 0; r < 16; ++r) {
            const int n = mt * 32 + (r & 3) + 8 * (r >> 2) + 4 * hh;
            v[mt][r] = (f2key(S[pp * 4 + mt][r]) & ~0x7F) | (127 - n);
        }
    top16_of_64(v);
    int o[16];
#pragma unroll
    for (int i = 0; i < 16; ++i) o[i] = xhalf_i(v[0][i], hh != 0);
    merge_top16(v[0], o);
#pragma unroll
    for (int i = 0; i < 16; ++i) K[i] = v[0][i];
}
#define RT_STEPS 33
template <bool PRE, bool NEXT>
__device__ __forceinline__ void route_gemm(const Params& p, unsigned char* smem, int m0, int h, f32x16 (&S)[8], int nm0, int nh, int& sp) {
    LDS_AS unsigned char* lds = (LDS_AS unsigned char*)smem;
    const int tid = threadIdx.x, lane = tid & 63, wid = __builtin_amdgcn_readfirstlane(tid >> 6);
    const int r32 = lane & 31, hh = lane >> 5;
    const int prow = lane >> 2, pc = (lane & 3) ^ ((4 - ((prow >> 2) & 3)) & 3);
    const bf16_t* gA = p.y1b + (size_t)(m0 + wid * 32 + prow) * DM + pc * 8;
    const bf16_t* gB = p.MT + (size_t)(h * 256 + wid * 64 + prow) * DM + pc * 8;
    const bf16_t* eA = p.yext + (size_t)(m0 + wid * 32 + prow) * 32 + pc * 8;
    const bf16_t* eB = p.mext + (size_t)(h * 256 + wid * 64 + prow) * 32 + pc * 8;
    const size_t r16 = (size_t)16 * DM;
#define RH_ISSUE_AT(pa, sa, pb, sb_, st) do { \
        _Pragma("unroll") for (int _i = 0; _i < 2; ++_i) \
            __builtin_amdgcn_global_load_lds((const unsigned*)((pa) + _i * (sa)), (LDS_AS unsigned*)(lds + (st) * GW_STAGE + (wid * 2 + _i) * 1024), 16, 0, 0); \
        _Pragma("unroll") for (int _i = 0; _i < 4; ++_i) \
            __builtin_amdgcn_global_load_lds((const unsigned*)((pb) + _i * (sb_)), (LDS_AS unsigned*)(lds + (st) * GW_STAGE + 8192 + (wid * 4 + _i) * 1024), 16, 0, 0); \
        } while (0)
#pragma unroll
    for (int mt = 0; mt < 8; ++mt)
#pragma unroll
        for (int r = 0; r < 16; ++r) S[mt][r] = 0.f;
    const int fx = (4 - ((r32 >> 2) & 3)) & 3;
    const int toff = (wid * 32 + r32) * 64, koff = 8192 + r32 * 64;
    if (!PRE) RH_ISSUE_AT(gA, r16, gB, r16, sp);
#pragma unroll 1
    for (int kt = 0; kt < RT_STEPS; ++kt) {
        const int st = (kt + sp) & 1;
        asm volatile("s_waitcnt vmcnt(0)" ::: "memory");
        __builtin_amdgcn_s_barrier();
        asm volatile("" ::: "memory");
        if (kt + 1 < RT_STEPS - 1) RH_ISSUE_AT(gA + (size_t)(kt + 1) * 32, r16, gB + (size_t)(kt + 1) * 32, r16, st ^ 1);
        else if (kt + 1 == RT_STEPS - 1) RH_ISSUE_AT(eA, (size_t)(16 * 32), eB, (size_t)(16 * 32), st ^ 1);
        else if (NEXT) {
            const bf16_t* qA = p.y1b + (size_t)(nm0 + wid * 32 + prow) * DM + pc * 8;
            const bf16_t* qB = p.MT + (size_t)(nh * 256 + wid * 64 + prow) * DM + pc * 8;
            RH_ISSUE_AT(qA, r16, qB, r16, st ^ 1);
        }
        const LDS_AS unsigned char* sb = lds + st * GW_STAGE;
        __builtin_amdgcn_s_setprio(1);
#pragma unroll
        for (int k16 = 0; k16 < 2; ++k16) {
            const int sw = ((k16 * 2 + hh) ^ fx) * 16;
            const bf16x8 b = *(const LDS_AS bf16x8*)(sb + toff + sw);
#pragma unroll
            for (int mt = 0; mt < 8; ++mt) {
                const bf16x8 a = *(const LDS_AS bf16x8*)(sb + koff + mt * 2048 + sw);
                S[mt] = __builtin_amdgcn_mfma_f32_32x32x16_bf16(a, b, S[mt], 0, 0, 0);
            }
        }
        __builtin_amdgcn_s_setprio(0);
        asm volatile("s_waitcnt lgkmcnt(0)" ::: "memory");
        __builtin_amdgcn_s_barrier();
        asm volatile("" ::: "memory");
    }
    sp ^= (RT_STEPS & 1);
#undef RH_ISSUE_AT
}

__device__ void ph_route(const Params& p, unsigned char* smem, const int vb) {
    const int tid = threadIdx.x, lane = tid & 63, wid = tid >> 6;
    const int r32 = lane & 31, hh = lane >> 5;
    const int hmask = -hh;
    int* KL = (int*)(smem + 2 * GW_STAGE + (size_t)wid * 32 * 33 * 4);
    const int nunits = (T_TOK / 128) * 8;
    bool pre = false; int sp = 0;
    for (int u = vb; u < nunits; u += gridDim.x) {
        const int m0 = (u >> 3) * 128, h = u & 7;
        const int un = u + gridDim.x;
        const bool has_next = un < nunits;
        const int nm0 = ((has_next ? un : u) >> 3) * 128, nh = (has_next ? un : u) & 7;
        float mu, rstd;
        {
            const float* stp = p.stats + (size_t)(m0 + wid * 32 + r32) * 16;
            const f32x4 a = *(const f32x4*)(stp), b = *(const f32x4*)(stp + 4), c4 = *(const f32x4*)(stp + 8), d = *(const f32x4*)(stp + 12);
            const float sm = (a[0] + a[2]) + (b[0] + b[2]) + (c4[0] + c4[2]) + (d[0] + d[2]);
            const float sq = (a[1] + a[3]) + (b[1] + b[3]) + (c4[1] + c4[3]) + (d[1] + d[3]);
            mu = sm * (1.0f / 1024.0f);
            rstd = rsqrtf(fmaxf(sq * (1.0f / 1024.0f) - mu * mu, 0.f) + LN_EPS);
        }
        {
            bf16_t* ye = p.yext + (size_t)(m0 + wid * 32 + r32) * 32 + hh * 16;
            const u32x4 z4 = {0u, 0u, 0u, 0u};
            u32x4 c0 = z4; if (hh == 0) c0[0] = pack2(-mu, __builtin_amdgcn_rcpf(rstd));
            *(u32x4*)(ye) = c0; *(u32x4*)(ye + 8) = z4;
        }
        f32x16 S[8];
        if (pre) { if (has_next) route_gemm<true, true>(p, smem, m0, h, S, nm0, nh, sp); else route_gemm<true, false>(p, smem, m0, h, S, nm0, nh, sp); }
        else     { if (has_next) route_gemm<false, true>(p, smem, m0, h, S, nm0, nh, sp); else route_gemm<false, false>(p, smem, m0, h, S, nm0, nh, sp); }
        int K0[16], K1[16];
        route_topk(S, 0, hh, K0);
        route_topk(S, 1, hh, K1);
        pre = has_next;
#pragma unroll
        for (int i = 0; i < 16; ++i) KL[r32 * 33 + hh * 16 + i] = K0[i] ^ ((K0[i] ^ K1[i]) & hmask);
        float sa[16], sb[16];
#pragma unroll
        for (int i = 0; i < 16; ++i) {
            const int d = (K0[i] ^ K1[i]) & hmask;
            sa[i] = key2f((K0[i] ^ d) & ~0x7F); sb[i] = key2f((K1[i] ^ d) & ~0x7F);
        }
        int c[2][16];
        { const int k_ = (f2key(sa[0] + sb[0]) & ~0xFF) | 255; c[0][0] = k_ ^ ((k_ ^ KPAD) & hmask); }
        c[0][1] = (f2key(sa[0] + sb[1]) & ~0xFF) | (254 ^ (17 & hmask));
        c[0][2] = (f2key(sa[0] + sb[2]) & ~0xFF) | (253 ^ (34 & hmask));
        c[0][3] = (f2key(sa[0] + sb[3]) & ~0xFF) | (252 ^ (51 & hmask));
        c[0][4] = (f2key(sa[0] + sb[4]) & ~0xFF) | (251 ^ (68 & hmask));
        c[0][5] = (f2key(sa[0] + sb[5]) & ~0xFF) | (250 ^ (85 & hmask));
        c[0][6] = (f2key(sa[0] + sb[6]) & ~0xFF) | (249 ^ (102 & hmask));
        c[0][7] = (f2key(sa[0] + sb[7]) & ~0xFF) | (248 ^ (119 & hmask));
        c[0][8] = (f2key(sa[0] + sb[8]) & ~0xFF) | (247 ^ (136 & hmask));
        c[0][9] = (f2key(sa[0] + sb[9]) & ~0xFF) | (246 ^ (153 & hmask));
        c[0][10] = (f2key(sa[0] + sb[10]) & ~0xFF) | (245 ^ (170 & hmask));
        c[0][11] = (f2key(sa[0] + sb[11]) & ~0xFF) | (244 ^ (187 & hmask));
        c[0][12] = (f2key(sa[0] + sb[12]) & ~0xFF) | (243 ^ (204 & hmask));
        c[0][13] = (f2key(sa[0] + sb[13]) & ~0xFF) | (242 ^ (221 & hmask));
        c[0][14] = (f2key(sa[0] + sb[14]) & ~0xFF) | (241 ^ (238 & hmask));
        c[0][15] = (f2key(sa[0] + sb[15]) & ~0xFF) | (240 ^ (255 & hmask));
        { const int k_ = (f2key(sa[1] + sb[1]) & ~0xFF) | 238; c[1][0] = k_ ^ ((k_ ^ KPAD) & hmask); }
        c[1][1] = (f2key(sa[1] + sb[2]) & ~0xFF) | (237 ^ (51 & hmask));
        c[1][2] = (f2key(sa[1] + sb[3]) & ~0xFF) | (236 ^ (34 & hmask));
        c[1][3] = (f2key(sa[1] + sb[4]) & ~0xFF) | (235 ^ (85 & hmask));
        c[1][4] = (f2key(sa[1] + sb[5]) & ~0xFF) | (234 ^ (68 & hmask));
        c[1][5] = (f2key(sa[1] + sb[6]) & ~0xFF) | (233 ^ (119 & hmask));
        c[1][6] = (f2key(sa[1] + sb[7]) & ~0xFF) | (232 ^ (102 & hmask));
        { const int k_ = (f2key(sa[2] + sb[2]) & ~0xFF) | 221; c[1][7] = k_ ^ ((k_ ^ KPAD) & hmask); }
        c[1][8] = (f2key(sa[2] + sb[3]) & ~0xFF) | (220 ^ (17 & hmask));
        c[1][9] = (f2key(sa[2] + sb[4]) & ~0xFF) | (219 ^ (102 & hmask));
        { const int k_ = (f2key(sa[3] + sb[3]) & ~0xFF) | 204; c[1][10] = k_ ^ ((k_ ^ KPAD) & hmask); }
        c[1][11] = KPAD;
        c[1][12] = KPAD;
        c[1][13] = KPAD;
        c[1][14] = KPAD;
        c[1][15] = KPAD;
        sort16_desc(c[0]); sort16_desc(c[1]);
        merge_top16(c[0], c[1]);
        {
            int o[16];
#pragma unroll
            for (int i = 0; i < 16; ++i) o[i] = xhalf_i(c[0][i], hh != 0);
            merge_top16(c[0], o);
        }
        const float mx = key2f(c[0][0] & ~0xFF);
        float e[16]; float den = 0.f;
#pragma unroll
        for (int i = 0; i < 16; ++i) { e[i] = __expf(rstd * (key2f(c[0][i] & ~0xFF) - mx)); den += e[i]; }
        const float inv = __builtin_amdgcn_rcpf(den);
        const size_t ob = (size_t)(m0 + wid * 32 + r32) * 128 + h * 16 + hh * 8;
        int idv[8]; float gv[8];
#pragma unroll
        for (int qq = 0; qq < 8; ++qq) {
            const int F = c[0][qq] ^ ((c[0][qq] ^ c[0][8 + qq]) & hmask);
            gv[qq] = __int_as_float(__float_as_int(e[qq]) ^ ((__float_as_int(e[qq]) ^ __float_as_int(e[8 + qq])) & hmask)) * inv;
            const int idx = 255 - (F & 0xFF);
            const int k0 = KL[r32 * 33 + (idx >> 4)], k1 = KL[r32 * 33 + 16 + (idx & 15)];
            idv[qq] = (127 - (k0 & 0x7F)) * 128 + (127 - (k1 & 0x7F));
        }
        *(int4*)(p.ids + ob) = make_int4(idv[0], idv[1], idv[2], idv[3]);
        *(int4*)(p.ids + ob + 4) = make_int4(idv[4], idv[5], idv[6], idv[7]);
        *(float4*)(p.gates + ob) = make_float4(gv[0], gv[1], gv[2], gv[3]);
        *(float4*)(p.gates + ob + 4) = make_float4(gv[4], gv[5], gv[6], gv[7]);
    }
}

__device__ __forceinline__ float gelu_gate(float h, float g) { return 0.5f * h * (1.0f + erff(h * 0.70710678118654752f)) * g; }

__device__ void ph_peer_u(const Params& p, unsigned char* smem, const int vb) {
    const int lane = threadIdx.x & 63, wid = __builtin_amdgcn_readfirstlane(threadIdx.x >> 6);
    const int q = lane >> 3, c = lane & 7, j = lane & 15, kb = lane >> 4;
    const int nlb = gridDim.x >> 3, s = vb / nlb, lb = vb - s * nlb;
    const int stride = nlb * 4, t0 = lb * 4 + wid;
    const int ntok = (T_TOK - t0 + stride - 1) / stride;
    if (ntok <= 0) return;
    LDS_AS unsigned char* wb = (LDS_AS unsigned char*)smem + wid * 18432;
    LDS_AS unsigned char* ring = wb + 16384;
    const unsigned char* ubs = p.u8 + (size_t)__builtin_amdgcn_readfirstlane(s) * (16384 * 128);
    const unsigned ulo = (c ^ q) * 16, ulo1 = (c ^ q ^ 1) * 16;
    const unsigned char* rsrc; unsigned rstr;
    if (lane < 32) { rsrc = (const unsigned char*)p.ids + lane * 16; rstr = 512; }
    else if (lane < 48) { rsrc = (const unsigned char*)p.y1b + s * 256 + (lane - 32) * 16; rstr = 2048; }
    else { rsrc = (const unsigned char*)p.stats + ((2 * s + 1) >> 2) * 16; rstr = 64; }
#define PM_TOK(n) (t0 + ((n) < ntok ? (n) : ntok - 1) * stride)
#define PM_RING(n) do { if (lane < 49) __builtin_amdgcn_global_load_lds((const unsigned*)(rsrc + (size_t)PM_TOK(n) * rstr), (LDS_AS unsigned*)(ring + ((n) & 1) * 1024), 16, 0, 0); } while (0)
#define PM_IDS(n, ia, ib) do { const LDS_AS u32x4* _q = (const LDS_AS u32x4*)(ring + ((n) & 1) * 1024 + q * 32); \
        const u32x4 _a0 = _q[0], _a1 = _q[1], _b0 = _q[16], _b1 = _q[17]; \
        ia[0] = _a0[0]; ia[1] = _a0[1]; ia[2] = _a0[2]; ia[3] = _a0[3]; ia[4] = _a1[0]; ia[5] = _a1[1]; ia[6] = _a1[2]; ia[7] = _a1[3]; \
        ib[0] = _b0[0]; ib[1] = _b0[1]; ib[2] = _b0[2]; ib[3] = _b0[3]; ib[4] = _b1[0]; ib[5] = _b1[1]; ib[6] = _b1[2]; ib[7] = _b1[3]; } while (0)
#define PM_DMA(i, id) __builtin_amdgcn_global_load_lds((const unsigned*)(ubs + (unsigned)(((id) << 7) + (((i) & 1) ? ulo1 : ulo))), (LDS_AS unsigned*)(wb + (i) * 1024), 16, 0, 0)
    const int key = (j & 7) ^ (j >> 3);
    const LDS_AS unsigned char* brd = wb + j * 128 + (((2 * kb) ^ key) * 16);
    const int bx1 = (key & 1) ? -16 : 16;
    const LDS_AS unsigned char* ard = ring + (j & 1) * 1024 + 832 + kb * 32;
    PM_RING(0); PM_RING(1);
    asm volatile("s_waitcnt vmcnt(0)" ::: "memory");
    {
        unsigned ia[8], ib[8]; PM_IDS(0, ia, ib);
#pragma unroll
        for (int m = 0; m < 4; ++m) { PM_DMA(2 * m, ia[m]); PM_DMA(2 * m + 1, ib[m]); }
#pragma unroll
        for (int m = 4; m < 8; ++m) { PM_DMA(2 * m, ia[m]); PM_DMA(2 * m + 1, ib[m]); }
    }
    const int sqi = ((2 * s + 1) & 3) * 4;
#define PM_XLOAD(nn, xw, ssq) do { const LDS_AS unsigned char* _sl = ring + ((nn) & 1) * 1024; \
        xw = *(const LDS_AS unsigned*)(_sl + 512 + lane * 4); ssq = *(const LDS_AS float*)(_sl + 768 + sqi); } while (0)
#define PM_XCONV(xw, ssq, xq0, xq1, iscv) do { \
        const int _e2 = (int)(__float_as_uint(ssq) >> 23) - 126;              \
        int _eh = (_e2 + 1) >> 1; _eh = _eh < -60 ? -60 : (_eh > 60 ? 60 : _eh);    \
        const float _sc = __uint_as_float((unsigned)(127 + 8 - _eh) << 23); iscv = __uint_as_float((unsigned)(127 - 8 + _eh) << 23); \
        const float _x0 = bflo(xw) * _sc, _x1 = bfhi(xw) * _sc; \
        const unsigned _h8 = (unsigned)__builtin_amdgcn_cvt_pk_fp8_f32(_x0, _x1, 0, false); \
        const f32x2 _hd = __builtin_amdgcn_cvt_pk_f32_fp8((int)_h8, false); \
        const unsigned _l8 = (unsigned)__builtin_amdgcn_cvt_pk_fp8_f32(_x0 - _hd.x, _x1 - _hd.y, 0, false); \
        *(LDS_AS unsigned short*)(ring + 832 + lane * 2) = (unsigned short)_h8; \
        *(LDS_AS unsigned short*)(ring + 1024 + 832 + lane * 2) = (unsigned short)_l8; \
        xq0 = *(const LDS_AS u32x4*)(ard); xq1 = *(const LDS_AS u32x4*)(ard + 16); } while (0)
    u32x4 xc0, xc1; float isc;
    { unsigned xw; float ssq; PM_XLOAD(0, xw, ssq); PM_XCONV(xw, ssq, xc0, xc1, isc); }
#pragma unroll 1
    for (int n = 0; n < ntok; ++n) {
        const int t = t0 + n * stride;
        i64 xa[4];
        xa[0] = (i64)(((unsigned long long)xc0[1] << 32) | xc0[0]); xa[1] = (i64)(((unsigned long long)xc0[3] << 32) | xc0[2]);
        xa[2] = (i64)(((unsigned long long)xc1[1] << 32) | xc1[0]); xa[3] = (i64)(((unsigned long long)xc1[3] << 32) | xc1[2]);
        const float isc_cur = isc;
        f32x4 acc[8];
        asm volatile("s_waitcnt vmcnt(16)" ::: "memory");
        unsigned ia[8], ib[8]; PM_IDS(n + 1, ia, ib);
        PM_RING(n + 2);
        u32x4 bq[2][2]; unsigned xwn; float ssqn; u32x4 xn0, xn1; float iscn;
        asm volatile("s_waitcnt vmcnt(15)" ::: "memory");
        bq[0][0] = *(const LDS_AS u32x4*)(brd); bq[0][1] = *(const LDS_AS u32x4*)(brd + bx1);
#pragma unroll
        for (int m = 0; m < 8; ++m) {
            __builtin_amdgcn_s_setprio(2);
            if (m < 7) {
                asm volatile("s_waitcnt vmcnt(13)" ::: "memory");
                bq[(m + 1) & 1][0] = *(const LDS_AS u32x4*)(brd + (m + 1) * 2048); bq[(m + 1) & 1][1] = *(const LDS_AS u32x4*)(brd + (m + 1) * 2048 + bx1);
                asm volatile("s_waitcnt lgkmcnt(2)" ::: "memory");
            } else {
                asm volatile("s_waitcnt lgkmcnt(0)" ::: "memory");
            }
            PM_DMA(2 * m, ia[m]); PM_DMA(2 * m + 1, ib[m]);
            __builtin_amdgcn_s_setprio(0);
            const u32x4 b0 = bq[m & 1][0], b1 = bq[m & 1][1];
            f32x4 a = {0.f, 0.f, 0.f, 0.f};
            a = __builtin_amdgcn_mfma_f32_16x16x32_fp8_fp8(xa[0], (i64)(((unsigned long long)b0[1] << 32) | b0[0]), a, 0, 0, 0);
            a = __builtin_amdgcn_mfma_f32_16x16x32_fp8_fp8(xa[1], (i64)(((unsigned long long)b0[3] << 32) | b0[2]), a, 0, 0, 0);
            a = __builtin_amdgcn_mfma_f32_16x16x32_fp8_fp8(xa[2], (i64)(((unsigned long long)b1[1] << 32) | b1[0]), a, 0, 0, 0);
            a = __builtin_amdgcn_mfma_f32_16x16x32_fp8_fp8(xa[3], (i64)(((unsigned long long)b1[3] << 32) | b1[2]), a, 0, 0, 0);
            acc[m] = a;
            if (m == 1) PM_XLOAD(n + 1, xwn, ssqn);
            if (m == 4) PM_XCONV(xwn, ssqn, xn0, xn1, iscn);
        }
        if (lane < 16) {
            u32x4 o;
#pragma unroll
            for (int k = 0; k < 4; ++k) o[k] = pack2((acc[2 * k][0] + acc[2 * k][1]) * isc_cur, (acc[2 * k + 1][0] + acc[2 * k + 1][1]) * isc_cur);
            *(u32x4*)(p.hp + ((size_t)t * 8 + s) * 128 + lane * 8) = o;
        }
        xc0 = xn0; xc1 = xn1; isc = iscn;
    }
    asm volatile("s_waitcnt vmcnt(0)" ::: "memory");
}
__device__ void ph_peer_act(const Params& p, unsigned char* smem, const int vb) {
    const int lane = threadIdx.x & 63, wid = threadIdx.x >> 6;
    unsigned* lsc = (unsigned*)smem;
    LDS_AS unsigned char* img = (LDS_AS unsigned char*)smem + 65536 + wid * 256;
    __syncthreads();
    {
        const int wv = __builtin_amdgcn_readfirstlane(threadIdx.x >> 6);
#pragma unroll
        for (int i = 0; i < 16; ++i)
            __builtin_amdgcn_global_load_lds((const unsigned*)((const unsigned char*)p.sc2 + (wv * 16 + i) * 1024 + lane * 16), (LDS_AS unsigned*)((LDS_AS unsigned char*)smem + (wv * 16 + i) * 1024), 16, 0, 0);
        asm volatile("s_waitcnt vmcnt(0)" ::: "memory");
    }
    __syncthreads();
    const int e0 = 2 * lane, e1 = e0 + 1;
    const int ix0 = (e0 & 3) * 32 + ((e0 >> 2) & 3) * 8 + (e0 >> 4), ix1 = (e1 & 3) * 32 + ((e1 >> 2) & 3) * 8 + (e1 >> 4);
    for (int t = vb * 4 + wid; t < T_TOK; t += gridDim.x * 4) {
        f32x2 h = {0.f, 0.f};
#pragma unroll
        for (int s = 0; s < 8; ++s) { const unsigned w = *(const unsigned*)(p.hp + ((size_t)t * 8 + s) * 128 + 2 * lane); h += (f32x2){bflo(w), bfhi(w)}; }
        f32x2 pq = *(const f32x2*)(p.stats + (size_t)t * 16 + (lane & 7) * 2);
        pq.x += dppf<DPP_ROR(4)>(pq.x); pq.y += dppf<DPP_ROR(4)>(pq.y); pq.x += dppf<DPP_ROR(2)>(pq.x); pq.y += dppf<DPP_ROR(2)>(pq.y);
        pq.x += dppf<DPP_ROR(1)>(pq.x); pq.y += dppf<DPP_ROR(1)>(pq.y);
        const float mu = pq.x * (1.0f / 1024.0f), rstd = rsqrtf(fmaxf(pq.y * (1.0f / 1024.0f) - mu * mu, 0.f) + LN_EPS);
        int2 id = *(const int2*)(p.ids + (size_t)t * 128 + 2 * lane);
        id.x &= 0x3fff; id.y &= 0x3fff;
        const f32x2 gt = *(const f32x2*)(p.gates + (size_t)t * 128 + 2 * lane);
        const unsigned s0 = lsc[id.x], s1 = lsc[id.y];
        const unsigned c0 = p.cb2[id.x], c1 = p.cb2[id.y];
        f32x2 a;
        a.x = gelu_gate(rstd * (h.x * bflo(s0) - mu * bflo(c0)) + bfhi(c0), gt.x) * bfhi(s0);
        a.y = gelu_gate(rstd * (h.y * bflo(s1) - mu * bflo(c1)) + bfhi(c1), gt.y) * bfhi(s1);
        float am = fmaxf(fabsf(a.x), fabsf(a.y));
        am = wave_max(am);
        int be = (int)(__float_as_uint(am) >> 23); be = be < 20 ? 20 : (be > 240 ? 240 : be);
        const float sc = __uint_as_float((unsigned)(261 - be) << 23);
        const unsigned iscb = (unsigned)(be - 7) << 23;
        const float x0 = a.x * sc, x1 = a.y * sc;
        const unsigned h8 = (unsigned)__builtin_amdgcn_cvt_pk_fp8_f32(x0, x1, 0, false);
        const f32x2 hd = __builtin_amdgcn_cvt_pk_f32_fp8((int)h8, false);
        const unsigned l8 = (unsigned)__builtin_amdgcn_cvt_pk_fp8_f32(x0 - hd.x, x1 - hd.y, 0, false);
        img[ix0] = (unsigned char)h8; img[ix1] = (unsigned char)(h8 >> 8);
        img[128 + ix0] = (unsigned char)l8; img[128 + ix1] = (unsigned char)(l8 >> 8);
        const unsigned iw = *(const LDS_AS unsigned*)(img + lane * 4);
        *(unsigned*)((unsigned char*)p.gates + (size_t)t * 512 + lane * 4) = iw;
        if (lane < 3) {
            const unsigned pb = lane == 0 ? __float_as_uint(mu) : (lane == 1 ? __float_as_uint(rstd) : iscb);
            *(int2*)(p.ids + (size_t)t * 128 + 2 * lane) = make_int2(id.x | (int)(pb & 0xffff0000u), id.y | (int)(pb << 16));
        }
    }
}
typedef int v2i32 __attribute__((ext_vector_type(2)));
__device__ void ph_peer_v(const Params& p, unsigned char* smem, const int vb) {
    const int lane = threadIdx.x & 63, wid = __builtin_amdgcn_readfirstlane(threadIdx.x >> 6);
    const int q = lane >> 3, c = lane & 7, j = lane & 15, kb = lane >> 4;
    const int nlb = gridDim.x >> 3, s = vb / nlb, lb = vb - s * nlb;
    const int stride = nlb * 4, t0 = lb * 4 + wid;
    const int ntok = (T_TOK - t0 + stride - 1) / stride;
    if (ntok <= 0) return;
    LDS_AS unsigned char* wb = (LDS_AS unsigned char*)smem + wid * 18432;
    LDS_AS unsigned char* ring = wb + 16384;
    const unsigned char* vbs = p.v8 + (size_t)__builtin_amdgcn_readfirstlane(s) * (16384 * 128);
    const unsigned vlo = (c ^ q) * 16, vlo1 = (c ^ q ^ 1) * 16;
    const unsigned char* rsrc; unsigned rstr;
    if (lane < 32) { rsrc = (const unsigned char*)p.ids + lane * 16; rstr = 512; }
    else if (lane < 48) { rsrc = (const unsigned char*)p.gates + (lane - 32) * 16; rstr = 512; }
    else { rsrc = (const unsigned char*)p.y1b + s * 256 + (lane - 48) * 16; rstr = 2048; }
#define PV_RING(n) __builtin_amdgcn_global_load_lds((const unsigned*)(rsrc + (size_t)PM_TOK(n) * rstr), (LDS_AS unsigned*)(ring + ((n) & 1) * 1024), 16, 0, 0)
#define PV_IDS(n, idv) do { const LDS_AS u32x4* _q = (const LDS_AS u32x4*)(ring + ((n) & 1) * 1024 + q * 64); \
        _Pragma("unroll") for (int _k = 0; _k < 4; ++_k) { const u32x4 _v = _q[_k]; idv[4 * _k] = _v[0] & 0x3fffu; idv[4 * _k + 1] = _v[1] & 0x3fffu; idv[4 * _k + 2] = _v[2] & 0x3fffu; idv[4 * _k + 3] = _v[3] & 0x3fffu; } } while (0)
#define PV_DMA(i, id) __builtin_amdgcn_global_load_lds((const unsigned*)(vbs + (unsigned)(((id) << 7) + (((i) & 1) ? vlo1 : vlo))), (LDS_AS unsigned*)(wb + (i) * 1024), 16, 0, 0)
    const int key = (j >> 1) ^ (kb & 1);
    const LDS_AS unsigned char* tb = wb + (8 * kb + (j >> 1)) * 128 + (j & 1) * 8;
    const LDS_AS unsigned char* ard = ring + 512 + (j & 1) * 128 + kb * 32;
    const int dl = 32 * kb + (j & 1) * 16 + (j & 14), d0 = s * 128 + dl;
    const f32x2 g2 = *(const f32x2*)(p.ln1_g + d0), b2 = *(const f32x2*)(p.ln1_b + d0);
    PV_RING(0); PV_RING(1);
    asm volatile("s_waitcnt vmcnt(0)" ::: "memory");
    {
        unsigned idv[16]; PV_IDS(0, idv);
#pragma unroll
        for (int i = 0; i < 16; ++i) PV_DMA(i, idv[i]);
    }
#define PV_SLOT(nn, q0, q1, h4, h5, yy) do { const LDS_AS unsigned char* _sl = ring + ((nn) & 1) * 1024; \
        q0 = *(const LDS_AS u32x4*)(ard + ((nn) & 1) * 1024); q1 = *(const LDS_AS u32x4*)(ard + ((nn) & 1) * 1024 + 16); \
        h4 = *(const LDS_AS u32x4*)(_sl); h5 = *(const LDS_AS unsigned*)(_sl + 16); yy = *(const LDS_AS unsigned*)(_sl + 768 + dl * 2); } while (0)
    u32x4 xc0, xc1, hc4; unsigned hc5, ywc;
    PV_SLOT(0, xc0, xc1, hc4, hc5, ywc);
#pragma unroll 1
    for (int n = 0; n < ntok; ++n) {
        const int t = t0 + n * stride;
        const u32x4 hd4 = hc4; const unsigned hd5 = hc5, yw = ywc;
        i64 xa[4];
        xa[0] = (i64)(((unsigned long long)xc0[1] << 32) | xc0[0]); xa[1] = (i64)(((unsigned long long)xc0[3] << 32) | xc0[2]);
        xa[2] = (i64)(((unsigned long long)xc1[1] << 32) | xc1[0]); xa[3] = (i64)(((unsigned long long)xc1[3] << 32) | xc1[2]);
        const float mu = __uint_as_float((hd4[0] & 0xffff0000u) | (hd4[1] >> 16)), rs = __uint_as_float((hd4[2] & 0xffff0000u) | (hd4[3] >> 16));
        const float isc = __uint_as_float(hd5 & 0xffff0000u);
        f32x4 acc[8];
#pragma unroll
        for (int ct = 0; ct < 8; ++ct) acc[ct] = (f32x4){0.f, 0.f, 0.f, 0.f};
        asm volatile("s_waitcnt vmcnt(16)" ::: "memory");
        unsigned idv[16]; PV_IDS(n + 1, idv);
        PV_RING(n + 2);
        v2i32 bv[2][8];
        asm volatile("s_waitcnt vmcnt(13)" ::: "memory");
#pragma unroll
        for (int ct = 0; ct < 8; ++ct) bv[0][ct] = __builtin_amdgcn_ds_read_tr8_b64_v2i32((LDS_AS v2i32*)(tb + ((ct ^ key) << 4)));
#pragma unroll
        for (int ks = 0; ks < 4; ++ks) {
            __builtin_amdgcn_s_setprio(2);
            if (ks < 3) {
                asm volatile("s_waitcnt vmcnt(9)" ::: "memory");
#pragma unroll
                for (int ct = 0; ct < 8; ++ct) bv[(ks + 1) & 1][ct] = __builtin_amdgcn_ds_read_tr8_b64_v2i32((LDS_AS v2i32*)(tb + (ks + 1) * 4096 + ((ct ^ key) << 4)));
                asm volatile("s_waitcnt lgkmcnt(8)" ::: "memory");
            } else {
                asm volatile("s_waitcnt lgkmcnt(0)" ::: "memory");
            }
#pragma unroll
            for (int i = 0; i < 4; ++i) PV_DMA(4 * ks + i, idv[4 * ks + i]);
            __builtin_amdgcn_s_setprio(0);
#pragma unroll
            for (int ct = 0; ct < 8; ++ct)
                acc[ct] = __builtin_amdgcn_mfma_f32_16x16x32_fp8_fp8(xa[ks], (i64)(((unsigned long long)(unsigned)bv[ks & 1][ct][1] << 32) | (unsigned)bv[ks & 1][ct][0]), acc[ct], 0, 0, 0);
            if (ks == 1) PV_SLOT(n + 1, xc0, xc1, hc4, hc5, ywc);
        }
        float va, vc;
        {
            const float w0 = acc[0][0] + acc[0][1], w1 = acc[1][0] + acc[1][1], w2 = acc[2][0] + acc[2][1], w3 = acc[3][0] + acc[3][1];
            const float w4 = acc[4][0] + acc[4][1], w5 = acc[5][0] + acc[5][1], w6 = acc[6][0] + acc[6][1], w7 = acc[7][0] + acc[7][1];
            va = kb == 0 ? w0 : (kb == 1 ? w2 : (kb == 2 ? w4 : w6));
            vc = kb == 0 ? w1 : (kb == 1 ? w3 : (kb == 2 ? w5 : w7));
        }
        const bool od = (j & 1) != 0;
        const float got = dppf<DPP_XOR1>(od ? va : vc);
        const float p0 = (od ? got : va) * isc, p1 = (od ? vc : got) * isc;
        const float r0 = ALPHA * ((bflo(yw) - mu) * rs * g2.x + b2.x) + p0, r1 = ALPHA * ((bfhi(yw) - mu) * rs * g2.y + b2.y) + p1;
        *(unsigned*)(p.rb + (size_t)t * DM + d0) = pack2(r0, r1);
    }
    asm volatile("s_waitcnt vmcnt(0)" ::: "memory");
}

__device__ void ph_gemm_ple(const Params& p, unsigned char* smem, const int vb) {
    const int ntn = DM / 128;
    const int tid = threadIdx.x, lane = tid & 63, wid = tid >> 6, wr = wid >> 1, wc = wid & 1, fr = lane & 15, fq = lane >> 4;
    const int ntiles = (T_TOK / 128) * ntn;
    bool pre = false;
    for (int t = vb; t < ntiles; t += gridDim.x) {
        const int m0 = (t / ntn) * 128, n0 = (t % ntn) * 128;
        const int tn = t + gridDim.x;
        const bool has_next = tn < ntiles;
        const bf16_t* nA = p.pb + (size_t)((has_next ? tn : t) / ntn) * 128 * 256;
        const bf16_t* nB = p.WpT + (size_t)((has_next ? tn : t) % ntn) * 128 * 256;
        const bf16_t* gA = p.rb + (size_t)m0 * DM; const bf16_t* gB = p.WgT + (size_t)n0 * DM;
        f32x4 acc[4][4], acc2[4][4]; zero_acc(acc); zero_acc(acc2);
        if (pre) gemm128<true, true>(p.pb + (size_t)m0 * 256, 256, p.WpT + (size_t)n0 * 256, 256, 256, smem, acc2, gA, DM, gB, DM);
        else     gemm128<false, true>(p.pb + (size_t)m0 * 256, 256, p.WpT + (size_t)n0 * 256, 256, 256, smem, acc2, gA, DM, gB, DM);
        if (has_next) gemm128<true, true>(gA, DM, gB, DM, DM, smem, acc, nA, 256, nB, 256);
        else          gemm128<true, false>(gA, DM, gB, DM, DM, smem, acc);
        pre = has_next;
#pragma unroll
        for (int mi = 0; mi < 4; ++mi) {
            const int row = m0 + wr * 64 + mi * 16 + fr;
#pragma unroll
            for (int k = 0; k < 2; ++k) {
                const u32x4 rl = *(const u32x4*)(p.rb + (size_t)row * DM + n0 + wc * 64 + k * 32 + (fq & 1) * 16 + (fq & 2) * 4);
                const auto s0 = __builtin_amdgcn_permlane16_swap(rl[0], rl[2], false, false), s1 = __builtin_amdgcn_permlane16_swap(rl[1], rl[3], false, false);
                unsigned pk[2][2];
#pragma unroll
                for (int h = 0; h < 2; ++h) {
                    const int ni = 2 * k + h;
                    f32x4 rv = {bflo(s0[h]), bfhi(s0[h]), bflo(s1[h]), bfhi(s1[h])};
#pragma unroll
                    for (int r = 0; r < 4; ++r) rv[r] += sigmul(acc2[mi][ni][r], acc[mi][ni][r]);
                    pk[h][0] = pack2(rv[0], rv[1]); pk[h][1] = pack2(rv[2], rv[3]);
                }
                const auto t0 = __builtin_amdgcn_permlane16_swap(pk[0][0], pk[1][0], false, false), t1 = __builtin_amdgcn_permlane16_swap(pk[0][1], pk[1][1], false, false);
                *(u32x4*)(p.y2b + (size_t)row * DM + n0 + wc * 64 + k * 32 + (fq & 1) * 16 + (fq & 2) * 4) = (u32x4){t0[0], t1[0], t0[1], t1[1]};
            }
        }
    }
}

#define XB_TMO      128
#define XB_XCNT(j)  (256  + 64 * (j))
#define XB_XSUB(j)  (1280 + 64 * (j))
#define XB_XGEN(j)  (2304 + 64 * (j))
#define XB_TOP      3328
#define XB_TOPGEN   3392
#define XCD_BAR_WORDS 3456
#define XB_SPIN_CAP (1u << 20)
__device__ __forceinline__ unsigned xb_ld(unsigned* p)              { return __hip_atomic_load(p, __ATOMIC_RELAXED, __HIP_MEMORY_SCOPE_AGENT); }
__device__ __forceinline__ unsigned xb_add(unsigned* p, unsigned v) { return __hip_atomic_fetch_add(p, v, __ATOMIC_RELAXED, __HIP_MEMORY_SCOPE_AGENT); }
__device__ __forceinline__ unsigned xb_xcc_id() { return (unsigned)__builtin_amdgcn_s_getreg((3 << 11) | 20) & 0xFu; }
#define XB_SPIN(cond, bar) do { unsigned _sp = 0; while (cond) { __builtin_amdgcn_s_sleep(1); \
    if ((++_sp & 255u) == 0u) { if (xb_ld(&(bar)[XB_TMO])) break; if (_sp > XB_SPIN_CAP) { atomicAdd(&(bar)[XB_TMO], 1u); break; } } } } while (0)
struct XcdBarrier { unsigned* bar; unsigned x; volatile LDS_AS unsigned* st; };
__device__ __forceinline__ XcdBarrier xcd_barrier_post(unsigned* bar, volatile LDS_AS unsigned* st) {
    XcdBarrier b; b.bar = bar; b.x = xb_xcc_id(); b.st = st;
    if (threadIdx.x == 0) st[3] = xb_add(&bar[XB_XCNT(b.x)], 1u);
    return b;
}
__device__ __forceinline__ void xcd_barrier_complete(unsigned* bar, unsigned x, unsigned rank, unsigned& nloc, unsigned& nx, unsigned& vb) {
    const unsigned G = gridDim.x;
    unsigned sum, cnt, mine, sp = 0u; bool even;
    for (;;) {
        sum = 0u; cnt = 0u; mine = 0u; even = true;
#pragma unroll
        for (unsigned j = 0; j < 16; ++j) {
            const unsigned c = xb_ld(&bar[XB_XCNT(j)]); sum += c; cnt += (c > 0u) ? 1u : 0u; mine = (j == x) ? c : mine;
            even = even && (c == ((j < 8u) ? (G >> 3) : 0u));
        }
        if (sum == G) break;
        __builtin_amdgcn_s_sleep(1);
        if ((++sp & 255u) == 0u) { if (xb_ld(&bar[XB_TMO])) break; if (sp > XB_SPIN_CAP) { atomicAdd(&bar[XB_TMO], 1u); break; } }
    }
    nloc = mine > 0u ? mine : 1u; nx = cnt > 0u ? cnt : 1u;
    vb = (even && sum == G && (G & 7u) == 0u) ? (x * (G >> 3) + rank) : blockIdx.x;
}
__device__ __forceinline__ void xcd_barrier(const XcdBarrier& b) {
    asm volatile("s_waitcnt vmcnt(0)" ::: "memory");
    __syncthreads();
    if (threadIdx.x == 0) {
        unsigned* bar = b.bar;
        __builtin_amdgcn_s_waitcnt(0);
        unsigned nloc = b.st[0], nx = b.st[1];
        if (nloc == 0u) { unsigned vb; xcd_barrier_complete(bar, b.x, b.st[3], nloc, nx, vb); b.st[0] = nloc; b.st[1] = nx; b.st[2] = vb; }
        const unsigned old = xb_add(&bar[XB_XSUB(b.x)], 1u);
        const unsigned gen = old / nloc;
        if (old + 1u == (gen + 1u) * nloc) {
            __builtin_amdgcn_fence(__ATOMIC_RELEASE, "agent");
            asm volatile("s_waitcnt vmcnt(0)" ::: "memory");
            const unsigned og = xb_add(&bar[XB_TOP], 1u);
            const unsigned tg = og / nx;
            if (og + 1u == (tg + 1u) * nx) xb_add(&bar[XB_TOPGEN], 1u);
            else XB_SPIN(xb_ld(&bar[XB_TOPGEN]) == tg, bar);
            __builtin_amdgcn_fence(__ATOMIC_ACQUIRE, "agent");
            asm volatile("s_waitcnt vmcnt(0)" ::: "memory");
        } else {
            XB_SPIN(xb_ld(&bar[XB_TOPGEN]) == gen, bar);
            __builtin_amdgcn_fence(__ATOMIC_ACQUIRE, "agent");
            asm volatile("s_waitcnt vmcnt(0)" ::: "memory");
        }
    }
    __syncthreads();
}

#define SMEM_PHASE (256 * ASTR * 2 * 2)
#define SMEM_BYTES (SMEM_PHASE + 16)
__global__ void __launch_bounds__(256, 2) mega(Params p) {
    __shared__ __attribute__((aligned(16))) unsigned char smem[SMEM_BYTES];
    volatile LDS_AS unsigned* st = (volatile LDS_AS unsigned*)(LDS_AS unsigned char*)(smem + SMEM_PHASE);
    if (threadIdx.x < 4) st[threadIdx.x] = 0u;
    __syncthreads();
    const XcdBarrier gb = xcd_barrier_post(p.bar, st);
    ph_prep(p, smem);            xcd_barrier(gb);
    const int vb = (int)st[2];
    ph_gemm_in(p, smem, vb);     xcd_barrier(gb);
    if (vb & 1) { ph_tables(p, smem); ph_attn(p, smem, vb); ph_conv(p, smem, vb); }
    else        { ph_attn(p, smem, vb); ph_conv(p, smem, vb); ph_tables(p, smem); }
    xcd_barrier(gb);
    ph_mprep(p, smem, vb);
    ph_gemm_out(p, smem, vb);    xcd_barrier(gb);
    ph_route(p, smem, vb);       xcd_barrier(gb);
    ph_peer_u(p, smem, vb);      xcd_barrier(gb);
    ph_peer_act(p, smem, vb);    xcd_barrier(gb);
    ph_peer_v(p, smem, vb);      xcd_barrier(gb);
    ph_gemm_ple(p, smem, vb);    xcd_barrier(gb);
    ph_ln2(p, vb);
}

extern "C" void kernel_launch(void* const* d_in, const int* in_sizes, int n_in, void* d_out, int out_size, void* d_ws, size_t ws_size,
                              hipStream_t stream) {
    Params p{};
    p.x = (const float*)d_in[0]; p.p = (const float*)d_in[1]; p.pos = (const int*)d_in[2];
    p.w_in = (const float*)d_in[3]; p.sinks = (const float*)d_in[4]; p.conv_w = (const float*)d_in[5]; p.conv_b = (const float*)d_in[6];
    p.cln_g = (const float*)d_in[7]; p.cln_b = (const float*)d_in[8]; p.w_out = (const float*)d_in[9]; p.ln1_g = (const float*)d_in[10];
    p.ln1_b = (const float*)d_in[11]; p.wq = (const float*)d_in[12]; p.keys = (const float*)d_in[13]; p.pu = (const float*)d_in[14];
    p.pv = (const float*)d_in[15]; p.ple_proj = (const float*)d_in[16]; p.ple_gate = (const float*)d_in[17]; p.ln2_g = (const float*)d_in[18];
    p.ln2_b = (const float*)d_in[19];
    p.out = (float*)d_out;
    unsigned char* ws = (unsigned char*)d_ws;
    const size_t MiB = 1024 * 1024;
    p.y1 = (float*)(ws + 0 * MiB);
    p.y2b = (bf16_t*)(ws + 64 * MiB);
    p.hb = (bf16_t*)(ws + 128 * MiB);
    p.hp = (bf16_t*)(ws + 128 * MiB);
    p.xb = (bf16_t*)(ws + 256 * MiB);
    p.mixb = (bf16_t*)(ws + 320 * MiB);
    p.rb = (bf16_t*)(ws + 320 * MiB);
    p.pb = (bf16_t*)(ws + 384 * MiB);
    p.u8 = (unsigned char*)(ws + 400 * MiB);
    p.v8 = (unsigned char*)(ws + 416 * MiB);
    p.sc2 = (bf16_t*)(ws + 432 * MiB);
    p.rope = (float*)(ws + 434 * MiB);
    p.stats = (float*)(ws + 436 * MiB);
    p.cb2 = (unsigned*)(ws + 438 * MiB);
    p.mext = (bf16_t*)(ws + 440 * MiB);
    p.yext = (bf16_t*)(ws + 442 * MiB);
    p.y1b = (bf16_t*)(ws + 0 * MiB);
    p.ids = (int*)(ws + 464 * MiB);
    p.gates = (float*)(ws + 480 * MiB);
    unsigned char* wb = ws + 496 * MiB;
    p.WinT = (bf16_t*)wb; wb += (size_t)INW * DM * 2;
    p.WoutT = (bf16_t*)wb; wb += (size_t)DM * DM * 2;
    p.WgT = (bf16_t*)wb; wb += (size_t)DM * DM * 2;
    p.WpT = (bf16_t*)wb; wb += (size_t)DM * 256 * 2;
    p.keysb = (bf16_t*)wb; wb += (size_t)16 * 128 * 128 * 2;
    p.Wqb = (bf16_t*)(ws + 240 * MiB);
    p.MT = (bf16_t*)(ws + 244 * MiB);
    p.bar = (unsigned*)(ws + 510 * MiB);
    p.wgb = (float*)(p.bar + XCD_BAR_WORDS + 640);

    static int grid_blocks = 0;
    if (!grid_blocks) {
        int dev = 0, cus = 0, per_cu = 0;
        (void)hipGetDevice(&dev);
        (void)hipDeviceGetAttribute(&cus, hipDeviceAttributeMultiprocessorCount, dev);
        (void)hipOccupancyMaxActiveBlocksPerMultiprocessor(&per_cu, mega, 256, 0);
        if (per_cu > 2) per_cu = 2;
        grid_blocks = cus * per_cu;
    }
    (void)hipMemsetAsync(p.bar, 0, (XCD_BAR_WORDS + 640 + 4096) * sizeof(unsigned), stream);
    void* args[] = {&p};
    hipError_t e = hipLaunchCooperativeKernel((void*)mega, dim3(grid_blocks), dim3(256), args, 0, stream);
    if (e != hipSuccess) fprintf(stderr, "cooperative launch failed: %s (grid %d)\n", hipGetErrorString(e), grid_blocks);
}
```
